# Optimizing an MI355X kernel written in HIP

```python
import jax, jax.numpy as jnp
from jax import lax
import numpy as np

D_MODEL = 1024
BATCH = 8
SEQ = 4096
DEPTH = 4

FOX_HEADS = 8
FOX_HEAD_DIM = 64
FOX_WIDTH = FOX_HEADS * FOX_HEAD_DIM
QBLK = 128
HG_HEADS = 4
HG_DK = 64
HG_DV = 64
HG_KWIDTH = HG_HEADS * HG_DK
HG_WIDTH = HG_HEADS * HG_DV
HG_CHUNK = 64
POOL_WINDOWS = (2, 4, 8, 16)
POOL_GROUPS = 4
POOL_GROUP_DIM = 64
POOL_WIDTH = POOL_GROUPS * POOL_GROUP_DIM
MIX_WIDTH = FOX_WIDTH + HG_WIDTH + POOL_WIDTH
IN_COLS = 3 * FOX_WIDTH + FOX_HEADS + 2 * HG_KWIDTH + 2 * HG_WIDTH + POOL_WIDTH
N_EXPERTS = 32
TOP_K = 4
D_FF = 1024
SWIGLU_LIMIT = 7.0
SWIGLU_ALPHA = 1.702
MOE_BLOCK = 256
RMS_EPS = 1e-5

kernel_name = 'hybrid_fox_hgrn2_pool_moe_trunk'


def rmsnorm(x, g):
    xf = x.astype(jnp.float32)
    y = xf * lax.rsqrt(jnp.mean(xf * xf, axis=-1, keepdims=True) + RMS_EPS)
    return (y * g.astype(jnp.float32)).astype(x.dtype)


def split_projection(proj):
    sizes = (FOX_WIDTH, FOX_WIDTH, FOX_WIDTH, FOX_HEADS,
             HG_KWIDTH, HG_KWIDTH, HG_WIDTH, HG_WIDTH, POOL_WIDTH)
    points, acc = [], 0
    for s in sizes[:-1]:
        acc += s
        points.append(acc)
    return jnp.split(proj, points, axis=-1)


def fox_attention(q, k, v, logf):
    B, H, S, Dh = q.shape
    c = jnp.cumsum(logf, axis=-1)
    scale = 1.0 / math.sqrt(Dh) if False else Dh ** -0.5
    kpos = jnp.arange(S)
    nq = S // QBLK

    def block(i):
        start = i * QBLK
        qb = lax.dynamic_slice_in_dim(q, start, QBLK, axis=2)
        cb = lax.dynamic_slice_in_dim(c, start, QBLK, axis=2)
        s = jnp.einsum('bhqd,bhkd->bhqk', qb, k).astype(jnp.float32) * scale
        s = s + cb[..., None] - c[:, :, None, :]
        qpos = start + jnp.arange(QBLK)
        s = jnp.where(kpos[None, :] <= qpos[:, None], s, -jnp.inf)
        p = jax.nn.softmax(s, axis=-1)
        return jnp.einsum('bhqk,bhkd->bhqd', p.astype(v.dtype), v)

    o = lax.map(block, jnp.arange(nq))
    return o.transpose(1, 2, 0, 3, 4).reshape(B, H, S, Dh)


def hgrn2_chunked(q, f_logit, v, lb):
    B, S, H, Dk = q.shape
    Dv = v.shape[-1]
    C = HG_CHUNK
    nC = S // C
    fl = f_logit.astype(jnp.float32)
    lbf = lb.astype(jnp.float32)
    logf = jnp.logaddexp(jnp.log(lbf), jnp.log1p(-lbf) + jax.nn.log_sigmoid(fl))
    kk = (1.0 - lbf) * jax.nn.sigmoid(-fl)

    def chunks(t):
        return t.reshape(B, nC, C, H, t.shape[-1]).transpose(1, 0, 3, 2, 4)

    a = jnp.cumsum(chunks(logf), axis=3)
    causal = jnp.tril(jnp.ones((C, C), dtype=bool))

    def step(state, xs):
        qc, kc, vc, ac = xs
        o_inter = jnp.einsum('bhtk,bhkv->bhtv', qc * jnp.exp(ac), state)
        diff = ac[:, :, :, None, :] - ac[:, :, None, :, :]
        decay = jnp.exp(jnp.where(causal[:, :, None], diff, -jnp.inf))
        scores = jnp.einsum('bhtk,bhsk,bhtsk->bhts', qc, kc, decay)
        o = o_inter + jnp.einsum('bhts,bhsv->bhtv', scores, vc)
        a_last = ac[:, :, -1]
        new_state = jnp.exp(a_last)[..., None] * state + jnp.einsum(
            'bhsk,bhsv->bhkv', kc * jnp.exp(a_last[:, :, None] - ac), vc)
        return new_state, o

    init = jnp.zeros((B, H, Dk, Dv), jnp.float32)
    _, o = lax.scan(step, init, (chunks(q.astype(jnp.float32)), chunks(kk),
                                 chunks(v.astype(jnp.float32)), a))
    return o.transpose(1, 0, 3, 2, 4).reshape(B, S, H, Dv)


def pool_mixer(u, pool_w, pool_scale):
    B, S, _ = u.shape
    uf = u.astype(jnp.float32).reshape(B, S, POOL_GROUPS, POOL_GROUP_DIM)
    cs = jnp.cumsum(uf, axis=1)
    pos = jnp.arange(1, S + 1, dtype=jnp.float32)
    outs = []
    for g, w in enumerate(POOL_WINDOWS):
        c = cs[:, :, g]
        prev = jnp.pad(c[:, :-w], ((0, 0), (w, 0), (0, 0)))
        mean = (c - prev) / jnp.minimum(pos, float(w))[None, :, None]
        outs.append(mean - uf[:, :, g])
    pooled = jnp.stack(outs, axis=2)
    y = jnp.einsum('bsgc,gcd->bsgd', pooled, pool_w.astype(jnp.float32))
    y = y.reshape(B, S, POOL_WIDTH) * pool_scale.astype(jnp.float32)
    return y.astype(u.dtype)


def mixer(h, w_in, b_f, fox_gain, lb, hg_gain, pool_w, pool_scale, w_out):
    B, S, _ = h.shape
    proj = h @ w_in
    fq, fk, fv, ff, gq, gf, gi, gg, pu = split_projection(proj)

    def heads(t):
        return t.reshape(B, S, FOX_HEADS, FOX_HEAD_DIM).transpose(0, 2, 1, 3)
    logf = jax.nn.log_sigmoid((ff + b_f).astype(jnp.float32)).transpose(0, 2, 1)
    o_fox = fox_attention(heads(fq), heads(fk), heads(fv), logf)
    o_fox = rmsnorm(o_fox, fox_gain.reshape(FOX_HEADS, 1, FOX_HEAD_DIM))
    o_fox = o_fox.transpose(0, 2, 1, 3).reshape(B, S, FOX_WIDTH)

    o_hg = hgrn2_chunked(gq.reshape(B, S, HG_HEADS, HG_DK), gf.reshape(B, S, HG_HEADS, HG_DK),
                         gi.reshape(B, S, HG_HEADS, HG_DV), lb.reshape(HG_HEADS, HG_DK))
    o_hg = o_hg.astype(h.dtype)
    o_hg = rmsnorm(o_hg, hg_gain.reshape(HG_HEADS, HG_DV)) * jax.nn.silu(gg.reshape(B, S, HG_HEADS, HG_DV))
    o_hg = o_hg.reshape(B, S, HG_WIDTH)

    o_pool = pool_mixer(pu, pool_w, pool_scale)

    return jnp.concatenate([o_fox, o_hg, o_pool], axis=-1) @ w_out


def moe(h, w_router, b_router, w1, b1, w2, b2):
    B, S, D = h.shape
    T = B * S
    M = T * TOP_K
    xt = h.reshape(T, D)
    logits = xt.astype(jnp.float32) @ w_router.astype(jnp.float32) + b_router.astype(jnp.float32)
    top_val, top_idx = lax.top_k(logits, TOP_K)
    gate = jax.nn.softmax(top_val, axis=-1)
    e_flat = top_idx.reshape(M)
    order = jnp.argsort(e_flat, stable=True)
    e_sorted = e_flat[order]
    tok_sorted = order // TOP_K
    gate_sorted = gate.reshape(M)[order]
    counts = jnp.bincount(e_flat, length=N_EXPERTS)
    padded = (counts + MOE_BLOCK - 1) // MOE_BLOCK * MOE_BLOCK
    start = jnp.cumsum(counts) - counts
    pend = jnp.cumsum(padded)
    pstart = pend - padded
    dst = pstart[e_sorted] + (jnp.arange(M) - start[e_sorted])
    R = -(-M // MOE_BLOCK) * MOE_BLOCK + N_EXPERTS * MOE_BLOCK
    NB = R // MOE_BLOCK
    buf = jnp.zeros((R, D), h.dtype).at[dst].set(xt[tok_sorted])
    block_e = jnp.minimum(jnp.searchsorted(pend, jnp.arange(NB) * MOE_BLOCK, side='right'),
                          N_EXPERTS - 1)

    def expert_block(args):
        xb, e = args
        hh = xb @ w1[e] + b1[e]
        glu = jnp.minimum(hh[:, 0::2], SWIGLU_LIMIT)
        lin = jnp.clip(hh[:, 1::2], -SWIGLU_LIMIT, SWIGLU_LIMIT)
        act = glu * jax.nn.sigmoid(SWIGLU_ALPHA * glu) * (lin + 1.0)
        return act @ w2[e] + b2[e]

    yb = lax.map(expert_block, (buf.reshape(NB, MOE_BLOCK, D), block_e))
    y_sorted = yb.reshape(R, D)[dst] * gate_sorted[:, None].astype(h.dtype)
    out = jax.ops.segment_sum(y_sorted, tok_sorted, num_segments=T)
    return out.reshape(B, S, D)


def setup_inputs(seed: int = 0) -> dict:
    key = jax.random.key(seed)
    ks = jax.random.split(key, 18)
    nrm = jax.random.normal
    L, D, E, F = DEPTH, D_MODEL, N_EXPERTS, D_FF
    res_scale = (2 * DEPTH) ** -0.5
    return {
        'x': nrm(ks[0], (BATCH, SEQ, D), jnp.float32),
        'norm_mix': 1.0 + 0.02 * nrm(ks[1], (L, D), jnp.float32),
        'w_in': nrm(ks[2], (L, D, IN_COLS), jnp.float32) * D ** -0.5,
        'b_fox_f': 1.5 + 0.5 * nrm(ks[3], (L, FOX_HEADS), jnp.float32),
        'fox_gain': 1.0 + 0.02 * nrm(ks[4], (L, FOX_WIDTH), jnp.float32),
        'hgrn_lb': 0.1 * nrm(ks[5], (L, HG_KWIDTH), jnp.float32),
        'hgrn_gain': 1.0 + 0.02 * nrm(ks[6], (L, HG_WIDTH), jnp.float32),
        'pool_w': nrm(ks[7], (L, POOL_GROUPS, POOL_GROUP_DIM, POOL_GROUP_DIM), jnp.float32) * POOL_GROUP_DIM ** -0.5,
        'pool_scale': 1.0 + 0.1 * nrm(ks[8], (L, POOL_WIDTH), jnp.float32),
        'w_out': nrm(ks[9], (L, MIX_WIDTH, D), jnp.float32) * MIX_WIDTH ** -0.5 * res_scale,
        'norm_moe': 1.0 + 0.02 * nrm(ks[10], (L, D), jnp.float32),
        'w_router': nrm(ks[11], (L, D, E), jnp.float32) * D ** -0.5,
        'b_router': 0.01 * nrm(ks[12], (L, E), jnp.float32),
        'w1': nrm(ks[13], (L, E, D, 2 * F), jnp.float32) * D ** -0.5,
        'b1': 0.01 * nrm(ks[14], (L, E, 2 * F), jnp.float32),
        'w2': nrm(ks[15], (L, E, F, D), jnp.float32) * F ** -0.5 * res_scale,
        'b2': 0.01 * nrm(ks[16], (L, E, D), jnp.float32),
        'norm_final': 1.0 + 0.02 * nrm(ks[17], (D,), jnp.float32),
    }


def reference(x, norm_mix, w_in, b_fox_f, fox_gain, hgrn_lb, hgrn_gain, pool_w, pool_scale,
              w_out, norm_moe, w_router, b_router, w1, b1, w2, b2, norm_final):
    p = jax.nn.softmax(hgrn_lb.astype(jnp.float32), axis=0)
    cs = jnp.cumsum(p, axis=0)
    lbs = cs - cs[0:1]
    h = x
    for l in range(DEPTH):
        h = h + mixer(rmsnorm(h, norm_mix[l]), w_in[l], b_fox_f[l], fox_gain[l], lbs[l],
                      hgrn_gain[l], pool_w[l], pool_scale[l], w_out[l])
        h = h + moe(rmsnorm(h, norm_moe[l]), w_router[l], b_router[l], w1[l], b1[l], w2[l], b2[l])
    return rmsnorm(h, norm_final)
```

```cpp
#include <hip/hip_runtime.h>
#include <cstdio>
#include <cstdint>

#ifndef MK_SPLIT
#define MK_SPLIT 1
#endif

#define LAS __attribute__((address_space(3)))
#define GAS __attribute__((address_space(1)))
typedef unsigned short bf16_t;
typedef short bf16x8 __attribute__((ext_vector_type(8)));
typedef float f32x4 __attribute__((ext_vector_type(4)));
typedef float f32x2 __attribute__((ext_vector_type(2)));
typedef float f32x16 __attribute__((ext_vector_type(16)));
typedef unsigned u32x4 __attribute__((ext_vector_type(4)));
typedef unsigned u32x2 __attribute__((ext_vector_type(2)));
typedef __bf16 bf16x2_t __attribute__((ext_vector_type(2)));
typedef short v4i16_t __attribute__((ext_vector_type(4)));

constexpr int NB = 8, SEQ = 4096, T = NB * SEQ, D = 1024, NL = 4;
constexpr int NPROJ = 2816;
constexpr int C_FQ = 0, C_FK = 512, C_FV = 1024, C_GQ = 1536, C_GF = 1792, C_GI = 2048, C_GG = 2304, C_PU = 2560;
constexpr int IN_COLS = 2824;
constexpr int NE = 32, TOPK = 4, FF = 1024, MROWS = T * TOPK, LISTCAP = MROWS, MAXTILES = MROWS / 256 + NE;
constexpr float RMS_EPS = 1e-5f, LOG2E = 1.4426950408889634f;
constexpr float QSCALE = 0.125f * LOG2E;
constexpr int NWAVES = 8, NTHREADS = 512;

constexpr size_t MiB = 1u << 20;
constexpr size_t WS_CTL = 0, CTL_ZERO_BYTES = 1 * MiB;
constexpr size_t WS_RSTD1 = 1 * MiB, WS_RSTD2 = WS_RSTD1 + 128 * 1024;
constexpr size_t WS_LOGF = 2 * MiB, WS_C2 = 3 * MiB, WS_GATE = 4 * MiB, WS_B1R = 5 * MiB, WS_WFRAG = 6 * MiB, WS_LIST = 8 * MiB;
constexpr size_t WS_WIN = 40 * MiB, WIN_BYTES = (size_t)NPROJ * D * 2;
constexpr size_t WS_WOUT = 62 * MiB, WOUT_BYTES = (size_t)D * D * 2;
constexpr size_t WS_W1 = 70 * MiB, W1E_BYTES = (size_t)2 * FF * D * 2;
constexpr size_t WS_W2 = 582 * MiB, W2E_BYTES = (size_t)D * FF * 2;
constexpr size_t WS_HB = 838 * MiB;
constexpr size_t WS_PA = 902 * MiB;
constexpr size_t WS_MIXED = WS_PA + 176 * MiB;
constexpr size_t WS_Y = 1174 * MiB;
constexpr size_t WS_ORAW = 1430 * MiB;
constexpr size_t WS_END = 1558 * MiB;
static_assert(WS_WIN + NL * WIN_BYTES <= WS_WOUT && WS_WOUT + NL * WOUT_BYTES <= WS_W1 && WS_W1 + (size_t)NL * NE * W1E_BYTES <= WS_W2 && WS_W2 + (size_t)NL * NE * W2E_BYTES <= WS_HB, "ws map");
static_assert((size_t)MAXTILES * 256 * FF * 2 <= 272 * MiB && (size_t)T * NPROJ * 2 <= 176 * MiB, "ws map 2");
constexpr int CW_TMO = 0, CW_BAR = 4096, CW_CUR = 16384, CW_KMAX = 32768;
constexpr int PH_BYTES = 139264, LDSCTL_OFF = PH_BYTES, LDS_BYTES = PH_BYTES + 2048;
constexpr int LC_BAR = 0, LC_TB = 64, LC_CN = 256, LC_R2CNT = 512, LC_R2BASE = 640, LC_STOP = 768, LC_SCAN = 896, LC_INP = 1024;

__device__ __forceinline__ unsigned cvtpk(float lo, float hi) { f32x2 v = {lo, hi}; bf16x2_t b = __builtin_convertvector(v, bf16x2_t); return __builtin_bit_cast(unsigned, b); }
__device__ __forceinline__ float bflo(unsigned w) { return __uint_as_float(w << 16); }
__device__ __forceinline__ float bfhi(unsigned w) { return __uint_as_float(w & 0xffff0000u); }
__device__ __forceinline__ float bf2f(bf16_t h) { return __uint_as_float((unsigned)h << 16); }
__device__ __forceinline__ bf16_t f2bf(float f) { return (bf16_t)(cvtpk(f, 0.f) & 0xffffu); }
__device__ __forceinline__ float rdlane(float v, int l) { return __uint_as_float((unsigned)__builtin_amdgcn_readlane((int)__float_as_uint(v), l)); }
#define LDS_WAIT() asm volatile("s_waitcnt lgkmcnt(0)" ::: "memory")
#define VM_WAIT() asm volatile("s_waitcnt vmcnt(0)" ::: "memory")

namespace pg8 {
constexpr int BM = 256, BK = 64, HALF = 128, HTB = HALF * BK * 2, STAGE_BYTES = 8 * HTB, NXCD = 8, WGM = 8;
__host__ __device__ __forceinline__ int lds_byte(int r, int c) { const int st = (r >> 4) * 2 + (c >> 5), rr = r & 15, cc = c & 31, ob = rr * 64 + cc * 2; return st * 1024 + (ob ^ (((ob >> 9) & 1) << 5)); }
__host__ __device__ __forceinline__ void stage_rc(int b, int& R, int& C) { const int st = b / 1024, sb = b % 1024, swz = sb ^ (((sb >> 9) & 1) << 5); R = (st >> 1) * 16 + swz / 64; C = (st & 1) * 32 + (swz % 64) / 2; }
__host__ __device__ __forceinline__ int perm32(int rho) { const int n = rho >> 4, i = rho & 15; return 8 * (i >> 2) + 4 * n + (i & 3); }

struct Unit { int pm, pn, e, lt, cnt; };

__device__ __forceinline__ void tile_of(int L, int nM, int nN, int& pm, int& pn) {
    const int nwg = nM * nN; int wgid = L;
    { const int q = nwg / NXCD, r = nwg % NXCD, xcd = wgid % NXCD, off = wgid / NXCD; wgid = (xcd < r ? xcd * (q + 1) : r * (q + 1) + (xcd - r) * q) + off; }
    const int nig = WGM * nN, gid = wgid / nig, fm = gid * WGM, gsz = (nM - fm) < WGM ? (nM - fm) : WGM;
    pm = fm + ((wgid % nig) % gsz); pn = (wgid % nig) / gsz;
}
struct StaticOrder {
    int nM, nN, nwg, G, c; const char* Bt; size_t tstep;
    __device__ void init(int M, int N, int K, int G_, int c_, const bf16_t* Bt_) { nM = M / BM; nN = N / BM; nwg = nM * nN; G = G_; c = c_; Bt = (const char*)Bt_; tstep = (size_t)BM * K * 2; }
    __device__ __forceinline__ bool next(int i, Unit& u) const { const long L = (long)i * G + c; if (L >= nwg) return false; tile_of((int)L, nM, nN, u.pm, u.pn); u.e = 0; u.lt = 0; u.cnt = 0; return true; }
    __device__ __forceinline__ const char* bbase(const Unit& u) const { return Bt + (size_t)u.pn * tstep; }
    __device__ __forceinline__ int arow(const Unit& u, int r) const { return u.pm * BM + r; }
};
template <bool GATHER> struct MoeOrder {
    int nM, nN, nwg, G, c; const char* Wt; size_t estride, tstep; LAS const int* tb; LAS const int* cn; const u32x2* list;
    __device__ __forceinline__ bool next(int i, Unit& u) const {
        const long L = (long)i * G + c; if (L >= nwg) return false; tile_of((int)L, nM, nN, u.pm, u.pn);
        int e = 0; while (e < NE - 1 && tb[e + 1] <= u.pm) ++e;
        u.e = e; u.lt = u.pm - tb[e]; u.cnt = cn[e]; return true; }
    __device__ __forceinline__ const char* bbase(const Unit& u) const { return Wt + (size_t)u.e * estride + (size_t)u.pn * tstep; }
    __device__ __forceinline__ int arow(const Unit& u, int r) const {
        if (!GATHER) return u.pm * BM + r;
        const int pos = u.lt * BM + r; return pos < u.cnt ? (int)(list[(size_t)u.e * LISTCAP + pos].x >> 2) : 0; }
};

template <class Epi, class Sched, bool ALIGN_EPI>
__device__ __forceinline__ void gemm_phase(const int tid, LAS unsigned char* lds, const bf16_t* Abase, const int K, const Sched& S, const Epi& E) {
    const int wid = __builtin_amdgcn_readfirstlane(tid >> 6), lane = tid & 63, wr = wid >> 2, wc = wid & 3, fr = lane & 15, fq = lane >> 4;
    const int nt = K / BK;
    unsigned voffB[2];
#pragma unroll
    for (int i = 0; i < 2; ++i) { int R, C; stage_rc(tid * 16 + i * 8192, R, C); const int Rb = Epi::PERM ? ((R & ~31) + perm32(R & 31)) : R; voffB[i] = (unsigned)(Rb * K + C) * 2u; }
    const size_t kstep = (size_t)(BK * 2);
    const size_t hstep = (size_t)HALF * K * 2;
    const unsigned ldsw = (unsigned)wid * 1024u;
    const int aoff = lds_byte(wr * 64 + fr, fq * 8), boff = lds_byte(wc * 32 + fr, fq * 8);
    const char* A8 = (const char*)Abase;
#define PG8_SA(b, h) (((b) * 2 + (h)) * HTB)
#define PG8_SB(b, h) ((4 + (b) * 2 + (h)) * HTB)
#define PG8_STGB(bufoff, gbase) do { _Pragma("unroll") for (int _i = 0; _i < 2; ++_i) \
        __builtin_amdgcn_global_load_lds((const unsigned*)((const char*)(gbase) + voffB[_i]), (LAS unsigned*)(lds + (bufoff) + ldsw + _i * 8192), 16, 0, 0); } while (0)
#define PG8_STGA(bufoff, kb, o0, o1) do { \
        __builtin_amdgcn_global_load_lds((const unsigned*)(A8 + (size_t)(kb) + (o0)), (LAS unsigned*)(lds + (bufoff) + ldsw), 16, 0, 0); \
        __builtin_amdgcn_global_load_lds((const unsigned*)(A8 + (size_t)(kb) + (o1)), (LAS unsigned*)(lds + (bufoff) + ldsw + 8192), 16, 0, 0); } while (0)
#define PG8_LDA(dst, b, h) do { _Pragma("unroll") for (int m = 0; m < 4; ++m) _Pragma("unroll") for (int k = 0; k < 2; ++k) dst[m][k] = *(const LAS bf16x8*)(lds + PG8_SA(b, h) + aoff + m * 2048 + k * 1024); } while (0)
#define PG8_LDB(dst, b, h) do { _Pragma("unroll") for (int n = 0; n < 2; ++n) _Pragma("unroll") for (int k = 0; k < 2; ++k) dst[n][k] = *(const LAS bf16x8*)(lds + PG8_SB(b, h) + boff + n * 2048 + k * 1024); } while (0)
#define PG8_MMA(ai, bj, At, Bt) do { __builtin_amdgcn_s_setprio(1); _Pragma("unroll") for (int m = 0; m < 4; ++m) _Pragma("unroll") for (int n = 0; n < 2; ++n) _Pragma("unroll") for (int k = 0; k < 2; ++k) \
        acc[ai][bj][m][n] = __builtin_amdgcn_mfma_f32_16x16x32_bf16(Bt[n][k], At[m][k], acc[ai][bj][m][n], 0, 0, 0); __builtin_amdgcn_s_setprio(0); } while (0)
#define PG8_WAIT_V(n) asm volatile("s_waitcnt vmcnt(" #n ")" ::: "memory")
#define PG8_WAIT_L(n) asm volatile("s_waitcnt lgkmcnt(" #n ")" ::: "memory")
#define PG8_BAR __builtin_amdgcn_s_barrier()
#define PG8_SCHED __builtin_amdgcn_sched_barrier(0)
#define PG8_AOFF(u, dst) do { _Pragma("unroll") for (int _h = 0; _h < 2; ++_h) _Pragma("unroll") for (int _i = 0; _i < 2; ++_i) \
        { int R_, C_; stage_rc(tid * 16 + _i * 8192, R_, C_); dst[_h][_i] = (unsigned)((size_t)S.arow(u, _h * HALF + R_) * (size_t)K + (size_t)C_) * 2u; } } while (0)
    Unit cur, nxt; int ui = 0;
    if (!S.next(0, cur)) return;
    f32x4 acc[2][2][4][2];
#pragma unroll
    for (int a = 0; a < 2; ++a)
#pragma unroll
        for (int b = 0; b < 2; ++b)
#pragma unroll
            for (int m = 0; m < 4; ++m)
#pragma unroll
                for (int n = 0; n < 2; ++n) acc[a][b][m][n] = (f32x4){0.f, 0.f, 0.f, 0.f};
    bf16x8 At[4][2], B0[2][2], B1[2][2];
    unsigned aoC[2][2], aoN[2][2];
    PG8_AOFF(cur, aoC);
    const char* cB = S.bbase(cur);
    PG8_STGB(PG8_SB(0, 0), cB); PG8_STGB(PG8_SB(0, 1), cB + hstep); PG8_STGA(PG8_SA(0, 0), 0, aoC[0][0], aoC[0][1]); PG8_STGA(PG8_SA(0, 1), 0, aoC[1][0], aoC[1][1]);
    if (wr == 1) PG8_BAR;
    PG8_WAIT_V(2); PG8_BAR;
    PG8_STGB(PG8_SB(1, 0), cB + kstep); PG8_STGA(PG8_SA(1, 0), kstep, aoC[0][0], aoC[0][1]); PG8_STGB(PG8_SB(1, 1), cB + hstep + kstep);
    PG8_WAIT_V(6); PG8_BAR;
    for (;;) {
        const bool has_next = S.next(ui + 1, nxt);
        if (has_next) { PG8_AOFF(nxt, aoN); } else { aoN[0][0] = aoC[0][0]; aoN[0][1] = aoC[0][1]; aoN[1][0] = aoC[1][0]; aoN[1][1] = aoC[1][1]; }
        const char* nB = has_next ? S.bbase(nxt) : cB;
        for (int t = 0; t < nt; t += 2) {
            const bool last = (t == nt - 2);
            const size_t k1 = (size_t)(t + 1) * kstep, k2 = last ? 0 : (size_t)(t + 2) * kstep, k3 = k2 + kstep;
            const char* b2 = last ? nB : cB + (size_t)(t + 2) * kstep; const char* b3 = b2 + kstep;
            const unsigned a200 = last ? aoN[0][0] : aoC[0][0], a201 = last ? aoN[0][1] : aoC[0][1], a210 = last ? aoN[1][0] : aoC[1][0], a211 = last ? aoN[1][1] : aoC[1][1];
            PG8_LDB(B0, 0, 0); PG8_LDB(B1, 0, 1); PG8_SCHED; PG8_LDA(At, 0, 0); PG8_STGA(PG8_SA(1, 1), k1, aoC[1][0], aoC[1][1]);
            PG8_WAIT_V(8); PG8_WAIT_L(0); PG8_BAR; PG8_MMA(0, 0, At, B0); PG8_MMA(0, 1, At, B1); PG8_BAR; PG8_SCHED;
            PG8_LDA(At, 0, 1); PG8_STGB(PG8_SB(0, 0), b2); PG8_STGB(PG8_SB(0, 1), b2 + hstep); PG8_STGA(PG8_SA(0, 0), k2, a200, a201);
            PG8_WAIT_V(8); PG8_WAIT_L(0); PG8_BAR; PG8_MMA(1, 0, At, B0); PG8_MMA(1, 1, At, B1); PG8_BAR; PG8_SCHED;
            PG8_LDB(B0, 1, 0); PG8_LDB(B1, 1, 1); PG8_SCHED; PG8_LDA(At, 1, 0); PG8_STGA(PG8_SA(0, 1), k2, a210, a211);
            PG8_WAIT_V(8); PG8_WAIT_L(0); PG8_BAR; PG8_MMA(0, 0, At, B0); PG8_MMA(0, 1, At, B1); PG8_BAR; PG8_SCHED;
            PG8_LDA(At, 1, 1); PG8_STGB(PG8_SB(1, 0), b3); PG8_STGB(PG8_SB(1, 1), b3 + hstep); PG8_STGA(PG8_SA(1, 0), k3, a200, a201);
            PG8_WAIT_V(8); PG8_WAIT_L(0); PG8_BAR; PG8_MMA(1, 0, At, B0); PG8_MMA(1, 1, At, B1); PG8_BAR; PG8_SCHED;
        }
        if constexpr (ALIGN_EPI) { if (wr == 0) PG8_BAR; }
        E(acc, cur, wr, wc, fr, fq);
        if (!has_next) break;
#pragma unroll
        for (int a = 0; a < 2; ++a)
#pragma unroll
            for (int b = 0; b < 2; ++b)
#pragma unroll
                for (int m = 0; m < 4; ++m)
#pragma unroll
                    for (int n = 0; n < 2; ++n) acc[a][b][m][n] = (f32x4){0.f, 0.f, 0.f, 0.f};
        cur = nxt; cB = nB; ++ui;
        aoC[0][0] = aoN[0][0]; aoC[0][1] = aoN[0][1]; aoC[1][0] = aoN[1][0]; aoC[1][1] = aoN[1][1];
        if constexpr (ALIGN_EPI) { if (wr == 1) PG8_BAR; }
    }
    PG8_WAIT_V(0);
    if constexpr (!ALIGN_EPI) { if (wr == 0) PG8_BAR; }
    PG8_BAR;
#undef PG8_SA
#undef PG8_SB
#undef PG8_STGA
#undef PG8_STGB
#undef PG8_LDA
#undef PG8_LDB
#undef PG8_MMA
#undef PG8_WAIT_V
#undef PG8_WAIT_L
#undef PG8_BAR
#undef PG8_SCHED
#undef PG8_AOFF
}

struct EpiProj {
    static constexpr bool PERM = true;
    bf16_t* O; const float* rstd; unsigned* kmax;
    __device__ __forceinline__ void operator()(const f32x4 (&acc)[2][2][4][2], const Unit& u, int wr, int wc, int fr, int fq) const {
        const int row0 = u.pm * BM + wr * 64 + fr, col0 = u.pn * BM + wc * 32 + 8 * fq;
        const float sc = (u.pn < 2) ? QSCALE : 1.f; const bool isk = (u.pn == 2 || u.pn == 3);
        float km[2] = {0.f, 0.f};
#pragma unroll
        for (int ai = 0; ai < 2; ++ai)
#pragma unroll
            for (int m = 0; m < 4; ++m) { const int row = row0 + ai * HALF + m * 16; const float rs = rstd[row] * sc; bf16_t* rowp = O + (size_t)row * NPROJ + col0;
#pragma unroll
                for (int bj = 0; bj < 2; ++bj) { const f32x4 v0 = acc[ai][bj][m][0] * rs, v1 = acc[ai][bj][m][1] * rs;
                    u32x4 w; w.x = cvtpk(v0[0], v0[1]); w.y = cvtpk(v0[2], v0[3]); w.z = cvtpk(v1[0], v1[1]); w.w = cvtpk(v1[2], v1[3]);
                    *(u32x4*)(rowp + bj * HALF) = w;
                    if (isk) { float s = bflo(w.x) * bflo(w.x) + bfhi(w.x) * bfhi(w.x) + bflo(w.y) * bflo(w.y) + bfhi(w.y) * bfhi(w.y) + bflo(w.z) * bflo(w.z) + bfhi(w.z) * bfhi(w.z) + bflo(w.w) * bflo(w.w) + bfhi(w.w) * bfhi(w.w);
                        s += __shfl_xor(s, 16); s += __shfl_xor(s, 32); km[bj] = fmaxf(km[bj], s); } } }
        if (isk) {
#pragma unroll
            for (int bj = 0; bj < 2; ++bj) { float v = km[bj]; v = fmaxf(v, __shfl_xor(v, 1)); v = fmaxf(v, __shfl_xor(v, 2)); v = fmaxf(v, __shfl_xor(v, 4)); v = fmaxf(v, __shfl_xor(v, 8));
                if ((threadIdx.x & 63) == 0) { const int b = u.pm >> 4, h = (u.pn - 2) * 4 + bj * 2 + (wc >> 1); atomicMax(kmax + (b * 8 + h) * 16, __float_as_uint(v)); } }
        }
    }
};
struct EpiOut {
    static constexpr bool PERM = false;
    const float* res; float* out;
    __device__ __forceinline__ void operator()(const f32x4 (&acc)[2][2][4][2], const Unit& u, int wr, int wc, int fr, int fq) const {
        const int row0 = u.pm * BM + wr * 64 + fr, col0 = u.pn * BM + wc * 32 + 4 * fq;
#pragma unroll
        for (int ai = 0; ai < 2; ++ai)
#pragma unroll
            for (int m = 0; m < 4; ++m) { const size_t off = (size_t)(row0 + ai * HALF + m * 16) * D + col0;
#pragma unroll
                for (int bj = 0; bj < 2; ++bj)
#pragma unroll
                    for (int n = 0; n < 2; ++n) { const f32x4 r = *(const f32x4*)(res + off + bj * HALF + n * 16); *(f32x4*)(out + off + bj * HALF + n * 16) = r + acc[ai][bj][m][n]; } }
    }
};
struct EpiGlu {
    static constexpr bool PERM = true;
    bf16_t* act; const u32x2* list; const float* b1r;
    __device__ __forceinline__ void operator()(const f32x4 (&acc)[2][2][4][2], const Unit& u, int wr, int wc, int fr, int fq) const {
        const int cb = u.pn * BM + wc * 32 + 8 * fq; const float* bp = b1r + (size_t)u.e * 2048 + cb;
        const f32x4 bg0 = *(const f32x4*)(bp), bg1 = *(const f32x4*)(bp + 4), bl0 = *(const f32x4*)(bp + HALF), bl1 = *(const f32x4*)(bp + HALF + 4);
#pragma unroll
        for (int ai = 0; ai < 2; ++ai)
#pragma unroll
            for (int m = 0; m < 4; ++m) { const int r = ai * HALF + wr * 64 + m * 16 + fr, pos = u.lt * BM + r;
                float rs = 0.f; if (pos < u.cnt) rs = __uint_as_float(list[(size_t)u.e * LISTCAP + pos].y);
                f32x4 g0 = acc[ai][0][m][0] * rs + bg0, g1 = acc[ai][0][m][1] * rs + bg1, l0 = acc[ai][1][m][0] * rs + bl0, l1 = acc[ai][1][m][1] * rs + bl1;
                float o[8];
#pragma unroll
                for (int j = 0; j < 8; ++j) { float g = j < 4 ? g0[j & 3] : g1[j & 3], li = j < 4 ? l0[j & 3] : l1[j & 3];
                    g = fminf(g, 7.f); li = fminf(fmaxf(li, -7.f), 7.f);
                    const float sg = __builtin_amdgcn_rcpf(1.f + __builtin_amdgcn_exp2f(-1.702f * LOG2E * g)); o[j] = g * sg * (li + 1.f); }
                u32x4 w; w.x = cvtpk(o[0], o[1]); w.y = cvtpk(o[2], o[3]); w.z = cvtpk(o[4], o[5]); w.w = cvtpk(o[6], o[7]);
                *(u32x4*)(act + (size_t)(u.pm * BM + r) * FF + u.pn * HALF + wc * 32 + 8 * fq) = w; }
    }
};
struct EpiDown {
    static constexpr bool PERM = true;
    bf16_t* Y; const u32x2* list; const float* gate; const float* b2;
    __device__ __forceinline__ void operator()(const f32x4 (&acc)[2][2][4][2], const Unit& u, int wr, int wc, int fr, int fq) const {
        const int cb = u.pn * BM + wc * 32 + 8 * fq; const float* bp = b2 + (size_t)u.e * D + cb;
        f32x4 bv[2][2];
#pragma unroll
        for (int bj = 0; bj < 2; ++bj)
#pragma unroll
            for (int n = 0; n < 2; ++n) bv[bj][n] = *(const f32x4*)(bp + bj * HALF + 4 * n);
#pragma unroll
        for (int ai = 0; ai < 2; ++ai)
#pragma unroll
            for (int m = 0; m < 4; ++m) { const int r = ai * HALF + wr * 64 + m * 16 + fr, pos = u.lt * BM + r;
                if (pos < u.cnt) { const unsigned ent = list[(size_t)u.e * LISTCAP + pos].x; const float gt = gate[ent]; bf16_t* rowp = Y + (size_t)ent * D + cb;
#pragma unroll
                    for (int bj = 0; bj < 2; ++bj) { const f32x4 v0 = (acc[ai][bj][m][0] + bv[bj][0]) * gt, v1 = (acc[ai][bj][m][1] + bv[bj][1]) * gt;
                        u32x4 w; w.x = cvtpk(v0[0], v0[1]); w.y = cvtpk(v0[2], v0[3]); w.z = cvtpk(v1[0], v1[1]); w.w = cvtpk(v1[2], v1[3]);
                        *(u32x4*)(rowp + bj * HALF) = w; } } }
    }
};
}

#define XB_TMO      128
#define XB_XCNT(j)  (256  + 64 * (j))
#define XB_XSUB(j)  (1280 + 64 * (j))
#define XB_XGEN(j)  (2304 + 64 * (j))
#define XB_TOP      3328
#define XB_TOPGEN   3392
#define XCD_BAR_WORDS 3456
#define XB_SPIN_CAP (1u << 18)
__device__ __forceinline__ unsigned xb_ld(unsigned* p)              { return __hip_atomic_load(p, __ATOMIC_RELAXED, __HIP_MEMORY_SCOPE_AGENT); }
__device__ __forceinline__ unsigned xb_add(unsigned* p, unsigned v) { return __hip_atomic_fetch_add(p, v, __ATOMIC_RELAXED, __HIP_MEMORY_SCOPE_AGENT); }
__device__ __forceinline__ unsigned xb_xcc_id() { return (unsigned)__builtin_amdgcn_s_getreg((3 << 11) | 20) & 0xFu; }
#define XB_SPIN(cond, bar) do { unsigned _sp = 0; while (cond) { __builtin_amdgcn_s_sleep(1); \
    if ((++_sp & 255u) == 0u) { if (xb_ld(&(bar)[XB_TMO])) break; if (_sp > XB_SPIN_CAP) { atomicAdd(&(bar)[XB_TMO], 1u); break; } } } } while (0)
struct XcdBarrier { unsigned* bar; unsigned x; volatile LAS unsigned* st; };
__device__ __forceinline__ XcdBarrier xcd_barrier_post(unsigned* bar, volatile LAS unsigned* st) {
    XcdBarrier b; b.bar = bar; b.x = xb_xcc_id(); b.st = st;
    if (threadIdx.x == 0) (void)xb_add(&bar[XB_XCNT(b.x)], 1u);
    return b;
}
__device__ __forceinline__ void xcd_barrier_complete(unsigned* bar, unsigned x, unsigned& nloc, unsigned& nx) {
    const unsigned G = gridDim.x * gridDim.y * gridDim.z;
    unsigned sum, cnt, mine, sp = 0u;
    for (;;) {
        sum = 0u; cnt = 0u; mine = 0u;
#pragma unroll
        for (unsigned j = 0; j < 16; ++j) { const unsigned c = xb_ld(&bar[XB_XCNT(j)]); sum += c; cnt += (c > 0u) ? 1u : 0u; mine = (j == x) ? c : mine; }
        if (sum == G) break;
        __builtin_amdgcn_s_sleep(1);
        if ((++sp & 255u) == 0u) { if (xb_ld(&bar[XB_TMO])) break; if (sp > XB_SPIN_CAP) { atomicAdd(&bar[XB_TMO], 1u); break; } }
    }
    nloc = mine > 0u ? mine : 1u; nx = cnt > 0u ? cnt : 1u;
}
__device__ __forceinline__ void xcd_barrier(const XcdBarrier& b, const bool leader  ) {
    asm volatile("s_waitcnt vmcnt(0)" ::: "memory");
    __syncthreads();
    if (leader) {
        unsigned* bar = b.bar;
        __builtin_amdgcn_s_waitcnt(0);
        unsigned nloc = b.st[0], nx = b.st[1];
        if (nloc == 0u) { xcd_barrier_complete(bar, b.x, nloc, nx); b.st[0] = nloc; b.st[1] = nx; }
        const unsigned old = xb_add(&bar[XB_XSUB(b.x)], 1u);
        const unsigned gen = old / nloc;
        if (old + 1u == (gen + 1u) * nloc) {
            __builtin_amdgcn_fence(__ATOMIC_RELEASE, "agent");
            asm volatile("s_waitcnt vmcnt(0)" ::: "memory");
            const unsigned og = xb_add(&bar[XB_TOP], 1u);
            const unsigned tg = og / nx;
            if (og + 1u == (tg + 1u) * nx) xb_add(&bar[XB_TOPGEN], 1u);
            else XB_SPIN(xb_ld(&bar[XB_TOPGEN]) == tg, bar);
            __builtin_amdgcn_fence(__ATOMIC_ACQUIRE, "agent");
            xb_add(&bar[XB_XGEN(b.x)], 1u);
            asm volatile("s_waitcnt vmcnt(0)" ::: "memory");
        } else {
            XB_SPIN(xb_ld(&bar[XB_XGEN(b.x)]) == gen, bar);
            __builtin_amdgcn_fence(__ATOMIC_ACQUIRE, "agent");
            asm volatile("s_waitcnt vmcnt(0)" ::: "memory");
        }
    }
    __syncthreads();
}

enum { I_x = 0, I_norm_mix, I_w_in, I_b_fox_f, I_fox_gain, I_hgrn_lb, I_hgrn_gain, I_pool_w, I_pool_scale, I_w_out, I_norm_moe, I_w_router, I_b_router, I_w1, I_b1, I_w2, I_b2, I_norm_final };
struct Frame {
    LAS unsigned char* lds; unsigned char* ws; unsigned* ctl; float* out;
    int tid, lane, wave, bid, G;
};
__device__ __forceinline__ const float* inp(const Frame& F, int i) {
    const LAS unsigned* p = (const LAS unsigned*)(F.lds + LDSCTL_OFF + LC_INP) + 2 * i;
    const unsigned lo = __builtin_amdgcn_readfirstlane(p[0]), hi = __builtin_amdgcn_readfirstlane(p[1]);
    return (const float*)(((unsigned long long)hi << 32) | lo);
}

__device__ __forceinline__ void p0_item(const float* src, int ldn, int c0, int cs, const float* g, bf16_t* dstrow0, int K, int k0, LAS float* scr, int lane) {
#pragma unroll 8
    for (int i = 0; i < 32; ++i) { const int kk = 2 * i + (lane >> 5); float v = src[(size_t)(k0 + kk) * ldn + c0 + cs * (lane & 31)]; if (g) v *= g[k0 + kk]; scr[kk * 33 + (lane & 31)] = v; }
    LDS_WAIT(); asm volatile("" ::: "memory");
    const int c = lane & 7;
#pragma unroll
    for (int j = 0; j < 4; ++j) { const int n = (lane >> 3) + 8 * j; const LAS float* s = scr + (8 * c) * 33 + n;
        u32x4 o; o.x = cvtpk(s[0 * 33], s[1 * 33]); o.y = cvtpk(s[2 * 33], s[3 * 33]); o.z = cvtpk(s[4 * 33], s[5 * 33]); o.w = cvtpk(s[6 * 33], s[7 * 33]);
        *(u32x4*)(dstrow0 + (size_t)n * K + k0 + 8 * c) = o; }
    LDS_WAIT(); asm volatile("" ::: "memory");
}
__device__ __forceinline__ void p0_prologue(const Frame& F) {
    LAS float* scr = (LAS float*)(F.lds + F.wave * 16384);
    const int gw = F.bid * NWAVES + F.wave, NGW = F.G * NWAVES;
    constexpr int I_IN = 16 * 88, I_OUT = 16 * 32, I_W1 = NE * 16 * 64, I_W2 = NE * 16 * 32, I_L = I_IN + I_OUT + I_W1 + I_W2;
    for (int it = gw; it < NL * I_L; it += NGW) {
        const int l = it / I_L; int r = it % I_L;
        if (r < I_IN) { const int kb = r / 88, nb = r % 88, n0 = 32 * nb;
            p0_item(inp(F, I_w_in) + (size_t)l * D * IN_COLS, IN_COLS, n0 + (n0 >= 1536 ? 8 : 0), 1, inp(F, I_norm_mix) + l * D, (bf16_t*)(F.ws + WS_WIN + l * WIN_BYTES) + (size_t)n0 * D, D, 64 * kb, scr, F.lane); continue; }
        r -= I_IN;
        if (r < I_OUT) { const int kb = r / 32, nb = r % 32, n0 = 32 * nb;
            p0_item(inp(F, I_w_out) + (size_t)l * D * D, D, n0, 1, nullptr, (bf16_t*)(F.ws + WS_WOUT + l * WOUT_BYTES) + (size_t)n0 * D, D, 64 * kb, scr, F.lane); continue; }
        r -= I_OUT;
        if (r < I_W1) { const int e = r / (16 * 64), q = r % (16 * 64), kb = q / 64, nb = q % 64, n0 = 32 * nb, pn = n0 >> 8, rr = n0 & 255, j0 = 128 * pn + (rr & 127), par = rr >> 7;
            p0_item(inp(F, I_w1) + ((size_t)l * NE + e) * D * 2 * FF, 2 * FF, 2 * j0 + par, 2, inp(F, I_norm_moe) + l * D, (bf16_t*)(F.ws + WS_W1 + ((size_t)l * NE + e) * W1E_BYTES) + (size_t)n0 * D, D, 64 * kb, scr, F.lane); continue; }
        r -= I_W1;
        { const int e = r / (16 * 32), q = r % (16 * 32), kb = q / 32, nb = q % 32, n0 = 32 * nb;
            p0_item(inp(F, I_w2) + ((size_t)l * NE + e) * FF * D, D, n0, 1, nullptr, (bf16_t*)(F.ws + WS_W2 + ((size_t)l * NE + e) * W2E_BYTES) + (size_t)n0 * FF, FF, 64 * kb, scr, F.lane); }
    }
    const int gt = F.bid * NTHREADS + F.tid, NGT = F.G * NTHREADS;
    float* b1r = (float*)(F.ws + WS_B1R);
    for (int i = gt; i < NL * NE * 2048; i += NGT) { const int le = i >> 11, n = i & 2047, pn = n >> 8, rr = n & 255; b1r[i] = inp(F, I_b1)[(size_t)le * 2048 + 2 * (128 * pn + (rr & 127)) + (rr >> 7)]; }
    bf16_t* wf = (bf16_t*)(F.ws + WS_WFRAG);
    for (int i = gt; i < NL * 2 * 32 * 2 * 64 * 8; i += NGT) {
        const int j = i & 7, ln = (i >> 3) & 63, et = (i >> 9) & 1, ks = (i >> 10) & 31, kind = (i >> 15) & 1, l = i >> 16;
        const int e = 16 * et + (ln & 15), k = 32 * ks + 8 * (ln >> 4) + j;
        float v;
        if (kind == 0) v = (e < 8) ? inp(F, I_norm_mix)[l * D + k] * inp(F, I_w_in)[((size_t)l * D + k) * IN_COLS + 1536 + e] : 0.f;
        else v = inp(F, I_norm_moe)[l * D + k] * inp(F, I_w_router)[((size_t)l * D + k) * NE + e];
        const bf16_t h = f2bf(v), lo = f2bf(v - bf2f(h));
        const size_t base = ((((size_t)(l * 2 + kind) * 32 + ks) * 2 + et) * 2) * 512 + ln * 8 + j;
        wf[base] = h; wf[base + 512] = lo;
    }
}

template <int KIND, bool COMBINE, bool WRITE_H>
__device__ __forceinline__ void r_phase(const Frame& F, int l, const float* hin, float* hout) {
    const int lane = F.lane, r16 = lane & 15, q4 = lane >> 4;
    const u32x4* Wf = (const u32x4*)(F.ws + WS_WFRAG + (size_t)(l * 2 + KIND) * 131072);
    const bf16_t* Y = (const bf16_t*)(F.ws + WS_Y);
    bf16_t* HB = (bf16_t*)(F.ws + WS_HB);
    float* rstdp = (float*)(F.ws + (KIND == 0 ? WS_RSTD1 : WS_RSTD2));
    LAS float* lg = (LAS float*)(F.lds) + F.wave * (16 * 33);
    LAS int* r2cnt = (LAS int*)(F.lds + LDSCTL_OFF + LC_R2CNT); LAS int* r2base = (LAS int*)(F.lds + LDSCTL_OFF + LC_R2BASE);
    for (int task = F.bid; task < T / 128; task += F.G) {
        const int tok = task * 128 + F.wave * 16 + r16;
        const float* xr = hin + (size_t)tok * D + 8 * q4; float* ho = hout + (size_t)tok * D + 8 * q4;
        const bf16_t* yr = Y + (size_t)tok * 4 * D + 8 * q4; bf16_t* hbr = HB + (size_t)tok * D + 8 * q4;
        f32x4 acc0 = {0.f, 0.f, 0.f, 0.f}, acc1 = {0.f, 0.f, 0.f, 0.f}; float ssq = 0.f;
        if (KIND == 1) { if (F.tid < 32) r2cnt[F.tid] = 0; }
#pragma unroll 2
        for (int ks = 0; ks < 32; ++ks) {
            f32x4 x0 = *(const f32x4*)(xr + 32 * ks), x1 = *(const f32x4*)(xr + 32 * ks + 4);
            if (COMBINE) {
#pragma unroll
                for (int k = 0; k < 4; ++k) { const u32x4 y = *(const u32x4*)(yr + (size_t)k * D + 32 * ks);
                    x0[0] += bflo(y.x); x0[1] += bfhi(y.x); x0[2] += bflo(y.y); x0[3] += bfhi(y.y); x1[0] += bflo(y.z); x1[1] += bfhi(y.z); x1[2] += bflo(y.w); x1[3] += bfhi(y.w); }
            }
            if (WRITE_H) { *(f32x4*)(ho + 32 * ks) = x0; *(f32x4*)(ho + 32 * ks + 4) = x1; }
            ssq += (x0[0] * x0[0] + x0[1] * x0[1]) + (x0[2] * x0[2] + x0[3] * x0[3]) + (x1[0] * x1[0] + x1[1] * x1[1]) + (x1[2] * x1[2] + x1[3] * x1[3]);
            u32x4 hw; hw.x = cvtpk(x0[0], x0[1]); hw.y = cvtpk(x0[2], x0[3]); hw.z = cvtpk(x1[0], x1[1]); hw.w = cvtpk(x1[2], x1[3]);
            u32x4 lw; lw.x = cvtpk(x0[0] - bflo(hw.x), x0[1] - bfhi(hw.x)); lw.y = cvtpk(x0[2] - bflo(hw.y), x0[3] - bfhi(hw.y)); lw.z = cvtpk(x1[0] - bflo(hw.z), x1[1] - bfhi(hw.z)); lw.w = cvtpk(x1[2] - bflo(hw.w), x1[3] - bfhi(hw.w));
            *(u32x4*)(hbr + 32 * ks) = hw;
            const bf16x8 xh = __builtin_bit_cast(bf16x8, hw), xl = __builtin_bit_cast(bf16x8, lw);
            const bf16x8 wh0 = __builtin_bit_cast(bf16x8, Wf[((ks * 2 + 0) * 2 + 0) * 64 + lane]), wl0 = __builtin_bit_cast(bf16x8, Wf[((ks * 2 + 0) * 2 + 1) * 64 + lane]);
            acc0 = __builtin_amdgcn_mfma_f32_16x16x32_bf16(wh0, xh, acc0, 0, 0, 0);
            acc0 = __builtin_amdgcn_mfma_f32_16x16x32_bf16(wl0, xh, acc0, 0, 0, 0);
            acc0 = __builtin_amdgcn_mfma_f32_16x16x32_bf16(wh0, xl, acc0, 0, 0, 0);
            if (KIND == 1) {
                const bf16x8 wh1 = __builtin_bit_cast(bf16x8, Wf[((ks * 2 + 1) * 2 + 0) * 64 + lane]), wl1 = __builtin_bit_cast(bf16x8, Wf[((ks * 2 + 1) * 2 + 1) * 64 + lane]);
                acc1 = __builtin_amdgcn_mfma_f32_16x16x32_bf16(wh1, xh, acc1, 0, 0, 0);
                acc1 = __builtin_amdgcn_mfma_f32_16x16x32_bf16(wl1, xh, acc1, 0, 0, 0);
                acc1 = __builtin_amdgcn_mfma_f32_16x16x32_bf16(wh1, xl, acc1, 0, 0, 0);
            }
        }
        ssq += __shfl_xor(ssq, 16); ssq += __shfl_xor(ssq, 32);
        const float rstd = 1.0f / sqrtf(ssq * (1.0f / D) + RMS_EPS);
        if (q4 == 0) rstdp[tok] = rstd;
        if (KIND == 0) {
            if (q4 < 2) { const f32x4 bf = *(const f32x4*)(inp(F, I_b_fox_f) + l * 8 + 4 * q4); f32x4 lf;
#pragma unroll
                for (int i = 0; i < 4; ++i) { const float z = rstd * acc0[i] + bf[i]; lf[i] = fminf(z, 0.f) - log1pf(expf(-fabsf(z))); }
                *(f32x4*)((float*)(F.ws + WS_LOGF) + (size_t)tok * 8 + 4 * q4) = lf; }
        } else {
            const f32x4 b0 = *(const f32x4*)(inp(F, I_b_router) + l * NE + 4 * q4), b1v = *(const f32x4*)(inp(F, I_b_router) + l * NE + 16 + 4 * q4);
#pragma unroll
            for (int i = 0; i < 4; ++i) { lg[r16 * 33 + 4 * q4 + i] = rstd * acc0[i] + b0[i]; lg[r16 * 33 + 16 + 4 * q4 + i] = rstd * acc1[i] + b1v[i]; }
            LDS_WAIT(); asm volatile("" ::: "memory");
            float v0 = -INFINITY, v1 = -INFINITY, v2 = -INFINITY, v3 = -INFINITY; int i0 = 0, i1 = 0, i2 = 0, i3 = 0;
            if (lane < 16) {
                for (int e = 0; e < NE; ++e) { const float x = lg[lane * 33 + e];
                    if (x > v3) { if (x > v0) { v3 = v2; i3 = i2; v2 = v1; i2 = i1; v1 = v0; i1 = i0; v0 = x; i0 = e; }
                        else if (x > v1) { v3 = v2; i3 = i2; v2 = v1; i2 = i1; v1 = x; i1 = e; }
                        else if (x > v2) { v3 = v2; i3 = i2; v2 = x; i2 = e; }
                        else { v3 = x; i3 = e; } } }
            }
            __syncthreads();
            int rk0 = 0, rk1 = 0, rk2 = 0, rk3 = 0;
            if (lane < 16) { rk0 = __hip_atomic_fetch_add(&r2cnt[i0], 1, __ATOMIC_RELAXED, __HIP_MEMORY_SCOPE_WORKGROUP); rk1 = __hip_atomic_fetch_add(&r2cnt[i1], 1, __ATOMIC_RELAXED, __HIP_MEMORY_SCOPE_WORKGROUP); rk2 = __hip_atomic_fetch_add(&r2cnt[i2], 1, __ATOMIC_RELAXED, __HIP_MEMORY_SCOPE_WORKGROUP); rk3 = __hip_atomic_fetch_add(&r2cnt[i3], 1, __ATOMIC_RELAXED, __HIP_MEMORY_SCOPE_WORKGROUP); }
            __syncthreads();
            if (F.tid < 32) r2base[F.tid] = (int)atomicAdd(F.ctl + CW_CUR + (l * NE + F.tid) * 16, (unsigned)r2cnt[F.tid]);
            __syncthreads();
            if (lane < 16) {
                const float e1 = expf(v1 - v0), e2 = expf(v2 - v0), e3 = expf(v3 - v0), inv = 1.0f / (1.0f + e1 + e2 + e3);
                u32x2* list = (u32x2*)(F.ws + WS_LIST); float* gate = (float*)(F.ws + WS_GATE);
                const int tk = (task * 128 + F.wave * 16 + lane) * 4; const unsigned rb = __float_as_uint(__shfl(rstd, lane & 15));
                list[(size_t)i0 * LISTCAP + r2base[i0] + rk0] = (u32x2){(unsigned)(tk + 0), rb}; gate[tk + 0] = inv;
                list[(size_t)i1 * LISTCAP + r2base[i1] + rk1] = (u32x2){(unsigned)(tk + 1), rb}; gate[tk + 1] = e1 * inv;
                list[(size_t)i2 * LISTCAP + r2base[i2] + rk2] = (u32x2){(unsigned)(tk + 2), rb}; gate[tk + 2] = e2 * inv;
                list[(size_t)i3 * LISTCAP + r2base[i3] + rk3] = (u32x2){(unsigned)(tk + 3), rb}; gate[tk + 3] = e3 * inv;
            }
            __syncthreads();
        }
    }
}
__device__ __forceinline__ void r_final(const Frame& F) {
    const int lane = F.lane, r16 = lane & 15, q4 = lane >> 4;
    const bf16_t* Y = (const bf16_t*)(F.ws + WS_Y);
    for (int task = F.bid; task < T / 128; task += F.G) {
        const int tok = task * 128 + F.wave * 16 + r16;
        float* xr = F.out + (size_t)tok * D + 8 * q4; const bf16_t* yr = Y + (size_t)tok * 4 * D + 8 * q4;
        float ssq = 0.f;
#pragma unroll 2
        for (int ks = 0; ks < 32; ++ks) {
            f32x4 x0 = *(const f32x4*)(xr + 32 * ks), x1 = *(const f32x4*)(xr + 32 * ks + 4);
#pragma unroll
            for (int k = 0; k < 4; ++k) { const u32x4 y = *(const u32x4*)(yr + (size_t)k * D + 32 * ks);
                x0[0] += bflo(y.x); x0[1] += bfhi(y.x); x0[2] += bflo(y.y); x0[3] += bfhi(y.y); x1[0] += bflo(y.z); x1[1] += bfhi(y.z); x1[2] += bflo(y.w); x1[3] += bfhi(y.w); }
            ssq += (x0[0] * x0[0] + x0[1] * x0[1]) + (x0[2] * x0[2] + x0[3] * x0[3]) + (x1[0] * x1[0] + x1[1] * x1[1]) + (x1[2] * x1[2] + x1[3] * x1[3]);
        }
        ssq += __shfl_xor(ssq, 16); ssq += __shfl_xor(ssq, 32);
        const float rstd = 1.0f / sqrtf(ssq * (1.0f / D) + RMS_EPS);
#pragma unroll 2
        for (int ks = 0; ks < 32; ++ks) {
            f32x4 x0 = *(const f32x4*)(xr + 32 * ks), x1 = *(const f32x4*)(xr + 32 * ks + 4);
#pragma unroll
            for (int k = 0; k < 4; ++k) { const u32x4 y = *(const u32x4*)(yr + (size_t)k * D + 32 * ks);
                x0[0] += bflo(y.x); x0[1] += bfhi(y.x); x0[2] += bflo(y.y); x0[3] += bfhi(y.y); x1[0] += bflo(y.z); x1[1] += bfhi(y.z); x1[2] += bflo(y.w); x1[3] += bfhi(y.w); }
            const f32x4 g0 = *(const f32x4*)(inp(F, I_norm_final) + 32 * ks + 8 * q4), g1 = *(const f32x4*)(inp(F, I_norm_final) + 32 * ks + 8 * q4 + 4);
            *(f32x4*)(xr + 32 * ks) = x0 * rstd * g0; *(f32x4*)(xr + 32 * ks + 4) = x1 * rstd * g1;
        }
    }
}
__device__ __forceinline__ void cumsum_step(const Frame& F) {
    LAS float* sc = (LAS float*)(F.lds + LDSCTL_OFF + LC_SCAN);
    const float* LF = (const float*)(F.ws + WS_LOGF); float* c2 = (float*)(F.ws + WS_C2);
    for (int seq = F.bid; seq < 64; seq += F.G) {
        const int b = seq >> 3, h = seq & 7, t0 = F.tid * 8; const float* lf = LF + ((size_t)b * SEQ + t0) * 8 + h;
        float v[8], s = 0.f;
#pragma unroll
        for (int j = 0; j < 8; ++j) { s += lf[j * 8]; v[j] = s; }
        float inc = s;
#pragma unroll
        for (int off = 1; off < 64; off <<= 1) { const float y = __shfl_up(inc, off); if (F.lane >= off) inc += y; }
        if (F.lane == 63) sc[F.wave] = inc;
        __syncthreads();
        float pre = 0.f;
        for (int w = 0; w < F.wave; ++w) pre += sc[w];
        const float base = pre + inc - s;
#pragma unroll
        for (int j = 0; j < 8; ++j) c2[(size_t)seq * SEQ + t0 + j] = (base + v[j]) * LOG2E;
        __syncthreads();
    }
}

__device__ __forceinline__ int crow(int r, int hi) { return (r & 3) + 8 * (r >> 2) + 4 * hi; }
constexpr int AT_KT = 0, AT_KTB = 8320, AT_VT = 2 * AT_KTB, AT_VTB = 8192, AT_CK = AT_VT + 2 * AT_VTB, AT_WSF = AT_CK + 512, AT_OST = AT_WSF + 2048, AT_END = AT_OST + 65536;
static_assert(AT_END <= PH_BYTES, "attention LDS");
__device__ __forceinline__ void attn_unit(const Frame& F, int l, int b, int h, int qb) {
    const int tid = F.tid, lane = F.lane, r32 = lane & 31, hi = lane >> 5, wid = F.wave;
    const bf16_t* proj = (const bf16_t*)(F.ws + WS_PA); bf16_t* mixed = (bf16_t*)(F.ws + WS_MIXED);
    const int bh = b * 8 + h; const float* c2 = (const float*)(F.ws + WS_C2) + (size_t)bh * SEQ;
    const size_t rowbase = (size_t)b * SEQ; const int q0 = qb * 256;
    LAS unsigned char* L = F.lds;
    LAS float* wsf = (LAS float*)(L + AT_WSF) + wid * 64;
    LAS float* ost = (LAS float*)(L + AT_OST) + wid * 2048;
    volatile LAS int* stopf = (volatile LAS int*)(L + LDSCTL_OFF + LC_STOP);
    const bf16_t* Qw = proj + (rowbase + q0 + wid * 32 + r32) * NPROJ + C_FQ + h * 64;
    bf16x8 qr[4]; float qn = 0.f;
#pragma unroll
    for (int d0 = 0; d0 < 4; ++d0) { const u32x4 w = *(const u32x4*)(Qw + d0 * 16 + hi * 8); qr[d0] = __builtin_bit_cast(bf16x8, w);
        qn += bflo(w.x) * bflo(w.x) + bfhi(w.x) * bfhi(w.x) + bflo(w.y) * bflo(w.y) + bfhi(w.y) * bfhi(w.y) + bflo(w.z) * bflo(w.z) + bfhi(w.z) * bfhi(w.z) + bflo(w.w) * bflo(w.w) + bfhi(w.w) * bfhi(w.w); }
    qn += __shfl_xor(qn, 32); qn = sqrtf(qn) * 1.001f;
    const float kb = sqrtf(2.0f * __uint_as_float(__hip_atomic_load(F.ctl + CW_KMAX + (l * 64 + bh) * 16, __ATOMIC_RELAXED, __HIP_MEMORY_SCOPE_AGENT))) * 1.001f;
    const float c2q = c2[q0 + wid * 32 + r32];
    f32x16 cq16;
#pragma unroll
    for (int r = 0; r < 16; ++r) cq16[r] = c2q;
    float m = -INFINITY, lsum = 0.f; f32x16 o[2];
#pragma unroll
    for (int r = 0; r < 16; ++r) { o[0][r] = 0.f; o[1][r] = 0.f; }
    const int jd = 4 * qb + 3;
    const int lkey = tid >> 3, lpiece = tid & 7;
    const bf16_t* ksrc = proj + (rowbase + lkey) * NPROJ + C_FK + h * 64 + lpiece * 8;
    const bf16_t* vsrc = proj + (rowbase + lkey) * NPROJ + C_FV + h * 64 + lpiece * 8;
    const int kdst = lpiece * 1040 + lkey * 16, vdst = (lpiece >> 2) * 4096 + lkey * 64 + (lpiece & 3) * 16;
    u32x4 kreg = *(const u32x4*)(ksrc + (size_t)jd * 64 * NPROJ), vreg = *(const u32x4*)(vsrc + (size_t)jd * 64 * NPROJ);
    float ckreg = 0.f; if (tid < 64) ckreg = c2[jd * 64 + tid];
    const int vrd = (4 * hi + ((lane & 15) >> 2)) * 64 + ((lane >> 4) & 1) * 32 + (lane & 3) * 8;
    const int qrel = wid * 32 + r32;
    int buf = 0;
    for (int j = jd; j >= 0; --j) {
        *(LAS u32x4*)(L + AT_KT + buf * AT_KTB + kdst) = kreg; *(LAS u32x4*)(L + AT_VT + buf * AT_VTB + vdst) = vreg;
        if (tid < 64) ((LAS float*)(L + AT_CK))[buf * 64 + tid] = ckreg;
        __syncthreads();
        if (j < jd) { int all = 1;
#pragma unroll
            for (int w = 0; w < 8; ++w) all &= stopf[((j + 1) & 1) * 8 + w];
            if (all) break; }
        float cklast = 0.f;
        if (j > 0) { kreg = *(const u32x4*)(ksrc + (size_t)(j - 1) * 64 * NPROJ); vreg = *(const u32x4*)(vsrc + (size_t)(j - 1) * 64 * NPROJ); if (tid < 64) ckreg = c2[(j - 1) * 64 + tid]; cklast = c2[(j - 1) * 64 + 63]; }
        const int jrel = j - 4 * qb;
        const bool active = !(jrel >= 0 && 64 * jrel > 32 * wid + 31);
        if (active) {
            const LAS unsigned char* Kb = L + AT_KT + buf * AT_KTB; const LAS unsigned char* Vb = L + AT_VT + buf * AT_VTB; const LAS float* Ck = (const LAS float*)(L + AT_CK) + buf * 64;
            f32x16 p0 = cq16, p1 = cq16;
#pragma unroll
            for (int d0 = 0; d0 < 4; ++d0) {
                const bf16x8 k0 = *(const LAS bf16x8*)(Kb + (2 * d0 + hi) * 1040 + r32 * 16), k1 = *(const LAS bf16x8*)(Kb + (2 * d0 + hi) * 1040 + (32 + r32) * 16);
                p0 = __builtin_amdgcn_mfma_f32_32x32x16_bf16(k0, qr[d0], p0, 0, 0, 0); p1 = __builtin_amdgcn_mfma_f32_32x32x16_bf16(k1, qr[d0], p1, 0, 0, 0); }
#pragma unroll
            for (int g = 0; g < 4; ++g) { const f32x4 ca = *(const LAS f32x4*)(Ck + 8 * g + 4 * hi), cb = *(const LAS f32x4*)(Ck + 32 + 8 * g + 4 * hi);
#pragma unroll
                for (int i = 0; i < 4; ++i) { p0[4 * g + i] -= ca[i]; p1[4 * g + i] -= cb[i]; } }
            if (jrel >= 0) { const int kbase = 64 * jrel + 4 * hi;
#pragma unroll
                for (int r = 0; r < 16; ++r) { const int kv = kbase + (r & 3) + 8 * (r >> 2); if (kv > qrel) p0[r] = -INFINITY; if (kv + 32 > qrel) p1[r] = -INFINITY; } }
            float mx = fmaxf(p0[0], p1[0]);
#pragma unroll
            for (int r = 1; r < 16; ++r) mx = fmaxf(mx, fmaxf(p0[r], p1[r]));
            mx = fmaxf(mx, __shfl_xor(mx, 32));
            const float mnew = fmaxf(m, mx), alpha = __builtin_amdgcn_exp2f(m - mnew);
            float ls = 0.f;
#pragma unroll
            for (int r = 0; r < 16; ++r) { p0[r] = __builtin_amdgcn_exp2f(p0[r] - mnew); p1[r] = __builtin_amdgcn_exp2f(p1[r] - mnew); ls += p0[r] + p1[r]; }
            lsum = lsum * alpha + ls;
            if (__any(mnew > m)) {
                if (hi == 0) wsf[r32] = alpha;
                LDS_WAIT(); asm volatile("" ::: "memory");
#pragma unroll
                for (int r = 0; r < 16; ++r) { const float a = wsf[crow(r, hi)]; o[0][r] *= a; o[1][r] *= a; }
            }
            m = mnew;
            u32x4 pw[4];
            pw[0] = (u32x4){cvtpk(p0[0], p0[1]), cvtpk(p0[2], p0[3]), cvtpk(p0[4], p0[5]), cvtpk(p0[6], p0[7])};
            pw[1] = (u32x4){cvtpk(p0[8], p0[9]), cvtpk(p0[10], p0[11]), cvtpk(p0[12], p0[13]), cvtpk(p0[14], p0[15])};
            pw[2] = (u32x4){cvtpk(p1[0], p1[1]), cvtpk(p1[2], p1[3]), cvtpk(p1[4], p1[5]), cvtpk(p1[6], p1[7])};
            pw[3] = (u32x4){cvtpk(p1[8], p1[9]), cvtpk(p1[10], p1[11]), cvtpk(p1[12], p1[13]), cvtpk(p1[14], p1[15])};
#pragma unroll
            for (int s = 0; s < 4; ++s)
#pragma unroll
                for (int d0 = 0; d0 < 2; ++d0) {
                    const LAS unsigned char* vp = Vb + d0 * 4096 + s * 1024 + vrd;
                    const v4i16_t lo = __builtin_amdgcn_ds_read_tr16_b64_v4i16((LAS v4i16_t*)vp), hv = __builtin_amdgcn_ds_read_tr16_b64_v4i16((LAS v4i16_t*)(vp + 512));
                    const bf16x8 vf = (bf16x8){lo[0], lo[1], lo[2], lo[3], hv[0], hv[1], hv[2], hv[3]};
                    o[d0] = __builtin_amdgcn_mfma_f32_32x32x16_bf16(__builtin_bit_cast(bf16x8, pw[s]), vf, o[d0], 0, 0, 0); }
        }
        if (j > 0) { int st = 0; if (active) { const float ub = qn * kb + (c2q - cklast); st = __all((ub - m) < -152.0f) ? 1 : 0; } if (lane == 0) stopf[(j & 1) * 8 + wid] = st; }
        buf ^= 1;
    }
    lsum += __shfl_xor(lsum, 32);
    if (hi == 0) wsf[32 + r32] = 1.0f / lsum;
    LDS_WAIT(); asm volatile("" ::: "memory");
#pragma unroll
    for (int r = 0; r < 16; ++r) { const int q = crow(r, hi); const float inv = wsf[32 + q]; ost[q * 64 + r32] = o[0][r] * inv; ost[q * 64 + 32 + r32] = o[1][r] * inv; }
    LDS_WAIT(); asm volatile("" ::: "memory");
    { const int row = lane >> 1, half = lane & 1; const LAS float* src = ost + row * 64 + half * 32; float v[32]; float ss = 0.f;
#pragma unroll
        for (int i = 0; i < 8; ++i) { const f32x4 t4 = *(const LAS f32x4*)(src + 4 * i); v[4 * i] = t4[0]; v[4 * i + 1] = t4[1]; v[4 * i + 2] = t4[2]; v[4 * i + 3] = t4[3]; ss += (t4[0] * t4[0] + t4[1] * t4[1]) + (t4[2] * t4[2] + t4[3] * t4[3]); }
        ss += __shfl_xor(ss, 1);
        const float rs = 1.0f / sqrtf(ss * (1.0f / 64.0f) + RMS_EPS);
        const float* gn = inp(F, I_fox_gain) + l * 512 + h * 64 + half * 32;
        bf16_t* dst = mixed + (rowbase + q0 + wid * 32 + row) * D + h * 64 + half * 32;
#pragma unroll
        for (int i = 0; i < 4; ++i) { const f32x4 ga = *(const f32x4*)(gn + 8 * i), gb = *(const f32x4*)(gn + 8 * i + 4); u32x4 w;
            w.x = cvtpk(v[8 * i] * rs * ga[0], v[8 * i + 1] * rs * ga[1]); w.y = cvtpk(v[8 * i + 2] * rs * ga[2], v[8 * i + 3] * rs * ga[3]);
            w.z = cvtpk(v[8 * i + 4] * rs * gb[0], v[8 * i + 5] * rs * gb[1]); w.w = cvtpk(v[8 * i + 6] * rs * gb[2], v[8 * i + 7] * rs * gb[3]);
            *(u32x4*)(dst + 8 * i) = w; } }
    __syncthreads();
}

__device__ __forceinline__ float hg_lb(const Frame& F, int l, int col) {
    float x[NL], mx = -INFINITY;
#pragma unroll
    for (int i = 0; i < NL; ++i) { x[i] = inp(F, I_hgrn_lb)[i * 256 + col]; mx = fmaxf(mx, x[i]); }
    float s = 0.f, a = 0.f;
#pragma unroll
    for (int i = 0; i < NL; ++i) { x[i] = expf(x[i] - mx); s += x[i]; }
#pragma unroll
    for (int i = 1; i < NL; ++i) if (i <= l) a += x[i];
    return a / s;
}
__device__ __forceinline__ void hg_naive_unit(const Frame& F, int l, int u) {
    const int bh = u >> 2, ks = u & 3, b = bh >> 2, hd = bh & 3, lane = F.lane;
    const bf16_t* proj = (const bf16_t*)(F.ws + WS_PA) + (size_t)b * SEQ * NPROJ;
    float* oraw = (float*)(F.ws + WS_ORAW) + (size_t)ks * T * 256 + (size_t)b * SEQ * 256 + hd * 64 + lane;
    const float lbv = hg_lb(F, l, hd * 64 + ks * 16 + (lane & 15));
    float S[16];
#pragma unroll
    for (int j = 0; j < 16; ++j) S[j] = 0.f;
    for (int t0 = 0; t0 < SEQ; t0 += 4) {
        float fl[4], qv[4], vin[4];
#pragma unroll
        for (int i = 0; i < 4; ++i) { const bf16_t* row = proj + (size_t)(t0 + i) * NPROJ;
            fl[i] = bf2f(row[C_GF + hd * 64 + ks * 16 + (lane & 15)]); qv[i] = bf2f(row[C_GQ + hd * 64 + ks * 16 + (lane & 15)]); vin[i] = bf2f(row[C_GI + hd * 64 + lane]); }
#pragma unroll
        for (int i = 0; i < 4; ++i) {
            const float sg = 1.0f / (1.0f + expf(-fl[i])), f = lbv + (1.0f - lbv) * sg, kk = (1.0f - lbv) * (1.0f - sg);
            float o = 0.f;
#pragma unroll
            for (int j = 0; j < 16; ++j) { const float fj = rdlane(f, j), kj = rdlane(kk, j), qj = rdlane(qv[i], j); S[j] = fj * S[j] + kj * vin[i]; o += qj * S[j]; }
            oraw[(size_t)(t0 + i) * 256] = o;
        }
    }
}
__device__ __forceinline__ void hg_fix_phase(const Frame& F, int l) {
    const int gw = F.bid * NWAVES + F.wave, NGW = F.G * NWAVES, lane = F.lane;
    const float* oraw = (const float*)(F.ws + WS_ORAW); const bf16_t* proj = (const bf16_t*)(F.ws + WS_PA); bf16_t* mixed = (bf16_t*)(F.ws + WS_MIXED);
    const f32x4 gn = *(const f32x4*)(inp(F, I_hgrn_gain) + l * 256 + 4 * lane);
    for (int tok = gw; tok < T; tok += NGW) {
        f32x4 o = *(const f32x4*)(oraw + (size_t)tok * 256 + 4 * lane);
#pragma unroll
        for (int k = 1; k < 4; ++k) o += *(const f32x4*)(oraw + (size_t)k * T * 256 + (size_t)tok * 256 + 4 * lane);
        float ss = (o[0] * o[0] + o[1] * o[1]) + (o[2] * o[2] + o[3] * o[3]);
        ss += __shfl_xor(ss, 1); ss += __shfl_xor(ss, 2); ss += __shfl_xor(ss, 4); ss += __shfl_xor(ss, 8);
        const float rs = 1.0f / sqrtf(ss * (1.0f / 64.0f) + RMS_EPS);
        const u32x2 gw2 = *(const u32x2*)(proj + (size_t)tok * NPROJ + C_GG + 4 * lane);
        const float g[4] = {bflo(gw2.x), bfhi(gw2.x), bflo(gw2.y), bfhi(gw2.y)}; float r[4];
#pragma unroll
        for (int i = 0; i < 4; ++i) { const float si = g[i] / (1.0f + expf(-g[i])); r[i] = o[i] * rs * gn[i] * si; }
        *(u32x2*)(mixed + (size_t)tok * D + 512 + 4 * lane) = (u32x2){cvtpk(r[0], r[1]), cvtpk(r[2], r[3])};
    }
}
__device__ __forceinline__ void pool_unit(const Frame& F, int l, int u) {
    const int seg = u & 63, g = (u >> 6) & 3, b = u >> 8, lane = F.lane;
    const int w = 2 << g;
    const bf16_t* up = (const bf16_t*)(F.ws + WS_PA) + (size_t)b * SEQ * NPROJ + C_PU + g * 64 + lane;
    bf16_t* mixed = (bf16_t*)(F.ws + WS_MIXED) + (size_t)b * SEQ * D + 768 + g * 64 + lane;
    float wcol[64];
#pragma unroll
    for (int c = 0; c < 64; ++c) wcol[c] = inp(F, I_pool_w)[(((size_t)l * 4 + g) * 64 + c) * 64 + lane];
    const float psc = inp(F, I_pool_scale)[l * 256 + g * 64 + lane];
    const int t0 = seg * 64; float wsum = 0.f;
    for (int i = 1; i <= w; ++i) { const int t = t0 - i; if (t >= 0) wsum += bf2f(up[(size_t)t * NPROJ]); }
    for (int i = 0; i < 64; ++i) { const int t = t0 + i; const float ut = bf2f(up[(size_t)t * NPROJ]);
        wsum += ut; if (t - w >= 0) wsum -= bf2f(up[(size_t)(t - w) * NPROJ]);
        const float pooled = wsum / (float)((t + 1 < w) ? (t + 1) : w) - ut; float acc = 0.f;
#pragma unroll
        for (int c = 0; c < 64; ++c) acc += rdlane(pooled, c) * wcol[c];
        mixed[(size_t)t * D] = f2bf(acc * psc); }
}

struct Args { const float* in[18]; float* out; unsigned char* ws; int ph_lo, ph_hi; };
constexpr int N_PHASES = 2 + 8 * NL;

__global__ void __launch_bounds__(NTHREADS, 2) trunk_fwd(Args args) {
    extern __shared__ __attribute__((aligned(16))) unsigned char lds_raw[];
    Frame F;
    F.lds = (LAS unsigned char*)lds_raw; F.ws = args.ws; F.ctl = (unsigned*)(args.ws + WS_CTL); F.out = args.out;
    F.tid = threadIdx.x; F.lane = F.tid & 63; F.wave = __builtin_amdgcn_readfirstlane(F.tid >> 6);
    for (int u = F.tid; u < (LDS_BYTES - LDSCTL_OFF) / 4; u += NTHREADS) ((LAS unsigned*)(F.lds + LDSCTL_OFF))[u] = 0u;
    __syncthreads();
    if (F.tid == 0) {
#pragma unroll
        for (int i = 0; i < 18; ++i) ((LAS unsigned long long*)(F.lds + LDSCTL_OFF + LC_INP))[i] = (unsigned long long)args.in[i];
    }
    __syncthreads();
    const int lo = args.ph_lo, hi = args.ph_hi; const bool use_bar = (hi - lo) > 1;
    XcdBarrier bar; bar.bar = F.ctl + CW_BAR; bar.x = 0; bar.st = nullptr;
    if (use_bar) bar = xcd_barrier_post(F.ctl + CW_BAR, (volatile LAS unsigned*)(F.lds + LDSCTL_OFF + LC_BAR));
#ifndef PHMASK
#define PHMASK 0xFFFF
#endif
#define PM(b) ((PHMASK >> (b)) & 1)
#define FRESH() do { int l_ = (int)__builtin_amdgcn_mbcnt_hi(~0u, __builtin_amdgcn_mbcnt_lo(~0u, 0u)); asm volatile("" : "+v"(l_)); F.lane = l_; F.tid = F.wave * 64 + l_; int b_ = blockIdx.x, g_ = gridDim.x; asm volatile("" : "+s"(b_), "+s"(g_)); F.bid = b_; F.G = g_; } while (0)
#define IN(k) (lo <= (k) && (k) < hi)
#define SEAM(k) do { if (use_bar && (k) + 1 < hi) xcd_barrier(bar, F.tid == 0); } while (0)
    if (IN(0) && PM(0)) { FRESH(); p0_prologue(F); SEAM(0); }
    for (int l = 0; l < NL; ++l) {
        const int pb = 1 + 8 * l;
        if (IN(pb + 0) && PM(1)) { FRESH(); if (l == 0) r_phase<0, false, false>(F, l, inp(F, I_x), F.out); else r_phase<0, true, true>(F, l, F.out, F.out); SEAM(pb + 0); }
        if (IN(pb + 1) && PM(2)) { FRESH();
            cumsum_step(F);
            pg8::StaticOrder S; S.init(T, NPROJ, D, F.G, F.bid, (const bf16_t*)(F.ws + WS_WIN + l * WIN_BYTES));
            pg8::EpiProj E{(bf16_t*)(F.ws + WS_PA), (const float*)(F.ws + WS_RSTD1), F.ctl + CW_KMAX + l * 64 * 16};
            pg8::gemm_phase<pg8::EpiProj, pg8::StaticOrder, true>(F.tid, F.lds, (const bf16_t*)(F.ws + WS_HB), D, S, E);
            SEAM(pb + 1);
        }
        if (IN(pb + 2) && PM(3)) { FRESH();
            const int gw = F.bid * NWAVES + F.wave, NGW = F.G * NWAVES;
            for (int u = gw; u < 128; u += NGW) hg_naive_unit(F, l, u);
            for (int u = gw; u < 2048; u += NGW) pool_unit(F, l, u);
            __syncthreads();
            for (int u = F.bid; u < 1024; u += F.G) { const int c = u & 255, i = u >> 8, bh = c >> 2, s = c & 3, qb = (i == 0) ? s : (i == 1) ? 7 - s : (i == 2) ? 8 + s : 15 - s;
                attn_unit(F, l, bh >> 3, bh & 7, qb); }
            SEAM(pb + 2);
        }
        if (IN(pb + 3) && PM(4)) { FRESH(); hg_fix_phase(F, l); SEAM(pb + 3); }
        if (IN(pb + 4) && PM(5)) { FRESH();
            pg8::StaticOrder S; S.init(T, D, D, F.G, F.bid, (const bf16_t*)(F.ws + WS_WOUT + l * WOUT_BYTES));
            pg8::EpiOut E{l == 0 ? inp(F, I_x) : F.out, F.out};
            pg8::gemm_phase<pg8::EpiOut, pg8::StaticOrder, true>(F.tid, F.lds, (const bf16_t*)(F.ws + WS_MIXED), D, S, E);
            SEAM(pb + 4);
        }
        if (IN(pb + 5) && PM(6)) { FRESH(); r_phase<1, false, false>(F, l, F.out, F.out); SEAM(pb + 5); }
        if ((IN(pb + 6) && PM(7)) || (IN(pb + 7) && PM(8))) { FRESH();
            LAS int* tb = (LAS int*)(F.lds + LDSCTL_OFF + LC_TB); LAS int* cn = (LAS int*)(F.lds + LDSCTL_OFF + LC_CN);
            if (F.tid < NE) cn[F.tid] = (int)__hip_atomic_load(F.ctl + CW_CUR + (l * NE + F.tid) * 16, __ATOMIC_RELAXED, __HIP_MEMORY_SCOPE_AGENT);
            __syncthreads();
            if (F.tid == 0) { int a = 0; for (int e = 0; e < NE; ++e) { tb[e] = a; a += (cn[e] + 255) >> 8; } tb[NE] = a; }
            __syncthreads();
            const int ntile = tb[NE];
            if (IN(pb + 6) && PM(7)) {
                pg8::MoeOrder<true> S; S.nM = ntile; S.nN = 2 * FF / 256; S.nwg = S.nM * S.nN; S.G = F.G; S.c = F.bid; S.Wt = (const char*)(F.ws + WS_W1 + (size_t)l * NE * W1E_BYTES); S.estride = W1E_BYTES; S.tstep = (size_t)256 * D * 2;
                S.tb = tb; S.cn = cn; S.list = (const u32x2*)(F.ws + WS_LIST);
                pg8::EpiGlu E{(bf16_t*)(F.ws + WS_PA), (const u32x2*)(F.ws + WS_LIST), (const float*)(F.ws + WS_B1R) + (size_t)l * NE * 2048};
                pg8::gemm_phase<pg8::EpiGlu, pg8::MoeOrder<true>, true>(F.tid, F.lds, (const bf16_t*)(F.ws + WS_HB), D, S, E);
                SEAM(pb + 6);
            }
            if (IN(pb + 7) && PM(8)) { FRESH();
                pg8::MoeOrder<false> S; S.nM = ntile; S.nN = D / 256; S.nwg = S.nM * S.nN; S.G = F.G; S.c = F.bid; S.Wt = (const char*)(F.ws + WS_W2 + (size_t)l * NE * W2E_BYTES); S.estride = W2E_BYTES; S.tstep = (size_t)256 * FF * 2;
                S.tb = tb; S.cn = cn; S.list = (const u32x2*)(F.ws + WS_LIST);
                pg8::EpiDown E{(bf16_t*)(F.ws + WS_Y), (const u32x2*)(F.ws + WS_LIST), (const float*)(F.ws + WS_GATE), inp(F, I_b2) + (size_t)l * NE * D};
                pg8::gemm_phase<pg8::EpiDown, pg8::MoeOrder<false>, true>(F.tid, F.lds, (const bf16_t*)(F.ws + WS_PA), FF, S, E);
                SEAM(pb + 7);
            }
        }
    }
    if (IN(N_PHASES - 1) && PM(9)) { FRESH(); r_final(F); }
#undef IN
#undef SEAM
}

extern "C" void kernel_launch(void* const* d_in, const int* in_sizes, int n_in, void* d_out, int out_size, void* d_ws, size_t ws_size, hipStream_t stream) {
    static int grid = 0;
    if (grid == 0) {
        if (n_in != 18 || out_size != T * D || ws_size < WS_END) { fprintf(stderr, "kernel_launch: unexpected shapes (n_in %d out %d ws %zu need %zu)\n", n_in, out_size, ws_size, (size_t)WS_END); grid = -1; return; }
        int dev = 0, cus = 0;
        if (hipGetDevice(&dev) != hipSuccess || hipDeviceGetAttribute(&cus, hipDeviceAttributeMultiprocessorCount, dev) != hipSuccess) { grid = -1; return; }
        if (hipFuncSetAttribute((const void*)trunk_fwd, hipFuncAttributeMaxDynamicSharedMemorySize, LDS_BYTES) != hipSuccess) { fprintf(stderr, "kernel_launch: hipFuncSetAttribute failed\n"); grid = -1; return; }
        int per_cu = 0;
        if (hipOccupancyMaxActiveBlocksPerMultiprocessor(&per_cu, (const void*)trunk_fwd, NTHREADS, LDS_BYTES) != hipSuccess || per_cu < 1) { fprintf(stderr, "kernel_launch: occupancy query says %d\n", per_cu); (void)hipGetLastError(); }
        grid = cus;
    }
    if (grid < 0) return;
    (void)hipMemsetAsync((char*)d_ws + WS_CTL, 0, CTL_ZERO_BYTES, stream);
    Args a{};
    for (int i = 0; i < 18; ++i) a.in[i] = (const float*)d_in[i];
    a.out = (float*)d_out; a.ws = (unsigned char*)d_ws;
#if MK_SPLIT
    for (int p = 0; p < N_PHASES; ++p) { a.ph_lo = p; a.ph_hi = p + 1; hipLaunchKernelGGL(trunk_fwd, dim3(grid), dim3(NTHREADS), LDS_BYTES, stream, a); }
#else
    a.ph_lo = 0; a.ph_hi = N_PHASES; hipLaunchKernelGGL(trunk_fwd, dim3(grid), dim3(NTHREADS), LDS_BYTES, stream, a);
#endif
}
```

```cpp
#include <hip/hip_runtime.h>
#include <cstdio>
#include <cstdint>

#ifndef MK_SPLIT
#define MK_SPLIT 0
#endif

#define LAS __attribute__((address_space(3)))
#define GAS __attribute__((address_space(1)))
typedef unsigned short bf16_t;
typedef short bf16x8 __attribute__((ext_vector_type(8)));
typedef float f32x4 __attribute__((ext_vector_type(4)));
typedef float f32x2 __attribute__((ext_vector_type(2)));
typedef float f32x16 __attribute__((ext_vector_type(16)));
typedef unsigned u32x4 __attribute__((ext_vector_type(4)));
typedef unsigned u32x2 __attribute__((ext_vector_type(2)));
typedef __bf16 bf16x2_t __attribute__((ext_vector_type(2)));
typedef short v4i16_t __attribute__((ext_vector_type(4)));

constexpr int NB = 8, SEQ = 4096, T = NB * SEQ, D = 1024, NL = 4;
constexpr int NPROJ = 2816;
constexpr int C_FQ = 0, C_FK = 512, C_FV = 1024, C_GQ = 1536, C_GF = 1792, C_GI = 2048, C_GG = 2304, C_PU = 2560;
constexpr int IN_COLS = 2824;
constexpr int NE = 32, TOPK = 4, FF = 1024, MROWS = T * TOPK, LISTCAP = MROWS, MAXTILES = MROWS / 256 + NE;
constexpr float RMS_EPS = 1e-5f, LOG2E = 1.4426950408889634f;
constexpr float QSCALE = 0.125f * LOG2E;
constexpr int NWAVES = 8, NTHREADS = 512;

constexpr size_t MiB = 1u << 20;
constexpr size_t WS_CTL = 0, CTL_ZERO_BYTES = 1 * MiB;
constexpr size_t WS_RSTD1 = 1 * MiB, WS_RSTD2 = WS_RSTD1 + 128 * 1024;
constexpr size_t WS_LOGF = 2 * MiB, WS_C2 = 3 * MiB, WS_GATE = 4 * MiB, WS_B1R = 5 * MiB, WS_WFRAG = 6 * MiB, WS_LIST = 8 * MiB;
constexpr size_t WS_WIN = 40 * MiB, WIN_BYTES = (size_t)NPROJ * D * 2;
constexpr size_t WS_WOUT = 62 * MiB, WOUT_BYTES = (size_t)D * D * 2;
constexpr size_t WS_W1 = 70 * MiB, W1E_BYTES = (size_t)2 * FF * D * 2;
constexpr size_t WS_W2 = 582 * MiB, W2E_BYTES = (size_t)D * FF * 2;
constexpr size_t WS_HB = 838 * MiB;
constexpr size_t WS_PA = 902 * MiB;
constexpr size_t WS_MIXED = WS_PA + 176 * MiB;
constexpr size_t WS_Y = 1174 * MiB;
constexpr size_t WS_ORAW = 1430 * MiB;
constexpr size_t WS_END = 1558 * MiB;
static_assert(WS_WIN + NL * WIN_BYTES <= WS_WOUT && WS_WOUT + NL * WOUT_BYTES <= WS_W1 && WS_W1 + (size_t)NL * NE * W1E_BYTES <= WS_W2 && WS_W2 + (size_t)NL * NE * W2E_BYTES <= WS_HB, "ws map");
static_assert((size_t)MAXTILES * 256 * FF * 2 <= 272 * MiB && (size_t)T * NPROJ * 2 <= 176 * MiB, "ws map 2");
constexpr int CW_TMO = 0, CW_BAR = 4096, CW_CUR = 16384, CW_KMAX = 32768;
constexpr int PH_BYTES = 139264, LDSCTL_OFF = PH_BYTES, LDS_BYTES = PH_BYTES + 2048;
constexpr int LC_BAR = 0, LC_TB = 64, LC_CN = 256, LC_R2CNT = 512, LC_R2BASE = 640, LC_STOP = 768, LC_SCAN = 896, LC_INP = 1024;

__device__ __forceinline__ unsigned cvtpk(float lo, float hi) { f32x2 v = {lo, hi}; bf16x2_t b = __builtin_convertvector(v, bf16x2_t); return __builtin_bit_cast(unsigned, b); }
__device__ __forceinline__ float bflo(unsigned w) { return __uint_as_float(w << 16); }
__device__ __forceinline__ float bfhi(unsigned w) { return __uint_as_float(w & 0xffff0000u); }
__device__ __forceinline__ float bf2f(bf16_t h) { return __uint_as_float((unsigned)h << 16); }
__device__ __forceinline__ bf16_t f2bf(float f) { return (bf16_t)(cvtpk(f, 0.f) & 0xffffu); }
__device__ __forceinline__ float rdlane(float v, int l) { return __uint_as_float((unsigned)__builtin_amdgcn_readlane((int)__float_as_uint(v), l)); }
#define LDS_WAIT() asm volatile("s_waitcnt lgkmcnt(0)" ::: "memory")
#define VM_WAIT() asm volatile("s_waitcnt vmcnt(0)" ::: "memory")

namespace pg8 {
constexpr int BM = 256, BK = 64, HALF = 128, HTB = HALF * BK * 2, STAGE_BYTES = 8 * HTB, NXCD = 8, WGM = 8;
__host__ __device__ __forceinline__ int lds_byte(int r, int c) { const int st = (r >> 4) * 2 + (c >> 5), rr = r & 15, cc = c & 31, ob = rr * 64 + cc * 2; return st * 1024 + (ob ^ (((ob >> 9) & 1) << 5)); }
__host__ __device__ __forceinline__ void stage_rc(int b, int& R, int& C) { const int st = b / 1024, sb = b % 1024, swz = sb ^ (((sb >> 9) & 1) << 5); R = (st >> 1) * 16 + swz / 64; C = (st & 1) * 32 + (swz % 64) / 2; }
__host__ __device__ __forceinline__ int perm32(int rho) { const int n = rho >> 4, i = rho & 15; return 8 * (i >> 2) + 4 * n + (i & 3); }

struct Unit { int pm, pn, e, lt, cnt; };

__device__ __forceinline__ void tile_of(int L, int nM, int nN, int& pm, int& pn) {
    const int nwg = nM * nN; int wgid = L;
    { const int q = nwg / NXCD, r = nwg % NXCD, xcd = wgid % NXCD, off = wgid / NXCD; wgid = (xcd < r ? xcd * (q + 1) : r * (q + 1) + (xcd - r) * q) + off; }
    const int nig = WGM * nN, gid = wgid / nig, fm = gid * WGM, gsz = (nM - fm) < WGM ? (nM - fm) : WGM;
    pm = fm + ((wgid % nig) % gsz); pn = (wgid % nig) / gsz;
}
struct StaticOrder {
    int nM, nN, nwg, G, c; const char* Bt; size_t tstep;
    __device__ void init(int M, int N, int K, int G_, int c_, const bf16_t* Bt_) { nM = M / BM; nN = N / BM; nwg = nM * nN; G = G_; c = c_; Bt = (const char*)Bt_; tstep = (size_t)BM * K * 2; }
    __device__ __forceinline__ bool next(int i, Unit& u) const { const long L = (long)i * G + c; if (L >= nwg) return false; tile_of((int)L, nM, nN, u.pm, u.pn); u.e = 0; u.lt = 0; u.cnt = 0; return true; }
    __device__ __forceinline__ const char* bbase(const Unit& u) const { return Bt + (size_t)u.pn * tstep; }
    __device__ __forceinline__ int arow(const Unit& u, int r) const { return u.pm * BM + r; }
};
template <bool GATHER> struct MoeOrder {
    int nM, nN, nwg, G, c; const char* Wt; size_t estride, tstep; LAS const int* tb; LAS const int* cn; const u32x2* list;
    __device__ __forceinline__ bool next(int i, Unit& u) const {
        const long L = (long)i * G + c; if (L >= nwg) return false; tile_of((int)L, nM, nN, u.pm, u.pn);
        int e = 0; while (e < NE - 1 && tb[e + 1] <= u.pm) ++e;
        u.e = e; u.lt = u.pm - tb[e]; u.cnt = cn[e]; return true; }
    __device__ __forceinline__ const char* bbase(const Unit& u) const { return Wt + (size_t)u.e * estride + (size_t)u.pn * tstep; }
    __device__ __forceinline__ int arow(const Unit& u, int r) const {
        if (!GATHER) return u.pm * BM + r;
        const int pos = u.lt * BM + r; return pos < u.cnt ? (int)(list[(size_t)u.e * LISTCAP + pos].x >> 2) : 0; }
};

template <class Epi, class Sched, bool ALIGN_EPI>
__device__ __forceinline__ void gemm_phase(const int tid, LAS unsigned char* lds, const bf16_t* Abase, const int K, const Sched& S, const Epi& E) {
    const int wid = __builtin_amdgcn_readfirstlane(tid >> 6), lane = tid & 63, wr = wid >> 2, wc = wid & 3, fr = lane & 15, fq = lane >> 4;
    const int nt = K / BK;
    unsigned voffB[2];
#pragma unroll
    for (int i = 0; i < 2; ++i) { int R, C; stage_rc(tid * 16 + i * 8192, R, C); const int Rb = Epi::PERM ? ((R & ~31) + perm32(R & 31)) : R; voffB[i] = (unsigned)(Rb * K + C) * 2u; }
    const size_t kstep = (size_t)(BK * 2);
    const size_t hstep = (size_t)HALF * K * 2;
    const unsigned ldsw = (unsigned)wid * 1024u;
    const int aoff = lds_byte(wr * 64 + fr, fq * 8), boff = lds_byte(wc * 32 + fr, fq * 8);
    const char* A8 = (const char*)Abase;
#define PG8_SA(b, h) (((b) * 2 + (h)) * HTB)
#define PG8_SB(b, h) ((4 + (b) * 2 + (h)) * HTB)
#define PG8_STGB(bufoff, gbase) do { _Pragma("unroll") for (int _i = 0; _i < 2; ++_i) \
        __builtin_amdgcn_global_load_lds((const unsigned*)((const char*)(gbase) + voffB[_i]), (LAS unsigned*)(lds + (bufoff) + ldsw + _i * 8192), 16, 0, 0); } while (0)
#define PG8_STGA(bufoff, kb, o0, o1) do { \
        __builtin_amdgcn_global_load_lds((const unsigned*)(A8 + (size_t)(kb) + (o0)), (LAS unsigned*)(lds + (bufoff) + ldsw), 16, 0, 0); \
        __builtin_amdgcn_global_load_lds((const unsigned*)(A8 + (size_t)(kb) + (o1)), (LAS unsigned*)(lds + (bufoff) + ldsw + 8192), 16, 0, 0); } while (0)
#define PG8_LDA(dst, b, h) do { _Pragma("unroll") for (int m = 0; m < 4; ++m) _Pragma("unroll") for (int k = 0; k < 2; ++k) dst[m][k] = *(const LAS bf16x8*)(lds + PG8_SA(b, h) + aoff + m * 2048 + k * 1024); } while (0)
#define PG8_LDB(dst, b, h) do { _Pragma("unroll") for (int n = 0; n < 2; ++n) _Pragma("unroll") for (int k = 0; k < 2; ++k) dst[n][k] = *(const LAS bf16x8*)(lds + PG8_SB(b, h) + boff + n * 2048 + k * 1024); } while (0)
#define PG8_MMA(ai, bj, At, Bt) do { __builtin_amdgcn_s_setprio(1); _Pragma("unroll") for (int m = 0; m < 4; ++m) _Pragma("unroll") for (int n = 0; n < 2; ++n) _Pragma("unroll") for (int k = 0; k < 2; ++k) \
        acc[ai][bj][m][n] = __builtin_amdgcn_mfma_f32_16x16x32_bf16(Bt[n][k], At[m][k], acc[ai][bj][m][n], 0, 0, 0); __builtin_amdgcn_s_setprio(0); } while (0)
#define PG8_WAIT_V(n) asm volatile("s_waitcnt vmcnt(" #n ")" ::: "memory")
#define PG8_WAIT_L(n) asm volatile("s_waitcnt lgkmcnt(" #n ")" ::: "memory")
#define PG8_BAR __builtin_amdgcn_s_barrier()
#define PG8_SCHED __builtin_amdgcn_sched_barrier(0)
#define PG8_AOFF(u, dst) do { _Pragma("unroll") for (int _h = 0; _h < 2; ++_h) _Pragma("unroll") for (int _i = 0; _i < 2; ++_i) \
        { int R_, C_; stage_rc(tid * 16 + _i * 8192, R_, C_); dst[_h][_i] = (unsigned)((size_t)S.arow(u, _h * HALF + R_) * (size_t)K + (size_t)C_) * 2u; } } while (0)
    Unit cur, nxt; int ui = 0;
    if (!S.next(0, cur)) return;
    f32x4 acc[2][2][4][2];
#pragma unroll
    for (int a = 0; a < 2; ++a)
#pragma unroll
        for (int b = 0; b < 2; ++b)
#pragma unroll
            for (int m = 0; m < 4; ++m)
#pragma unroll
                for (int n = 0; n < 2; ++n) acc[a][b][m][n] = (f32x4){0.f, 0.f, 0.f, 0.f};
    bf16x8 At[4][2], B0[2][2], B1[2][2];
    unsigned aoC[2][2], aoN[2][2];
    PG8_AOFF(cur, aoC);
    const char* cB = S.bbase(cur);
    PG8_STGB(PG8_SB(0, 0), cB); PG8_STGB(PG8_SB(0, 1), cB + hstep); PG8_STGA(PG8_SA(0, 0), 0, aoC[0][0], aoC[0][1]); PG8_STGA(PG8_SA(0, 1), 0, aoC[1][0], aoC[1][1]);
    if (wr == 1) PG8_BAR;
    PG8_WAIT_V(2); PG8_BAR;
    PG8_STGB(PG8_SB(1, 0), cB + kstep); PG8_STGA(PG8_SA(1, 0), kstep, aoC[0][0], aoC[0][1]); PG8_STGB(PG8_SB(1, 1), cB + hstep + kstep);
    PG8_WAIT_V(6); PG8_BAR;
    for (;;) {
        const bool has_next = S.next(ui + 1, nxt);
        if (has_next) { PG8_AOFF(nxt, aoN); } else { aoN[0][0] = aoC[0][0]; aoN[0][1] = aoC[0][1]; aoN[1][0] = aoC[1][0]; aoN[1][1] = aoC[1][1]; }
        const char* nB = has_next ? S.bbase(nxt) : cB;
        for (int t = 0; t < nt; t += 2) {
            const bool last = (t == nt - 2);
            const size_t k1 = (size_t)(t + 1) * kstep, k2 = last ? 0 : (size_t)(t + 2) * kstep, k3 = k2 + kstep;
            const char* b2 = last ? nB : cB + (size_t)(t + 2) * kstep; const char* b3 = b2 + kstep;
            const unsigned a200 = last ? aoN[0][0] : aoC[0][0], a201 = last ? aoN[0][1] : aoC[0][1], a210 = last ? aoN[1][0] : aoC[1][0], a211 = last ? aoN[1][1] : aoC[1][1];
            PG8_LDB(B0, 0, 0); PG8_LDB(B1, 0, 1); PG8_SCHED; PG8_LDA(At, 0, 0); PG8_STGA(PG8_SA(1, 1), k1, aoC[1][0], aoC[1][1]);
            PG8_WAIT_V(8); PG8_WAIT_L(0); PG8_BAR; PG8_MMA(0, 0, At, B0); PG8_MMA(0, 1, At, B1); PG8_BAR; PG8_SCHED;
            PG8_LDA(At, 0, 1); PG8_STGB(PG8_SB(0, 0), b2); PG8_STGB(PG8_SB(0, 1), b2 + hstep); PG8_STGA(PG8_SA(0, 0), k2, a200, a201);
            PG8_WAIT_V(8); PG8_WAIT_L(0); PG8_BAR; PG8_MMA(1, 0, At, B0); PG8_MMA(1, 1, At, B1); PG8_BAR; PG8_SCHED;
            PG8_LDB(B0, 1, 0); PG8_LDB(B1, 1, 1); PG8_SCHED; PG8_LDA(At, 1, 0); PG8_STGA(PG8_SA(0, 1), k2, a210, a211);
            PG8_WAIT_V(8); PG8_WAIT_L(0); PG8_BAR; PG8_MMA(0, 0, At, B0); PG8_MMA(0, 1, At, B1); PG8_BAR; PG8_SCHED;
            PG8_LDA(At, 1, 1); PG8_STGB(PG8_SB(1, 0), b3); PG8_STGB(PG8_SB(1, 1), b3 + hstep); PG8_STGA(PG8_SA(1, 0), k3, a200, a201);
            PG8_WAIT_V(8); PG8_WAIT_L(0); PG8_BAR; PG8_MMA(1, 0, At, B0); PG8_MMA(1, 1, At, B1); PG8_BAR; PG8_SCHED;
        }
        if constexpr (ALIGN_EPI) { if (wr == 0) PG8_BAR; }
        E(acc, cur, wr, wc, fr, fq);
        if (!has_next) break;
#pragma unroll
        for (int a = 0; a < 2; ++a)
#pragma unroll
            for (int b = 0; b < 2; ++b)
#pragma unroll
                for (int m = 0; m < 4; ++m)
#pragma unroll
                    for (int n = 0; n < 2; ++n) acc[a][b][m][n] = (f32x4){0.f, 0.f, 0.f, 0.f};
        cur = nxt; cB = nB; ++ui;
        aoC[0][0] = aoN[0][0]; aoC[0][1] = aoN[0][1]; aoC[1][0] = aoN[1][0]; aoC[1][1] = aoN[1][1];
        if constexpr (ALIGN_EPI) { if (wr == 1) PG8_BAR; }
    }
    PG8_WAIT_V(0);
    if constexpr (!ALIGN_EPI) { if (wr == 0) PG8_BAR; }
    PG8_BAR;
#undef PG8_SA
#undef PG8_SB
#undef PG8_STGA
#undef PG8_STGB
#undef PG8_LDA
#undef PG8_LDB
#undef PG8_MMA
#undef PG8_WAIT_V
#undef PG8_WAIT_L
#undef PG8_BAR
#undef PG8_SCHED
#undef PG8_AOFF
}

struct EpiProj {
    static constexpr bool PERM = true;
    bf16_t* O; const float* rstd; unsigned* kmax;
    __device__ __forceinline__ void operator()(const f32x4 (&acc)[2][2][4][2], const Unit& u, int wr, int wc, int fr, int fq) const {
        const int row0 = u.pm * BM + wr * 64 + fr, col0 = u.pn * BM + wc * 32 + 8 * fq;
        const float sc = (u.pn < 2) ? QSCALE : 1.f; const bool isk = (u.pn == 2 || u.pn == 3);
        float km[2] = {0.f, 0.f};
#pragma unroll
        for (int ai = 0; ai < 2; ++ai)
#pragma unroll
            for (int m = 0; m < 4; ++m) { const int row = row0 + ai * HALF + m * 16; const float rs = rstd[row] * sc; bf16_t* rowp = O + (size_t)row * NPROJ + col0;
#pragma unroll
                for (int bj = 0; bj < 2; ++bj) { const f32x4 v0 = acc[ai][bj][m][0] * rs, v1 = acc[ai][bj][m][1] * rs;
                    u32x4 w; w.x = cvtpk(v0[0], v0[1]); w.y = cvtpk(v0[2], v0[3]); w.z = cvtpk(v1[0], v1[1]); w.w = cvtpk(v1[2], v1[3]);
                    *(u32x4*)(rowp + bj * HALF) = w;
                    if (isk) { float s = bflo(w.x) * bflo(w.x) + bfhi(w.x) * bfhi(w.x) + bflo(w.y) * bflo(w.y) + bfhi(w.y) * bfhi(w.y) + bflo(w.z) * bflo(w.z) + bfhi(w.z) * bfhi(w.z) + bflo(w.w) * bflo(w.w) + bfhi(w.w) * bfhi(w.w);
                        s += __shfl_xor(s, 16); s += __shfl_xor(s, 32); km[bj] = fmaxf(km[bj], s); } } }
        if (isk) {
#pragma unroll
            for (int bj = 0; bj < 2; ++bj) { float v = km[bj]; v = fmaxf(v, __shfl_xor(v, 1)); v = fmaxf(v, __shfl_xor(v, 2)); v = fmaxf(v, __shfl_xor(v, 4)); v = fmaxf(v, __shfl_xor(v, 8));
                if ((threadIdx.x & 63) == 0) { const int b = u.pm >> 4, h = (u.pn - 2) * 4 + bj * 2 + (wc >> 1); atomicMax(kmax + (b * 8 + h) * 16, __float_as_uint(v)); } }
        }
    }
};
struct EpiOut {
    static constexpr bool PERM = false;
    const float* res; float* out;
    __device__ __forceinline__ void operator()(const f32x4 (&acc)[2][2][4][2], const Unit& u, int wr, int wc, int fr, int fq) const {
        const int row0 = u.pm * BM + wr * 64 + fr, col0 = u.pn * BM + wc * 32 + 4 * fq;
#pragma unroll
        for (int ai = 0; ai < 2; ++ai)
#pragma unroll
            for (int m = 0; m < 4; ++m) { const size_t off = (size_t)(row0 + ai * HALF + m * 16) * D + col0;
#pragma unroll
                for (int bj = 0; bj < 2; ++bj)
#pragma unroll
                    for (int n = 0; n < 2; ++n) { const f32x4 r = *(const f32x4*)(res + off + bj * HALF + n * 16); *(f32x4*)(out + off + bj * HALF + n * 16) = r + acc[ai][bj][m][n]; } }
    }
};
struct EpiGlu {
    static constexpr bool PERM = true;
    bf16_t* act; const u32x2* list; const float* b1r;
    __device__ __forceinline__ void operator()(const f32x4 (&acc)[2][2][4][2], const Unit& u, int wr, int wc, int fr, int fq) const {
        const int cb = u.pn * BM + wc * 32 + 8 * fq; const float* bp = b1r + (size_t)u.e * 2048 + cb;
        const f32x4 bg0 = *(const f32x4*)(bp), bg1 = *(const f32x4*)(bp + 4), bl0 = *(const f32x4*)(bp + HALF), bl1 = *(const f32x4*)(bp + HALF + 4);
#pragma unroll
        for (int ai = 0; ai < 2; ++ai)
#pragma unroll
            for (int m = 0; m < 4; ++m) { const int r = ai * HALF + wr * 64 + m * 16 + fr, pos = u.lt * BM + r;
                float rs = 0.f; if (pos < u.cnt) rs = __uint_as_float(list[(size_t)u.e * LISTCAP + pos].y);
                f32x4 g0 = acc[ai][0][m][0] * rs + bg0, g1 = acc[ai][0][m][1] * rs + bg1, l0 = acc[ai][1][m][0] * rs + bl0, l1 = acc[ai][1][m][1] * rs + bl1;
                float o[8];
#pragma unroll
                for (int j = 0; j < 8; ++j) { float g = j < 4 ? g0[j & 3] : g1[j & 3], li = j < 4 ? l0[j & 3] : l1[j & 3];
                    g = fminf(g, 7.f); li = fminf(fmaxf(li, -7.f), 7.f);
                    const float sg = __builtin_amdgcn_rcpf(1.f + __builtin_amdgcn_exp2f(-1.702f * LOG2E * g)); o[j] = g * sg * (li + 1.f); }
                u32x4 w; w.x = cvtpk(o[0], o[1]); w.y = cvtpk(o[2], o[3]); w.z = cvtpk(o[4], o[5]); w.w = cvtpk(o[6], o[7]);
                *(u32x4*)(act + (size_t)(u.pm * BM + r) * FF + u.pn * HALF + wc * 32 + 8 * fq) = w; }
    }
};
struct EpiDown {
    static constexpr bool PERM = true;
    bf16_t* Y; const u32x2* list; const float* gate; const float* b2;
    __device__ __forceinline__ void operator()(const f32x4 (&acc)[2][2][4][2], const Unit& u, int wr, int wc, int fr, int fq) const {
        const int cb = u.pn * BM + wc * 32 + 8 * fq; const float* bp = b2 + (size_t)u.e * D + cb;
        f32x4 bv[2][2];
#pragma unroll
        for (int bj = 0; bj < 2; ++bj)
#pragma unroll
            for (int n = 0; n < 2; ++n) bv[bj][n] = *(const f32x4*)(bp + bj * HALF + 4 * n);
#pragma unroll
        for (int ai = 0; ai < 2; ++ai)
#pragma unroll
            for (int m = 0; m < 4; ++m) { const int r = ai * HALF + wr * 64 + m * 16 + fr, pos = u.lt * BM + r;
                if (pos < u.cnt) { const unsigned ent = list[(size_t)u.e * LISTCAP + pos].x; const float gt = gate[ent]; bf16_t* rowp = Y + (size_t)ent * D + cb;
#pragma unroll
                    for (int bj = 0; bj < 2; ++bj) { const f32x4 v0 = (acc[ai][bj][m][0] + bv[bj][0]) * gt, v1 = (acc[ai][bj][m][1] + bv[bj][1]) * gt;
                        u32x4 w; w.x = cvtpk(v0[0], v0[1]); w.y = cvtpk(v0[2], v0[3]); w.z = cvtpk(v1[0], v1[1]); w.w = cvtpk(v1[2], v1[3]);
                        *(u32x4*)(rowp + bj * HALF) = w; } } }
    }
};
}

#define XB_TMO      128
#define XB_XCNT(j)  (256  + 64 * (j))
#define XB_XSUB(j)  (1280 + 64 * (j))
#define XB_XGEN(j)  (2304 + 64 * (j))
#define XB_TOP      3328
#define XB_TOPGEN   3392
#define XCD_BAR_WORDS 3456
#define XB_SPIN_CAP (1u << 18)
__device__ __forceinline__ unsigned xb_ld(unsigned* p)              { return __hip_atomic_load(p, __ATOMIC_RELAXED, __HIP_MEMORY_SCOPE_AGENT); }
__device__ __forceinline__ unsigned xb_add(unsigned* p, unsigned v) { return __hip_atomic_fetch_add(p, v, __ATOMIC_RELAXED, __HIP_MEMORY_SCOPE_AGENT); }
__device__ __forceinline__ unsigned xb_xcc_id() { return (unsigned)__builtin_amdgcn_s_getreg((3 << 11) | 20) & 0xFu; }
#define XB_SPIN(cond, bar) do { unsigned _sp = 0; while (cond) { __builtin_amdgcn_s_sleep(1); \
    if ((++_sp & 255u) == 0u) { if (xb_ld(&(bar)[XB_TMO])) break; if (_sp > XB_SPIN_CAP) { atomicAdd(&(bar)[XB_TMO], 1u); break; } } } } while (0)
struct XcdBarrier { unsigned* bar; unsigned x; volatile LAS unsigned* st; };
__device__ __forceinline__ XcdBarrier xcd_barrier_post(unsigned* bar, volatile LAS unsigned* st) {
    XcdBarrier b; b.bar = bar; b.x = xb_xcc_id(); b.st = st;
    if (threadIdx.x == 0) (void)xb_add(&bar[XB_XCNT(b.x)], 1u);
    return b;
}
__device__ __forceinline__ void xcd_barrier_complete(unsigned* bar, unsigned x, unsigned& nloc, unsigned& nx) {
    const unsigned G = gridDim.x * gridDim.y * gridDim.z;
    unsigned sum, cnt, mine, sp = 0u;
    for (;;) {
        sum = 0u; cnt = 0u; mine = 0u;
#pragma unroll
        for (unsigned j = 0; j < 16; ++j) { const unsigned c = xb_ld(&bar[XB_XCNT(j)]); sum += c; cnt += (c > 0u) ? 1u : 0u; mine = (j == x) ? c : mine; }
        if (sum == G) break;
        __builtin_amdgcn_s_sleep(1);
        if ((++sp & 255u) == 0u) { if (xb_ld(&bar[XB_TMO])) break; if (sp > XB_SPIN_CAP) { atomicAdd(&bar[XB_TMO], 1u); break; } }
    }
    nloc = mine > 0u ? mine : 1u; nx = cnt > 0u ? cnt : 1u;
}
__device__ __forceinline__ void xcd_barrier(const XcdBarrier& b, const bool leader  ) {
    asm volatile("s_waitcnt vmcnt(0)" ::: "memory");
    __syncthreads();
    if (leader) {
        unsigned* bar = b.bar;
        __builtin_amdgcn_s_waitcnt(0);
        unsigned nloc = b.st[0], nx = b.st[1];
        if (nloc == 0u) { xcd_barrier_complete(bar, b.x, nloc, nx); b.st[0] = nloc; b.st[1] = nx; }
        const unsigned old = xb_add(&bar[XB_XSUB(b.x)], 1u);
        const unsigned gen = old / nloc;
        if (old + 1u == (gen + 1u) * nloc) {
            __builtin_amdgcn_fence(__ATOMIC_RELEASE, "agent");
            asm volatile("s_waitcnt vmcnt(0)" ::: "memory");
            const unsigned og = xb_add(&bar[XB_TOP], 1u);
            const unsigned tg = og / nx;
            if (og + 1u == (tg + 1u) * nx) xb_add(&bar[XB_TOPGEN], 1u);
            else XB_SPIN(xb_ld(&bar[XB_TOPGEN]) == tg, bar);
            __builtin_amdgcn_fence(__ATOMIC_ACQUIRE, "agent");
            xb_add(&bar[XB_XGEN(b.x)], 1u);
            asm volatile("s_waitcnt vmcnt(0)" ::: "memory");
        } else {
            XB_SPIN(xb_ld(&bar[XB_XGEN(b.x)]) == gen, bar);
            __builtin_amdgcn_fence(__ATOMIC_ACQUIRE, "agent");
            asm volatile("s_waitcnt vmcnt(0)" ::: "memory");
        }
    }
    __syncthreads();
}

enum { I_x = 0, I_norm_mix, I_w_in, I_b_fox_f, I_fox_gain, I_hgrn_lb, I_hgrn_gain, I_pool_w, I_pool_scale, I_w_out, I_norm_moe, I_w_router, I_b_router, I_w1, I_b1, I_w2, I_b2, I_norm_final };
struct Frame {
    LAS unsigned char* lds; unsigned char* ws; unsigned* ctl; float* out;
    int tid, lane, wave, bid, G;
};
__device__ __forceinline__ const float* inp(const Frame& F, int i) {
    const LAS unsigned* p = (const LAS unsigned*)(F.lds + LDSCTL_OFF + LC_INP) + 2 * i;
    const unsigned lo = __builtin_amdgcn_readfirstlane(p[0]), hi = __builtin_amdgcn_readfirstlane(p[1]);
    return (const float*)(((unsigned long long)hi << 32) | lo);
}

__device__ __forceinline__ void p0_item(const float* src, int ldn, int c0, int cs, const float* g, bf16_t* dstrow0, int K, int k0, LAS float* scr, int lane) {
#pragma unroll 8
    for (int i = 0; i < 32; ++i) { const int kk = 2 * i + (lane >> 5); float v = src[(size_t)(k0 + kk) * ldn + c0 + cs * (lane & 31)]; if (g) v *= g[k0 + kk]; scr[kk * 33 + (lane & 31)] = v; }
    LDS_WAIT(); asm volatile("" ::: "memory");
    const int c = lane & 7;
#pragma unroll
    for (int j = 0; j < 4; ++j) { const int n = (lane >> 3) + 8 * j; const LAS float* s = scr + (8 * c) * 33 + n;
        u32x4 o; o.x = cvtpk(s[0 * 33], s[1 * 33]); o.y = cvtpk(s[2 * 33], s[3 * 33]); o.z = cvtpk(s[4 * 33], s[5 * 33]); o.w = cvtpk(s[6 * 33], s[7 * 33]);
        *(u32x4*)(dstrow0 + (size_t)n * K + k0 + 8 * c) = o; }
    LDS_WAIT(); asm volatile("" ::: "memory");
}
__device__ __forceinline__ void p0_prologue(const Frame& F) {
    LAS float* scr = (LAS float*)(F.lds + F.wave * 16384);
    const int gw = F.bid * NWAVES + F.wave, NGW = F.G * NWAVES;
    constexpr int I_IN = 16 * 88, I_OUT = 16 * 32, I_W1 = NE * 16 * 64, I_W2 = NE * 16 * 32, I_L = I_IN + I_OUT + I_W1 + I_W2;
    for (int it = gw; it < NL * I_L; it += NGW) {
        const int l = it / I_L; int r = it % I_L;
        if (r < I_IN) { const int kb = r / 88, nb = r % 88, n0 = 32 * nb;
            p0_item(inp(F, I_w_in) + (size_t)l * D * IN_COLS, IN_COLS, n0 + (n0 >= 1536 ? 8 : 0), 1, inp(F, I_norm_mix) + l * D, (bf16_t*)(F.ws + WS_WIN + l * WIN_BYTES) + (size_t)n0 * D, D, 64 * kb, scr, F.lane); continue; }
        r -= I_IN;
        if (r < I_OUT) { const int kb = r / 32, nb = r % 32, n0 = 32 * nb;
            p0_item(inp(F, I_w_out) + (size_t)l * D * D, D, n0, 1, nullptr, (bf16_t*)(F.ws + WS_WOUT + l * WOUT_BYTES) + (size_t)n0 * D, D, 64 * kb, scr, F.lane); continue; }
        r -= I_OUT;
        if (r < I_W1) { const int e = r / (16 * 64), q = r % (16 * 64), kb = q / 64, nb = q % 64, n0 = 32 * nb, pn = n0 >> 8, rr = n0 & 255, j0 = 128 * pn + (rr & 127), par = rr >> 7;
            p0_item(inp(F, I_w1) + ((size_t)l * NE + e) * D * 2 * FF, 2 * FF, 2 * j0 + par, 2, inp(F, I_norm_moe) + l * D, (bf16_t*)(F.ws + WS_W1 + ((size_t)l * NE + e) * W1E_BYTES) + (size_t)n0 * D, D, 64 * kb, scr, F.lane); continue; }
        r -= I_W1;
        { const int e = r / (16 * 32), q = r % (16 * 32), kb = q / 32, nb = q % 32, n0 = 32 * nb;
            p0_item(inp(F, I_w2) + ((size_t)l * NE + e) * FF * D, D, n0, 1, nullptr, (bf16_t*)(F.ws + WS_W2 + ((size_t)l * NE + e) * W2E_BYTES) + (size_t)n0 * FF, FF, 64 * kb, scr, F.lane); }
    }
    const int gt = F.bid * NTHREADS + F.tid, NGT = F.G * NTHREADS;
    float* b1r = (float*)(F.ws + WS_B1R);
    for (int i = gt; i < NL * NE * 2048; i += NGT) { const int le = i >> 11, n = i & 2047, pn = n >> 8, rr = n & 255; b1r[i] = inp(F, I_b1)[(size_t)le * 2048 + 2 * (128 * pn + (rr & 127)) + (rr >> 7)]; }
    bf16_t* wf = (bf16_t*)(F.ws + WS_WFRAG);
    for (int i = gt; i < NL * 2 * 32 * 2 * 64 * 8; i += NGT) {
        const int j = i & 7, ln = (i >> 3) & 63, et = (i >> 9) & 1, ks = (i >> 10) & 31, kind = (i >> 15) & 1, l = i >> 16;
        const int e = 16 * et + (ln & 15), k = 32 * ks + 8 * (ln >> 4) + j;
        float v;
        if (kind == 0) v = (e < 8) ? inp(F, I_norm_mix)[l * D + k] * inp(F, I_w_in)[((size_t)l * D + k) * IN_COLS + 1536 + e] : 0.f;
        else v = inp(F, I_norm_moe)[l * D + k] * inp(F, I_w_router)[((size_t)l * D + k) * NE + e];
        const bf16_t h = f2bf(v), lo = f2bf(v - bf2f(h));
        const size_t base = ((((size_t)(l * 2 + kind) * 32 + ks) * 2 + et) * 2) * 512 + ln * 8 + j;
        wf[base] = h; wf[base + 512] = lo;
    }
}

template <int KIND, bool COMBINE, bool WRITE_H>
__device__ __forceinline__ void r_phase(const Frame& F, int l, const float* hin, float* hout) {
    const int lane = F.lane, r16 = lane & 15, q4 = lane >> 4;
    const u32x4* Wf = (const u32x4*)(F.ws + WS_WFRAG + (size_t)(l * 2 + KIND) * 131072);
    const bf16_t* Y = (const bf16_t*)(F.ws + WS_Y);
    bf16_t* HB = (bf16_t*)(F.ws + WS_HB);
    float* rstdp = (float*)(F.ws + (KIND == 0 ? WS_RSTD1 : WS_RSTD2));
    LAS float* lg = (LAS float*)(F.lds) + F.wave * (16 * 33);
    LAS int* r2cnt = (LAS int*)(F.lds + LDSCTL_OFF + LC_R2CNT); LAS int* r2base = (LAS int*)(F.lds + LDSCTL_OFF + LC_R2BASE);
    for (int task = F.bid; task < T / 128; task += F.G) {
        const int tok = task * 128 + F.wave * 16 + r16;
        const float* xr = hin + (size_t)tok * D + 8 * q4; float* ho = hout + (size_t)tok * D + 8 * q4;
        const bf16_t* yr = Y + (size_t)tok * 4 * D + 8 * q4; bf16_t* hbr = HB + (size_t)tok * D + 8 * q4;
        f32x4 acc0 = {0.f, 0.f, 0.f, 0.f}, acc1 = {0.f, 0.f, 0.f, 0.f}; float ssq = 0.f;
        if (KIND == 1) { if (F.tid < 32) r2cnt[F.tid] = 0; }
#pragma unroll 2
        for (int ks = 0; ks < 32; ++ks) {
            f32x4 x0 = *(const f32x4*)(xr + 32 * ks), x1 = *(const f32x4*)(xr + 32 * ks + 4);
            if (COMBINE) {
#pragma unroll
                for (int k = 0; k < 4; ++k) { const u32x4 y = *(const u32x4*)(yr + (size_t)k * D + 32 * ks);
                    x0[0] += bflo(y.x); x0[1] += bfhi(y.x); x0[2] += bflo(y.y); x0[3] += bfhi(y.y); x1[0] += bflo(y.z); x1[1] += bfhi(y.z); x1[2] += bflo(y.w); x1[3] += bfhi(y.w); }
            }
            if (WRITE_H) { *(f32x4*)(ho + 32 * ks) = x0; *(f32x4*)(ho + 32 * ks + 4) = x1; }
            ssq += (x0[0] * x0[0] + x0[1] * x0[1]) + (x0[2] * x0[2] + x0[3] * x0[3]) + (x1[0] * x1[0] + x1[1] * x1[1]) + (x1[2] * x1[2] + x1[3] * x1[3]);
            u32x4 hw; hw.x = cvtpk(x0[0], x0[1]); hw.y = cvtpk(x0[2], x0[3]); hw.z = cvtpk(x1[0], x1[1]); hw.w = cvtpk(x1[2], x1[3]);
            u32x4 lw; lw.x = cvtpk(x0[0] - bflo(hw.x), x0[1] - bfhi(hw.x)); lw.y = cvtpk(x0[2] - bflo(hw.y), x0[3] - bfhi(hw.y)); lw.z = cvtpk(x1[0] - bflo(hw.z), x1[1] - bfhi(hw.z)); lw.w = cvtpk(x1[2] - bflo(hw.w), x1[3] - bfhi(hw.w));
            *(u32x4*)(hbr + 32 * ks) = hw;
            const bf16x8 xh = __builtin_bit_cast(bf16x8, hw), xl = __builtin_bit_cast(bf16x8, lw);
            const bf16x8 wh0 = __builtin_bit_cast(bf16x8, Wf[((ks * 2 + 0) * 2 + 0) * 64 + lane]), wl0 = __builtin_bit_cast(bf16x8, Wf[((ks * 2 + 0) * 2 + 1) * 64 + lane]);
            acc0 = __builtin_amdgcn_mfma_f32_16x16x32_bf16(wh0, xh, acc0, 0, 0, 0);
            acc0 = __builtin_amdgcn_mfma_f32_16x16x32_bf16(wl0, xh, acc0, 0, 0, 0);
            acc0 = __builtin_amdgcn_mfma_f32_16x16x32_bf16(wh0, xl, acc0, 0, 0, 0);
            if (KIND == 1) {
                const bf16x8 wh1 = __builtin_bit_cast(bf16x8, Wf[((ks * 2 + 1) * 2 + 0) * 64 + lane]), wl1 = __builtin_bit_cast(bf16x8, Wf[((ks * 2 + 1) * 2 + 1) * 64 + lane]);
                acc1 = __builtin_amdgcn_mfma_f32_16x16x32_bf16(wh1, xh, acc1, 0, 0, 0);
                acc1 = __builtin_amdgcn_mfma_f32_16x16x32_bf16(wl1, xh, acc1, 0, 0, 0);
                acc1 = __builtin_amdgcn_mfma_f32_16x16x32_bf16(wh1, xl, acc1, 0, 0, 0);
            }
        }
        ssq += __shfl_xor(ssq, 16); ssq += __shfl_xor(ssq, 32);
        const float rstd = 1.0f / sqrtf(ssq * (1.0f / D) + RMS_EPS);
        if (q4 == 0) rstdp[tok] = rstd;
        if (KIND == 0) {
            if (q4 < 2) { const f32x4 bf = *(const f32x4*)(inp(F, I_b_fox_f) + l * 8 + 4 * q4); f32x4 lf;
#pragma unroll
                for (int i = 0; i < 4; ++i) { const float z = rstd * acc0[i] + bf[i]; lf[i] = fminf(z, 0.f) - log1pf(expf(-fabsf(z))); }
                *(f32x4*)((float*)(F.ws + WS_LOGF) + (size_t)tok * 8 + 4 * q4) = lf; }
        } else {
            const f32x4 b0 = *(const f32x4*)(inp(F, I_b_router) + l * NE + 4 * q4), b1v = *(const f32x4*)(inp(F, I_b_router) + l * NE + 16 + 4 * q4);
#pragma unroll
            for (int i = 0; i < 4; ++i) { lg[r16 * 33 + 4 * q4 + i] = rstd * acc0[i] + b0[i]; lg[r16 * 33 + 16 + 4 * q4 + i] = rstd * acc1[i] + b1v[i]; }
            LDS_WAIT(); asm volatile("" ::: "memory");
            float v0 = -INFINITY, v1 = -INFINITY, v2 = -INFINITY, v3 = -INFINITY; int i0 = 0, i1 = 0, i2 = 0, i3 = 0;
            if (lane < 16) {
                for (int e = 0; e < NE; ++e) { const float x = lg[lane * 33 + e];
                    if (x > v3) { if (x > v0) { v3 = v2; i3 = i2; v2 = v1; i2 = i1; v1 = v0; i1 = i0; v0 = x; i0 = e; }
                        else if (x > v1) { v3 = v2; i3 = i2; v2 = v1; i2 = i1; v1 = x; i1 = e; }
                        else if (x > v2) { v3 = v2; i3 = i2; v2 = x; i2 = e; }
                        else { v3 = x; i3 = e; } } }
            }
            __syncthreads();
            int rk0 = 0, rk1 = 0, rk2 = 0, rk3 = 0;
            if (lane < 16) { rk0 = __hip_atomic_fetch_add(&r2cnt[i0], 1, __ATOMIC_RELAXED, __HIP_MEMORY_SCOPE_WORKGROUP); rk1 = __hip_atomic_fetch_add(&r2cnt[i1], 1, __ATOMIC_RELAXED, __HIP_MEMORY_SCOPE_WORKGROUP); rk2 = __hip_atomic_fetch_add(&r2cnt[i2], 1, __ATOMIC_RELAXED, __HIP_MEMORY_SCOPE_WORKGROUP); rk3 = __hip_atomic_fetch_add(&r2cnt[i3], 1, __ATOMIC_RELAXED, __HIP_MEMORY_SCOPE_WORKGROUP); }
            __syncthreads();
            if (F.tid < 32) r2base[F.tid] = (int)atomicAdd(F.ctl + CW_CUR + (l * NE + F.tid) * 16, (unsigned)r2cnt[F.tid]);
            __syncthreads();
            if (lane < 16) {
                const float e1 = expf(v1 - v0), e2 = expf(v2 - v0), e3 = expf(v3 - v0), inv = 1.0f / (1.0f + e1 + e2 + e3);
                u32x2* list = (u32x2*)(F.ws + WS_LIST); float* gate = (float*)(F.ws + WS_GATE);
                const int tk = (task * 128 + F.wave * 16 + lane) * 4; const unsigned rb = __float_as_uint(__shfl(rstd, lane & 15));
                list[(size_t)i0 * LISTCAP + r2base[i0] + rk0] = (u32x2){(unsigned)(tk + 0), rb}; gate[tk + 0] = inv;
                list[(size_t)i1 * LISTCAP + r2base[i1] + rk1] = (u32x2){(unsigned)(tk + 1), rb}; gate[tk + 1] = e1 * inv;
                list[(size_t)i2 * LISTCAP + r2base[i2] + rk2] = (u32x2){(unsigned)(tk + 2), rb}; gate[tk + 2] = e2 * inv;
                list[(size_t)i3 * LISTCAP + r2base[i3] + rk3] = (u32x2){(unsigned)(tk + 3), rb}; gate[tk + 3] = e3 * inv;
            }
            __syncthreads();
        }
    }
}
__device__ __forceinline__ void r_final(const Frame& F) {
    const int lane = F.lane, r16 = lane & 15, q4 = lane >> 4;
    const bf16_t* Y = (const bf16_t*)(F.ws + WS_Y);
    for (int task = F.bid; task < T / 128; task += F.G) {
        const int tok = task * 128 + F.wave * 16 + r16;
        float* xr = F.out + (size_t)tok * D + 8 * q4; const bf16_t* yr = Y + (size_t)tok * 4 * D + 8 * q4;
        float ssq = 0.f;
#pragma unroll 2
        for (int ks = 0; ks < 32; ++ks) {
            f32x4 x0 = *(const f32x4*)(xr + 32 * ks), x1 = *(const f32x4*)(xr + 32 * ks + 4);
#pragma unroll
            for (int k = 0; k < 4; ++k) { const u32x4 y = *(const u32x4*)(yr + (size_t)k * D + 32 * ks);
                x0[0] += bflo(y.x); x0[1] += bfhi(y.x); x0[2] += bflo(y.y); x0[3] += bfhi(y.y); x1[0] += bflo(y.z); x1[1] += bfhi(y.z); x1[2] += bflo(y.w); x1[3] += bfhi(y.w); }
            ssq += (x0[0] * x0[0] + x0[1] * x0[1]) + (x0[2] * x0[2] + x0[3] * x0[3]) + (x1[0] * x1[0] + x1[1] * x1[1]) + (x1[2] * x1[2] + x1[3] * x1[3]);
        }
        ssq += __shfl_xor(ssq, 16); ssq += __shfl_xor(ssq, 32);
        const float rstd = 1.0f / sqrtf(ssq * (1.0f / D) + RMS_EPS);
#pragma unroll 2
        for (int ks = 0; ks < 32; ++ks) {
            f32x4 x0 = *(const f32x4*)(xr + 32 * ks), x1 = *(const f32x4*)(xr + 32 * ks + 4);
#pragma unroll
            for (int k = 0; k < 4; ++k) { const u32x4 y = *(const u32x4*)(yr + (size_t)k * D + 32 * ks);
                x0[0] += bflo(y.x); x0[1] += bfhi(y.x); x0[2] += bflo(y.y); x0[3] += bfhi(y.y); x1[0] += bflo(y.z); x1[1] += bfhi(y.z); x1[2] += bflo(y.w); x1[3] += bfhi(y.w); }
            const f32x4 g0 = *(const f32x4*)(inp(F, I_norm_final) + 32 * ks + 8 * q4), g1 = *(const f32x4*)(inp(F, I_norm_final) + 32 * ks + 8 * q4 + 4);
            *(f32x4*)(xr + 32 * ks) = x0 * rstd * g0; *(f32x4*)(xr + 32 * ks + 4) = x1 * rstd * g1;
        }
    }
}
__device__ __forceinline__ void cumsum_step(const Frame& F) {
    LAS float* sc = (LAS float*)(F.lds + LDSCTL_OFF + LC_SCAN);
    const float* LF = (const float*)(F.ws + WS_LOGF); float* c2 = (float*)(F.ws + WS_C2);
    for (int seq = F.bid; seq < 64; seq += F.G) {
        const int b = seq >> 3, h = seq & 7, t0 = F.tid * 8; const float* lf = LF + ((size_t)b * SEQ + t0) * 8 + h;
        float v[8], s = 0.f;
#pragma unroll
        for (int j = 0; j < 8; ++j) { s += lf[j * 8]; v[j] = s; }
        float inc = s;
#pragma unroll
        for (int off = 1; off < 64; off <<= 1) { const float y = __shfl_up(inc, off); if (F.lane >= off) inc += y; }
        if (F.lane == 63) sc[F.wave] = inc;
        __syncthreads();
        float pre = 0.f;
        for (int w = 0; w < F.wave; ++w) pre += sc[w];
        const float base = pre + inc - s;
#pragma unroll
        for (int j = 0; j < 8; ++j) c2[(size_t)seq * SEQ + t0 + j] = (base + v[j]) * LOG2E;
        __syncthreads();
    }
}

__device__ __forceinline__ int crow(int r, int hi) { return (r & 3) + 8 * (r >> 2) + 4 * hi; }
constexpr int AT_KT = 0, AT_KTB = 8320, AT_VT = 2 * AT_KTB, AT_VTB = 8192, AT_CK = AT_VT + 2 * AT_VTB, AT_WSF = AT_CK + 512, AT_OST = AT_WSF + 2048, AT_END = AT_OST + 65536;
static_assert(AT_END <= PH_BYTES, "attention LDS");
__device__ __forceinline__ void attn_unit(const Frame& F, int l, int b, int h, int qb) {
    const int tid = F.tid, lane = F.lane, r32 = lane & 31, hi = lane >> 5, wid = F.wave;
    const bf16_t* proj = (const bf16_t*)(F.ws + WS_PA); bf16_t* mixed = (bf16_t*)(F.ws + WS_MIXED);
    const int bh = b * 8 + h; const float* c2 = (const float*)(F.ws + WS_C2) + (size_t)bh * SEQ;
    const size_t rowbase = (size_t)b * SEQ; const int q0 = qb * 256;
    LAS unsigned char* L = F.lds;
    LAS float* wsf = (LAS float*)(L + AT_WSF) + wid * 64;
    LAS float* ost = (LAS float*)(L + AT_OST) + wid * 2048;
    volatile LAS int* stopf = (volatile LAS int*)(L + LDSCTL_OFF + LC_STOP);
    const bf16_t* Qw = proj + (rowbase + q0 + wid * 32 + r32) * NPROJ + C_FQ + h * 64;
    bf16x8 qr[4]; float qn = 0.f;
#pragma unroll
    for (int d0 = 0; d0 < 4; ++d0) { const u32x4 w = *(const u32x4*)(Qw + d0 * 16 + hi * 8); qr[d0] = __builtin_bit_cast(bf16x8, w);
        qn += bflo(w.x) * bflo(w.x) + bfhi(w.x) * bfhi(w.x) + bflo(w.y) * bflo(w.y) + bfhi(w.y) * bfhi(w.y) + bflo(w.z) * bflo(w.z) + bfhi(w.z) * bfhi(w.z) + bflo(w.w) * bflo(w.w) + bfhi(w.w) * bfhi(w.w); }
    qn += __shfl_xor(qn, 32); qn = sqrtf(qn) * 1.001f;
    const float kb = sqrtf(2.0f * __uint_as_float(__hip_atomic_load(F.ctl + CW_KMAX + (l * 64 + bh) * 16, __ATOMIC_RELAXED, __HIP_MEMORY_SCOPE_AGENT))) * 1.001f;
    const float c2q = c2[q0 + wid * 32 + r32];
    f32x16 cq16;
#pragma unroll
    for (int r = 0; r < 16; ++r) cq16[r] = c2q;
    float m = -INFINITY, lsum = 0.f; f32x16 o[2];
#pragma unroll
    for (int r = 0; r < 16; ++r) { o[0][r] = 0.f; o[1][r] = 0.f; }
    const int jd = 4 * qb + 3;
    const int lkey = tid >> 3, lpiece = tid & 7;
    const bf16_t* ksrc = proj + (rowbase + lkey) * NPROJ + C_FK + h * 64 + lpiece * 8;
    const bf16_t* vsrc = proj + (rowbase + lkey) * NPROJ + C_FV + h * 64 + lpiece * 8;
    const int kdst = lpiece * 1040 + lkey * 16, vdst = (lpiece >> 2) * 4096 + lkey * 64 + (lpiece & 3) * 16;
    u32x4 kreg = *(const u32x4*)(ksrc + (size_t)jd * 64 * NPROJ), vreg = *(const u32x4*)(vsrc + (size_t)jd * 64 * NPROJ);
    float ckreg = 0.f; if (tid < 64) ckreg = c2[jd * 64 + tid];
    const int vrd = (4 * hi + ((lane & 15) >> 2)) * 64 + ((lane >> 4) & 1) * 32 + (lane & 3) * 8;
    const int qrel = wid * 32 + r32;
    int buf = 0;
    for (int j = jd; j >= 0; --j) {
        *(LAS u32x4*)(L + AT_KT + buf * AT_KTB + kdst) = kreg; *(LAS u32x4*)(L + AT_VT + buf * AT_VTB + vdst) = vreg;
        if (tid < 64) ((LAS float*)(L + AT_CK))[buf * 64 + tid] = ckreg;
        __syncthreads();
        if (j < jd) { int all = 1;
#pragma unroll
            for (int w = 0; w < 8; ++w) all &= stopf[((j + 1) & 1) * 8 + w];
            if (all) break; }
        float cklast = 0.f;
        if (j > 0) { kreg = *(const u32x4*)(ksrc + (size_t)(j - 1) * 64 * NPROJ); vreg = *(const u32x4*)(vsrc + (size_t)(j - 1) * 64 * NPROJ); if (tid < 64) ckreg = c2[(j - 1) * 64 + tid]; cklast = c2[(j - 1) * 64 + 63]; }
        const int jrel = j - 4 * qb;
        const bool active = !(jrel >= 0 && 64 * jrel > 32 * wid + 31);
        if (active) {
            const LAS unsigned char* Kb = L + AT_KT + buf * AT_KTB; const LAS unsigned char* Vb = L + AT_VT + buf * AT_VTB; const LAS float* Ck = (const LAS float*)(L + AT_CK) + buf * 64;
            f32x16 p0 = cq16, p1 = cq16;
#pragma unroll
            for (int d0 = 0; d0 < 4; ++d0) {
                const bf16x8 k0 = *(const LAS bf16x8*)(Kb + (2 * d0 + hi) * 1040 + r32 * 16), k1 = *(const LAS bf16x8*)(Kb + (2 * d0 + hi) * 1040 + (32 + r32) * 16);
                p0 = __builtin_amdgcn_mfma_f32_32x32x16_bf16(k0, qr[d0], p0, 0, 0, 0); p1 = __builtin_amdgcn_mfma_f32_32x32x16_bf16(k1, qr[d0], p1, 0, 0, 0); }
#pragma unroll
            for (int g = 0; g < 4; ++g) { const f32x4 ca = *(const LAS f32x4*)(Ck + 8 * g + 4 * hi), cb = *(const LAS f32x4*)(Ck + 32 + 8 * g + 4 * hi);
#pragma unroll
                for (int i = 0; i < 4; ++i) { p0[4 * g + i] -= ca[i]; p1[4 * g + i] -= cb[i]; } }
            if (jrel >= 0) { const int kbase = 64 * jrel + 4 * hi;
#pragma unroll
                for (int r = 0; r < 16; ++r) { const int kv = kbase + (r & 3) + 8 * (r >> 2); if (kv > qrel) p0[r] = -INFINITY; if (kv + 32 > qrel) p1[r] = -INFINITY; } }
            float mx = fmaxf(p0[0], p1[0]);
#pragma unroll
            for (int r = 1; r < 16; ++r) mx = fmaxf(mx, fmaxf(p0[r], p1[r]));
            mx = fmaxf(mx, __shfl_xor(mx, 32));
            const float mnew = fmaxf(m, mx), alpha = __builtin_amdgcn_exp2f(m - mnew);
            float ls = 0.f;
#pragma unroll
            for (int r = 0; r < 16; ++r) { p0[r] = __builtin_amdgcn_exp2f(p0[r] - mnew); p1[r] = __builtin_amdgcn_exp2f(p1[r] - mnew); ls += p0[r] + p1[r]; }
            lsum = lsum * alpha + ls;
            if (__any(mnew > m)) {
                if (hi == 0) wsf[r32] = alpha;
                LDS_WAIT(); asm volatile("" ::: "memory");
#pragma unroll
                for (int r = 0; r < 16; ++r) { const float a = wsf[crow(r, hi)]; o[0][r] *= a; o[1][r] *= a; }
            }
            m = mnew;
            u32x4 pw[4];
            pw[0] = (u32x4){cvtpk(p0[0], p0[1]), cvtpk(p0[2], p0[3]), cvtpk(p0[4], p0[5]), cvtpk(p0[6], p0[7])};
            pw[1] = (u32x4){cvtpk(p0[8], p0[9]), cvtpk(p0[10], p0[11]), cvtpk(p0[12], p0[13]), cvtpk(p0[14], p0[15])};
            pw[2] = (u32x4){cvtpk(p1[0], p1[1]), cvtpk(p1[2], p1[3]), cvtpk(p1[4], p1[5]), cvtpk(p1[6], p1[7])};
            pw[3] = (u32x4){cvtpk(p1[8], p1[9]), cvtpk(p1[10], p1[11]), cvtpk(p1[12], p1[13]), cvtpk(p1[14], p1[15])};
#pragma unroll
            for (int s = 0; s < 4; ++s)
#pragma unroll
                for (int d0 = 0; d0 < 2; ++d0) {
                    const LAS unsigned char* vp = Vb + d0 * 4096 + s * 1024 + vrd;
                    const v4i16_t lo = __builtin_amdgcn_ds_read_tr16_b64_v4i16((LAS v4i16_t*)vp), hv = __builtin_amdgcn_ds_read_tr16_b64_v4i16((LAS v4i16_t*)(vp + 512));
                    const bf16x8 vf = (bf16x8){lo[0], lo[1], lo[2], lo[3], hv[0], hv[1], hv[2], hv[3]};
                    o[d0] = __builtin_amdgcn_mfma_f32_32x32x16_bf16(__builtin_bit_cast(bf16x8, pw[s]), vf, o[d0], 0, 0, 0); }
        }
        if (j > 0) { int st = 0; if (active) { const float ub = qn * kb + (c2q - cklast); st = __all((ub - m) < -152.0f) ? 1 : 0; } if (lane == 0) stopf[(j & 1) * 8 + wid] = st; }
        buf ^= 1;
    }
    lsum += __shfl_xor(lsum, 32);
    if (hi == 0) wsf[32 + r32] = 1.0f / lsum;
    LDS_WAIT(); asm volatile("" ::: "memory");
#pragma unroll
    for (int r = 0; r < 16; ++r) { const int q = crow(r, hi); const float inv = wsf[32 + q]; ost[q * 64 + r32] = o[0][r] * inv; ost[q * 64 + 32 + r32] = o[1][r] * inv; }
    LDS_WAIT(); asm volatile("" ::: "memory");
    { const int row = lane >> 1, half = lane & 1; const LAS float* src = ost + row * 64 + half * 32; float v[32]; float ss = 0.f;
#pragma unroll
        for (int i = 0; i < 8; ++i) { const f32x4 t4 = *(const LAS f32x4*)(src + 4 * i); v[4 * i] = t4[0]; v[4 * i + 1] = t4[1]; v[4 * i + 2] = t4[2]; v[4 * i + 3] = t4[3]; ss += (t4[0] * t4[0] + t4[1] * t4[1]) + (t4[2] * t4[2] + t4[3] * t4[3]); }
        ss += __shfl_xor(ss, 1);
        const float rs = 1.0f / sqrtf(ss * (1.0f / 64.0f) + RMS_EPS);
        const float* gn = inp(F, I_fox_gain) + l * 512 + h * 64 + half * 32;
        bf16_t* dst = mixed + (rowbase + q0 + wid * 32 + row) * D + h * 64 + half * 32;
#pragma unroll
        for (int i = 0; i < 4; ++i) { const f32x4 ga = *(const f32x4*)(gn + 8 * i), gb = *(const f32x4*)(gn + 8 * i + 4); u32x4 w;
            w.x = cvtpk(v[8 * i] * rs * ga[0], v[8 * i + 1] * rs * ga[1]); w.y = cvtpk(v[8 * i + 2] * rs * ga[2], v[8 * i + 3] * rs * ga[3]);
            w.z = cvtpk(v[8 * i + 4] * rs * gb[0], v[8 * i + 5] * rs * gb[1]); w.w = cvtpk(v[8 * i + 6] * rs * gb[2], v[8 * i + 7] * rs * gb[3]);
            *(u32x4*)(dst + 8 * i) = w; } }
    __syncthreads();
}

__device__ __forceinline__ float hg_lb(const Frame& F, int l, int col) {
    float x[NL], mx = -INFINITY;
#pragma unroll
    for (int i = 0; i < NL; ++i) { x[i] = inp(F, I_hgrn_lb)[i * 256 + col]; mx = fmaxf(mx, x[i]); }
    float s = 0.f, a = 0.f;
#pragma unroll
    for (int i = 0; i < NL; ++i) { x[i] = expf(x[i] - mx); s += x[i]; }
#pragma unroll
    for (int i = 1; i < NL; ++i) if (i <= l) a += x[i];
    return a / s;
}
__device__ __forceinline__ void hg_naive_unit(const Frame& F, int l, int u) {
    const int bh = u >> 2, ks = u & 3, b = bh >> 2, hd = bh & 3, lane = F.lane;
    const bf16_t* proj = (const bf16_t*)(F.ws + WS_PA) + (size_t)b * SEQ * NPROJ;
    float* oraw = (float*)(F.ws + WS_ORAW) + (size_t)ks * T * 256 + (size_t)b * SEQ * 256 + hd * 64 + lane;
    const float lbv = hg_lb(F, l, hd * 64 + ks * 16 + (lane & 15));
    float S[16];
#pragma unroll
    for (int j = 0; j < 16; ++j) S[j] = 0.f;
    for (int t0 = 0; t0 < SEQ; t0 += 4) {
        float fl[4], qv[4], vin[4];
#pragma unroll
        for (int i = 0; i < 4; ++i) { const bf16_t* row = proj + (size_t)(t0 + i) * NPROJ;
            fl[i] = bf2f(row[C_GF + hd * 64 + ks * 16 + (lane & 15)]); qv[i] = bf2f(row[C_GQ + hd * 64 + ks * 16 + (lane & 15)]); vin[i] = bf2f(row[C_GI + hd * 64 + lane]); }
#pragma unroll
        for (int i = 0; i < 4; ++i) {
            const float sg = 1.0f / (1.0f + expf(-fl[i])), f = lbv + (1.0f - lbv) * sg, kk = (1.0f - lbv) * (1.0f - sg);
            float o = 0.f;
#pragma unroll
            for (int j = 0; j < 16; ++j) { const float fj = rdlane(f, j), kj = rdlane(kk, j), qj = rdlane(qv[i], j); S[j] = fj * S[j] + kj * vin[i]; o += qj * S[j]; }
            oraw[(size_t)(t0 + i) * 256] = o;
        }
    }
}
__device__ __forceinline__ void hg_fix_phase(const Frame& F, int l) {
    const int gw = F.bid * NWAVES + F.wave, NGW = F.G * NWAVES, lane = F.lane;
    const float* oraw = (const float*)(F.ws + WS_ORAW); const bf16_t* proj = (const bf16_t*)(F.ws + WS_PA); bf16_t* mixed = (bf16_t*)(F.ws + WS_MIXED);
    const f32x4 gn = *(const f32x4*)(inp(F, I_hgrn_gain) + l * 256 + 4 * lane);
    for (int tok = gw; tok < T; tok += NGW) {
        f32x4 o = *(const f32x4*)(oraw + (size_t)tok * 256 + 4 * lane);
#pragma unroll
        for (int k = 1; k < 4; ++k) o += *(const f32x4*)(oraw + (size_t)k * T * 256 + (size_t)tok * 256 + 4 * lane);
        float ss = (o[0] * o[0] + o[1] * o[1]) + (o[2] * o[2] + o[3] * o[3]);
        ss += __shfl_xor(ss, 1); ss += __shfl_xor(ss, 2); ss += __shfl_xor(ss, 4); ss += __shfl_xor(ss, 8);
        const float rs = 1.0f / sqrtf(ss * (1.0f / 64.0f) + RMS_EPS);
        const u32x2 gw2 = *(const u32x2*)(proj + (size_t)tok * NPROJ + C_GG + 4 * lane);
        const float g[4] = {bflo(gw2.x), bfhi(gw2.x), bflo(gw2.y), bfhi(gw2.y)}; float r[4];
#pragma unroll
        for (int i = 0; i < 4; ++i) { const float si = g[i] / (1.0f + expf(-g[i])); r[i] = o[i] * rs * gn[i] * si; }
        *(u32x2*)(mixed + (size_t)tok * D + 512 + 4 * lane) = (u32x2){cvtpk(r[0], r[1]), cvtpk(r[2], r[3])};
    }
}
__device__ __forceinline__ void pool_unit(const Frame& F, int l, int u) {
    const int seg = u & 63, g = (u >> 6) & 3, b = u >> 8, lane = F.lane;
    const int w = 2 << g;
    const bf16_t* up = (const bf16_t*)(F.ws + WS_PA) + (size_t)b * SEQ * NPROJ + C_PU + g * 64 + lane;
    bf16_t* mixed = (bf16_t*)(F.ws + WS_MIXED) + (size_t)b * SEQ * D + 768 + g * 64 + lane;
    float wcol[64];
#pragma unroll
    for (int c = 0; c < 64; ++c) wcol[c] = inp(F, I_pool_w)[(((size_t)l * 4 + g) * 64 + c) * 64 + lane];
    const float psc = inp(F, I_pool_scale)[l * 256 + g * 64 + lane];
    const int t0 = seg * 64; float wsum = 0.f;
    for (int i = 1; i <= w; ++i) { const int t = t0 - i; if (t >= 0) wsum += bf2f(up[(size_t)t * NPROJ]); }
    for (int i = 0; i < 64; ++i) { const int t = t0 + i; const float ut = bf2f(up[(size_t)t * NPROJ]);
        wsum += ut; if (t - w >= 0) wsum -= bf2f(up[(size_t)(t - w) * NPROJ]);
        const float pooled = wsum / (float)((t + 1 < w) ? (t + 1) : w) - ut; float acc = 0.f;
#pragma unroll
        for (int c = 0; c < 64; ++c) acc += rdlane(pooled, c) * wcol[c];
        mixed[(size_t)t * D] = f2bf(acc * psc); }
}

struct Args { const float* in[18]; float* out; unsigned char* ws; int ph_lo, ph_hi; };
constexpr int N_PHASES = 2 + 8 * NL;

__global__ void __launch_bounds__(NTHREADS, 2) trunk_fwd(Args args) {
    extern __shared__ __attribute__((aligned(16))) unsigned char lds_raw[];
    Frame F;
    F.lds = (LAS unsigned char*)lds_raw; F.ws = args.ws; F.ctl = (unsigned*)(args.ws + WS_CTL); F.out = args.out;
    F.tid = threadIdx.x; F.lane = F.tid & 63; F.wave = __builtin_amdgcn_readfirstlane(F.tid >> 6);
    for (int u = F.tid; u < (LDS_BYTES - LDSCTL_OFF) / 4; u += NTHREADS) ((LAS unsigned*)(F.lds + LDSCTL_OFF))[u] = 0u;
    __syncthreads();
    if (F.tid == 0) {
#pragma unroll
        for (int i = 0; i < 18; ++i) ((LAS unsigned long long*)(F.lds + LDSCTL_OFF + LC_INP))[i] = (unsigned long long)args.in[i];
    }
    __syncthreads();
    const int lo = args.ph_lo, hi = args.ph_hi; const bool use_bar = (hi - lo) > 1;
    XcdBarrier bar; bar.bar = F.ctl + CW_BAR; bar.x = 0; bar.st = nullptr;
    if (use_bar) bar = xcd_barrier_post(F.ctl + CW_BAR, (volatile LAS unsigned*)(F.lds + LDSCTL_OFF + LC_BAR));
#ifndef PHMASK
#define PHMASK 0xFFFF
#endif
#define PM(b) ((PHMASK >> (b)) & 1)
#define FRESH() do { int l_ = (int)__builtin_amdgcn_mbcnt_hi(~0u, __builtin_amdgcn_mbcnt_lo(~0u, 0u)); asm volatile("" : "+v"(l_)); F.lane = l_; F.tid = F.wave * 64 + l_; int b_ = blockIdx.x, g_ = gridDim.x; asm volatile("" : "+s"(b_), "+s"(g_)); F.bid = b_; F.G = g_; } while (0)
#define IN(k) (lo <= (k) && (k) < hi)
#define SEAM(k) do { if (use_bar && (k) + 1 < hi) xcd_barrier(bar, F.tid == 0); } while (0)
    if (IN(0) && PM(0)) { FRESH(); p0_prologue(F); SEAM(0); }
    for (int l = 0; l < NL; ++l) {
        const int pb = 1 + 8 * l;
        if (IN(pb + 0) && PM(1)) { FRESH(); if (l == 0) r_phase<0, false, false>(F, l, inp(F, I_x), F.out); else r_phase<0, true, true>(F, l, F.out, F.out); SEAM(pb + 0); }
        if (IN(pb + 1) && PM(2)) { FRESH();
            cumsum_step(F);
            pg8::StaticOrder S; S.init(T, NPROJ, D, F.G, F.bid, (const bf16_t*)(F.ws + WS_WIN + l * WIN_BYTES));
            pg8::EpiProj E{(bf16_t*)(F.ws + WS_PA), (const float*)(F.ws + WS_RSTD1), F.ctl + CW_KMAX + l * 64 * 16};
            pg8::gemm_phase<pg8::EpiProj, pg8::StaticOrder, true>(F.tid, F.lds, (const bf16_t*)(F.ws + WS_HB), D, S, E);
            SEAM(pb + 1);
        }
        if (IN(pb + 2) && PM(3)) { FRESH();
            const int gw = F.bid * NWAVES + F.wave, NGW = F.G * NWAVES;
            for (int u = gw; u < 128; u += NGW) hg_naive_unit(F, l, u);
            for (int u = gw; u < 2048; u += NGW) pool_unit(F, l, u);
            __syncthreads();
            for (int u = F.bid; u < 1024; u += F.G) { const int c = u & 255, i = u >> 8, bh = c >> 2, s = c & 3, qb = (i == 0) ? s : (i == 1) ? 7 - s : (i == 2) ? 8 + s : 15 - s;
                attn_unit(F, l, bh >> 3, bh & 7, qb); }
            SEAM(pb + 2);
        }
        if (IN(pb + 3) && PM(4)) { FRESH(); hg_fix_phase(F, l); SEAM(pb + 3); }
        if (IN(pb + 4) && PM(5)) { FRESH();
            pg8::StaticOrder S; S.init(T, D, D, F.G, F.bid, (const bf16_t*)(F.ws + WS_WOUT + l * WOUT_BYTES));
            pg8::EpiOut E{l == 0 ? inp(F, I_x) : F.out, F.out};
            pg8::gemm_phase<pg8::EpiOut, pg8::StaticOrder, true>(F.tid, F.lds, (const bf16_t*)(F.ws + WS_MIXED), D, S, E);
            SEAM(pb + 4);
        }
        if (IN(pb + 5) && PM(6)) { FRESH(); r_phase<1, false, false>(F, l, F.out, F.out); SEAM(pb + 5); }
        if ((IN(pb + 6) && PM(7)) || (IN(pb + 7) && PM(8))) { FRESH();
            LAS int* tb = (LAS int*)(F.lds + LDSCTL_OFF + LC_TB); LAS int* cn = (LAS int*)(F.lds + LDSCTL_OFF + LC_CN);
            if (F.tid < NE) cn[F.tid] = (int)__hip_atomic_load(F.ctl + CW_CUR + (l * NE + F.tid) * 16, __ATOMIC_RELAXED, __HIP_MEMORY_SCOPE_AGENT);
            __syncthreads();
            if (F.tid == 0) { int a = 0; for (int e = 0; e < NE; ++e) { tb[e] = a; a += (cn[e] + 255) >> 8; } tb[NE] = a; }
            __syncthreads();
            const int ntile = tb[NE];
            if (IN(pb + 6) && PM(7)) {
                pg8::MoeOrder<true> S; S.nM = ntile; S.nN = 2 * FF / 256; S.nwg = S.nM * S.nN; S.G = F.G; S.c = F.bid; S.Wt = (const char*)(F.ws + WS_W1 + (size_t)l * NE * W1E_BYTES); S.estride = W1E_BYTES; S.tstep = (size_t)256 * D * 2;
                S.tb = tb; S.cn = cn; S.list = (const u32x2*)(F.ws + WS_LIST);
                pg8::EpiGlu E{(bf16_t*)(F.ws + WS_PA), (const u32x2*)(F.ws + WS_LIST), (const float*)(F.ws + WS_B1R) + (size_t)l * NE * 2048};
                pg8::gemm_phase<pg8::EpiGlu, pg8::MoeOrder<true>, true>(F.tid, F.lds, (const bf16_t*)(F.ws + WS_HB), D, S, E);
                SEAM(pb + 6);
            }
            if (IN(pb + 7) && PM(8)) { FRESH();
                pg8::MoeOrder<false> S; S.nM = ntile; S.nN = D / 256; S.nwg = S.nM * S.nN; S.G = F.G; S.c = F.bid; S.Wt = (const char*)(F.ws + WS_W2 + (size_t)l * NE * W2E_BYTES); S.estride = W2E_BYTES; S.tstep = (size_t)256 * FF * 2;
                S.tb = tb; S.cn = cn; S.list = (const u32x2*)(F.ws + WS_LIST);
                pg8::EpiDown E{(bf16_t*)(F.ws + WS_Y), (const u32x2*)(F.ws + WS_LIST), (const float*)(F.ws + WS_GATE), inp(F, I_b2) + (size_t)l * NE * D};
                pg8::gemm_phase<pg8::EpiDown, pg8::MoeOrder<false>, true>(F.tid, F.lds, (const bf16_t*)(F.ws + WS_PA), FF, S, E);
                SEAM(pb + 7);
            }
        }
    }
    if (IN(N_PHASES - 1) && PM(9)) { FRESH(); r_final(F); }
#undef IN
#undef SEAM
}

extern "C" void kernel_launch(void* const* d_in, const int* in_sizes, int n_in, void* d_out, int out_size, void* d_ws, size_t ws_size, hipStream_t stream) {
    static int grid = 0;
    if (grid == 0) {
        if (n_in != 18 || out_size != T * D || ws_size < WS_END) { fprintf(stderr, "kernel_launch: unexpected shapes (n_in %d out %d ws %zu need %zu)\n", n_in, out_size, ws_size, (size_t)WS_END); grid = -1; return; }
        int dev = 0, cus = 0;
        if (hipGetDevice(&dev) != hipSuccess || hipDeviceGetAttribute(&cus, hipDeviceAttributeMultiprocessorCount, dev) != hipSuccess) { grid = -1; return; }
        if (hipFuncSetAttribute((const void*)trunk_fwd, hipFuncAttributeMaxDynamicSharedMemorySize, LDS_BYTES) != hipSuccess) { fprintf(stderr, "kernel_launch: hipFuncSetAttribute failed\n"); grid = -1; return; }
        int per_cu = 0;
        if (hipOccupancyMaxActiveBlocksPerMultiprocessor(&per_cu, (const void*)trunk_fwd, NTHREADS, LDS_BYTES) != hipSuccess || per_cu < 1) { fprintf(stderr, "kernel_launch: occupancy query says %d\n", per_cu); (void)hipGetLastError(); }
        grid = cus;
    }
    if (grid < 0) return;
    (void)hipMemsetAsync((char*)d_ws + WS_CTL, 0, CTL_ZERO_BYTES, stream);
    Args a{};
    for (int i = 0; i < 18; ++i) a.in[i] = (const float*)d_in[i];
    a.out = (float*)d_out; a.ws = (unsigned char*)d_ws;
#if MK_SPLIT
    for (int p = 0; p < N_PHASES; ++p) { a.ph_lo = p; a.ph_hi = p + 1; hipLaunchKernelGGL(trunk_fwd, dim3(grid), dim3(NTHREADS), LDS_BYTES, stream, a); }
#else
    a.ph_lo = 0; a.ph_hi = N_PHASES; hipLaunchKernelGGL(trunk_fwd, dim3(grid), dim3(NTHREADS), LDS_BYTES, stream, a);
#endif
}
```

```cpp
#include <hip/hip_runtime.h>
#include <cstdio>
#include <cstdint>

#ifndef MK_SPLIT
#define MK_SPLIT 0
#endif

#define LAS __attribute__((address_space(3)))
#define GAS __attribute__((address_space(1)))
typedef unsigned short bf16_t;
typedef short bf16x8 __attribute__((ext_vector_type(8)));
typedef float f32x4 __attribute__((ext_vector_type(4)));
typedef float f32x2 __attribute__((ext_vector_type(2)));
typedef float f32x16 __attribute__((ext_vector_type(16)));
typedef unsigned u32x4 __attribute__((ext_vector_type(4)));
typedef unsigned u32x2 __attribute__((ext_vector_type(2)));
typedef __bf16 bf16x2_t __attribute__((ext_vector_type(2)));
typedef short v4i16_t __attribute__((ext_vector_type(4)));

constexpr int NB = 8, SEQ = 4096, T = NB * SEQ, D = 1024, NL = 4;
constexpr int NPROJ = 2816;
constexpr int C_FQ = 0, C_FK = 512, C_FV = 1024, C_GQ = 1536, C_GF = 1792, C_GI = 2048, C_GG = 2304, C_PU = 2560;
constexpr int IN_COLS = 2824;
constexpr int NE = 32, TOPK = 4, FF = 1024, MROWS = T * TOPK, LISTCAP = MROWS, MAXTILES = MROWS / 256 + NE;
constexpr float RMS_EPS = 1e-5f, LOG2E = 1.4426950408889634f;
constexpr float QSCALE = 0.125f * LOG2E;
constexpr int NWAVES = 8, NTHREADS = 512;

constexpr size_t MiB = 1u << 20;
constexpr size_t WS_CTL = 0, CTL_ZERO_BYTES = 1 * MiB;
constexpr size_t WS_RSTD1 = 1 * MiB, WS_RSTD2 = WS_RSTD1 + 128 * 1024;
constexpr size_t WS_LOGF = 2 * MiB, WS_C2 = 3 * MiB, WS_GATE = 4 * MiB, WS_B1R = 5 * MiB, WS_WFRAG = 6 * MiB, WS_LIST = 8 * MiB;
constexpr size_t WS_WIN = 40 * MiB, WIN_BYTES = (size_t)NPROJ * D * 2;
constexpr size_t WS_WOUT = 62 * MiB, WOUT_BYTES = (size_t)D * D * 2;
constexpr size_t WS_W1 = 70 * MiB, W1E_BYTES = (size_t)2 * FF * D * 2;
constexpr size_t WS_W2 = 582 * MiB, W2E_BYTES = (size_t)D * FF * 2;
constexpr size_t WS_HB = 838 * MiB;
constexpr size_t WS_PA = 902 * MiB;
constexpr size_t WS_MIXED = WS_PA + 176 * MiB;
constexpr size_t WS_Y = 1174 * MiB;
constexpr size_t WS_ORAW = 1430 * MiB;
constexpr size_t WS_SEND = 1558 * MiB;
constexpr size_t WS_PSEG = 1566 * MiB;
constexpr size_t WS_QE = 1567 * MiB;
constexpr size_t WS_END = 1583 * MiB;
static_assert(WS_WIN + NL * WIN_BYTES <= WS_WOUT && WS_WOUT + NL * WOUT_BYTES <= WS_W1 && WS_W1 + (size_t)NL * NE * W1E_BYTES <= WS_W2 && WS_W2 + (size_t)NL * NE * W2E_BYTES <= WS_HB, "ws map");
static_assert((size_t)MAXTILES * 256 * FF * 2 <= 272 * MiB && (size_t)T * NPROJ * 2 <= 176 * MiB, "ws map 2");
constexpr int CW_TMO = 0, CW_BAR = 4096, CW_CUR = 16384, CW_KMAX = 32768;
constexpr int PH_BYTES = 139264, LDSCTL_OFF = PH_BYTES, LDS_BYTES = PH_BYTES + 2048;
constexpr int LC_BAR = 0, LC_TB = 64, LC_CN = 256, LC_R2CNT = 512, LC_R2BASE = 640, LC_STOP = 768, LC_SCAN = 896, LC_INP = 1024;

__device__ __forceinline__ unsigned cvtpk(float lo, float hi) { f32x2 v = {lo, hi}; bf16x2_t b = __builtin_convertvector(v, bf16x2_t); return __builtin_bit_cast(unsigned, b); }
__device__ __forceinline__ float bflo(unsigned w) { return __uint_as_float(w << 16); }
__device__ __forceinline__ float bfhi(unsigned w) { return __uint_as_float(w & 0xffff0000u); }
__device__ __forceinline__ float bf2f(bf16_t h) { return __uint_as_float((unsigned)h << 16); }
__device__ __forceinline__ bf16_t f2bf(float f) { return (bf16_t)(cvtpk(f, 0.f) & 0xffffu); }
__device__ __forceinline__ float rdlane(float v, int l) { return __uint_as_float((unsigned)__builtin_amdgcn_readlane((int)__float_as_uint(v), l)); }
#define LDS_WAIT() asm volatile("s_waitcnt lgkmcnt(0)" ::: "memory")
#define VM_WAIT() asm volatile("s_waitcnt vmcnt(0)" ::: "memory")

namespace pg8 {
constexpr int BM = 256, BK = 64, HALF = 128, HTB = HALF * BK * 2, STAGE_BYTES = 8 * HTB, NXCD = 8, WGM = 8;
__host__ __device__ __forceinline__ int lds_byte(int r, int c) { const int st = (r >> 4) * 2 + (c >> 5), rr = r & 15, cc = c & 31, ob = rr * 64 + cc * 2; return st * 1024 + (ob ^ (((ob >> 9) & 1) << 5)); }
__host__ __device__ __forceinline__ void stage_rc(int b, int& R, int& C) { const int st = b / 1024, sb = b % 1024, swz = sb ^ (((sb >> 9) & 1) << 5); R = (st >> 1) * 16 + swz / 64; C = (st & 1) * 32 + (swz % 64) / 2; }
__host__ __device__ __forceinline__ int perm32(int rho) { const int n = rho >> 4, i = rho & 15; return 8 * (i >> 2) + 4 * n + (i & 3); }

struct Unit { int pm, pn, e, lt, cnt; };

__device__ __forceinline__ void tile_of(int L, int nM, int nN, int& pm, int& pn) {
    const int nwg = nM * nN; int wgid = L;
    { const int q = nwg / NXCD, r = nwg % NXCD, xcd = wgid % NXCD, off = wgid / NXCD; wgid = (xcd < r ? xcd * (q + 1) : r * (q + 1) + (xcd - r) * q) + off; }
    const int nig = WGM * nN, gid = wgid / nig, fm = gid * WGM, gsz = (nM - fm) < WGM ? (nM - fm) : WGM;
    pm = fm + ((wgid % nig) % gsz); pn = (wgid % nig) / gsz;
}
struct StaticOrder {
    int nM, nN, nwg, G, c; const char* Bt; size_t tstep;
    __device__ void init(int M, int N, int K, int G_, int c_, const bf16_t* Bt_) { nM = M / BM; nN = N / BM; nwg = nM * nN; G = G_; c = c_; Bt = (const char*)Bt_; tstep = (size_t)BM * K * 2; }
    __device__ __forceinline__ bool next(int i, Unit& u) const { const long L = (long)i * G + c; if (L >= nwg) return false; tile_of((int)L, nM, nN, u.pm, u.pn); u.e = 0; u.lt = 0; u.cnt = 0; return true; }
    __device__ __forceinline__ const char* bbase(const Unit& u) const { return Bt + (size_t)u.pn * tstep; }
    __device__ __forceinline__ int arow(const Unit& u, int r) const { return u.pm * BM + r; }
};
template <bool GATHER> struct MoeOrder {
    int nM, nN, nwg, G, c; const char* Wt; size_t estride, tstep; LAS const int* tb; LAS const int* cn; const u32x2* list;
    __device__ __forceinline__ bool next(int i, Unit& u) const {
        const long L = (long)i * G + c; if (L >= nwg) return false; tile_of((int)L, nM, nN, u.pm, u.pn);
        int e = 0; while (e < NE - 1 && tb[e + 1] <= u.pm) ++e;
        u.e = e; u.lt = u.pm - tb[e]; u.cnt = cn[e]; return true; }
    __device__ __forceinline__ const char* bbase(const Unit& u) const { return Wt + (size_t)u.e * estride + (size_t)u.pn * tstep; }
    __device__ __forceinline__ int arow(const Unit& u, int r) const {
        if (!GATHER) return u.pm * BM + r;
        const int pos = u.lt * BM + r; return pos < u.cnt ? (int)(list[(size_t)u.e * LISTCAP + pos].x >> 2) : 0; }
};

template <class Epi, class Sched, bool ALIGN_EPI>
__device__ __forceinline__ void gemm_phase(const int tid, LAS unsigned char* lds, const bf16_t* Abase, const int K, const Sched& S, const Epi& E) {
    const int wid = __builtin_amdgcn_readfirstlane(tid >> 6), lane = tid & 63, wr = wid >> 2, wc = wid & 3, fr = lane & 15, fq = lane >> 4;
    const int nt = K / BK;
    unsigned voffB[2];
#pragma unroll
    for (int i = 0; i < 2; ++i) { int R, C; stage_rc(tid * 16 + i * 8192, R, C); const int Rb = Epi::PERM ? ((R & ~31) + perm32(R & 31)) : R; voffB[i] = (unsigned)(Rb * K + C) * 2u; }
    const size_t kstep = (size_t)(BK * 2);
    const size_t hstep = (size_t)HALF * K * 2;
    const unsigned ldsw = (unsigned)wid * 1024u;
    const int aoff = lds_byte(wr * 64 + fr, fq * 8), boff = lds_byte(wc * 32 + fr, fq * 8);
    const char* A8 = (const char*)Abase;
#define PG8_SA(b, h) (((b) * 2 + (h)) * HTB)
#define PG8_SB(b, h) ((4 + (b) * 2 + (h)) * HTB)
#define PG8_STGB(bufoff, gbase) do { _Pragma("unroll") for (int _i = 0; _i < 2; ++_i) \
        __builtin_amdgcn_global_load_lds((const unsigned*)((const char*)(gbase) + voffB[_i]), (LAS unsigned*)(lds + (bufoff) + ldsw + _i * 8192), 16, 0, 0); } while (0)
#define PG8_STGA(bufoff, kb, o0, o1) do { \
        __builtin_amdgcn_global_load_lds((const unsigned*)(A8 + (size_t)(kb) + (o0)), (LAS unsigned*)(lds + (bufoff) + ldsw), 16, 0, 0); \
        __builtin_amdgcn_global_load_lds((const unsigned*)(A8 + (size_t)(kb) + (o1)), (LAS unsigned*)(lds + (bufoff) + ldsw + 8192), 16, 0, 0); } while (0)
#define PG8_LDA(dst, b, h) do { _Pragma("unroll") for (int m = 0; m < 4; ++m) _Pragma("unroll") for (int k = 0; k < 2; ++k) dst[m][k] = *(const LAS bf16x8*)(lds + PG8_SA(b, h) + aoff + m * 2048 + k * 1024); } while (0)
#define PG8_LDB(dst, b, h) do { _Pragma("unroll") for (int n = 0; n < 2; ++n) _Pragma("unroll") for (int k = 0; k < 2; ++k) dst[n][k] = *(const LAS bf16x8*)(lds + PG8_SB(b, h) + boff + n * 2048 + k * 1024); } while (0)
#define PG8_MMA(ai, bj, At, Bt) do { __builtin_amdgcn_s_setprio(1); _Pragma("unroll") for (int m = 0; m < 4; ++m) _Pragma("unroll") for (int n = 0; n < 2; ++n) _Pragma("unroll") for (int k = 0; k < 2; ++k) \
        acc[ai][bj][m][n] = __builtin_amdgcn_mfma_f32_16x16x32_bf16(Bt[n][k], At[m][k], acc[ai][bj][m][n], 0, 0, 0); __builtin_amdgcn_s_setprio(0); } while (0)
#define PG8_WAIT_V(n) asm volatile("s_waitcnt vmcnt(" #n ")" ::: "memory")
#define PG8_WAIT_L(n) asm volatile("s_waitcnt lgkmcnt(" #n ")" ::: "memory")
#define PG8_BAR __builtin_amdgcn_s_barrier()
#define PG8_SCHED __builtin_amdgcn_sched_barrier(0)
#define PG8_AOFF(u, dst) do { _Pragma("unroll") for (int _h = 0; _h < 2; ++_h) _Pragma("unroll") for (int _i = 0; _i < 2; ++_i) \
        { int R_, C_; stage_rc(tid * 16 + _i * 8192, R_, C_); dst[_h][_i] = (unsigned)((size_t)S.arow(u, _h * HALF + R_) * (size_t)K + (size_t)C_) * 2u; } } while (0)
    Unit cur, nxt; int ui = 0;
    if (!S.next(0, cur)) return;
    f32x4 acc[2][2][4][2];
#pragma unroll
    for (int a = 0; a < 2; ++a)
#pragma unroll
        for (int b = 0; b < 2; ++b)
#pragma unroll
            for (int m = 0; m < 4; ++m)
#pragma unroll
                for (int n = 0; n < 2; ++n) acc[a][b][m][n] = (f32x4){0.f, 0.f, 0.f, 0.f};
    bf16x8 At[4][2], B0[2][2], B1[2][2];
    unsigned aoC[2][2], aoN[2][2];
    PG8_AOFF(cur, aoC);
    const char* cB = S.bbase(cur);
    PG8_STGB(PG8_SB(0, 0), cB); PG8_STGB(PG8_SB(0, 1), cB + hstep); PG8_STGA(PG8_SA(0, 0), 0, aoC[0][0], aoC[0][1]); PG8_STGA(PG8_SA(0, 1), 0, aoC[1][0], aoC[1][1]);
    if (wr == 1) PG8_BAR;
    PG8_WAIT_V(2); PG8_BAR;
    PG8_STGB(PG8_SB(1, 0), cB + kstep); PG8_STGA(PG8_SA(1, 0), kstep, aoC[0][0], aoC[0][1]); PG8_STGB(PG8_SB(1, 1), cB + hstep + kstep);
    PG8_WAIT_V(6); PG8_BAR;
    for (;;) {
        const bool has_next = S.next(ui + 1, nxt);
        if (has_next) { PG8_AOFF(nxt, aoN); } else { aoN[0][0] = aoC[0][0]; aoN[0][1] = aoC[0][1]; aoN[1][0] = aoC[1][0]; aoN[1][1] = aoC[1][1]; }
        const char* nB = has_next ? S.bbase(nxt) : cB;
        for (int t = 0; t < nt; t += 2) {
            const bool last = (t == nt - 2);
            const size_t k1 = (size_t)(t + 1) * kstep, k2 = last ? 0 : (size_t)(t + 2) * kstep, k3 = k2 + kstep;
            const char* b2 = last ? nB : cB + (size_t)(t + 2) * kstep; const char* b3 = b2 + kstep;
            const unsigned a200 = last ? aoN[0][0] : aoC[0][0], a201 = last ? aoN[0][1] : aoC[0][1], a210 = last ? aoN[1][0] : aoC[1][0], a211 = last ? aoN[1][1] : aoC[1][1];
            PG8_LDB(B0, 0, 0); PG8_LDB(B1, 0, 1); PG8_SCHED; PG8_LDA(At, 0, 0); PG8_STGA(PG8_SA(1, 1), k1, aoC[1][0], aoC[1][1]);
            PG8_WAIT_V(8); PG8_WAIT_L(0); PG8_BAR; PG8_MMA(0, 0, At, B0); PG8_MMA(0, 1, At, B1); PG8_BAR; PG8_SCHED;
            PG8_LDA(At, 0, 1); PG8_STGB(PG8_SB(0, 0), b2); PG8_STGB(PG8_SB(0, 1), b2 + hstep); PG8_STGA(PG8_SA(0, 0), k2, a200, a201);
            PG8_WAIT_V(8); PG8_WAIT_L(0); PG8_BAR; PG8_MMA(1, 0, At, B0); PG8_MMA(1, 1, At, B1); PG8_BAR; PG8_SCHED;
            PG8_LDB(B0, 1, 0); PG8_LDB(B1, 1, 1); PG8_SCHED; PG8_LDA(At, 1, 0); PG8_STGA(PG8_SA(0, 1), k2, a210, a211);
            PG8_WAIT_V(8); PG8_WAIT_L(0); PG8_BAR; PG8_MMA(0, 0, At, B0); PG8_MMA(0, 1, At, B1); PG8_BAR; PG8_SCHED;
            PG8_LDA(At, 1, 1); PG8_STGB(PG8_SB(1, 0), b3); PG8_STGB(PG8_SB(1, 1), b3 + hstep); PG8_STGA(PG8_SA(1, 0), k3, a200, a201);
            PG8_WAIT_V(8); PG8_WAIT_L(0); PG8_BAR; PG8_MMA(1, 0, At, B0); PG8_MMA(1, 1, At, B1); PG8_BAR; PG8_SCHED;
        }
        if constexpr (ALIGN_EPI) { if (wr == 0) PG8_BAR; }
        E(acc, cur, wr, wc, fr, fq);
        if (!has_next) break;
#pragma unroll
        for (int a = 0; a < 2; ++a)
#pragma unroll
            for (int b = 0; b < 2; ++b)
#pragma unroll
                for (int m = 0; m < 4; ++m)
#pragma unroll
                    for (int n = 0; n < 2; ++n) acc[a][b][m][n] = (f32x4){0.f, 0.f, 0.f, 0.f};
        cur = nxt; cB = nB; ++ui;
        aoC[0][0] = aoN[0][0]; aoC[0][1] = aoN[0][1]; aoC[1][0] = aoN[1][0]; aoC[1][1] = aoN[1][1];
        if constexpr (ALIGN_EPI) { if (wr == 1) PG8_BAR; }
    }
    PG8_WAIT_V(0);
    if constexpr (!ALIGN_EPI) { if (wr == 0) PG8_BAR; }
    PG8_BAR;
#undef PG8_SA
#undef PG8_SB
#undef PG8_STGA
#undef PG8_STGB
#undef PG8_LDA
#undef PG8_LDB
#undef PG8_MMA
#undef PG8_WAIT_V
#undef PG8_WAIT_L
#undef PG8_BAR
#undef PG8_SCHED
#undef PG8_AOFF
}

struct EpiProj {
    static constexpr bool PERM = true;
    bf16_t* O; const float* rstd; unsigned* kmax;
    __device__ __forceinline__ void operator()(const f32x4 (&acc)[2][2][4][2], const Unit& u, int wr, int wc, int fr, int fq) const {
        const int row0 = u.pm * BM + wr * 64 + fr, col0 = u.pn * BM + wc * 32 + 8 * fq;
        const float sc = (u.pn < 2) ? QSCALE : 1.f; const bool isk = (u.pn == 2 || u.pn == 3);
        float km[2] = {0.f, 0.f};
#pragma unroll
        for (int ai = 0; ai < 2; ++ai)
#pragma unroll
            for (int m = 0; m < 4; ++m) { const int row = row0 + ai * HALF + m * 16; const float rs = rstd[row] * sc; bf16_t* rowp = O + (size_t)row * NPROJ + col0;
#pragma unroll
                for (int bj = 0; bj < 2; ++bj) { const f32x4 v0 = acc[ai][bj][m][0] * rs, v1 = acc[ai][bj][m][1] * rs;
                    u32x4 w; w.x = cvtpk(v0[0], v0[1]); w.y = cvtpk(v0[2], v0[3]); w.z = cvtpk(v1[0], v1[1]); w.w = cvtpk(v1[2], v1[3]);
                    *(u32x4*)(rowp + bj * HALF) = w;
                    if (isk) { float s = bflo(w.x) * bflo(w.x) + bfhi(w.x) * bfhi(w.x) + bflo(w.y) * bflo(w.y) + bfhi(w.y) * bfhi(w.y) + bflo(w.z) * bflo(w.z) + bfhi(w.z) * bfhi(w.z) + bflo(w.w) * bflo(w.w) + bfhi(w.w) * bfhi(w.w);
                        s += __shfl_xor(s, 16); s += __shfl_xor(s, 32); km[bj] = fmaxf(km[bj], s); } } }
        if (isk) {
#pragma unroll
            for (int bj = 0; bj < 2; ++bj) { float v = km[bj]; v = fmaxf(v, __shfl_xor(v, 1)); v = fmaxf(v, __shfl_xor(v, 2)); v = fmaxf(v, __shfl_xor(v, 4)); v = fmaxf(v, __shfl_xor(v, 8));
                if ((threadIdx.x & 63) == 0) { const int b = u.pm >> 4, h = (u.pn - 2) * 4 + bj * 2 + (wc >> 1); atomicMax(kmax + (b * 8 + h) * 16, __float_as_uint(v)); } }
        }
    }
};
struct EpiOut {
    static constexpr bool PERM = false;
    const float* res; float* out;
    __device__ __forceinline__ void operator()(const f32x4 (&acc)[2][2][4][2], const Unit& u, int wr, int wc, int fr, int fq) const {
        const int row0 = u.pm * BM + wr * 64 + fr, col0 = u.pn * BM + wc * 32 + 4 * fq;
#pragma unroll
        for (int ai = 0; ai < 2; ++ai)
#pragma unroll
            for (int m = 0; m < 4; ++m) { const size_t off = (size_t)(row0 + ai * HALF + m * 16) * D + col0;
#pragma unroll
                for (int bj = 0; bj < 2; ++bj)
#pragma unroll
                    for (int n = 0; n < 2; ++n) { const f32x4 r = *(const f32x4*)(res + off + bj * HALF + n * 16); *(f32x4*)(out + off + bj * HALF + n * 16) = r + acc[ai][bj][m][n]; } }
    }
};
struct EpiGlu {
    static constexpr bool PERM = true;
    bf16_t* act; const u32x2* list; const float* b1r;
    __device__ __forceinline__ void operator()(const f32x4 (&acc)[2][2][4][2], const Unit& u, int wr, int wc, int fr, int fq) const {
        const int cb = u.pn * BM + wc * 32 + 8 * fq; const float* bp = b1r + (size_t)u.e * 2048 + cb;
        const f32x4 bg0 = *(const f32x4*)(bp), bg1 = *(const f32x4*)(bp + 4), bl0 = *(const f32x4*)(bp + HALF), bl1 = *(const f32x4*)(bp + HALF + 4);
#pragma unroll
        for (int ai = 0; ai < 2; ++ai)
#pragma unroll
            for (int m = 0; m < 4; ++m) { const int r = ai * HALF + wr * 64 + m * 16 + fr, pos = u.lt * BM + r;
                float rs = 0.f; if (pos < u.cnt) rs = __uint_as_float(list[(size_t)u.e * LISTCAP + pos].y);
                f32x4 g0 = acc[ai][0][m][0] * rs + bg0, g1 = acc[ai][0][m][1] * rs + bg1, l0 = acc[ai][1][m][0] * rs + bl0, l1 = acc[ai][1][m][1] * rs + bl1;
                float o[8];
#pragma unroll
                for (int j = 0; j < 8; ++j) { float g = j < 4 ? g0[j & 3] : g1[j & 3], li = j < 4 ? l0[j & 3] : l1[j & 3];
                    g = fminf(g, 7.f); li = fminf(fmaxf(li, -7.f), 7.f);
                    const float sg = __builtin_amdgcn_rcpf(1.f + __builtin_amdgcn_exp2f(-1.702f * LOG2E * g)); o[j] = g * sg * (li + 1.f); }
                u32x4 w; w.x = cvtpk(o[0], o[1]); w.y = cvtpk(o[2], o[3]); w.z = cvtpk(o[4], o[5]); w.w = cvtpk(o[6], o[7]);
                *(u32x4*)(act + (size_t)(u.pm * BM + r) * FF + u.pn * HALF + wc * 32 + 8 * fq) = w; }
    }
};
struct EpiDown {
    static constexpr bool PERM = true;
    bf16_t* Y; const u32x2* list; const float* gate; const float* b2;
    __device__ __forceinline__ void operator()(const f32x4 (&acc)[2][2][4][2], const Unit& u, int wr, int wc, int fr, int fq) const {
        const int cb = u.pn * BM + wc * 32 + 8 * fq; const float* bp = b2 + (size_t)u.e * D + cb;
        f32x4 bv[2][2];
#pragma unroll
        for (int bj = 0; bj < 2; ++bj)
#pragma unroll
            for (int n = 0; n < 2; ++n) bv[bj][n] = *(const f32x4*)(bp + bj * HALF + 4 * n);
#pragma unroll
        for (int ai = 0; ai < 2; ++ai)
#pragma unroll
            for (int m = 0; m < 4; ++m) { const int r = ai * HALF + wr * 64 + m * 16 + fr, pos = u.lt * BM + r;
                if (pos < u.cnt) { const unsigned ent = list[(size_t)u.e * LISTCAP + pos].x; const float gt = gate[ent]; bf16_t* rowp = Y + (size_t)ent * D + cb;
#pragma unroll
                    for (int bj = 0; bj < 2; ++bj) { const f32x4 v0 = (acc[ai][bj][m][0] + bv[bj][0]) * gt, v1 = (acc[ai][bj][m][1] + bv[bj][1]) * gt;
                        u32x4 w; w.x = cvtpk(v0[0], v0[1]); w.y = cvtpk(v0[2], v0[3]); w.z = cvtpk(v1[0], v1[1]); w.w = cvtpk(v1[2], v1[3]);
                        *(u32x4*)(rowp + bj * HALF) = w; } } }
    }
};
}

#define XB_TMO      128
#define XB_XCNT(j)  (256  + 64 * (j))
#define XB_XSUB(j)  (1280 + 64 * (j))
#define XB_XGEN(j)  (2304 + 64 * (j))
#define XB_TOP      3328
#define XB_TOPGEN   3392
#define XCD_BAR_WORDS 3456
#define XB_SPIN_CAP (1u << 18)
__device__ __forceinline__ unsigned xb_ld(unsigned* p)              { return __hip_atomic_load(p, __ATOMIC_RELAXED, __HIP_MEMORY_SCOPE_AGENT); }
__device__ __forceinline__ unsigned xb_add(unsigned* p, unsigned v) { return __hip_atomic_fetch_add(p, v, __ATOMIC_RELAXED, __HIP_MEMORY_SCOPE_AGENT); }
__device__ __forceinline__ unsigned xb_xcc_id() { return (unsigned)__builtin_amdgcn_s_getreg((3 << 11) | 20) & 0xFu; }
#define XB_SPIN(cond, bar) do { unsigned _sp = 0; while (cond) { __builtin_amdgcn_s_sleep(1); \
    if ((++_sp & 255u) == 0u) { if (xb_ld(&(bar)[XB_TMO])) break; if (_sp > XB_SPIN_CAP) { atomicAdd(&(bar)[XB_TMO], 1u); break; } } } } while (0)
struct XcdBarrier { unsigned* bar; unsigned x; volatile LAS unsigned* st; };
__device__ __forceinline__ XcdBarrier xcd_barrier_post(unsigned* bar, volatile LAS unsigned* st) {
    XcdBarrier b; b.bar = bar; b.x = xb_xcc_id(); b.st = st;
    if (threadIdx.x == 0) (void)xb_add(&bar[XB_XCNT(b.x)], 1u);
    return b;
}
__device__ __forceinline__ void xcd_barrier_complete(unsigned* bar, unsigned x, unsigned& nloc, unsigned& nx) {
    const unsigned G = gridDim.x * gridDim.y * gridDim.z;
    unsigned sum, cnt, mine, sp = 0u;
    for (;;) {
        sum = 0u; cnt = 0u; mine = 0u;
#pragma unroll
        for (unsigned j = 0; j < 16; ++j) { const unsigned c = xb_ld(&bar[XB_XCNT(j)]); sum += c; cnt += (c > 0u) ? 1u : 0u; mine = (j == x) ? c : mine; }
        if (sum == G) break;
        __builtin_amdgcn_s_sleep(1);
        if ((++sp & 255u) == 0u) { if (xb_ld(&bar[XB_TMO])) break; if (sp > XB_SPIN_CAP) { atomicAdd(&bar[XB_TMO], 1u); break; } }
    }
    nloc = mine > 0u ? mine : 1u; nx = cnt > 0u ? cnt : 1u;
}
__device__ __forceinline__ void xcd_barrier(const XcdBarrier& b, const bool leader  ) {
    asm volatile("s_waitcnt vmcnt(0)" ::: "memory");
    __syncthreads();
    if (leader) {
        unsigned* bar = b.bar;
        __builtin_amdgcn_s_waitcnt(0);
        unsigned nloc = b.st[0], nx = b.st[1];
        if (nloc == 0u) { xcd_barrier_complete(bar, b.x, nloc, nx); b.st[0] = nloc; b.st[1] = nx; }
        const unsigned old = xb_add(&bar[XB_XSUB(b.x)], 1u);
        const unsigned gen = old / nloc;
        if (old + 1u == (gen + 1u) * nloc) {
            __builtin_amdgcn_fence(__ATOMIC_RELEASE, "agent");
            asm volatile("s_waitcnt vmcnt(0)" ::: "memory");
            const unsigned og = xb_add(&bar[XB_TOP], 1u);
            const unsigned tg = og / nx;
            if (og + 1u == (tg + 1u) * nx) xb_add(&bar[XB_TOPGEN], 1u);
            else XB_SPIN(xb_ld(&bar[XB_TOPGEN]) == tg, bar);
            __builtin_amdgcn_fence(__ATOMIC_ACQUIRE, "agent");
            xb_add(&bar[XB_XGEN(b.x)], 1u);
            asm volatile("s_waitcnt vmcnt(0)" ::: "memory");
        } else {
            XB_SPIN(xb_ld(&bar[XB_XGEN(b.x)]) == gen, bar);
            __builtin_amdgcn_fence(__ATOMIC_ACQUIRE, "agent");
            asm volatile("s_waitcnt vmcnt(0)" ::: "memory");
        }
    }
    __syncthreads();
}

enum { I_x = 0, I_norm_mix, I_w_in, I_b_fox_f, I_fox_gain, I_hgrn_lb, I_hgrn_gain, I_pool_w, I_pool_scale, I_w_out, I_norm_moe, I_w_router, I_b_router, I_w1, I_b1, I_w2, I_b2, I_norm_final };
struct Frame {
    LAS unsigned char* lds; unsigned char* ws; unsigned* ctl; float* out;
    int tid, lane, wave, bid, G;
};
__device__ __forceinline__ const float* inp(const Frame& F, int i) {
    const LAS unsigned* p = (const LAS unsigned*)(F.lds + LDSCTL_OFF + LC_INP) + 2 * i;
    const unsigned lo = __builtin_amdgcn_readfirstlane(p[0]), hi = __builtin_amdgcn_readfirstlane(p[1]);
    return (const float*)(((unsigned long long)hi << 32) | lo);
}

__device__ __forceinline__ void p0_item(const float* src, int ldn, int c0, int cs, const float* g, bf16_t* dstrow0, int K, int k0, LAS float* scr, int lane) {
#pragma unroll 8
    for (int i = 0; i < 32; ++i) { const int kk = 2 * i + (lane >> 5); float v = src[(size_t)(k0 + kk) * ldn + c0 + cs * (lane & 31)]; if (g) v *= g[k0 + kk]; scr[kk * 33 + (lane & 31)] = v; }
    LDS_WAIT(); asm volatile("" ::: "memory");
    const int c = lane & 7;
#pragma unroll
    for (int j = 0; j < 4; ++j) { const int n = (lane >> 3) + 8 * j; const LAS float* s = scr + (8 * c) * 33 + n;
        u32x4 o; o.x = cvtpk(s[0 * 33], s[1 * 33]); o.y = cvtpk(s[2 * 33], s[3 * 33]); o.z = cvtpk(s[4 * 33], s[5 * 33]); o.w = cvtpk(s[6 * 33], s[7 * 33]);
        *(u32x4*)(dstrow0 + (size_t)n * K + k0 + 8 * c) = o; }
    LDS_WAIT(); asm volatile("" ::: "memory");
}
__device__ __forceinline__ void p0_prologue(const Frame& F) {
    LAS float* scr = (LAS float*)(F.lds + F.wave * 16384);
    const int gw = F.bid * NWAVES + F.wave, NGW = F.G * NWAVES;
    constexpr int I_IN = 16 * 88, I_OUT = 16 * 32, I_W1 = NE * 16 * 64, I_W2 = NE * 16 * 32, I_L = I_IN + I_OUT + I_W1 + I_W2;
    for (int it = gw; it < NL * I_L; it += NGW) {
        const int l = it / I_L; int r = it % I_L;
        if (r < I_IN) { const int kb = r / 88, nb = r % 88, n0 = 32 * nb;
            p0_item(inp(F, I_w_in) + (size_t)l * D * IN_COLS, IN_COLS, n0 + (n0 >= 1536 ? 8 : 0), 1, inp(F, I_norm_mix) + l * D, (bf16_t*)(F.ws + WS_WIN + l * WIN_BYTES) + (size_t)n0 * D, D, 64 * kb, scr, F.lane); continue; }
        r -= I_IN;
        if (r < I_OUT) { const int kb = r / 32, nb = r % 32, n0 = 32 * nb;
            p0_item(inp(F, I_w_out) + (size_t)l * D * D, D, n0, 1, nullptr, (bf16_t*)(F.ws + WS_WOUT + l * WOUT_BYTES) + (size_t)n0 * D, D, 64 * kb, scr, F.lane); continue; }
        r -= I_OUT;
        if (r < I_W1) { const int e = r / (16 * 64), q = r % (16 * 64), kb = q / 64, nb = q % 64, n0 = 32 * nb, pn = n0 >> 8, rr = n0 & 255, j0 = 128 * pn + (rr & 127), par = rr >> 7;
            p0_item(inp(F, I_w1) + ((size_t)l * NE + e) * D * 2 * FF, 2 * FF, 2 * j0 + par, 2, inp(F, I_norm_moe) + l * D, (bf16_t*)(F.ws + WS_W1 + ((size_t)l * NE + e) * W1E_BYTES) + (size_t)n0 * D, D, 64 * kb, scr, F.lane); continue; }
        r -= I_W1;
        { const int e = r / (16 * 32), q = r % (16 * 32), kb = q / 32, nb = q % 32, n0 = 32 * nb;
            p0_item(inp(F, I_w2) + ((size_t)l * NE + e) * FF * D, D, n0, 1, nullptr, (bf16_t*)(F.ws + WS_W2 + ((size_t)l * NE + e) * W2E_BYTES) + (size_t)n0 * FF, FF, 64 * kb, scr, F.lane); }
    }
    const int gt = F.bid * NTHREADS + F.tid, NGT = F.G * NTHREADS;
    float* b1r = (float*)(F.ws + WS_B1R);
    for (int i = gt; i < NL * NE * 2048; i += NGT) { const int le = i >> 11, n = i & 2047, pn = n >> 8, rr = n & 255; b1r[i] = inp(F, I_b1)[(size_t)le * 2048 + 2 * (128 * pn + (rr & 127)) + (rr >> 7)]; }
    bf16_t* wf = (bf16_t*)(F.ws + WS_WFRAG);
    for (int i = gt; i < NL * 2 * 32 * 2 * 64 * 8; i += NGT) {
        const int j = i & 7, ln = (i >> 3) & 63, et = (i >> 9) & 1, ks = (i >> 10) & 31, kind = (i >> 15) & 1, l = i >> 16;
        const int e = 16 * et + (ln & 15), k = 32 * ks + 8 * (ln >> 4) + j;
        float v;
        if (kind == 0) v = (e < 8) ? inp(F, I_norm_mix)[l * D + k] * inp(F, I_w_in)[((size_t)l * D + k) * IN_COLS + 1536 + e] : 0.f;
        else v = inp(F, I_norm_moe)[l * D + k] * inp(F, I_w_router)[((size_t)l * D + k) * NE + e];
        const bf16_t h = f2bf(v), lo = f2bf(v - bf2f(h));
        const size_t base = ((((size_t)(l * 2 + kind) * 32 + ks) * 2 + et) * 2) * 512 + ln * 8 + j;
        wf[base] = h; wf[base + 512] = lo;
    }
}

template <int KIND, bool COMBINE, bool WRITE_H>
__device__ __forceinline__ void r_phase(const Frame& F, int l, const float* hin, float* hout) {
    const int lane = F.lane, r16 = lane & 15, q4 = lane >> 4;
    const u32x4* Wf = (const u32x4*)(F.ws + WS_WFRAG + (size_t)(l * 2 + KIND) * 131072);
    const bf16_t* Y = (const bf16_t*)(F.ws + WS_Y);
    bf16_t* HB = (bf16_t*)(F.ws + WS_HB);
    float* rstdp = (float*)(F.ws + (KIND == 0 ? WS_RSTD1 : WS_RSTD2));
    LAS float* lg = (LAS float*)(F.lds) + F.wave * (16 * 33);
    LAS int* r2cnt = (LAS int*)(F.lds + LDSCTL_OFF + LC_R2CNT); LAS int* r2base = (LAS int*)(F.lds + LDSCTL_OFF + LC_R2BASE);
    for (int task = F.bid; task < T / 128; task += F.G) {
        const int tok = task * 128 + F.wave * 16 + r16;
        const float* xr = hin + (size_t)tok * D + 8 * q4; float* ho = hout + (size_t)tok * D + 8 * q4;
        const bf16_t* yr = Y + (size_t)tok * 4 * D + 8 * q4; bf16_t* hbr = HB + (size_t)tok * D + 8 * q4;
        f32x4 acc0 = {0.f, 0.f, 0.f, 0.f}, acc1 = {0.f, 0.f, 0.f, 0.f}; float ssq = 0.f;
        if (KIND == 1) { if (F.tid < 32) r2cnt[F.tid] = 0; }
#pragma unroll 2
        for (int ks = 0; ks < 32; ++ks) {
            f32x4 x0 = *(const f32x4*)(xr + 32 * ks), x1 = *(const f32x4*)(xr + 32 * ks + 4);
            if (COMBINE) {
#pragma unroll
                for (int k = 0; k < 4; ++k) { const u32x4 y = *(const u32x4*)(yr + (size_t)k * D + 32 * ks);
                    x0[0] += bflo(y.x); x0[1] += bfhi(y.x); x0[2] += bflo(y.y); x0[3] += bfhi(y.y); x1[0] += bflo(y.z); x1[1] += bfhi(y.z); x1[2] += bflo(y.w); x1[3] += bfhi(y.w); }
            }
            if (WRITE_H) { *(f32x4*)(ho + 32 * ks) = x0; *(f32x4*)(ho + 32 * ks + 4) = x1; }
            ssq += (x0[0] * x0[0] + x0[1] * x0[1]) + (x0[2] * x0[2] + x0[3] * x0[3]) + (x1[0] * x1[0] + x1[1] * x1[1]) + (x1[2] * x1[2] + x1[3] * x1[3]);
            u32x4 hw; hw.x = cvtpk(x0[0], x0[1]); hw.y = cvtpk(x0[2], x0[3]); hw.z = cvtpk(x1[0], x1[1]); hw.w = cvtpk(x1[2], x1[3]);
            u32x4 lw; lw.x = cvtpk(x0[0] - bflo(hw.x), x0[1] - bfhi(hw.x)); lw.y = cvtpk(x0[2] - bflo(hw.y), x0[3] - bfhi(hw.y)); lw.z = cvtpk(x1[0] - bflo(hw.z), x1[1] - bfhi(hw.z)); lw.w = cvtpk(x1[2] - bflo(hw.w), x1[3] - bfhi(hw.w));
            *(u32x4*)(hbr + 32 * ks) = hw;
            const bf16x8 xh = __builtin_bit_cast(bf16x8, hw), xl = __builtin_bit_cast(bf16x8, lw);
            const bf16x8 wh0 = __builtin_bit_cast(bf16x8, Wf[((ks * 2 + 0) * 2 + 0) * 64 + lane]), wl0 = __builtin_bit_cast(bf16x8, Wf[((ks * 2 + 0) * 2 + 1) * 64 + lane]);
            acc0 = __builtin_amdgcn_mfma_f32_16x16x32_bf16(wh0, xh, acc0, 0, 0, 0);
            acc0 = __builtin_amdgcn_mfma_f32_16x16x32_bf16(wl0, xh, acc0, 0, 0, 0);
            acc0 = __builtin_amdgcn_mfma_f32_16x16x32_bf16(wh0, xl, acc0, 0, 0, 0);
            if (KIND == 1) {
                const bf16x8 wh1 = __builtin_bit_cast(bf16x8, Wf[((ks * 2 + 1) * 2 + 0) * 64 + lane]), wl1 = __builtin_bit_cast(bf16x8, Wf[((ks * 2 + 1) * 2 + 1) * 64 + lane]);
                acc1 = __builtin_amdgcn_mfma_f32_16x16x32_bf16(wh1, xh, acc1, 0, 0, 0);
                acc1 = __builtin_amdgcn_mfma_f32_16x16x32_bf16(wl1, xh, acc1, 0, 0, 0);
                acc1 = __builtin_amdgcn_mfma_f32_16x16x32_bf16(wh1, xl, acc1, 0, 0, 0);
            }
        }
        ssq += __shfl_xor(ssq, 16); ssq += __shfl_xor(ssq, 32);
        const float rstd = 1.0f / sqrtf(ssq * (1.0f / D) + RMS_EPS);
        if (q4 == 0) rstdp[tok] = rstd;
        if (KIND == 0) {
            if (q4 < 2) { const f32x4 bf = *(const f32x4*)(inp(F, I_b_fox_f) + l * 8 + 4 * q4); f32x4 lf;
#pragma unroll
                for (int i = 0; i < 4; ++i) { const float z = rstd * acc0[i] + bf[i]; lf[i] = fminf(z, 0.f) - log1pf(expf(-fabsf(z))); }
                *(f32x4*)((float*)(F.ws + WS_LOGF) + (size_t)tok * 8 + 4 * q4) = lf; }
        } else {
            const f32x4 b0 = *(const f32x4*)(inp(F, I_b_router) + l * NE + 4 * q4), b1v = *(const f32x4*)(inp(F, I_b_router) + l * NE + 16 + 4 * q4);
#pragma unroll
            for (int i = 0; i < 4; ++i) { lg[r16 * 33 + 4 * q4 + i] = rstd * acc0[i] + b0[i]; lg[r16 * 33 + 16 + 4 * q4 + i] = rstd * acc1[i] + b1v[i]; }
            LDS_WAIT(); asm volatile("" ::: "memory");
            float v0 = -INFINITY, v1 = -INFINITY, v2 = -INFINITY, v3 = -INFINITY; int i0 = 0, i1 = 0, i2 = 0, i3 = 0;
            if (lane < 16) {
                for (int e = 0; e < NE; ++e) { const float x = lg[lane * 33 + e];
                    if (x > v3) { if (x > v0) { v3 = v2; i3 = i2; v2 = v1; i2 = i1; v1 = v0; i1 = i0; v0 = x; i0 = e; }
                        else if (x > v1) { v3 = v2; i3 = i2; v2 = v1; i2 = i1; v1 = x; i1 = e; }
                        else if (x > v2) { v3 = v2; i3 = i2; v2 = x; i2 = e; }
                        else { v3 = x; i3 = e; } } }
            }
            __syncthreads();
            int rk0 = 0, rk1 = 0, rk2 = 0, rk3 = 0;
            if (lane < 16) { rk0 = __hip_atomic_fetch_add(&r2cnt[i0], 1, __ATOMIC_RELAXED, __HIP_MEMORY_SCOPE_WORKGROUP); rk1 = __hip_atomic_fetch_add(&r2cnt[i1], 1, __ATOMIC_RELAXED, __HIP_MEMORY_SCOPE_WORKGROUP); rk2 = __hip_atomic_fetch_add(&r2cnt[i2], 1, __ATOMIC_RELAXED, __HIP_MEMORY_SCOPE_WORKGROUP); rk3 = __hip_atomic_fetch_add(&r2cnt[i3], 1, __ATOMIC_RELAXED, __HIP_MEMORY_SCOPE_WORKGROUP); }
            __syncthreads();
            if (F.tid < 32) r2base[F.tid] = (int)atomicAdd(F.ctl + CW_CUR + (l * NE + F.tid) * 16, (unsigned)r2cnt[F.tid]);
            __syncthreads();
            if (lane < 16) {
                const float e1 = expf(v1 - v0), e2 = expf(v2 - v0), e3 = expf(v3 - v0), inv = 1.0f / (1.0f + e1 + e2 + e3);
                u32x2* list = (u32x2*)(F.ws + WS_LIST); float* gate = (float*)(F.ws + WS_GATE);
                const int tk = (task * 128 + F.wave * 16 + lane) * 4; const unsigned rb = __float_as_uint(__shfl(rstd, lane & 15));
                list[(size_t)i0 * LISTCAP + r2base[i0] + rk0] = (u32x2){(unsigned)(tk + 0), rb}; gate[tk + 0] = inv;
                list[(size_t)i1 * LISTCAP + r2base[i1] + rk1] = (u32x2){(unsigned)(tk + 1), rb}; gate[tk + 1] = e1 * inv;
                list[(size_t)i2 * LISTCAP + r2base[i2] + rk2] = (u32x2){(unsigned)(tk + 2), rb}; gate[tk + 2] = e2 * inv;
                list[(size_t)i3 * LISTCAP + r2base[i3] + rk3] = (u32x2){(unsigned)(tk + 3), rb}; gate[tk + 3] = e3 * inv;
            }
            __syncthreads();
        }
    }
}
__device__ __forceinline__ void r_final(const Frame& F) {
    const int lane = F.lane, r16 = lane & 15, q4 = lane >> 4;
    const bf16_t* Y = (const bf16_t*)(F.ws + WS_Y);
    for (int task = F.bid; task < T / 128; task += F.G) {
        const int tok = task * 128 + F.wave * 16 + r16;
        float* xr = F.out + (size_t)tok * D + 8 * q4; const bf16_t* yr = Y + (size_t)tok * 4 * D + 8 * q4;
        float ssq = 0.f;
#pragma unroll 2
        for (int ks = 0; ks < 32; ++ks) {
            f32x4 x0 = *(const f32x4*)(xr + 32 * ks), x1 = *(const f32x4*)(xr + 32 * ks + 4);
#pragma unroll
            for (int k = 0; k < 4; ++k) { const u32x4 y = *(const u32x4*)(yr + (size_t)k * D + 32 * ks);
                x0[0] += bflo(y.x); x0[1] += bfhi(y.x); x0[2] += bflo(y.y); x0[3] += bfhi(y.y); x1[0] += bflo(y.z); x1[1] += bfhi(y.z); x1[2] += bflo(y.w); x1[3] += bfhi(y.w); }
            ssq += (x0[0] * x0[0] + x0[1] * x0[1]) + (x0[2] * x0[2] + x0[3] * x0[3]) + (x1[0] * x1[0] + x1[1] * x1[1]) + (x1[2] * x1[2] + x1[3] * x1[3]);
        }
        ssq += __shfl_xor(ssq, 16); ssq += __shfl_xor(ssq, 32);
        const float rstd = 1.0f / sqrtf(ssq * (1.0f / D) + RMS_EPS);
#pragma unroll 2
        for (int ks = 0; ks < 32; ++ks) {
            f32x4 x0 = *(const f32x4*)(xr + 32 * ks), x1 = *(const f32x4*)(xr + 32 * ks + 4);
#pragma unroll
            for (int k = 0; k < 4; ++k) { const u32x4 y = *(const u32x4*)(yr + (size_t)k * D + 32 * ks);
                x0[0] += bflo(y.x); x0[1] += bfhi(y.x); x0[2] += bflo(y.y); x0[3] += bfhi(y.y); x1[0] += bflo(y.z); x1[1] += bfhi(y.z); x1[2] += bflo(y.w); x1[3] += bfhi(y.w); }
            const f32x4 g0 = *(const f32x4*)(inp(F, I_norm_final) + 32 * ks + 8 * q4), g1 = *(const f32x4*)(inp(F, I_norm_final) + 32 * ks + 8 * q4 + 4);
            *(f32x4*)(xr + 32 * ks) = x0 * rstd * g0; *(f32x4*)(xr + 32 * ks + 4) = x1 * rstd * g1;
        }
    }
}
__device__ __forceinline__ void cumsum_step(const Frame& F) {
    LAS float* sc = (LAS float*)(F.lds + LDSCTL_OFF + LC_SCAN);
    const float* LF = (const float*)(F.ws + WS_LOGF); float* c2 = (float*)(F.ws + WS_C2);
    for (int seq = F.bid; seq < 64; seq += F.G) {
        const int b = seq >> 3, h = seq & 7, t0 = F.tid * 8; const float* lf = LF + ((size_t)b * SEQ + t0) * 8 + h;
        float v[8], s = 0.f;
#pragma unroll
        for (int j = 0; j < 8; ++j) { s += lf[j * 8]; v[j] = s; }
        float inc = s;
#pragma unroll
        for (int off = 1; off < 64; off <<= 1) { const float y = __shfl_up(inc, off); if (F.lane >= off) inc += y; }
        if (F.lane == 63) sc[F.wave] = inc;
        __syncthreads();
        float pre = 0.f;
        for (int w = 0; w < F.wave; ++w) pre += sc[w];
        const float base = pre + inc - s;
#pragma unroll
        for (int j = 0; j < 8; ++j) c2[(size_t)seq * SEQ + t0 + j] = (base + v[j]) * LOG2E;
        __syncthreads();
    }
}

__device__ __forceinline__ int crow(int r, int hi) { return (r & 3) + 8 * (r >> 2) + 4 * hi; }
constexpr int AT_KT = 0, AT_KTB = 8320, AT_VT = 2 * AT_KTB, AT_VTB = 8192, AT_CK = AT_VT + 2 * AT_VTB, AT_WSF = AT_CK + 512, AT_OST = AT_WSF + 2048, AT_END = AT_OST + 65536;
static_assert(AT_END <= PH_BYTES, "attention LDS");
__device__ __forceinline__ void attn_unit(const Frame& F, int l, int b, int h, int qb) {
    const int tid = F.tid, lane = F.lane, r32 = lane & 31, hi = lane >> 5, wid = F.wave;
    const bf16_t* proj = (const bf16_t*)(F.ws + WS_PA); bf16_t* mixed = (bf16_t*)(F.ws + WS_MIXED);
    const int bh = b * 8 + h; const float* c2 = (const float*)(F.ws + WS_C2) + (size_t)bh * SEQ;
    const size_t rowbase = (size_t)b * SEQ; const int q0 = qb * 256;
    LAS unsigned char* L = F.lds;
    LAS float* wsf = (LAS float*)(L + AT_WSF) + wid * 64;
    LAS float* ost = (LAS float*)(L + AT_OST) + wid * 2048;
    volatile LAS int* stopf = (volatile LAS int*)(L + LDSCTL_OFF + LC_STOP);
    const bf16_t* Qw = proj + (rowbase + q0 + wid * 32 + r32) * NPROJ + C_FQ + h * 64;
    bf16x8 qr[4]; float qn = 0.f;
#pragma unroll
    for (int d0 = 0; d0 < 4; ++d0) { const u32x4 w = *(const u32x4*)(Qw + d0 * 16 + hi * 8); qr[d0] = __builtin_bit_cast(bf16x8, w);
        qn += bflo(w.x) * bflo(w.x) + bfhi(w.x) * bfhi(w.x) + bflo(w.y) * bflo(w.y) + bfhi(w.y) * bfhi(w.y) + bflo(w.z) * bflo(w.z) + bfhi(w.z) * bfhi(w.z) + bflo(w.w) * bflo(w.w) + bfhi(w.w) * bfhi(w.w); }
    qn += __shfl_xor(qn, 32); qn = sqrtf(qn) * 1.001f;
    const float kb = sqrtf(2.0f * __uint_as_float(__hip_atomic_load(F.ctl + CW_KMAX + (l * 64 + bh) * 16, __ATOMIC_RELAXED, __HIP_MEMORY_SCOPE_AGENT))) * 1.001f;
    const float c2q = c2[q0 + wid * 32 + r32];
    f32x16 cq16;
#pragma unroll
    for (int r = 0; r < 16; ++r) cq16[r] = c2q;
    float m = -INFINITY, lsum = 0.f; f32x16 o[2];
#pragma unroll
    for (int r = 0; r < 16; ++r) { o[0][r] = 0.f; o[1][r] = 0.f; }
    const int jd = 4 * qb + 3;
    const int lkey = tid >> 3, lpiece = tid & 7;
    const bf16_t* ksrc = proj + (rowbase + lkey) * NPROJ + C_FK + h * 64 + lpiece * 8;
    const bf16_t* vsrc = proj + (rowbase + lkey) * NPROJ + C_FV + h * 64 + lpiece * 8;
    const int kdst = lpiece * 1040 + lkey * 16, vdst = (lpiece >> 2) * 4096 + lkey * 64 + (lpiece & 3) * 16;
    u32x4 kreg = *(const u32x4*)(ksrc + (size_t)jd * 64 * NPROJ), vreg = *(const u32x4*)(vsrc + (size_t)jd * 64 * NPROJ);
    float ckreg = 0.f; if (tid < 64) ckreg = c2[jd * 64 + tid];
    const int vrd = (4 * hi + ((lane & 15) >> 2)) * 64 + ((lane >> 4) & 1) * 32 + (lane & 3) * 8;
    const int qrel = wid * 32 + r32;
    int buf = 0;
    for (int j = jd; j >= 0; --j) {
        *(LAS u32x4*)(L + AT_KT + buf * AT_KTB + kdst) = kreg; *(LAS u32x4*)(L + AT_VT + buf * AT_VTB + vdst) = vreg;
        if (tid < 64) ((LAS float*)(L + AT_CK))[buf * 64 + tid] = ckreg;
        __syncthreads();
        if (j < jd) { int all = 1;
#pragma unroll
            for (int w = 0; w < 8; ++w) all &= stopf[((j + 1) & 1) * 8 + w];
            if (all) break; }
        float cklast = 0.f;
        if (j > 0) { kreg = *(const u32x4*)(ksrc + (size_t)(j - 1) * 64 * NPROJ); vreg = *(const u32x4*)(vsrc + (size_t)(j - 1) * 64 * NPROJ); if (tid < 64) ckreg = c2[(j - 1) * 64 + tid]; cklast = c2[(j - 1) * 64 + 63]; }
        const int jrel = j - 4 * qb;
        const bool active = !(jrel >= 0 && 64 * jrel > 32 * wid + 31);
        if (active) {
            const LAS unsigned char* Kb = L + AT_KT + buf * AT_KTB; const LAS unsigned char* Vb = L + AT_VT + buf * AT_VTB; const LAS float* Ck = (const LAS float*)(L + AT_CK) + buf * 64;
            f32x16 p0 = cq16, p1 = cq16;
#pragma unroll
            for (int d0 = 0; d0 < 4; ++d0) {
                const bf16x8 k0 = *(const LAS bf16x8*)(Kb + (2 * d0 + hi) * 1040 + r32 * 16), k1 = *(const LAS bf16x8*)(Kb + (2 * d0 + hi) * 1040 + (32 + r32) * 16);
                p0 = __builtin_amdgcn_mfma_f32_32x32x16_bf16(k0, qr[d0], p0, 0, 0, 0); p1 = __builtin_amdgcn_mfma_f32_32x32x16_bf16(k1, qr[d0], p1, 0, 0, 0); }
#pragma unroll
            for (int g = 0; g < 4; ++g) { const f32x4 ca = *(const LAS f32x4*)(Ck + 8 * g + 4 * hi), cb = *(const LAS f32x4*)(Ck + 32 + 8 * g + 4 * hi);
#pragma unroll
                for (int i = 0; i < 4; ++i) { p0[4 * g + i] -= ca[i]; p1[4 * g + i] -= cb[i]; } }
            if (jrel >= 0) { const int kbase = 64 * jrel + 4 * hi;
#pragma unroll
                for (int r = 0; r < 16; ++r) { const int kv = kbase + (r & 3) + 8 * (r >> 2); if (kv > qrel) p0[r] = -INFINITY; if (kv + 32 > qrel) p1[r] = -INFINITY; } }
            float mx = fmaxf(p0[0], p1[0]);
#pragma unroll
            for (int r = 1; r < 16; ++r) mx = fmaxf(mx, fmaxf(p0[r], p1[r]));
            mx = fmaxf(mx, __shfl_xor(mx, 32));
            const float mnew = fmaxf(m, mx), alpha = __builtin_amdgcn_exp2f(m - mnew);
            float ls = 0.f;
#pragma unroll
            for (int r = 0; r < 16; ++r) { p0[r] = __builtin_amdgcn_exp2f(p0[r] - mnew); p1[r] = __builtin_amdgcn_exp2f(p1[r] - mnew); ls += p0[r] + p1[r]; }
            lsum = lsum * alpha + ls;
            if (__any(mnew > m)) {
                if (hi == 0) wsf[r32] = alpha;
                LDS_WAIT(); asm volatile("" ::: "memory");
#pragma unroll
                for (int r = 0; r < 16; ++r) { const float a = wsf[crow(r, hi)]; o[0][r] *= a; o[1][r] *= a; }
            }
            m = mnew;
            u32x4 pw[4];
            pw[0] = (u32x4){cvtpk(p0[0], p0[1]), cvtpk(p0[2], p0[3]), cvtpk(p0[4], p0[5]), cvtpk(p0[6], p0[7])};
            pw[1] = (u32x4){cvtpk(p0[8], p0[9]), cvtpk(p0[10], p0[11]), cvtpk(p0[12], p0[13]), cvtpk(p0[14], p0[15])};
            pw[2] = (u32x4){cvtpk(p1[0], p1[1]), cvtpk(p1[2], p1[3]), cvtpk(p1[4], p1[5]), cvtpk(p1[6], p1[7])};
            pw[3] = (u32x4){cvtpk(p1[8], p1[9]), cvtpk(p1[10], p1[11]), cvtpk(p1[12], p1[13]), cvtpk(p1[14], p1[15])};
#pragma unroll
            for (int s = 0; s < 4; ++s)
#pragma unroll
                for (int d0 = 0; d0 < 2; ++d0) {
                    const LAS unsigned char* vp = Vb + d0 * 4096 + s * 1024 + vrd;
                    const v4i16_t lo = __builtin_amdgcn_ds_read_tr16_b64_v4i16((LAS v4i16_t*)vp), hv = __builtin_amdgcn_ds_read_tr16_b64_v4i16((LAS v4i16_t*)(vp + 512));
                    const bf16x8 vf = (bf16x8){lo[0], lo[1], lo[2], lo[3], hv[0], hv[1], hv[2], hv[3]};
                    o[d0] = __builtin_amdgcn_mfma_f32_32x32x16_bf16(__builtin_bit_cast(bf16x8, pw[s]), vf, o[d0], 0, 0, 0); }
        }
        if (j > 0) { int st = 0; if (active) { const float ub = qn * kb + (c2q - cklast); st = __all((ub - m) < -152.0f) ? 1 : 0; } if (lane == 0) stopf[(j & 1) * 8 + wid] = st; }
        buf ^= 1;
    }
    lsum += __shfl_xor(lsum, 32);
    if (hi == 0) wsf[32 + r32] = 1.0f / lsum;
    LDS_WAIT(); asm volatile("" ::: "memory");
#pragma unroll
    for (int r = 0; r < 16; ++r) { const int q = crow(r, hi); const float inv = wsf[32 + q]; ost[q * 64 + r32] = o[0][r] * inv; ost[q * 64 + 32 + r32] = o[1][r] * inv; }
    LDS_WAIT(); asm volatile("" ::: "memory");
    { const int row = lane >> 1, half = lane & 1; const LAS float* src = ost + row * 64 + half * 32; float v[32]; float ss = 0.f;
#pragma unroll
        for (int i = 0; i < 8; ++i) { const f32x4 t4 = *(const LAS f32x4*)(src + 4 * i); v[4 * i] = t4[0]; v[4 * i + 1] = t4[1]; v[4 * i + 2] = t4[2]; v[4 * i + 3] = t4[3]; ss += (t4[0] * t4[0] + t4[1] * t4[1]) + (t4[2] * t4[2] + t4[3] * t4[3]); }
        ss += __shfl_xor(ss, 1);
        const float rs = 1.0f / sqrtf(ss * (1.0f / 64.0f) + RMS_EPS);
        const float* gn = inp(F, I_fox_gain) + l * 512 + h * 64 + half * 32;
        bf16_t* dst = mixed + (rowbase + q0 + wid * 32 + row) * D + h * 64 + half * 32;
#pragma unroll
        for (int i = 0; i < 4; ++i) { const f32x4 ga = *(const f32x4*)(gn + 8 * i), gb = *(const f32x4*)(gn + 8 * i + 4); u32x4 w;
            w.x = cvtpk(v[8 * i] * rs * ga[0], v[8 * i + 1] * rs * ga[1]); w.y = cvtpk(v[8 * i + 2] * rs * ga[2], v[8 * i + 3] * rs * ga[3]);
            w.z = cvtpk(v[8 * i + 4] * rs * gb[0], v[8 * i + 5] * rs * gb[1]); w.w = cvtpk(v[8 * i + 6] * rs * gb[2], v[8 * i + 7] * rs * gb[3]);
            *(u32x4*)(dst + 8 * i) = w; } }
    __syncthreads();
}

__device__ __forceinline__ float hg_lb(const Frame& F, int l, int col) {
    float x[NL], mx = -INFINITY;
#pragma unroll
    for (int i = 0; i < NL; ++i) { x[i] = inp(F, I_hgrn_lb)[i * 256 + col]; mx = fmaxf(mx, x[i]); }
    float s = 0.f, a = 0.f;
#pragma unroll
    for (int i = 0; i < NL; ++i) { x[i] = expf(x[i] - mx); s += x[i]; }
#pragma unroll
    for (int i = 1; i < NL; ++i) if (i <= l) a += x[i];
    return a / s;
}
constexpr int HG_SEG = 256, HG_NSEG = SEQ / HG_SEG;
__device__ __forceinline__ void hg_seg_unit(const Frame& F, int l, int u) {
    const int seg = u & 15, ks = (u >> 4) & 3, bh = u >> 6, b = bh >> 2, hd = bh & 3, lane = F.lane;
    const bf16_t* proj = (const bf16_t*)(F.ws + WS_PA) + ((size_t)b * SEQ + seg * HG_SEG) * NPROJ;
    float* oraw = (float*)(F.ws + WS_ORAW) + (size_t)ks * T * 256 + ((size_t)b * SEQ + seg * HG_SEG) * 256 + hd * 64 + lane;
    bf16_t* qe = (bf16_t*)(F.ws + WS_QE) + ((size_t)b * SEQ + seg * HG_SEG) * 256 + hd * 64 + ks * 16 + (lane & 15);
    const float lbv = hg_lb(F, l, hd * 64 + ks * 16 + (lane & 15));
    float S[16], P = 1.0f;
#pragma unroll
    for (int j = 0; j < 16; ++j) S[j] = 0.f;
    for (int t0 = 0; t0 < HG_SEG; t0 += 4) {
        float fl[4], qv[4], vin[4];
#pragma unroll
        for (int i = 0; i < 4; ++i) { const bf16_t* row = proj + (size_t)(t0 + i) * NPROJ;
            fl[i] = bf2f(row[C_GF + hd * 64 + ks * 16 + (lane & 15)]); qv[i] = bf2f(row[C_GQ + hd * 64 + ks * 16 + (lane & 15)]); vin[i] = bf2f(row[C_GI + hd * 64 + lane]); }
#pragma unroll
        for (int i = 0; i < 4; ++i) {
            const float sg = 1.0f / (1.0f + expf(-fl[i])), f = lbv + (1.0f - lbv) * sg, kk = (1.0f - lbv) * (1.0f - sg);
            P *= f;
            float o = 0.f;
#pragma unroll
            for (int j = 0; j < 16; ++j) { const float fj = rdlane(f, j), kj = rdlane(kk, j), qj = rdlane(qv[i], j); S[j] = fj * S[j] + kj * vin[i]; o += qj * S[j]; }
            oraw[(size_t)(t0 + i) * 256] = o;
            if (lane < 16) qe[(size_t)(t0 + i) * 256] = f2bf(qv[i] * P);
        }
    }
    float* send = (float*)(F.ws + WS_SEND) + ((size_t)(bh * HG_NSEG + seg) * 64 + ks * 16) * 64 + lane;
#pragma unroll
    for (int j = 0; j < 16; ++j) send[j * 64] = S[j];
    if (lane < 16) ((float*)(F.ws + WS_PSEG))[(bh * HG_NSEG + seg) * 64 + ks * 16 + lane] = P;
}
__device__ __forceinline__ void hg_fix_phase(const Frame& F, int l) {
    const int lane = F.lane, r16 = lane & 15, q4 = lane >> 4, tid = F.tid;
    LAS bf16_t* ST = (LAS bf16_t*)(F.lds);
    const float* oraw = (const float*)(F.ws + WS_ORAW); const bf16_t* proj = (const bf16_t*)(F.ws + WS_PA); bf16_t* mixed = (bf16_t*)(F.ws + WS_MIXED);
    const bf16_t* QE = (const bf16_t*)(F.ws + WS_QE); const float* SEND = (const float*)(F.ws + WS_SEND); const float* PSEG = (const float*)(F.ws + WS_PSEG);
    for (int u = F.bid; u < 32 * HG_NSEG; u += F.G) {
        const int seg = u & 15, bh = u >> 4, b = bh >> 2, hd = bh & 3;
        if (seg > 0) {
            const int k = tid >> 3, v8 = (tid & 7) * 8; float S[8];
#pragma unroll
            for (int i = 0; i < 8; ++i) S[i] = 0.f;
            for (int sp = 0; sp < seg; ++sp) { const float P = PSEG[(bh * HG_NSEG + sp) * 64 + k]; const float* se = SEND + ((size_t)(bh * HG_NSEG + sp) * 64 + k) * 64 + v8;
                const f32x4 a = *(const f32x4*)se, c = *(const f32x4*)(se + 4);
                S[0] = P * S[0] + a[0]; S[1] = P * S[1] + a[1]; S[2] = P * S[2] + a[2]; S[3] = P * S[3] + a[3]; S[4] = P * S[4] + c[0]; S[5] = P * S[5] + c[1]; S[6] = P * S[6] + c[2]; S[7] = P * S[7] + c[3]; }
#pragma unroll
            for (int i = 0; i < 8; ++i) ST[(v8 + i) * 72 + k] = f2bf(S[i]);
        }
        __syncthreads();
#pragma unroll 1
        for (int mb = 0; mb < 2; ++mb) {
            const size_t tok0 = (size_t)b * SEQ + seg * HG_SEG + F.wave * 32 + mb * 16;
            f32x4 acc[4];
#pragma unroll
            for (int vb = 0; vb < 4; ++vb) acc[vb] = (f32x4){0.f, 0.f, 0.f, 0.f};
            if (seg > 0) {
#pragma unroll
                for (int kst = 0; kst < 2; ++kst) { const bf16x8 af = __builtin_bit_cast(bf16x8, *(const u32x4*)(QE + (tok0 + r16) * 256 + hd * 64 + 32 * kst + 8 * q4));
#pragma unroll
                    for (int vb = 0; vb < 4; ++vb) { const bf16x8 bfv = *(const LAS bf16x8*)(ST + (vb * 16 + r16) * 72 + 32 * kst + 8 * q4); acc[vb] = __builtin_amdgcn_mfma_f32_16x16x32_bf16(af, bfv, acc[vb], 0, 0, 0); } }
            }
            float ss[4] = {0.f, 0.f, 0.f, 0.f};
#pragma unroll
            for (int vb = 0; vb < 4; ++vb)
#pragma unroll
                for (int r = 0; r < 4; ++r) { const size_t o = (tok0 + 4 * q4 + r) * 256 + hd * 64 + vb * 16 + r16;
                    float x = acc[vb][r];
#pragma unroll
                    for (int k4 = 0; k4 < 4; ++k4) x += oraw[(size_t)k4 * T * 256 + o];
                    acc[vb][r] = x; ss[r] += x * x; }
#pragma unroll
            for (int r = 0; r < 4; ++r) { float t = ss[r]; t += __shfl_xor(t, 1); t += __shfl_xor(t, 2); t += __shfl_xor(t, 4); t += __shfl_xor(t, 8); ss[r] = 1.0f / sqrtf(t * (1.0f / 64.0f) + RMS_EPS); }
#pragma unroll
            for (int vb = 0; vb < 4; ++vb) { const float gn = inp(F, I_hgrn_gain)[l * 256 + hd * 64 + vb * 16 + r16];
#pragma unroll
                for (int r = 0; r < 4; ++r) { const size_t tok = tok0 + 4 * q4 + r; const float g = bf2f(proj[tok * NPROJ + C_GG + hd * 64 + vb * 16 + r16]);
                    const float si = g / (1.0f + expf(-g)); mixed[tok * D + 512 + hd * 64 + vb * 16 + r16] = f2bf(acc[vb][r] * ss[r] * gn * si); } }
        }
        __syncthreads();
    }
}
__device__ __forceinline__ void pool_unit(const Frame& F, int l, int u) {
    const int seg = u & 63, g = (u >> 6) & 3, b = u >> 8, lane = F.lane;
    const int w = 2 << g;
    const bf16_t* up = (const bf16_t*)(F.ws + WS_PA) + (size_t)b * SEQ * NPROJ + C_PU + g * 64 + lane;
    bf16_t* mixed = (bf16_t*)(F.ws + WS_MIXED) + (size_t)b * SEQ * D + 768 + g * 64 + lane;
    float wcol[64];
#pragma unroll
    for (int c = 0; c < 64; ++c) wcol[c] = inp(F, I_pool_w)[(((size_t)l * 4 + g) * 64 + c) * 64 + lane];
    const float psc = inp(F, I_pool_scale)[l * 256 + g * 64 + lane];
    const int t0 = seg * 64; float wsum = 0.f;
    for (int i = 1; i <= w; ++i) { const int t = t0 - i; if (t >= 0) wsum += bf2f(up[(size_t)t * NPROJ]); }
    for (int i = 0; i < 64; ++i) { const int t = t0 + i; const float ut = bf2f(up[(size_t)t * NPROJ]);
        wsum += ut; if (t - w >= 0) wsum -= bf2f(up[(size_t)(t - w) * NPROJ]);
        const float pooled = wsum / (float)((t + 1 < w) ? (t + 1) : w) - ut; float acc = 0.f;
#pragma unroll
        for (int c = 0; c < 64; ++c) acc += rdlane(pooled, c) * wcol[c];
        mixed[(size_t)t * D] = f2bf(acc * psc); }
}

struct Args { const float* in[18]; float* out; unsigned char* ws; int ph_lo, ph_hi; };
constexpr int N_PHASES = 2 + 8 * NL;

__global__ void __launch_bounds__(NTHREADS, 2) trunk_fwd(Args args) {
    extern __shared__ __attribute__((aligned(16))) unsigned char lds_raw[];
    Frame F;
    F.lds = (LAS unsigned char*)lds_raw; F.ws = args.ws; F.ctl = (unsigned*)(args.ws + WS_CTL); F.out = args.out;
    F.tid = threadIdx.x; F.lane = F.tid & 63; F.wave = __builtin_amdgcn_readfirstlane(F.tid >> 6);
    for (int u = F.tid; u < (LDS_BYTES - LDSCTL_OFF) / 4; u += NTHREADS) ((LAS unsigned*)(F.lds + LDSCTL_OFF))[u] = 0u;
    __syncthreads();
    if (F.tid == 0) {
#pragma unroll
        for (int i = 0; i < 18; ++i) ((LAS unsigned long long*)(F.lds + LDSCTL_OFF + LC_INP))[i] = (unsigned long long)args.in[i];
    }
    __syncthreads();
    const int lo = args.ph_lo, hi = args.ph_hi; const bool use_bar = (hi - lo) > 1;
    XcdBarrier bar; bar.bar = F.ctl + CW_BAR; bar.x = 0; bar.st = nullptr;
    if (use_bar) bar = xcd_barrier_post(F.ctl + CW_BAR, (volatile LAS unsigned*)(F.lds + LDSCTL_OFF + LC_BAR));
#ifndef PHMASK
#define PHMASK 0xFFFF
#endif
#define PM(b) ((PHMASK >> (b)) & 1)
#define FRESH() do { int l_ = (int)__builtin_amdgcn_mbcnt_hi(~0u, __builtin_amdgcn_mbcnt_lo(~0u, 0u)); asm volatile("" : "+v"(l_)); F.lane = l_; F.tid = F.wave * 64 + l_; int b_ = blockIdx.x, g_ = gridDim.x; asm volatile("" : "+s"(b_), "+s"(g_)); F.bid = b_; F.G = g_; } while (0)
#define IN(k) (lo <= (k) && (k) < hi)
#define SEAM(k) do { if (use_bar && (k) + 1 < hi) xcd_barrier(bar, F.tid == 0); } while (0)
    if (IN(0) && PM(0)) { FRESH(); p0_prologue(F); SEAM(0); }
    for (int l = 0; l < NL; ++l) {
        const int pb = 1 + 8 * l;
        if (IN(pb + 0) && PM(1)) { FRESH(); if (l == 0) r_phase<0, false, false>(F, l, inp(F, I_x), F.out); else r_phase<0, true, true>(F, l, F.out, F.out); SEAM(pb + 0); }
        if (IN(pb + 1) && PM(2)) { FRESH();
            cumsum_step(F);
            pg8::StaticOrder S; S.init(T, NPROJ, D, F.G, F.bid, (const bf16_t*)(F.ws + WS_WIN + l * WIN_BYTES));
            pg8::EpiProj E{(bf16_t*)(F.ws + WS_PA), (const float*)(F.ws + WS_RSTD1), F.ctl + CW_KMAX + l * 64 * 16};
            pg8::gemm_phase<pg8::EpiProj, pg8::StaticOrder, true>(F.tid, F.lds, (const bf16_t*)(F.ws + WS_HB), D, S, E);
            SEAM(pb + 1);
        }
        if (IN(pb + 2) && PM(3)) { FRESH();
            const int gw = F.bid * NWAVES + F.wave, NGW = F.G * NWAVES;
            for (int u = gw; u < 2048; u += NGW) hg_seg_unit(F, l, u);
            for (int u = gw; u < 2048; u += NGW) pool_unit(F, l, u);
            __syncthreads();
            for (int u = F.bid; u < 1024; u += F.G) { const int c = u & 255, i = u >> 8, bh = c >> 2, s = c & 3, qb = (i == 0) ? s : (i == 1) ? 7 - s : (i == 2) ? 8 + s : 15 - s;
                attn_unit(F, l, bh >> 3, bh & 7, qb); }
            SEAM(pb + 2);
        }
        if (IN(pb + 3) && PM(4)) { FRESH(); hg_fix_phase(F, l); SEAM(pb + 3); }
        if (IN(pb + 4) && PM(5)) { FRESH();
            pg8::StaticOrder S; S.init(T, D, D, F.G, F.bid, (const bf16_t*)(F.ws + WS_WOUT + l * WOUT_BYTES));
            pg8::EpiOut E{l == 0 ? inp(F, I_x) : F.out, F.out};
            pg8::gemm_phase<pg8::EpiOut, pg8::StaticOrder, true>(F.tid, F.lds, (const bf16_t*)(F.ws + WS_MIXED), D, S, E);
            SEAM(pb + 4);
        }
        if (IN(pb + 5) && PM(6)) { FRESH(); r_phase<1, false, false>(F, l, F.out, F.out); SEAM(pb + 5); }
        if ((IN(pb + 6) && PM(7)) || (IN(pb + 7) && PM(8))) { FRESH();
            LAS int* tb = (LAS int*)(F.lds + LDSCTL_OFF + LC_TB); LAS int* cn = (LAS int*)(F.lds + LDSCTL_OFF + LC_CN);
            if (F.tid < NE) cn[F.tid] = (int)__hip_atomic_load(F.ctl + CW_CUR + (l * NE + F.tid) * 16, __ATOMIC_RELAXED, __HIP_MEMORY_SCOPE_AGENT);
            __syncthreads();
            if (F.tid == 0) { int a = 0; for (int e = 0; e < NE; ++e) { tb[e] = a; a += (cn[e] + 255) >> 8; } tb[NE] = a; }
            __syncthreads();
            const int ntile = tb[NE];
            if (IN(pb + 6) && PM(7)) {
                pg8::MoeOrder<true> S; S.nM = ntile; S.nN = 2 * FF / 256; S.nwg = S.nM * S.nN; S.G = F.G; S.c = F.bid; S.Wt = (const char*)(F.ws + WS_W1 + (size_t)l * NE * W1E_BYTES); S.estride = W1E_BYTES; S.tstep = (size_t)256 * D * 2;
                S.tb = tb; S.cn = cn; S.list = (const u32x2*)(F.ws + WS_LIST);
                pg8::EpiGlu E{(bf16_t*)(F.ws + WS_PA), (const u32x2*)(F.ws + WS_LIST), (const float*)(F.ws + WS_B1R) + (size_t)l * NE * 2048};
                pg8::gemm_phase<pg8::EpiGlu, pg8::MoeOrder<true>, true>(F.tid, F.lds, (const bf16_t*)(F.ws + WS_HB), D, S, E);
                SEAM(pb + 6);
            }
            if (IN(pb + 7) && PM(8)) { FRESH();
                pg8::MoeOrder<false> S; S.nM = ntile; S.nN = D / 256; S.nwg = S.nM * S.nN; S.G = F.G; S.c = F.bid; S.Wt = (const char*)(F.ws + WS_W2 + (size_t)l * NE * W2E_BYTES); S.estride = W2E_BYTES; S.tstep = (size_t)256 * FF * 2;
                S.tb = tb; S.cn = cn; S.list = (const u32x2*)(F.ws + WS_LIST);
                pg8::EpiDown E{(bf16_t*)(F.ws + WS_Y), (const u32x2*)(F.ws + WS_LIST), (const float*)(F.ws + WS_GATE), inp(F, I_b2) + (size_t)l * NE * D};
                pg8::gemm_phase<pg8::EpiDown, pg8::MoeOrder<false>, true>(F.tid, F.lds, (const bf16_t*)(F.ws + WS_PA), FF, S, E);
                SEAM(pb + 7);
            }
        }
    }
    if (IN(N_PHASES - 1) && PM(9)) { FRESH(); r_final(F); }
#undef IN
#undef SEAM
}

extern "C" void kernel_launch(void* const* d_in, const int* in_sizes, int n_in, void* d_out, int out_size, void* d_ws, size_t ws_size, hipStream_t stream) {
    static int grid = 0;
    if (grid == 0) {
        if (n_in != 18 || out_size != T * D || ws_size < WS_END) { fprintf(stderr, "kernel_launch: unexpected shapes (n_in %d out %d ws %zu need %zu)\n", n_in, out_size, ws_size, (size_t)WS_END); grid = -1; return; }
        int dev = 0, cus = 0;
        if (hipGetDevice(&dev) != hipSuccess || hipDeviceGetAttribute(&cus, hipDeviceAttributeMultiprocessorCount, dev) != hipSuccess) { grid = -1; return; }
        if (hipFuncSetAttribute((const void*)trunk_fwd, hipFuncAttributeMaxDynamicSharedMemorySize, LDS_BYTES) != hipSuccess) { fprintf(stderr, "kernel_launch: hipFuncSetAttribute failed\n"); grid = -1; return; }
        int per_cu = 0;
        if (hipOccupancyMaxActiveBlocksPerMultiprocessor(&per_cu, (const void*)trunk_fwd, NTHREADS, LDS_BYTES) != hipSuccess || per_cu < 1) { fprintf(stderr, "kernel_launch: occupancy query says %d\n", per_cu); (void)hipGetLastError(); }
        grid = cus;
    }
    if (grid < 0) return;
    (void)hipMemsetAsync((char*)d_ws + WS_CTL, 0, CTL_ZERO_BYTES, stream);
    Args a{};
    for (int i = 0; i < 18; ++i) a.in[i] = (const float*)d_in[i];
    a.out = (float*)d_out; a.ws = (unsigned char*)d_ws;
#if MK_SPLIT
    for (int p = 0; p < N_PHASES; ++p) { a.ph_lo = p; a.ph_hi = p + 1; hipLaunchKernelGGL(trunk_fwd, dim3(grid), dim3(NTHREADS), LDS_BYTES, stream, a); }
#else
    a.ph_lo = 0; a.ph_hi = N_PHASES; hipLaunchKernelGGL(trunk_fwd, dim3(grid), dim3(NTHREADS), LDS_BYTES, stream, a);
#endif
}
```

```cpp
#include <hip/hip_runtime.h>
#include <cstdio>
#include <cstdint>

#ifndef MK_SPLIT
#define MK_SPLIT 0
#endif

#define LAS __attribute__((address_space(3)))
#define GAS __attribute__((address_space(1)))
typedef unsigned short bf16_t;
typedef short bf16x8 __attribute__((ext_vector_type(8)));
typedef float f32x4 __attribute__((ext_vector_type(4)));
typedef float f32x2 __attribute__((ext_vector_type(2)));
typedef float f32x16 __attribute__((ext_vector_type(16)));
typedef unsigned u32x4 __attribute__((ext_vector_type(4)));
typedef unsigned u32x2 __attribute__((ext_vector_type(2)));
typedef __bf16 bf16x2_t __attribute__((ext_vector_type(2)));
typedef short v4i16_t __attribute__((ext_vector_type(4)));

constexpr int NB = 8, SEQ = 4096, T = NB * SEQ, D = 1024, NL = 4;
constexpr int NPROJ = 2816;
constexpr int C_FQ = 0, C_FK = 512, C_FV = 1024, C_GQ = 1536, C_GF = 1792, C_GI = 2048, C_GG = 2304, C_PU = 2560;
constexpr int IN_COLS = 2824;
constexpr int NE = 32, TOPK = 4, FF = 1024, MROWS = T * TOPK, LISTCAP = MROWS, MAXTILES = MROWS / 256 + NE;
constexpr float RMS_EPS = 1e-5f, LOG2E = 1.4426950408889634f;
constexpr float QSCALE = 0.125f * LOG2E;
constexpr int NWAVES = 8, NTHREADS = 512;

constexpr size_t MiB = 1u << 20;
constexpr size_t WS_CTL = 0, CTL_ZERO_BYTES = 1 * MiB;
constexpr size_t WS_RSTD1 = 1 * MiB, WS_RSTD2 = WS_RSTD1 + 128 * 1024;
constexpr size_t WS_LOGF = 2 * MiB, WS_C2 = 3 * MiB, WS_GATE = 4 * MiB, WS_B1R = 5 * MiB, WS_WFRAG = 6 * MiB, WS_LIST = 8 * MiB;
constexpr size_t WS_WIN = 40 * MiB, WIN_BYTES = (size_t)NPROJ * D * 2;
constexpr size_t WS_WOUT = 62 * MiB, WOUT_BYTES = (size_t)D * D * 2;
constexpr size_t WS_W1 = 70 * MiB, W1E_BYTES = (size_t)2 * FF * D * 2;
constexpr size_t WS_W2 = 582 * MiB, W2E_BYTES = (size_t)D * FF * 2;
constexpr size_t WS_HB = 838 * MiB;
constexpr size_t WS_PA = 902 * MiB;
constexpr size_t WS_MIXED = WS_PA + 176 * MiB;
constexpr size_t WS_Y = 1174 * MiB;
constexpr size_t WS_ORAW = 1430 * MiB;
constexpr size_t WS_SEND = 1558 * MiB;
constexpr size_t WS_PSEG = 1566 * MiB;
constexpr size_t WS_QE = 1567 * MiB;
constexpr size_t WS_PWT = 1583 * MiB;
constexpr size_t WS_END = 1584 * MiB;
static_assert(WS_WIN + NL * WIN_BYTES <= WS_WOUT && WS_WOUT + NL * WOUT_BYTES <= WS_W1 && WS_W1 + (size_t)NL * NE * W1E_BYTES <= WS_W2 && WS_W2 + (size_t)NL * NE * W2E_BYTES <= WS_HB, "ws map");
static_assert((size_t)MAXTILES * 256 * FF * 2 <= 272 * MiB && (size_t)T * NPROJ * 2 <= 176 * MiB, "ws map 2");
constexpr int CW_TMO = 0, CW_BAR = 4096, CW_CUR = 16384, CW_KMAX = 32768;
constexpr int PH_BYTES = 139264, LDSCTL_OFF = PH_BYTES, LDS_BYTES = PH_BYTES + 2048;
constexpr int LC_BAR = 0, LC_TB = 64, LC_CN = 256, LC_R2CNT = 512, LC_R2BASE = 640, LC_STOP = 768, LC_SCAN = 896, LC_INP = 1024;

__device__ __forceinline__ unsigned cvtpk(float lo, float hi) { f32x2 v = {lo, hi}; bf16x2_t b = __builtin_convertvector(v, bf16x2_t); return __builtin_bit_cast(unsigned, b); }
__device__ __forceinline__ float bflo(unsigned w) { return __uint_as_float(w << 16); }
__device__ __forceinline__ float bfhi(unsigned w) { return __uint_as_float(w & 0xffff0000u); }
__device__ __forceinline__ float bf2f(bf16_t h) { return __uint_as_float((unsigned)h << 16); }
__device__ __forceinline__ bf16_t f2bf(float f) { return (bf16_t)(cvtpk(f, 0.f) & 0xffffu); }
__device__ __forceinline__ float rdlane(float v, int l) { return __uint_as_float((unsigned)__builtin_amdgcn_readlane((int)__float_as_uint(v), l)); }
#define LDS_WAIT() asm volatile("s_waitcnt lgkmcnt(0)" ::: "memory")
#define VM_WAIT() asm volatile("s_waitcnt vmcnt(0)" ::: "memory")

namespace pg8 {
constexpr int BM = 256, BK = 64, HALF = 128, HTB = HALF * BK * 2, STAGE_BYTES = 8 * HTB, NXCD = 8, WGM = 8;
__host__ __device__ __forceinline__ int lds_byte(int r, int c) { const int st = (r >> 4) * 2 + (c >> 5), rr = r & 15, cc = c & 31, ob = rr * 64 + cc * 2; return st * 1024 + (ob ^ (((ob >> 9) & 1) << 5)); }
__host__ __device__ __forceinline__ void stage_rc(int b, int& R, int& C) { const int st = b / 1024, sb = b % 1024, swz = sb ^ (((sb >> 9) & 1) << 5); R = (st >> 1) * 16 + swz / 64; C = (st & 1) * 32 + (swz % 64) / 2; }
__host__ __device__ __forceinline__ int perm32(int rho) { const int n = rho >> 4, i = rho & 15; return 8 * (i >> 2) + 4 * n + (i & 3); }

struct Unit { int pm, pn, e, lt, cnt; };

__device__ __forceinline__ void tile_of(int L, int nM, int nN, int& pm, int& pn) {
    const int nwg = nM * nN; int wgid = L;
    { const int q = nwg / NXCD, r = nwg % NXCD, xcd = wgid % NXCD, off = wgid / NXCD; wgid = (xcd < r ? xcd * (q + 1) : r * (q + 1) + (xcd - r) * q) + off; }
    const int nig = WGM * nN, gid = wgid / nig, fm = gid * WGM, gsz = (nM - fm) < WGM ? (nM - fm) : WGM;
    pm = fm + ((wgid % nig) % gsz); pn = (wgid % nig) / gsz;
}
struct StaticOrder {
    int nM, nN, nwg, G, c, rep = 1; const char* Bt; size_t tstep;
    __device__ void init(int M, int N, int K, int G_, int c_, const bf16_t* Bt_) { nM = M / BM; nN = N / BM; nwg = nM * nN; G = G_; c = c_; Bt = (const char*)Bt_; tstep = (size_t)BM * K * 2; }
    __device__ __forceinline__ bool next(int i, Unit& u) const { long L = (long)i * G + c; if (L >= (long)nwg * rep) return false; L %= nwg; tile_of((int)L, nM, nN, u.pm, u.pn); u.e = 0; u.lt = 0; u.cnt = 0; return true; }
    __device__ __forceinline__ const char* bbase(const Unit& u) const { return Bt + (size_t)u.pn * tstep; }
    __device__ __forceinline__ int arow(const Unit& u, int r) const { return u.pm * BM + r; }
};
template <bool GATHER> struct MoeOrder {
    int nM, nN, nwg, G, c, rep = 1; const char* Wt; size_t estride, tstep; LAS const int* tb; LAS const int* cn; const u32x2* list;
    __device__ __forceinline__ bool next(int i, Unit& u) const {
        long L = (long)i * G + c; if (L >= (long)nwg * rep) return false; L %= nwg; tile_of((int)L, nM, nN, u.pm, u.pn);
        int e = 0; while (e < NE - 1 && tb[e + 1] <= u.pm) ++e;
        u.e = e; u.lt = u.pm - tb[e]; u.cnt = cn[e]; return true; }
    __device__ __forceinline__ const char* bbase(const Unit& u) const { return Wt + (size_t)u.e * estride + (size_t)u.pn * tstep; }
    __device__ __forceinline__ int arow(const Unit& u, int r) const {
        if (!GATHER) return u.pm * BM + r;
        const int pos = u.lt * BM + r; return pos < u.cnt ? (int)(list[(size_t)u.e * LISTCAP + pos].x >> 2) : 0; }
};

template <class Epi, class Sched, bool ALIGN_EPI>
__device__ __forceinline__ void gemm_phase(const int tid, LAS unsigned char* lds, const bf16_t* Abase, const int K, const Sched& S, const Epi& E) {
    const int wid = __builtin_amdgcn_readfirstlane(tid >> 6), lane = tid & 63, wr = wid >> 2, wc = wid & 3, fr = lane & 15, fq = lane >> 4;
    const int nt = K / BK;
    unsigned voffB[2];
#pragma unroll
    for (int i = 0; i < 2; ++i) { int R, C; stage_rc(tid * 16 + i * 8192, R, C); const int Rb = Epi::PERM ? ((R & ~31) + perm32(R & 31)) : R; voffB[i] = (unsigned)(Rb * K + C) * 2u; }
    const size_t kstep = (size_t)(BK * 2);
    const size_t hstep = (size_t)HALF * K * 2;
    const unsigned ldsw = (unsigned)wid * 1024u;
    const int aoff = lds_byte(wr * 64 + fr, fq * 8), boff = lds_byte(wc * 32 + fr, fq * 8);
    const char* A8 = (const char*)Abase;
#define PG8_SA(b, h) (((b) * 2 + (h)) * HTB)
#define PG8_SB(b, h) ((4 + (b) * 2 + (h)) * HTB)
#define PG8_STGB(bufoff, gbase) do { _Pragma("unroll") for (int _i = 0; _i < 2; ++_i) \
        __builtin_amdgcn_global_load_lds((const unsigned*)((const char*)(gbase) + voffB[_i]), (LAS unsigned*)(lds + (bufoff) + ldsw + _i * 8192), 16, 0, 0); } while (0)
#define PG8_STGA(bufoff, kb, o0, o1) do { \
        __builtin_amdgcn_global_load_lds((const unsigned*)(A8 + (size_t)(kb) + (o0)), (LAS unsigned*)(lds + (bufoff) + ldsw), 16, 0, 0); \
        __builtin_amdgcn_global_load_lds((const unsigned*)(A8 + (size_t)(kb) + (o1)), (LAS unsigned*)(lds + (bufoff) + ldsw + 8192), 16, 0, 0); } while (0)
#define PG8_LDA(dst, b, h) do { _Pragma("unroll") for (int m = 0; m < 4; ++m) _Pragma("unroll") for (int k = 0; k < 2; ++k) dst[m][k] = *(const LAS bf16x8*)(lds + PG8_SA(b, h) + aoff + m * 2048 + k * 1024); } while (0)
#define PG8_LDB(dst, b, h) do { _Pragma("unroll") for (int n = 0; n < 2; ++n) _Pragma("unroll") for (int k = 0; k < 2; ++k) dst[n][k] = *(const LAS bf16x8*)(lds + PG8_SB(b, h) + boff + n * 2048 + k * 1024); } while (0)
#define PG8_MMA(ai, bj, At, Bt) do { __builtin_amdgcn_s_setprio(1); _Pragma("unroll") for (int m = 0; m < 4; ++m) _Pragma("unroll") for (int n = 0; n < 2; ++n) _Pragma("unroll") for (int k = 0; k < 2; ++k) \
        acc[ai][bj][m][n] = __builtin_amdgcn_mfma_f32_16x16x32_bf16(Bt[n][k], At[m][k], acc[ai][bj][m][n], 0, 0, 0); __builtin_amdgcn_s_setprio(0); } while (0)
#define PG8_WAIT_V(n) asm volatile("s_waitcnt vmcnt(" #n ")" ::: "memory")
#define PG8_WAIT_L(n) asm volatile("s_waitcnt lgkmcnt(" #n ")" ::: "memory")
#define PG8_BAR __builtin_amdgcn_s_barrier()
#define PG8_SCHED __builtin_amdgcn_sched_barrier(0)
#define PG8_AOFF(u, dst) do { _Pragma("unroll") for (int _h = 0; _h < 2; ++_h) _Pragma("unroll") for (int _i = 0; _i < 2; ++_i) \
        { int R_, C_; stage_rc(tid * 16 + _i * 8192, R_, C_); dst[_h][_i] = (unsigned)((size_t)S.arow(u, _h * HALF + R_) * (size_t)K + (size_t)C_) * 2u; } } while (0)
    Unit cur, nxt; int ui = 0;
    if (!S.next(0, cur)) return;
    f32x4 acc[2][2][4][2];
#pragma unroll
    for (int a = 0; a < 2; ++a)
#pragma unroll
        for (int b = 0; b < 2; ++b)
#pragma unroll
            for (int m = 0; m < 4; ++m)
#pragma unroll
                for (int n = 0; n < 2; ++n) acc[a][b][m][n] = (f32x4){0.f, 0.f, 0.f, 0.f};
    bf16x8 At[4][2], B0[2][2], B1[2][2];
    unsigned aoC[2][2], aoN[2][2];
    PG8_AOFF(cur, aoC);
    const char* cB = S.bbase(cur);
    PG8_STGB(PG8_SB(0, 0), cB); PG8_STGB(PG8_SB(0, 1), cB + hstep); PG8_STGA(PG8_SA(0, 0), 0, aoC[0][0], aoC[0][1]); PG8_STGA(PG8_SA(0, 1), 0, aoC[1][0], aoC[1][1]);
    if (wr == 1) PG8_BAR;
    PG8_WAIT_V(2); PG8_BAR;
    PG8_STGB(PG8_SB(1, 0), cB + kstep); PG8_STGA(PG8_SA(1, 0), kstep, aoC[0][0], aoC[0][1]); PG8_STGB(PG8_SB(1, 1), cB + hstep + kstep);
    PG8_WAIT_V(6); PG8_BAR;
    for (;;) {
        const bool has_next = S.next(ui + 1, nxt);
        if (has_next) { PG8_AOFF(nxt, aoN); } else { aoN[0][0] = aoC[0][0]; aoN[0][1] = aoC[0][1]; aoN[1][0] = aoC[1][0]; aoN[1][1] = aoC[1][1]; }
        const char* nB = has_next ? S.bbase(nxt) : cB;
        for (int t = 0; t < nt; t += 2) {
            const bool last = (t == nt - 2);
            const size_t k1 = (size_t)(t + 1) * kstep, k2 = last ? 0 : (size_t)(t + 2) * kstep, k3 = k2 + kstep;
            const char* b2 = last ? nB : cB + (size_t)(t + 2) * kstep; const char* b3 = b2 + kstep;
            const unsigned a200 = last ? aoN[0][0] : aoC[0][0], a201 = last ? aoN[0][1] : aoC[0][1], a210 = last ? aoN[1][0] : aoC[1][0], a211 = last ? aoN[1][1] : aoC[1][1];
            PG8_LDB(B0, 0, 0); PG8_LDB(B1, 0, 1); PG8_SCHED; PG8_LDA(At, 0, 0); PG8_STGA(PG8_SA(1, 1), k1, aoC[1][0], aoC[1][1]);
            PG8_WAIT_V(8); PG8_WAIT_L(0); PG8_BAR; PG8_MMA(0, 0, At, B0); PG8_MMA(0, 1, At, B1); PG8_BAR; PG8_SCHED;
            PG8_LDA(At, 0, 1); PG8_STGB(PG8_SB(0, 0), b2); PG8_STGB(PG8_SB(0, 1), b2 + hstep); PG8_STGA(PG8_SA(0, 0), k2, a200, a201);
            PG8_WAIT_V(8); PG8_WAIT_L(0); PG8_BAR; PG8_MMA(1, 0, At, B0); PG8_MMA(1, 1, At, B1); PG8_BAR; PG8_SCHED;
            PG8_LDB(B0, 1, 0); PG8_LDB(B1, 1, 1); PG8_SCHED; PG8_LDA(At, 1, 0); PG8_STGA(PG8_SA(0, 1), k2, a210, a211);
            PG8_WAIT_V(8); PG8_WAIT_L(0); PG8_BAR; PG8_MMA(0, 0, At, B0); PG8_MMA(0, 1, At, B1); PG8_BAR; PG8_SCHED;
            PG8_LDA(At, 1, 1); PG8_STGB(PG8_SB(1, 0), b3); PG8_STGB(PG8_SB(1, 1), b3 + hstep); PG8_STGA(PG8_SA(1, 0), k3, a200, a201);
            PG8_WAIT_V(8); PG8_WAIT_L(0); PG8_BAR; PG8_MMA(1, 0, At, B0); PG8_MMA(1, 1, At, B1); PG8_BAR; PG8_SCHED;
        }
        if constexpr (ALIGN_EPI) { if (wr == 0) PG8_BAR; }
        E(acc, cur, wr, wc, fr, fq);
        if (!has_next) break;
#pragma unroll
        for (int a = 0; a < 2; ++a)
#pragma unroll
            for (int b = 0; b < 2; ++b)
#pragma unroll
                for (int m = 0; m < 4; ++m)
#pragma unroll
                    for (int n = 0; n < 2; ++n) acc[a][b][m][n] = (f32x4){0.f, 0.f, 0.f, 0.f};
        cur = nxt; cB = nB; ++ui;
        aoC[0][0] = aoN[0][0]; aoC[0][1] = aoN[0][1]; aoC[1][0] = aoN[1][0]; aoC[1][1] = aoN[1][1];
        if constexpr (ALIGN_EPI) { if (wr == 1) PG8_BAR; }
    }
    PG8_WAIT_V(0);
    if constexpr (!ALIGN_EPI) { if (wr == 0) PG8_BAR; }
    PG8_BAR;
#undef PG8_SA
#undef PG8_SB
#undef PG8_STGA
#undef PG8_STGB
#undef PG8_LDA
#undef PG8_LDB
#undef PG8_MMA
#undef PG8_WAIT_V
#undef PG8_WAIT_L
#undef PG8_BAR
#undef PG8_SCHED
#undef PG8_AOFF
}

struct EpiProj {
    static constexpr bool PERM = true;
    bf16_t* O; const float* rstd; unsigned* kmax;
    __device__ __forceinline__ void operator()(const f32x4 (&acc)[2][2][4][2], const Unit& u, int wr, int wc, int fr, int fq) const {
        const int row0 = u.pm * BM + wr * 64 + fr, col0 = u.pn * BM + wc * 32 + 8 * fq;
        const float sc = (u.pn < 2) ? QSCALE : 1.f; const bool isk = (u.pn == 2 || u.pn == 3);
        float km[2] = {0.f, 0.f};
#pragma unroll
        for (int ai = 0; ai < 2; ++ai)
#pragma unroll
            for (int m = 0; m < 4; ++m) { const int row = row0 + ai * HALF + m * 16; const float rs = rstd[row] * sc; bf16_t* rowp = O + (size_t)row * NPROJ + col0;
#pragma unroll
                for (int bj = 0; bj < 2; ++bj) { const f32x4 v0 = acc[ai][bj][m][0] * rs, v1 = acc[ai][bj][m][1] * rs;
                    u32x4 w; w.x = cvtpk(v0[0], v0[1]); w.y = cvtpk(v0[2], v0[3]); w.z = cvtpk(v1[0], v1[1]); w.w = cvtpk(v1[2], v1[3]);
                    *(u32x4*)(rowp + bj * HALF) = w;
                    if (isk) { float s = bflo(w.x) * bflo(w.x) + bfhi(w.x) * bfhi(w.x) + bflo(w.y) * bflo(w.y) + bfhi(w.y) * bfhi(w.y) + bflo(w.z) * bflo(w.z) + bfhi(w.z) * bfhi(w.z) + bflo(w.w) * bflo(w.w) + bfhi(w.w) * bfhi(w.w);
                        s += __shfl_xor(s, 16); s += __shfl_xor(s, 32); km[bj] = fmaxf(km[bj], s); } } }
        if (isk) {
#pragma unroll
            for (int bj = 0; bj < 2; ++bj) { float v = km[bj]; v = fmaxf(v, __shfl_xor(v, 1)); v = fmaxf(v, __shfl_xor(v, 2)); v = fmaxf(v, __shfl_xor(v, 4)); v = fmaxf(v, __shfl_xor(v, 8));
                if ((threadIdx.x & 63) == 0) { const int b = u.pm >> 4, h = (u.pn - 2) * 4 + bj * 2 + (wc >> 1); atomicMax(kmax + (b * 8 + h) * 16, __float_as_uint(v)); } }
        }
    }
};
struct EpiOut {
    static constexpr bool PERM = false;
    const float* res; float* out;
    __device__ __forceinline__ void operator()(const f32x4 (&acc)[2][2][4][2], const Unit& u, int wr, int wc, int fr, int fq) const {
        const int row0 = u.pm * BM + wr * 64 + fr, col0 = u.pn * BM + wc * 32 + 4 * fq;
#pragma unroll
        for (int ai = 0; ai < 2; ++ai)
#pragma unroll
            for (int m = 0; m < 4; ++m) { const size_t off = (size_t)(row0 + ai * HALF + m * 16) * D + col0;
#pragma unroll
                for (int bj = 0; bj < 2; ++bj)
#pragma unroll
                    for (int n = 0; n < 2; ++n) { const f32x4 r = *(const f32x4*)(res + off + bj * HALF + n * 16); *(f32x4*)(out + off + bj * HALF + n * 16) = r + acc[ai][bj][m][n]; } }
    }
};
struct EpiGlu {
    static constexpr bool PERM = true;
    bf16_t* act; const u32x2* list; const float* b1r;
    __device__ __forceinline__ void operator()(const f32x4 (&acc)[2][2][4][2], const Unit& u, int wr, int wc, int fr, int fq) const {
        const int cb = u.pn * BM + wc * 32 + 8 * fq; const float* bp = b1r + (size_t)u.e * 2048 + cb;
        const f32x4 bg0 = *(const f32x4*)(bp), bg1 = *(const f32x4*)(bp + 4), bl0 = *(const f32x4*)(bp + HALF), bl1 = *(const f32x4*)(bp + HALF + 4);
#pragma unroll
        for (int ai = 0; ai < 2; ++ai)
#pragma unroll
            for (int m = 0; m < 4; ++m) { const int r = ai * HALF + wr * 64 + m * 16 + fr, pos = u.lt * BM + r;
                float rs = 0.f; if (pos < u.cnt) rs = __uint_as_float(list[(size_t)u.e * LISTCAP + pos].y);
                f32x4 g0 = acc[ai][0][m][0] * rs + bg0, g1 = acc[ai][0][m][1] * rs + bg1, l0 = acc[ai][1][m][0] * rs + bl0, l1 = acc[ai][1][m][1] * rs + bl1;
                float o[8];
#pragma unroll
                for (int j = 0; j < 8; ++j) { float g = j < 4 ? g0[j & 3] : g1[j & 3], li = j < 4 ? l0[j & 3] : l1[j & 3];
                    g = fminf(g, 7.f); li = fminf(fmaxf(li, -7.f), 7.f);
                    const float sg = __builtin_amdgcn_rcpf(1.f + __builtin_amdgcn_exp2f(-1.702f * LOG2E * g)); o[j] = g * sg * (li + 1.f); }
                u32x4 w; w.x = cvtpk(o[0], o[1]); w.y = cvtpk(o[2], o[3]); w.z = cvtpk(o[4], o[5]); w.w = cvtpk(o[6], o[7]);
                *(u32x4*)(act + (size_t)(u.pm * BM + r) * FF + u.pn * HALF + wc * 32 + 8 * fq) = w; }
    }
};
struct EpiDown {
    static constexpr bool PERM = true;
    bf16_t* Y; const u32x2* list; const float* gate; const float* b2;
    __device__ __forceinline__ void operator()(const f32x4 (&acc)[2][2][4][2], const Unit& u, int wr, int wc, int fr, int fq) const {
        const int cb = u.pn * BM + wc * 32 + 8 * fq; const float* bp = b2 + (size_t)u.e * D + cb;
        f32x4 bv[2][2];
#pragma unroll
        for (int bj = 0; bj < 2; ++bj)
#pragma unroll
            for (int n = 0; n < 2; ++n) bv[bj][n] = *(const f32x4*)(bp + bj * HALF + 4 * n);
#pragma unroll
        for (int ai = 0; ai < 2; ++ai)
#pragma unroll
            for (int m = 0; m < 4; ++m) { const int r = ai * HALF + wr * 64 + m * 16 + fr, pos = u.lt * BM + r;
                if (pos < u.cnt) { const unsigned ent = list[(size_t)u.e * LISTCAP + pos].x; const float gt = gate[ent]; bf16_t* rowp = Y + (size_t)ent * D + cb;
#pragma unroll
                    for (int bj = 0; bj < 2; ++bj) { const f32x4 v0 = (acc[ai][bj][m][0] + bv[bj][0]) * gt, v1 = (acc[ai][bj][m][1] + bv[bj][1]) * gt;
                        u32x4 w; w.x = cvtpk(v0[0], v0[1]); w.y = cvtpk(v0[2], v0[3]); w.z = cvtpk(v1[0], v1[1]); w.w = cvtpk(v1[2], v1[3]);
                        *(u32x4*)(rowp + bj * HALF) = w; } } }
    }
};
}

#define XB_TMO      128
#define XB_XCNT(j)  (256  + 64 * (j))
#define XB_XSUB(j)  (1280 + 64 * (j))
#define XB_XGEN(j)  (2304 + 64 * (j))
#define XB_TOP      3328
#define XB_TOPGEN   3392
#define XCD_BAR_WORDS 3456
#define XB_SPIN_CAP (1u << 18)
__device__ __forceinline__ unsigned xb_ld(unsigned* p)              { return __hip_atomic_load(p, __ATOMIC_RELAXED, __HIP_MEMORY_SCOPE_AGENT); }
__device__ __forceinline__ unsigned xb_add(unsigned* p, unsigned v) { return __hip_atomic_fetch_add(p, v, __ATOMIC_RELAXED, __HIP_MEMORY_SCOPE_AGENT); }
__device__ __forceinline__ unsigned xb_xcc_id() { return (unsigned)__builtin_amdgcn_s_getreg((3 << 11) | 20) & 0xFu; }
#define XB_SPIN(cond, bar) do { unsigned _sp = 0; while (cond) { __builtin_amdgcn_s_sleep(1); \
    if ((++_sp & 255u) == 0u) { if (xb_ld(&(bar)[XB_TMO])) break; if (_sp > XB_SPIN_CAP) { atomicAdd(&(bar)[XB_TMO], 1u); break; } } } } while (0)
struct XcdBarrier { unsigned* bar; unsigned x; volatile LAS unsigned* st; };
__device__ __forceinline__ XcdBarrier xcd_barrier_post(unsigned* bar, volatile LAS unsigned* st) {
    XcdBarrier b; b.bar = bar; b.x = xb_xcc_id(); b.st = st;
    if (threadIdx.x == 0) (void)xb_add(&bar[XB_XCNT(b.x)], 1u);
    return b;
}
__device__ __forceinline__ void xcd_barrier_complete(unsigned* bar, unsigned x, unsigned& nloc, unsigned& nx) {
    const unsigned G = gridDim.x * gridDim.y * gridDim.z;
    unsigned sum, cnt, mine, sp = 0u;
    for (;;) {
        sum = 0u; cnt = 0u; mine = 0u;
#pragma unroll
        for (unsigned j = 0; j < 16; ++j) { const unsigned c = xb_ld(&bar[XB_XCNT(j)]); sum += c; cnt += (c > 0u) ? 1u : 0u; mine = (j == x) ? c : mine; }
        if (sum == G) break;
        __builtin_amdgcn_s_sleep(1);
        if ((++sp & 255u) == 0u) { if (xb_ld(&bar[XB_TMO])) break; if (sp > XB_SPIN_CAP) { atomicAdd(&bar[XB_TMO], 1u); break; } }
    }
    nloc = mine > 0u ? mine : 1u; nx = cnt > 0u ? cnt : 1u;
}
__device__ __forceinline__ void xcd_barrier(const XcdBarrier& b, const bool leader  ) {
    asm volatile("s_waitcnt vmcnt(0)" ::: "memory");
    __syncthreads();
    if (leader) {
        unsigned* bar = b.bar;
        __builtin_amdgcn_s_waitcnt(0);
        unsigned nloc = b.st[0], nx = b.st[1];
        if (nloc == 0u) { xcd_barrier_complete(bar, b.x, nloc, nx); b.st[0] = nloc; b.st[1] = nx; }
        const unsigned old = xb_add(&bar[XB_XSUB(b.x)], 1u);
        const unsigned gen = old / nloc;
        if (old + 1u == (gen + 1u) * nloc) {
            __builtin_amdgcn_fence(__ATOMIC_RELEASE, "agent");
            asm volatile("s_waitcnt vmcnt(0)" ::: "memory");
            const unsigned og = xb_add(&bar[XB_TOP], 1u);
            const unsigned tg = og / nx;
            if (og + 1u == (tg + 1u) * nx) xb_add(&bar[XB_TOPGEN], 1u);
            else XB_SPIN(xb_ld(&bar[XB_TOPGEN]) == tg, bar);
            __builtin_amdgcn_fence(__ATOMIC_ACQUIRE, "agent");
            xb_add(&bar[XB_XGEN(b.x)], 1u);
            asm volatile("s_waitcnt vmcnt(0)" ::: "memory");
        } else {
            XB_SPIN(xb_ld(&bar[XB_XGEN(b.x)]) == gen, bar);
            __builtin_amdgcn_fence(__ATOMIC_ACQUIRE, "agent");
            asm volatile("s_waitcnt vmcnt(0)" ::: "memory");
        }
    }
    __syncthreads();
}

enum { I_x = 0, I_norm_mix, I_w_in, I_b_fox_f, I_fox_gain, I_hgrn_lb, I_hgrn_gain, I_pool_w, I_pool_scale, I_w_out, I_norm_moe, I_w_router, I_b_router, I_w1, I_b1, I_w2, I_b2, I_norm_final };
struct Frame {
    LAS unsigned char* lds; unsigned char* ws; unsigned* ctl; float* out;
    int tid, lane, wave, bid, G;
};
__device__ __forceinline__ const float* inp(const Frame& F, int i) {
    const LAS unsigned* p = (const LAS unsigned*)(F.lds + LDSCTL_OFF + LC_INP) + 2 * i;
    const unsigned lo = __builtin_amdgcn_readfirstlane(p[0]), hi = __builtin_amdgcn_readfirstlane(p[1]);
    return (const float*)(((unsigned long long)hi << 32) | lo);
}

constexpr int P0_ROWB = 272;
template <bool INTERLEAVED>
__device__ __forceinline__ void p0_item(const float* src  , int ldn, const float* g  , bf16_t* dst  , int K, int drow0, int extra, LAS unsigned char* tile, int lane) {
    f32x4 v[16];
    const float* sp = src + (size_t)(lane >> 5) * ldn + 4 * (lane & 31);
#pragma unroll
    for (int j = 0; j < 16; ++j) v[j] = __builtin_nontemporal_load((const f32x4*)(sp + (size_t)(2 * j) * ldn));
    if (g) {
#pragma unroll
        for (int j = 0; j < 16; ++j) v[j] = v[j] * g[2 * j + (lane >> 5)];
    }
#pragma unroll
    for (int j = 0; j < 16; ++j) { const int k = 2 * j + (lane >> 5); const unsigned w0 = cvtpk(v[j][0], v[j][1]), w1 = cvtpk(v[j][2], v[j][3]);
        if (INTERLEAVED) { const unsigned gg = (w0 & 0xffffu) | (w1 << 16), ll = (w0 >> 16) | (w1 & 0xffff0000u);
            *(LAS unsigned*)(tile + k * P0_ROWB + 4 * (lane & 31)) = gg; *(LAS unsigned*)(tile + k * P0_ROWB + 128 + 4 * (lane & 31)) = ll; }
        else *(LAS u32x2*)(tile + k * P0_ROWB + 8 * (lane & 31)) = (u32x2){w0, w1}; }
    LDS_WAIT(); asm volatile("" ::: "memory");
    const int gq = lane >> 4, i16 = lane & 15;
    const LAS unsigned char* rp = tile + (8 * gq + (i16 >> 2)) * P0_ROWB + 8 * (lane & 3);
#pragma unroll
    for (int nb = 0; nb < 8; ++nb) {
        const v4i16_t lo = __builtin_amdgcn_ds_read_tr16_b64_v4i16((LAS v4i16_t*)(rp + nb * 32)), hi = __builtin_amdgcn_ds_read_tr16_b64_v4i16((LAS v4i16_t*)(rp + nb * 32 + 4 * P0_ROWB));
        const int tc = nb * 16 + i16, row = drow0 + tc + (tc >= 64 ? extra : 0);
        const bf16x8 o = (bf16x8){lo[0], lo[1], lo[2], lo[3], hi[0], hi[1], hi[2], hi[3]};
        *(bf16x8*)(dst + (size_t)row * K + 8 * gq) = o; }
    LDS_WAIT(); asm volatile("" ::: "memory");
}
__device__ __forceinline__ void p0_prologue(const Frame& F) {
    LAS unsigned char* tile = F.lds + F.wave * (32 * P0_ROWB);
    const int gw = F.bid * NWAVES + F.wave, NGW = F.G * NWAVES;
    constexpr int I_IN = 32 * 22, I_OUT = 32 * 8, I_W1 = NE * 32 * 16, I_W2 = NE * 32 * 8, I_L = I_IN + I_OUT + I_W1 + I_W2;
    for (int it = gw; it < NL * I_L; it += NGW) {
        const int l = it / I_L; int r = it % I_L;
        if (r < I_IN) { const int nb = r / 32, kb = r % 32, n0 = 128 * nb, k0 = 32 * kb;
            p0_item<false>(inp(F, I_w_in) + ((size_t)l * D + k0) * IN_COLS + n0 + (n0 >= 1536 ? 8 : 0), IN_COLS, inp(F, I_norm_mix) + l * D + k0, (bf16_t*)(F.ws + WS_WIN + l * WIN_BYTES) + k0, D, n0, 0, tile, F.lane); continue; }
        r -= I_IN;
        if (r < I_OUT) { const int nb = r / 32, kb = r % 32, n0 = 128 * nb, k0 = 32 * kb;
            p0_item<false>(inp(F, I_w_out) + ((size_t)l * D + k0) * D + n0, D, nullptr, (bf16_t*)(F.ws + WS_WOUT + l * WOUT_BYTES) + k0, D, n0, 0, tile, F.lane); continue; }
        r -= I_OUT;
        if (r < I_W1) { const int e = r / (32 * 16), q = r % (32 * 16), cb = q / 32, kb = q % 32, k0 = 32 * kb, j0 = 64 * cb;
            p0_item<true>(inp(F, I_w1) + (((size_t)l * NE + e) * D + k0) * (2 * FF) + 2 * j0, 2 * FF, inp(F, I_norm_moe) + l * D + k0, (bf16_t*)(F.ws + WS_W1 + ((size_t)l * NE + e) * W1E_BYTES) + k0, D, (j0 >> 7) * 256 + (j0 & 127), 64, tile, F.lane); continue; }
        r -= I_W1;
        { const int e = r / (32 * 8), q = r % (32 * 8), nb = q / 32, kb = q % 32, n0 = 128 * nb, k0 = 32 * kb;
            p0_item<false>(inp(F, I_w2) + (((size_t)l * NE + e) * FF + k0) * D + n0, D, nullptr, (bf16_t*)(F.ws + WS_W2 + ((size_t)l * NE + e) * W2E_BYTES) + k0, FF, n0, 0, tile, F.lane); }
    }
    const int gt = F.bid * NTHREADS + F.tid, NGT = F.G * NTHREADS;
    float* b1r = (float*)(F.ws + WS_B1R);
    for (int i = gt; i < NL * NE * 2048; i += NGT) { const int le = i >> 11, n = i & 2047, pn = n >> 8, rr = n & 255; b1r[i] = inp(F, I_b1)[(size_t)le * 2048 + 2 * (128 * pn + (rr & 127)) + (rr >> 7)]; }
    { bf16_t* pwt = (bf16_t*)(F.ws + WS_PWT);
      for (int i = gt; i < NL * 4 * 64 * 64; i += NGT) { const int c = i & 63, d = (i >> 6) & 63, lg = i >> 12; pwt[i] = f2bf(inp(F, I_pool_w)[((size_t)lg * 64 + c) * 64 + d]); } }
    bf16_t* wf = (bf16_t*)(F.ws + WS_WFRAG);
    for (int i = gt; i < NL * 2 * 32 * 2 * 64 * 8; i += NGT) {
        const int j = i & 7, ln = (i >> 3) & 63, et = (i >> 9) & 1, ks = (i >> 10) & 31, kind = (i >> 15) & 1, l = i >> 16;
        const int e = 16 * et + (ln & 15), k = 32 * ks + 8 * (ln >> 4) + j;
        float v;
        if (kind == 0) v = (e < 8) ? inp(F, I_norm_mix)[l * D + k] * inp(F, I_w_in)[((size_t)l * D + k) * IN_COLS + 1536 + e] : 0.f;
        else v = inp(F, I_norm_moe)[l * D + k] * inp(F, I_w_router)[((size_t)l * D + k) * NE + e];
        const bf16_t h = f2bf(v), lo = f2bf(v - bf2f(h));
        const size_t base = ((((size_t)(l * 2 + kind) * 32 + ks) * 2 + et) * 2) * 512 + ln * 8 + j;
        wf[base] = h; wf[base + 512] = lo;
    }
}

template <int KIND, bool COMBINE, bool WRITE_H>
__device__ __forceinline__ void r_phase(const Frame& F, int l, const float* hin, float* hout) {
    const int lane = F.lane, r16 = lane & 15, q4 = lane >> 4;
    const u32x4* Wf = (const u32x4*)(F.ws + WS_WFRAG + (size_t)(l * 2 + KIND) * 131072);
    const bf16_t* Y = (const bf16_t*)(F.ws + WS_Y);
    bf16_t* HB = (bf16_t*)(F.ws + WS_HB);
    float* rstdp = (float*)(F.ws + (KIND == 0 ? WS_RSTD1 : WS_RSTD2));
    LAS float* lg = (LAS float*)(F.lds) + F.wave * (16 * 33);
    LAS int* r2cnt = (LAS int*)(F.lds + LDSCTL_OFF + LC_R2CNT); LAS int* r2base = (LAS int*)(F.lds + LDSCTL_OFF + LC_R2BASE);
    for (int task = F.bid; task < T / 128; task += F.G) {
        const int tok = task * 128 + F.wave * 16 + r16;
        const float* xr = hin + (size_t)tok * D + 8 * q4; float* ho = hout + (size_t)tok * D + 8 * q4;
        const bf16_t* yr = Y + (size_t)tok * 4 * D + 8 * q4; bf16_t* hbr = HB + (size_t)tok * D + 8 * q4;
        f32x4 acc0 = {0.f, 0.f, 0.f, 0.f}, acc1 = {0.f, 0.f, 0.f, 0.f}; float ssq = 0.f;
        if (KIND == 1) { if (F.tid < 32) r2cnt[F.tid] = 0; }
#pragma unroll 2
        for (int ks = 0; ks < 32; ++ks) {
            f32x4 x0 = *(const f32x4*)(xr + 32 * ks), x1 = *(const f32x4*)(xr + 32 * ks + 4);
            if (COMBINE) {
#pragma unroll
                for (int k = 0; k < 4; ++k) { const u32x4 y = *(const u32x4*)(yr + (size_t)k * D + 32 * ks);
                    x0[0] += bflo(y.x); x0[1] += bfhi(y.x); x0[2] += bflo(y.y); x0[3] += bfhi(y.y); x1[0] += bflo(y.z); x1[1] += bfhi(y.z); x1[2] += bflo(y.w); x1[3] += bfhi(y.w); }
            }
            if (WRITE_H) { *(f32x4*)(ho + 32 * ks) = x0; *(f32x4*)(ho + 32 * ks + 4) = x1; }
            ssq += (x0[0] * x0[0] + x0[1] * x0[1]) + (x0[2] * x0[2] + x0[3] * x0[3]) + (x1[0] * x1[0] + x1[1] * x1[1]) + (x1[2] * x1[2] + x1[3] * x1[3]);
            u32x4 hw; hw.x = cvtpk(x0[0], x0[1]); hw.y = cvtpk(x0[2], x0[3]); hw.z = cvtpk(x1[0], x1[1]); hw.w = cvtpk(x1[2], x1[3]);
            u32x4 lw; lw.x = cvtpk(x0[0] - bflo(hw.x), x0[1] - bfhi(hw.x)); lw.y = cvtpk(x0[2] - bflo(hw.y), x0[3] - bfhi(hw.y)); lw.z = cvtpk(x1[0] - bflo(hw.z), x1[1] - bfhi(hw.z)); lw.w = cvtpk(x1[2] - bflo(hw.w), x1[3] - bfhi(hw.w));
            *(u32x4*)(hbr + 32 * ks) = hw;
            const bf16x8 xh = __builtin_bit_cast(bf16x8, hw), xl = __builtin_bit_cast(bf16x8, lw);
            const bf16x8 wh0 = __builtin_bit_cast(bf16x8, Wf[((ks * 2 + 0) * 2 + 0) * 64 + lane]), wl0 = __builtin_bit_cast(bf16x8, Wf[((ks * 2 + 0) * 2 + 1) * 64 + lane]);
            acc0 = __builtin_amdgcn_mfma_f32_16x16x32_bf16(wh0, xh, acc0, 0, 0, 0);
            acc0 = __builtin_amdgcn_mfma_f32_16x16x32_bf16(wl0, xh, acc0, 0, 0, 0);
            acc0 = __builtin_amdgcn_mfma_f32_16x16x32_bf16(wh0, xl, acc0, 0, 0, 0);
            if (KIND == 1) {
                const bf16x8 wh1 = __builtin_bit_cast(bf16x8, Wf[((ks * 2 + 1) * 2 + 0) * 64 + lane]), wl1 = __builtin_bit_cast(bf16x8, Wf[((ks * 2 + 1) * 2 + 1) * 64 + lane]);
                acc1 = __builtin_amdgcn_mfma_f32_16x16x32_bf16(wh1, xh, acc1, 0, 0, 0);
                acc1 = __builtin_amdgcn_mfma_f32_16x16x32_bf16(wl1, xh, acc1, 0, 0, 0);
                acc1 = __builtin_amdgcn_mfma_f32_16x16x32_bf16(wh1, xl, acc1, 0, 0, 0);
            }
        }
        ssq += __shfl_xor(ssq, 16); ssq += __shfl_xor(ssq, 32);
        const float rstd = 1.0f / sqrtf(ssq * (1.0f / D) + RMS_EPS);
        if (q4 == 0) rstdp[tok] = rstd;
        if (KIND == 0) {
            if (q4 < 2) { const f32x4 bf = *(const f32x4*)(inp(F, I_b_fox_f) + l * 8 + 4 * q4); f32x4 lf;
#pragma unroll
                for (int i = 0; i < 4; ++i) { const float z = rstd * acc0[i] + bf[i]; lf[i] = fminf(z, 0.f) - log1pf(expf(-fabsf(z))); }
                *(f32x4*)((float*)(F.ws + WS_LOGF) + (size_t)tok * 8 + 4 * q4) = lf; }
        } else {
            const f32x4 b0 = *(const f32x4*)(inp(F, I_b_router) + l * NE + 4 * q4), b1v = *(const f32x4*)(inp(F, I_b_router) + l * NE + 16 + 4 * q4);
#pragma unroll
            for (int i = 0; i < 4; ++i) { lg[r16 * 33 + 4 * q4 + i] = rstd * acc0[i] + b0[i]; lg[r16 * 33 + 16 + 4 * q4 + i] = rstd * acc1[i] + b1v[i]; }
            LDS_WAIT(); asm volatile("" ::: "memory");
            float v0 = -INFINITY, v1 = -INFINITY, v2 = -INFINITY, v3 = -INFINITY; int i0 = 0, i1 = 0, i2 = 0, i3 = 0;
            if (lane < 16) {
                for (int e = 0; e < NE; ++e) { const float x = lg[lane * 33 + e];
                    if (x > v3) { if (x > v0) { v3 = v2; i3 = i2; v2 = v1; i2 = i1; v1 = v0; i1 = i0; v0 = x; i0 = e; }
                        else if (x > v1) { v3 = v2; i3 = i2; v2 = v1; i2 = i1; v1 = x; i1 = e; }
                        else if (x > v2) { v3 = v2; i3 = i2; v2 = x; i2 = e; }
                        else { v3 = x; i3 = e; } } }
            }
            __syncthreads();
            int rk0 = 0, rk1 = 0, rk2 = 0, rk3 = 0;
            if (lane < 16) { rk0 = __hip_atomic_fetch_add(&r2cnt[i0], 1, __ATOMIC_RELAXED, __HIP_MEMORY_SCOPE_WORKGROUP); rk1 = __hip_atomic_fetch_add(&r2cnt[i1], 1, __ATOMIC_RELAXED, __HIP_MEMORY_SCOPE_WORKGROUP); rk2 = __hip_atomic_fetch_add(&r2cnt[i2], 1, __ATOMIC_RELAXED, __HIP_MEMORY_SCOPE_WORKGROUP); rk3 = __hip_atomic_fetch_add(&r2cnt[i3], 1, __ATOMIC_RELAXED, __HIP_MEMORY_SCOPE_WORKGROUP); }
            __syncthreads();
            if (F.tid < 32) r2base[F.tid] = (int)atomicAdd(F.ctl + CW_CUR + (l * NE + F.tid) * 16, (unsigned)r2cnt[F.tid]);
            __syncthreads();
            if (lane < 16) {
                const float e1 = expf(v1 - v0), e2 = expf(v2 - v0), e3 = expf(v3 - v0), inv = 1.0f / (1.0f + e1 + e2 + e3);
                u32x2* list = (u32x2*)(F.ws + WS_LIST); float* gate = (float*)(F.ws + WS_GATE);
                const int tk = (task * 128 + F.wave * 16 + lane) * 4; const unsigned rb = __float_as_uint(__shfl(rstd, lane & 15));
                list[(size_t)i0 * LISTCAP + r2base[i0] + rk0] = (u32x2){(unsigned)(tk + 0), rb}; gate[tk + 0] = inv;
                list[(size_t)i1 * LISTCAP + r2base[i1] + rk1] = (u32x2){(unsigned)(tk + 1), rb}; gate[tk + 1] = e1 * inv;
                list[(size_t)i2 * LISTCAP + r2base[i2] + rk2] = (u32x2){(unsigned)(tk + 2), rb}; gate[tk + 2] = e2 * inv;
                list[(size_t)i3 * LISTCAP + r2base[i3] + rk3] = (u32x2){(unsigned)(tk + 3), rb}; gate[tk + 3] = e3 * inv;
            }
            __syncthreads();
        }
    }
}
__device__ __forceinline__ void r_final(const Frame& F) {
    const int lane = F.lane, r16 = lane & 15, q4 = lane >> 4;
    const bf16_t* Y = (const bf16_t*)(F.ws + WS_Y);
    for (int task = F.bid; task < T / 128; task += F.G) {
        const int tok = task * 128 + F.wave * 16 + r16;
        float* xr = F.out + (size_t)tok * D + 8 * q4; const bf16_t* yr = Y + (size_t)tok * 4 * D + 8 * q4;
        float ssq = 0.f;
#pragma unroll 2
        for (int ks = 0; ks < 32; ++ks) {
            f32x4 x0 = *(const f32x4*)(xr + 32 * ks), x1 = *(const f32x4*)(xr + 32 * ks + 4);
#pragma unroll
            for (int k = 0; k < 4; ++k) { const u32x4 y = *(const u32x4*)(yr + (size_t)k * D + 32 * ks);
                x0[0] += bflo(y.x); x0[1] += bfhi(y.x); x0[2] += bflo(y.y); x0[3] += bfhi(y.y); x1[0] += bflo(y.z); x1[1] += bfhi(y.z); x1[2] += bflo(y.w); x1[3] += bfhi(y.w); }
            ssq += (x0[0] * x0[0] + x0[1] * x0[1]) + (x0[2] * x0[2] + x0[3] * x0[3]) + (x1[0] * x1[0] + x1[1] * x1[1]) + (x1[2] * x1[2] + x1[3] * x1[3]);
        }
        ssq += __shfl_xor(ssq, 16); ssq += __shfl_xor(ssq, 32);
        const float rstd = 1.0f / sqrtf(ssq * (1.0f / D) + RMS_EPS);
#pragma unroll 2
        for (int ks = 0; ks < 32; ++ks) {
            f32x4 x0 = *(const f32x4*)(xr + 32 * ks), x1 = *(const f32x4*)(xr + 32 * ks + 4);
#pragma unroll
            for (int k = 0; k < 4; ++k) { const u32x4 y = *(const u32x4*)(yr + (size_t)k * D + 32 * ks);
                x0[0] += bflo(y.x); x0[1] += bfhi(y.x); x0[2] += bflo(y.y); x0[3] += bfhi(y.y); x1[0] += bflo(y.z); x1[1] += bfhi(y.z); x1[2] += bflo(y.w); x1[3] += bfhi(y.w); }
            const f32x4 g0 = *(const f32x4*)(inp(F, I_norm_final) + 32 * ks + 8 * q4), g1 = *(const f32x4*)(inp(F, I_norm_final) + 32 * ks + 8 * q4 + 4);
            *(f32x4*)(xr + 32 * ks) = x0 * rstd * g0; *(f32x4*)(xr + 32 * ks + 4) = x1 * rstd * g1;
        }
    }
}
__device__ __forceinline__ void cumsum_step(const Frame& F) {
    LAS float* sc = (LAS float*)(F.lds + LDSCTL_OFF + LC_SCAN);
    const float* LF = (const float*)(F.ws + WS_LOGF); float* c2 = (float*)(F.ws + WS_C2);
    for (int seq = F.bid; seq < 64; seq += F.G) {
        const int b = seq >> 3, h = seq & 7, t0 = F.tid * 8; const float* lf = LF + ((size_t)b * SEQ + t0) * 8 + h;
        float v[8], s = 0.f;
#pragma unroll
        for (int j = 0; j < 8; ++j) { s += lf[j * 8]; v[j] = s; }
        float inc = s;
#pragma unroll
        for (int off = 1; off < 64; off <<= 1) { const float y = __shfl_up(inc, off); if (F.lane >= off) inc += y; }
        if (F.lane == 63) sc[F.wave] = inc;
        __syncthreads();
        float pre = 0.f;
        for (int w = 0; w < F.wave; ++w) pre += sc[w];
        const float base = pre + inc - s;
#pragma unroll
        for (int j = 0; j < 8; ++j) c2[(size_t)seq * SEQ + t0 + j] = (base + v[j]) * LOG2E;
        __syncthreads();
    }
}

__device__ __forceinline__ int crow(int r, int hi) { return (r & 3) + 8 * (r >> 2) + 4 * hi; }
constexpr int AT_KT = 0, AT_KTB = 8320, AT_VT = 2 * AT_KTB, AT_VTB = 8192, AT_CK = AT_VT + 2 * AT_VTB, AT_WSF = AT_CK + 512, AT_OST = AT_WSF + 2048, AT_END = AT_OST + 65536;
static_assert(AT_END <= PH_BYTES, "attention LDS");
__device__ __forceinline__ void attn_unit(const Frame& F, int l, int b, int h, int qb) {
    const int tid = F.tid, lane = F.lane, r32 = lane & 31, hi = lane >> 5, wid = F.wave;
    const bf16_t* proj = (const bf16_t*)(F.ws + WS_PA); bf16_t* mixed = (bf16_t*)(F.ws + WS_MIXED);
    const int bh = b * 8 + h; const float* c2 = (const float*)(F.ws + WS_C2) + (size_t)bh * SEQ;
    const size_t rowbase = (size_t)b * SEQ; const int q0 = qb * 256;
    LAS unsigned char* L = F.lds;
    LAS float* wsf = (LAS float*)(L + AT_WSF) + wid * 64;
    LAS float* ost = (LAS float*)(L + AT_OST) + wid * 2048;
    LAS unsigned* stopv = (LAS unsigned*)(L + LDSCTL_OFF + LC_STOP);
    const bf16_t* Qw = proj + (rowbase + q0 + wid * 32 + r32) * NPROJ + C_FQ + h * 64;
    bf16x8 qr[4]; float qn = 0.f;
#pragma unroll
    for (int d0 = 0; d0 < 4; ++d0) { const u32x4 w = *(const u32x4*)(Qw + d0 * 16 + hi * 8); qr[d0] = __builtin_bit_cast(bf16x8, w);
        qn += bflo(w.x) * bflo(w.x) + bfhi(w.x) * bfhi(w.x) + bflo(w.y) * bflo(w.y) + bfhi(w.y) * bfhi(w.y) + bflo(w.z) * bflo(w.z) + bfhi(w.z) * bfhi(w.z) + bflo(w.w) * bflo(w.w) + bfhi(w.w) * bfhi(w.w); }
    qn += __shfl_xor(qn, 32); qn = sqrtf(qn) * 1.001f;
    const float kb = sqrtf(2.0f * __uint_as_float(__hip_atomic_load(F.ctl + CW_KMAX + (l * 64 + bh) * 16, __ATOMIC_RELAXED, __HIP_MEMORY_SCOPE_AGENT))) * 1.001f;
    const float c2q = c2[q0 + wid * 32 + r32];
    f32x16 cq16;
#pragma unroll
    for (int r = 0; r < 16; ++r) cq16[r] = c2q;
    float lsum = 0.f; f32x16 o[2];
#pragma unroll
    for (int r = 0; r < 16; ++r) { o[0][r] = 0.f; o[1][r] = 0.f; }
    const int jd = 4 * qb + 3;
    const int lkey = tid >> 3, lpiece = tid & 7;
    const bf16_t* ksrc = proj + (rowbase + lkey) * NPROJ + C_FK + h * 64 + lpiece * 8;
    const bf16_t* vsrc = proj + (rowbase + lkey) * NPROJ + C_FV + h * 64 + lpiece * 8;
    const int kdst = lpiece * 1040 + lkey * 16, vdst = (lpiece >> 2) * 4096 + lkey * 64 + (lpiece & 3) * 16;
    u32x4 kA = *(const u32x4*)(ksrc + (size_t)jd * 64 * NPROJ), vA = *(const u32x4*)(vsrc + (size_t)jd * 64 * NPROJ); float cA = c2[jd * 64 + lane];
    u32x4 kB = kA, vB = vA; float cB = cA;
    if (jd >= 1) { kB = *(const u32x4*)(ksrc + (size_t)(jd - 1) * 64 * NPROJ); vB = *(const u32x4*)(vsrc + (size_t)(jd - 1) * 64 * NPROJ); cB = c2[(jd - 1) * 64 + lane]; }
    const int vrd = (4 * hi + ((lane & 15) >> 2)) * 64 + ((lane >> 4) & 1) * 32 + (lane & 3) * 8;
    const int qrel = wid * 32 + r32;
    int buf = 0; bool done = false, wstop = false, first = true;
    float mhat = 0.f;
#define AT_ITER(j, kR, vR, cR, cNext) do { \
        const float cklast = rdlane(cNext, 63);     \
        *(LAS u32x4*)(L + AT_KT + buf * AT_KTB + kdst) = kR; *(LAS u32x4*)(L + AT_VT + buf * AT_VTB + vdst) = vR; \
        if (tid < 64) ((LAS float*)(L + AT_CK))[buf * 64 + tid] = cR; \
        asm volatile("s_waitcnt lgkmcnt(0)\n\ts_barrier" ::: "memory");     \
        if ((j) < jd) { const u32x4 fa = *(const LAS u32x4*)(stopv + (((j) + 1) & 1) * 8), fb = *(const LAS u32x4*)(stopv + (((j) + 1) & 1) * 8 + 4); \
            if ((fa.x & fa.y & fa.z & fa.w & fb.x & fb.y & fb.z & fb.w) != 0u) { done = true; break; } } \
        if ((j) >= 2) { kR = *(const u32x4*)(ksrc + (size_t)((j) - 2) * 64 * NPROJ); vR = *(const u32x4*)(vsrc + (size_t)((j) - 2) * 64 * NPROJ); cR = c2[((j) - 2) * 64 + lane]; } \
        const int jrel = (j) - 4 * qb; \
        const bool active = !(jrel >= 0 && 64 * jrel > 32 * wid + 31) && !wstop; \
        if (active) { \
            const LAS unsigned char* Kb = L + AT_KT + buf * AT_KTB; const LAS unsigned char* Vb = L + AT_VT + buf * AT_VTB; const LAS float* Ck = (const LAS float*)(L + AT_CK) + buf * 64; \
            const float base = c2q - mhat; \
            f32x16 p0, p1; \
            _Pragma("unroll") for (int g = 0; g < 4; ++g) { const f32x4 ca = *(const LAS f32x4*)(Ck + 8 * g + 4 * hi), cb = *(const LAS f32x4*)(Ck + 32 + 8 * g + 4 * hi); \
                _Pragma("unroll") for (int i = 0; i < 4; ++i) { p0[4 * g + i] = base - ca[i]; p1[4 * g + i] = base - cb[i]; } } \
            bf16x8 kf0[4], kf1[4]; \
            _Pragma("unroll") for (int d0 = 0; d0 < 4; ++d0) { kf0[d0] = *(const LAS bf16x8*)(Kb + (2 * d0 + hi) * 1040 + r32 * 16); kf1[d0] = *(const LAS bf16x8*)(Kb + (2 * d0 + hi) * 1040 + (32 + r32) * 16); } \
            _Pragma("unroll") for (int d0 = 0; d0 < 4; ++d0) { \
                p0 = __builtin_amdgcn_mfma_f32_32x32x16_bf16(kf0[d0], qr[d0], p0, 0, 0, 0); p1 = __builtin_amdgcn_mfma_f32_32x32x16_bf16(kf1[d0], qr[d0], p1, 0, 0, 0); } \
            if (jrel >= 0) { const int kbase = 64 * jrel + 4 * hi; \
                _Pragma("unroll") for (int r = 0; r < 16; ++r) { const int kv = kbase + (r & 3) + 8 * (r >> 2); if (kv > qrel) p0[r] = -INFINITY; if (kv + 32 > qrel) p1[r] = -INFINITY; } } \
            float mx = fmaxf(p0[0], p1[0]); \
            _Pragma("unroll") for (int r = 1; r < 16; ++r) mx = fmaxf(mx, fmaxf(p0[r], p1[r])); \
            { auto rr = __builtin_amdgcn_permlane32_swap(__float_as_uint(mx), __float_as_uint(mx), false, false); mx = fmaxf(__uint_as_float(rr[0]), __uint_as_float(rr[1])); } \
            if (first || __any(mx > 8.0f)) { \
                const float dl = first ? mx : fmaxf(mx, 0.f); mhat += dl; \
                _Pragma("unroll") for (int r = 0; r < 16; ++r) { p0[r] -= dl; p1[r] -= dl; } \
                const float alpha = __builtin_amdgcn_exp2f(-dl); lsum *= alpha; \
                if (!first) { \
                    if (hi == 0) wsf[r32] = alpha; \
                    LDS_WAIT(); asm volatile("" ::: "memory"); \
                    _Pragma("unroll") for (int r = 0; r < 16; ++r) { const float a = wsf[crow(r, hi)]; o[0][r] *= a; o[1][r] *= a; } } \
                first = false; \
            } \
            float ls = 0.f; \
            _Pragma("unroll") for (int r = 0; r < 16; ++r) { p0[r] = __builtin_amdgcn_exp2f(p0[r]); p1[r] = __builtin_amdgcn_exp2f(p1[r]); ls += p0[r] + p1[r]; } \
            lsum += ls; \
            u32x4 pw[4]; \
            pw[0] = (u32x4){cvtpk(p0[0], p0[1]), cvtpk(p0[2], p0[3]), cvtpk(p0[4], p0[5]), cvtpk(p0[6], p0[7])}; \
            pw[1] = (u32x4){cvtpk(p0[8], p0[9]), cvtpk(p0[10], p0[11]), cvtpk(p0[12], p0[13]), cvtpk(p0[14], p0[15])}; \
            pw[2] = (u32x4){cvtpk(p1[0], p1[1]), cvtpk(p1[2], p1[3]), cvtpk(p1[4], p1[5]), cvtpk(p1[6], p1[7])}; \
            pw[3] = (u32x4){cvtpk(p1[8], p1[9]), cvtpk(p1[10], p1[11]), cvtpk(p1[12], p1[13]), cvtpk(p1[14], p1[15])}; \
            _Pragma("unroll") for (int s = 0; s < 4; ++s) \
                _Pragma("unroll") for (int d0 = 0; d0 < 2; ++d0) { \
                    const LAS unsigned char* vp = Vb + d0 * 4096 + s * 1024 + vrd; \
                    const v4i16_t lo = __builtin_amdgcn_ds_read_tr16_b64_v4i16((LAS v4i16_t*)vp), hv = __builtin_amdgcn_ds_read_tr16_b64_v4i16((LAS v4i16_t*)(vp + 512)); \
                    const bf16x8 vf = (bf16x8){lo[0], lo[1], lo[2], lo[3], hv[0], hv[1], hv[2], hv[3]}; \
                    o[d0] = __builtin_amdgcn_mfma_f32_32x32x16_bf16(__builtin_bit_cast(bf16x8, pw[s]), vf, o[d0], 0, 0, 0); } \
        } \
        if ((j) > 0) { if (active) { const float ub = qn * kb + (c2q - cklast); if (__all((ub - mhat) < -152.0f)) wstop = true; } if (lane == 0) stopv[((j) & 1) * 8 + wid] = wstop ? 1u : 0u; } \
        buf ^= 1; \
    } while (0)
    for (int j = jd; j >= 0; j -= 2) {
        AT_ITER(j, kA, vA, cA, cB);
        if (done || j == 0) break;
        AT_ITER(j - 1, kB, vB, cB, cA);
        if (done) break;
    }
#undef AT_ITER
    lsum += __shfl_xor(lsum, 32);
    if (hi == 0) wsf[32 + r32] = 1.0f / lsum;
    LDS_WAIT(); asm volatile("" ::: "memory");
#pragma unroll
    for (int r = 0; r < 16; ++r) { const int q = crow(r, hi); const float inv = wsf[32 + q]; ost[q * 64 + r32] = o[0][r] * inv; ost[q * 64 + 32 + r32] = o[1][r] * inv; }
    LDS_WAIT(); asm volatile("" ::: "memory");
    { const int row = lane >> 1, half = lane & 1; const LAS float* src = ost + row * 64 + half * 32; float v[32]; float ss = 0.f;
#pragma unroll
        for (int i = 0; i < 8; ++i) { const f32x4 t4 = *(const LAS f32x4*)(src + 4 * i); v[4 * i] = t4[0]; v[4 * i + 1] = t4[1]; v[4 * i + 2] = t4[2]; v[4 * i + 3] = t4[3]; ss += (t4[0] * t4[0] + t4[1] * t4[1]) + (t4[2] * t4[2] + t4[3] * t4[3]); }
        ss += __shfl_xor(ss, 1);
        const float rs = 1.0f / sqrtf(ss * (1.0f / 64.0f) + RMS_EPS);
        const float* gn = inp(F, I_fox_gain) + l * 512 + h * 64 + half * 32;
        bf16_t* dst = mixed + (rowbase + q0 + wid * 32 + row) * D + h * 64 + half * 32;
#pragma unroll
        for (int i = 0; i < 4; ++i) { const f32x4 ga = *(const f32x4*)(gn + 8 * i), gb = *(const f32x4*)(gn + 8 * i + 4); u32x4 w;
            w.x = cvtpk(v[8 * i] * rs * ga[0], v[8 * i + 1] * rs * ga[1]); w.y = cvtpk(v[8 * i + 2] * rs * ga[2], v[8 * i + 3] * rs * ga[3]);
            w.z = cvtpk(v[8 * i + 4] * rs * gb[0], v[8 * i + 5] * rs * gb[1]); w.w = cvtpk(v[8 * i + 6] * rs * gb[2], v[8 * i + 7] * rs * gb[3]);
            *(u32x4*)(dst + 8 * i) = w; } }
    __syncthreads();
}

__device__ __forceinline__ float hg_lb(const Frame& F, int l, int col) {
    float x[NL], mx = -INFINITY;
#pragma unroll
    for (int i = 0; i < NL; ++i) { x[i] = inp(F, I_hgrn_lb)[i * 256 + col]; mx = fmaxf(mx, x[i]); }
    float s = 0.f, a = 0.f;
#pragma unroll
    for (int i = 0; i < NL; ++i) { x[i] = expf(x[i] - mx); s += x[i]; }
#pragma unroll
    for (int i = 1; i < NL; ++i) if (i <= l) a += x[i];
    return a / s;
}
constexpr int HG_SEG = 256, HG_NSEG = SEQ / HG_SEG, HG_NPART = 1;
constexpr int HGL_ROW = 136, HGL_QT = 0, HGL_KT = 32 * HGL_ROW, HGL_KP = 2 * 32 * HGL_ROW, HGL_V = HGL_KP + 4096, HGL_PE = HGL_V + 4096, HGL_BYTES = HGL_PE + 256;
static_assert(NWAVES * HGL_BYTES <= PH_BYTES, "HGRN2 LDS");
__device__ __forceinline__ void hg_mfma_unit(const Frame& F, int l, int u) {
    const int seg = u & 15, bh = u >> 4, b = bh >> 2, hd = bh & 3, lane = F.lane, r32 = lane & 31, hi = lane >> 5;
    LAS unsigned char* W = F.lds + F.wave * HGL_BYTES;
    const size_t tokS = (size_t)b * SEQ + seg * HG_SEG;
    const bf16_t* proj = (const bf16_t*)(F.ws + WS_PA);
    float* oraw = (float*)(F.ws + WS_ORAW); bf16_t* QE = (bf16_t*)(F.ws + WS_QE);
    const float lbv = hg_lb(F, l, hd * 64 + lane);
    f32x16 Sacc[2][2];
#pragma unroll
    for (int kb = 0; kb < 2; ++kb)
#pragma unroll
        for (int vb = 0; vb < 2; ++vb)
#pragma unroll
            for (int r = 0; r < 16; ++r) Sacc[kb][vb][r] = 0.f;
    float Pseg = 1.0f;
    const int vrd = (4 * hi + ((lane & 15) >> 2)) * 64 + ((lane >> 4) & 1) * 32 + (lane & 3) * 8;
    int tb = 0;
    while (tb < HG_SEG) {
        const int nmax = (HG_SEG - tb) < 32 ? (HG_SEG - tb) : 32;
        const char* pu8 = (const char*)(proj + (tokS + tb) * NPROJ + hd * 64);
        const unsigned lo2 = (unsigned)lane * 2u;
        char* qe8 = (char*)(QE + (tokS + tb) * 256 + hd * 64);
        char* or8 = (char*)(oraw + (tokS + tb) * 256 + hd * 64);
        const unsigned lof = (unsigned)(4 * hi * 256 + r32) * 4u;
        float fv[32], qv[32]; u32x4 vreg[4];
#pragma unroll
        for (int t = 0; t < 32; ++t) { const bool ok = t < nmax; fv[t] = ok ? bf2f(*(const bf16_t*)(pu8 + (size_t)t * (NPROJ * 2) + C_GF * 2 + lo2)) : 0.f; qv[t] = ok ? bf2f(*(const bf16_t*)(pu8 + (size_t)t * (NPROJ * 2) + C_GQ * 2 + lo2)) : 0.f; }
#pragma unroll
        for (int it = 0; it < 4; ++it) { const int c = lane + 64 * it, sr = c >> 3, pc = c & 7;
            vreg[it] = (u32x4){0u, 0u, 0u, 0u}; if (sr < nmax) vreg[it] = *(const u32x4*)(pu8 + (size_t)sr * (NPROJ * 2) + C_GI * 2 + pc * 16); }
        int nl = 32; { float P = 1.0f;
#pragma unroll
            for (int t = 0; t < 32; ++t) { const float sg = 1.0f / (1.0f + expf(-fv[t])); float f = fmaxf(lbv + (1.0f - lbv) * sg, 1e-30f); if (t >= nmax) f = 1.0f; fv[t] = f; P *= f; if (P < 1e-32f && nl == 32) nl = t; } }
#pragma unroll
        for (int off = 1; off < 64; off <<= 1) { const int o = __shfl_xor(nl, off); nl = o < nl ? o : nl; }
        const int n = __builtin_amdgcn_readfirstlane(nl < nmax ? nl : nmax);
#pragma unroll
        for (int it = 0; it < 4; ++it) { const int c = lane + 64 * it, sr = c >> 3, pc = c & 7;
            *(LAS u32x4*)(W + HGL_V + (pc >> 2) * 2048 + sr * 64 + (pc & 3) * 16) = (sr < n) ? vreg[it] : (u32x4){0u, 0u, 0u, 0u}; }
        float P = 1.0f;
        {
#pragma unroll
          for (int t = 0; t < 32; ++t) { const bool ok = t < n; const float f = fv[t]; if (ok) P *= f;
            const float qt = ok ? qv[t] * P : 0.f, kt = ok ? (1.0f - f) / P : 0.f;
            *(LAS bf16_t*)(W + HGL_QT + t * HGL_ROW + lane * 2) = f2bf(qt); *(LAS bf16_t*)(W + HGL_KT + t * HGL_ROW + lane * 2) = f2bf(kt);
            if (ok) *(bf16_t*)(qe8 + (size_t)t * 512 + lo2) = f2bf(qv[t] * (Pseg * P)); } }
        { float suf = 1.0f;
#pragma unroll
          for (int t = 31; t >= 0; --t) { const bool ok = t < n; const float f = fv[t]; const float kp = ok ? (1.0f - f) * suf : 0.f; if (ok) suf *= f;
            *(LAS bf16_t*)(W + HGL_KP + (lane >> 5) * 2048 + t * 64 + (lane & 31) * 2) = f2bf(kp); } }
        ((LAS float*)(W + HGL_PE))[lane] = P;
        Pseg *= P;
        LDS_WAIT(); asm volatile("" ::: "memory");
        f32x16 st;
#pragma unroll
        for (int r = 0; r < 16; ++r) st[r] = 0.f;
#pragma unroll
        for (int d0 = 0; d0 < 4; ++d0) { const bf16x8 ka = *(const LAS bf16x8*)(W + HGL_KT + r32 * HGL_ROW + (16 * d0 + 8 * hi) * 2), qb = *(const LAS bf16x8*)(W + HGL_QT + r32 * HGL_ROW + (16 * d0 + 8 * hi) * 2);
            st = __builtin_amdgcn_mfma_f32_32x32x16_bf16(ka, qb, st, 0, 0, 0); }
#pragma unroll
        for (int r = 0; r < 16; ++r) if (crow(r, hi) > r32) st[r] = 0.f;
        u32x4 pst[2];
        pst[0] = (u32x4){cvtpk(st[0], st[1]), cvtpk(st[2], st[3]), cvtpk(st[4], st[5]), cvtpk(st[6], st[7])};
        pst[1] = (u32x4){cvtpk(st[8], st[9]), cvtpk(st[10], st[11]), cvtpk(st[12], st[13]), cvtpk(st[14], st[15])};
        bf16x8 vf[2][2];
#pragma unroll
        for (int s2 = 0; s2 < 2; ++s2)
#pragma unroll
            for (int vb = 0; vb < 2; ++vb) { const LAS unsigned char* vp = W + HGL_V + vb * 2048 + s2 * 1024 + vrd;
                const v4i16_t lo = __builtin_amdgcn_ds_read_tr16_b64_v4i16((LAS v4i16_t*)vp), hv = __builtin_amdgcn_ds_read_tr16_b64_v4i16((LAS v4i16_t*)(vp + 512));
                vf[s2][vb] = (bf16x8){lo[0], lo[1], lo[2], lo[3], hv[0], hv[1], hv[2], hv[3]}; }
        f32x16 oacc[2];
#pragma unroll
        for (int vb = 0; vb < 2; ++vb) {
#pragma unroll
            for (int r = 0; r < 16; ++r) oacc[vb][r] = 0.f;
#pragma unroll
            for (int s2 = 0; s2 < 2; ++s2) oacc[vb] = __builtin_amdgcn_mfma_f32_32x32x16_bf16(__builtin_bit_cast(bf16x8, pst[s2]), vf[s2][vb], oacc[vb], 0, 0, 0);
        }
#pragma unroll
        for (int kst = 0; kst < 4; ++kst) {
            const u32x2 qa = *(const LAS u32x2*)(W + HGL_QT + r32 * HGL_ROW + (16 * kst + 4 * hi) * 2), qc = *(const LAS u32x2*)(W + HGL_QT + r32 * HGL_ROW + (16 * kst + 8 + 4 * hi) * 2);
            const bf16x8 qf = __builtin_bit_cast(bf16x8, (u32x4){qa.x, qa.y, qc.x, qc.y});
#pragma unroll
            for (int vb = 0; vb < 2; ++vb) { const f32x16& S = Sacc[kst >> 1][vb]; const int o8 = 8 * (kst & 1);
                const u32x4 sp = (u32x4){cvtpk(S[o8 + 0], S[o8 + 1]), cvtpk(S[o8 + 2], S[o8 + 3]), cvtpk(S[o8 + 4], S[o8 + 5]), cvtpk(S[o8 + 6], S[o8 + 7])};
                oacc[vb] = __builtin_amdgcn_mfma_f32_32x32x16_bf16(qf, __builtin_bit_cast(bf16x8, sp), oacc[vb], 0, 0, 0); }
        }
#pragma unroll
        for (int vb = 0; vb < 2; ++vb)
#pragma unroll
            for (int r = 0; r < 16; ++r) { const int t = crow(r, hi); if (t < n) *(float*)(or8 + (size_t)(((r & 3) + 8 * (r >> 2)) * 1024 + vb * 128) + lof) = oacc[vb][r]; }
#pragma unroll
        for (int kb = 0; kb < 2; ++kb) {
            float pe[16];
#pragma unroll
            for (int g = 0; g < 4; ++g) { const f32x4 p4 = *(const LAS f32x4*)(W + HGL_PE + (32 * kb + 8 * g + 4 * hi) * 4); pe[4 * g] = p4[0]; pe[4 * g + 1] = p4[1]; pe[4 * g + 2] = p4[2]; pe[4 * g + 3] = p4[3]; }
            bf16x8 kf[2];
#pragma unroll
            for (int s2 = 0; s2 < 2; ++s2) { const LAS unsigned char* kp = W + HGL_KP + kb * 2048 + s2 * 1024 + vrd;
                const v4i16_t lo = __builtin_amdgcn_ds_read_tr16_b64_v4i16((LAS v4i16_t*)kp), hv = __builtin_amdgcn_ds_read_tr16_b64_v4i16((LAS v4i16_t*)(kp + 512));
                kf[s2] = (bf16x8){lo[0], lo[1], lo[2], lo[3], hv[0], hv[1], hv[2], hv[3]}; }
#pragma unroll
            for (int vb = 0; vb < 2; ++vb) {
#pragma unroll
                for (int r = 0; r < 16; ++r) Sacc[kb][vb][r] *= pe[r];
#pragma unroll
                for (int s2 = 0; s2 < 2; ++s2) Sacc[kb][vb] = __builtin_amdgcn_mfma_f32_32x32x16_bf16(kf[s2], vf[s2][vb], Sacc[kb][vb], 0, 0, 0);
            }
        }
        LDS_WAIT(); asm volatile("" ::: "memory");
        tb += n;
    }
    char* send8 = (char*)((float*)(F.ws + WS_SEND) + (size_t)(bh * HG_NSEG + seg) * 4096);
    const unsigned lsf = (unsigned)(4 * hi * 64 + r32) * 4u;
#pragma unroll
    for (int kb = 0; kb < 2; ++kb)
#pragma unroll
        for (int vb = 0; vb < 2; ++vb)
#pragma unroll
            for (int r = 0; r < 16; ++r) *(float*)(send8 + (size_t)((32 * kb + (r & 3) + 8 * (r >> 2)) * 256 + vb * 128) + lsf) = Sacc[kb][vb][r];
    ((float*)(F.ws + WS_PSEG))[(bh * HG_NSEG + seg) * 64 + lane] = Pseg;
}
__device__ __forceinline__ void hg_fix_phase(const Frame& F, int l) {
    const int lane = F.lane, r16 = lane & 15, q4 = lane >> 4, tid = F.tid;
    LAS bf16_t* ST = (LAS bf16_t*)(F.lds);
    const float* oraw = (const float*)(F.ws + WS_ORAW); const bf16_t* proj = (const bf16_t*)(F.ws + WS_PA); bf16_t* mixed = (bf16_t*)(F.ws + WS_MIXED);
    const bf16_t* QE = (const bf16_t*)(F.ws + WS_QE); const float* SEND = (const float*)(F.ws + WS_SEND); const float* PSEG = (const float*)(F.ws + WS_PSEG);
    for (int u = F.bid; u < 32 * HG_NSEG; u += F.G) {
        const int seg = u & 15, bh = u >> 4, b = bh >> 2, hd = bh & 3;
        if (seg > 0) {
            const int k = tid >> 3, v8 = (tid & 7) * 8; float S[8];
#pragma unroll
            for (int i = 0; i < 8; ++i) S[i] = 0.f;
            for (int sp = 0; sp < seg; ++sp) { const float P = PSEG[(bh * HG_NSEG + sp) * 64 + k]; const float* se = SEND + ((size_t)(bh * HG_NSEG + sp) * 64 + k) * 64 + v8;
                const f32x4 a = *(const f32x4*)se, c = *(const f32x4*)(se + 4);
                S[0] = P * S[0] + a[0]; S[1] = P * S[1] + a[1]; S[2] = P * S[2] + a[2]; S[3] = P * S[3] + a[3]; S[4] = P * S[4] + c[0]; S[5] = P * S[5] + c[1]; S[6] = P * S[6] + c[2]; S[7] = P * S[7] + c[3]; }
#pragma unroll
            for (int i = 0; i < 8; ++i) ST[(v8 + i) * 72 + k] = f2bf(S[i]);
        }
        __syncthreads();
#pragma unroll 1
        for (int mb = 0; mb < 2; ++mb) {
            const size_t tok0 = (size_t)b * SEQ + seg * HG_SEG + F.wave * 32 + mb * 16;
            f32x4 acc[4];
#pragma unroll
            for (int vb = 0; vb < 4; ++vb) acc[vb] = (f32x4){0.f, 0.f, 0.f, 0.f};
            if (seg > 0) {
#pragma unroll
                for (int kst = 0; kst < 2; ++kst) { const bf16x8 af = __builtin_bit_cast(bf16x8, *(const u32x4*)(QE + (tok0 + r16) * 256 + hd * 64 + 32 * kst + 8 * q4));
#pragma unroll
                    for (int vb = 0; vb < 4; ++vb) { const bf16x8 bfv = *(const LAS bf16x8*)(ST + (vb * 16 + r16) * 72 + 32 * kst + 8 * q4); acc[vb] = __builtin_amdgcn_mfma_f32_16x16x32_bf16(af, bfv, acc[vb], 0, 0, 0); } }
            }
            float ss[4] = {0.f, 0.f, 0.f, 0.f};
#pragma unroll
            for (int vb = 0; vb < 4; ++vb)
#pragma unroll
                for (int r = 0; r < 4; ++r) { const size_t o = (tok0 + 4 * q4 + r) * 256 + hd * 64 + vb * 16 + r16;
                    float x = acc[vb][r];
#pragma unroll
                    for (int k4 = 0; k4 < HG_NPART; ++k4) x += oraw[(size_t)k4 * T * 256 + o];
                    acc[vb][r] = x; ss[r] += x * x; }
#pragma unroll
            for (int r = 0; r < 4; ++r) { float t = ss[r]; t += __shfl_xor(t, 1); t += __shfl_xor(t, 2); t += __shfl_xor(t, 4); t += __shfl_xor(t, 8); ss[r] = 1.0f / sqrtf(t * (1.0f / 64.0f) + RMS_EPS); }
#pragma unroll
            for (int vb = 0; vb < 4; ++vb) { const float gn = inp(F, I_hgrn_gain)[l * 256 + hd * 64 + vb * 16 + r16];
#pragma unroll
                for (int r = 0; r < 4; ++r) { const size_t tok = tok0 + 4 * q4 + r; const float g = bf2f(proj[tok * NPROJ + C_GG + hd * 64 + vb * 16 + r16]);
                    const float si = g / (1.0f + expf(-g)); mixed[tok * D + 512 + hd * 64 + vb * 16 + r16] = f2bf(acc[vb][r] * ss[r] * gn * si); } }
        }
        __syncthreads();
    }
}
constexpr int PL_ROW = 136, PL_BYTES = 64 * PL_ROW;
static_assert(NWAVES * PL_BYTES <= PH_BYTES, "pool LDS");
template <int W> __device__ __forceinline__ void pool_body(const Frame& F, int l, int b, int g, int seg) {
    const int lane = F.lane, r32 = lane & 31, hi = lane >> 5, t0 = seg * 64;
    LAS unsigned char* PT = F.lds + F.wave * PL_BYTES;
    const char* ub = (const char*)((const bf16_t*)(F.ws + WS_PA) + (size_t)b * SEQ * NPROJ + C_PU + g * 64);
    const unsigned lo2 = (unsigned)lane * 2u;
    float prev[16], cur[16];
#pragma unroll
    for (int i = 0; i < 16; ++i) { const int t = t0 - 16 + i; prev[i] = (t >= 0) ? bf2f(*(const bf16_t*)(ub + (size_t)(t < 0 ? 0 : t) * (NPROJ * 2) + lo2)) : 0.f; }
    float wsum = 0.f;
#pragma unroll
    for (int i = 1; i <= W; ++i) wsum += prev[16 - i];
#pragma unroll
    for (int ci = 0; ci < 4; ++ci) {
#pragma unroll
        for (int i = 0; i < 16; ++i) cur[i] = bf2f(*(const bf16_t*)(ub + (size_t)(t0 + 16 * ci + i) * (NPROJ * 2) + lo2));
#pragma unroll
        for (int i = 0; i < 16; ++i) { const float ut = cur[i]; wsum += ut; wsum -= (i - W >= 0) ? cur[(i - W >= 0) ? i - W : 0] : prev[(i - W >= 0) ? 0 : 16 + i - W];
            const int t = t0 + 16 * ci + i; const float pooled = wsum / (float)((t + 1 < W) ? (t + 1) : W) - ut;
            *(LAS bf16_t*)(PT + (16 * ci + i) * PL_ROW + lane * 2) = f2bf(pooled); }
#pragma unroll
        for (int i = 0; i < 16; ++i) prev[i] = cur[i];
    }
    LDS_WAIT(); asm volatile("" ::: "memory");
    const bf16_t* pwt = (const bf16_t*)(F.ws + WS_PWT) + (size_t)(l * 4 + g) * 4096;
    bf16x8 bw[2][4];
#pragma unroll
    for (int db = 0; db < 2; ++db)
#pragma unroll
        for (int st = 0; st < 4; ++st) bw[db][st] = __builtin_bit_cast(bf16x8, *(const u32x4*)(pwt + (32 * db + r32) * 64 + 16 * st + 8 * hi));
    char* ob = (char*)((bf16_t*)(F.ws + WS_MIXED) + ((size_t)b * SEQ + t0) * D + 768 + g * 64);
    const unsigned lof = (unsigned)(4 * hi * D + r32) * 2u;
#pragma unroll
    for (int tb2 = 0; tb2 < 2; ++tb2)
#pragma unroll
        for (int db = 0; db < 2; ++db) {
            f32x16 acc;
#pragma unroll
            for (int r = 0; r < 16; ++r) acc[r] = 0.f;
#pragma unroll
            for (int st = 0; st < 4; ++st) { const bf16x8 af = *(const LAS bf16x8*)(PT + (32 * tb2 + r32) * PL_ROW + (16 * st + 8 * hi) * 2); acc = __builtin_amdgcn_mfma_f32_32x32x16_bf16(af, bw[db][st], acc, 0, 0, 0); }
            const float psc = inp(F, I_pool_scale)[l * 256 + g * 64 + 32 * db + r32];
#pragma unroll
            for (int r = 0; r < 16; ++r) *(bf16_t*)(ob + (size_t)((32 * tb2 + (r & 3) + 8 * (r >> 2)) * D + 32 * db) * 2 + lof) = f2bf(acc[r] * psc);
        }
    LDS_WAIT(); asm volatile("" ::: "memory");
}
__device__ __forceinline__ void pool_unit(const Frame& F, int l, int u) {
    const int seg = u & 63, g = (u >> 6) & 3, b = u >> 8;
    if (g == 0) pool_body<2>(F, l, b, g, seg); else if (g == 1) pool_body<4>(F, l, b, g, seg); else if (g == 2) pool_body<8>(F, l, b, g, seg); else pool_body<16>(F, l, b, g, seg);
}

struct Args { const float* in[18]; float* out; unsigned char* ws; int ph_lo, ph_hi; };
constexpr int N_PHASES = 2 + 8 * NL;

__global__ void __launch_bounds__(NTHREADS, 2) trunk_fwd(Args args) {
    extern __shared__ __attribute__((aligned(16))) unsigned char lds_raw[];
    Frame F;
    F.lds = (LAS unsigned char*)lds_raw; F.ws = args.ws; F.ctl = (unsigned*)(args.ws + WS_CTL); F.out = args.out;
    F.tid = threadIdx.x; F.lane = F.tid & 63; F.wave = __builtin_amdgcn_readfirstlane(F.tid >> 6);
    for (int u = F.tid; u < (LDS_BYTES - LDSCTL_OFF) / 4; u += NTHREADS) ((LAS unsigned*)(F.lds + LDSCTL_OFF))[u] = 0u;
    __syncthreads();
    if (F.tid == 0) {
#pragma unroll
        for (int i = 0; i < 18; ++i) ((LAS unsigned long long*)(F.lds + LDSCTL_OFF + LC_INP))[i] = (unsigned long long)args.in[i];
    }
    __syncthreads();
    const int lo = args.ph_lo, hi = args.ph_hi; const bool use_bar = (hi - lo) > 1;
    XcdBarrier bar; bar.bar = F.ctl + CW_BAR; bar.x = 0; bar.st = nullptr;
    if (use_bar) bar = xcd_barrier_post(F.ctl + CW_BAR, (volatile LAS unsigned*)(F.lds + LDSCTL_OFF + LC_BAR));
#ifndef PHMASK
#define PHMASK 0xFFFF
#endif
#define PM(b) ((PHMASK >> (b)) & 1)
#ifndef DUPMASK
#define DUPMASK 0
#endif
#define DUP(b) (1 + ((DUPMASK >> (b)) & 1))
#define FRESH() do { int l_ = (int)__builtin_amdgcn_mbcnt_hi(~0u, __builtin_amdgcn_mbcnt_lo(~0u, 0u)); asm volatile("" : "+v"(l_)); F.lane = l_; F.tid = F.wave * 64 + l_; int b_ = blockIdx.x, g_ = gridDim.x; asm volatile("" : "+s"(b_), "+s"(g_)); F.bid = b_; F.G = g_; } while (0)
#define IN(k) (lo <= (k) && (k) < hi)
#define SEAM(k) do { if (use_bar && (k) + 1 < hi) xcd_barrier(bar, F.tid == 0); } while (0)
    if (IN(0) && PM(0)) { for (int rep = 0; rep < DUP(5); ++rep) { FRESH(); p0_prologue(F); } SEAM(0); }
    for (int l = 0; l < NL; ++l) {
        const int pb = 1 + 8 * l;
        if (IN(pb + 0) && PM(1)) { FRESH(); if (l == 0) r_phase<0, false, false>(F, l, inp(F, I_x), F.out); else r_phase<0, true, true>(F, l, F.out, F.out); SEAM(pb + 0); }
        if (IN(pb + 1) && PM(2)) { FRESH();
            cumsum_step(F);
            pg8::StaticOrder S; S.init(T, NPROJ, D, F.G, F.bid, (const bf16_t*)(F.ws + WS_WIN + l * WIN_BYTES)); S.rep = DUP(2);
            pg8::EpiProj E{(bf16_t*)(F.ws + WS_PA), (const float*)(F.ws + WS_RSTD1), F.ctl + CW_KMAX + l * 64 * 16};
            pg8::gemm_phase<pg8::EpiProj, pg8::StaticOrder, true>(F.tid, F.lds, (const bf16_t*)(F.ws + WS_HB), D, S, E);
            SEAM(pb + 1);
        }
        if (IN(pb + 2) && PM(3)) { FRESH();
            const int gw = F.bid * NWAVES + F.wave, NGW = F.G * NWAVES;
            for (int rep = 0; rep < DUP(0); ++rep) {
            for (int u = gw; u < 2048; u += NGW) pool_unit(F, l, u);
            __syncthreads();
            for (int u = F.wave * F.G + F.bid; u < 32 * HG_NSEG; u += NWAVES * F.G) hg_mfma_unit(F, l, u);
            }
            __syncthreads();
            for (int rep = 0; rep < DUP(1); ++rep)
            for (int u = F.bid; u < 1024; u += F.G) { const int c = u & 255, i = u >> 8, b = c >> 5, hg = (c >> 2) & 7, s = c & 3, h = (hg + 2 * i) & 7, qb = (i == 0) ? s : (i == 1) ? 7 - s : (i == 2) ? 8 + s : 15 - s;
                attn_unit(F, l, b, h, qb); }
            SEAM(pb + 2);
        }
        if (IN(pb + 3) && PM(4)) { FRESH(); hg_fix_phase(F, l); SEAM(pb + 3); }
        if (IN(pb + 4) && PM(5)) { FRESH();
            pg8::StaticOrder S; S.init(T, D, D, F.G, F.bid, (const bf16_t*)(F.ws + WS_WOUT + l * WOUT_BYTES));
            pg8::EpiOut E{l == 0 ? inp(F, I_x) : F.out, F.out};
            pg8::gemm_phase<pg8::EpiOut, pg8::StaticOrder, true>(F.tid, F.lds, (const bf16_t*)(F.ws + WS_MIXED), D, S, E);
            SEAM(pb + 4);
        }
        if (IN(pb + 5) && PM(6)) { FRESH(); r_phase<1, false, false>(F, l, F.out, F.out); SEAM(pb + 5); }
        if ((IN(pb + 6) && PM(7)) || (IN(pb + 7) && PM(8))) { FRESH();
            LAS int* tb = (LAS int*)(F.lds + LDSCTL_OFF + LC_TB); LAS int* cn = (LAS int*)(F.lds + LDSCTL_OFF + LC_CN);
            if (F.tid < NE) cn[F.tid] = (int)__hip_atomic_load(F.ctl + CW_CUR + (l * NE + F.tid) * 16, __ATOMIC_RELAXED, __HIP_MEMORY_SCOPE_AGENT);
            __syncthreads();
            if (F.tid == 0) { int a = 0; for (int e = 0; e < NE; ++e) { tb[e] = a; a += (cn[e] + 255) >> 8; } tb[NE] = a; }
            __syncthreads();
            const int ntile = tb[NE];
            if (IN(pb + 6) && PM(7)) {
                pg8::MoeOrder<true> S; S.rep = DUP(3); S.nM = ntile; S.nN = 2 * FF / 256; S.nwg = S.nM * S.nN; S.G = F.G; S.c = F.bid; S.Wt = (const char*)(F.ws + WS_W1 + (size_t)l * NE * W1E_BYTES); S.estride = W1E_BYTES; S.tstep = (size_t)256 * D * 2;
                S.tb = tb; S.cn = cn; S.list = (const u32x2*)(F.ws + WS_LIST);
                pg8::EpiGlu E{(bf16_t*)(F.ws + WS_PA), (const u32x2*)(F.ws + WS_LIST), (const float*)(F.ws + WS_B1R) + (size_t)l * NE * 2048};
                pg8::gemm_phase<pg8::EpiGlu, pg8::MoeOrder<true>, true>(F.tid, F.lds, (const bf16_t*)(F.ws + WS_HB), D, S, E);
                SEAM(pb + 6);
            }
            if (IN(pb + 7) && PM(8)) { FRESH();
                pg8::MoeOrder<false> S; S.rep = DUP(4); S.nM = ntile; S.nN = D / 256; S.nwg = S.nM * S.nN; S.G = F.G; S.c = F.bid; S.Wt = (const char*)(F.ws + WS_W2 + (size_t)l * NE * W2E_BYTES); S.estride = W2E_BYTES; S.tstep = (size_t)256 * FF * 2;
                S.tb = tb; S.cn = cn; S.list = (const u32x2*)(F.ws + WS_LIST);
                pg8::EpiDown E{(bf16_t*)(F.ws + WS_Y), (const u32x2*)(F.ws + WS_LIST), (const float*)(F.ws + WS_GATE), inp(F, I_b2) + (size_t)l * NE * D};
                pg8::gemm_phase<pg8::EpiDown, pg8::MoeOrder<false>, true>(F.tid, F.lds, (const bf16_t*)(F.ws + WS_PA), FF, S, E);
                SEAM(pb + 7);
            }
        }
    }
    if (IN(N_PHASES - 1) && PM(9)) { FRESH(); r_final(F); }
#undef IN
#undef SEAM
}

extern "C" void kernel_launch(void* const* d_in, const int* in_sizes, int n_in, void* d_out, int out_size, void* d_ws, size_t ws_size, hipStream_t stream) {
    static int grid = 0;
    if (grid == 0) {
        if (n_in != 18 || out_size != T * D || ws_size < WS_END) { fprintf(stderr, "kernel_launch: unexpected shapes (n_in %d out %d ws %zu need %zu)\n", n_in, out_size, ws_size, (size_t)WS_END); grid = -1; return; }
        int dev = 0, cus = 0;
        if (hipGetDevice(&dev) != hipSuccess || hipDeviceGetAttribute(&cus, hipDeviceAttributeMultiprocessorCount, dev) != hipSuccess) { grid = -1; return; }
        if (hipFuncSetAttribute((const void*)trunk_fwd, hipFuncAttributeMaxDynamicSharedMemorySize, LDS_BYTES) != hipSuccess) { fprintf(stderr, "kernel_launch: hipFuncSetAttribute failed\n"); grid = -1; return; }
        int per_cu = 0;
        if (hipOccupancyMaxActiveBlocksPerMultiprocessor(&per_cu, (const void*)trunk_fwd, NTHREADS, LDS_BYTES) != hipSuccess || per_cu < 1) { fprintf(stderr, "kernel_launch: occupancy query says %d\n", per_cu); (void)hipGetLastError(); }
        grid = cus;
    }
    if (grid < 0) return;
    (void)hipMemsetAsync((char*)d_ws + WS_CTL, 0, CTL_ZERO_BYTES, stream);
    Args a{};
    for (int i = 0; i < 18; ++i) a.in[i] = (const float*)d_in[i];
    a.out = (float*)d_out; a.ws = (unsigned char*)d_ws;
#if MK_SPLIT
    for (int p = 0; p < N_PHASES; ++p) { a.ph_lo = p; a.ph_hi = p + 1; hipLaunchKernelGGL(trunk_fwd, dim3(grid), dim3(NTHREADS), LDS_BYTES, stream, a); }
#else
    a.ph_lo = 0; a.ph_hi = N_PHASES; hipLaunchKernelGGL(trunk_fwd, dim3(grid), dim3(NTHREADS), LDS_BYTES, stream, a);
#endif
}
```

```cpp
#include <hip/hip_runtime.h>
#include <cstdio>
#include <cstdint>

#ifndef MK_SPLIT
#define MK_SPLIT 0
#endif

#ifndef DUPMASK
#define DUPMASK 0
#endif
#define DUP(b) (1 + ((DUPMASK >> (b)) & 1))
#define LAS __attribute__((address_space(3)))
#define GAS __attribute__((address_space(1)))
typedef unsigned short bf16_t;
typedef short bf16x8 __attribute__((ext_vector_type(8)));
typedef float f32x4 __attribute__((ext_vector_type(4)));
typedef float f32x2 __attribute__((ext_vector_type(2)));
typedef float f32x16 __attribute__((ext_vector_type(16)));
typedef unsigned u32x4 __attribute__((ext_vector_type(4)));
typedef unsigned u32x2 __attribute__((ext_vector_type(2)));
typedef __bf16 bf16x2_t __attribute__((ext_vector_type(2)));
typedef short v4i16_t __attribute__((ext_vector_type(4)));

constexpr int NB = 8, SEQ = 4096, T = NB * SEQ, D = 1024, NL = 4;
constexpr int NPROJ = 2816;
constexpr int C_FQ = 0, C_FK = 512, C_FV = 1024, C_GQ = 1536, C_GF = 1792, C_GI = 2048, C_GG = 2304, C_PU = 2560;
constexpr int IN_COLS = 2824;
constexpr int NE = 32, TOPK = 4, FF = 1024, MROWS = T * TOPK, LISTCAP = MROWS, MAXTILES = MROWS / 256 + NE;
constexpr float RMS_EPS = 1e-5f, LOG2E = 1.4426950408889634f;
constexpr float QSCALE = 0.125f * LOG2E;
constexpr int NWAVES = 8, NTHREADS = 512;

constexpr size_t MiB = 1u << 20;
constexpr size_t WS_CTL = 0, CTL_ZERO_BYTES = 1 * MiB;
constexpr size_t WS_RSTD1 = 1 * MiB, WS_RSTD2 = WS_RSTD1 + 128 * 1024;
constexpr size_t WS_LOGF = 2 * MiB, WS_C2 = 3 * MiB, WS_GATE = 4 * MiB, WS_B1R = 5 * MiB, WS_WFRAG = 6 * MiB, WS_LIST = 8 * MiB;
constexpr size_t WS_WIN = 40 * MiB, WIN_BYTES = (size_t)NPROJ * D * 2;
constexpr size_t WS_WOUT = 62 * MiB, WOUT_BYTES = (size_t)D * D * 2;
constexpr size_t WS_W1 = 70 * MiB, W1E_BYTES = (size_t)2 * FF * D * 2;
constexpr size_t WS_W2 = 582 * MiB, W2E_BYTES = (size_t)D * FF * 2;
constexpr size_t WS_HB = 838 * MiB;
constexpr size_t WS_PA = 902 * MiB;
constexpr size_t WS_MIXED = WS_PA + 176 * MiB;
constexpr size_t WS_Y = 1174 * MiB;
constexpr size_t WS_ORAW = 1430 * MiB;
constexpr size_t WS_SEND = 1558 * MiB;
constexpr size_t WS_PSEG = 1566 * MiB;
constexpr size_t WS_QE = 1567 * MiB;
constexpr size_t WS_PWT = 1583 * MiB;
constexpr size_t WS_SEND2 = 1584 * MiB;
constexpr size_t WS_END = 1600 * MiB;
static_assert(WS_WIN + NL * WIN_BYTES <= WS_WOUT && WS_WOUT + NL * WOUT_BYTES <= WS_W1 && WS_W1 + (size_t)NL * NE * W1E_BYTES <= WS_W2 && WS_W2 + (size_t)NL * NE * W2E_BYTES <= WS_HB, "ws map");
static_assert((size_t)MAXTILES * 256 * FF * 2 <= 272 * MiB && (size_t)T * NPROJ * 2 <= 176 * MiB, "ws map 2");
constexpr int CW_TMO = 0, CW_BAR = 4096, CW_CUR = 16384, CW_KMAX = 32768, CW_AQ = 40960;
constexpr int PH_BYTES = 139264, LDSCTL_OFF = PH_BYTES, LDS_BYTES = PH_BYTES + 2048;
constexpr int LC_BAR = 0, LC_TB = 64, LC_CN = 256, LC_R2CNT = 512, LC_R2BASE = 640, LC_STOP = 768, LC_SCAN = 896, LC_INP = 1024, LC_AQ = 1280;

__device__ __forceinline__ unsigned cvtpk(float lo, float hi) { f32x2 v = {lo, hi}; bf16x2_t b = __builtin_convertvector(v, bf16x2_t); return __builtin_bit_cast(unsigned, b); }
__device__ __forceinline__ float bflo(unsigned w) { return __uint_as_float(w << 16); }
__device__ __forceinline__ float bfhi(unsigned w) { return __uint_as_float(w & 0xffff0000u); }
__device__ __forceinline__ float bf2f(bf16_t h) { return __uint_as_float((unsigned)h << 16); }
__device__ __forceinline__ bf16_t f2bf(float f) { return (bf16_t)(cvtpk(f, 0.f) & 0xffffu); }
__device__ __forceinline__ float rdlane(float v, int l) { return __uint_as_float((unsigned)__builtin_amdgcn_readlane((int)__float_as_uint(v), l)); }
#define LDS_WAIT() asm volatile("s_waitcnt lgkmcnt(0)" ::: "memory")
#define VM_WAIT() asm volatile("s_waitcnt vmcnt(0)" ::: "memory")

namespace pg8 {
constexpr int BM = 256, BK = 64, HALF = 128, HTB = HALF * BK * 2, STAGE_BYTES = 8 * HTB, NXCD = 8, WGM = 8;
__host__ __device__ __forceinline__ int lds_byte(int r, int c) { const int st = (r >> 4) * 2 + (c >> 5), rr = r & 15, cc = c & 31, ob = rr * 64 + cc * 2; return st * 1024 + (ob ^ (((ob >> 9) & 1) << 5)); }
__host__ __device__ __forceinline__ void stage_rc(int b, int& R, int& C) { const int st = b / 1024, sb = b % 1024, swz = sb ^ (((sb >> 9) & 1) << 5); R = (st >> 1) * 16 + swz / 64; C = (st & 1) * 32 + (swz % 64) / 2; }
__host__ __device__ __forceinline__ int perm32(int rho) { const int n = rho >> 4, i = rho & 15; return 8 * (i >> 2) + 4 * n + (i & 3); }

struct Unit { int pm, pn, e, lt, cnt; };

__device__ __forceinline__ void tile_of(int L, int nM, int nN, int& pm, int& pn) {
    const int nwg = nM * nN; int wgid = L;
    { const int q = nwg / NXCD, r = nwg % NXCD, xcd = wgid % NXCD, off = wgid / NXCD; wgid = (xcd < r ? xcd * (q + 1) : r * (q + 1) + (xcd - r) * q) + off; }
    const int nig = WGM * nN, gid = wgid / nig, fm = gid * WGM, gsz = (nM - fm) < WGM ? (nM - fm) : WGM;
    pm = fm + ((wgid % nig) % gsz); pn = (wgid % nig) / gsz;
}
struct StaticOrder {
    int nM, nN, nwg, G, c, rep = 1; const char* Bt; size_t tstep;
    __device__ void init(int M, int N, int K, int G_, int c_, const bf16_t* Bt_) { nM = M / BM; nN = N / BM; nwg = nM * nN; G = G_; c = c_; Bt = (const char*)Bt_; tstep = (size_t)BM * K * 2; }
    __device__ __forceinline__ bool next(int i, Unit& u) const { long L = (long)i * G + c; if (L >= (long)nwg * rep) return false; L %= nwg; tile_of((int)L, nM, nN, u.pm, u.pn); u.e = 0; u.lt = 0; u.cnt = 0; return true; }
    __device__ __forceinline__ const char* bbase(const Unit& u) const { return Bt + (size_t)u.pn * tstep; }
    __device__ __forceinline__ int arow(const Unit& u, int r) const { return u.pm * BM + r; }
};
template <bool GATHER> struct MoeOrder {
    int nM, nN, nwg, G, c, rep = 1; const char* Wt; size_t estride, tstep; LAS const int* tb; LAS const int* cn; const u32x2* list;
    __device__ __forceinline__ bool next(int i, Unit& u) const {
        long L = (long)i * G + c; if (L >= (long)nwg * rep) return false; L %= nwg; tile_of((int)L, nM, nN, u.pm, u.pn);
        int e = 0; while (e < NE - 1 && tb[e + 1] <= u.pm) ++e;
        u.e = e; u.lt = u.pm - tb[e]; u.cnt = cn[e]; return true; }
    __device__ __forceinline__ const char* bbase(const Unit& u) const { return Wt + (size_t)u.e * estride + (size_t)u.pn * tstep; }
    __device__ __forceinline__ int arow(const Unit& u, int r) const {
        if (!GATHER) return u.pm * BM + r;
        const int pos = u.lt * BM + r; return pos < u.cnt ? (int)(list[(size_t)u.e * LISTCAP + pos].x >> 2) : 0; }
};

template <class Epi, class Sched, bool ALIGN_EPI>
__device__ __forceinline__ void gemm_phase(const int tid, LAS unsigned char* lds, const bf16_t* Abase, const int K, const Sched& S, const Epi& E) {
    const int wid = __builtin_amdgcn_readfirstlane(tid >> 6), lane = tid & 63, wr = wid >> 2, wc = wid & 3, fr = lane & 15, fq = lane >> 4;
    const int nt = K / BK;
    unsigned voffB[2];
#pragma unroll
    for (int i = 0; i < 2; ++i) { int R, C; stage_rc(tid * 16 + i * 8192, R, C); const int Rb = Epi::PERM ? ((R & ~31) + perm32(R & 31)) : R; voffB[i] = (unsigned)(Rb * K + C) * 2u; }
    const size_t kstep = (size_t)(BK * 2);
    const size_t hstep = (size_t)HALF * K * 2;
    const unsigned ldsw = (unsigned)wid * 1024u;
    const int aoff = lds_byte(wr * 64 + fr, fq * 8), boff = lds_byte(wc * 32 + fr, fq * 8);
    const char* A8 = (const char*)Abase;
#define PG8_SA(b, h) (((b) * 2 + (h)) * HTB)
#define PG8_SB(b, h) ((4 + (b) * 2 + (h)) * HTB)
#define PG8_STGB(bufoff, gbase) do { _Pragma("unroll") for (int _i = 0; _i < 2; ++_i) \
        __builtin_amdgcn_global_load_lds((const unsigned*)((const char*)(gbase) + voffB[_i]), (LAS unsigned*)(lds + (bufoff) + ldsw + _i * 8192), 16, 0, 0); } while (0)
#define PG8_STGA(bufoff, kb, o0, o1) do { \
        __builtin_amdgcn_global_load_lds((const unsigned*)(A8 + (size_t)(kb) + (o0)), (LAS unsigned*)(lds + (bufoff) + ldsw), 16, 0, 0); \
        __builtin_amdgcn_global_load_lds((const unsigned*)(A8 + (size_t)(kb) + (o1)), (LAS unsigned*)(lds + (bufoff) + ldsw + 8192), 16, 0, 0); } while (0)
#define PG8_LDA(dst, b, h) do { _Pragma("unroll") for (int m = 0; m < 4; ++m) _Pragma("unroll") for (int k = 0; k < 2; ++k) dst[m][k] = *(const LAS bf16x8*)(lds + PG8_SA(b, h) + aoff + m * 2048 + k * 1024); } while (0)
#define PG8_LDB(dst, b, h) do { _Pragma("unroll") for (int n = 0; n < 2; ++n) _Pragma("unroll") for (int k = 0; k < 2; ++k) dst[n][k] = *(const LAS bf16x8*)(lds + PG8_SB(b, h) + boff + n * 2048 + k * 1024); } while (0)
#define PG8_MMA(ai, bj, At, Bt) do { __builtin_amdgcn_s_setprio(1); _Pragma("unroll") for (int m = 0; m < 4; ++m) _Pragma("unroll") for (int n = 0; n < 2; ++n) _Pragma("unroll") for (int k = 0; k < 2; ++k) \
        acc[ai][bj][m][n] = __builtin_amdgcn_mfma_f32_16x16x32_bf16(Bt[n][k], At[m][k], acc[ai][bj][m][n], 0, 0, 0); __builtin_amdgcn_s_setprio(0); } while (0)
#define PG8_WAIT_V(n) asm volatile("s_waitcnt vmcnt(" #n ")" ::: "memory")
#define PG8_WAIT_L(n) asm volatile("s_waitcnt lgkmcnt(" #n ")" ::: "memory")
#define PG8_BAR __builtin_amdgcn_s_barrier()
#define PG8_SCHED __builtin_amdgcn_sched_barrier(0)
#define PG8_AOFF(u, dst) do { _Pragma("unroll") for (int _h = 0; _h < 2; ++_h) _Pragma("unroll") for (int _i = 0; _i < 2; ++_i) \
        { int R_, C_; stage_rc(tid * 16 + _i * 8192, R_, C_); dst[_h][_i] = (unsigned)((size_t)S.arow(u, _h * HALF + R_) * (size_t)K + (size_t)C_) * 2u; } } while (0)
    Unit cur, nxt; int ui = 0;
    if (!S.next(0, cur)) return;
    f32x4 acc[2][2][4][2];
#pragma unroll
    for (int a = 0; a < 2; ++a)
#pragma unroll
        for (int b = 0; b < 2; ++b)
#pragma unroll
            for (int m = 0; m < 4; ++m)
#pragma unroll
                for (int n = 0; n < 2; ++n) acc[a][b][m][n] = (f32x4){0.f, 0.f, 0.f, 0.f};
    bf16x8 At[4][2], B0[2][2], B1[2][2];
    unsigned aoC[2][2], aoN[2][2];
    PG8_AOFF(cur, aoC);
    const char* cB = S.bbase(cur);
    PG8_STGB(PG8_SB(0, 0), cB); PG8_STGB(PG8_SB(0, 1), cB + hstep); PG8_STGA(PG8_SA(0, 0), 0, aoC[0][0], aoC[0][1]); PG8_STGA(PG8_SA(0, 1), 0, aoC[1][0], aoC[1][1]);
    if (wr == 1) PG8_BAR;
    PG8_WAIT_V(2); PG8_BAR;
    PG8_STGB(PG8_SB(1, 0), cB + kstep); PG8_STGA(PG8_SA(1, 0), kstep, aoC[0][0], aoC[0][1]); PG8_STGB(PG8_SB(1, 1), cB + hstep + kstep);
    PG8_WAIT_V(6); PG8_BAR;
    for (;;) {
        const bool has_next = S.next(ui + 1, nxt);
        if (has_next) { PG8_AOFF(nxt, aoN); } else { aoN[0][0] = aoC[0][0]; aoN[0][1] = aoC[0][1]; aoN[1][0] = aoC[1][0]; aoN[1][1] = aoC[1][1]; }
        const char* nB = has_next ? S.bbase(nxt) : cB;
        for (int t = 0; t < nt; t += 2) {
            const bool last = (t == nt - 2);
            const size_t k1 = (size_t)(t + 1) * kstep, k2 = last ? 0 : (size_t)(t + 2) * kstep, k3 = k2 + kstep;
            const char* b2 = last ? nB : cB + (size_t)(t + 2) * kstep; const char* b3 = b2 + kstep;
            const unsigned a200 = last ? aoN[0][0] : aoC[0][0], a201 = last ? aoN[0][1] : aoC[0][1], a210 = last ? aoN[1][0] : aoC[1][0], a211 = last ? aoN[1][1] : aoC[1][1];
            PG8_LDB(B0, 0, 0); PG8_LDB(B1, 0, 1); PG8_SCHED; PG8_LDA(At, 0, 0); PG8_STGA(PG8_SA(1, 1), k1, aoC[1][0], aoC[1][1]);
            PG8_WAIT_V(8); PG8_WAIT_L(0); PG8_BAR; PG8_MMA(0, 0, At, B0); PG8_MMA(0, 1, At, B1); PG8_BAR; PG8_SCHED;
            PG8_LDA(At, 0, 1); PG8_STGB(PG8_SB(0, 0), b2); PG8_STGB(PG8_SB(0, 1), b2 + hstep); PG8_STGA(PG8_SA(0, 0), k2, a200, a201);
            PG8_WAIT_V(8); PG8_WAIT_L(0); PG8_BAR; PG8_MMA(1, 0, At, B0); PG8_MMA(1, 1, At, B1); PG8_BAR; PG8_SCHED;
            PG8_LDB(B0, 1, 0); PG8_LDB(B1, 1, 1); PG8_SCHED; PG8_LDA(At, 1, 0); PG8_STGA(PG8_SA(0, 1), k2, a210, a211);
            PG8_WAIT_V(8); PG8_WAIT_L(0); PG8_BAR; PG8_MMA(0, 0, At, B0); PG8_MMA(0, 1, At, B1); PG8_BAR; PG8_SCHED;
            PG8_LDA(At, 1, 1); PG8_STGB(PG8_SB(1, 0), b3); PG8_STGB(PG8_SB(1, 1), b3 + hstep); PG8_STGA(PG8_SA(1, 0), k3, a200, a201);
            PG8_WAIT_V(8); PG8_WAIT_L(0); PG8_BAR; PG8_MMA(1, 0, At, B0); PG8_MMA(1, 1, At, B1); PG8_BAR; PG8_SCHED;
        }
        if constexpr (ALIGN_EPI) { if (wr == 0) PG8_BAR; }
        E(acc, cur, wr, wc, fr, fq);
        if (!has_next) break;
#pragma unroll
        for (int a = 0; a < 2; ++a)
#pragma unroll
            for (int b = 0; b < 2; ++b)
#pragma unroll
                for (int m = 0; m < 4; ++m)
#pragma unroll
                    for (int n = 0; n < 2; ++n) acc[a][b][m][n] = (f32x4){0.f, 0.f, 0.f, 0.f};
        cur = nxt; cB = nB; ++ui;
        aoC[0][0] = aoN[0][0]; aoC[0][1] = aoN[0][1]; aoC[1][0] = aoN[1][0]; aoC[1][1] = aoN[1][1];
        if constexpr (ALIGN_EPI) { if (wr == 1) PG8_BAR; }
    }
    PG8_WAIT_V(0);
    if constexpr (!ALIGN_EPI) { if (wr == 0) PG8_BAR; }
    PG8_BAR;
#undef PG8_SA
#undef PG8_SB
#undef PG8_STGA
#undef PG8_STGB
#undef PG8_LDA
#undef PG8_LDB
#undef PG8_MMA
#undef PG8_WAIT_V
#undef PG8_WAIT_L
#undef PG8_BAR
#undef PG8_SCHED
#undef PG8_AOFF
}

struct EpiProj {
    static constexpr bool PERM = true;
    bf16_t* O; const float* rstd; unsigned* kmax;
    __device__ __forceinline__ void operator()(const f32x4 (&acc)[2][2][4][2], const Unit& u, int wr, int wc, int fr, int fq) const {
        const int row0 = u.pm * BM + wr * 64 + fr, col0 = u.pn * BM + wc * 32 + 8 * fq;
        const float sc = (u.pn < 2) ? QSCALE : 1.f; const bool isk = (u.pn == 2 || u.pn == 3);
        float km[2] = {0.f, 0.f};
#pragma unroll
        for (int ai = 0; ai < 2; ++ai)
#pragma unroll
            for (int m = 0; m < 4; ++m) { const int row = row0 + ai * HALF + m * 16; const float rs = rstd[row] * sc; bf16_t* rowp = O + (size_t)row * NPROJ + col0;
#pragma unroll
                for (int bj = 0; bj < 2; ++bj) { const f32x4 v0 = acc[ai][bj][m][0] * rs, v1 = acc[ai][bj][m][1] * rs;
                    u32x4 w; w.x = cvtpk(v0[0], v0[1]); w.y = cvtpk(v0[2], v0[3]); w.z = cvtpk(v1[0], v1[1]); w.w = cvtpk(v1[2], v1[3]);
                    *(u32x4*)(rowp + bj * HALF) = w;
                    if (isk) { float s = bflo(w.x) * bflo(w.x) + bfhi(w.x) * bfhi(w.x) + bflo(w.y) * bflo(w.y) + bfhi(w.y) * bfhi(w.y) + bflo(w.z) * bflo(w.z) + bfhi(w.z) * bfhi(w.z) + bflo(w.w) * bflo(w.w) + bfhi(w.w) * bfhi(w.w);
                        s += __shfl_xor(s, 16); s += __shfl_xor(s, 32); km[bj] = fmaxf(km[bj], s); } } }
        if (isk) {
#pragma unroll
            for (int bj = 0; bj < 2; ++bj) { float v = km[bj]; v = fmaxf(v, __shfl_xor(v, 1)); v = fmaxf(v, __shfl_xor(v, 2)); v = fmaxf(v, __shfl_xor(v, 4)); v = fmaxf(v, __shfl_xor(v, 8));
                if ((threadIdx.x & 63) == 0) { const int b = u.pm >> 4, h = (u.pn - 2) * 4 + bj * 2 + (wc >> 1); atomicMax(kmax + (b * 8 + h) * 16, __float_as_uint(v)); } }
        }
    }
};
struct EpiOut {
    static constexpr bool PERM = false;
    const float* res; float* out;
    __device__ __forceinline__ void operator()(const f32x4 (&acc)[2][2][4][2], const Unit& u, int wr, int wc, int fr, int fq) const {
        const int row0 = u.pm * BM + wr * 64 + fr, col0 = u.pn * BM + wc * 32 + 4 * fq;
#pragma unroll
        for (int ai = 0; ai < 2; ++ai)
#pragma unroll
            for (int m = 0; m < 4; ++m) { const size_t off = (size_t)(row0 + ai * HALF + m * 16) * D + col0;
#pragma unroll
                for (int bj = 0; bj < 2; ++bj)
#pragma unroll
                    for (int n = 0; n < 2; ++n) { const f32x4 r = *(const f32x4*)(res + off + bj * HALF + n * 16); *(f32x4*)(out + off + bj * HALF + n * 16) = r + acc[ai][bj][m][n]; } }
    }
};
struct EpiGlu {
    static constexpr bool PERM = true;
    bf16_t* act; const u32x2* list; const float* b1r;
    __device__ __forceinline__ void operator()(const f32x4 (&acc)[2][2][4][2], const Unit& u, int wr, int wc, int fr, int fq) const {
        const int cb = u.pn * BM + wc * 32 + 8 * fq; const float* bp = b1r + (size_t)u.e * 2048 + cb;
        const f32x4 bg0 = *(const f32x4*)(bp), bg1 = *(const f32x4*)(bp + 4), bl0 = *(const f32x4*)(bp + HALF), bl1 = *(const f32x4*)(bp + HALF + 4);
#pragma unroll
        for (int ai = 0; ai < 2; ++ai)
#pragma unroll
            for (int m = 0; m < 4; ++m) { const int r = ai * HALF + wr * 64 + m * 16 + fr, pos = u.lt * BM + r;
                float rs = 0.f; if (pos < u.cnt) rs = __uint_as_float(list[(size_t)u.e * LISTCAP + pos].y);
                f32x4 g0 = acc[ai][0][m][0] * rs + bg0, g1 = acc[ai][0][m][1] * rs + bg1, l0 = acc[ai][1][m][0] * rs + bl0, l1 = acc[ai][1][m][1] * rs + bl1;
                float o[8];
#pragma unroll
                for (int j = 0; j < 8; ++j) { float g = j < 4 ? g0[j & 3] : g1[j & 3], li = j < 4 ? l0[j & 3] : l1[j & 3];
                    g = fminf(g, 7.f); li = fminf(fmaxf(li, -7.f), 7.f);
                    const float sg = __builtin_amdgcn_rcpf(1.f + __builtin_amdgcn_exp2f(-1.702f * LOG2E * g)); o[j] = g * sg * (li + 1.f); }
                u32x4 w; w.x = cvtpk(o[0], o[1]); w.y = cvtpk(o[2], o[3]); w.z = cvtpk(o[4], o[5]); w.w = cvtpk(o[6], o[7]);
                *(u32x4*)(act + (size_t)(u.pm * BM + r) * FF + u.pn * HALF + wc * 32 + 8 * fq) = w; }
    }
};
struct EpiDown {
    static constexpr bool PERM = true;
    bf16_t* Y; const u32x2* list; const float* gate; const float* b2;
    __device__ __forceinline__ void operator()(const f32x4 (&acc)[2][2][4][2], const Unit& u, int wr, int wc, int fr, int fq) const {
        const int cb = u.pn * BM + wc * 32 + 8 * fq; const float* bp = b2 + (size_t)u.e * D + cb;
        f32x4 bv[2][2];
#pragma unroll
        for (int bj = 0; bj < 2; ++bj)
#pragma unroll
            for (int n = 0; n < 2; ++n) bv[bj][n] = *(const f32x4*)(bp + bj * HALF + 4 * n);
#pragma unroll
        for (int ai = 0; ai < 2; ++ai)
#pragma unroll
            for (int m = 0; m < 4; ++m) { const int r = ai * HALF + wr * 64 + m * 16 + fr, pos = u.lt * BM + r;
                if (pos < u.cnt) { const unsigned ent = list[(size_t)u.e * LISTCAP + pos].x; const float gt = gate[ent]; bf16_t* rowp = Y + (size_t)ent * D + cb;
#pragma unroll
                    for (int bj = 0; bj < 2; ++bj) { const f32x4 v0 = (acc[ai][bj][m][0] + bv[bj][0]) * gt, v1 = (acc[ai][bj][m][1] + bv[bj][1]) * gt;
                        u32x4 w; w.x = cvtpk(v0[0], v0[1]); w.y = cvtpk(v0[2], v0[3]); w.z = cvtpk(v1[0], v1[1]); w.w = cvtpk(v1[2], v1[3]);
                        *(u32x4*)(rowp + bj * HALF) = w; } } }
    }
};
}

#define XB_TMO      128
#define XB_XCNT(j)  (256  + 64 * (j))
#define XB_XSUB(j)  (1280 + 64 * (j))
#define XB_XGEN(j)  (2304 + 64 * (j))
#define XB_TOP      3328
#define XB_TOPGEN   3392
#define XCD_BAR_WORDS 3456
#define XB_SPIN_CAP (1u << 18)
__device__ __forceinline__ unsigned xb_ld(unsigned* p)              { return __hip_atomic_load(p, __ATOMIC_RELAXED, __HIP_MEMORY_SCOPE_AGENT); }
__device__ __forceinline__ unsigned xb_add(unsigned* p, unsigned v) { return __hip_atomic_fetch_add(p, v, __ATOMIC_RELAXED, __HIP_MEMORY_SCOPE_AGENT); }
__device__ __forceinline__ unsigned xb_xcc_id() { return (unsigned)__builtin_amdgcn_s_getreg((3 << 11) | 20) & 0xFu; }
#define XB_SPIN(cond, bar) do { unsigned _sp = 0; while (cond) { __builtin_amdgcn_s_sleep(1); \
    if ((++_sp & 255u) == 0u) { if (xb_ld(&(bar)[XB_TMO])) break; if (_sp > XB_SPIN_CAP) { atomicAdd(&(bar)[XB_TMO], 1u); break; } } } } while (0)
struct XcdBarrier { unsigned* bar; unsigned x; volatile LAS unsigned* st; };
__device__ __forceinline__ XcdBarrier xcd_barrier_post(unsigned* bar, volatile LAS unsigned* st) {
    XcdBarrier b; b.bar = bar; b.x = xb_xcc_id(); b.st = st;
    if (threadIdx.x == 0) (void)xb_add(&bar[XB_XCNT(b.x)], 1u);
    return b;
}
__device__ __forceinline__ void xcd_barrier_complete(unsigned* bar, unsigned x, unsigned& nloc, unsigned& nx) {
    const unsigned G = gridDim.x * gridDim.y * gridDim.z;
    unsigned sum, cnt, mine, sp = 0u;
    for (;;) {
        sum = 0u; cnt = 0u; mine = 0u;
#pragma unroll
        for (unsigned j = 0; j < 16; ++j) { const unsigned c = xb_ld(&bar[XB_XCNT(j)]); sum += c; cnt += (c > 0u) ? 1u : 0u; mine = (j == x) ? c : mine; }
        if (sum == G) break;
        __builtin_amdgcn_s_sleep(1);
        if ((++sp & 255u) == 0u) { if (xb_ld(&bar[XB_TMO])) break; if (sp > XB_SPIN_CAP) { atomicAdd(&bar[XB_TMO], 1u); break; } }
    }
    nloc = mine > 0u ? mine : 1u; nx = cnt > 0u ? cnt : 1u;
}
__device__ __forceinline__ void xcd_barrier(const XcdBarrier& b, const bool leader  ) {
    asm volatile("s_waitcnt vmcnt(0)" ::: "memory");
    __syncthreads();
    if (leader) {
        unsigned* bar = b.bar;
        __builtin_amdgcn_s_waitcnt(0);
        unsigned nloc = b.st[0], nx = b.st[1];
        if (nloc == 0u) { xcd_barrier_complete(bar, b.x, nloc, nx); b.st[0] = nloc; b.st[1] = nx; }
        const unsigned old = xb_add(&bar[XB_XSUB(b.x)], 1u);
        const unsigned gen = old / nloc;
        if (old + 1u == (gen + 1u) * nloc) {
            __builtin_amdgcn_fence(__ATOMIC_RELEASE, "agent");
            asm volatile("s_waitcnt vmcnt(0)" ::: "memory");
            const unsigned og = xb_add(&bar[XB_TOP], 1u);
            const unsigned tg = og / nx;
            if (og + 1u == (tg + 1u) * nx) xb_add(&bar[XB_TOPGEN], 1u);
            else XB_SPIN(xb_ld(&bar[XB_TOPGEN]) == tg, bar);
            __builtin_amdgcn_fence(__ATOMIC_ACQUIRE, "agent");
            xb_add(&bar[XB_XGEN(b.x)], 1u);
            asm volatile("s_waitcnt vmcnt(0)" ::: "memory");
        } else {
            XB_SPIN(xb_ld(&bar[XB_XGEN(b.x)]) == gen, bar);
            __builtin_amdgcn_fence(__ATOMIC_ACQUIRE, "agent");
            asm volatile("s_waitcnt vmcnt(0)" ::: "memory");
        }
    }
    __syncthreads();
}

enum { I_x = 0, I_norm_mix, I_w_in, I_b_fox_f, I_fox_gain, I_hgrn_lb, I_hgrn_gain, I_pool_w, I_pool_scale, I_w_out, I_norm_moe, I_w_router, I_b_router, I_w1, I_b1, I_w2, I_b2, I_norm_final };
struct Frame {
    LAS unsigned char* lds; unsigned char* ws; unsigned* ctl; float* out;
    int tid, lane, wave, bid, G;
};
__device__ __forceinline__ const float* inp(const Frame& F, int i) {
    const LAS unsigned* p = (const LAS unsigned*)(F.lds + LDSCTL_OFF + LC_INP) + 2 * i;
    const unsigned lo = __builtin_amdgcn_readfirstlane(p[0]), hi = __builtin_amdgcn_readfirstlane(p[1]);
    return (const float*)(((unsigned long long)hi << 32) | lo);
}

constexpr int P0_ROWB = 272;
template <bool INTERLEAVED>
__device__ __forceinline__ void p0_item(const float* src  , int ldn, const float* g  , bf16_t* dst  , int K, int drow0, int extra, LAS unsigned char* tile, int lane) {
    f32x4 v[16];
    const float* sp = src + (size_t)(lane >> 5) * ldn + 4 * (lane & 31);
#pragma unroll
    for (int j = 0; j < 16; ++j) v[j] = __builtin_nontemporal_load((const f32x4*)(sp + (size_t)(2 * j) * ldn));
    if (g) {
#pragma unroll
        for (int j = 0; j < 16; ++j) v[j] = v[j] * g[2 * j + (lane >> 5)];
    }
#pragma unroll
    for (int j = 0; j < 16; ++j) { const int k = 2 * j + (lane >> 5); const unsigned w0 = cvtpk(v[j][0], v[j][1]), w1 = cvtpk(v[j][2], v[j][3]);
        if (INTERLEAVED) { const unsigned gg = (w0 & 0xffffu) | (w1 << 16), ll = (w0 >> 16) | (w1 & 0xffff0000u);
            *(LAS unsigned*)(tile + k * P0_ROWB + 4 * (lane & 31)) = gg; *(LAS unsigned*)(tile + k * P0_ROWB + 128 + 4 * (lane & 31)) = ll; }
        else *(LAS u32x2*)(tile + k * P0_ROWB + 8 * (lane & 31)) = (u32x2){w0, w1}; }
    LDS_WAIT(); asm volatile("" ::: "memory");
    const int gq = lane >> 4, i16 = lane & 15;
    const LAS unsigned char* rp = tile + (8 * gq + (i16 >> 2)) * P0_ROWB + 8 * (lane & 3);
#pragma unroll
    for (int nb = 0; nb < 8; ++nb) {
        const v4i16_t lo = __builtin_amdgcn_ds_read_tr16_b64_v4i16((LAS v4i16_t*)(rp + nb * 32)), hi = __builtin_amdgcn_ds_read_tr16_b64_v4i16((LAS v4i16_t*)(rp + nb * 32 + 4 * P0_ROWB));
        const int tc = nb * 16 + i16, row = drow0 + tc + (tc >= 64 ? extra : 0);
        const bf16x8 o = (bf16x8){lo[0], lo[1], lo[2], lo[3], hi[0], hi[1], hi[2], hi[3]};
        *(bf16x8*)(dst + (size_t)row * K + 8 * gq) = o; }
    LDS_WAIT(); asm volatile("" ::: "memory");
}
__device__ __forceinline__ void p0_prologue(const Frame& F) {
    LAS unsigned char* tile = F.lds + F.wave * (32 * P0_ROWB);
    const int gw = F.bid * NWAVES + F.wave, NGW = F.G * NWAVES;
    constexpr int I_IN = 32 * 22, I_OUT = 32 * 8, I_W1 = NE * 32 * 16, I_W2 = NE * 32 * 8, I_L = I_IN + I_OUT + I_W1 + I_W2;
    for (int it = gw; it < NL * I_L; it += NGW) {
        const int l = it / I_L; int r = it % I_L;
        if (r < I_IN) { const int nb = r / 32, kb = r % 32, n0 = 128 * nb, k0 = 32 * kb;
            p0_item<false>(inp(F, I_w_in) + ((size_t)l * D + k0) * IN_COLS + n0 + (n0 >= 1536 ? 8 : 0), IN_COLS, inp(F, I_norm_mix) + l * D + k0, (bf16_t*)(F.ws + WS_WIN + l * WIN_BYTES) + k0, D, n0, 0, tile, F.lane); continue; }
        r -= I_IN;
        if (r < I_OUT) { const int nb = r / 32, kb = r % 32, n0 = 128 * nb, k0 = 32 * kb;
            p0_item<false>(inp(F, I_w_out) + ((size_t)l * D + k0) * D + n0, D, nullptr, (bf16_t*)(F.ws + WS_WOUT + l * WOUT_BYTES) + k0, D, n0, 0, tile, F.lane); continue; }
        r -= I_OUT;
        if (r < I_W1) { const int e = r / (32 * 16), q = r % (32 * 16), cb = q / 32, kb = q % 32, k0 = 32 * kb, j0 = 64 * cb;
            p0_item<true>(inp(F, I_w1) + (((size_t)l * NE + e) * D + k0) * (2 * FF) + 2 * j0, 2 * FF, inp(F, I_norm_moe) + l * D + k0, (bf16_t*)(F.ws + WS_W1 + ((size_t)l * NE + e) * W1E_BYTES) + k0, D, (j0 >> 7) * 256 + (j0 & 127), 64, tile, F.lane); continue; }
        r -= I_W1;
        { const int e = r / (32 * 8), q = r % (32 * 8), nb = q / 32, kb = q % 32, n0 = 128 * nb, k0 = 32 * kb;
            p0_item<false>(inp(F, I_w2) + (((size_t)l * NE + e) * FF + k0) * D + n0, D, nullptr, (bf16_t*)(F.ws + WS_W2 + ((size_t)l * NE + e) * W2E_BYTES) + k0, FF, n0, 0, tile, F.lane); }
    }
    const int gt = F.bid * NTHREADS + F.tid, NGT = F.G * NTHREADS;
    float* b1r = (float*)(F.ws + WS_B1R);
    for (int i = gt; i < NL * NE * 2048; i += NGT) { const int le = i >> 11, n = i & 2047, pn = n >> 8, rr = n & 255; b1r[i] = inp(F, I_b1)[(size_t)le * 2048 + 2 * (128 * pn + (rr & 127)) + (rr >> 7)]; }
    { bf16_t* pwt = (bf16_t*)(F.ws + WS_PWT);
      for (int i = gt; i < NL * 4 * 64 * 64; i += NGT) { const int c = i & 63, d = (i >> 6) & 63, lg = i >> 12; pwt[i] = f2bf(inp(F, I_pool_w)[((size_t)lg * 64 + c) * 64 + d]); } }
    bf16_t* wf = (bf16_t*)(F.ws + WS_WFRAG);
    for (int i = gt; i < NL * 2 * 32 * 2 * 64 * 8; i += NGT) {
        const int j = i & 7, ln = (i >> 3) & 63, et = (i >> 9) & 1, ks = (i >> 10) & 31, kind = (i >> 15) & 1, l = i >> 16;
        const int e = 16 * et + (ln & 15), k = 32 * ks + 8 * (ln >> 4) + j;
        float v;
        if (kind == 0) v = (e < 8) ? inp(F, I_norm_mix)[l * D + k] * inp(F, I_w_in)[((size_t)l * D + k) * IN_COLS + 1536 + e] : 0.f;
        else v = inp(F, I_norm_moe)[l * D + k] * inp(F, I_w_router)[((size_t)l * D + k) * NE + e];
        const bf16_t h = f2bf(v), lo = f2bf(v - bf2f(h));
        const size_t base = ((((size_t)(l * 2 + kind) * 32 + ks) * 2 + et) * 2) * 512 + ln * 8 + j;
        wf[base] = h; wf[base + 512] = lo;
    }
}

template <int KIND, bool COMBINE, bool WRITE_H, bool DRY = false>
__device__ __forceinline__ void r_phase(const Frame& F, int l, const float* hin, float* hout) {
    const int lane = F.lane, r16 = lane & 15, q4 = lane >> 4;
    const u32x4* Wf = (const u32x4*)(F.ws + WS_WFRAG + (size_t)(l * 2 + KIND) * 131072);
    const bf16_t* Y = (const bf16_t*)(F.ws + WS_Y);
    bf16_t* HB = (bf16_t*)(F.ws + WS_HB);
    float* rstdp = (float*)(F.ws + (KIND == 0 ? WS_RSTD1 : WS_RSTD2));
    LAS float* lg = (LAS float*)(F.lds) + F.wave * (16 * 33);
    LAS int* r2cnt = (LAS int*)(F.lds + LDSCTL_OFF + LC_R2CNT); LAS int* r2base = (LAS int*)(F.lds + LDSCTL_OFF + LC_R2BASE);
    for (int task = F.bid; task < T / 128; task += F.G) {
        const int tok = task * 128 + F.wave * 16 + r16;
        const float* xr = hin + (size_t)tok * D + 8 * q4; float* ho = hout + (size_t)tok * D + 8 * q4;
        const bf16_t* yr = Y + (size_t)tok * 4 * D + 8 * q4; bf16_t* hbr = HB + (size_t)tok * D + 8 * q4;
        f32x4 acc0 = {0.f, 0.f, 0.f, 0.f}, acc1 = {0.f, 0.f, 0.f, 0.f}; float ssq = 0.f;
        if (KIND == 1) { if (F.tid < 32) r2cnt[F.tid] = 0; }
#pragma unroll 2
        for (int ks = 0; ks < 32; ++ks) {
            f32x4 x0 = *(const f32x4*)(xr + 32 * ks), x1 = *(const f32x4*)(xr + 32 * ks + 4);
            if (COMBINE) {
#pragma unroll
                for (int k = 0; k < 4; ++k) { const u32x4 y = *(const u32x4*)(yr + (size_t)k * D + 32 * ks);
                    x0[0] += bflo(y.x); x0[1] += bfhi(y.x); x0[2] += bflo(y.y); x0[3] += bfhi(y.y); x1[0] += bflo(y.z); x1[1] += bfhi(y.z); x1[2] += bflo(y.w); x1[3] += bfhi(y.w); }
            }
            if (WRITE_H) { *(f32x4*)(ho + 32 * ks) = x0; *(f32x4*)(ho + 32 * ks + 4) = x1; }
            ssq += (x0[0] * x0[0] + x0[1] * x0[1]) + (x0[2] * x0[2] + x0[3] * x0[3]) + (x1[0] * x1[0] + x1[1] * x1[1]) + (x1[2] * x1[2] + x1[3] * x1[3]);
            u32x4 hw; hw.x = cvtpk(x0[0], x0[1]); hw.y = cvtpk(x0[2], x0[3]); hw.z = cvtpk(x1[0], x1[1]); hw.w = cvtpk(x1[2], x1[3]);
            u32x4 lw; lw.x = cvtpk(x0[0] - bflo(hw.x), x0[1] - bfhi(hw.x)); lw.y = cvtpk(x0[2] - bflo(hw.y), x0[3] - bfhi(hw.y)); lw.z = cvtpk(x1[0] - bflo(hw.z), x1[1] - bfhi(hw.z)); lw.w = cvtpk(x1[2] - bflo(hw.w), x1[3] - bfhi(hw.w));
            *(u32x4*)(hbr + 32 * ks) = hw;
            const bf16x8 xh = __builtin_bit_cast(bf16x8, hw), xl = __builtin_bit_cast(bf16x8, lw);
            const bf16x8 wh0 = __builtin_bit_cast(bf16x8, Wf[((ks * 2 + 0) * 2 + 0) * 64 + lane]), wl0 = __builtin_bit_cast(bf16x8, Wf[((ks * 2 + 0) * 2 + 1) * 64 + lane]);
            acc0 = __builtin_amdgcn_mfma_f32_16x16x32_bf16(wh0, xh, acc0, 0, 0, 0);
            acc0 = __builtin_amdgcn_mfma_f32_16x16x32_bf16(wl0, xh, acc0, 0, 0, 0);
            acc0 = __builtin_amdgcn_mfma_f32_16x16x32_bf16(wh0, xl, acc0, 0, 0, 0);
            if (KIND == 1) {
                const bf16x8 wh1 = __builtin_bit_cast(bf16x8, Wf[((ks * 2 + 1) * 2 + 0) * 64 + lane]), wl1 = __builtin_bit_cast(bf16x8, Wf[((ks * 2 + 1) * 2 + 1) * 64 + lane]);
                acc1 = __builtin_amdgcn_mfma_f32_16x16x32_bf16(wh1, xh, acc1, 0, 0, 0);
                acc1 = __builtin_amdgcn_mfma_f32_16x16x32_bf16(wl1, xh, acc1, 0, 0, 0);
                acc1 = __builtin_amdgcn_mfma_f32_16x16x32_bf16(wh1, xl, acc1, 0, 0, 0);
            }
        }
        ssq += __shfl_xor(ssq, 16); ssq += __shfl_xor(ssq, 32);
        const float rstd = 1.0f / sqrtf(ssq * (1.0f / D) + RMS_EPS);
        if (q4 == 0) rstdp[tok] = rstd;
        if (KIND == 0) {
            if (q4 < 2) { const f32x4 bf = *(const f32x4*)(inp(F, I_b_fox_f) + l * 8 + 4 * q4); f32x4 lf;
#pragma unroll
                for (int i = 0; i < 4; ++i) { const float z = rstd * acc0[i] + bf[i]; lf[i] = fminf(z, 0.f) - log1pf(expf(-fabsf(z))); }
                *(f32x4*)((float*)(F.ws + WS_LOGF) + (size_t)tok * 8 + 4 * q4) = lf; }
        } else if (!DRY) {
            const f32x4 b0 = *(const f32x4*)(inp(F, I_b_router) + l * NE + 4 * q4), b1v = *(const f32x4*)(inp(F, I_b_router) + l * NE + 16 + 4 * q4);
#pragma unroll
            for (int i = 0; i < 4; ++i) { lg[r16 * 33 + 4 * q4 + i] = rstd * acc0[i] + b0[i]; lg[r16 * 33 + 16 + 4 * q4 + i] = rstd * acc1[i] + b1v[i]; }
            LDS_WAIT(); asm volatile("" ::: "memory");
            float v0 = -INFINITY, v1 = -INFINITY, v2 = -INFINITY, v3 = -INFINITY; int i0 = 0, i1 = 0, i2 = 0, i3 = 0;
            if (lane < 16) {
                for (int e = 0; e < NE; ++e) { const float x = lg[lane * 33 + e];
                    if (x > v3) { if (x > v0) { v3 = v2; i3 = i2; v2 = v1; i2 = i1; v1 = v0; i1 = i0; v0 = x; i0 = e; }
                        else if (x > v1) { v3 = v2; i3 = i2; v2 = v1; i2 = i1; v1 = x; i1 = e; }
                        else if (x > v2) { v3 = v2; i3 = i2; v2 = x; i2 = e; }
                        else { v3 = x; i3 = e; } } }
            }
            __syncthreads();
            int rk0 = 0, rk1 = 0, rk2 = 0, rk3 = 0;
            if (lane < 16) { rk0 = __hip_atomic_fetch_add(&r2cnt[i0], 1, __ATOMIC_RELAXED, __HIP_MEMORY_SCOPE_WORKGROUP); rk1 = __hip_atomic_fetch_add(&r2cnt[i1], 1, __ATOMIC_RELAXED, __HIP_MEMORY_SCOPE_WORKGROUP); rk2 = __hip_atomic_fetch_add(&r2cnt[i2], 1, __ATOMIC_RELAXED, __HIP_MEMORY_SCOPE_WORKGROUP); rk3 = __hip_atomic_fetch_add(&r2cnt[i3], 1, __ATOMIC_RELAXED, __HIP_MEMORY_SCOPE_WORKGROUP); }
            __syncthreads();
            if (F.tid < 32) r2base[F.tid] = (int)atomicAdd(F.ctl + CW_CUR + (l * NE + F.tid) * 16, (unsigned)r2cnt[F.tid]);
            __syncthreads();
            if (lane < 16) {
                const float e1 = expf(v1 - v0), e2 = expf(v2 - v0), e3 = expf(v3 - v0), inv = 1.0f / (1.0f + e1 + e2 + e3);
                u32x2* list = (u32x2*)(F.ws + WS_LIST); float* gate = (float*)(F.ws + WS_GATE);
                const int tk = (task * 128 + F.wave * 16 + lane) * 4; const unsigned rb = __float_as_uint(__shfl(rstd, lane & 15));
                list[(size_t)i0 * LISTCAP + r2base[i0] + rk0] = (u32x2){(unsigned)(tk + 0), rb}; gate[tk + 0] = inv;
                list[(size_t)i1 * LISTCAP + r2base[i1] + rk1] = (u32x2){(unsigned)(tk + 1), rb}; gate[tk + 1] = e1 * inv;
                list[(size_t)i2 * LISTCAP + r2base[i2] + rk2] = (u32x2){(unsigned)(tk + 2), rb}; gate[tk + 2] = e2 * inv;
                list[(size_t)i3 * LISTCAP + r2base[i3] + rk3] = (u32x2){(unsigned)(tk + 3), rb}; gate[tk + 3] = e3 * inv;
            }
            __syncthreads();
        }
    }
}
__device__ __forceinline__ void r_final(const Frame& F) {
    const int lane = F.lane, tr = lane >> 5, c = lane & 31;
    const bf16_t* Y = (const bf16_t*)(F.ws + WS_Y);
    const float* gf = inp(F, I_norm_final);
    for (int task = F.bid; task < T / 128; task += F.G) {
#pragma unroll 1
        for (int pr = 0; pr < 8; ++pr) {
            const int tok = task * 128 + F.wave * 16 + pr * 2 + tr;
            float* xr = F.out + (size_t)tok * D + 8 * c; const bf16_t* yr = Y + (size_t)tok * 4 * D + 8 * c;
            f32x4 x0[4], x1[4]; float ssq = 0.f;
#pragma unroll
            for (int i = 0; i < 4; ++i) { x0[i] = *(const f32x4*)(xr + 256 * i); x1[i] = *(const f32x4*)(xr + 256 * i + 4); }
#pragma unroll
            for (int i = 0; i < 4; ++i) {
#pragma unroll
                for (int k = 0; k < 4; ++k) { const u32x4 y = *(const u32x4*)(yr + (size_t)k * D + 256 * i);
                    x0[i][0] += bflo(y.x); x0[i][1] += bfhi(y.x); x0[i][2] += bflo(y.y); x0[i][3] += bfhi(y.y); x1[i][0] += bflo(y.z); x1[i][1] += bfhi(y.z); x1[i][2] += bflo(y.w); x1[i][3] += bfhi(y.w); }
                ssq += (x0[i][0] * x0[i][0] + x0[i][1] * x0[i][1]) + (x0[i][2] * x0[i][2] + x0[i][3] * x0[i][3]) + (x1[i][0] * x1[i][0] + x1[i][1] * x1[i][1]) + (x1[i][2] * x1[i][2] + x1[i][3] * x1[i][3]); }
            ssq += __shfl_xor(ssq, 1); ssq += __shfl_xor(ssq, 2); ssq += __shfl_xor(ssq, 4); ssq += __shfl_xor(ssq, 8); ssq += __shfl_xor(ssq, 16);
            const float rstd = 1.0f / sqrtf(ssq * (1.0f / D) + RMS_EPS);
#pragma unroll
            for (int i = 0; i < 4; ++i) { const f32x4 g0 = *(const f32x4*)(gf + 256 * i + 8 * c), g1 = *(const f32x4*)(gf + 256 * i + 8 * c + 4);
                *(f32x4*)(xr + 256 * i) = x0[i] * rstd * g0; *(f32x4*)(xr + 256 * i + 4) = x1[i] * rstd * g1; }
        }
    }
}
__device__ __forceinline__ void cumsum_step(const Frame& F) {
    LAS float* sc = (LAS float*)(F.lds + LDSCTL_OFF + LC_SCAN);
    const float* LF = (const float*)(F.ws + WS_LOGF); float* c2 = (float*)(F.ws + WS_C2);
    for (int seq = F.bid; seq < 64; seq += F.G) {
        const int b = seq >> 3, h = seq & 7, t0 = F.tid * 8; const float* lf = LF + ((size_t)b * SEQ + t0) * 8 + h;
        float v[8], s = 0.f;
#pragma unroll
        for (int j = 0; j < 8; ++j) { s += lf[j * 8]; v[j] = s; }
        float inc = s;
#pragma unroll
        for (int off = 1; off < 64; off <<= 1) { const float y = __shfl_up(inc, off); if (F.lane >= off) inc += y; }
        if (F.lane == 63) sc[F.wave] = inc;
        __syncthreads();
        float pre = 0.f;
        for (int w = 0; w < F.wave; ++w) pre += sc[w];
        const float base = pre + inc - s;
#pragma unroll
        for (int j = 0; j < 8; ++j) c2[(size_t)seq * SEQ + t0 + j] = (base + v[j]) * LOG2E;
        __syncthreads();
    }
}

__device__ __forceinline__ float max3f(float a, float b, float c) { float r; asm("v_max3_f32 %0, %1, %2, %3" : "=v"(r) : "v"(a), "v"(b), "v"(c)); return r; }
__device__ __forceinline__ float max2f(float a, float b) { float r; asm("v_max_f32_e32 %0, %1, %2" : "=v"(r) : "v"(a), "v"(b)); return r; }
__device__ __forceinline__ int crow(int r, int hi) { return (r & 3) + 8 * (r >> 2) + 4 * hi; }
constexpr int AT_KT = 0, AT_KTB = 8320, AT_VT = 2 * AT_KTB, AT_VTB = 8192, AT_CK = AT_VT + 2 * AT_VTB, AT_WSF = AT_CK + 512, AT_OST = AT_WSF + 2048, AT_END = AT_OST + 65536;
static_assert(AT_END <= PH_BYTES, "attention LDS");
__device__ __forceinline__ void attn_unit(const Frame& F, int l, int b, int h, int qb) {
    const int tid = F.tid, lane = F.lane, r32 = lane & 31, hi = lane >> 5, wid = F.wave;
    const bf16_t* proj = (const bf16_t*)(F.ws + WS_PA); bf16_t* mixed = (bf16_t*)(F.ws + WS_MIXED);
    const int bh = b * 8 + h; const float* c2 = (const float*)(F.ws + WS_C2) + (size_t)bh * SEQ;
    const size_t rowbase = (size_t)b * SEQ; const int q0 = qb * 256;
    LAS unsigned char* L = F.lds;
    LAS float* wsf = (LAS float*)(L + AT_WSF) + wid * 64;
    LAS float* ost = (LAS float*)(L + AT_OST) + wid * 2048;
    LAS unsigned* stopv = (LAS unsigned*)(L + LDSCTL_OFF + LC_STOP);
    const bf16_t* Qw = proj + (rowbase + q0 + wid * 32 + r32) * NPROJ + C_FQ + h * 64;
    bf16x8 qr[4]; float qn = 0.f;
#pragma unroll
    for (int d0 = 0; d0 < 4; ++d0) { const u32x4 w = *(const u32x4*)(Qw + d0 * 16 + hi * 8); qr[d0] = __builtin_bit_cast(bf16x8, w);
        qn += bflo(w.x) * bflo(w.x) + bfhi(w.x) * bfhi(w.x) + bflo(w.y) * bflo(w.y) + bfhi(w.y) * bfhi(w.y) + bflo(w.z) * bflo(w.z) + bfhi(w.z) * bfhi(w.z) + bflo(w.w) * bflo(w.w) + bfhi(w.w) * bfhi(w.w); }
    qn += __shfl_xor(qn, 32); qn = sqrtf(qn) * 1.001f;
    const float kb = sqrtf(2.0f * __uint_as_float(__hip_atomic_load(F.ctl + CW_KMAX + (l * 64 + bh) * 16, __ATOMIC_RELAXED, __HIP_MEMORY_SCOPE_AGENT))) * 1.001f;
    const float c2q = c2[q0 + wid * 32 + r32];
    f32x16 cq16;
#pragma unroll
    for (int r = 0; r < 16; ++r) cq16[r] = c2q;
    float lsum = 0.f; f32x16 o[2];
#pragma unroll
    for (int r = 0; r < 16; ++r) { o[0][r] = 0.f; o[1][r] = 0.f; }
    const int jd = 4 * qb + 3;
    const int lkey = tid >> 3, lpiece = tid & 7;
    const bf16_t* ksrc = proj + (rowbase + lkey) * NPROJ + C_FK + h * 64 + lpiece * 8;
    const bf16_t* vsrc = proj + (rowbase + lkey) * NPROJ + C_FV + h * 64 + lpiece * 8;
    const int kdst = lpiece * 1040 + lkey * 16, vdst = (lpiece >> 2) * 4096 + lkey * 64 + (lpiece & 3) * 16;
    u32x4 kA = *(const u32x4*)(ksrc + (size_t)jd * 64 * NPROJ), vA = *(const u32x4*)(vsrc + (size_t)jd * 64 * NPROJ); float cA = c2[jd * 64 + lane];
    u32x4 kB = kA, vB = vA; float cB = cA;
    if (jd >= 1) { kB = *(const u32x4*)(ksrc + (size_t)(jd - 1) * 64 * NPROJ); vB = *(const u32x4*)(vsrc + (size_t)(jd - 1) * 64 * NPROJ); cB = c2[(jd - 1) * 64 + lane]; }
    const int vrd = (4 * hi + ((lane & 15) >> 2)) * 64 + ((lane >> 4) & 1) * 32 + (lane & 3) * 8;
    const int qrel = wid * 32 + r32;
    int buf = 0; bool done = false, wstop = false, first = true;
    float mhat = 0.f;
#define AT_ITER(j, kR, vR, cR, cNext) do { \
        const float cklast = rdlane(cNext, 63);     \
        *(LAS u32x4*)(L + AT_KT + buf * AT_KTB + kdst) = kR; *(LAS u32x4*)(L + AT_VT + buf * AT_VTB + vdst) = vR; \
        if (tid < 64) ((LAS float*)(L + AT_CK))[buf * 64 + tid] = cR; \
        asm volatile("s_waitcnt lgkmcnt(0)\n\ts_barrier" ::: "memory");     \
        if ((j) < jd) { const u32x4 fa = *(const LAS u32x4*)(stopv + (((j) + 1) & 1) * 8), fb = *(const LAS u32x4*)(stopv + (((j) + 1) & 1) * 8 + 4); \
            if ((fa.x & fa.y & fa.z & fa.w & fb.x & fb.y & fb.z & fb.w) != 0u) { done = true; break; } } \
        if ((j) >= 2) { kR = *(const u32x4*)(ksrc + (size_t)((j) - 2) * 64 * NPROJ); vR = *(const u32x4*)(vsrc + (size_t)((j) - 2) * 64 * NPROJ); cR = c2[((j) - 2) * 64 + lane]; } \
        const int jrel = (j) - 4 * qb; \
        const bool active = !(jrel >= 0 && 64 * jrel > 32 * wid + 31) && !wstop; \
        if (active) { \
            const LAS unsigned char* Kb = L + AT_KT + buf * AT_KTB; const LAS unsigned char* Vb = L + AT_VT + buf * AT_VTB; const LAS float* Ck = (const LAS float*)(L + AT_CK) + buf * 64; \
            const float base = c2q - mhat; \
            f32x16 p0, p1; \
            _Pragma("unroll") for (int g = 0; g < 4; ++g) { const f32x4 ca = *(const LAS f32x4*)(Ck + 8 * g + 4 * hi), cb = *(const LAS f32x4*)(Ck + 32 + 8 * g + 4 * hi); \
                _Pragma("unroll") for (int i = 0; i < 4; ++i) { p0[4 * g + i] = base - ca[i]; p1[4 * g + i] = base - cb[i]; } } \
            bf16x8 kf0[4], kf1[4]; \
            _Pragma("unroll") for (int d0 = 0; d0 < 4; ++d0) { kf0[d0] = *(const LAS bf16x8*)(Kb + (2 * d0 + hi) * 1040 + r32 * 16); kf1[d0] = *(const LAS bf16x8*)(Kb + (2 * d0 + hi) * 1040 + (32 + r32) * 16); } \
            _Pragma("unroll") for (int d0 = 0; d0 < 4; ++d0) { \
                p0 = __builtin_amdgcn_mfma_f32_32x32x16_bf16(kf0[d0], qr[d0], p0, 0, 0, 0); p1 = __builtin_amdgcn_mfma_f32_32x32x16_bf16(kf1[d0], qr[d0], p1, 0, 0, 0); } \
            asm volatile("s_nop 15\n\ts_nop 7" : "+v"(p0), "+v"(p1));     \
            if (jrel >= 0) { const int kbase = 64 * jrel + 4 * hi; \
                _Pragma("unroll") for (int r = 0; r < 16; ++r) { const int kv = kbase + (r & 3) + 8 * (r >> 2); if (kv > qrel) p0[r] = -INFINITY; if (kv + 32 > qrel) p1[r] = -INFINITY; } } \
            float mx = max3f(p0[0], p0[1], p1[0]), mb_ = max3f(p0[2], p0[3], p1[1]); mx = max3f(mx, p1[2], p1[3]); \
            _Pragma("unroll") for (int r = 4; r < 16; r += 4) { mx = max3f(mx, p0[r], p0[r + 1]); mb_ = max3f(mb_, p0[r + 2], p0[r + 3]); mx = max3f(mx, p1[r], p1[r + 1]); mb_ = max3f(mb_, p1[r + 2], p1[r + 3]); } \
            mx = max2f(mx, mb_); \
            { auto rr = __builtin_amdgcn_permlane32_swap(__float_as_uint(mx), __float_as_uint(mx), false, false); mx = max2f(__uint_as_float(rr[0]), __uint_as_float(rr[1])); } \
            if (first || __any(mx > 8.0f)) { \
                const float dl = first ? mx : fmaxf(mx, 0.f); mhat += dl; \
                _Pragma("unroll") for (int r = 0; r < 16; ++r) { p0[r] -= dl; p1[r] -= dl; } \
                const float alpha = __builtin_amdgcn_exp2f(-dl); lsum *= alpha; \
                if (!first) { \
                    if (hi == 0) wsf[r32] = alpha; \
                    LDS_WAIT(); asm volatile("" ::: "memory"); \
                    _Pragma("unroll") for (int r = 0; r < 16; ++r) { const float a = wsf[crow(r, hi)]; o[0][r] *= a; o[1][r] *= a; } } \
                first = false; \
            } \
            _Pragma("unroll") for (int r = 0; r < 16; ++r) { p0[r] = __builtin_amdgcn_exp2f(p0[r]); p1[r] = __builtin_amdgcn_exp2f(p1[r]); } \
            { f32x2 sa = {p0[0] + p1[0], p0[1] + p1[1]}; \
              _Pragma("unroll") for (int r = 2; r < 16; r += 2) { sa += (f32x2){p0[r], p0[r + 1]}; sa += (f32x2){p1[r], p1[r + 1]}; } \
              lsum += sa[0] + sa[1]; } \
            u32x4 pw[4]; \
            pw[0] = (u32x4){cvtpk(p0[0], p0[1]), cvtpk(p0[2], p0[3]), cvtpk(p0[4], p0[5]), cvtpk(p0[6], p0[7])}; \
            pw[1] = (u32x4){cvtpk(p0[8], p0[9]), cvtpk(p0[10], p0[11]), cvtpk(p0[12], p0[13]), cvtpk(p0[14], p0[15])}; \
            pw[2] = (u32x4){cvtpk(p1[0], p1[1]), cvtpk(p1[2], p1[3]), cvtpk(p1[4], p1[5]), cvtpk(p1[6], p1[7])}; \
            pw[3] = (u32x4){cvtpk(p1[8], p1[9]), cvtpk(p1[10], p1[11]), cvtpk(p1[12], p1[13]), cvtpk(p1[14], p1[15])}; \
            _Pragma("unroll") for (int s = 0; s < 4; ++s) \
                _Pragma("unroll") for (int d0 = 0; d0 < 2; ++d0) { \
                    const LAS unsigned char* vp = Vb + d0 * 4096 + s * 1024 + vrd; \
                    const v4i16_t lo = __builtin_amdgcn_ds_read_tr16_b64_v4i16((LAS v4i16_t*)vp), hv = __builtin_amdgcn_ds_read_tr16_b64_v4i16((LAS v4i16_t*)(vp + 512)); \
                    const bf16x8 vf = (bf16x8){lo[0], lo[1], lo[2], lo[3], hv[0], hv[1], hv[2], hv[3]}; \
                    o[d0] = __builtin_amdgcn_mfma_f32_32x32x16_bf16(__builtin_bit_cast(bf16x8, pw[s]), vf, o[d0], 0, 0, 0); } \
        } \
        if ((j) > 0) { if (active) { const float ub = qn * kb + (c2q - cklast); if (__all((ub - mhat) < -152.0f)) wstop = true; } if (lane == 0) stopv[((j) & 1) * 8 + wid] = wstop ? 1u : 0u; } \
        buf ^= 1; \
    } while (0)
    for (int j = jd; j >= 0; j -= 2) {
        AT_ITER(j, kA, vA, cA, cB);
        if (done || j == 0) break;
        AT_ITER(j - 1, kB, vB, cB, cA);
        if (done) break;
    }
#undef AT_ITER
    lsum += __shfl_xor(lsum, 32);
    if (hi == 0) wsf[32 + r32] = 1.0f / lsum;
    LDS_WAIT(); asm volatile("" ::: "memory");
#pragma unroll
    for (int r = 0; r < 16; ++r) { const int q = crow(r, hi); const float inv = wsf[32 + q]; ost[q * 64 + r32] = o[0][r] * inv; ost[q * 64 + 32 + r32] = o[1][r] * inv; }
    LDS_WAIT(); asm volatile("" ::: "memory");
    { const int row = lane >> 1, half = lane & 1; const LAS float* src = ost + row * 64 + half * 32; float v[32]; float ss = 0.f;
#pragma unroll
        for (int i = 0; i < 8; ++i) { const f32x4 t4 = *(const LAS f32x4*)(src + 4 * i); v[4 * i] = t4[0]; v[4 * i + 1] = t4[1]; v[4 * i + 2] = t4[2]; v[4 * i + 3] = t4[3]; ss += (t4[0] * t4[0] + t4[1] * t4[1]) + (t4[2] * t4[2] + t4[3] * t4[3]); }
        ss += __shfl_xor(ss, 1);
        const float rs = 1.0f / sqrtf(ss * (1.0f / 64.0f) + RMS_EPS);
        const float* gn = inp(F, I_fox_gain) + l * 512 + h * 64 + half * 32;
        bf16_t* dst = mixed + (rowbase + q0 + wid * 32 + row) * D + h * 64 + half * 32;
#pragma unroll
        for (int i = 0; i < 4; ++i) { const f32x4 ga = *(const f32x4*)(gn + 8 * i), gb = *(const f32x4*)(gn + 8 * i + 4); u32x4 w;
            w.x = cvtpk(v[8 * i] * rs * ga[0], v[8 * i + 1] * rs * ga[1]); w.y = cvtpk(v[8 * i + 2] * rs * ga[2], v[8 * i + 3] * rs * ga[3]);
            w.z = cvtpk(v[8 * i + 4] * rs * gb[0], v[8 * i + 5] * rs * gb[1]); w.w = cvtpk(v[8 * i + 6] * rs * gb[2], v[8 * i + 7] * rs * gb[3]);
            *(u32x4*)(dst + 8 * i) = w; } }
    __syncthreads();
}

__device__ __forceinline__ float hg_lb(const Frame& F, int l, int col) {
    float x[NL], mx = -INFINITY;
#pragma unroll
    for (int i = 0; i < NL; ++i) { x[i] = inp(F, I_hgrn_lb)[i * 256 + col]; mx = fmaxf(mx, x[i]); }
    float s = 0.f, a = 0.f;
#pragma unroll
    for (int i = 0; i < NL; ++i) { x[i] = expf(x[i] - mx); s += x[i]; }
#pragma unroll
    for (int i = 1; i < NL; ++i) if (i <= l) a += x[i];
    return a / s;
}
constexpr int HG_SEG = 128, HG_NSEG = SEQ / HG_SEG, HG_NPART = 1, HG_WAVES = 4;
constexpr int HGL_ROW = 136, HGL_QT = 0, HGL_KT = 32 * HGL_ROW, HGL_KP = 2 * 32 * HGL_ROW, HGL_V = HGL_KP + 4096, HGL_PE = HGL_V + 4096, HGL_BYTES = HGL_PE + 256;
static_assert(NWAVES * HGL_BYTES <= PH_BYTES, "HGRN2 LDS");
__device__ __forceinline__ void hg_mfma_unit(const Frame& F, int l, int u) {
    const int seg = u % HG_NSEG, bh = u / HG_NSEG, b = bh >> 2, hd = bh & 3, lane = F.lane, r32 = lane & 31, hi = lane >> 5;
    LAS unsigned char* W = F.lds + F.wave * HGL_BYTES;
    const size_t tokS = (size_t)b * SEQ + seg * HG_SEG;
    const bf16_t* proj = (const bf16_t*)(F.ws + WS_PA);
    float* oraw = (float*)(F.ws + WS_ORAW); bf16_t* QE = (bf16_t*)(F.ws + WS_QE);
    const float lbv = hg_lb(F, l, hd * 64 + lane);
    f32x16 Sacc[2][2];
#pragma unroll
    for (int kb = 0; kb < 2; ++kb)
#pragma unroll
        for (int vb = 0; vb < 2; ++vb)
#pragma unroll
            for (int r = 0; r < 16; ++r) Sacc[kb][vb][r] = 0.f;
    float Pseg = 1.0f;
    const int vrd = (4 * hi + ((lane & 15) >> 2)) * 64 + ((lane >> 4) & 1) * 32 + (lane & 3) * 8;
    int tb = 0;
    while (tb < HG_SEG) {
        const int nmax = (HG_SEG - tb) < 32 ? (HG_SEG - tb) : 32;
        const char* pu8 = (const char*)(proj + (tokS + tb) * NPROJ + hd * 64);
        const unsigned lo2 = (unsigned)lane * 2u;
        char* qe8 = (char*)(QE + (tokS + tb) * 256 + hd * 64);
        char* or8 = (char*)(oraw + (tokS + tb) * 256 + hd * 64);
        const unsigned lof = (unsigned)(4 * hi * 256 + r32) * 4u;
        float fv[32], qv[32]; u32x4 vreg[4];
#pragma unroll
        for (int t = 0; t < 32; ++t) { const bool ok = t < nmax; fv[t] = ok ? bf2f(*(const bf16_t*)(pu8 + (size_t)t * (NPROJ * 2) + C_GF * 2 + lo2)) : 0.f; qv[t] = ok ? bf2f(*(const bf16_t*)(pu8 + (size_t)t * (NPROJ * 2) + C_GQ * 2 + lo2)) : 0.f; }
#pragma unroll
        for (int it = 0; it < 4; ++it) { const int c = lane + 64 * it, sr = c >> 3, pc = c & 7;
            vreg[it] = (u32x4){0u, 0u, 0u, 0u}; if (sr < nmax) vreg[it] = *(const u32x4*)(pu8 + (size_t)sr * (NPROJ * 2) + C_GI * 2 + pc * 16); }
        int nl = 32; { float P = 1.0f;
#pragma unroll
            for (int t = 0; t < 32; ++t) { const float sg = __builtin_amdgcn_rcpf(1.0f + __builtin_amdgcn_exp2f(-LOG2E * fv[t])); float f = fmaxf(lbv + (1.0f - lbv) * sg, 1e-30f); if (t >= nmax) f = 1.0f; fv[t] = f; P *= f; if (P < 1e-32f && nl == 32) nl = t; } }
#pragma unroll
        for (int off = 1; off < 64; off <<= 1) { const int o = __shfl_xor(nl, off); nl = o < nl ? o : nl; }
        const int n = __builtin_amdgcn_readfirstlane(nl < nmax ? nl : nmax);
#pragma unroll
        for (int it = 0; it < 4; ++it) { const int c = lane + 64 * it, sr = c >> 3, pc = c & 7;
            *(LAS u32x4*)(W + HGL_V + (pc >> 2) * 2048 + sr * 64 + (pc & 3) * 16) = (sr < n) ? vreg[it] : (u32x4){0u, 0u, 0u, 0u}; }
        float P = 1.0f;
        {
#pragma unroll
          for (int t = 0; t < 32; ++t) { const bool ok = t < n; const float f = fv[t]; if (ok) P *= f;
            const float qt = ok ? qv[t] * P : 0.f, kt = ok ? (1.0f - f) * __builtin_amdgcn_rcpf(P) : 0.f;
            *(LAS bf16_t*)(W + HGL_QT + t * HGL_ROW + lane * 2) = f2bf(qt); *(LAS bf16_t*)(W + HGL_KT + t * HGL_ROW + lane * 2) = f2bf(kt);
            if (ok) *(bf16_t*)(qe8 + (size_t)t * 512 + lo2) = f2bf(qv[t] * (Pseg * P)); } }
        { float suf = 1.0f;
#pragma unroll
          for (int t = 31; t >= 0; --t) { const bool ok = t < n; const float f = fv[t]; const float kp = ok ? (1.0f - f) * suf : 0.f; if (ok) suf *= f;
            *(LAS bf16_t*)(W + HGL_KP + (lane >> 5) * 2048 + t * 64 + (lane & 31) * 2) = f2bf(kp); } }
        ((LAS float*)(W + HGL_PE))[lane] = P;
        Pseg *= P;
        LDS_WAIT(); asm volatile("" ::: "memory");
        f32x16 st;
#pragma unroll
        for (int r = 0; r < 16; ++r) st[r] = 0.f;
#pragma unroll
        for (int d0 = 0; d0 < 4; ++d0) { const bf16x8 ka = *(const LAS bf16x8*)(W + HGL_KT + r32 * HGL_ROW + (16 * d0 + 8 * hi) * 2), qb = *(const LAS bf16x8*)(W + HGL_QT + r32 * HGL_ROW + (16 * d0 + 8 * hi) * 2);
            st = __builtin_amdgcn_mfma_f32_32x32x16_bf16(ka, qb, st, 0, 0, 0); }
#pragma unroll
        for (int r = 0; r < 16; ++r) if (crow(r, hi) > r32) st[r] = 0.f;
        u32x4 pst[2];
        pst[0] = (u32x4){cvtpk(st[0], st[1]), cvtpk(st[2], st[3]), cvtpk(st[4], st[5]), cvtpk(st[6], st[7])};
        pst[1] = (u32x4){cvtpk(st[8], st[9]), cvtpk(st[10], st[11]), cvtpk(st[12], st[13]), cvtpk(st[14], st[15])};
        bf16x8 vf[2][2];
#pragma unroll
        for (int s2 = 0; s2 < 2; ++s2)
#pragma unroll
            for (int vb = 0; vb < 2; ++vb) { const LAS unsigned char* vp = W + HGL_V + vb * 2048 + s2 * 1024 + vrd;
                const v4i16_t lo = __builtin_amdgcn_ds_read_tr16_b64_v4i16((LAS v4i16_t*)vp), hv = __builtin_amdgcn_ds_read_tr16_b64_v4i16((LAS v4i16_t*)(vp + 512));
                vf[s2][vb] = (bf16x8){lo[0], lo[1], lo[2], lo[3], hv[0], hv[1], hv[2], hv[3]}; }
        f32x16 oacc[2];
#pragma unroll
        for (int vb = 0; vb < 2; ++vb) {
#pragma unroll
            for (int r = 0; r < 16; ++r) oacc[vb][r] = 0.f;
#pragma unroll
            for (int s2 = 0; s2 < 2; ++s2) oacc[vb] = __builtin_amdgcn_mfma_f32_32x32x16_bf16(__builtin_bit_cast(bf16x8, pst[s2]), vf[s2][vb], oacc[vb], 0, 0, 0);
        }
#pragma unroll
        for (int kst = 0; kst < 4; ++kst) {
            const u32x2 qa = *(const LAS u32x2*)(W + HGL_QT + r32 * HGL_ROW + (16 * kst + 4 * hi) * 2), qc = *(const LAS u32x2*)(W + HGL_QT + r32 * HGL_ROW + (16 * kst + 8 + 4 * hi) * 2);
            const bf16x8 qf = __builtin_bit_cast(bf16x8, (u32x4){qa.x, qa.y, qc.x, qc.y});
#pragma unroll
            for (int vb = 0; vb < 2; ++vb) { const f32x16& S = Sacc[kst >> 1][vb]; const int o8 = 8 * (kst & 1);
                const u32x4 sp = (u32x4){cvtpk(S[o8 + 0], S[o8 + 1]), cvtpk(S[o8 + 2], S[o8 + 3]), cvtpk(S[o8 + 4], S[o8 + 5]), cvtpk(S[o8 + 6], S[o8 + 7])};
                oacc[vb] = __builtin_amdgcn_mfma_f32_32x32x16_bf16(qf, __builtin_bit_cast(bf16x8, sp), oacc[vb], 0, 0, 0); }
        }
#pragma unroll
        for (int vb = 0; vb < 2; ++vb)
#pragma unroll
            for (int r = 0; r < 16; ++r) { const int t = crow(r, hi); if (t < n) *(float*)(or8 + (size_t)(((r & 3) + 8 * (r >> 2)) * 1024 + vb * 128) + lof) = oacc[vb][r]; }
#pragma unroll
        for (int kb = 0; kb < 2; ++kb) {
            float pe[16];
#pragma unroll
            for (int g = 0; g < 4; ++g) { const f32x4 p4 = *(const LAS f32x4*)(W + HGL_PE + (32 * kb + 8 * g + 4 * hi) * 4); pe[4 * g] = p4[0]; pe[4 * g + 1] = p4[1]; pe[4 * g + 2] = p4[2]; pe[4 * g + 3] = p4[3]; }
            bf16x8 kf[2];
#pragma unroll
            for (int s2 = 0; s2 < 2; ++s2) { const LAS unsigned char* kp = W + HGL_KP + kb * 2048 + s2 * 1024 + vrd;
                const v4i16_t lo = __builtin_amdgcn_ds_read_tr16_b64_v4i16((LAS v4i16_t*)kp), hv = __builtin_amdgcn_ds_read_tr16_b64_v4i16((LAS v4i16_t*)(kp + 512));
                kf[s2] = (bf16x8){lo[0], lo[1], lo[2], lo[3], hv[0], hv[1], hv[2], hv[3]}; }
#pragma unroll
            for (int vb = 0; vb < 2; ++vb) {
#pragma unroll
                for (int r = 0; r < 16; ++r) Sacc[kb][vb][r] *= pe[r];
#pragma unroll
                for (int s2 = 0; s2 < 2; ++s2) Sacc[kb][vb] = __builtin_amdgcn_mfma_f32_32x32x16_bf16(kf[s2], vf[s2][vb], Sacc[kb][vb], 0, 0, 0);
            }
        }
        LDS_WAIT(); asm volatile("" ::: "memory");
        tb += n;
    }
    char* send8 = (char*)((float*)(F.ws + WS_SEND2) + (size_t)(bh * HG_NSEG + seg) * 4096);
    const unsigned lsf = (unsigned)(4 * hi * 64 + r32) * 4u;
#pragma unroll
    for (int kb = 0; kb < 2; ++kb)
#pragma unroll
        for (int vb = 0; vb < 2; ++vb)
#pragma unroll
            for (int r = 0; r < 16; ++r) *(float*)(send8 + (size_t)((32 * kb + (r & 3) + 8 * (r >> 2)) * 256 + vb * 128) + lsf) = Sacc[kb][vb][r];
    ((float*)(F.ws + WS_PSEG))[(bh * HG_NSEG + seg) * 64 + lane] = Pseg;
}
__device__ __forceinline__ void hg_fix_phase(const Frame& F, int l) {
    const int lane = F.lane, r16 = lane & 15, q4 = lane >> 4, tid = F.tid;
    LAS bf16_t* ST = (LAS bf16_t*)(F.lds);
    const float* oraw = (const float*)(F.ws + WS_ORAW); const bf16_t* proj = (const bf16_t*)(F.ws + WS_PA); bf16_t* mixed = (bf16_t*)(F.ws + WS_MIXED);
    const bf16_t* QE = (const bf16_t*)(F.ws + WS_QE); const float* SEND = (const float*)(F.ws + WS_SEND2); const float* PSEG = (const float*)(F.ws + WS_PSEG);
    for (int uu = F.bid; uu < 32 * HG_NSEG * DUP(7); uu += F.G) {
        const int u = uu % (32 * HG_NSEG), seg = u % HG_NSEG, bh = u / HG_NSEG, b = bh >> 2, hd = bh & 3;
        if (seg > 0) {
            const int k = tid >> 3, v8 = (tid & 7) * 8; float S[8];
#pragma unroll
            for (int i = 0; i < 8; ++i) S[i] = 0.f;
#pragma unroll 4
            for (int sp = 0; sp < seg; ++sp) { const float P = PSEG[(bh * HG_NSEG + sp) * 64 + k]; const float* se = SEND + ((size_t)(bh * HG_NSEG + sp) * 64 + k) * 64 + v8;
                const f32x4 a = *(const f32x4*)se, c = *(const f32x4*)(se + 4);
                S[0] = P * S[0] + a[0]; S[1] = P * S[1] + a[1]; S[2] = P * S[2] + a[2]; S[3] = P * S[3] + a[3]; S[4] = P * S[4] + c[0]; S[5] = P * S[5] + c[1]; S[6] = P * S[6] + c[2]; S[7] = P * S[7] + c[3]; }
#pragma unroll
            for (int i = 0; i < 8; ++i) ST[(v8 + i) * 72 + k] = f2bf(S[i]);
        }
        __syncthreads();
        {
            const size_t tok0 = (size_t)b * SEQ + seg * HG_SEG + F.wave * 16;
            f32x4 acc[4];
#pragma unroll
            for (int vb = 0; vb < 4; ++vb) acc[vb] = (f32x4){0.f, 0.f, 0.f, 0.f};
            if (seg > 0) {
#pragma unroll
                for (int kst = 0; kst < 2; ++kst) { const bf16x8 af = __builtin_bit_cast(bf16x8, *(const u32x4*)(QE + (tok0 + r16) * 256 + hd * 64 + 32 * kst + 8 * q4));
#pragma unroll
                    for (int vb = 0; vb < 4; ++vb) { const bf16x8 bfv = *(const LAS bf16x8*)(ST + (vb * 16 + r16) * 72 + 32 * kst + 8 * q4); acc[vb] = __builtin_amdgcn_mfma_f32_16x16x32_bf16(af, bfv, acc[vb], 0, 0, 0); } }
            }
            float ss[4] = {0.f, 0.f, 0.f, 0.f};
#pragma unroll
            for (int vb = 0; vb < 4; ++vb)
#pragma unroll
                for (int r = 0; r < 4; ++r) { const size_t o = (tok0 + 4 * q4 + r) * 256 + hd * 64 + vb * 16 + r16;
                    float x = acc[vb][r];
#pragma unroll
                    for (int k4 = 0; k4 < HG_NPART; ++k4) x += oraw[(size_t)k4 * T * 256 + o];
                    acc[vb][r] = x; ss[r] += x * x; }
#pragma unroll
            for (int r = 0; r < 4; ++r) { float t = ss[r]; t += __shfl_xor(t, 1); t += __shfl_xor(t, 2); t += __shfl_xor(t, 4); t += __shfl_xor(t, 8); ss[r] = 1.0f / sqrtf(t * (1.0f / 64.0f) + RMS_EPS); }
#pragma unroll
            for (int vb = 0; vb < 4; ++vb) { const float gn = inp(F, I_hgrn_gain)[l * 256 + hd * 64 + vb * 16 + r16];
#pragma unroll
                for (int r = 0; r < 4; ++r) { const size_t tok = tok0 + 4 * q4 + r; const float g = bf2f(proj[tok * NPROJ + C_GG + hd * 64 + vb * 16 + r16]);
                    const float si = g * __builtin_amdgcn_rcpf(1.0f + __builtin_amdgcn_exp2f(-LOG2E * g)); mixed[tok * D + 512 + hd * 64 + vb * 16 + r16] = f2bf(acc[vb][r] * ss[r] * gn * si); } }
        }
        __syncthreads();
    }
}
constexpr int PL_ROW = 136, PL_BYTES = 64 * PL_ROW;
static_assert(NWAVES * PL_BYTES <= PH_BYTES, "pool LDS");
template <int W> __device__ __forceinline__ void pool_body(const Frame& F, int l, int b, int g, int seg) {
    const int lane = F.lane, r32 = lane & 31, hi = lane >> 5, t0 = seg * 64;
    LAS unsigned char* PT = F.lds + F.wave * PL_BYTES;
    const char* ub = (const char*)((const bf16_t*)(F.ws + WS_PA) + (size_t)b * SEQ * NPROJ + C_PU + g * 64);
    const unsigned lo2 = (unsigned)lane * 2u;
    float prev[16], cur[16];
#pragma unroll
    for (int i = 0; i < 16; ++i) { const int t = t0 - 16 + i; prev[i] = (t >= 0) ? bf2f(*(const bf16_t*)(ub + (size_t)(t < 0 ? 0 : t) * (NPROJ * 2) + lo2)) : 0.f; }
    float wsum = 0.f;
#pragma unroll
    for (int i = 1; i <= W; ++i) wsum += prev[16 - i];
#pragma unroll
    for (int ci = 0; ci < 4; ++ci) {
#pragma unroll
        for (int i = 0; i < 16; ++i) cur[i] = bf2f(*(const bf16_t*)(ub + (size_t)(t0 + 16 * ci + i) * (NPROJ * 2) + lo2));
#pragma unroll
        for (int i = 0; i < 16; ++i) { const float ut = cur[i]; wsum += ut; wsum -= (i - W >= 0) ? cur[(i - W >= 0) ? i - W : 0] : prev[(i - W >= 0) ? 0 : 16 + i - W];
            const int t = t0 + 16 * ci + i; const float pooled = wsum / (float)((t + 1 < W) ? (t + 1) : W) - ut;
            *(LAS bf16_t*)(PT + (16 * ci + i) * PL_ROW + lane * 2) = f2bf(pooled); }
#pragma unroll
        for (int i = 0; i < 16; ++i) prev[i] = cur[i];
    }
    LDS_WAIT(); asm volatile("" ::: "memory");
    const bf16_t* pwt = (const bf16_t*)(F.ws + WS_PWT) + (size_t)(l * 4 + g) * 4096;
    bf16x8 bw[2][4];
#pragma unroll
    for (int db = 0; db < 2; ++db)
#pragma unroll
        for (int st = 0; st < 4; ++st) bw[db][st] = __builtin_bit_cast(bf16x8, *(const u32x4*)(pwt + (32 * db + r32) * 64 + 16 * st + 8 * hi));
    char* ob = (char*)((bf16_t*)(F.ws + WS_MIXED) + ((size_t)b * SEQ + t0) * D + 768 + g * 64);
    const unsigned lof = (unsigned)(4 * hi * D + r32) * 2u;
#pragma unroll
    for (int tb2 = 0; tb2 < 2; ++tb2)
#pragma unroll
        for (int db = 0; db < 2; ++db) {
            f32x16 acc;
#pragma unroll
            for (int r = 0; r < 16; ++r) acc[r] = 0.f;
#pragma unroll
            for (int st = 0; st < 4; ++st) { const bf16x8 af = *(const LAS bf16x8*)(PT + (32 * tb2 + r32) * PL_ROW + (16 * st + 8 * hi) * 2); acc = __builtin_amdgcn_mfma_f32_32x32x16_bf16(af, bw[db][st], acc, 0, 0, 0); }
            const float psc = inp(F, I_pool_scale)[l * 256 + g * 64 + 32 * db + r32];
#pragma unroll
            for (int r = 0; r < 16; ++r) *(bf16_t*)(ob + (size_t)((32 * tb2 + (r & 3) + 8 * (r >> 2)) * D + 32 * db) * 2 + lof) = f2bf(acc[r] * psc);
        }
    LDS_WAIT(); asm volatile("" ::: "memory");
}
__device__ __forceinline__ void pool_unit(const Frame& F, int l, int u) {
    const int seg = u & 63, g = (u >> 6) & 3, b = u >> 8;
    if (g == 0) pool_body<2>(F, l, b, g, seg); else if (g == 1) pool_body<4>(F, l, b, g, seg); else if (g == 2) pool_body<8>(F, l, b, g, seg); else pool_body<16>(F, l, b, g, seg);
}

struct Args { const float* in[18]; float* out; unsigned char* ws; int ph_lo, ph_hi; };
constexpr int N_PHASES = 2 + 8 * NL;

__global__ void __launch_bounds__(NTHREADS, 2) trunk_fwd(Args args) {
    extern __shared__ __attribute__((aligned(16))) unsigned char lds_raw[];
    Frame F;
    F.lds = (LAS unsigned char*)lds_raw; F.ws = args.ws; F.ctl = (unsigned*)(args.ws + WS_CTL); F.out = args.out;
    F.tid = threadIdx.x; F.lane = F.tid & 63; F.wave = __builtin_amdgcn_readfirstlane(F.tid >> 6);
    for (int u = F.tid; u < (LDS_BYTES - LDSCTL_OFF) / 4; u += NTHREADS) ((LAS unsigned*)(F.lds + LDSCTL_OFF))[u] = 0u;
    __syncthreads();
    if (F.tid == 0) {
#pragma unroll
        for (int i = 0; i < 18; ++i) ((LAS unsigned long long*)(F.lds + LDSCTL_OFF + LC_INP))[i] = (unsigned long long)args.in[i];
    }
    __syncthreads();
    const int lo = args.ph_lo, hi = args.ph_hi; const bool use_bar = (hi - lo) > 1;
    XcdBarrier bar; bar.bar = F.ctl + CW_BAR; bar.x = 0; bar.st = nullptr;
    if (use_bar) bar = xcd_barrier_post(F.ctl + CW_BAR, (volatile LAS unsigned*)(F.lds + LDSCTL_OFF + LC_BAR));
#ifndef PHMASK
#define PHMASK 0xFFFF
#endif
#define PM(b) ((PHMASK >> (b)) & 1)
#define FRESH() do { int l_ = (int)__builtin_amdgcn_mbcnt_hi(~0u, __builtin_amdgcn_mbcnt_lo(~0u, 0u)); asm volatile("" : "+v"(l_)); F.lane = l_; F.tid = F.wave * 64 + l_; int b_ = blockIdx.x, g_ = gridDim.x; asm volatile("" : "+s"(b_), "+s"(g_)); F.bid = b_; F.G = g_; } while (0)
#define IN(k) (lo <= (k) && (k) < hi)
#define SEAM(k) do { if (use_bar && (k) + 1 < hi) xcd_barrier(bar, F.tid == 0); } while (0)
    if (IN(0) && PM(0)) { for (int rep = 0; rep < DUP(5); ++rep) { FRESH(); p0_prologue(F); } SEAM(0); }
    for (int l = 0; l < NL; ++l) {
        const int pb = 1 + 8 * l;
        if (IN(pb + 0) && PM(1)) { FRESH(); if (l == 0) r_phase<0, false, false>(F, l, inp(F, I_x), F.out); else { if (DUP(6) > 1) r_phase<0, true, false, true>(F, l, F.out, F.out); r_phase<0, true, true>(F, l, F.out, F.out); } SEAM(pb + 0); }
        if (IN(pb + 1) && PM(2)) { FRESH();
            cumsum_step(F);
            pg8::StaticOrder S; S.init(T, NPROJ, D, F.G, F.bid, (const bf16_t*)(F.ws + WS_WIN + l * WIN_BYTES)); S.rep = DUP(2);
            pg8::EpiProj E{(bf16_t*)(F.ws + WS_PA), (const float*)(F.ws + WS_RSTD1), F.ctl + CW_KMAX + l * 64 * 16};
            pg8::gemm_phase<pg8::EpiProj, pg8::StaticOrder, true>(F.tid, F.lds, (const bf16_t*)(F.ws + WS_HB), D, S, E);
            SEAM(pb + 1);
        }
        if (IN(pb + 2) && PM(3)) { FRESH();
            const int gw = F.bid * NWAVES + F.wave, NGW = F.G * NWAVES;
            for (int u = gw; u < 2048; u += NGW) pool_unit(F, l, u);
            __syncthreads();
            if (F.wave < HG_WAVES) for (int u = F.wave * F.G + F.bid; u < 32 * HG_NSEG * DUP(0); u += HG_WAVES * F.G) hg_mfma_unit(F, l, u % (32 * HG_NSEG));
            __syncthreads();
            { LAS int* aq = (LAS int*)(F.lds + LDSCTL_OFF + LC_AQ);
              for (;;) {
                if (F.tid == 0) aq[0] = (int)__hip_atomic_fetch_add(F.ctl + CW_AQ + 16 * l, 1u, __ATOMIC_RELAXED, __HIP_MEMORY_SCOPE_AGENT);
                __syncthreads();
                const int idx = aq[0];
                __syncthreads();
                if (idx >= 1024) break;
                attn_unit(F, l, (idx >> 3) & 7, idx & 7, 15 - (idx >> 6)); } }
            SEAM(pb + 2);
        }
        if (IN(pb + 3) && PM(4)) { FRESH(); hg_fix_phase(F, l); SEAM(pb + 3); }
        if (IN(pb + 4) && PM(5)) { FRESH();
            pg8::StaticOrder S; S.init(T, D, D, F.G, F.bid, (const bf16_t*)(F.ws + WS_WOUT + l * WOUT_BYTES));
            pg8::EpiOut E{l == 0 ? inp(F, I_x) : F.out, F.out};
            pg8::gemm_phase<pg8::EpiOut, pg8::StaticOrder, true>(F.tid, F.lds, (const bf16_t*)(F.ws + WS_MIXED), D, S, E);
            SEAM(pb + 4);
        }
        if (IN(pb + 5) && PM(6)) { FRESH(); if (DUP(6) > 1) r_phase<1, false, false, true>(F, l, F.out, F.out); r_phase<1, false, false>(F, l, F.out, F.out); SEAM(pb + 5); }
        if ((IN(pb + 6) && PM(7)) || (IN(pb + 7) && PM(8))) { FRESH();
            LAS int* tb = (LAS int*)(F.lds + LDSCTL_OFF + LC_TB); LAS int* cn = (LAS int*)(F.lds + LDSCTL_OFF + LC_CN);
            if (F.tid < NE) cn[F.tid] = (int)__hip_atomic_load(F.ctl + CW_CUR + (l * NE + F.tid) * 16, __ATOMIC_RELAXED, __HIP_MEMORY_SCOPE_AGENT);
            __syncthreads();
            if (F.tid == 0) { int a = 0; for (int e = 0; e < NE; ++e) { tb[e] = a; a += (cn[e] + 255) >> 8; } tb[NE] = a; }
            __syncthreads();
            const int ntile = tb[NE];
            if (IN(pb + 6) && PM(7)) {
                pg8::MoeOrder<true> S; S.rep = DUP(3); S.nM = ntile; S.nN = 2 * FF / 256; S.nwg = S.nM * S.nN; S.G = F.G; S.c = F.bid; S.Wt = (const char*)(F.ws + WS_W1 + (size_t)l * NE * W1E_BYTES); S.estride = W1E_BYTES; S.tstep = (size_t)256 * D * 2;
                S.tb = tb; S.cn = cn; S.list = (const u32x2*)(F.ws + WS_LIST);
                pg8::EpiGlu E{(bf16_t*)(F.ws + WS_PA), (const u32x2*)(F.ws + WS_LIST), (const float*)(F.ws + WS_B1R) + (size_t)l * NE * 2048};
                pg8::gemm_phase<pg8::EpiGlu, pg8::MoeOrder<true>, true>(F.tid, F.lds, (const bf16_t*)(F.ws + WS_HB), D, S, E);
                SEAM(pb + 6);
            }
            if (IN(pb + 7) && PM(8)) { FRESH();
                pg8::MoeOrder<false> S; S.rep = DUP(4); S.nM = ntile; S.nN = D / 256; S.nwg = S.nM * S.nN; S.G = F.G; S.c = F.bid; S.Wt = (const char*)(F.ws + WS_W2 + (size_t)l * NE * W2E_BYTES); S.estride = W2E_BYTES; S.tstep = (size_t)256 * FF * 2;
                S.tb = tb; S.cn = cn; S.list = (const u32x2*)(F.ws + WS_LIST);
                pg8::EpiDown E{(bf16_t*)(F.ws + WS_Y), (const u32x2*)(F.ws + WS_LIST), (const float*)(F.ws + WS_GATE), inp(F, I_b2) + (size_t)l * NE * D};
                pg8::gemm_phase<pg8::EpiDown, pg8::MoeOrder<false>, true>(F.tid, F.lds, (const bf16_t*)(F.ws + WS_PA), FF, S, E);
                SEAM(pb + 7);
            }
        }
    }
    if (IN(N_PHASES - 1) && PM(9)) { FRESH(); r_final(F); }
#undef IN
#undef SEAM
}

extern "C" void kernel_launch(void* const* d_in, const int* in_sizes, int n_in, void* d_out, int out_size, void* d_ws, size_t ws_size, hipStream_t stream) {
    static int grid = 0;
    if (grid == 0) {
        if (n_in != 18 || out_size != T * D || ws_size < WS_END) { fprintf(stderr, "kernel_launch: unexpected shapes (n_in %d out %d ws %zu need %zu)\n", n_in, out_size, ws_size, (size_t)WS_END); grid = -1; return; }
        int dev = 0, cus = 0;
        if (hipGetDevice(&dev) != hipSuccess || hipDeviceGetAttribute(&cus, hipDeviceAttributeMultiprocessorCount, dev) != hipSuccess) { grid = -1; return; }
        if (hipFuncSetAttribute((const void*)trunk_fwd, hipFuncAttributeMaxDynamicSharedMemorySize, LDS_BYTES) != hipSuccess) { fprintf(stderr, "kernel_launch: hipFuncSetAttribute failed\n"); grid = -1; return; }
        int per_cu = 0;
        if (hipOccupancyMaxActiveBlocksPerMultiprocessor(&per_cu, (const void*)trunk_fwd, NTHREADS, LDS_BYTES) != hipSuccess || per_cu < 1) { fprintf(stderr, "kernel_launch: occupancy query says %d\n", per_cu); (void)hipGetLastError(); }
        grid = cus;
    }
    if (grid < 0) return;
    (void)hipMemsetAsync((char*)d_ws + WS_CTL, 0, CTL_ZERO_BYTES, stream);
    Args a{};
    for (int i = 0; i < 18; ++i) a.in[i] = (const float*)d_in[i];
    a.out = (float*)d_out; a.ws = (unsigned char*)d_ws;
#if MK_SPLIT
    for (int p = 0; p < N_PHASES; ++p) { a.ph_lo = p; a.ph_hi = p + 1; hipLaunchKernelGGL(trunk_fwd, dim3(grid), dim3(NTHREADS), LDS_BYTES, stream, a); }
#else
    a.ph_lo = 0; a.ph_hi = N_PHASES; hipLaunchKernelGGL(trunk_fwd, dim3(grid), dim3(NTHREADS), LDS_BYTES, stream, a);
#endif
}
```

```cpp
#include <hip/hip_runtime.h>
#include <cstdio>
#include <cstdint>

#ifndef MK_SPLIT
#define MK_SPLIT 0
#endif

#ifndef DUPMASK
#define DUPMASK 0
#endif
#define DUP(b) (1 + ((DUPMASK >> (b)) & 1))
#define LAS __attribute__((address_space(3)))
#define GAS __attribute__((address_space(1)))
typedef unsigned short bf16_t;
typedef short bf16x8 __attribute__((ext_vector_type(8)));
typedef float f32x4 __attribute__((ext_vector_type(4)));
typedef float f32x2 __attribute__((ext_vector_type(2)));
typedef float f32x16 __attribute__((ext_vector_type(16)));
typedef unsigned u32x4 __attribute__((ext_vector_type(4)));
typedef unsigned u32x2 __attribute__((ext_vector_type(2)));
typedef __bf16 bf16x2_t __attribute__((ext_vector_type(2)));
typedef short v4i16_t __attribute__((ext_vector_type(4)));
typedef int v8i __attribute__((ext_vector_type(8)));
struct bf16x8_pair { bf16x8 a, b; };

constexpr int NB = 8, SEQ = 4096, T = NB * SEQ, D = 1024, NL = 4;
constexpr int NPROJ = 2816;
constexpr int C_FQ = 0, C_FK = 512, C_FV = 1024, C_GQ = 1536, C_GF = 1792, C_GI = 2048, C_GG = 2304, C_PU = 2560;
constexpr int IN_COLS = 2824;
constexpr int NE = 32, TOPK = 4, FF = 1024, MROWS = T * TOPK, LISTCAP = MROWS, MAXTILES = MROWS / 256 + NE;
constexpr float RMS_EPS = 1e-5f, LOG2E = 1.4426950408889634f;
constexpr float QSCALE = 0.125f * LOG2E;
constexpr int NWAVES = 8, NTHREADS = 512;

constexpr size_t MiB = 1u << 20;
constexpr size_t WS_CTL = 0, CTL_ZERO_BYTES = 1 * MiB;
constexpr size_t WS_RSTD1 = 1 * MiB, WS_RSTD2 = WS_RSTD1 + 128 * 1024;
constexpr size_t WS_LOGF = 2 * MiB, WS_C2 = 3 * MiB, WS_GATE = 4 * MiB, WS_B1R = 5 * MiB, WS_WFRAG = 6 * MiB, WS_LIST = 8 * MiB;
constexpr size_t WS_WIN = 40 * MiB, WIN_BYTES = (size_t)NPROJ * D * 2;
constexpr size_t WS_WOUT = 62 * MiB, WOUT_BYTES = (size_t)D * D * 2;
constexpr size_t WS_W1 = 70 * MiB, W1E_BYTES = (size_t)2 * FF * D;
constexpr size_t WS_W2 = 582 * MiB, W2E_BYTES = (size_t)D * FF;
constexpr size_t WS_HB8 = 400 * MiB;
constexpr float W1_SCALE = 64.f, W2_SCALE = 128.f, ACT_SCALE = 4.f;
constexpr size_t WS_HB = 838 * MiB;
constexpr size_t WS_PA = 902 * MiB;
constexpr size_t WS_MIXED = WS_PA + 176 * MiB;
constexpr size_t WS_Y = 1174 * MiB;
constexpr size_t WS_ORAW = 1430 * MiB;
constexpr size_t WS_SEND = 1558 * MiB;
constexpr size_t WS_PSEG = 1566 * MiB;
constexpr size_t WS_QE = 1567 * MiB;
constexpr size_t WS_PWT = 1583 * MiB;
constexpr size_t WS_SEND2 = 1584 * MiB;
constexpr size_t WS_END = 1600 * MiB;
static_assert(WS_WIN + NL * WIN_BYTES <= WS_WOUT && WS_WOUT + NL * WOUT_BYTES <= WS_W1 && WS_W1 + (size_t)NL * NE * W1E_BYTES <= WS_W2 && WS_W2 + (size_t)NL * NE * W2E_BYTES <= WS_HB, "ws map");
static_assert((size_t)MAXTILES * 256 * FF * 2 <= 272 * MiB && (size_t)T * NPROJ * 2 <= 176 * MiB, "ws map 2");
constexpr int CW_TMO = 0, CW_BAR = 4096, CW_CUR = 16384, CW_KMAX = 32768, CW_AQ = 40960;
constexpr int PH_BYTES = 139264, LDSCTL_OFF = PH_BYTES, LDS_BYTES = PH_BYTES + 2048;
static_assert(PH_BYTES >= 131072 + 512 * 16, "GEMM phase: stage buffers + parked A offsets");
constexpr int LC_BAR = 0, LC_TB = 64, LC_CN = 256, LC_R2CNT = 512, LC_R2BASE = 640, LC_STOP = 768, LC_SCAN = 896, LC_INP = 1024, LC_AQ = 1280;

__device__ __forceinline__ unsigned cvtpk(float lo, float hi) { f32x2 v = {lo, hi}; bf16x2_t b = __builtin_convertvector(v, bf16x2_t); return __builtin_bit_cast(unsigned, b); }
__device__ __forceinline__ float bflo(unsigned w) { return __uint_as_float(w << 16); }
__device__ __forceinline__ float bfhi(unsigned w) { return __uint_as_float(w & 0xffff0000u); }
__device__ __forceinline__ float bf2f(bf16_t h) { return __uint_as_float((unsigned)h << 16); }
__device__ __forceinline__ bf16_t f2bf(float f) { return (bf16_t)(cvtpk(f, 0.f) & 0xffffu); }
__device__ __forceinline__ float rdlane(float v, int l) { return __uint_as_float((unsigned)__builtin_amdgcn_readlane((int)__float_as_uint(v), l)); }
__device__ __forceinline__ unsigned pk4_fp8(float a, float b, float c, float d) { int w = __builtin_amdgcn_cvt_pk_fp8_f32(a, b, 0, false); w = __builtin_amdgcn_cvt_pk_fp8_f32(c, d, w, true); return (unsigned)w; }
#define LDS_WAIT() asm volatile("s_waitcnt lgkmcnt(0)" ::: "memory")
#define VM_WAIT() asm volatile("s_waitcnt vmcnt(0)" ::: "memory")

namespace pg8 {
constexpr int BM = 256, BK = 64, HALF = 128, HTB = HALF * BK * 2, STAGE_BYTES = 8 * HTB, NXCD = 8, WGM = 8;
__host__ __device__ __forceinline__ int lds_byte(int r, int c) { const int st = (r >> 4) * 2 + (c >> 5), rr = r & 15, cc = c & 31, ob = rr * 64 + cc * 2; return st * 1024 + (ob ^ (((ob >> 9) & 1) << 5)); }
__host__ __device__ __forceinline__ void stage_rc(int b, int& R, int& C) { const int st = b / 1024, sb = b % 1024, swz = sb ^ (((sb >> 9) & 1) << 5); R = (st >> 1) * 16 + swz / 64; C = (st & 1) * 32 + (swz % 64) / 2; }
__host__ __device__ __forceinline__ int perm32(int rho) { const int n = rho >> 4, i = rho & 15; return 8 * (i >> 2) + 4 * n + (i & 3); }

struct Unit { int pm, pn, e, lt, cnt; };

__device__ __forceinline__ void tile_of(int L, int nM, int nN, int& pm, int& pn) {
    const int nwg = nM * nN; int wgid = L;
    { const int q = nwg / NXCD, r = nwg % NXCD, xcd = wgid % NXCD, off = wgid / NXCD; wgid = (xcd < r ? xcd * (q + 1) : r * (q + 1) + (xcd - r) * q) + off; }
    const int nig = WGM * nN, gid = wgid / nig, fm = gid * WGM, gsz = (nM - fm) < WGM ? (nM - fm) : WGM;
    pm = fm + ((wgid % nig) % gsz); pn = (wgid % nig) / gsz;
}
struct StaticOrder {
    int nM, nN, nwg, G, c, rep = 1; const char* Bt; size_t tstep;
    __device__ void init(int M, int N, int K, int G_, int c_, const bf16_t* Bt_) { nM = M / BM; nN = N / BM; nwg = nM * nN; G = G_; c = c_; Bt = (const char*)Bt_; tstep = (size_t)BM * K * 2; }
    __device__ __forceinline__ bool next(int i, Unit& u) const { long L = (long)i * G + c; if (L >= (long)nwg * rep) return false; L %= nwg; tile_of((int)L, nM, nN, u.pm, u.pn); u.e = 0; u.lt = 0; u.cnt = 0; return true; }
    __device__ __forceinline__ const char* bbase(const Unit& u) const { return Bt + (size_t)u.pn * tstep; }
    __device__ __forceinline__ int arow(const Unit& u, int r) const { return u.pm * BM + r; }
};
template <bool GATHER, size_t ESTRIDE, size_t TSTEP> struct MoeOrder {
    static constexpr size_t estride = ESTRIDE, tstep = TSTEP;
    int nM, nN, nwg, G, c, rep = 1; const char* Wt; LAS const int* tb; LAS const int* cn; const u32x2* list;
    __device__ __forceinline__ bool next(int i, Unit& u) const {
        long L = (long)i * G + c; if (L >= (long)nwg * rep) return false; L %= nwg; tile_of((int)L, nM, nN, u.pm, u.pn);
        int e = 0; while (e < NE - 1 && __builtin_amdgcn_readfirstlane(tb[e + 1]) <= u.pm) ++e;
        u.e = e; u.lt = u.pm - __builtin_amdgcn_readfirstlane(tb[e]); u.cnt = __builtin_amdgcn_readfirstlane(cn[e]); return true; }
    __device__ __forceinline__ const char* bbase(const Unit& u) const { return Wt + (size_t)u.e * estride + (size_t)u.pn * tstep; }
    __device__ __forceinline__ int arow(const Unit& u, int r) const {
        if (!GATHER) return u.pm * BM + r;
        const int pos = u.lt * BM + r; const char* lb = (const char*)(list + (size_t)u.e * LISTCAP);
        return pos < u.cnt ? (int)(*(const unsigned*)(lb + (unsigned)pos * 8u) >> 2) : 0; }
};

template <class Epi, class Sched, bool ALIGN_EPI, bool FP8 = false>
__device__ __forceinline__ void gemm_phase(const int tid, LAS unsigned char* lds, const void* Abase, const int  , const Sched& S, const Epi& E) {
    constexpr int K = 1024;
    const int wid = __builtin_amdgcn_readfirstlane(tid >> 6), lane = tid & 63, wr = wid >> 2, wc = wid & 3, fr = lane & 15, fq = lane >> 4;
    constexpr int rowB = FP8 ? K : 2 * K;
    constexpr int nt = rowB / (BK * 2);
    unsigned voffB[2];
#pragma unroll
    for (int i = 0; i < 2; ++i) { int R, C; stage_rc(tid * 16 + i * 8192, R, C); const int Rb = Epi::PERM ? ((R & ~31) + perm32(R & 31)) : R; voffB[i] = (unsigned)(Rb * rowB + C * 2); }
    constexpr size_t kstep = (size_t)(BK * 2);
    constexpr size_t hstep = (size_t)HALF * rowB;
    const unsigned ldsw = (unsigned)wid * 1024u;
    const int a8off = (fq >> 1) * 1024 + ((fr * 64 + 32 * (fq & 1)) ^ (((fr >> 3) & 1) << 5));
    const int aoff = FP8 ? (wr * 8192 + a8off) : lds_byte(wr * 64 + fr, fq * 8), boff = FP8 ? (wc * 4096 + a8off) : lds_byte(wc * 32 + fr, fq * 8);
    const char* A8 = (const char*)Abase;
#define PG8_SA(b, h) (((b) * 2 + (h)) * HTB)
#define PG8_SB(b, h) ((4 + (b) * 2 + (h)) * HTB)
#define PG8_STGB(bufoff, gbase) do { _Pragma("unroll") for (int _i = 0; _i < 2; ++_i) \
        __builtin_amdgcn_global_load_lds((const unsigned*)((const char*)(gbase) + voffB[_i]), (LAS unsigned*)(lds + (bufoff) + ldsw + _i * 8192), 16, 0, 0); } while (0)
#define PG8_STGA(bufoff, kb, o0, o1) do { \
        __builtin_amdgcn_global_load_lds((const unsigned*)(A8 + (size_t)(kb) + (o0)), (LAS unsigned*)(lds + (bufoff) + ldsw), 16, 0, 0); \
        __builtin_amdgcn_global_load_lds((const unsigned*)(A8 + (size_t)(kb) + (o1)), (LAS unsigned*)(lds + (bufoff) + ldsw + 8192), 16, 0, 0); } while (0)
#define PG8_LD8(off) __builtin_bit_cast(v8i, bf16x8_pair{*(const LAS bf16x8*)(lds + (off)), *(const LAS bf16x8*)(lds + (off) + 16)})
#define PG8_LDA(dst, b, h) do { if constexpr (FP8) { _Pragma("unroll") for (int m = 0; m < 4; ++m) dst##8[m] = PG8_LD8(PG8_SA(b, h) + aoff + m * 2048); } \
        else { _Pragma("unroll") for (int m = 0; m < 4; ++m) _Pragma("unroll") for (int k = 0; k < 2; ++k) dst[m][k] = *(const LAS bf16x8*)(lds + PG8_SA(b, h) + aoff + m * 2048 + k * 1024); } } while (0)
#define PG8_LDB(dst, b, h) do { if constexpr (FP8) { _Pragma("unroll") for (int n = 0; n < 2; ++n) dst##8[n] = PG8_LD8(PG8_SB(b, h) + boff + n * 2048); } \
        else { _Pragma("unroll") for (int n = 0; n < 2; ++n) _Pragma("unroll") for (int k = 0; k < 2; ++k) dst[n][k] = *(const LAS bf16x8*)(lds + PG8_SB(b, h) + boff + n * 2048 + k * 1024); } } while (0)
#define PG8_MMA(ai, bj, At, Bt) do { __builtin_amdgcn_s_setprio(1); _Pragma("unroll") for (int m = 0; m < 4; ++m) _Pragma("unroll") for (int n = 0; n < 2; ++n) { \
        if constexpr (FP8) asm volatile("v_mfma_f32_16x16x128_f8f6f4 %0, %1, %2, %0" : "+v"(acc[ai][bj][m][n]) : "v"(Bt##8[n]), "v"(At##8[m]));     \
        else { _Pragma("unroll") for (int k = 0; k < 2; ++k) acc[ai][bj][m][n] = __builtin_amdgcn_mfma_f32_16x16x32_bf16(Bt[n][k], At[m][k], acc[ai][bj][m][n], 0, 0, 0); } } __builtin_amdgcn_s_setprio(0); } while (0)
#define PG8_WAIT_V(n) asm volatile("s_waitcnt vmcnt(" #n ")" ::: "memory")
#define PG8_WAIT_L(n) asm volatile("s_waitcnt lgkmcnt(" #n ")" ::: "memory")
#define PG8_BAR __builtin_amdgcn_s_barrier()
#define PG8_SCHED __builtin_amdgcn_sched_barrier(0)
#define PG8_AOFF(u, dst) do { int t_ = tid; asm volatile("" : "+v"(t_));     \
        _Pragma("unroll") for (int _h = 0; _h < 2; ++_h) _Pragma("unroll") for (int _i = 0; _i < 2; ++_i) \
        { int R_, C_; stage_rc(t_ * 16 + _i * 8192, R_, C_); dst[_h][_i] = (unsigned)((size_t)S.arow(u, _h * HALF + R_) * (size_t)rowB + (size_t)(C_ * 2)); } } while (0)
    Unit cur, nxt; int ui = 0;
    if (!S.next(0, cur)) return;
    f32x4 acc[2][2][4][2];
#pragma unroll
    for (int a = 0; a < 2; ++a)
#pragma unroll
        for (int b = 0; b < 2; ++b)
#pragma unroll
            for (int m = 0; m < 4; ++m)
#pragma unroll
                for (int n = 0; n < 2; ++n) acc[a][b][m][n] = (f32x4){0.f, 0.f, 0.f, 0.f};
    bf16x8 At[4][2], B0[2][2], B1[2][2]; v8i At8[4], B08[2], B18[2];
    unsigned aoC[2][2], aoN[2][2];
    PG8_AOFF(cur, aoC);
    const char* cB = S.bbase(cur);
    PG8_STGB(PG8_SB(0, 0), cB); PG8_STGB(PG8_SB(0, 1), cB + hstep); PG8_STGA(PG8_SA(0, 0), 0, aoC[0][0], aoC[0][1]); PG8_STGA(PG8_SA(0, 1), 0, aoC[1][0], aoC[1][1]);
    if (wr == 1) PG8_BAR;
    PG8_WAIT_V(2); PG8_BAR;
    PG8_STGB(PG8_SB(1, 0), cB + kstep); PG8_STGA(PG8_SA(1, 0), kstep, aoC[0][0], aoC[0][1]); PG8_STGB(PG8_SB(1, 1), cB + hstep + kstep);
    PG8_WAIT_V(6); PG8_BAR;
    for (;;) {
        const bool has_next = S.next(ui + 1, nxt);
        if (has_next) { PG8_AOFF(nxt, aoN); } else { aoN[0][0] = aoC[0][0]; aoN[0][1] = aoC[0][1]; aoN[1][0] = aoC[1][0]; aoN[1][1] = aoC[1][1]; }
        *(LAS u32x4*)(lds + STAGE_BYTES + tid * 16) = (u32x4){aoN[0][0], aoN[0][1], aoN[1][0], aoN[1][1]};
        const char* nB = has_next ? S.bbase(nxt) : cB;
        for (int t = 0; t < nt; t += 2) {
            asm volatile("" : "+v"(voffB[0]), "+v"(voffB[1]));
            const bool last = (t == nt - 2);
            const size_t k1 = (size_t)(t + 1) * kstep, k2 = last ? 0 : (size_t)(t + 2) * kstep, k3 = k2 + kstep;
            const char* b2 = last ? nB : cB + (size_t)(t + 2) * kstep; const char* b3 = b2 + kstep;
            PG8_LDB(B0, 0, 0); PG8_LDB(B1, 0, 1); PG8_SCHED; PG8_LDA(At, 0, 0); PG8_STGA(PG8_SA(1, 1), k1, aoC[1][0], aoC[1][1]);
            PG8_WAIT_V(8); PG8_WAIT_L(0); PG8_BAR; PG8_MMA(0, 0, At, B0); PG8_MMA(0, 1, At, B1); PG8_BAR; PG8_SCHED;
            if (last) { const u32x4 nx = *(const LAS u32x4*)(lds + STAGE_BYTES + tid * 16); aoC[0][0] = nx.x; aoC[0][1] = nx.y; aoC[1][0] = nx.z; aoC[1][1] = nx.w; }
            PG8_LDA(At, 0, 1); PG8_STGB(PG8_SB(0, 0), b2); PG8_STGB(PG8_SB(0, 1), b2 + hstep); PG8_STGA(PG8_SA(0, 0), k2, aoC[0][0], aoC[0][1]);
            PG8_WAIT_V(8); PG8_WAIT_L(0); PG8_BAR; PG8_MMA(1, 0, At, B0); PG8_MMA(1, 1, At, B1); PG8_BAR; PG8_SCHED;
            PG8_LDB(B0, 1, 0); PG8_LDB(B1, 1, 1); PG8_SCHED; PG8_LDA(At, 1, 0); PG8_STGA(PG8_SA(0, 1), k2, aoC[1][0], aoC[1][1]);
            PG8_WAIT_V(8); PG8_WAIT_L(0); PG8_BAR; PG8_MMA(0, 0, At, B0); PG8_MMA(0, 1, At, B1); PG8_BAR; PG8_SCHED;
            PG8_LDA(At, 1, 1); PG8_STGB(PG8_SB(1, 0), b3); PG8_STGB(PG8_SB(1, 1), b3 + hstep); PG8_STGA(PG8_SA(1, 0), k3, aoC[0][0], aoC[0][1]);
            PG8_WAIT_V(8); PG8_WAIT_L(0); PG8_BAR; PG8_MMA(1, 0, At, B0); PG8_MMA(1, 1, At, B1); PG8_BAR; PG8_SCHED;
        }
        if constexpr (FP8) asm volatile("s_nop 15\n\ts_nop 15" ::: "memory");
        if constexpr (ALIGN_EPI) { if (wr == 0) PG8_BAR; }
        { int t2_ = tid; asm volatile("" : "+v"(t2_)); const int l2_ = t2_ & 63; E(acc, cur, wr, wc, l2_ & 15, l2_ >> 4); }
        if (!has_next) break;
#pragma unroll
        for (int a = 0; a < 2; ++a)
#pragma unroll
            for (int b = 0; b < 2; ++b)
#pragma unroll
                for (int m = 0; m < 4; ++m)
#pragma unroll
                    for (int n = 0; n < 2; ++n) acc[a][b][m][n] = (f32x4){0.f, 0.f, 0.f, 0.f};
        cur = nxt; cB = nB; ++ui;
        if constexpr (ALIGN_EPI) { if (wr == 1) PG8_BAR; }
    }
    PG8_WAIT_V(0);
    if constexpr (!ALIGN_EPI) { if (wr == 0) PG8_BAR; }
    PG8_BAR;
#undef PG8_SA
#undef PG8_SB
#undef PG8_STGA
#undef PG8_STGB
#undef PG8_LDA
#undef PG8_LD8
#undef PG8_LDB
#undef PG8_MMA
#undef PG8_WAIT_V
#undef PG8_WAIT_L
#undef PG8_BAR
#undef PG8_SCHED
#undef PG8_AOFF
}

struct EpiProj {
    static constexpr bool PERM = true;
    bf16_t* O; const float* rstd; unsigned* kmax;
    __device__ __forceinline__ void operator()(const f32x4 (&acc)[2][2][4][2], const Unit& u, int wr, int wc, int fr, int fq) const {
        const int row0 = u.pm * BM + wr * 64 + fr, col0 = u.pn * BM + wc * 32 + 8 * fq;
        const float sc = (u.pn < 2) ? QSCALE : 1.f; const bool isk = (u.pn == 2 || u.pn == 3);
        float km[2] = {0.f, 0.f};
#pragma unroll
        for (int ai = 0; ai < 2; ++ai)
#pragma unroll
            for (int m = 0; m < 4; ++m) { const int row = row0 + ai * HALF + m * 16; const float rs = rstd[row] * sc; bf16_t* rowp = O + (size_t)row * NPROJ + col0;
#pragma unroll
                for (int bj = 0; bj < 2; ++bj) { const f32x4 v0 = acc[ai][bj][m][0] * rs, v1 = acc[ai][bj][m][1] * rs;
                    u32x4 w; w.x = cvtpk(v0[0], v0[1]); w.y = cvtpk(v0[2], v0[3]); w.z = cvtpk(v1[0], v1[1]); w.w = cvtpk(v1[2], v1[3]);
                    *(u32x4*)(rowp + bj * HALF) = w;
                    if (isk) { float s = bflo(w.x) * bflo(w.x) + bfhi(w.x) * bfhi(w.x) + bflo(w.y) * bflo(w.y) + bfhi(w.y) * bfhi(w.y) + bflo(w.z) * bflo(w.z) + bfhi(w.z) * bfhi(w.z) + bflo(w.w) * bflo(w.w) + bfhi(w.w) * bfhi(w.w);
                        s += __shfl_xor(s, 16); s += __shfl_xor(s, 32); km[bj] = fmaxf(km[bj], s); } } }
        if (isk) {
#pragma unroll
            for (int bj = 0; bj < 2; ++bj) { float v = km[bj]; v = fmaxf(v, __shfl_xor(v, 1)); v = fmaxf(v, __shfl_xor(v, 2)); v = fmaxf(v, __shfl_xor(v, 4)); v = fmaxf(v, __shfl_xor(v, 8));
                if ((threadIdx.x & 63) == 0) { const int b = u.pm >> 4, h = (u.pn - 2) * 4 + bj * 2 + (wc >> 1); atomicMax(kmax + (b * 8 + h) * 16, __float_as_uint(v)); } }
        }
    }
};
struct EpiOut {
    static constexpr bool PERM = false;
    const float* res; float* out;
    __device__ __forceinline__ void operator()(const f32x4 (&acc)[2][2][4][2], const Unit& u, int wr, int wc, int fr, int fq) const {
        const int row0 = u.pm * BM + wr * 64 + fr, col0 = u.pn * BM + wc * 32 + 4 * fq;
#pragma unroll
        for (int ai = 0; ai < 2; ++ai)
#pragma unroll
            for (int m = 0; m < 4; ++m) { const size_t off = (size_t)(row0 + ai * HALF + m * 16) * D + col0;
#pragma unroll
                for (int bj = 0; bj < 2; ++bj)
#pragma unroll
                    for (int n = 0; n < 2; ++n) { const f32x4 r = *(const f32x4*)(res + off + bj * HALF + n * 16); *(f32x4*)(out + off + bj * HALF + n * 16) = r + acc[ai][bj][m][n]; } }
    }
};
struct EpiGlu {
    static constexpr bool PERM = true;
    unsigned char* act; const u32x2* list; const float* b1r;
    __device__ __forceinline__ void operator()(const f32x4 (&acc)[2][2][4][2], const Unit& u, int wr, int wc, int fr, int fq) const {
        const int cb = u.pn * BM + wc * 32 + 8 * fq; const float* bp = b1r + (size_t)u.e * 2048 + cb; const char* lbase = (const char*)(list + (size_t)u.e * LISTCAP);
#pragma unroll
        for (int ai = 0; ai < 2; ++ai)
#pragma unroll
            for (int m = 0; m < 4; ++m) { const int r = ai * HALF + wr * 64 + m * 16 + fr, pos = u.lt * BM + r;
                float rs = 0.f; if (pos < u.cnt) rs = __uint_as_float(*(const unsigned*)(lbase + (unsigned)pos * 8u + 4u)) * (1.0f / W1_SCALE);
                const f32x4 bg0 = *(const f32x4*)(bp), bg1 = *(const f32x4*)(bp + 4), bl0 = *(const f32x4*)(bp + HALF), bl1 = *(const f32x4*)(bp + HALF + 4);
                f32x4 g0 = acc[ai][0][m][0] * rs + bg0, g1 = acc[ai][0][m][1] * rs + bg1, l0 = acc[ai][1][m][0] * rs + bl0, l1 = acc[ai][1][m][1] * rs + bl1;
                float o[8];
#pragma unroll
                for (int j = 0; j < 8; ++j) { float g = j < 4 ? g0[j & 3] : g1[j & 3], li = j < 4 ? l0[j & 3] : l1[j & 3];
                    g = fminf(g, 7.f); li = fminf(fmaxf(li, -7.f), 7.f);
                    const float sg = __builtin_amdgcn_rcpf(1.f + __builtin_amdgcn_exp2f(-1.702f * LOG2E * g)); o[j] = g * sg * (li + 1.f) * ACT_SCALE; }
                *(u32x2*)(act + (size_t)(u.pm * BM + r) * FF + u.pn * HALF + wc * 32 + 8 * fq) = (u32x2){pk4_fp8(o[0], o[1], o[2], o[3]), pk4_fp8(o[4], o[5], o[6], o[7])}; }
    }
};
struct EpiDown {
    static constexpr bool PERM = true;
    bf16_t* Y; const u32x2* list; const float* gate; const float* b2;
    __device__ __forceinline__ void operator()(const f32x4 (&acc)[2][2][4][2], const Unit& u, int wr, int wc, int fr, int fq) const {
        const int cb = u.pn * BM + wc * 32 + 8 * fq; const float* bp = b2 + (size_t)u.e * D + cb;
        f32x4 bv[2][2];
#pragma unroll
        for (int bj = 0; bj < 2; ++bj)
#pragma unroll
            for (int n = 0; n < 2; ++n) bv[bj][n] = *(const f32x4*)(bp + bj * HALF + 4 * n);
#pragma unroll
        for (int ai = 0; ai < 2; ++ai)
#pragma unroll
            for (int m = 0; m < 4; ++m) { const int r = ai * HALF + wr * 64 + m * 16 + fr, pos = u.lt * BM + r;
                if (pos < u.cnt) { const unsigned ent = list[(size_t)u.e * LISTCAP + pos].x; const float gt = gate[ent]; bf16_t* rowp = Y + (size_t)ent * D + cb;
#pragma unroll
                    for (int bj = 0; bj < 2; ++bj) { const f32x4 v0 = (acc[ai][bj][m][0] * (1.0f / (W2_SCALE * ACT_SCALE)) + bv[bj][0]) * gt, v1 = (acc[ai][bj][m][1] * (1.0f / (W2_SCALE * ACT_SCALE)) + bv[bj][1]) * gt;
                        u32x4 w; w.x = cvtpk(v0[0], v0[1]); w.y = cvtpk(v0[2], v0[3]); w.z = cvtpk(v1[0], v1[1]); w.w = cvtpk(v1[2], v1[3]);
                        *(u32x4*)(rowp + bj * HALF) = w; } } }
    }
};
}

#define XB_TMO      128
#define XB_XCNT(j)  (256  + 64 * (j))
#define XB_XSUB(j)  (1280 + 64 * (j))
#define XB_XGEN(j)  (2304 + 64 * (j))
#define XB_TOP      3328
#define XB_TOPGEN   3392
#define XCD_BAR_WORDS 3456
#define XB_SPIN_CAP (1u << 18)
__device__ __forceinline__ unsigned xb_ld(unsigned* p)              { return __hip_atomic_load(p, __ATOMIC_RELAXED, __HIP_MEMORY_SCOPE_AGENT); }
__device__ __forceinline__ unsigned xb_add(unsigned* p, unsigned v) { return __hip_atomic_fetch_add(p, v, __ATOMIC_RELAXED, __HIP_MEMORY_SCOPE_AGENT); }
__device__ __forceinline__ unsigned xb_xcc_id() { return (unsigned)__builtin_amdgcn_s_getreg((3 << 11) | 20) & 0xFu; }
#define XB_SPIN(cond, bar) do { unsigned _sp = 0; while (cond) { __builtin_amdgcn_s_sleep(1); \
    if ((++_sp & 255u) == 0u) { if (xb_ld(&(bar)[XB_TMO])) break; if (_sp > XB_SPIN_CAP) { atomicAdd(&(bar)[XB_TMO], 1u); break; } } } } while (0)
struct XcdBarrier { unsigned* bar; unsigned x; volatile LAS unsigned* st; };
__device__ __forceinline__ XcdBarrier xcd_barrier_post(unsigned* bar, volatile LAS unsigned* st) {
    XcdBarrier b; b.bar = bar; b.x = xb_xcc_id(); b.st = st;
    if (threadIdx.x == 0) (void)xb_add(&bar[XB_XCNT(b.x)], 1u);
    return b;
}
__device__ __forceinline__ void xcd_barrier_complete(unsigned* bar, unsigned x, unsigned& nloc, unsigned& nx) {
    const unsigned G = gridDim.x * gridDim.y * gridDim.z;
    unsigned sum, cnt, mine, sp = 0u;
    for (;;) {
        sum = 0u; cnt = 0u; mine = 0u;
#pragma unroll
        for (unsigned j = 0; j < 16; ++j) { const unsigned c = xb_ld(&bar[XB_XCNT(j)]); sum += c; cnt += (c > 0u) ? 1u : 0u; mine = (j == x) ? c : mine; }
        if (sum == G) break;
        __builtin_amdgcn_s_sleep(1);
        if ((++sp & 255u) == 0u) { if (xb_ld(&bar[XB_TMO])) break; if (sp > XB_SPIN_CAP) { atomicAdd(&bar[XB_TMO], 1u); break; } }
    }
    nloc = mine > 0u ? mine : 1u; nx = cnt > 0u ? cnt : 1u;
}
__device__ __forceinline__ void xcd_barrier(const XcdBarrier& b, const bool leader  ) {
    asm volatile("s_waitcnt vmcnt(0)" ::: "memory");
    __syncthreads();
    if (leader) {
        unsigned* bar = b.bar;
        __builtin_amdgcn_s_waitcnt(0);
        unsigned nloc = b.st[0], nx = b.st[1];
        if (nloc == 0u) { xcd_barrier_complete(bar, b.x, nloc, nx); b.st[0] = nloc; b.st[1] = nx; }
        const unsigned old = xb_add(&bar[XB_XSUB(b.x)], 1u);
        const unsigned gen = old / nloc;
        if (old + 1u == (gen + 1u) * nloc) {
            __builtin_amdgcn_fence(__ATOMIC_RELEASE, "agent");
            asm volatile("s_waitcnt vmcnt(0)" ::: "memory");
            const unsigned og = xb_add(&bar[XB_TOP], 1u);
            const unsigned tg = og / nx;
            if (og + 1u == (tg + 1u) * nx) xb_add(&bar[XB_TOPGEN], 1u);
            else XB_SPIN(xb_ld(&bar[XB_TOPGEN]) == tg, bar);
            __builtin_amdgcn_fence(__ATOMIC_ACQUIRE, "agent");
            xb_add(&bar[XB_XGEN(b.x)], 1u);
            asm volatile("s_waitcnt vmcnt(0)" ::: "memory");
        } else {
            XB_SPIN(xb_ld(&bar[XB_XGEN(b.x)]) == gen, bar);
            __builtin_amdgcn_fence(__ATOMIC_ACQUIRE, "agent");
            asm volatile("s_waitcnt vmcnt(0)" ::: "memory");
        }
    }
    __syncthreads();
}

enum { I_x = 0, I_norm_mix, I_w_in, I_b_fox_f, I_fox_gain, I_hgrn_lb, I_hgrn_gain, I_pool_w, I_pool_scale, I_w_out, I_norm_moe, I_w_router, I_b_router, I_w1, I_b1, I_w2, I_b2, I_norm_final };
struct Frame {
    LAS unsigned char* lds; unsigned char* ws; unsigned* ctl; float* out;
    int tid, lane, wave, bid, G;
};
__device__ __forceinline__ const float* inp(const Frame& F, int i) {
    const LAS unsigned* p = (const LAS unsigned*)(F.lds + LDSCTL_OFF + LC_INP) + 2 * i;
    const unsigned lo = __builtin_amdgcn_readfirstlane(p[0]), hi = __builtin_amdgcn_readfirstlane(p[1]);
    return (const float*)(((unsigned long long)hi << 32) | lo);
}

constexpr int P0_ROWB = 272;
template <bool INTERLEAVED, bool OUT8 = false>
__device__ __forceinline__ void p0_item(const float* src  , int ldn, const float* g  , void* dstv  , int K, int drow0, int extra, LAS unsigned char* tile, int lane, float scale = 1.f) {
    bf16_t* dst = (bf16_t*)dstv; unsigned char* dst8 = (unsigned char*)dstv;
    f32x4 v[16];
    const float* sp = src + (size_t)(lane >> 5) * ldn + 4 * (lane & 31);
#pragma unroll
    for (int j = 0; j < 16; ++j) v[j] = __builtin_nontemporal_load((const f32x4*)(sp + (size_t)(2 * j) * ldn));
    if (g) {
#pragma unroll
        for (int j = 0; j < 16; ++j) v[j] = v[j] * (g[2 * j + (lane >> 5)] * scale);
    } else if (OUT8) {
#pragma unroll
        for (int j = 0; j < 16; ++j) v[j] = v[j] * scale;
    }
#pragma unroll
    for (int j = 0; j < 16; ++j) { const int k = 2 * j + (lane >> 5); const unsigned w0 = cvtpk(v[j][0], v[j][1]), w1 = cvtpk(v[j][2], v[j][3]);
        if (INTERLEAVED) { const unsigned gg = (w0 & 0xffffu) | (w1 << 16), ll = (w0 >> 16) | (w1 & 0xffff0000u);
            *(LAS unsigned*)(tile + k * P0_ROWB + 4 * (lane & 31)) = gg; *(LAS unsigned*)(tile + k * P0_ROWB + 128 + 4 * (lane & 31)) = ll; }
        else *(LAS u32x2*)(tile + k * P0_ROWB + 8 * (lane & 31)) = (u32x2){w0, w1}; }
    LDS_WAIT(); asm volatile("" ::: "memory");
    const int gq = lane >> 4, i16 = lane & 15;
    const LAS unsigned char* rp = tile + (8 * gq + (i16 >> 2)) * P0_ROWB + 8 * (lane & 3);
#pragma unroll
    for (int nb = 0; nb < 8; ++nb) {
        const v4i16_t lo = __builtin_amdgcn_ds_read_tr16_b64_v4i16((LAS v4i16_t*)(rp + nb * 32)), hi = __builtin_amdgcn_ds_read_tr16_b64_v4i16((LAS v4i16_t*)(rp + nb * 32 + 4 * P0_ROWB));
        const int tc = nb * 16 + i16, row = drow0 + tc + (tc >= 64 ? extra : 0);
        if (OUT8) { *(u32x2*)(dst8 + (size_t)row * K + 8 * gq) = (u32x2){pk4_fp8(bf2f((bf16_t)lo[0]), bf2f((bf16_t)lo[1]), bf2f((bf16_t)lo[2]), bf2f((bf16_t)lo[3])), pk4_fp8(bf2f((bf16_t)hi[0]), bf2f((bf16_t)hi[1]), bf2f((bf16_t)hi[2]), bf2f((bf16_t)hi[3]))}; }
        else { const bf16x8 o = (bf16x8){lo[0], lo[1], lo[2], lo[3], hi[0], hi[1], hi[2], hi[3]};
            *(bf16x8*)(dst + (size_t)row * K + 8 * gq) = o; } }
    LDS_WAIT(); asm volatile("" ::: "memory");
}
__device__ __forceinline__ void p0_prologue(const Frame& F) {
    LAS unsigned char* tile = F.lds + F.wave * (32 * P0_ROWB);
    const int gw = F.bid * NWAVES + F.wave, NGW = F.G * NWAVES;
    constexpr int I_IN = 32 * 22, I_OUT = 32 * 8, I_W1 = NE * 32 * 16, I_W2 = NE * 32 * 8, I_L = I_IN + I_OUT + I_W1 + I_W2;
    for (int it = gw; it < NL * I_L; it += NGW) {
        const int l = it / I_L; int r = it % I_L;
        if (r < I_IN) { const int nb = r / 32, kb = r % 32, n0 = 128 * nb, k0 = 32 * kb;
            p0_item<false>(inp(F, I_w_in) + ((size_t)l * D + k0) * IN_COLS + n0 + (n0 >= 1536 ? 8 : 0), IN_COLS, inp(F, I_norm_mix) + l * D + k0, (bf16_t*)(F.ws + WS_WIN + l * WIN_BYTES) + k0, D, n0, 0, tile, F.lane); continue; }
        r -= I_IN;
        if (r < I_OUT) { const int nb = r / 32, kb = r % 32, n0 = 128 * nb, k0 = 32 * kb;
            p0_item<false>(inp(F, I_w_out) + ((size_t)l * D + k0) * D + n0, D, nullptr, (bf16_t*)(F.ws + WS_WOUT + l * WOUT_BYTES) + k0, D, n0, 0, tile, F.lane); continue; }
        r -= I_OUT;
        if (r < I_W1) { const int e = r / (32 * 16), q = r % (32 * 16), cb = q / 32, kb = q % 32, k0 = 32 * kb, j0 = 64 * cb;
            p0_item<true, true>(inp(F, I_w1) + (((size_t)l * NE + e) * D + k0) * (2 * FF) + 2 * j0, 2 * FF, inp(F, I_norm_moe) + l * D + k0, F.ws + WS_W1 + ((size_t)l * NE + e) * W1E_BYTES + k0, D, (j0 >> 7) * 256 + (j0 & 127), 64, tile, F.lane, W1_SCALE); continue; }
        r -= I_W1;
        { const int e = r / (32 * 8), q = r % (32 * 8), nb = q / 32, kb = q % 32, n0 = 128 * nb, k0 = 32 * kb;
            p0_item<false, true>(inp(F, I_w2) + (((size_t)l * NE + e) * FF + k0) * D + n0, D, nullptr, F.ws + WS_W2 + ((size_t)l * NE + e) * W2E_BYTES + k0, FF, n0, 0, tile, F.lane, W2_SCALE); }
    }
    const int gt = F.bid * NTHREADS + F.tid, NGT = F.G * NTHREADS;
    float* b1r = (float*)(F.ws + WS_B1R);
    for (int i = gt; i < NL * NE * 2048; i += NGT) { const int le = i >> 11, n = i & 2047, pn = n >> 8, rr = n & 255; b1r[i] = inp(F, I_b1)[(size_t)le * 2048 + 2 * (128 * pn + (rr & 127)) + (rr >> 7)]; }
    { bf16_t* pwt = (bf16_t*)(F.ws + WS_PWT);
      for (int i = gt; i < NL * 4 * 64 * 64; i += NGT) { const int c = i & 63, d = (i >> 6) & 63, lg = i >> 12; pwt[i] = f2bf(inp(F, I_pool_w)[((size_t)lg * 64 + c) * 64 + d]); } }
    bf16_t* wf = (bf16_t*)(F.ws + WS_WFRAG);
    for (int i = gt; i < NL * 2 * 32 * 2 * 64 * 8; i += NGT) {
        const int j = i & 7, ln = (i >> 3) & 63, et = (i >> 9) & 1, ks = (i >> 10) & 31, kind = (i >> 15) & 1, l = i >> 16;
        const int e = 16 * et + (ln & 15), k = 32 * ks + 8 * (ln >> 4) + j;
        float v;
        if (kind == 0) v = (e < 8) ? inp(F, I_norm_mix)[l * D + k] * inp(F, I_w_in)[((size_t)l * D + k) * IN_COLS + 1536 + e] : 0.f;
        else v = inp(F, I_norm_moe)[l * D + k] * inp(F, I_w_router)[((size_t)l * D + k) * NE + e];
        const bf16_t h = f2bf(v), lo = f2bf(v - bf2f(h));
        const size_t base = ((((size_t)(l * 2 + kind) * 32 + ks) * 2 + et) * 2) * 512 + ln * 8 + j;
        wf[base] = h; wf[base + 512] = lo;
    }
}

template <int KIND, bool COMBINE, bool WRITE_H, bool DRY = false>
__device__ __forceinline__ void r_phase(const Frame& F, int l, const float* hin, float* hout) {
    const int lane = F.lane, r16 = lane & 15, q4 = lane >> 4;
    const u32x4* Wf = (const u32x4*)(F.ws + WS_WFRAG + (size_t)(l * 2 + KIND) * 131072);
    const bf16_t* Y = (const bf16_t*)(F.ws + WS_Y);
    bf16_t* HB = (bf16_t*)(F.ws + WS_HB);
    float* rstdp = (float*)(F.ws + (KIND == 0 ? WS_RSTD1 : WS_RSTD2));
    LAS float* lg = (LAS float*)(F.lds) + F.wave * (16 * 33);
    LAS int* r2cnt = (LAS int*)(F.lds + LDSCTL_OFF + LC_R2CNT); LAS int* r2base = (LAS int*)(F.lds + LDSCTL_OFF + LC_R2BASE);
    for (int task = F.bid; task < T / 128; task += F.G) {
        const int tok = task * 128 + F.wave * 16 + r16;
        const float* xr = hin + (size_t)tok * D + 8 * q4; float* ho = hout + (size_t)tok * D + 8 * q4;
        const bf16_t* yr = Y + (size_t)tok * 4 * D + 8 * q4; bf16_t* hbr = HB + (size_t)tok * D + 8 * q4;
        f32x4 acc0 = {0.f, 0.f, 0.f, 0.f}, acc1 = {0.f, 0.f, 0.f, 0.f}; float ssq = 0.f;
        if (KIND == 1) { if (F.tid < 32) r2cnt[F.tid] = 0; }
#pragma unroll 2
        for (int ks = 0; ks < 32; ++ks) {
            f32x4 x0 = *(const f32x4*)(xr + 32 * ks), x1 = *(const f32x4*)(xr + 32 * ks + 4);
            if (COMBINE) {
#pragma unroll
                for (int k = 0; k < 4; ++k) { const u32x4 y = *(const u32x4*)(yr + (size_t)k * D + 32 * ks);
                    x0[0] += bflo(y.x); x0[1] += bfhi(y.x); x0[2] += bflo(y.y); x0[3] += bfhi(y.y); x1[0] += bflo(y.z); x1[1] += bfhi(y.z); x1[2] += bflo(y.w); x1[3] += bfhi(y.w); }
            }
            if (WRITE_H) { *(f32x4*)(ho + 32 * ks) = x0; *(f32x4*)(ho + 32 * ks + 4) = x1; }
            ssq += (x0[0] * x0[0] + x0[1] * x0[1]) + (x0[2] * x0[2] + x0[3] * x0[3]) + (x1[0] * x1[0] + x1[1] * x1[1]) + (x1[2] * x1[2] + x1[3] * x1[3]);
            u32x4 hw; hw.x = cvtpk(x0[0], x0[1]); hw.y = cvtpk(x0[2], x0[3]); hw.z = cvtpk(x1[0], x1[1]); hw.w = cvtpk(x1[2], x1[3]);
            u32x4 lw; lw.x = cvtpk(x0[0] - bflo(hw.x), x0[1] - bfhi(hw.x)); lw.y = cvtpk(x0[2] - bflo(hw.y), x0[3] - bfhi(hw.y)); lw.z = cvtpk(x1[0] - bflo(hw.z), x1[1] - bfhi(hw.z)); lw.w = cvtpk(x1[2] - bflo(hw.w), x1[3] - bfhi(hw.w));
            if (KIND == 0) *(u32x4*)(hbr + 32 * ks) = hw;
            else *(u32x2*)((unsigned char*)(F.ws + WS_HB8) + (size_t)tok * D + 8 * q4 + 32 * ks) = (u32x2){pk4_fp8(x0[0], x0[1], x0[2], x0[3]), pk4_fp8(x1[0], x1[1], x1[2], x1[3])};
            const bf16x8 xh = __builtin_bit_cast(bf16x8, hw), xl = __builtin_bit_cast(bf16x8, lw);
            const bf16x8 wh0 = __builtin_bit_cast(bf16x8, Wf[((ks * 2 + 0) * 2 + 0) * 64 + lane]), wl0 = __builtin_bit_cast(bf16x8, Wf[((ks * 2 + 0) * 2 + 1) * 64 + lane]);
            acc0 = __builtin_amdgcn_mfma_f32_16x16x32_bf16(wh0, xh, acc0, 0, 0, 0);
            acc0 = __builtin_amdgcn_mfma_f32_16x16x32_bf16(wl0, xh, acc0, 0, 0, 0);
            acc0 = __builtin_amdgcn_mfma_f32_16x16x32_bf16(wh0, xl, acc0, 0, 0, 0);
            if (KIND == 1) {
                const bf16x8 wh1 = __builtin_bit_cast(bf16x8, Wf[((ks * 2 + 1) * 2 + 0) * 64 + lane]), wl1 = __builtin_bit_cast(bf16x8, Wf[((ks * 2 + 1) * 2 + 1) * 64 + lane]);
                acc1 = __builtin_amdgcn_mfma_f32_16x16x32_bf16(wh1, xh, acc1, 0, 0, 0);
                acc1 = __builtin_amdgcn_mfma_f32_16x16x32_bf16(wl1, xh, acc1, 0, 0, 0);
                acc1 = __builtin_amdgcn_mfma_f32_16x16x32_bf16(wh1, xl, acc1, 0, 0, 0);
            }
        }
        ssq += __shfl_xor(ssq, 16); ssq += __shfl_xor(ssq, 32);
        const float rstd = 1.0f / sqrtf(ssq * (1.0f / D) + RMS_EPS);
        if (q4 == 0) rstdp[tok] = rstd;
        if (KIND == 0) {
            if (q4 < 2) { const f32x4 bf = *(const f32x4*)(inp(F, I_b_fox_f) + l * 8 + 4 * q4); f32x4 lf;
#pragma unroll
                for (int i = 0; i < 4; ++i) { const float z = rstd * acc0[i] + bf[i]; lf[i] = fminf(z, 0.f) - log1pf(expf(-fabsf(z))); }
                *(f32x4*)((float*)(F.ws + WS_LOGF) + (size_t)tok * 8 + 4 * q4) = lf; }
        } else if (!DRY) {
            const f32x4 b0 = *(const f32x4*)(inp(F, I_b_router) + l * NE + 4 * q4), b1v = *(const f32x4*)(inp(F, I_b_router) + l * NE + 16 + 4 * q4);
#pragma unroll
            for (int i = 0; i < 4; ++i) { lg[r16 * 33 + 4 * q4 + i] = rstd * acc0[i] + b0[i]; lg[r16 * 33 + 16 + 4 * q4 + i] = rstd * acc1[i] + b1v[i]; }
            LDS_WAIT(); asm volatile("" ::: "memory");
            float v0 = -INFINITY, v1 = -INFINITY, v2 = -INFINITY, v3 = -INFINITY; int i0 = 0, i1 = 0, i2 = 0, i3 = 0;
            if (lane < 16) {
                for (int e = 0; e < NE; ++e) { const float x = lg[lane * 33 + e];
                    if (x > v3) { if (x > v0) { v3 = v2; i3 = i2; v2 = v1; i2 = i1; v1 = v0; i1 = i0; v0 = x; i0 = e; }
                        else if (x > v1) { v3 = v2; i3 = i2; v2 = v1; i2 = i1; v1 = x; i1 = e; }
                        else if (x > v2) { v3 = v2; i3 = i2; v2 = x; i2 = e; }
                        else { v3 = x; i3 = e; } } }
            }
            __syncthreads();
            int rk0 = 0, rk1 = 0, rk2 = 0, rk3 = 0;
            if (lane < 16) { rk0 = __hip_atomic_fetch_add(&r2cnt[i0], 1, __ATOMIC_RELAXED, __HIP_MEMORY_SCOPE_WORKGROUP); rk1 = __hip_atomic_fetch_add(&r2cnt[i1], 1, __ATOMIC_RELAXED, __HIP_MEMORY_SCOPE_WORKGROUP); rk2 = __hip_atomic_fetch_add(&r2cnt[i2], 1, __ATOMIC_RELAXED, __HIP_MEMORY_SCOPE_WORKGROUP); rk3 = __hip_atomic_fetch_add(&r2cnt[i3], 1, __ATOMIC_RELAXED, __HIP_MEMORY_SCOPE_WORKGROUP); }
            __syncthreads();
            if (F.tid < 32) r2base[F.tid] = (int)atomicAdd(F.ctl + CW_CUR + (l * NE + F.tid) * 16, (unsigned)r2cnt[F.tid]);
            __syncthreads();
            if (lane < 16) {
                const float e1 = expf(v1 - v0), e2 = expf(v2 - v0), e3 = expf(v3 - v0), inv = 1.0f / (1.0f + e1 + e2 + e3);
                u32x2* list = (u32x2*)(F.ws + WS_LIST); float* gate = (float*)(F.ws + WS_GATE);
                const int tk = (task * 128 + F.wave * 16 + lane) * 4; const unsigned rb = __float_as_uint(__shfl(rstd, lane & 15));
                list[(size_t)i0 * LISTCAP + r2base[i0] + rk0] = (u32x2){(unsigned)(tk + 0), rb}; gate[tk + 0] = inv;
                list[(size_t)i1 * LISTCAP + r2base[i1] + rk1] = (u32x2){(unsigned)(tk + 1), rb}; gate[tk + 1] = e1 * inv;
                list[(size_t)i2 * LISTCAP + r2base[i2] + rk2] = (u32x2){(unsigned)(tk + 2), rb}; gate[tk + 2] = e2 * inv;
                list[(size_t)i3 * LISTCAP + r2base[i3] + rk3] = (u32x2){(unsigned)(tk + 3), rb}; gate[tk + 3] = e3 * inv;
            }
            __syncthreads();
        }
    }
}
__device__ __forceinline__ void r_final(const Frame& F) {
    const int lane = F.lane, tr = lane >> 5, c = lane & 31;
    const bf16_t* Y = (const bf16_t*)(F.ws + WS_Y);
    const float* gf = inp(F, I_norm_final);
    for (int task = F.bid; task < T / 128; task += F.G) {
#pragma unroll 1
        for (int pr = 0; pr < 8; ++pr) {
            const int tok = task * 128 + F.wave * 16 + pr * 2 + tr;
            float* xr = F.out + (size_t)tok * D + 8 * c; const bf16_t* yr = Y + (size_t)tok * 4 * D + 8 * c;
            f32x4 x0[4], x1[4]; float ssq = 0.f;
#pragma unroll
            for (int i = 0; i < 4; ++i) { x0[i] = *(const f32x4*)(xr + 256 * i); x1[i] = *(const f32x4*)(xr + 256 * i + 4); }
#pragma unroll
            for (int i = 0; i < 4; ++i) {
#pragma unroll
                for (int k = 0; k < 4; ++k) { const u32x4 y = *(const u32x4*)(yr + (size_t)k * D + 256 * i);
                    x0[i][0] += bflo(y.x); x0[i][1] += bfhi(y.x); x0[i][2] += bflo(y.y); x0[i][3] += bfhi(y.y); x1[i][0] += bflo(y.z); x1[i][1] += bfhi(y.z); x1[i][2] += bflo(y.w); x1[i][3] += bfhi(y.w); }
                ssq += (x0[i][0] * x0[i][0] + x0[i][1] * x0[i][1]) + (x0[i][2] * x0[i][2] + x0[i][3] * x0[i][3]) + (x1[i][0] * x1[i][0] + x1[i][1] * x1[i][1]) + (x1[i][2] * x1[i][2] + x1[i][3] * x1[i][3]); }
            ssq += __shfl_xor(ssq, 1); ssq += __shfl_xor(ssq, 2); ssq += __shfl_xor(ssq, 4); ssq += __shfl_xor(ssq, 8); ssq += __shfl_xor(ssq, 16);
            const float rstd = 1.0f / sqrtf(ssq * (1.0f / D) + RMS_EPS);
#pragma unroll
            for (int i = 0; i < 4; ++i) { const f32x4 g0 = *(const f32x4*)(gf + 256 * i + 8 * c), g1 = *(const f32x4*)(gf + 256 * i + 8 * c + 4);
                *(f32x4*)(xr + 256 * i) = x0[i] * rstd * g0; *(f32x4*)(xr + 256 * i + 4) = x1[i] * rstd * g1; }
        }
    }
}
__device__ __forceinline__ void cumsum_step(const Frame& F) {
    LAS float* sc = (LAS float*)(F.lds + LDSCTL_OFF + LC_SCAN);
    const float* LF = (const float*)(F.ws + WS_LOGF); float* c2 = (float*)(F.ws + WS_C2);
    for (int seq = F.bid; seq < 64; seq += F.G) {
        const int b = seq >> 3, h = seq & 7, t0 = F.tid * 8; const float* lf = LF + ((size_t)b * SEQ + t0) * 8 + h;
        float v[8], s = 0.f;
#pragma unroll
        for (int j = 0; j < 8; ++j) { s += lf[j * 8]; v[j] = s; }
        float inc = s;
#pragma unroll
        for (int off = 1; off < 64; off <<= 1) { const float y = __shfl_up(inc, off); if (F.lane >= off) inc += y; }
        if (F.lane == 63) sc[F.wave] = inc;
        __syncthreads();
        float pre = 0.f;
        for (int w = 0; w < F.wave; ++w) pre += sc[w];
        const float base = pre + inc - s;
#pragma unroll
        for (int j = 0; j < 8; ++j) c2[(size_t)seq * SEQ + t0 + j] = (base + v[j]) * LOG2E;
        __syncthreads();
    }
}

__device__ __forceinline__ float max3f(float a, float b, float c) { float r; asm("v_max3_f32 %0, %1, %2, %3" : "=v"(r) : "v"(a), "v"(b), "v"(c)); return r; }
__device__ __forceinline__ float max2f(float a, float b) { float r; asm("v_max_f32_e32 %0, %1, %2" : "=v"(r) : "v"(a), "v"(b)); return r; }
__device__ __forceinline__ int crow(int r, int hi) { return (r & 3) + 8 * (r >> 2) + 4 * hi; }
constexpr int AT_KT = 0, AT_KTB = 8320, AT_VT = 2 * AT_KTB, AT_VTB = 8192, AT_CK = AT_VT + 2 * AT_VTB, AT_WSF = AT_CK + 512, AT_OST = AT_WSF + 2048, AT_END = AT_OST + 65536;
static_assert(AT_END <= PH_BYTES, "attention LDS");
__device__ __forceinline__ void attn_unit(const Frame& F, int l, int b, int h, int qb) {
    const int tid = F.tid, lane = F.lane, r32 = lane & 31, hi = lane >> 5, wid = F.wave;
    const bf16_t* proj = (const bf16_t*)(F.ws + WS_PA); bf16_t* mixed = (bf16_t*)(F.ws + WS_MIXED);
    const int bh = b * 8 + h; const float* c2 = (const float*)(F.ws + WS_C2) + (size_t)bh * SEQ;
    const size_t rowbase = (size_t)b * SEQ; const int q0 = qb * 256;
    LAS unsigned char* L = F.lds;
    LAS float* wsf = (LAS float*)(L + AT_WSF) + wid * 64;
    LAS float* ost = (LAS float*)(L + AT_OST) + wid * 2048;
    LAS unsigned* stopv = (LAS unsigned*)(L + LDSCTL_OFF + LC_STOP);
    const bf16_t* Qw = proj + (rowbase + q0 + wid * 32 + r32) * NPROJ + C_FQ + h * 64;
    bf16x8 qr[4]; float qn = 0.f;
#pragma unroll
    for (int d0 = 0; d0 < 4; ++d0) { const u32x4 w = *(const u32x4*)(Qw + d0 * 16 + hi * 8); qr[d0] = __builtin_bit_cast(bf16x8, w);
        qn += bflo(w.x) * bflo(w.x) + bfhi(w.x) * bfhi(w.x) + bflo(w.y) * bflo(w.y) + bfhi(w.y) * bfhi(w.y) + bflo(w.z) * bflo(w.z) + bfhi(w.z) * bfhi(w.z) + bflo(w.w) * bflo(w.w) + bfhi(w.w) * bfhi(w.w); }
    qn += __shfl_xor(qn, 32); qn = sqrtf(qn) * 1.001f;
    const float kb = sqrtf(2.0f * __uint_as_float(__hip_atomic_load(F.ctl + CW_KMAX + (l * 64 + bh) * 16, __ATOMIC_RELAXED, __HIP_MEMORY_SCOPE_AGENT))) * 1.001f;
    const float c2q = c2[q0 + wid * 32 + r32];
    f32x16 cq16;
#pragma unroll
    for (int r = 0; r < 16; ++r) cq16[r] = c2q;
    float lsum = 0.f; f32x16 o[2];
#pragma unroll
    for (int r = 0; r < 16; ++r) { o[0][r] = 0.f; o[1][r] = 0.f; }
    const int jd = 4 * qb + 3;
    const int lkey = tid >> 3, lpiece = tid & 7;
    const bf16_t* ksrc = proj + (rowbase + lkey) * NPROJ + C_FK + h * 64 + lpiece * 8;
    const bf16_t* vsrc = proj + (rowbase + lkey) * NPROJ + C_FV + h * 64 + lpiece * 8;
    const int kdst = lpiece * 1040 + lkey * 16, vdst = (lpiece >> 2) * 4096 + lkey * 64 + (lpiece & 3) * 16;
    u32x4 kA = *(const u32x4*)(ksrc + (size_t)jd * 64 * NPROJ), vA = *(const u32x4*)(vsrc + (size_t)jd * 64 * NPROJ); float cA = c2[jd * 64 + lane];
    u32x4 kB = kA, vB = vA; float cB = cA;
    if (jd >= 1) { kB = *(const u32x4*)(ksrc + (size_t)(jd - 1) * 64 * NPROJ); vB = *(const u32x4*)(vsrc + (size_t)(jd - 1) * 64 * NPROJ); cB = c2[(jd - 1) * 64 + lane]; }
    const int vrd = (4 * hi + ((lane & 15) >> 2)) * 64 + ((lane >> 4) & 1) * 32 + (lane & 3) * 8;
    const int qrel = wid * 32 + r32;
    int buf = 0; bool done = false, wstop = false, first = true;
    float mhat = 0.f;
#define AT_ITER(j, kR, vR, cR, cNext) do { \
        const float cklast = rdlane(cNext, 63);     \
        *(LAS u32x4*)(L + AT_KT + buf * AT_KTB + kdst) = kR; *(LAS u32x4*)(L + AT_VT + buf * AT_VTB + vdst) = vR; \
        if (tid < 64) ((LAS float*)(L + AT_CK))[buf * 64 + tid] = cR; \
        asm volatile("s_waitcnt lgkmcnt(0)\n\ts_barrier" ::: "memory");     \
        if ((j) < jd) { const u32x4 fa = *(const LAS u32x4*)(stopv + (((j) + 1) & 1) * 8), fb = *(const LAS u32x4*)(stopv + (((j) + 1) & 1) * 8 + 4); \
            if ((fa.x & fa.y & fa.z & fa.w & fb.x & fb.y & fb.z & fb.w) != 0u) { done = true; break; } } \
        if ((j) >= 2) { kR = *(const u32x4*)(ksrc + (size_t)((j) - 2) * 64 * NPROJ); vR = *(const u32x4*)(vsrc + (size_t)((j) - 2) * 64 * NPROJ); cR = c2[((j) - 2) * 64 + lane]; } \
        const int jrel = (j) - 4 * qb; \
        const bool active = !(jrel >= 0 && 64 * jrel > 32 * wid + 31) && !wstop; \
        if (active) { \
            const LAS unsigned char* Kb = L + AT_KT + buf * AT_KTB; const LAS unsigned char* Vb = L + AT_VT + buf * AT_VTB; const LAS float* Ck = (const LAS float*)(L + AT_CK) + buf * 64; \
            const float base = c2q - mhat; \
            f32x16 p0, p1; \
            _Pragma("unroll") for (int g = 0; g < 4; ++g) { const f32x4 ca = *(const LAS f32x4*)(Ck + 8 * g + 4 * hi), cb = *(const LAS f32x4*)(Ck + 32 + 8 * g + 4 * hi); \
                _Pragma("unroll") for (int i = 0; i < 4; ++i) { p0[4 * g + i] = base - ca[i]; p1[4 * g + i] = base - cb[i]; } } \
            bf16x8 kf0[4], kf1[4]; \
            _Pragma("unroll") for (int d0 = 0; d0 < 4; ++d0) { kf0[d0] = *(const LAS bf16x8*)(Kb + (2 * d0 + hi) * 1040 + r32 * 16); kf1[d0] = *(const LAS bf16x8*)(Kb + (2 * d0 + hi) * 1040 + (32 + r32) * 16); } \
            _Pragma("unroll") for (int d0 = 0; d0 < 4; ++d0) { \
                p0 = __builtin_amdgcn_mfma_f32_32x32x16_bf16(kf0[d0], qr[d0], p0, 0, 0, 0); p1 = __builtin_amdgcn_mfma_f32_32x32x16_bf16(kf1[d0], qr[d0], p1, 0, 0, 0); } \
            asm volatile("s_nop 15\n\ts_nop 7" : "+v"(p0), "+v"(p1));     \
            if (jrel >= 0) { const int kbase = 64 * jrel + 4 * hi; \
                _Pragma("unroll") for (int r = 0; r < 16; ++r) { const int kv = kbase + (r & 3) + 8 * (r >> 2); if (kv > qrel) p0[r] = -INFINITY; if (kv + 32 > qrel) p1[r] = -INFINITY; } } \
            float mx = max3f(p0[0], p0[1], p1[0]), mb_ = max3f(p0[2], p0[3], p1[1]); mx = max3f(mx, p1[2], p1[3]); \
            _Pragma("unroll") for (int r = 4; r < 16; r += 4) { mx = max3f(mx, p0[r], p0[r + 1]); mb_ = max3f(mb_, p0[r + 2], p0[r + 3]); mx = max3f(mx, p1[r], p1[r + 1]); mb_ = max3f(mb_, p1[r + 2], p1[r + 3]); } \
            mx = max2f(mx, mb_); \
            { auto rr = __builtin_amdgcn_permlane32_swap(__float_as_uint(mx), __float_as_uint(mx), false, false); mx = max2f(__uint_as_float(rr[0]), __uint_as_float(rr[1])); } \
            if (first || __any(mx > 8.0f)) { \
                const float dl = first ? mx : fmaxf(mx, 0.f); mhat += dl; \
                _Pragma("unroll") for (int r = 0; r < 16; ++r) { p0[r] -= dl; p1[r] -= dl; } \
                const float alpha = __builtin_amdgcn_exp2f(-dl); lsum *= alpha; \
                if (!first) { \
                    if (hi == 0) wsf[r32] = alpha; \
                    LDS_WAIT(); asm volatile("" ::: "memory"); \
                    _Pragma("unroll") for (int r = 0; r < 16; ++r) { const float a = wsf[crow(r, hi)]; o[0][r] *= a; o[1][r] *= a; } } \
                first = false; \
            } \
            _Pragma("unroll") for (int r = 0; r < 16; ++r) { p0[r] = __builtin_amdgcn_exp2f(p0[r]); p1[r] = __builtin_amdgcn_exp2f(p1[r]); } \
            { f32x2 sa = {p0[0] + p1[0], p0[1] + p1[1]}; \
              _Pragma("unroll") for (int r = 2; r < 16; r += 2) { sa += (f32x2){p0[r], p0[r + 1]}; sa += (f32x2){p1[r], p1[r + 1]}; } \
              lsum += sa[0] + sa[1]; } \
            u32x4 pw[4]; \
            pw[0] = (u32x4){cvtpk(p0[0], p0[1]), cvtpk(p0[2], p0[3]), cvtpk(p0[4], p0[5]), cvtpk(p0[6], p0[7])}; \
            pw[1] = (u32x4){cvtpk(p0[8], p0[9]), cvtpk(p0[10], p0[11]), cvtpk(p0[12], p0[13]), cvtpk(p0[14], p0[15])}; \
            pw[2] = (u32x4){cvtpk(p1[0], p1[1]), cvtpk(p1[2], p1[3]), cvtpk(p1[4], p1[5]), cvtpk(p1[6], p1[7])}; \
            pw[3] = (u32x4){cvtpk(p1[8], p1[9]), cvtpk(p1[10], p1[11]), cvtpk(p1[12], p1[13]), cvtpk(p1[14], p1[15])}; \
            _Pragma("unroll") for (int s = 0; s < 4; ++s) \
                _Pragma("unroll") for (int d0 = 0; d0 < 2; ++d0) { \
                    const LAS unsigned char* vp = Vb + d0 * 4096 + s * 1024 + vrd; \
                    const v4i16_t lo = __builtin_amdgcn_ds_read_tr16_b64_v4i16((LAS v4i16_t*)vp), hv = __builtin_amdgcn_ds_read_tr16_b64_v4i16((LAS v4i16_t*)(vp + 512)); \
                    const bf16x8 vf = (bf16x8){lo[0], lo[1], lo[2], lo[3], hv[0], hv[1], hv[2], hv[3]}; \
                    o[d0] = __builtin_amdgcn_mfma_f32_32x32x16_bf16(__builtin_bit_cast(bf16x8, pw[s]), vf, o[d0], 0, 0, 0); } \
        } \
        if ((j) > 0) { if (active) { const float ub = qn * kb + (c2q - cklast); if (__all((ub - mhat) < -152.0f)) wstop = true; } if (lane == 0) stopv[((j) & 1) * 8 + wid] = wstop ? 1u : 0u; } \
        buf ^= 1; \
    } while (0)
    for (int j = jd; j >= 0; j -= 2) {
        AT_ITER(j, kA, vA, cA, cB);
        if (done || j == 0) break;
        AT_ITER(j - 1, kB, vB, cB, cA);
        if (done) break;
    }
#undef AT_ITER
    lsum += __shfl_xor(lsum, 32);
    if (hi == 0) wsf[32 + r32] = 1.0f / lsum;
    LDS_WAIT(); asm volatile("" ::: "memory");
#pragma unroll
    for (int r = 0; r < 16; ++r) { const int q = crow(r, hi); const float inv = wsf[32 + q]; ost[q * 64 + r32] = o[0][r] * inv; ost[q * 64 + 32 + r32] = o[1][r] * inv; }
    LDS_WAIT(); asm volatile("" ::: "memory");
    { const int row = lane >> 1, half = lane & 1; const LAS float* src = ost + row * 64 + half * 32; float v[32]; float ss = 0.f;
#pragma unroll
        for (int i = 0; i < 8; ++i) { const f32x4 t4 = *(const LAS f32x4*)(src + 4 * i); v[4 * i] = t4[0]; v[4 * i + 1] = t4[1]; v[4 * i + 2] = t4[2]; v[4 * i + 3] = t4[3]; ss += (t4[0] * t4[0] + t4[1] * t4[1]) + (t4[2] * t4[2] + t4[3] * t4[3]); }
        ss += __shfl_xor(ss, 1);
        const float rs = 1.0f / sqrtf(ss * (1.0f / 64.0f) + RMS_EPS);
        const float* gn = inp(F, I_fox_gain) + l * 512 + h * 64 + half * 32;
        bf16_t* dst = mixed + (rowbase + q0 + wid * 32 + row) * D + h * 64 + half * 32;
#pragma unroll
        for (int i = 0; i < 4; ++i) { const f32x4 ga = *(const f32x4*)(gn + 8 * i), gb = *(const f32x4*)(gn + 8 * i + 4); u32x4 w;
            w.x = cvtpk(v[8 * i] * rs * ga[0], v[8 * i + 1] * rs * ga[1]); w.y = cvtpk(v[8 * i + 2] * rs * ga[2], v[8 * i + 3] * rs * ga[3]);
            w.z = cvtpk(v[8 * i + 4] * rs * gb[0], v[8 * i + 5] * rs * gb[1]); w.w = cvtpk(v[8 * i + 6] * rs * gb[2], v[8 * i + 7] * rs * gb[3]);
            *(u32x4*)(dst + 8 * i) = w; } }
    __syncthreads();
}

__device__ __forceinline__ float hg_lb(const Frame& F, int l, int col) {
    float x[NL], mx = -INFINITY;
#pragma unroll
    for (int i = 0; i < NL; ++i) { x[i] = inp(F, I_hgrn_lb)[i * 256 + col]; mx = fmaxf(mx, x[i]); }
    float s = 0.f, a = 0.f;
#pragma unroll
    for (int i = 0; i < NL; ++i) { x[i] = expf(x[i] - mx); s += x[i]; }
#pragma unroll
    for (int i = 1; i < NL; ++i) if (i <= l) a += x[i];
    return a / s;
}
constexpr int HG_SEG = 128, HG_NSEG = SEQ / HG_SEG, HG_NPART = 1, HG_WAVES = 4;
constexpr int HGL_ROW = 136, HGL_QT = 0, HGL_KT = 32 * HGL_ROW, HGL_KP = 2 * 32 * HGL_ROW, HGL_V = HGL_KP + 4096, HGL_PE = HGL_V + 4096, HGL_BYTES = HGL_PE + 256;
static_assert(NWAVES * HGL_BYTES <= PH_BYTES, "HGRN2 LDS");
__device__ __forceinline__ void hg_mfma_unit(const Frame& F, int l, int u) {
    const int seg = u % HG_NSEG, bh = u / HG_NSEG, b = bh >> 2, hd = bh & 3, lane = F.lane, r32 = lane & 31, hi = lane >> 5;
    LAS unsigned char* W = F.lds + F.wave * HGL_BYTES;
    const size_t tokS = (size_t)b * SEQ + seg * HG_SEG;
    const bf16_t* proj = (const bf16_t*)(F.ws + WS_PA);
    float* oraw = (float*)(F.ws + WS_ORAW); bf16_t* QE = (bf16_t*)(F.ws + WS_QE);
    const float lbv = hg_lb(F, l, hd * 64 + lane);
    f32x16 Sacc[2][2];
#pragma unroll
    for (int kb = 0; kb < 2; ++kb)
#pragma unroll
        for (int vb = 0; vb < 2; ++vb)
#pragma unroll
            for (int r = 0; r < 16; ++r) Sacc[kb][vb][r] = 0.f;
    float Pseg = 1.0f;
    const int vrd = (4 * hi + ((lane & 15) >> 2)) * 64 + ((lane >> 4) & 1) * 32 + (lane & 3) * 8;
    int tb = 0;
    while (tb < HG_SEG) {
        const int nmax = (HG_SEG - tb) < 32 ? (HG_SEG - tb) : 32;
        const char* pu8 = (const char*)(proj + (tokS + tb) * NPROJ + hd * 64);
        const unsigned lo2 = (unsigned)lane * 2u;
        char* qe8 = (char*)(QE + (tokS + tb) * 256 + hd * 64);
        char* or8 = (char*)(oraw + (tokS + tb) * 256 + hd * 64);
        const unsigned lof = (unsigned)(4 * hi * 256 + r32) * 4u;
        float fv[32], qv[32]; u32x4 vreg[4];
#pragma unroll
        for (int t = 0; t < 32; ++t) { const bool ok = t < nmax; fv[t] = ok ? bf2f(*(const bf16_t*)(pu8 + (size_t)t * (NPROJ * 2) + C_GF * 2 + lo2)) : 0.f; qv[t] = ok ? bf2f(*(const bf16_t*)(pu8 + (size_t)t * (NPROJ * 2) + C_GQ * 2 + lo2)) : 0.f; }
#pragma unroll
        for (int it = 0; it < 4; ++it) { const int c = lane + 64 * it, sr = c >> 3, pc = c & 7;
            vreg[it] = (u32x4){0u, 0u, 0u, 0u}; if (sr < nmax) vreg[it] = *(const u32x4*)(pu8 + (size_t)sr * (NPROJ * 2) + C_GI * 2 + pc * 16); }
        int nl = 32; { float P = 1.0f;
#pragma unroll
            for (int t = 0; t < 32; ++t) { const float sg = __builtin_amdgcn_rcpf(1.0f + __builtin_amdgcn_exp2f(-LOG2E * fv[t])); float f = fmaxf(lbv + (1.0f - lbv) * sg, 1e-30f); if (t >= nmax) f = 1.0f; fv[t] = f; P *= f; if (P < 1e-32f && nl == 32) nl = t; } }
#pragma unroll
        for (int off = 1; off < 64; off <<= 1) { const int o = __shfl_xor(nl, off); nl = o < nl ? o : nl; }
        const int n = __builtin_amdgcn_readfirstlane(nl < nmax ? nl : nmax);
#pragma unroll
        for (int it = 0; it < 4; ++it) { const int c = lane + 64 * it, sr = c >> 3, pc = c & 7;
            *(LAS u32x4*)(W + HGL_V + (pc >> 2) * 2048 + sr * 64 + (pc & 3) * 16) = (sr < n) ? vreg[it] : (u32x4){0u, 0u, 0u, 0u}; }
        float P = 1.0f;
        {
#pragma unroll
          for (int t = 0; t < 32; ++t) { const bool ok = t < n; const float f = fv[t]; if (ok) P *= f;
            const float qt = ok ? qv[t] * P : 0.f, kt = ok ? (1.0f - f) * __builtin_amdgcn_rcpf(P) : 0.f;
            *(LAS bf16_t*)(W + HGL_QT + t * HGL_ROW + lane * 2) = f2bf(qt); *(LAS bf16_t*)(W + HGL_KT + t * HGL_ROW + lane * 2) = f2bf(kt);
            if (ok) *(bf16_t*)(qe8 + (size_t)t * 512 + lo2) = f2bf(qv[t] * (Pseg * P)); } }
        { float suf = 1.0f;
#pragma unroll
          for (int t = 31; t >= 0; --t) { const bool ok = t < n; const float f = fv[t]; const float kp = ok ? (1.0f - f) * suf : 0.f; if (ok) suf *= f;
            *(LAS bf16_t*)(W + HGL_KP + (lane >> 5) * 2048 + t * 64 + (lane & 31) * 2) = f2bf(kp); } }
        ((LAS float*)(W + HGL_PE))[lane] = P;
        Pseg *= P;
        LDS_WAIT(); asm volatile("" ::: "memory");
        f32x16 st;
#pragma unroll
        for (int r = 0; r < 16; ++r) st[r] = 0.f;
#pragma unroll
        for (int d0 = 0; d0 < 4; ++d0) { const bf16x8 ka = *(const LAS bf16x8*)(W + HGL_KT + r32 * HGL_ROW + (16 * d0 + 8 * hi) * 2), qb = *(const LAS bf16x8*)(W + HGL_QT + r32 * HGL_ROW + (16 * d0 + 8 * hi) * 2);
            st = __builtin_amdgcn_mfma_f32_32x32x16_bf16(ka, qb, st, 0, 0, 0); }
#pragma unroll
        for (int r = 0; r < 16; ++r) if (crow(r, hi) > r32) st[r] = 0.f;
        u32x4 pst[2];
        pst[0] = (u32x4){cvtpk(st[0], st[1]), cvtpk(st[2], st[3]), cvtpk(st[4], st[5]), cvtpk(st[6], st[7])};
        pst[1] = (u32x4){cvtpk(st[8], st[9]), cvtpk(st[10], st[11]), cvtpk(st[12], st[13]), cvtpk(st[14], st[15])};
        bf16x8 vf[2][2];
#pragma unroll
        for (int s2 = 0; s2 < 2; ++s2)
#pragma unroll
            for (int vb = 0; vb < 2; ++vb) { const LAS unsigned char* vp = W + HGL_V + vb * 2048 + s2 * 1024 + vrd;
                const v4i16_t lo = __builtin_amdgcn_ds_read_tr16_b64_v4i16((LAS v4i16_t*)vp), hv = __builtin_amdgcn_ds_read_tr16_b64_v4i16((LAS v4i16_t*)(vp + 512));
                vf[s2][vb] = (bf16x8){lo[0], lo[1], lo[2], lo[3], hv[0], hv[1], hv[2], hv[3]}; }
        f32x16 oacc[2];
#pragma unroll
        for (int vb = 0; vb < 2; ++vb) {
#pragma unroll
            for (int r = 0; r < 16; ++r) oacc[vb][r] = 0.f;
#pragma unroll
            for (int s2 = 0; s2 < 2; ++s2) oacc[vb] = __builtin_amdgcn_mfma_f32_32x32x16_bf16(__builtin_bit_cast(bf16x8, pst[s2]), vf[s2][vb], oacc[vb], 0, 0, 0);
        }
#pragma unroll
        for (int kst = 0; kst < 4; ++kst) {
            const u32x2 qa = *(const LAS u32x2*)(W + HGL_QT + r32 * HGL_ROW + (16 * kst + 4 * hi) * 2), qc = *(const LAS u32x2*)(W + HGL_QT + r32 * HGL_ROW + (16 * kst + 8 + 4 * hi) * 2);
            const bf16x8 qf = __builtin_bit_cast(bf16x8, (u32x4){qa.x, qa.y, qc.x, qc.y});
#pragma unroll
            for (int vb = 0; vb < 2; ++vb) { const f32x16& S = Sacc[kst >> 1][vb]; const int o8 = 8 * (kst & 1);
                const u32x4 sp = (u32x4){cvtpk(S[o8 + 0], S[o8 + 1]), cvtpk(S[o8 + 2], S[o8 + 3]), cvtpk(S[o8 + 4], S[o8 + 5]), cvtpk(S[o8 + 6], S[o8 + 7])};
                oacc[vb] = __builtin_amdgcn_mfma_f32_32x32x16_bf16(qf, __builtin_bit_cast(bf16x8, sp), oacc[vb], 0, 0, 0); }
        }
#pragma unroll
        for (int vb = 0; vb < 2; ++vb)
#pragma unroll
            for (int r = 0; r < 16; ++r) { const int t = crow(r, hi); if (t < n) *(float*)(or8 + (size_t)(((r & 3) + 8 * (r >> 2)) * 1024 + vb * 128) + lof) = oacc[vb][r]; }
#pragma unroll
        for (int kb = 0; kb < 2; ++kb) {
            float pe[16];
#pragma unroll
            for (int g = 0; g < 4; ++g) { const f32x4 p4 = *(const LAS f32x4*)(W + HGL_PE + (32 * kb + 8 * g + 4 * hi) * 4); pe[4 * g] = p4[0]; pe[4 * g + 1] = p4[1]; pe[4 * g + 2] = p4[2]; pe[4 * g + 3] = p4[3]; }
            bf16x8 kf[2];
#pragma unroll
            for (int s2 = 0; s2 < 2; ++s2) { const LAS unsigned char* kp = W + HGL_KP + kb * 2048 + s2 * 1024 + vrd;
                const v4i16_t lo = __builtin_amdgcn_ds_read_tr16_b64_v4i16((LAS v4i16_t*)kp), hv = __builtin_amdgcn_ds_read_tr16_b64_v4i16((LAS v4i16_t*)(kp + 512));
                kf[s2] = (bf16x8){lo[0], lo[1], lo[2], lo[3], hv[0], hv[1], hv[2], hv[3]}; }
#pragma unroll
            for (int vb = 0; vb < 2; ++vb) {
#pragma unroll
                for (int r = 0; r < 16; ++r) Sacc[kb][vb][r] *= pe[r];
#pragma unroll
                for (int s2 = 0; s2 < 2; ++s2) Sacc[kb][vb] = __builtin_amdgcn_mfma_f32_32x32x16_bf16(kf[s2], vf[s2][vb], Sacc[kb][vb], 0, 0, 0);
            }
        }
        LDS_WAIT(); asm volatile("" ::: "memory");
        tb += n;
    }
    char* send8 = (char*)((float*)(F.ws + WS_SEND2) + (size_t)(bh * HG_NSEG + seg) * 4096);
    const unsigned lsf = (unsigned)(4 * hi * 64 + r32) * 4u;
#pragma unroll
    for (int kb = 0; kb < 2; ++kb)
#pragma unroll
        for (int vb = 0; vb < 2; ++vb)
#pragma unroll
            for (int r = 0; r < 16; ++r) *(float*)(send8 + (size_t)((32 * kb + (r & 3) + 8 * (r >> 2)) * 256 + vb * 128) + lsf) = Sacc[kb][vb][r];
    ((float*)(F.ws + WS_PSEG))[(bh * HG_NSEG + seg) * 64 + lane] = Pseg;
}
__device__ __forceinline__ void hg_fix_phase(const Frame& F, int l) {
    const int lane = F.lane, r16 = lane & 15, q4 = lane >> 4, tid = F.tid;
    LAS bf16_t* ST = (LAS bf16_t*)(F.lds);
    const float* oraw = (const float*)(F.ws + WS_ORAW); const bf16_t* proj = (const bf16_t*)(F.ws + WS_PA); bf16_t* mixed = (bf16_t*)(F.ws + WS_MIXED);
    const bf16_t* QE = (const bf16_t*)(F.ws + WS_QE); const float* SEND = (const float*)(F.ws + WS_SEND2); const float* PSEG = (const float*)(F.ws + WS_PSEG);
    for (int uu = F.bid; uu < 32 * HG_NSEG * DUP(7); uu += F.G) {
        const int u = uu % (32 * HG_NSEG), seg = u % HG_NSEG, bh = u / HG_NSEG, b = bh >> 2, hd = bh & 3;
        if (seg > 0) {
            const int k = tid >> 3, v8 = (tid & 7) * 8; float S[8];
#pragma unroll
            for (int i = 0; i < 8; ++i) S[i] = 0.f;
#pragma unroll 4
            for (int sp = 0; sp < seg; ++sp) { const float P = PSEG[(bh * HG_NSEG + sp) * 64 + k]; const float* se = SEND + ((size_t)(bh * HG_NSEG + sp) * 64 + k) * 64 + v8;
                const f32x4 a = *(const f32x4*)se, c = *(const f32x4*)(se + 4);
                S[0] = P * S[0] + a[0]; S[1] = P * S[1] + a[1]; S[2] = P * S[2] + a[2]; S[3] = P * S[3] + a[3]; S[4] = P * S[4] + c[0]; S[5] = P * S[5] + c[1]; S[6] = P * S[6] + c[2]; S[7] = P * S[7] + c[3]; }
#pragma unroll
            for (int i = 0; i < 8; ++i) ST[(v8 + i) * 72 + k] = f2bf(S[i]);
        }
        __syncthreads();
        {
            const size_t tok0 = (size_t)b * SEQ + seg * HG_SEG + F.wave * 16;
            f32x4 acc[4];
#pragma unroll
            for (int vb = 0; vb < 4; ++vb) acc[vb] = (f32x4){0.f, 0.f, 0.f, 0.f};
            if (seg > 0) {
#pragma unroll
                for (int kst = 0; kst < 2; ++kst) { const bf16x8 af = __builtin_bit_cast(bf16x8, *(const u32x4*)(QE + (tok0 + r16) * 256 + hd * 64 + 32 * kst + 8 * q4));
#pragma unroll
                    for (int vb = 0; vb < 4; ++vb) { const bf16x8 bfv = *(const LAS bf16x8*)(ST + (vb * 16 + r16) * 72 + 32 * kst + 8 * q4); acc[vb] = __builtin_amdgcn_mfma_f32_16x16x32_bf16(af, bfv, acc[vb], 0, 0, 0); } }
            }
            float ss[4] = {0.f, 0.f, 0.f, 0.f};
#pragma unroll
            for (int vb = 0; vb < 4; ++vb)
#pragma unroll
                for (int r = 0; r < 4; ++r) { const size_t o = (tok0 + 4 * q4 + r) * 256 + hd * 64 + vb * 16 + r16;
                    float x = acc[vb][r];
#pragma unroll
                    for (int k4 = 0; k4 < HG_NPART; ++k4) x += oraw[(size_t)k4 * T * 256 + o];
                    acc[vb][r] = x; ss[r] += x * x; }
#pragma unroll
            for (int r = 0; r < 4; ++r) { float t = ss[r]; t += __shfl_xor(t, 1); t += __shfl_xor(t, 2); t += __shfl_xor(t, 4); t += __shfl_xor(t, 8); ss[r] = 1.0f / sqrtf(t * (1.0f / 64.0f) + RMS_EPS); }
#pragma unroll
            for (int vb = 0; vb < 4; ++vb) { const float gn = inp(F, I_hgrn_gain)[l * 256 + hd * 64 + vb * 16 + r16];
#pragma unroll
                for (int r = 0; r < 4; ++r) { const size_t tok = tok0 + 4 * q4 + r; const float g = bf2f(proj[tok * NPROJ + C_GG + hd * 64 + vb * 16 + r16]);
                    const float si = g * __builtin_amdgcn_rcpf(1.0f + __builtin_amdgcn_exp2f(-LOG2E * g)); mixed[tok * D + 512 + hd * 64 + vb * 16 + r16] = f2bf(acc[vb][r] * ss[r] * gn * si); } }
        }
        __syncthreads();
    }
}
constexpr int PL_ROW = 136, PL_BYTES = 64 * PL_ROW;
static_assert(NWAVES * PL_BYTES <= PH_BYTES, "pool LDS");
template <int W> __device__ __forceinline__ void pool_body(const Frame& F, int l, int b, int g, int seg) {
    const int lane = F.lane, r32 = lane & 31, hi = lane >> 5, t0 = seg * 64;
    LAS unsigned char* PT = F.lds + F.wave * PL_BYTES;
    const char* ub = (const char*)((const bf16_t*)(F.ws + WS_PA) + (size_t)b * SEQ * NPROJ + C_PU + g * 64);
    const unsigned lo2 = (unsigned)lane * 2u;
    float prev[16], cur[16];
#pragma unroll
    for (int i = 0; i < 16; ++i) { const int t = t0 - 16 + i; prev[i] = (t >= 0) ? bf2f(*(const bf16_t*)(ub + (size_t)(t < 0 ? 0 : t) * (NPROJ * 2) + lo2)) : 0.f; }
    float wsum = 0.f;
#pragma unroll
    for (int i = 1; i <= W; ++i) wsum += prev[16 - i];
#pragma unroll
    for (int ci = 0; ci < 4; ++ci) {
#pragma unroll
        for (int i = 0; i < 16; ++i) cur[i] = bf2f(*(const bf16_t*)(ub + (size_t)(t0 + 16 * ci + i) * (NPROJ * 2) + lo2));
#pragma unroll
        for (int i = 0; i < 16; ++i) { const float ut = cur[i]; wsum += ut; wsum -= (i - W >= 0) ? cur[(i - W >= 0) ? i - W : 0] : prev[(i - W >= 0) ? 0 : 16 + i - W];
            const int t = t0 + 16 * ci + i; const float pooled = wsum / (float)((t + 1 < W) ? (t + 1) : W) - ut;
            *(LAS bf16_t*)(PT + (16 * ci + i) * PL_ROW + lane * 2) = f2bf(pooled); }
#pragma unroll
        for (int i = 0; i < 16; ++i) prev[i] = cur[i];
    }
    LDS_WAIT(); asm volatile("" ::: "memory");
    const bf16_t* pwt = (const bf16_t*)(F.ws + WS_PWT) + (size_t)(l * 4 + g) * 4096;
    bf16x8 bw[2][4];
#pragma unroll
    for (int db = 0; db < 2; ++db)
#pragma unroll
        for (int st = 0; st < 4; ++st) bw[db][st] = __builtin_bit_cast(bf16x8, *(const u32x4*)(pwt + (32 * db + r32) * 64 + 16 * st + 8 * hi));
    char* ob = (char*)((bf16_t*)(F.ws + WS_MIXED) + ((size_t)b * SEQ + t0) * D + 768 + g * 64);
    const unsigned lof = (unsigned)(4 * hi * D + r32) * 2u;
#pragma unroll
    for (int tb2 = 0; tb2 < 2; ++tb2)
#pragma unroll
        for (int db = 0; db < 2; ++db) {
            f32x16 acc;
#pragma unroll
            for (int r = 0; r < 16; ++r) acc[r] = 0.f;
#pragma unroll
            for (int st = 0; st < 4; ++st) { const bf16x8 af = *(const LAS bf16x8*)(PT + (32 * tb2 + r32) * PL_ROW + (16 * st + 8 * hi) * 2); acc = __builtin_amdgcn_mfma_f32_32x32x16_bf16(af, bw[db][st], acc, 0, 0, 0); }
            const float psc = inp(F, I_pool_scale)[l * 256 + g * 64 + 32 * db + r32];
#pragma unroll
            for (int r = 0; r < 16; ++r) *(bf16_t*)(ob + (size_t)((32 * tb2 + (r & 3) + 8 * (r >> 2)) * D + 32 * db) * 2 + lof) = f2bf(acc[r] * psc);
        }
    LDS_WAIT(); asm volatile("" ::: "memory");
}
__device__ __forceinline__ void pool_unit(const Frame& F, int l, int u) {
    const int seg = u & 63, g = (u >> 6) & 3, b = u >> 8;
    if (g == 0) pool_body<2>(F, l, b, g, seg); else if (g == 1) pool_body<4>(F, l, b, g, seg); else if (g == 2) pool_body<8>(F, l, b, g, seg); else pool_body<16>(F, l, b, g, seg);
}

struct Args { const float* in[18]; float* out; unsigned char* ws; int ph_lo, ph_hi; };
constexpr int N_PHASES = 2 + 8 * NL;

__global__ void __launch_bounds__(NTHREADS, 2) trunk_fwd(Args args) {
    extern __shared__ __attribute__((aligned(16))) unsigned char lds_raw[];
    Frame F;
    F.lds = (LAS unsigned char*)lds_raw; F.ws = args.ws; F.ctl = (unsigned*)(args.ws + WS_CTL); F.out = args.out;
    F.tid = threadIdx.x; F.lane = F.tid & 63; F.wave = __builtin_amdgcn_readfirstlane(F.tid >> 6);
    for (int u = F.tid; u < (LDS_BYTES - LDSCTL_OFF) / 4; u += NTHREADS) ((LAS unsigned*)(F.lds + LDSCTL_OFF))[u] = 0u;
    __syncthreads();
    if (F.tid == 0) {
#pragma unroll
        for (int i = 0; i < 18; ++i) ((LAS unsigned long long*)(F.lds + LDSCTL_OFF + LC_INP))[i] = (unsigned long long)args.in[i];
    }
    __syncthreads();
    const int lo = args.ph_lo, hi = args.ph_hi; const bool use_bar = (hi - lo) > 1;
    XcdBarrier bar; bar.bar = F.ctl + CW_BAR; bar.x = 0; bar.st = nullptr;
    if (use_bar) bar = xcd_barrier_post(F.ctl + CW_BAR, (volatile LAS unsigned*)(F.lds + LDSCTL_OFF + LC_BAR));
#ifndef PHMASK
#define PHMASK 0xFFFF
#endif
#define PM(b) ((PHMASK >> (b)) & 1)
#define FRESH() do { int l_; asm volatile("v_mbcnt_lo_u32_b32 %0, -1, 0\n\tv_mbcnt_hi_u32_b32 %0, -1, %0" : "=v"(l_));     F.lane = l_; F.tid = F.wave * 64 + l_; int b_ = blockIdx.x, g_ = gridDim.x; asm volatile("" : "+s"(b_), "+s"(g_)); F.bid = b_; F.G = g_; } while (0)
#define IN(k) (lo <= (k) && (k) < hi)
#define SEAM(k) do { if (use_bar && (k) + 1 < hi) { int sl_; asm volatile("v_mbcnt_lo_u32_b32 %0, -1, 0\n\tv_mbcnt_hi_u32_b32 %0, -1, %0" : "=v"(sl_)); xcd_barrier(bar, F.wave == 0 && sl_ == 0); } } while (0)
    if (IN(0) && PM(0)) { for (int rep = 0; rep < DUP(5); ++rep) { FRESH(); p0_prologue(F); } SEAM(0); }
    for (int l = 0; l < NL; ++l) {
        const int pb = 1 + 8 * l;
        if (IN(pb + 0) && PM(1)) { FRESH(); if (l == 0) r_phase<0, false, false>(F, l, inp(F, I_x), F.out); else { if (DUP(6) > 1) r_phase<0, true, false, true>(F, l, F.out, F.out); r_phase<0, true, true>(F, l, F.out, F.out); } SEAM(pb + 0); }
        if (IN(pb + 1) && PM(2)) { FRESH();
            cumsum_step(F);
            pg8::StaticOrder S; S.init(T, NPROJ, D, F.G, F.bid, (const bf16_t*)(F.ws + WS_WIN + l * WIN_BYTES)); S.rep = DUP(2);
            pg8::EpiProj E{(bf16_t*)(F.ws + WS_PA), (const float*)(F.ws + WS_RSTD1), F.ctl + CW_KMAX + l * 64 * 16};
            pg8::gemm_phase<pg8::EpiProj, pg8::StaticOrder, true>(F.tid, F.lds, (const bf16_t*)(F.ws + WS_HB), D, S, E);
            SEAM(pb + 1);
        }
        if (IN(pb + 2) && PM(3)) { FRESH();
            const int gw = F.bid * NWAVES + F.wave, NGW = F.G * NWAVES;
            for (int u = gw; u < 2048; u += NGW) pool_unit(F, l, u);
            __syncthreads();
            if (F.wave < HG_WAVES) for (int u = F.wave * F.G + F.bid; u < 32 * HG_NSEG * DUP(0); u += HG_WAVES * F.G) hg_mfma_unit(F, l, u % (32 * HG_NSEG));
            __syncthreads();
            { LAS int* aq = (LAS int*)(F.lds + LDSCTL_OFF + LC_AQ);
              for (;;) {
                if (F.tid == 0) aq[0] = (int)__hip_atomic_fetch_add(F.ctl + CW_AQ + 16 * l, 1u, __ATOMIC_RELAXED, __HIP_MEMORY_SCOPE_AGENT);
                __syncthreads();
                const int idx = aq[0];
                __syncthreads();
                if (idx >= 1024) break;
                attn_unit(F, l, (idx >> 3) & 7, idx & 7, 15 - (idx >> 6)); } }
            SEAM(pb + 2);
        }
        if (IN(pb + 3) && PM(4)) { FRESH(); hg_fix_phase(F, l); SEAM(pb + 3); }
        if (IN(pb + 4) && PM(5)) { FRESH();
            pg8::StaticOrder S; S.init(T, D, D, F.G, F.bid, (const bf16_t*)(F.ws + WS_WOUT + l * WOUT_BYTES));
            pg8::EpiOut E{l == 0 ? inp(F, I_x) : F.out, F.out};
            pg8::gemm_phase<pg8::EpiOut, pg8::StaticOrder, true>(F.tid, F.lds, (const bf16_t*)(F.ws + WS_MIXED), D, S, E);
            SEAM(pb + 4);
        }
        if (IN(pb + 5) && PM(6)) { FRESH(); if (DUP(6) > 1) r_phase<1, false, false, true>(F, l, F.out, F.out); r_phase<1, false, false>(F, l, F.out, F.out); SEAM(pb + 5); }
        if ((IN(pb + 6) && PM(7)) || (IN(pb + 7) && PM(8))) { FRESH();
            LAS int* tb = (LAS int*)(F.lds + LDSCTL_OFF + LC_TB); LAS int* cn = (LAS int*)(F.lds + LDSCTL_OFF + LC_CN);
            if (F.tid < NE) cn[F.tid] = (int)__hip_atomic_load(F.ctl + CW_CUR + (l * NE + F.tid) * 16, __ATOMIC_RELAXED, __HIP_MEMORY_SCOPE_AGENT);
            __syncthreads();
            if (F.tid == 0) { int a = 0; for (int e = 0; e < NE; ++e) { tb[e] = a; a += (cn[e] + 255) >> 8; } tb[NE] = a; }
            __syncthreads();
            const int ntile = tb[NE];
            if (IN(pb + 6) && PM(7)) {
                typedef pg8::MoeOrder<true, W1E_BYTES, (size_t)256 * D> Ord1; Ord1 S; S.rep = DUP(3); S.nM = ntile; S.nN = 2 * FF / 256; S.nwg = S.nM * S.nN; S.G = F.G; S.c = F.bid; S.Wt = (const char*)(F.ws + WS_W1 + (size_t)l * NE * W1E_BYTES);
                S.tb = tb; S.cn = cn; S.list = (const u32x2*)(F.ws + WS_LIST);
                pg8::EpiGlu E{(unsigned char*)(F.ws + WS_PA), (const u32x2*)(F.ws + WS_LIST), (const float*)(F.ws + WS_B1R) + (size_t)l * NE * 2048};
                pg8::gemm_phase<pg8::EpiGlu, Ord1, true, true>(F.tid, F.lds, F.ws + WS_HB8, D, S, E);
                SEAM(pb + 6);
            }
            if (IN(pb + 7) && PM(8)) { FRESH();
                typedef pg8::MoeOrder<false, W2E_BYTES, (size_t)256 * FF> Ord2; Ord2 S; S.rep = DUP(4); S.nM = ntile; S.nN = D / 256; S.nwg = S.nM * S.nN; S.G = F.G; S.c = F.bid; S.Wt = (const char*)(F.ws + WS_W2 + (size_t)l * NE * W2E_BYTES);
                S.tb = tb; S.cn = cn; S.list = (const u32x2*)(F.ws + WS_LIST);
                pg8::EpiDown E{(bf16_t*)(F.ws + WS_Y), (const u32x2*)(F.ws + WS_LIST), (const float*)(F.ws + WS_GATE), inp(F, I_b2) + (size_t)l * NE * D};
                pg8::gemm_phase<pg8::EpiDown, Ord2, true, true>(F.tid, F.lds, F.ws + WS_PA, FF, S, E);
                SEAM(pb + 7);
            }
        }
    }
    if (IN(N_PHASES - 1) && PM(9)) { FRESH(); r_final(F); }
#undef IN
#undef SEAM
}

extern "C" void kernel_launch(void* const* d_in, const int* in_sizes, int n_in, void* d_out, int out_size, void* d_ws, size_t ws_size, hipStream_t stream) {
    static int grid = 0;
    if (grid == 0) {
        if (n_in != 18 || out_size != T * D || ws_size < WS_END) { fprintf(stderr, "kernel_launch: unexpected shapes (n_in %d out %d ws %zu need %zu)\n", n_in, out_size, ws_size, (size_t)WS_END); grid = -1; return; }
        int dev = 0, cus = 0;
        if (hipGetDevice(&dev) != hipSuccess || hipDeviceGetAttribute(&cus, hipDeviceAttributeMultiprocessorCount, dev) != hipSuccess) { grid = -1; return; }
        if (hipFuncSetAttribute((const void*)trunk_fwd, hipFuncAttributeMaxDynamicSharedMemorySize, LDS_BYTES) != hipSuccess) { fprintf(stderr, "kernel_launch: hipFuncSetAttribute failed\n"); grid = -1; return; }
        int per_cu = 0;
        if (hipOccupancyMaxActiveBlocksPerMultiprocessor(&per_cu, (const void*)trunk_fwd, NTHREADS, LDS_BYTES) != hipSuccess || per_cu < 1) { fprintf(stderr, "kernel_launch: occupancy query says %d\n", per_cu); (void)hipGetLastError(); }
        grid = cus;
    }
    if (grid < 0) return;
    (void)hipMemsetAsync((char*)d_ws + WS_CTL, 0, CTL_ZERO_BYTES, stream);
    Args a{};
    for (int i = 0; i < 18; ++i) a.in[i] = (const float*)d_in[i];
    a.out = (float*)d_out; a.ws = (unsigned char*)d_ws;
#if MK_SPLIT
    for (int p = 0; p < N_PHASES; ++p) { a.ph_lo = p; a.ph_hi = p + 1; hipLaunchKernelGGL(trunk_fwd, dim3(grid), dim3(NTHREADS), LDS_BYTES, stream, a); }
#else
    a.ph_lo = 0; a.ph_hi = N_PHASES; hipLaunchKernelGGL(trunk_fwd, dim3(grid), dim3(NTHREADS), LDS_BYTES, stream, a);
#endif
}
```

```cpp
#include <hip/hip_runtime.h>
#include <cstdio>
#include <cstdint>

#ifndef MK_SPLIT
#define MK_SPLIT 0
#endif

#ifndef DUPMASK
#define DUPMASK 0
#endif
#define DUP(b) (1 + ((DUPMASK >> (b)) & 1))
#define LAS __attribute__((address_space(3)))
#define GAS __attribute__((address_space(1)))
typedef unsigned short bf16_t;
typedef short bf16x8 __attribute__((ext_vector_type(8)));
typedef float f32x4 __attribute__((ext_vector_type(4)));
typedef float f32x2 __attribute__((ext_vector_type(2)));
typedef float f32x16 __attribute__((ext_vector_type(16)));
typedef unsigned u32x4 __attribute__((ext_vector_type(4)));
typedef unsigned u32x2 __attribute__((ext_vector_type(2)));
typedef __bf16 bf16x2_t __attribute__((ext_vector_type(2)));
typedef short v4i16_t __attribute__((ext_vector_type(4)));
typedef int v8i __attribute__((ext_vector_type(8)));
struct bf16x8_pair { bf16x8 a, b; };

constexpr int NB = 8, SEQ = 4096, T = NB * SEQ, D = 1024, NL = 4;
constexpr int NPROJ = 2816;
constexpr int C_FQ = 0, C_FK = 512, C_FV = 1024, C_GQ = 1536, C_GF = 1792, C_GI = 2048, C_GG = 2304, C_PU = 2560;
constexpr int IN_COLS = 2824;
constexpr int NE = 32, TOPK = 4, FF = 1024, MROWS = T * TOPK, LISTCAP = MROWS, MAXTILES = MROWS / 256 + NE;
constexpr float RMS_EPS = 1e-5f, LOG2E = 1.4426950408889634f;
constexpr float QSCALE = 0.125f * LOG2E;
constexpr int NWAVES = 8, NTHREADS = 512;

constexpr size_t MiB = 1u << 20;
constexpr size_t WS_CTL = 0, CTL_ZERO_BYTES = 1 * MiB;
constexpr size_t WS_RSTD1 = 1 * MiB, WS_RSTD2 = WS_RSTD1 + 128 * 1024;
constexpr size_t WS_LOGF = 2 * MiB, WS_C2 = 3 * MiB, WS_GATE = 4 * MiB, WS_B1R = 5 * MiB, WS_WFRAG = 6 * MiB, WS_LIST = 8 * MiB;
constexpr size_t WS_WIN = 40 * MiB, WIN_BYTES = (size_t)NPROJ * D * 2;
constexpr size_t WS_WOUT = 62 * MiB, WOUT_BYTES = (size_t)D * D * 2;
constexpr size_t WS_W1 = 70 * MiB, W1E_BYTES = (size_t)2 * FF * D;
constexpr size_t WS_W2 = 582 * MiB, W2E_BYTES = (size_t)D * FF;
constexpr size_t WS_HB8 = 400 * MiB;
constexpr float W1_SCALE = 64.f, W2_SCALE = 128.f, ACT_SCALE = 4.f, Y_SCALE = 16.f;
constexpr size_t WS_HB = 838 * MiB;
constexpr size_t WS_PA = 902 * MiB;
constexpr size_t WS_MIXED = WS_PA + 176 * MiB;
constexpr size_t WS_Y = 1174 * MiB;
constexpr size_t WS_ORAW = 1430 * MiB;
constexpr size_t WS_SEND = 1558 * MiB;
constexpr size_t WS_PSEG = 1566 * MiB;
constexpr size_t WS_QE = 1567 * MiB;
constexpr size_t WS_PWT = 1583 * MiB;
constexpr size_t WS_SEND2 = 1584 * MiB;
constexpr size_t WS_END = 1600 * MiB;
static_assert(WS_WIN + NL * WIN_BYTES <= WS_WOUT && WS_WOUT + NL * WOUT_BYTES <= WS_W1 && WS_W1 + (size_t)NL * NE * W1E_BYTES <= WS_W2 && WS_W2 + (size_t)NL * NE * W2E_BYTES <= WS_HB, "ws map");
static_assert((size_t)MAXTILES * 256 * FF * 2 <= 272 * MiB && (size_t)T * NPROJ * 2 <= 176 * MiB, "ws map 2");
constexpr int CW_TMO = 0, CW_BAR = 4096, CW_CUR = 16384, CW_KMAX = 32768, CW_AQ = 40960;
constexpr int PH_BYTES = 139264, LDSCTL_OFF = PH_BYTES, LDS_BYTES = PH_BYTES + 2048;
static_assert(PH_BYTES >= 131072 + 512 * 16, "GEMM phase: stage buffers + parked A offsets");
constexpr int LC_BAR = 0, LC_TB = 64, LC_CN = 256, LC_R2CNT = 512, LC_R2BASE = 640, LC_STOP = 768, LC_SCAN = 896, LC_INP = 1024, LC_AQ = 1280;

__device__ __forceinline__ unsigned cvtpk(float lo, float hi) { f32x2 v = {lo, hi}; bf16x2_t b = __builtin_convertvector(v, bf16x2_t); return __builtin_bit_cast(unsigned, b); }
__device__ __forceinline__ float bflo(unsigned w) { return __uint_as_float(w << 16); }
__device__ __forceinline__ float bfhi(unsigned w) { return __uint_as_float(w & 0xffff0000u); }
__device__ __forceinline__ float bf2f(bf16_t h) { return __uint_as_float((unsigned)h << 16); }
__device__ __forceinline__ bf16_t f2bf(float f) { return (bf16_t)(cvtpk(f, 0.f) & 0xffffu); }
__device__ __forceinline__ float rdlane(float v, int l) { return __uint_as_float((unsigned)__builtin_amdgcn_readlane((int)__float_as_uint(v), l)); }
__device__ __forceinline__ unsigned pk4_fp8(float a, float b, float c, float d) { int w = __builtin_amdgcn_cvt_pk_fp8_f32(a, b, 0, false); w = __builtin_amdgcn_cvt_pk_fp8_f32(c, d, w, true); return (unsigned)w; }
__device__ __forceinline__ unsigned pk4_fp8_sat(float a, float b, float c, float d) {
    return pk4_fp8(__builtin_amdgcn_fmed3f(a, -448.f, 448.f), __builtin_amdgcn_fmed3f(b, -448.f, 448.f), __builtin_amdgcn_fmed3f(c, -448.f, 448.f), __builtin_amdgcn_fmed3f(d, -448.f, 448.f)); }
__device__ __forceinline__ f32x4 un4_fp8(unsigned w) { const f32x2 a = __builtin_amdgcn_cvt_pk_f32_fp8((int)w, false), b = __builtin_amdgcn_cvt_pk_f32_fp8((int)w, true); return (f32x4){a.x, a.y, b.x, b.y}; }
#define LDS_WAIT() asm volatile("s_waitcnt lgkmcnt(0)" ::: "memory")
#define VM_WAIT() asm volatile("s_waitcnt vmcnt(0)" ::: "memory")

namespace pg8 {
constexpr int BM = 256, BK = 64, HALF = 128, HTB = HALF * BK * 2, STAGE_BYTES = 8 * HTB, NXCD = 8, WGM = 8;
__host__ __device__ __forceinline__ int lds_byte(int r, int c) { const int st = (r >> 4) * 2 + (c >> 5), rr = r & 15, cc = c & 31, ob = rr * 64 + cc * 2; return st * 1024 + (ob ^ (((ob >> 9) & 1) << 5)); }
__host__ __device__ __forceinline__ void stage_rc(int b, int& R, int& C) { const int st = b / 1024, sb = b % 1024, swz = sb ^ (((sb >> 9) & 1) << 5); R = (st >> 1) * 16 + swz / 64; C = (st & 1) * 32 + (swz % 64) / 2; }
__host__ __device__ __forceinline__ int perm32(int rho) { const int n = rho >> 4, i = rho & 15; return 8 * (i >> 2) + 4 * n + (i & 3); }

struct Unit { int pm, pn, e, lt, cnt; };

__device__ __forceinline__ void tile_of(int L, int nM, int nN, int& pm, int& pn) {
    const int nwg = nM * nN; int wgid = L;
    { const int q = nwg / NXCD, r = nwg % NXCD, xcd = wgid % NXCD, off = wgid / NXCD; wgid = (xcd < r ? xcd * (q + 1) : r * (q + 1) + (xcd - r) * q) + off; }
    const int nig = WGM * nN, gid = wgid / nig, fm = gid * WGM, gsz = (nM - fm) < WGM ? (nM - fm) : WGM;
    pm = fm + ((wgid % nig) % gsz); pn = (wgid % nig) / gsz;
}
struct StaticOrder {
    int nM, nN, nwg, G, c, rep = 1; const char* Bt; size_t tstep;
    __device__ void init(int M, int N, int K, int G_, int c_, const bf16_t* Bt_) { nM = M / BM; nN = N / BM; nwg = nM * nN; G = G_; c = c_; Bt = (const char*)Bt_; tstep = (size_t)BM * K * 2; }
    __device__ __forceinline__ bool next(int i, Unit& u) const { long L = (long)i * G + c; if (L >= (long)nwg * rep) return false; L %= nwg; tile_of((int)L, nM, nN, u.pm, u.pn); u.e = 0; u.lt = 0; u.cnt = 0; return true; }
    __device__ __forceinline__ const char* bbase(const Unit& u) const { return Bt + (size_t)u.pn * tstep; }
    __device__ __forceinline__ int arow(const Unit& u, int r) const { return u.pm * BM + r; }
};
template <bool GATHER, size_t ESTRIDE, size_t TSTEP> struct MoeOrder {
    static constexpr size_t estride = ESTRIDE, tstep = TSTEP;
    int nM, nN, nwg, G, c, rep = 1; const char* Wt; LAS const int* tb; LAS const int* cn; const u32x2* list;
    __device__ __forceinline__ bool next(int i, Unit& u) const {
        long L = (long)i * G + c; if (L >= (long)nwg * rep) return false; L %= nwg; tile_of((int)L, nM, nN, u.pm, u.pn);
        int e = 0; while (e < NE - 1 && __builtin_amdgcn_readfirstlane(tb[e + 1]) <= u.pm) ++e;
        u.e = e; u.lt = u.pm - __builtin_amdgcn_readfirstlane(tb[e]); u.cnt = __builtin_amdgcn_readfirstlane(cn[e]); return true; }
    __device__ __forceinline__ const char* bbase(const Unit& u) const { return Wt + (size_t)u.e * estride + (size_t)u.pn * tstep; }
    __device__ __forceinline__ int arow(const Unit& u, int r) const {
        if (!GATHER) return u.pm * BM + r;
        const int pos = u.lt * BM + r; const char* lb = (const char*)(list + (size_t)u.e * LISTCAP);
        return pos < u.cnt ? (int)(*(const unsigned*)(lb + (unsigned)pos * 8u) >> 2) : 0; }
};

template <class Epi, class Sched, bool ALIGN_EPI, bool FP8 = false>
__device__ __forceinline__ void gemm_phase(const int tid, LAS unsigned char* lds, const void* Abase, const int  , const Sched& S, const Epi& E) {
    constexpr int K = 1024;
    const int wid = __builtin_amdgcn_readfirstlane(tid >> 6), lane = tid & 63, wr = wid >> 2, wc = wid & 3, fr = lane & 15, fq = lane >> 4;
    constexpr int rowB = FP8 ? K : 2 * K;
    constexpr int nt = rowB / (BK * 2);
    unsigned voffB[2];
#pragma unroll
    for (int i = 0; i < 2; ++i) { int R, C; stage_rc(tid * 16 + i * 8192, R, C); const int Rb = Epi::PERM ? ((R & ~31) + perm32(R & 31)) : R; voffB[i] = (unsigned)(Rb * rowB + C * 2); }
    constexpr size_t kstep = (size_t)(BK * 2);
    constexpr size_t hstep = (size_t)HALF * rowB;
    const unsigned ldsw = (unsigned)wid * 1024u;
    const int a8off = (fq >> 1) * 1024 + ((fr * 64 + 32 * (fq & 1)) ^ (((fr >> 3) & 1) << 5));
    const int aoff = FP8 ? (wr * 8192 + a8off) : lds_byte(wr * 64 + fr, fq * 8), boff = FP8 ? (wc * 4096 + a8off) : lds_byte(wc * 32 + fr, fq * 8);
    const char* A8 = (const char*)Abase;
#define PG8_SA(b, h) (((b) * 2 + (h)) * HTB)
#define PG8_SB(b, h) ((4 + (b) * 2 + (h)) * HTB)
#define PG8_STGB(bufoff, gbase) do { _Pragma("unroll") for (int _i = 0; _i < 2; ++_i) \
        __builtin_amdgcn_global_load_lds((const unsigned*)((const char*)(gbase) + voffB[_i]), (LAS unsigned*)(lds + (bufoff) + ldsw + _i * 8192), 16, 0, 0); } while (0)
#define PG8_STGA(bufoff, kb, o0, o1) do { \
        __builtin_amdgcn_global_load_lds((const unsigned*)(A8 + (size_t)(kb) + (o0)), (LAS unsigned*)(lds + (bufoff) + ldsw), 16, 0, 0); \
        __builtin_amdgcn_global_load_lds((const unsigned*)(A8 + (size_t)(kb) + (o1)), (LAS unsigned*)(lds + (bufoff) + ldsw + 8192), 16, 0, 0); } while (0)
#define PG8_LD8(off) __builtin_bit_cast(v8i, bf16x8_pair{*(const LAS bf16x8*)(lds + (off)), *(const LAS bf16x8*)(lds + (off) + 16)})
#define PG8_LDA(dst, b, h) do { if constexpr (FP8) { _Pragma("unroll") for (int m = 0; m < 4; ++m) dst##8[m] = PG8_LD8(PG8_SA(b, h) + aoff + m * 2048); } \
        else { _Pragma("unroll") for (int m = 0; m < 4; ++m) _Pragma("unroll") for (int k = 0; k < 2; ++k) dst[m][k] = *(const LAS bf16x8*)(lds + PG8_SA(b, h) + aoff + m * 2048 + k * 1024); } } while (0)
#define PG8_LDB(dst, b, h) do { if constexpr (FP8) { _Pragma("unroll") for (int n = 0; n < 2; ++n) dst##8[n] = PG8_LD8(PG8_SB(b, h) + boff + n * 2048); } \
        else { _Pragma("unroll") for (int n = 0; n < 2; ++n) _Pragma("unroll") for (int k = 0; k < 2; ++k) dst[n][k] = *(const LAS bf16x8*)(lds + PG8_SB(b, h) + boff + n * 2048 + k * 1024); } } while (0)
#define PG8_MMA(ai, bj, At, Bt) do { __builtin_amdgcn_s_setprio(1); _Pragma("unroll") for (int m = 0; m < 4; ++m) _Pragma("unroll") for (int n = 0; n < 2; ++n) { \
        if constexpr (FP8) asm volatile("v_mfma_f32_16x16x128_f8f6f4 %0, %1, %2, %0" : "+v"(acc[ai][bj][m][n]) : "v"(Bt##8[n]), "v"(At##8[m]));     \
        else { _Pragma("unroll") for (int k = 0; k < 2; ++k) acc[ai][bj][m][n] = __builtin_amdgcn_mfma_f32_16x16x32_bf16(Bt[n][k], At[m][k], acc[ai][bj][m][n], 0, 0, 0); } } __builtin_amdgcn_s_setprio(0); } while (0)
#define PG8_WAIT_V(n) asm volatile("s_waitcnt vmcnt(" #n ")" ::: "memory")
#define PG8_WAIT_L(n) asm volatile("s_waitcnt lgkmcnt(" #n ")" ::: "memory")
#define PG8_BAR __builtin_amdgcn_s_barrier()
#define PG8_SCHED __builtin_amdgcn_sched_barrier(0)
#define PG8_AOFF(u, dst) do { int t_ = tid; asm volatile("" : "+v"(t_));     \
        _Pragma("unroll") for (int _h = 0; _h < 2; ++_h) _Pragma("unroll") for (int _i = 0; _i < 2; ++_i) \
        { int R_, C_; stage_rc(t_ * 16 + _i * 8192, R_, C_); dst[_h][_i] = (unsigned)((size_t)S.arow(u, _h * HALF + R_) * (size_t)rowB + (size_t)(C_ * 2)); } } while (0)
    Unit cur, nxt; int ui = 0;
    if (!S.next(0, cur)) return;
    f32x4 acc[2][2][4][2];
#pragma unroll
    for (int a = 0; a < 2; ++a)
#pragma unroll
        for (int b = 0; b < 2; ++b)
#pragma unroll
            for (int m = 0; m < 4; ++m)
#pragma unroll
                for (int n = 0; n < 2; ++n) acc[a][b][m][n] = (f32x4){0.f, 0.f, 0.f, 0.f};
    bf16x8 At[4][2], B0[2][2], B1[2][2]; v8i At8[4], B08[2], B18[2];
    unsigned aoC[2][2], aoN[2][2];
    PG8_AOFF(cur, aoC);
    const char* cB = S.bbase(cur);
    PG8_STGB(PG8_SB(0, 0), cB); PG8_STGB(PG8_SB(0, 1), cB + hstep); PG8_STGA(PG8_SA(0, 0), 0, aoC[0][0], aoC[0][1]); PG8_STGA(PG8_SA(0, 1), 0, aoC[1][0], aoC[1][1]);
    if (wr == 1) PG8_BAR;
    PG8_WAIT_V(2); PG8_BAR;
    PG8_STGB(PG8_SB(1, 0), cB + kstep); PG8_STGA(PG8_SA(1, 0), kstep, aoC[0][0], aoC[0][1]); PG8_STGB(PG8_SB(1, 1), cB + hstep + kstep);
    PG8_WAIT_V(6); PG8_BAR;
    for (;;) {
        const bool has_next = S.next(ui + 1, nxt);
        if (has_next) { PG8_AOFF(nxt, aoN); } else { aoN[0][0] = aoC[0][0]; aoN[0][1] = aoC[0][1]; aoN[1][0] = aoC[1][0]; aoN[1][1] = aoC[1][1]; }
        *(LAS u32x4*)(lds + STAGE_BYTES + tid * 16) = (u32x4){aoN[0][0], aoN[0][1], aoN[1][0], aoN[1][1]};
        const char* nB = has_next ? S.bbase(nxt) : cB;
        for (int t = 0; t < nt; t += 2) {
            asm volatile("" : "+v"(voffB[0]), "+v"(voffB[1]));
            const bool last = (t == nt - 2);
            const size_t k1 = (size_t)(t + 1) * kstep, k2 = last ? 0 : (size_t)(t + 2) * kstep, k3 = k2 + kstep;
            const char* b2 = last ? nB : cB + (size_t)(t + 2) * kstep; const char* b3 = b2 + kstep;
            PG8_LDB(B0, 0, 0); PG8_LDB(B1, 0, 1); PG8_SCHED; PG8_LDA(At, 0, 0); PG8_STGA(PG8_SA(1, 1), k1, aoC[1][0], aoC[1][1]);
            PG8_WAIT_V(8); PG8_WAIT_L(0); PG8_BAR; PG8_MMA(0, 0, At, B0); PG8_MMA(0, 1, At, B1); PG8_BAR; PG8_SCHED;
            if (last) { const u32x4 nx = *(const LAS u32x4*)(lds + STAGE_BYTES + tid * 16); aoC[0][0] = nx.x; aoC[0][1] = nx.y; aoC[1][0] = nx.z; aoC[1][1] = nx.w; }
            PG8_LDA(At, 0, 1); PG8_STGB(PG8_SB(0, 0), b2); PG8_STGB(PG8_SB(0, 1), b2 + hstep); PG8_STGA(PG8_SA(0, 0), k2, aoC[0][0], aoC[0][1]);
            PG8_WAIT_V(8); PG8_WAIT_L(0); PG8_BAR; PG8_MMA(1, 0, At, B0); PG8_MMA(1, 1, At, B1); PG8_BAR; PG8_SCHED;
            PG8_LDB(B0, 1, 0); PG8_LDB(B1, 1, 1); PG8_SCHED; PG8_LDA(At, 1, 0); PG8_STGA(PG8_SA(0, 1), k2, aoC[1][0], aoC[1][1]);
            PG8_WAIT_V(8); PG8_WAIT_L(0); PG8_BAR; PG8_MMA(0, 0, At, B0); PG8_MMA(0, 1, At, B1); PG8_BAR; PG8_SCHED;
            PG8_LDA(At, 1, 1); PG8_STGB(PG8_SB(1, 0), b3); PG8_STGB(PG8_SB(1, 1), b3 + hstep); PG8_STGA(PG8_SA(1, 0), k3, aoC[0][0], aoC[0][1]);
            PG8_WAIT_V(8); PG8_WAIT_L(0); PG8_BAR; PG8_MMA(1, 0, At, B0); PG8_MMA(1, 1, At, B1); PG8_BAR; PG8_SCHED;
        }
        if constexpr (FP8) asm volatile("s_nop 15\n\ts_nop 15" ::: "memory");
        if constexpr (ALIGN_EPI) { if (wr == 0) PG8_BAR; }
        { int t2_ = tid; asm volatile("" : "+v"(t2_)); const int l2_ = t2_ & 63; E(acc, cur, wr, wc, l2_ & 15, l2_ >> 4); }
        if (!has_next) break;
#pragma unroll
        for (int a = 0; a < 2; ++a)
#pragma unroll
            for (int b = 0; b < 2; ++b)
#pragma unroll
                for (int m = 0; m < 4; ++m)
#pragma unroll
                    for (int n = 0; n < 2; ++n) acc[a][b][m][n] = (f32x4){0.f, 0.f, 0.f, 0.f};
        cur = nxt; cB = nB; ++ui;
        if constexpr (ALIGN_EPI) { if (wr == 1) PG8_BAR; }
    }
    PG8_WAIT_V(0);
    if constexpr (!ALIGN_EPI) { if (wr == 0) PG8_BAR; }
    PG8_BAR;
#undef PG8_SA
#undef PG8_SB
#undef PG8_STGA
#undef PG8_STGB
#undef PG8_LDA
#undef PG8_LD8
#undef PG8_LDB
#undef PG8_MMA
#undef PG8_WAIT_V
#undef PG8_WAIT_L
#undef PG8_BAR
#undef PG8_SCHED
#undef PG8_AOFF
}

struct EpiProj {
    static constexpr bool PERM = true;
    bf16_t* O; const float* rstd; unsigned* kmax;
    __device__ __forceinline__ void operator()(const f32x4 (&acc)[2][2][4][2], const Unit& u, int wr, int wc, int fr, int fq) const {
        const int row0 = u.pm * BM + wr * 64 + fr, col0 = u.pn * BM + wc * 32 + 8 * fq;
        const float sc = (u.pn < 2) ? QSCALE : 1.f; const bool isk = (u.pn == 2 || u.pn == 3);
        float km[2] = {0.f, 0.f};
#pragma unroll
        for (int ai = 0; ai < 2; ++ai)
#pragma unroll
            for (int m = 0; m < 4; ++m) { const int row = row0 + ai * HALF + m * 16; const float rs = rstd[row] * sc; bf16_t* rowp = O + (size_t)row * NPROJ + col0;
#pragma unroll
                for (int bj = 0; bj < 2; ++bj) { const f32x4 v0 = acc[ai][bj][m][0] * rs, v1 = acc[ai][bj][m][1] * rs;
                    u32x4 w; w.x = cvtpk(v0[0], v0[1]); w.y = cvtpk(v0[2], v0[3]); w.z = cvtpk(v1[0], v1[1]); w.w = cvtpk(v1[2], v1[3]);
                    *(u32x4*)(rowp + bj * HALF) = w;
                    if (isk) { float s = bflo(w.x) * bflo(w.x) + bfhi(w.x) * bfhi(w.x) + bflo(w.y) * bflo(w.y) + bfhi(w.y) * bfhi(w.y) + bflo(w.z) * bflo(w.z) + bfhi(w.z) * bfhi(w.z) + bflo(w.w) * bflo(w.w) + bfhi(w.w) * bfhi(w.w);
                        s += __shfl_xor(s, 16); s += __shfl_xor(s, 32); km[bj] = fmaxf(km[bj], s); } } }
        if (isk) {
#pragma unroll
            for (int bj = 0; bj < 2; ++bj) { float v = km[bj]; v = fmaxf(v, __shfl_xor(v, 1)); v = fmaxf(v, __shfl_xor(v, 2)); v = fmaxf(v, __shfl_xor(v, 4)); v = fmaxf(v, __shfl_xor(v, 8));
                if ((threadIdx.x & 63) == 0) { const int b = u.pm >> 4, h = (u.pn - 2) * 4 + bj * 2 + (wc >> 1); atomicMax(kmax + (b * 8 + h) * 16, __float_as_uint(v)); } }
        }
    }
};
struct EpiOut {
    static constexpr bool PERM = false;
    const float* res; float* out;
    __device__ __forceinline__ void operator()(const f32x4 (&acc)[2][2][4][2], const Unit& u, int wr, int wc, int fr, int fq) const {
        const int row0 = u.pm * BM + wr * 64 + fr, col0 = u.pn * BM + wc * 32 + 4 * fq;
#pragma unroll
        for (int ai = 0; ai < 2; ++ai)
#pragma unroll
            for (int m = 0; m < 4; ++m) { const size_t off = (size_t)(row0 + ai * HALF + m * 16) * D + col0;
#pragma unroll
                for (int bj = 0; bj < 2; ++bj)
#pragma unroll
                    for (int n = 0; n < 2; ++n) { const f32x4 r = *(const f32x4*)(res + off + bj * HALF + n * 16); *(f32x4*)(out + off + bj * HALF + n * 16) = r + acc[ai][bj][m][n]; } }
    }
};
struct EpiGlu {
    static constexpr bool PERM = true;
    unsigned char* act; const u32x2* list; const float* b1r;
    __device__ __forceinline__ void operator()(const f32x4 (&acc)[2][2][4][2], const Unit& u, int wr, int wc, int fr, int fq) const {
        const int cb = u.pn * BM + wc * 32 + 8 * fq; const float* bp = b1r + (size_t)u.e * 2048 + cb; const char* lbase = (const char*)(list + (size_t)u.e * LISTCAP);
#pragma unroll
        for (int ai = 0; ai < 2; ++ai)
#pragma unroll
            for (int m = 0; m < 4; ++m) { const int r = ai * HALF + wr * 64 + m * 16 + fr, pos = u.lt * BM + r;
                float rs = 0.f; if (pos < u.cnt) rs = __uint_as_float(*(const unsigned*)(lbase + (unsigned)pos * 8u + 4u)) * (1.0f / W1_SCALE);
                const f32x4 bg0 = *(const f32x4*)(bp), bg1 = *(const f32x4*)(bp + 4), bl0 = *(const f32x4*)(bp + HALF), bl1 = *(const f32x4*)(bp + HALF + 4);
                float o[8];
                const f32x2 rs2 = {rs, rs};
#pragma unroll
                for (int p = 0; p < 4; ++p) {
                    const f32x4& ag = acc[ai][0][m][p >> 1]; const f32x4& al = acc[ai][1][m][p >> 1]; const f32x4& bgv = (p >> 1) ? bg1 : bg0; const f32x4& blv = (p >> 1) ? bl1 : bl0; const int q = 2 * (p & 1);
                    f32x2 g = (f32x2){ag[q], ag[q + 1]} * rs2 + (f32x2){bgv[q], bgv[q + 1]}, li = (f32x2){al[q], al[q + 1]} * rs2 + (f32x2){blv[q], blv[q + 1]};
                    g.x = __builtin_fminf(g.x, 7.f); g.y = __builtin_fminf(g.y, 7.f); li.x = __builtin_amdgcn_fmed3f(li.x, -7.f, 7.f); li.y = __builtin_amdgcn_fmed3f(li.y, -7.f, 7.f);
                    const f32x2 ea = g * (-1.702f * LOG2E); f32x2 d; d.x = __builtin_amdgcn_exp2f(ea.x); d.y = __builtin_amdgcn_exp2f(ea.y); d = d + 1.0f;
                    f32x2 rc; rc.x = __builtin_amdgcn_rcpf(d.x); rc.y = __builtin_amdgcn_rcpf(d.y);
                    const f32x2 tt = li * ACT_SCALE + ACT_SCALE, oo = (g * tt) * rc;
                    o[2 * p] = oo.x; o[2 * p + 1] = oo.y; }
                *(u32x2*)(act + (size_t)(u.pm * BM + r) * FF + u.pn * HALF + wc * 32 + 8 * fq) = (u32x2){pk4_fp8(o[0], o[1], o[2], o[3]), pk4_fp8(o[4], o[5], o[6], o[7])}; }
    }
};
struct EpiDown {
    static constexpr bool PERM = true;
    unsigned char* Y; const u32x2* list; const float* gate; const float* b2;
    __device__ __forceinline__ void operator()(const f32x4 (&acc)[2][2][4][2], const Unit& u, int wr, int wc, int fr, int fq) const {
        const int cb = u.pn * BM + wc * 32 + 8 * fq; const float* bp = b2 + (size_t)u.e * D + cb;
        f32x4 bv[2][2];
#pragma unroll
        for (int bj = 0; bj < 2; ++bj)
#pragma unroll
            for (int n = 0; n < 2; ++n) bv[bj][n] = *(const f32x4*)(bp + bj * HALF + 4 * n);
#pragma unroll
        for (int ai = 0; ai < 2; ++ai)
#pragma unroll
            for (int m = 0; m < 4; ++m) { const int r = ai * HALF + wr * 64 + m * 16 + fr, pos = u.lt * BM + r;
                if (pos < u.cnt) { const unsigned ent = list[(size_t)u.e * LISTCAP + pos].x; const float gt = gate[ent] * Y_SCALE; unsigned char* rowp = Y + (size_t)ent * D + cb;
#pragma unroll
                    for (int bj = 0; bj < 2; ++bj) { const f32x4 v0 = (acc[ai][bj][m][0] * (1.0f / (W2_SCALE * ACT_SCALE)) + bv[bj][0]) * gt, v1 = (acc[ai][bj][m][1] * (1.0f / (W2_SCALE * ACT_SCALE)) + bv[bj][1]) * gt;
                        *(u32x2*)(rowp + bj * HALF) = (u32x2){pk4_fp8_sat(v0[0], v0[1], v0[2], v0[3]), pk4_fp8_sat(v1[0], v1[1], v1[2], v1[3])}; } } }
    }
};
}

#define XB_TMO      128
#define XB_XCNT(j)  (256  + 64 * (j))
#define XB_XSUB(j)  (1280 + 64 * (j))
#define XB_XGEN(j)  (2304 + 64 * (j))
#define XB_TOP      3328
#define XB_TOPGEN   3392
#define XCD_BAR_WORDS 3456
#define XB_SPIN_CAP (1u << 18)
__device__ __forceinline__ unsigned xb_ld(unsigned* p)              { return __hip_atomic_load(p, __ATOMIC_RELAXED, __HIP_MEMORY_SCOPE_AGENT); }
__device__ __forceinline__ unsigned xb_add(unsigned* p, unsigned v) { return __hip_atomic_fetch_add(p, v, __ATOMIC_RELAXED, __HIP_MEMORY_SCOPE_AGENT); }
__device__ __forceinline__ unsigned xb_xcc_id() { return (unsigned)__builtin_amdgcn_s_getreg((3 << 11) | 20) & 0xFu; }
#define XB_SPIN(cond, bar) do { unsigned _sp = 0; while (cond) { __builtin_amdgcn_s_sleep(1); \
    if ((++_sp & 255u) == 0u) { if (xb_ld(&(bar)[XB_TMO])) break; if (_sp > XB_SPIN_CAP) { atomicAdd(&(bar)[XB_TMO], 1u); break; } } } } while (0)
struct XcdBarrier { unsigned* bar; unsigned x; volatile LAS unsigned* st; };
__device__ __forceinline__ XcdBarrier xcd_barrier_post(unsigned* bar, volatile LAS unsigned* st) {
    XcdBarrier b; b.bar = bar; b.x = xb_xcc_id(); b.st = st;
    if (threadIdx.x == 0) (void)xb_add(&bar[XB_XCNT(b.x)], 1u);
    return b;
}
__device__ __forceinline__ void xcd_barrier_complete(unsigned* bar, unsigned x, unsigned& nloc, unsigned& nx) {
    const unsigned G = gridDim.x * gridDim.y * gridDim.z;
    unsigned sum, cnt, mine, sp = 0u;
    for (;;) {
        sum = 0u; cnt = 0u; mine = 0u;
#pragma unroll
        for (unsigned j = 0; j < 16; ++j) { const unsigned c = xb_ld(&bar[XB_XCNT(j)]); sum += c; cnt += (c > 0u) ? 1u : 0u; mine = (j == x) ? c : mine; }
        if (sum == G) break;
        __builtin_amdgcn_s_sleep(1);
        if ((++sp & 255u) == 0u) { if (xb_ld(&bar[XB_TMO])) break; if (sp > XB_SPIN_CAP) { atomicAdd(&bar[XB_TMO], 1u); break; } }
    }
    nloc = mine > 0u ? mine : 1u; nx = cnt > 0u ? cnt : 1u;
}
__device__ __forceinline__ void xcd_barrier(const XcdBarrier& b, const bool leader  ) {
    asm volatile("s_waitcnt vmcnt(0)" ::: "memory");
    __syncthreads();
    if (leader) {
        unsigned* bar = b.bar;
        __builtin_amdgcn_s_waitcnt(0);
        unsigned nloc = b.st[0], nx = b.st[1];
        if (nloc == 0u) { xcd_barrier_complete(bar, b.x, nloc, nx); b.st[0] = nloc; b.st[1] = nx; }
        const unsigned old = xb_add(&bar[XB_XSUB(b.x)], 1u);
        const unsigned gen = old / nloc;
        if (old + 1u == (gen + 1u) * nloc) {
            __builtin_amdgcn_fence(__ATOMIC_RELEASE, "agent");
            asm volatile("s_waitcnt vmcnt(0)" ::: "memory");
            const unsigned og = xb_add(&bar[XB_TOP], 1u);
            const unsigned tg = og / nx;
            if (og + 1u == (tg + 1u) * nx) xb_add(&bar[XB_TOPGEN], 1u);
            else XB_SPIN(xb_ld(&bar[XB_TOPGEN]) == tg, bar);
            __builtin_amdgcn_fence(__ATOMIC_ACQUIRE, "agent");
            xb_add(&bar[XB_XGEN(b.x)], 1u);
            asm volatile("s_waitcnt vmcnt(0)" ::: "memory");
        } else {
            XB_SPIN(xb_ld(&bar[XB_XGEN(b.x)]) == gen, bar);
            __builtin_amdgcn_fence(__ATOMIC_ACQUIRE, "agent");
            asm volatile("s_waitcnt vmcnt(0)" ::: "memory");
        }
    }
    __syncthreads();
}

enum { I_x = 0, I_norm_mix, I_w_in, I_b_fox_f, I_fox_gain, I_hgrn_lb, I_hgrn_gain, I_pool_w, I_pool_scale, I_w_out, I_norm_moe, I_w_router, I_b_router, I_w1, I_b1, I_w2, I_b2, I_norm_final };
struct Frame {
    LAS unsigned char* lds; unsigned char* ws; unsigned* ctl; float* out;
    int tid, lane, wave, bid, G;
};
__device__ __forceinline__ const float* inp(const Frame& F, int i) {
    const LAS unsigned* p = (const LAS unsigned*)(F.lds + LDSCTL_OFF + LC_INP) + 2 * i;
    const unsigned lo = __builtin_amdgcn_readfirstlane(p[0]), hi = __builtin_amdgcn_readfirstlane(p[1]);
    return (const float*)(((unsigned long long)hi << 32) | lo);
}

constexpr int P0_ROWB = 272;
template <bool INTERLEAVED, bool OUT8 = false>
__device__ __forceinline__ void p0_item(const float* src  , int ldn, const float* g  , void* dstv  , int K, int drow0, int extra, LAS unsigned char* tile, int lane, float scale = 1.f) {
    bf16_t* dst = (bf16_t*)dstv; unsigned char* dst8 = (unsigned char*)dstv;
    f32x4 v[16];
    const float* sp = src + (size_t)(lane >> 5) * ldn + 4 * (lane & 31);
#pragma unroll
    for (int j = 0; j < 16; ++j) v[j] = __builtin_nontemporal_load((const f32x4*)(sp + (size_t)(2 * j) * ldn));
    if (g) {
#pragma unroll
        for (int j = 0; j < 16; ++j) v[j] = v[j] * (g[2 * j + (lane >> 5)] * scale);
    } else if (OUT8) {
#pragma unroll
        for (int j = 0; j < 16; ++j) v[j] = v[j] * scale;
    }
#pragma unroll
    for (int j = 0; j < 16; ++j) { const int k = 2 * j + (lane >> 5); const unsigned w0 = cvtpk(v[j][0], v[j][1]), w1 = cvtpk(v[j][2], v[j][3]);
        if (INTERLEAVED) { const unsigned gg = (w0 & 0xffffu) | (w1 << 16), ll = (w0 >> 16) | (w1 & 0xffff0000u);
            *(LAS unsigned*)(tile + k * P0_ROWB + 4 * (lane & 31)) = gg; *(LAS unsigned*)(tile + k * P0_ROWB + 128 + 4 * (lane & 31)) = ll; }
        else *(LAS u32x2*)(tile + k * P0_ROWB + 8 * (lane & 31)) = (u32x2){w0, w1}; }
    LDS_WAIT(); asm volatile("" ::: "memory");
    const int gq = lane >> 4, i16 = lane & 15;
    const LAS unsigned char* rp = tile + (8 * gq + (i16 >> 2)) * P0_ROWB + 8 * (lane & 3);
#pragma unroll
    for (int nb = 0; nb < 8; ++nb) {
        const v4i16_t lo = __builtin_amdgcn_ds_read_tr16_b64_v4i16((LAS v4i16_t*)(rp + nb * 32)), hi = __builtin_amdgcn_ds_read_tr16_b64_v4i16((LAS v4i16_t*)(rp + nb * 32 + 4 * P0_ROWB));
        const int tc = nb * 16 + i16, row = drow0 + tc + (tc >= 64 ? extra : 0);
        if (OUT8) { *(u32x2*)(dst8 + (size_t)row * K + 8 * gq) = (u32x2){pk4_fp8(bf2f((bf16_t)lo[0]), bf2f((bf16_t)lo[1]), bf2f((bf16_t)lo[2]), bf2f((bf16_t)lo[3])), pk4_fp8(bf2f((bf16_t)hi[0]), bf2f((bf16_t)hi[1]), bf2f((bf16_t)hi[2]), bf2f((bf16_t)hi[3]))}; }
        else { const bf16x8 o = (bf16x8){lo[0], lo[1], lo[2], lo[3], hi[0], hi[1], hi[2], hi[3]};
            *(bf16x8*)(dst + (size_t)row * K + 8 * gq) = o; } }
    LDS_WAIT(); asm volatile("" ::: "memory");
}
__device__ __forceinline__ void p0_prologue(const Frame& F) {
    LAS unsigned char* tile = F.lds + F.wave * (32 * P0_ROWB);
    const int gw = F.bid * NWAVES + F.wave, NGW = F.G * NWAVES;
    constexpr int I_IN = 32 * 22, I_OUT = 32 * 8, I_W1 = NE * 32 * 16, I_W2 = NE * 32 * 8, I_L = I_IN + I_OUT + I_W1 + I_W2;
    for (int it = gw; it < NL * I_L; it += NGW) {
        const int l = it / I_L; int r = it % I_L;
        if (r < I_IN) { const int nb = r / 32, kb = r % 32, n0 = 128 * nb, k0 = 32 * kb;
            p0_item<false>(inp(F, I_w_in) + ((size_t)l * D + k0) * IN_COLS + n0 + (n0 >= 1536 ? 8 : 0), IN_COLS, inp(F, I_norm_mix) + l * D + k0, (bf16_t*)(F.ws + WS_WIN + l * WIN_BYTES) + k0, D, n0, 0, tile, F.lane); continue; }
        r -= I_IN;
        if (r < I_OUT) { const int nb = r / 32, kb = r % 32, n0 = 128 * nb, k0 = 32 * kb;
            p0_item<false>(inp(F, I_w_out) + ((size_t)l * D + k0) * D + n0, D, nullptr, (bf16_t*)(F.ws + WS_WOUT + l * WOUT_BYTES) + k0, D, n0, 0, tile, F.lane); continue; }
        r -= I_OUT;
        if (r < I_W1) { const int e = r / (32 * 16), q = r % (32 * 16), cb = q / 32, kb = q % 32, k0 = 32 * kb, j0 = 64 * cb;
            p0_item<true, true>(inp(F, I_w1) + (((size_t)l * NE + e) * D + k0) * (2 * FF) + 2 * j0, 2 * FF, inp(F, I_norm_moe) + l * D + k0, F.ws + WS_W1 + ((size_t)l * NE + e) * W1E_BYTES + k0, D, (j0 >> 7) * 256 + (j0 & 127), 64, tile, F.lane, W1_SCALE); continue; }
        r -= I_W1;
        { const int e = r / (32 * 8), q = r % (32 * 8), nb = q / 32, kb = q % 32, n0 = 128 * nb, k0 = 32 * kb;
            p0_item<false, true>(inp(F, I_w2) + (((size_t)l * NE + e) * FF + k0) * D + n0, D, nullptr, F.ws + WS_W2 + ((size_t)l * NE + e) * W2E_BYTES + k0, FF, n0, 0, tile, F.lane, W2_SCALE); }
    }
    const int gt = F.bid * NTHREADS + F.tid, NGT = F.G * NTHREADS;
    float* b1r = (float*)(F.ws + WS_B1R);
    for (int i = gt; i < NL * NE * 2048; i += NGT) { const int le = i >> 11, n = i & 2047, pn = n >> 8, rr = n & 255; b1r[i] = inp(F, I_b1)[(size_t)le * 2048 + 2 * (128 * pn + (rr & 127)) + (rr >> 7)]; }
    { bf16_t* pwt = (bf16_t*)(F.ws + WS_PWT);
      for (int i = gt; i < NL * 4 * 64 * 64; i += NGT) { const int c = i & 63, d = (i >> 6) & 63, lg = i >> 12; pwt[i] = f2bf(inp(F, I_pool_w)[((size_t)lg * 64 + c) * 64 + d]); } }
    bf16_t* wf = (bf16_t*)(F.ws + WS_WFRAG);
    for (int i = gt; i < NL * 2 * 32 * 2 * 64 * 8; i += NGT) {
        const int j = i & 7, ln = (i >> 3) & 63, et = (i >> 9) & 1, ks = (i >> 10) & 31, kind = (i >> 15) & 1, l = i >> 16;
        const int e = 16 * et + (ln & 15), k = 32 * ks + 8 * (ln >> 4) + j;
        float v;
        if (kind == 0) v = (e < 8) ? inp(F, I_norm_mix)[l * D + k] * inp(F, I_w_in)[((size_t)l * D + k) * IN_COLS + 1536 + e] : 0.f;
        else v = inp(F, I_norm_moe)[l * D + k] * inp(F, I_w_router)[((size_t)l * D + k) * NE + e];
        const bf16_t h = f2bf(v), lo = f2bf(v - bf2f(h));
        const size_t base = ((((size_t)(l * 2 + kind) * 32 + ks) * 2 + et) * 2) * 512 + ln * 8 + j;
        wf[base] = h; wf[base + 512] = lo;
    }
}

template <int KIND, bool COMBINE, bool WRITE_H, bool DRY = false>
__device__ __forceinline__ void r_phase(const Frame& F, int l, const float* hin, float* hout) {
    const int lane = F.lane, r16 = lane & 15, q4 = lane >> 4;
    const u32x4* Wf = (const u32x4*)(F.ws + WS_WFRAG + (size_t)(l * 2 + KIND) * 131072);
    const bf16_t* Y = (const bf16_t*)(F.ws + WS_Y);
    bf16_t* HB = (bf16_t*)(F.ws + WS_HB);
    float* rstdp = (float*)(F.ws + (KIND == 0 ? WS_RSTD1 : WS_RSTD2));
    LAS float* lg = (LAS float*)(F.lds) + F.wave * (16 * 33);
    LAS int* r2cnt = (LAS int*)(F.lds + LDSCTL_OFF + LC_R2CNT); LAS int* r2base = (LAS int*)(F.lds + LDSCTL_OFF + LC_R2BASE);
    for (int task = F.bid; task < T / 128; task += F.G) {
        const int tok = task * 128 + F.wave * 16 + r16;
        const float* xr = hin + (size_t)tok * D + 8 * q4; float* ho = hout + (size_t)tok * D + 8 * q4;
        const unsigned char* yr = (const unsigned char*)Y + (size_t)tok * 4 * D + 8 * q4; bf16_t* hbr = HB + (size_t)tok * D + 8 * q4;
        f32x4 acc0 = {0.f, 0.f, 0.f, 0.f}, acc1 = {0.f, 0.f, 0.f, 0.f}; float ssq = 0.f;
        if (KIND == 1) { if (F.tid < 32) r2cnt[F.tid] = 0; }
#pragma unroll 2
        for (int ks = 0; ks < 32; ++ks) {
            f32x4 x0 = *(const f32x4*)(xr + 32 * ks), x1 = *(const f32x4*)(xr + 32 * ks + 4);
            if (COMBINE) {
#pragma unroll
                for (int k = 0; k < 4; ++k) { const u32x2 y = *(const u32x2*)(yr + (size_t)k * D + 32 * ks);
                    x0 += un4_fp8(y.x) * (1.0f / Y_SCALE); x1 += un4_fp8(y.y) * (1.0f / Y_SCALE); }
            }
            if (WRITE_H) { *(f32x4*)(ho + 32 * ks) = x0; *(f32x4*)(ho + 32 * ks + 4) = x1; }
            ssq += (x0[0] * x0[0] + x0[1] * x0[1]) + (x0[2] * x0[2] + x0[3] * x0[3]) + (x1[0] * x1[0] + x1[1] * x1[1]) + (x1[2] * x1[2] + x1[3] * x1[3]);
            u32x4 hw; hw.x = cvtpk(x0[0], x0[1]); hw.y = cvtpk(x0[2], x0[3]); hw.z = cvtpk(x1[0], x1[1]); hw.w = cvtpk(x1[2], x1[3]);
            u32x4 lw; lw.x = cvtpk(x0[0] - bflo(hw.x), x0[1] - bfhi(hw.x)); lw.y = cvtpk(x0[2] - bflo(hw.y), x0[3] - bfhi(hw.y)); lw.z = cvtpk(x1[0] - bflo(hw.z), x1[1] - bfhi(hw.z)); lw.w = cvtpk(x1[2] - bflo(hw.w), x1[3] - bfhi(hw.w));
            if (KIND == 0) *(u32x4*)(hbr + 32 * ks) = hw;
            else *(u32x2*)((unsigned char*)(F.ws + WS_HB8) + (size_t)tok * D + 8 * q4 + 32 * ks) = (u32x2){pk4_fp8_sat(x0[0], x0[1], x0[2], x0[3]), pk4_fp8_sat(x1[0], x1[1], x1[2], x1[3])};
            const bf16x8 xh = __builtin_bit_cast(bf16x8, hw), xl = __builtin_bit_cast(bf16x8, lw);
            const bf16x8 wh0 = __builtin_bit_cast(bf16x8, Wf[((ks * 2 + 0) * 2 + 0) * 64 + lane]), wl0 = __builtin_bit_cast(bf16x8, Wf[((ks * 2 + 0) * 2 + 1) * 64 + lane]);
            acc0 = __builtin_amdgcn_mfma_f32_16x16x32_bf16(wh0, xh, acc0, 0, 0, 0);
            acc0 = __builtin_amdgcn_mfma_f32_16x16x32_bf16(wl0, xh, acc0, 0, 0, 0);
            acc0 = __builtin_amdgcn_mfma_f32_16x16x32_bf16(wh0, xl, acc0, 0, 0, 0);
            if (KIND == 1) {
                const bf16x8 wh1 = __builtin_bit_cast(bf16x8, Wf[((ks * 2 + 1) * 2 + 0) * 64 + lane]), wl1 = __builtin_bit_cast(bf16x8, Wf[((ks * 2 + 1) * 2 + 1) * 64 + lane]);
                acc1 = __builtin_amdgcn_mfma_f32_16x16x32_bf16(wh1, xh, acc1, 0, 0, 0);
                acc1 = __builtin_amdgcn_mfma_f32_16x16x32_bf16(wl1, xh, acc1, 0, 0, 0);
                acc1 = __builtin_amdgcn_mfma_f32_16x16x32_bf16(wh1, xl, acc1, 0, 0, 0);
            }
        }
        ssq += __shfl_xor(ssq, 16); ssq += __shfl_xor(ssq, 32);
        const float rstd = 1.0f / sqrtf(ssq * (1.0f / D) + RMS_EPS);
        if (q4 == 0) rstdp[tok] = rstd;
        if (KIND == 0) {
            if (q4 < 2) { const f32x4 bf = *(const f32x4*)(inp(F, I_b_fox_f) + l * 8 + 4 * q4); f32x4 lf;
#pragma unroll
                for (int i = 0; i < 4; ++i) { const float z = rstd * acc0[i] + bf[i]; lf[i] = fminf(z, 0.f) - log1pf(expf(-fabsf(z))); }
                *(f32x4*)((float*)(F.ws + WS_LOGF) + (size_t)tok * 8 + 4 * q4) = lf; }
        } else if (!DRY) {
            const f32x4 b0 = *(const f32x4*)(inp(F, I_b_router) + l * NE + 4 * q4), b1v = *(const f32x4*)(inp(F, I_b_router) + l * NE + 16 + 4 * q4);
#pragma unroll
            for (int i = 0; i < 4; ++i) { lg[r16 * 33 + 4 * q4 + i] = rstd * acc0[i] + b0[i]; lg[r16 * 33 + 16 + 4 * q4 + i] = rstd * acc1[i] + b1v[i]; }
            LDS_WAIT(); asm volatile("" ::: "memory");
            float v0 = -INFINITY, v1 = -INFINITY, v2 = -INFINITY, v3 = -INFINITY; int i0 = 0, i1 = 0, i2 = 0, i3 = 0;
            if (lane < 16) {
                for (int e = 0; e < NE; ++e) { const float x = lg[lane * 33 + e];
                    if (x > v3) { if (x > v0) { v3 = v2; i3 = i2; v2 = v1; i2 = i1; v1 = v0; i1 = i0; v0 = x; i0 = e; }
                        else if (x > v1) { v3 = v2; i3 = i2; v2 = v1; i2 = i1; v1 = x; i1 = e; }
                        else if (x > v2) { v3 = v2; i3 = i2; v2 = x; i2 = e; }
                        else { v3 = x; i3 = e; } } }
            }
            __syncthreads();
            int rk0 = 0, rk1 = 0, rk2 = 0, rk3 = 0;
            if (lane < 16) { rk0 = __hip_atomic_fetch_add(&r2cnt[i0], 1, __ATOMIC_RELAXED, __HIP_MEMORY_SCOPE_WORKGROUP); rk1 = __hip_atomic_fetch_add(&r2cnt[i1], 1, __ATOMIC_RELAXED, __HIP_MEMORY_SCOPE_WORKGROUP); rk2 = __hip_atomic_fetch_add(&r2cnt[i2], 1, __ATOMIC_RELAXED, __HIP_MEMORY_SCOPE_WORKGROUP); rk3 = __hip_atomic_fetch_add(&r2cnt[i3], 1, __ATOMIC_RELAXED, __HIP_MEMORY_SCOPE_WORKGROUP); }
            __syncthreads();
            if (F.tid < 32) r2base[F.tid] = (int)atomicAdd(F.ctl + CW_CUR + (l * NE + F.tid) * 16, (unsigned)r2cnt[F.tid]);
            __syncthreads();
            if (lane < 16) {
                const float e1 = expf(v1 - v0), e2 = expf(v2 - v0), e3 = expf(v3 - v0), inv = 1.0f / (1.0f + e1 + e2 + e3);
                u32x2* list = (u32x2*)(F.ws + WS_LIST); float* gate = (float*)(F.ws + WS_GATE);
                const int tk = (task * 128 + F.wave * 16 + lane) * 4; const unsigned rb = __float_as_uint(__shfl(rstd, lane & 15));
                list[(size_t)i0 * LISTCAP + r2base[i0] + rk0] = (u32x2){(unsigned)(tk + 0), rb}; gate[tk + 0] = inv;
                list[(size_t)i1 * LISTCAP + r2base[i1] + rk1] = (u32x2){(unsigned)(tk + 1), rb}; gate[tk + 1] = e1 * inv;
                list[(size_t)i2 * LISTCAP + r2base[i2] + rk2] = (u32x2){(unsigned)(tk + 2), rb}; gate[tk + 2] = e2 * inv;
                list[(size_t)i3 * LISTCAP + r2base[i3] + rk3] = (u32x2){(unsigned)(tk + 3), rb}; gate[tk + 3] = e3 * inv;
            }
            __syncthreads();
        }
    }
}
__device__ __forceinline__ void r_final(const Frame& F) {
    const int lane = F.lane, tr = lane >> 5, c = lane & 31;
    const bf16_t* Y = (const bf16_t*)(F.ws + WS_Y);
    const float* gf = inp(F, I_norm_final);
    for (int task = F.bid; task < T / 128; task += F.G) {
#pragma unroll 1
        for (int pr = 0; pr < 8; ++pr) {
            const int tok = task * 128 + F.wave * 16 + pr * 2 + tr;
            float* xr = F.out + (size_t)tok * D + 8 * c; const unsigned char* yr = (const unsigned char*)Y + (size_t)tok * 4 * D + 8 * c;
            f32x4 x0[4], x1[4]; float ssq = 0.f;
#pragma unroll
            for (int i = 0; i < 4; ++i) { x0[i] = *(const f32x4*)(xr + 256 * i); x1[i] = *(const f32x4*)(xr + 256 * i + 4); }
#pragma unroll
            for (int i = 0; i < 4; ++i) {
#pragma unroll
                for (int k = 0; k < 4; ++k) { const u32x2 y = *(const u32x2*)(yr + (size_t)k * D + 256 * i);
                    x0[i] += un4_fp8(y.x) * (1.0f / Y_SCALE); x1[i] += un4_fp8(y.y) * (1.0f / Y_SCALE); }
                ssq += (x0[i][0] * x0[i][0] + x0[i][1] * x0[i][1]) + (x0[i][2] * x0[i][2] + x0[i][3] * x0[i][3]) + (x1[i][0] * x1[i][0] + x1[i][1] * x1[i][1]) + (x1[i][2] * x1[i][2] + x1[i][3] * x1[i][3]); }
            ssq += __shfl_xor(ssq, 1); ssq += __shfl_xor(ssq, 2); ssq += __shfl_xor(ssq, 4); ssq += __shfl_xor(ssq, 8); ssq += __shfl_xor(ssq, 16);
            const float rstd = 1.0f / sqrtf(ssq * (1.0f / D) + RMS_EPS);
#pragma unroll
            for (int i = 0; i < 4; ++i) { const f32x4 g0 = *(const f32x4*)(gf + 256 * i + 8 * c), g1 = *(const f32x4*)(gf + 256 * i + 8 * c + 4);
                *(f32x4*)(xr + 256 * i) = x0[i] * rstd * g0; *(f32x4*)(xr + 256 * i + 4) = x1[i] * rstd * g1; }
        }
    }
}
__device__ __forceinline__ void cumsum_step(const Frame& F) {
    LAS float* sc = (LAS float*)(F.lds + LDSCTL_OFF + LC_SCAN);
    const float* LF = (const float*)(F.ws + WS_LOGF); float* c2 = (float*)(F.ws + WS_C2);
    for (int seq = F.bid; seq < 64; seq += F.G) {
        const int b = seq >> 3, h = seq & 7, t0 = F.tid * 8; const float* lf = LF + ((size_t)b * SEQ + t0) * 8 + h;
        float v[8], s = 0.f;
#pragma unroll
        for (int j = 0; j < 8; ++j) { s += lf[j * 8]; v[j] = s; }
        float inc = s;
#pragma unroll
        for (int off = 1; off < 64; off <<= 1) { const float y = __shfl_up(inc, off); if (F.lane >= off) inc += y; }
        if (F.lane == 63) sc[F.wave] = inc;
        __syncthreads();
        float pre = 0.f;
        for (int w = 0; w < F.wave; ++w) pre += sc[w];
        const float base = pre + inc - s;
#pragma unroll
        for (int j = 0; j < 8; ++j) c2[(size_t)seq * SEQ + t0 + j] = (base + v[j]) * LOG2E;
        __syncthreads();
    }
}

__device__ __forceinline__ float max3f(float a, float b, float c) { float r; asm("v_max3_f32 %0, %1, %2, %3" : "=v"(r) : "v"(a), "v"(b), "v"(c)); return r; }
__device__ __forceinline__ float max2f(float a, float b) { float r; asm("v_max_f32_e32 %0, %1, %2" : "=v"(r) : "v"(a), "v"(b)); return r; }
__device__ __forceinline__ int crow(int r, int hi) { return (r & 3) + 8 * (r >> 2) + 4 * hi; }
constexpr int AT_KT = 0, AT_KTB = 8320, AT_VT = 2 * AT_KTB, AT_VTB = 8192, AT_CK = AT_VT + 2 * AT_VTB, AT_WSF = AT_CK + 512, AT_OST = AT_WSF + 2048, AT_END = AT_OST + 65536;
static_assert(AT_END <= PH_BYTES, "attention LDS");
__device__ __forceinline__ void attn_unit(const Frame& F, int l, int b, int h, int qb) {
    const int tid = F.tid, lane = F.lane, r32 = lane & 31, hi = lane >> 5, wid = F.wave;
    const bf16_t* proj = (const bf16_t*)(F.ws + WS_PA); bf16_t* mixed = (bf16_t*)(F.ws + WS_MIXED);
    const int bh = b * 8 + h; const float* c2 = (const float*)(F.ws + WS_C2) + (size_t)bh * SEQ;
    const size_t rowbase = (size_t)b * SEQ; const int q0 = qb * 256;
    LAS unsigned char* L = F.lds;
    LAS float* wsf = (LAS float*)(L + AT_WSF) + wid * 64;
    LAS float* ost = (LAS float*)(L + AT_OST) + wid * 2048;
    LAS unsigned* stopv = (LAS unsigned*)(L + LDSCTL_OFF + LC_STOP);
    const bf16_t* Qw = proj + (rowbase + q0 + wid * 32 + r32) * NPROJ + C_FQ + h * 64;
    bf16x8 qr[4]; float qn = 0.f;
#pragma unroll
    for (int d0 = 0; d0 < 4; ++d0) { const u32x4 w = *(const u32x4*)(Qw + d0 * 16 + hi * 8); qr[d0] = __builtin_bit_cast(bf16x8, w);
        qn += bflo(w.x) * bflo(w.x) + bfhi(w.x) * bfhi(w.x) + bflo(w.y) * bflo(w.y) + bfhi(w.y) * bfhi(w.y) + bflo(w.z) * bflo(w.z) + bfhi(w.z) * bfhi(w.z) + bflo(w.w) * bflo(w.w) + bfhi(w.w) * bfhi(w.w); }
    qn += __shfl_xor(qn, 32); qn = sqrtf(qn) * 1.001f;
    const float kb = sqrtf(2.0f * __uint_as_float(__hip_atomic_load(F.ctl + CW_KMAX + (l * 64 + bh) * 16, __ATOMIC_RELAXED, __HIP_MEMORY_SCOPE_AGENT))) * 1.001f;
    const float c2q = c2[q0 + wid * 32 + r32];
    f32x16 cq16;
#pragma unroll
    for (int r = 0; r < 16; ++r) cq16[r] = c2q;
    float lsum = 0.f; f32x16 o[2];
#pragma unroll
    for (int r = 0; r < 16; ++r) { o[0][r] = 0.f; o[1][r] = 0.f; }
    const int jd = 4 * qb + 3;
    const int lkey = tid >> 3, lpiece = tid & 7;
    const bf16_t* ksrc = proj + (rowbase + lkey) * NPROJ + C_FK + h * 64 + lpiece * 8;
    const bf16_t* vsrc = proj + (rowbase + lkey) * NPROJ + C_FV + h * 64 + lpiece * 8;
    const int kdst = lpiece * 1040 + lkey * 16, vdst = (lpiece >> 2) * 4096 + lkey * 64 + (lpiece & 3) * 16;
    u32x4 kA = *(const u32x4*)(ksrc + (size_t)jd * 64 * NPROJ), vA = *(const u32x4*)(vsrc + (size_t)jd * 64 * NPROJ); float cA = c2[jd * 64 + lane];
    u32x4 kB = kA, vB = vA; float cB = cA;
    if (jd >= 1) { kB = *(const u32x4*)(ksrc + (size_t)(jd - 1) * 64 * NPROJ); vB = *(const u32x4*)(vsrc + (size_t)(jd - 1) * 64 * NPROJ); cB = c2[(jd - 1) * 64 + lane]; }
    const int vrd = (4 * hi + ((lane & 15) >> 2)) * 64 + ((lane >> 4) & 1) * 32 + (lane & 3) * 8;
    const int qrel = wid * 32 + r32;
    int buf = 0; bool done = false, wstop = false, first = true;
    float mhat = 0.f;
#define AT_ITER(j, kR, vR, cR, cNext) do { \
        const float cklast = rdlane(cNext, 63);     \
        *(LAS u32x4*)(L + AT_KT + buf * AT_KTB + kdst) = kR; *(LAS u32x4*)(L + AT_VT + buf * AT_VTB + vdst) = vR; \
        if (tid < 64) ((LAS float*)(L + AT_CK))[buf * 64 + tid] = cR; \
        asm volatile("s_waitcnt lgkmcnt(0)\n\ts_barrier" ::: "memory");     \
        if ((j) < jd) { const u32x4 fa = *(const LAS u32x4*)(stopv + (((j) + 1) & 1) * 8), fb = *(const LAS u32x4*)(stopv + (((j) + 1) & 1) * 8 + 4); \
            if ((fa.x & fa.y & fa.z & fa.w & fb.x & fb.y & fb.z & fb.w) != 0u) { done = true; break; } } \
        if ((j) >= 2) { kR = *(const u32x4*)(ksrc + (size_t)((j) - 2) * 64 * NPROJ); vR = *(const u32x4*)(vsrc + (size_t)((j) - 2) * 64 * NPROJ); cR = c2[((j) - 2) * 64 + lane]; } \
        const int jrel = (j) - 4 * qb; \
        const bool active = !(jrel >= 0 && 64 * jrel > 32 * wid + 31) && !wstop; \
        if (active) { \
            const LAS unsigned char* Kb = L + AT_KT + buf * AT_KTB; const LAS unsigned char* Vb = L + AT_VT + buf * AT_VTB; const LAS float* Ck = (const LAS float*)(L + AT_CK) + buf * 64; \
            const float base = c2q - mhat; \
            f32x16 p0, p1; \
            _Pragma("unroll") for (int g = 0; g < 4; ++g) { const f32x4 ca = *(const LAS f32x4*)(Ck + 8 * g + 4 * hi), cb = *(const LAS f32x4*)(Ck + 32 + 8 * g + 4 * hi); \
                _Pragma("unroll") for (int i = 0; i < 4; ++i) { p0[4 * g + i] = base - ca[i]; p1[4 * g + i] = base - cb[i]; } } \
            bf16x8 kf0[4], kf1[4]; \
            _Pragma("unroll") for (int d0 = 0; d0 < 4; ++d0) { kf0[d0] = *(const LAS bf16x8*)(Kb + (2 * d0 + hi) * 1040 + r32 * 16); kf1[d0] = *(const LAS bf16x8*)(Kb + (2 * d0 + hi) * 1040 + (32 + r32) * 16); } \
            _Pragma("unroll") for (int d0 = 0; d0 < 4; ++d0) { \
                p0 = __builtin_amdgcn_mfma_f32_32x32x16_bf16(kf0[d0], qr[d0], p0, 0, 0, 0); p1 = __builtin_amdgcn_mfma_f32_32x32x16_bf16(kf1[d0], qr[d0], p1, 0, 0, 0); } \
            asm volatile("s_nop 15\n\ts_nop 7" : "+v"(p0), "+v"(p1));     \
            if (jrel >= 0) { const int kbase = 64 * jrel + 4 * hi; \
                _Pragma("unroll") for (int r = 0; r < 16; ++r) { const int kv = kbase + (r & 3) + 8 * (r >> 2); if (kv > qrel) p0[r] = -INFINITY; if (kv + 32 > qrel) p1[r] = -INFINITY; } } \
            float mx = max3f(p0[0], p0[1], p1[0]), mb_ = max3f(p0[2], p0[3], p1[1]); mx = max3f(mx, p1[2], p1[3]); \
            _Pragma("unroll") for (int r = 4; r < 16; r += 4) { mx = max3f(mx, p0[r], p0[r + 1]); mb_ = max3f(mb_, p0[r + 2], p0[r + 3]); mx = max3f(mx, p1[r], p1[r + 1]); mb_ = max3f(mb_, p1[r + 2], p1[r + 3]); } \
            mx = max2f(mx, mb_); \
            { auto rr = __builtin_amdgcn_permlane32_swap(__float_as_uint(mx), __float_as_uint(mx), false, false); mx = max2f(__uint_as_float(rr[0]), __uint_as_float(rr[1])); } \
            if (first || __any(mx > 8.0f)) { \
                const float dl = first ? mx : fmaxf(mx, 0.f); mhat += dl; \
                _Pragma("unroll") for (int r = 0; r < 16; ++r) { p0[r] -= dl; p1[r] -= dl; } \
                const float alpha = __builtin_amdgcn_exp2f(-dl); lsum *= alpha; \
                if (!first) { \
                    if (hi == 0) wsf[r32] = alpha; \
                    LDS_WAIT(); asm volatile("" ::: "memory"); \
                    _Pragma("unroll") for (int r = 0; r < 16; ++r) { const float a = wsf[crow(r, hi)]; o[0][r] *= a; o[1][r] *= a; } } \
                first = false; \
            } \
            _Pragma("unroll") for (int r = 0; r < 16; ++r) { p0[r] = __builtin_amdgcn_exp2f(p0[r]); p1[r] = __builtin_amdgcn_exp2f(p1[r]); } \
            { f32x2 sa = {p0[0] + p1[0], p0[1] + p1[1]}; \
              _Pragma("unroll") for (int r = 2; r < 16; r += 2) { sa += (f32x2){p0[r], p0[r + 1]}; sa += (f32x2){p1[r], p1[r + 1]}; } \
              lsum += sa[0] + sa[1]; } \
            u32x4 pw[4]; \
            pw[0] = (u32x4){cvtpk(p0[0], p0[1]), cvtpk(p0[2], p0[3]), cvtpk(p0[4], p0[5]), cvtpk(p0[6], p0[7])}; \
            pw[1] = (u32x4){cvtpk(p0[8], p0[9]), cvtpk(p0[10], p0[11]), cvtpk(p0[12], p0[13]), cvtpk(p0[14], p0[15])}; \
            pw[2] = (u32x4){cvtpk(p1[0], p1[1]), cvtpk(p1[2], p1[3]), cvtpk(p1[4], p1[5]), cvtpk(p1[6], p1[7])}; \
            pw[3] = (u32x4){cvtpk(p1[8], p1[9]), cvtpk(p1[10], p1[11]), cvtpk(p1[12], p1[13]), cvtpk(p1[14], p1[15])}; \
            _Pragma("unroll") for (int s = 0; s < 4; ++s) \
                _Pragma("unroll") for (int d0 = 0; d0 < 2; ++d0) { \
                    const LAS unsigned char* vp = Vb + d0 * 4096 + s * 1024 + vrd; \
                    const v4i16_t lo = __builtin_amdgcn_ds_read_tr16_b64_v4i16((LAS v4i16_t*)vp), hv = __builtin_amdgcn_ds_read_tr16_b64_v4i16((LAS v4i16_t*)(vp + 512)); \
                    const bf16x8 vf = (bf16x8){lo[0], lo[1], lo[2], lo[3], hv[0], hv[1], hv[2], hv[3]}; \
                    o[d0] = __builtin_amdgcn_mfma_f32_32x32x16_bf16(__builtin_bit_cast(bf16x8, pw[s]), vf, o[d0], 0, 0, 0); } \
        } \
        if ((j) > 0) { if (active) { const float ub = qn * kb + (c2q - cklast); if (__all((ub - mhat) < -152.0f)) wstop = true; } if (lane == 0) stopv[((j) & 1) * 8 + wid] = wstop ? 1u : 0u; } \
        buf ^= 1; \
    } while (0)
    for (int j = jd; j >= 0; j -= 2) {
        AT_ITER(j, kA, vA, cA, cB);
        if (done || j == 0) break;
        AT_ITER(j - 1, kB, vB, cB, cA);
        if (done) break;
    }
#undef AT_ITER
    lsum += __shfl_xor(lsum, 32);
    if (hi == 0) wsf[32 + r32] = 1.0f / lsum;
    LDS_WAIT(); asm volatile("" ::: "memory");
#pragma unroll
    for (int r = 0; r < 16; ++r) { const int q = crow(r, hi); const float inv = wsf[32 + q]; ost[q * 64 + r32] = o[0][r] * inv; ost[q * 64 + 32 + r32] = o[1][r] * inv; }
    LDS_WAIT(); asm volatile("" ::: "memory");
    { const int row = lane >> 1, half = lane & 1; const LAS float* src = ost + row * 64 + half * 32; float v[32]; float ss = 0.f;
#pragma unroll
        for (int i = 0; i < 8; ++i) { const f32x4 t4 = *(const LAS f32x4*)(src + 4 * i); v[4 * i] = t4[0]; v[4 * i + 1] = t4[1]; v[4 * i + 2] = t4[2]; v[4 * i + 3] = t4[3]; ss += (t4[0] * t4[0] + t4[1] * t4[1]) + (t4[2] * t4[2] + t4[3] * t4[3]); }
        ss += __shfl_xor(ss, 1);
        const float rs = 1.0f / sqrtf(ss * (1.0f / 64.0f) + RMS_EPS);
        const float* gn = inp(F, I_fox_gain) + l * 512 + h * 64 + half * 32;
        bf16_t* dst = mixed + (rowbase + q0 + wid * 32 + row) * D + h * 64 + half * 32;
#pragma unroll
        for (int i = 0; i < 4; ++i) { const f32x4 ga = *(const f32x4*)(gn + 8 * i), gb = *(const f32x4*)(gn + 8 * i + 4); u32x4 w;
            w.x = cvtpk(v[8 * i] * rs * ga[0], v[8 * i + 1] * rs * ga[1]); w.y = cvtpk(v[8 * i + 2] * rs * ga[2], v[8 * i + 3] * rs * ga[3]);
            w.z = cvtpk(v[8 * i + 4] * rs * gb[0], v[8 * i + 5] * rs * gb[1]); w.w = cvtpk(v[8 * i + 6] * rs * gb[2], v[8 * i + 7] * rs * gb[3]);
            *(u32x4*)(dst + 8 * i) = w; } }
    __syncthreads();
}

__device__ __forceinline__ float hg_lb(const Frame& F, int l, int col) {
    float x[NL], mx = -INFINITY;
#pragma unroll
    for (int i = 0; i < NL; ++i) { x[i] = inp(F, I_hgrn_lb)[i * 256 + col]; mx = fmaxf(mx, x[i]); }
    float s = 0.f, a = 0.f;
#pragma unroll
    for (int i = 0; i < NL; ++i) { x[i] = expf(x[i] - mx); s += x[i]; }
#pragma unroll
    for (int i = 1; i < NL; ++i) if (i <= l) a += x[i];
    return a / s;
}
constexpr int HG_SEG = 128, HG_NSEG = SEQ / HG_SEG, HG_NPART = 1, HG_WAVES = 4;
constexpr int HGL_ROW = 136, HGL_QT = 0, HGL_KT = 32 * HGL_ROW, HGL_KP = 2 * 32 * HGL_ROW, HGL_V = HGL_KP + 4096, HGL_PE = HGL_V + 4096, HGL_BYTES = HGL_PE + 256;
static_assert(NWAVES * HGL_BYTES <= PH_BYTES, "HGRN2 LDS");
__device__ __forceinline__ void hg_mfma_unit(const Frame& F, int l, int u) {
    const int seg = u % HG_NSEG, bh = u / HG_NSEG, b = bh >> 2, hd = bh & 3, lane = F.lane, r32 = lane & 31, hi = lane >> 5;
    LAS unsigned char* W = F.lds + F.wave * HGL_BYTES;
    const size_t tokS = (size_t)b * SEQ + seg * HG_SEG;
    const bf16_t* proj = (const bf16_t*)(F.ws + WS_PA);
    float* oraw = (float*)(F.ws + WS_ORAW); bf16_t* QE = (bf16_t*)(F.ws + WS_QE);
    const float lbv = hg_lb(F, l, hd * 64 + lane);
    f32x16 Sacc[2][2];
#pragma unroll
    for (int kb = 0; kb < 2; ++kb)
#pragma unroll
        for (int vb = 0; vb < 2; ++vb)
#pragma unroll
            for (int r = 0; r < 16; ++r) Sacc[kb][vb][r] = 0.f;
    float Pseg = 1.0f;
    const int vrd = (4 * hi + ((lane & 15) >> 2)) * 64 + ((lane >> 4) & 1) * 32 + (lane & 3) * 8;
    int tb = 0;
    while (tb < HG_SEG) {
        const int nmax = (HG_SEG - tb) < 32 ? (HG_SEG - tb) : 32;
        const char* pu8 = (const char*)(proj + (tokS + tb) * NPROJ + hd * 64);
        const unsigned lo2 = (unsigned)lane * 2u;
        char* qe8 = (char*)(QE + (tokS + tb) * 256 + hd * 64);
        char* or8 = (char*)(oraw + (tokS + tb) * 256 + hd * 64);
        const unsigned lof = (unsigned)(4 * hi * 256 + r32) * 4u;
        float fv[32], qv[32]; u32x4 vreg[4];
#pragma unroll
        for (int t = 0; t < 32; ++t) { const bool ok = t < nmax; fv[t] = ok ? bf2f(*(const bf16_t*)(pu8 + (size_t)t * (NPROJ * 2) + C_GF * 2 + lo2)) : 0.f; qv[t] = ok ? bf2f(*(const bf16_t*)(pu8 + (size_t)t * (NPROJ * 2) + C_GQ * 2 + lo2)) : 0.f; }
#pragma unroll
        for (int it = 0; it < 4; ++it) { const int c = lane + 64 * it, sr = c >> 3, pc = c & 7;
            vreg[it] = (u32x4){0u, 0u, 0u, 0u}; if (sr < nmax) vreg[it] = *(const u32x4*)(pu8 + (size_t)sr * (NPROJ * 2) + C_GI * 2 + pc * 16); }
        int nl = 32; { float P = 1.0f;
#pragma unroll
            for (int t = 0; t < 32; ++t) { const float sg = __builtin_amdgcn_rcpf(1.0f + __builtin_amdgcn_exp2f(-LOG2E * fv[t])); float f = fmaxf(lbv + (1.0f - lbv) * sg, 1e-30f); if (t >= nmax) f = 1.0f; fv[t] = f; P *= f; if (P < 1e-32f && nl == 32) nl = t; } }
#pragma unroll
        for (int off = 1; off < 64; off <<= 1) { const int o = __shfl_xor(nl, off); nl = o < nl ? o : nl; }
        const int n = __builtin_amdgcn_readfirstlane(nl < nmax ? nl : nmax);
#pragma unroll
        for (int it = 0; it < 4; ++it) { const int c = lane + 64 * it, sr = c >> 3, pc = c & 7;
            *(LAS u32x4*)(W + HGL_V + (pc >> 2) * 2048 + sr * 64 + (pc & 3) * 16) = (sr < n) ? vreg[it] : (u32x4){0u, 0u, 0u, 0u}; }
        float P = 1.0f;
        {
#pragma unroll
          for (int t = 0; t < 32; ++t) { const bool ok = t < n; const float f = fv[t]; if (ok) P *= f;
            const float qt = ok ? qv[t] * P : 0.f, kt = ok ? (1.0f - f) * __builtin_amdgcn_rcpf(P) : 0.f;
            *(LAS bf16_t*)(W + HGL_QT + t * HGL_ROW + lane * 2) = f2bf(qt); *(LAS bf16_t*)(W + HGL_KT + t * HGL_ROW + lane * 2) = f2bf(kt);
            if (ok) *(bf16_t*)(qe8 + (size_t)t * 512 + lo2) = f2bf(qv[t] * (Pseg * P)); } }
        { float suf = 1.0f;
#pragma unroll
          for (int t = 31; t >= 0; --t) { const bool ok = t < n; const float f = fv[t]; const float kp = ok ? (1.0f - f) * suf : 0.f; if (ok) suf *= f;
            *(LAS bf16_t*)(W + HGL_KP + (lane >> 5) * 2048 + t * 64 + (lane & 31) * 2) = f2bf(kp); } }
        ((LAS float*)(W + HGL_PE))[lane] = P;
        Pseg *= P;
        LDS_WAIT(); asm volatile("" ::: "memory");
        f32x16 st;
#pragma unroll
        for (int r = 0; r < 16; ++r) st[r] = 0.f;
#pragma unroll
        for (int d0 = 0; d0 < 4; ++d0) { const bf16x8 ka = *(const LAS bf16x8*)(W + HGL_KT + r32 * HGL_ROW + (16 * d0 + 8 * hi) * 2), qb = *(const LAS bf16x8*)(W + HGL_QT + r32 * HGL_ROW + (16 * d0 + 8 * hi) * 2);
            st = __builtin_amdgcn_mfma_f32_32x32x16_bf16(ka, qb, st, 0, 0, 0); }
#pragma unroll
        for (int r = 0; r < 16; ++r) if (crow(r, hi) > r32) st[r] = 0.f;
        u32x4 pst[2];
        pst[0] = (u32x4){cvtpk(st[0], st[1]), cvtpk(st[2], st[3]), cvtpk(st[4], st[5]), cvtpk(st[6], st[7])};
        pst[1] = (u32x4){cvtpk(st[8], st[9]), cvtpk(st[10], st[11]), cvtpk(st[12], st[13]), cvtpk(st[14], st[15])};
        bf16x8 vf[2][2];
#pragma unroll
        for (int s2 = 0; s2 < 2; ++s2)
#pragma unroll
            for (int vb = 0; vb < 2; ++vb) { const LAS unsigned char* vp = W + HGL_V + vb * 2048 + s2 * 1024 + vrd;
                const v4i16_t lo = __builtin_amdgcn_ds_read_tr16_b64_v4i16((LAS v4i16_t*)vp), hv = __builtin_amdgcn_ds_read_tr16_b64_v4i16((LAS v4i16_t*)(vp + 512));
                vf[s2][vb] = (bf16x8){lo[0], lo[1], lo[2], lo[3], hv[0], hv[1], hv[2], hv[3]}; }
        f32x16 oacc[2];
#pragma unroll
        for (int vb = 0; vb < 2; ++vb) {
#pragma unroll
            for (int r = 0; r < 16; ++r) oacc[vb][r] = 0.f;
#pragma unroll
            for (int s2 = 0; s2 < 2; ++s2) oacc[vb] = __builtin_amdgcn_mfma_f32_32x32x16_bf16(__builtin_bit_cast(bf16x8, pst[s2]), vf[s2][vb], oacc[vb], 0, 0, 0);
        }
#pragma unroll
        for (int kst = 0; kst < 4; ++kst) {
            const u32x2 qa = *(const LAS u32x2*)(W + HGL_QT + r32 * HGL_ROW + (16 * kst + 4 * hi) * 2), qc = *(const LAS u32x2*)(W + HGL_QT + r32 * HGL_ROW + (16 * kst + 8 + 4 * hi) * 2);
            const bf16x8 qf = __builtin_bit_cast(bf16x8, (u32x4){qa.x, qa.y, qc.x, qc.y});
#pragma unroll
            for (int vb = 0; vb < 2; ++vb) { const f32x16& S = Sacc[kst >> 1][vb]; const int o8 = 8 * (kst & 1);
                const u32x4 sp = (u32x4){cvtpk(S[o8 + 0], S[o8 + 1]), cvtpk(S[o8 + 2], S[o8 + 3]), cvtpk(S[o8 + 4], S[o8 + 5]), cvtpk(S[o8 + 6], S[o8 + 7])};
                oacc[vb] = __builtin_amdgcn_mfma_f32_32x32x16_bf16(qf, __builtin_bit_cast(bf16x8, sp), oacc[vb], 0, 0, 0); }
        }
#pragma unroll
        for (int vb = 0; vb < 2; ++vb)
#pragma unroll
            for (int r = 0; r < 16; ++r) { const int t = crow(r, hi); if (t < n) *(float*)(or8 + (size_t)(((r & 3) + 8 * (r >> 2)) * 1024 + vb * 128) + lof) = oacc[vb][r]; }
#pragma unroll
        for (int kb = 0; kb < 2; ++kb) {
            float pe[16];
#pragma unroll
            for (int g = 0; g < 4; ++g) { const f32x4 p4 = *(const LAS f32x4*)(W + HGL_PE + (32 * kb + 8 * g + 4 * hi) * 4); pe[4 * g] = p4[0]; pe[4 * g + 1] = p4[1]; pe[4 * g + 2] = p4[2]; pe[4 * g + 3] = p4[3]; }
            bf16x8 kf[2];
#pragma unroll
            for (int s2 = 0; s2 < 2; ++s2) { const LAS unsigned char* kp = W + HGL_KP + kb * 2048 + s2 * 1024 + vrd;
                const v4i16_t lo = __builtin_amdgcn_ds_read_tr16_b64_v4i16((LAS v4i16_t*)kp), hv = __builtin_amdgcn_ds_read_tr16_b64_v4i16((LAS v4i16_t*)(kp + 512));
                kf[s2] = (bf16x8){lo[0], lo[1], lo[2], lo[3], hv[0], hv[1], hv[2], hv[3]}; }
#pragma unroll
            for (int vb = 0; vb < 2; ++vb) {
#pragma unroll
                for (int r = 0; r < 16; ++r) Sacc[kb][vb][r] *= pe[r];
#pragma unroll
                for (int s2 = 0; s2 < 2; ++s2) Sacc[kb][vb] = __builtin_amdgcn_mfma_f32_32x32x16_bf16(kf[s2], vf[s2][vb], Sacc[kb][vb], 0, 0, 0);
            }
        }
        LDS_WAIT(); asm volatile("" ::: "memory");
        tb += n;
    }
    char* send8 = (char*)((float*)(F.ws + WS_SEND2) + (size_t)(bh * HG_NSEG + seg) * 4096);
    const unsigned lsf = (unsigned)(4 * hi * 64 + r32) * 4u;
#pragma unroll
    for (int kb = 0; kb < 2; ++kb)
#pragma unroll
        for (int vb = 0; vb < 2; ++vb)
#pragma unroll
            for (int r = 0; r < 16; ++r) *(float*)(send8 + (size_t)((32 * kb + (r & 3) + 8 * (r >> 2)) * 256 + vb * 128) + lsf) = Sacc[kb][vb][r];
    ((float*)(F.ws + WS_PSEG))[(bh * HG_NSEG + seg) * 64 + lane] = Pseg;
}
__device__ __forceinline__ void hg_fix_phase(const Frame& F, int l) {
    const int lane = F.lane, r16 = lane & 15, q4 = lane >> 4, tid = F.tid;
    LAS bf16_t* ST = (LAS bf16_t*)(F.lds);
    const float* oraw = (const float*)(F.ws + WS_ORAW); const bf16_t* proj = (const bf16_t*)(F.ws + WS_PA); bf16_t* mixed = (bf16_t*)(F.ws + WS_MIXED);
    const bf16_t* QE = (const bf16_t*)(F.ws + WS_QE); const float* SEND = (const float*)(F.ws + WS_SEND2); const float* PSEG = (const float*)(F.ws + WS_PSEG);
    for (int uu = F.bid; uu < 32 * HG_NSEG * DUP(7); uu += F.G) {
        const int u = uu % (32 * HG_NSEG), seg = u % HG_NSEG, bh = u / HG_NSEG, b = bh >> 2, hd = bh & 3;
        if (seg > 0) {
            const int k = tid >> 3, v8 = (tid & 7) * 8; float S[8];
#pragma unroll
            for (int i = 0; i < 8; ++i) S[i] = 0.f;
#pragma unroll 4
            for (int sp = 0; sp < seg; ++sp) { const float P = PSEG[(bh * HG_NSEG + sp) * 64 + k]; const float* se = SEND + ((size_t)(bh * HG_NSEG + sp) * 64 + k) * 64 + v8;
                const f32x4 a = *(const f32x4*)se, c = *(const f32x4*)(se + 4);
                S[0] = P * S[0] + a[0]; S[1] = P * S[1] + a[1]; S[2] = P * S[2] + a[2]; S[3] = P * S[3] + a[3]; S[4] = P * S[4] + c[0]; S[5] = P * S[5] + c[1]; S[6] = P * S[6] + c[2]; S[7] = P * S[7] + c[3]; }
#pragma unroll
            for (int i = 0; i < 8; ++i) ST[(v8 + i) * 72 + k] = f2bf(S[i]);
        }
        __syncthreads();
        {
            const size_t tok0 = (size_t)b * SEQ + seg * HG_SEG + F.wave * 16;
            f32x4 acc[4];
#pragma unroll
            for (int vb = 0; vb < 4; ++vb) acc[vb] = (f32x4){0.f, 0.f, 0.f, 0.f};
            if (seg > 0) {
#pragma unroll
                for (int kst = 0; kst < 2; ++kst) { const bf16x8 af = __builtin_bit_cast(bf16x8, *(const u32x4*)(QE + (tok0 + r16) * 256 + hd * 64 + 32 * kst + 8 * q4));
#pragma unroll
                    for (int vb = 0; vb < 4; ++vb) { const bf16x8 bfv = *(const LAS bf16x8*)(ST + (vb * 16 + r16) * 72 + 32 * kst + 8 * q4); acc[vb] = __builtin_amdgcn_mfma_f32_16x16x32_bf16(af, bfv, acc[vb], 0, 0, 0); } }
            }
            float ss[4] = {0.f, 0.f, 0.f, 0.f};
#pragma unroll
            for (int vb = 0; vb < 4; ++vb)
#pragma unroll
                for (int r = 0; r < 4; ++r) { const size_t o = (tok0 + 4 * q4 + r) * 256 + hd * 64 + vb * 16 + r16;
                    float x = acc[vb][r];
#pragma unroll
                    for (int k4 = 0; k4 < HG_NPART; ++k4) x += oraw[(size_t)k4 * T * 256 + o];
                    acc[vb][r] = x; ss[r] += x * x; }
#pragma unroll
            for (int r = 0; r < 4; ++r) { float t = ss[r]; t += __shfl_xor(t, 1); t += __shfl_xor(t, 2); t += __shfl_xor(t, 4); t += __shfl_xor(t, 8); ss[r] = 1.0f / sqrtf(t * (1.0f / 64.0f) + RMS_EPS); }
#pragma unroll
            for (int vb = 0; vb < 4; ++vb) { const float gn = inp(F, I_hgrn_gain)[l * 256 + hd * 64 + vb * 16 + r16];
#pragma unroll
                for (int r = 0; r < 4; ++r) { const size_t tok = tok0 + 4 * q4 + r; const float g = bf2f(proj[tok * NPROJ + C_GG + hd * 64 + vb * 16 + r16]);
                    const float si = g * __builtin_amdgcn_rcpf(1.0f + __builtin_amdgcn_exp2f(-LOG2E * g)); mixed[tok * D + 512 + hd * 64 + vb * 16 + r16] = f2bf(acc[vb][r] * ss[r] * gn * si); } }
        }
        __syncthreads();
    }
}
constexpr int PL_ROW = 136, PL_BYTES = 64 * PL_ROW;
static_assert(NWAVES * PL_BYTES <= PH_BYTES, "pool LDS");
template <int W> __device__ __forceinline__ void pool_body(const Frame& F, int l, int b, int g, int seg) {
    const int lane = F.lane, r32 = lane & 31, hi = lane >> 5, t0 = seg * 64;
    LAS unsigned char* PT = F.lds + F.wave * PL_BYTES;
    const char* ub = (const char*)((const bf16_t*)(F.ws + WS_PA) + (size_t)b * SEQ * NPROJ + C_PU + g * 64);
    const unsigned lo2 = (unsigned)lane * 2u;
    float prev[16], cur[16];
#pragma unroll
    for (int i = 0; i < 16; ++i) { const int t = t0 - 16 + i; prev[i] = (t >= 0) ? bf2f(*(const bf16_t*)(ub + (size_t)(t < 0 ? 0 : t) * (NPROJ * 2) + lo2)) : 0.f; }
    float wsum = 0.f;
#pragma unroll
    for (int i = 1; i <= W; ++i) wsum += prev[16 - i];
#pragma unroll
    for (int ci = 0; ci < 4; ++ci) {
#pragma unroll
        for (int i = 0; i < 16; ++i) cur[i] = bf2f(*(const bf16_t*)(ub + (size_t)(t0 + 16 * ci + i) * (NPROJ * 2) + lo2));
#pragma unroll
        for (int i = 0; i < 16; ++i) { const float ut = cur[i]; wsum += ut; wsum -= (i - W >= 0) ? cur[(i - W >= 0) ? i - W : 0] : prev[(i - W >= 0) ? 0 : 16 + i - W];
            const int t = t0 + 16 * ci + i; const float pooled = wsum / (float)((t + 1 < W) ? (t + 1) : W) - ut;
            *(LAS bf16_t*)(PT + (16 * ci + i) * PL_ROW + lane * 2) = f2bf(pooled); }
#pragma unroll
        for (int i = 0; i < 16; ++i) prev[i] = cur[i];
    }
    LDS_WAIT(); asm volatile("" ::: "memory");
    const bf16_t* pwt = (const bf16_t*)(F.ws + WS_PWT) + (size_t)(l * 4 + g) * 4096;
    bf16x8 bw[2][4];
#pragma unroll
    for (int db = 0; db < 2; ++db)
#pragma unroll
        for (int st = 0; st < 4; ++st) bw[db][st] = __builtin_bit_cast(bf16x8, *(const u32x4*)(pwt + (32 * db + r32) * 64 + 16 * st + 8 * hi));
    char* ob = (char*)((bf16_t*)(F.ws + WS_MIXED) + ((size_t)b * SEQ + t0) * D + 768 + g * 64);
    const unsigned lof = (unsigned)(4 * hi * D + r32) * 2u;
#pragma unroll
    for (int tb2 = 0; tb2 < 2; ++tb2)
#pragma unroll
        for (int db = 0; db < 2; ++db) {
            f32x16 acc;
#pragma unroll
            for (int r = 0; r < 16; ++r) acc[r] = 0.f;
#pragma unroll
            for (int st = 0; st < 4; ++st) { const bf16x8 af = *(const LAS bf16x8*)(PT + (32 * tb2 + r32) * PL_ROW + (16 * st + 8 * hi) * 2); acc = __builtin_amdgcn_mfma_f32_32x32x16_bf16(af, bw[db][st], acc, 0, 0, 0); }
            const float psc = inp(F, I_pool_scale)[l * 256 + g * 64 + 32 * db + r32];
#pragma unroll
            for (int r = 0; r < 16; ++r) *(bf16_t*)(ob + (size_t)((32 * tb2 + (r & 3) + 8 * (r >> 2)) * D + 32 * db) * 2 + lof) = f2bf(acc[r] * psc);
        }
    LDS_WAIT(); asm volatile("" ::: "memory");
}
__device__ __forceinline__ void pool_unit(const Frame& F, int l, int u) {
    const int seg = u & 63, g = (u >> 6) & 3, b = u >> 8;
    if (g == 0) pool_body<2>(F, l, b, g, seg); else if (g == 1) pool_body<4>(F, l, b, g, seg); else if (g == 2) pool_body<8>(F, l, b, g, seg); else pool_body<16>(F, l, b, g, seg);
}

struct Args { const float* in[18]; float* out; unsigned char* ws; int ph_lo, ph_hi; };
constexpr int N_PHASES = 2 + 8 * NL;

__global__ void __launch_bounds__(NTHREADS, 2) trunk_fwd(Args args) {
    extern __shared__ __attribute__((aligned(16))) unsigned char lds_raw[];
    Frame F;
    F.lds = (LAS unsigned char*)lds_raw; F.ws = args.ws; F.ctl = (unsigned*)(args.ws + WS_CTL); F.out = args.out;
    F.tid = threadIdx.x; F.lane = F.tid & 63; F.wave = __builtin_amdgcn_readfirstlane(F.tid >> 6);
    for (int u = F.tid; u < (LDS_BYTES - LDSCTL_OFF) / 4; u += NTHREADS) ((LAS unsigned*)(F.lds + LDSCTL_OFF))[u] = 0u;
    __syncthreads();
    if (F.tid == 0) {
#pragma unroll
        for (int i = 0; i < 18; ++i) ((LAS unsigned long long*)(F.lds + LDSCTL_OFF + LC_INP))[i] = (unsigned long long)args.in[i];
    }
    __syncthreads();
    const int lo = args.ph_lo, hi = args.ph_hi; const bool use_bar = (hi - lo) > 1;
    XcdBarrier bar; bar.bar = F.ctl + CW_BAR; bar.x = 0; bar.st = nullptr;
    if (use_bar) bar = xcd_barrier_post(F.ctl + CW_BAR, (volatile LAS unsigned*)(F.lds + LDSCTL_OFF + LC_BAR));
#ifndef PHMASK
#define PHMASK 0xFFFF
#endif
#define PM(b) ((PHMASK >> (b)) & 1)
#define FRESH() do { int l_; asm volatile("v_mbcnt_lo_u32_b32 %0, -1, 0\n\tv_mbcnt_hi_u32_b32 %0, -1, %0" : "=v"(l_));     F.lane = l_; F.tid = F.wave * 64 + l_; int b_ = blockIdx.x, g_ = gridDim.x; asm volatile("" : "+s"(b_), "+s"(g_)); F.bid = b_; F.G = g_; } while (0)
#define IN(k) (lo <= (k) && (k) < hi)
#define SEAM(k) do { if (use_bar && (k) + 1 < hi) { int sl_; asm volatile("v_mbcnt_lo_u32_b32 %0, -1, 0\n\tv_mbcnt_hi_u32_b32 %0, -1, %0" : "=v"(sl_)); xcd_barrier(bar, F.wave == 0 && sl_ == 0); } } while (0)
    if (IN(0) && PM(0)) { for (int rep = 0; rep < DUP(5); ++rep) { FRESH(); p0_prologue(F); } SEAM(0); }
    for (int l = 0; l < NL; ++l) {
        const int pb = 1 + 8 * l;
        if (IN(pb + 0) && PM(1)) { FRESH(); if (l == 0) r_phase<0, false, false>(F, l, inp(F, I_x), F.out); else { if (DUP(6) > 1) r_phase<0, true, false, true>(F, l, F.out, F.out); r_phase<0, true, true>(F, l, F.out, F.out); } SEAM(pb + 0); }
        if (IN(pb + 1) && PM(2)) { FRESH();
            cumsum_step(F);
            pg8::StaticOrder S; S.init(T, NPROJ, D, F.G, F.bid, (const bf16_t*)(F.ws + WS_WIN + l * WIN_BYTES)); S.rep = DUP(2);
            pg8::EpiProj E{(bf16_t*)(F.ws + WS_PA), (const float*)(F.ws + WS_RSTD1), F.ctl + CW_KMAX + l * 64 * 16};
            pg8::gemm_phase<pg8::EpiProj, pg8::StaticOrder, true>(F.tid, F.lds, (const bf16_t*)(F.ws + WS_HB), D, S, E);
            SEAM(pb + 1);
        }
        if (IN(pb + 2) && PM(3)) { FRESH();
            const int gw = F.bid * NWAVES + F.wave, NGW = F.G * NWAVES;
            for (int u = gw; u < 2048; u += NGW) pool_unit(F, l, u);
            __syncthreads();
            if (F.wave < HG_WAVES) for (int u = F.wave * F.G + F.bid; u < 32 * HG_NSEG * DUP(0); u += HG_WAVES * F.G) hg_mfma_unit(F, l, u % (32 * HG_NSEG));
            __syncthreads();
            { LAS int* aq = (LAS int*)(F.lds + LDSCTL_OFF + LC_AQ);
              for (int rep = 0; rep < DUP(1); ++rep)
              for (;;) {
                if (F.tid == 0) aq[0] = (int)__hip_atomic_fetch_add(F.ctl + CW_AQ + 16 * (l + 4 * rep), 1u, __ATOMIC_RELAXED, __HIP_MEMORY_SCOPE_AGENT);
                __syncthreads();
                const int idx = aq[0];
                __syncthreads();
                if (idx >= 1024) break;
                attn_unit(F, l, (idx >> 3) & 7, idx & 7, 15 - (idx >> 6)); } }
            SEAM(pb + 2);
        }
        if (IN(pb + 3) && PM(4)) { FRESH(); hg_fix_phase(F, l); SEAM(pb + 3); }
        if (IN(pb + 4) && PM(5)) { FRESH();
            pg8::StaticOrder S; S.init(T, D, D, F.G, F.bid, (const bf16_t*)(F.ws + WS_WOUT + l * WOUT_BYTES));
            if (DUP(8) > 1) { pg8::EpiOut E0{l == 0 ? inp(F, I_x) : F.out, (float*)(F.ws + WS_Y)}; pg8::gemm_phase<pg8::EpiOut, pg8::StaticOrder, true>(F.tid, F.lds, (const bf16_t*)(F.ws + WS_MIXED), D, S, E0); }
            pg8::EpiOut E{l == 0 ? inp(F, I_x) : F.out, F.out};
            pg8::gemm_phase<pg8::EpiOut, pg8::StaticOrder, true>(F.tid, F.lds, (const bf16_t*)(F.ws + WS_MIXED), D, S, E);
            SEAM(pb + 4);
        }
        if (IN(pb + 5) && PM(6)) { FRESH(); if (DUP(6) > 1) r_phase<1, false, false, true>(F, l, F.out, F.out); r_phase<1, false, false>(F, l, F.out, F.out); SEAM(pb + 5); }
        if ((IN(pb + 6) && PM(7)) || (IN(pb + 7) && PM(8))) { FRESH();
            LAS int* tb = (LAS int*)(F.lds + LDSCTL_OFF + LC_TB); LAS int* cn = (LAS int*)(F.lds + LDSCTL_OFF + LC_CN);
            if (F.tid < NE) cn[F.tid] = (int)__hip_atomic_load(F.ctl + CW_CUR + (l * NE + F.tid) * 16, __ATOMIC_RELAXED, __HIP_MEMORY_SCOPE_AGENT);
            __syncthreads();
            if (F.tid == 0) { int a = 0; for (int e = 0; e < NE; ++e) { tb[e] = a; a += (cn[e] + 255) >> 8; } tb[NE] = a; }
            __syncthreads();
            const int ntile = tb[NE];
            if (IN(pb + 6) && PM(7)) {
                typedef pg8::MoeOrder<true, W1E_BYTES, (size_t)256 * D> Ord1; Ord1 S; S.rep = DUP(3); S.nM = ntile; S.nN = 2 * FF / 256; S.nwg = S.nM * S.nN; S.G = F.G; S.c = F.bid; S.Wt = (const char*)(F.ws + WS_W1 + (size_t)l * NE * W1E_BYTES);
                S.tb = tb; S.cn = cn; S.list = (const u32x2*)(F.ws + WS_LIST);
                pg8::EpiGlu E{(unsigned char*)(F.ws + WS_PA), (const u32x2*)(F.ws + WS_LIST), (const float*)(F.ws + WS_B1R) + (size_t)l * NE * 2048};
                pg8::gemm_phase<pg8::EpiGlu, Ord1, true, true>(F.tid, F.lds, F.ws + WS_HB8, D, S, E);
                SEAM(pb + 6);
            }
            if (IN(pb + 7) && PM(8)) { FRESH();
                typedef pg8::MoeOrder<false, W2E_BYTES, (size_t)256 * FF> Ord2; Ord2 S; S.rep = DUP(4); S.nM = ntile; S.nN = D / 256; S.nwg = S.nM * S.nN; S.G = F.G; S.c = F.bid; S.Wt = (const char*)(F.ws + WS_W2 + (size_t)l * NE * W2E_BYTES);
                S.tb = tb; S.cn = cn; S.list = (const u32x2*)(F.ws + WS_LIST);
                pg8::EpiDown E{(unsigned char*)(F.ws + WS_Y), (const u32x2*)(F.ws + WS_LIST), (const float*)(F.ws + WS_GATE), inp(F, I_b2) + (size_t)l * NE * D};
                pg8::gemm_phase<pg8::EpiDown, Ord2, true, true>(F.tid, F.lds, F.ws + WS_PA, FF, S, E);
                SEAM(pb + 7);
            }
        }
    }
    if (IN(N_PHASES - 1) && PM(9)) { FRESH(); r_final(F); }
#undef IN
#undef SEAM
}

extern "C" void kernel_launch(void* const* d_in, const int* in_sizes, int n_in, void* d_out, int out_size, void* d_ws, size_t ws_size, hipStream_t stream) {
    static int grid = 0;
    if (grid == 0) {
        if (n_in != 18 || out_size != T * D || ws_size < WS_END) { fprintf(stderr, "kernel_launch: unexpected shapes (n_in %d out %d ws %zu need %zu)\n", n_in, out_size, ws_size, (size_t)WS_END); grid = -1; return; }
        int dev = 0, cus = 0;
        if (hipGetDevice(&dev) != hipSuccess || hipDeviceGetAttribute(&cus, hipDeviceAttributeMultiprocessorCount, dev) != hipSuccess) { grid = -1; return; }
        if (hipFuncSetAttribute((const void*)trunk_fwd, hipFuncAttributeMaxDynamicSharedMemorySize, LDS_BYTES) != hipSuccess) { fprintf(stderr, "kernel_launch: hipFuncSetAttribute failed\n"); grid = -1; return; }
        int per_cu = 0;
        if (hipOccupancyMaxActiveBlocksPerMultiprocessor(&per_cu, (const void*)trunk_fwd, NTHREADS, LDS_BYTES) != hipSuccess || per_cu < 1) { fprintf(stderr, "kernel_launch: occupancy query says %d\n", per_cu); (void)hipGetLastError(); }
        grid = cus;
    }
    if (grid < 0) return;
    (void)hipMemsetAsync((char*)d_ws + WS_CTL, 0, CTL_ZERO_BYTES, stream);
    Args a{};
    for (int i = 0; i < 18; ++i) a.in[i] = (const float*)d_in[i];
    a.out = (float*)d_out; a.ws = (unsigned char*)d_ws;
#if MK_SPLIT
    for (int p = 0; p < N_PHASES; ++p) { a.ph_lo = p; a.ph_hi = p + 1; hipLaunchKernelGGL(trunk_fwd, dim3(grid), dim3(NTHREADS), LDS_BYTES, stream, a); }
#else
    a.ph_lo = 0; a.ph_hi = N_PHASES; hipLaunchKernelGGL(trunk_fwd, dim3(grid), dim3(NTHREADS), LDS_BYTES, stream, a);
#endif
}
```

```cpp
#include <hip/hip_runtime.h>
#include <cstdio>
#include <cstdint>

#ifndef MK_SPLIT
#define MK_SPLIT 0
#endif

#ifndef DUPMASK
#define DUPMASK 0
#endif
#define DUP(b) (1 + ((DUPMASK >> (b)) & 1))
#define LAS __attribute__((address_space(3)))
#define GAS __attribute__((address_space(1)))
typedef unsigned short bf16_t;
typedef short bf16x8 __attribute__((ext_vector_type(8)));
typedef float f32x4 __attribute__((ext_vector_type(4)));
typedef float f32x2 __attribute__((ext_vector_type(2)));
typedef float f32x16 __attribute__((ext_vector_type(16)));
typedef unsigned u32x4 __attribute__((ext_vector_type(4)));
typedef unsigned u32x2 __attribute__((ext_vector_type(2)));
typedef __bf16 bf16x2_t __attribute__((ext_vector_type(2)));
typedef short v4i16_t __attribute__((ext_vector_type(4)));
typedef int v8i __attribute__((ext_vector_type(8)));
struct bf16x8_pair { bf16x8 a, b; };

constexpr int NB = 8, SEQ = 4096, T = NB * SEQ, D = 1024, NL = 4;
constexpr int NPROJ = 2816;
constexpr int C_FQ = 0, C_FK = 512, C_FV = 1024, C_GQ = 1536, C_GF = 1792, C_GI = 2048, C_GG = 2304, C_PU = 2560;
constexpr int IN_COLS = 2824;
constexpr int NE = 32, TOPK = 4, FF = 1024, MROWS = T * TOPK, LISTCAP = MROWS, MAXTILES = MROWS / 256 + NE;
constexpr float RMS_EPS = 1e-5f, LOG2E = 1.4426950408889634f;
constexpr float QSCALE = 0.125f * LOG2E;
constexpr int NWAVES = 8, NTHREADS = 512;

constexpr size_t MiB = 1u << 20;
constexpr size_t WS_CTL = 0, CTL_ZERO_BYTES = 1 * MiB;
constexpr size_t WS_RSTD1 = 1 * MiB, WS_RSTD2 = WS_RSTD1 + 128 * 1024;
constexpr size_t WS_LOGF = 2 * MiB, WS_C2 = 3 * MiB, WS_GATE = 4 * MiB, WS_B1R = 5 * MiB, WS_WFRAG = 6 * MiB, WS_LIST = 8 * MiB;
constexpr size_t WS_WIN = 40 * MiB, WIN_BYTES = (size_t)NPROJ * D * 2;
constexpr size_t WS_WOUT = 62 * MiB, WOUT_BYTES = (size_t)D * D * 2;
constexpr size_t WS_W1 = 70 * MiB, W1E_BYTES = (size_t)2 * FF * D;
constexpr size_t WS_W2 = 582 * MiB, W2E_BYTES = (size_t)D * FF;
constexpr size_t WS_HB8 = 400 * MiB;
constexpr float W1_SCALE = 64.f, W2_SCALE = 128.f, ACT_SCALE = 4.f, Y_SCALE = 16.f;
constexpr size_t WS_HB = 838 * MiB;
constexpr size_t WS_PA = 902 * MiB;
constexpr size_t WS_MIXED = WS_PA + 176 * MiB;
constexpr size_t WS_Y = 1174 * MiB;
constexpr size_t WS_ORAW = 1430 * MiB;
constexpr size_t WS_SEND = 1558 * MiB;
constexpr size_t WS_PSEG = 1566 * MiB;
constexpr size_t WS_QE = 1567 * MiB;
constexpr size_t WS_PWT = 1583 * MiB;
constexpr size_t WS_SEND2 = 1584 * MiB;
constexpr size_t WS_END = 1600 * MiB;
static_assert(WS_WIN + NL * WIN_BYTES <= WS_WOUT && WS_WOUT + NL * WOUT_BYTES <= WS_W1 && WS_W1 + (size_t)NL * NE * W1E_BYTES <= WS_W2 && WS_W2 + (size_t)NL * NE * W2E_BYTES <= WS_HB, "ws map");
static_assert((size_t)MAXTILES * 256 * FF * 2 <= 272 * MiB && (size_t)T * NPROJ * 2 <= 176 * MiB, "ws map 2");
constexpr int CW_TMO = 0, CW_BAR = 4096, CW_CUR = 16384, CW_KMAX = 32768, CW_AQ = 40960;
constexpr int PH_BYTES = 139264, LDSCTL_OFF = PH_BYTES, LDS_BYTES = PH_BYTES + 2048;
static_assert(PH_BYTES >= 131072 + 512 * 16, "GEMM phase: stage buffers + parked A offsets");
constexpr int LC_BAR = 0, LC_TB = 64, LC_CN = 256, LC_R2CNT = 512, LC_R2BASE = 640, LC_STOP = 768, LC_SCAN = 896, LC_INP = 1024, LC_AQ = 1280;

__device__ __forceinline__ unsigned cvtpk(float lo, float hi) { f32x2 v = {lo, hi}; bf16x2_t b = __builtin_convertvector(v, bf16x2_t); return __builtin_bit_cast(unsigned, b); }
__device__ __forceinline__ float bflo(unsigned w) { return __uint_as_float(w << 16); }
__device__ __forceinline__ float bfhi(unsigned w) { return __uint_as_float(w & 0xffff0000u); }
__device__ __forceinline__ float bf2f(bf16_t h) { return __uint_as_float((unsigned)h << 16); }
__device__ __forceinline__ bf16_t f2bf(float f) { return (bf16_t)(cvtpk(f, 0.f) & 0xffffu); }
__device__ __forceinline__ float rdlane(float v, int l) { return __uint_as_float((unsigned)__builtin_amdgcn_readlane((int)__float_as_uint(v), l)); }
__device__ __forceinline__ unsigned pk4_fp8(float a, float b, float c, float d) { int w = __builtin_amdgcn_cvt_pk_fp8_f32(a, b, 0, false); w = __builtin_amdgcn_cvt_pk_fp8_f32(c, d, w, true); return (unsigned)w; }
__device__ __forceinline__ unsigned pk4_fp8_sat(float a, float b, float c, float d) {
    return pk4_fp8(__builtin_amdgcn_fmed3f(a, -448.f, 448.f), __builtin_amdgcn_fmed3f(b, -448.f, 448.f), __builtin_amdgcn_fmed3f(c, -448.f, 448.f), __builtin_amdgcn_fmed3f(d, -448.f, 448.f)); }
__device__ __forceinline__ f32x4 un4_fp8(unsigned w) { const f32x2 a = __builtin_amdgcn_cvt_pk_f32_fp8((int)w, false), b = __builtin_amdgcn_cvt_pk_f32_fp8((int)w, true); return (f32x4){a.x, a.y, b.x, b.y}; }
#define LDS_WAIT() asm volatile("s_waitcnt lgkmcnt(0)" ::: "memory")
#define VM_WAIT() asm volatile("s_waitcnt vmcnt(0)" ::: "memory")

namespace pg8 {
constexpr int BM = 256, BK = 64, HALF = 128, HTB = HALF * BK * 2, STAGE_BYTES = 8 * HTB, NXCD = 8, WGM = 8;
__host__ __device__ __forceinline__ int lds_byte(int r, int c) { const int st = (r >> 4) * 2 + (c >> 5), rr = r & 15, cc = c & 31, ob = rr * 64 + cc * 2; return st * 1024 + (ob ^ (((ob >> 9) & 1) << 5)); }
__host__ __device__ __forceinline__ void stage_rc(int b, int& R, int& C) { const int st = b / 1024, sb = b % 1024, swz = sb ^ (((sb >> 9) & 1) << 5); R = (st >> 1) * 16 + swz / 64; C = (st & 1) * 32 + (swz % 64) / 2; }
__host__ __device__ __forceinline__ int perm32(int rho) { const int n = rho >> 4, i = rho & 15; return 8 * (i >> 2) + 4 * n + (i & 3); }

struct Unit { int pm, pn, e, lt, cnt; };

__device__ __forceinline__ void tile_of(int L, int nM, int nN, int& pm, int& pn) {
    const int nwg = nM * nN; int wgid = L;
    { const int q = nwg / NXCD, r = nwg % NXCD, xcd = wgid % NXCD, off = wgid / NXCD; wgid = (xcd < r ? xcd * (q + 1) : r * (q + 1) + (xcd - r) * q) + off; }
    const int nig = WGM * nN, gid = wgid / nig, fm = gid * WGM, gsz = (nM - fm) < WGM ? (nM - fm) : WGM;
    pm = fm + ((wgid % nig) % gsz); pn = (wgid % nig) / gsz;
}
struct StaticOrder {
    int nM, nN, nwg, G, c, rep = 1; const char* Bt; size_t tstep;
    __device__ void init(int M, int N, int K, int G_, int c_, const bf16_t* Bt_) { nM = M / BM; nN = N / BM; nwg = nM * nN; G = G_; c = c_; Bt = (const char*)Bt_; tstep = (size_t)BM * K * 2; }
    __device__ __forceinline__ bool next(int i, Unit& u) const { long L = (long)i * G + c; if (L >= (long)nwg * rep) return false; L %= nwg; tile_of((int)L, nM, nN, u.pm, u.pn); u.e = 0; u.lt = 0; u.cnt = 0; return true; }
    __device__ __forceinline__ const char* bbase(const Unit& u) const { return Bt + (size_t)u.pn * tstep; }
    __device__ __forceinline__ int arow(const Unit& u, int r) const { return u.pm * BM + r; }
};
template <bool GATHER, size_t ESTRIDE, size_t TSTEP> struct MoeOrder {
    static constexpr size_t estride = ESTRIDE, tstep = TSTEP;
    int nM, nN, nwg, G, c, rep = 1; const char* Wt; LAS const int* tb; LAS const int* cn; const u32x2* list;
    __device__ __forceinline__ bool next(int i, Unit& u) const {
        long L = (long)i * G + c; if (L >= (long)nwg * rep) return false; L %= nwg; tile_of((int)L, nM, nN, u.pm, u.pn);
        int e = 0; while (e < NE - 1 && __builtin_amdgcn_readfirstlane(tb[e + 1]) <= u.pm) ++e;
        u.e = e; u.lt = u.pm - __builtin_amdgcn_readfirstlane(tb[e]); u.cnt = __builtin_amdgcn_readfirstlane(cn[e]); return true; }
    __device__ __forceinline__ const char* bbase(const Unit& u) const { return Wt + (size_t)u.e * estride + (size_t)u.pn * tstep; }
    __device__ __forceinline__ int arow(const Unit& u, int r) const {
        if (!GATHER) return u.pm * BM + r;
        const int pos = u.lt * BM + r; const char* lb = (const char*)(list + (size_t)u.e * LISTCAP);
        return pos < u.cnt ? (int)(*(const unsigned*)(lb + (unsigned)pos * 8u) >> 2) : 0; }
};

template <class Epi, class Sched, bool ALIGN_EPI, bool FP8 = false>
__device__ __forceinline__ void gemm_phase(const int tid, LAS unsigned char* lds, const void* Abase, const int  , const Sched& S, const Epi& E) {
    constexpr int K = 1024;
    const int wid = __builtin_amdgcn_readfirstlane(tid >> 6), lane = tid & 63, wr = wid >> 2, wc = wid & 3, fr = lane & 15, fq = lane >> 4;
    constexpr int rowB = FP8 ? K : 2 * K;
    constexpr int nt = rowB / (BK * 2);
    unsigned voffB[2];
#pragma unroll
    for (int i = 0; i < 2; ++i) { int R, C; stage_rc(tid * 16 + i * 8192, R, C); const int Rb = Epi::PERM ? ((R & ~31) + perm32(R & 31)) : R; voffB[i] = (unsigned)(Rb * rowB + C * 2); }
    constexpr size_t kstep = (size_t)(BK * 2);
    constexpr size_t hstep = (size_t)HALF * rowB;
    const unsigned ldsw = (unsigned)wid * 1024u;
    const int a8off = (fq >> 1) * 1024 + ((fr * 64 + 32 * (fq & 1)) ^ (((fr >> 3) & 1) << 5));
    const int aoff = FP8 ? (wr * 8192 + a8off) : lds_byte(wr * 64 + fr, fq * 8), boff = FP8 ? (wc * 4096 + a8off) : lds_byte(wc * 32 + fr, fq * 8);
    const char* A8 = (const char*)Abase;
#define PG8_SA(b, h) (((b) * 2 + (h)) * HTB)
#define PG8_SB(b, h) ((4 + (b) * 2 + (h)) * HTB)
#define PG8_STGB(bufoff, gbase) do { _Pragma("unroll") for (int _i = 0; _i < 2; ++_i) \
        __builtin_amdgcn_global_load_lds((const unsigned*)((const char*)(gbase) + voffB[_i]), (LAS unsigned*)(lds + (bufoff) + ldsw + _i * 8192), 16, 0, 0); } while (0)
#define PG8_STGA(bufoff, kb, o0, o1) do { \
        __builtin_amdgcn_global_load_lds((const unsigned*)(A8 + (size_t)(kb) + (o0)), (LAS unsigned*)(lds + (bufoff) + ldsw), 16, 0, 0); \
        __builtin_amdgcn_global_load_lds((const unsigned*)(A8 + (size_t)(kb) + (o1)), (LAS unsigned*)(lds + (bufoff) + ldsw + 8192), 16, 0, 0); } while (0)
#define PG8_LD8(off) __builtin_bit_cast(v8i, bf16x8_pair{*(const LAS bf16x8*)(lds + (off)), *(const LAS bf16x8*)(lds + (off) + 16)})
#define PG8_LDA(dst, b, h) do { if constexpr (FP8) { _Pragma("unroll") for (int m = 0; m < 4; ++m) dst##8[m] = PG8_LD8(PG8_SA(b, h) + aoff + m * 2048); } \
        else { _Pragma("unroll") for (int m = 0; m < 4; ++m) _Pragma("unroll") for (int k = 0; k < 2; ++k) dst[m][k] = *(const LAS bf16x8*)(lds + PG8_SA(b, h) + aoff + m * 2048 + k * 1024); } } while (0)
#define PG8_LDB(dst, b, h) do { if constexpr (FP8) { _Pragma("unroll") for (int n = 0; n < 2; ++n) dst##8[n] = PG8_LD8(PG8_SB(b, h) + boff + n * 2048); } \
        else { _Pragma("unroll") for (int n = 0; n < 2; ++n) _Pragma("unroll") for (int k = 0; k < 2; ++k) dst[n][k] = *(const LAS bf16x8*)(lds + PG8_SB(b, h) + boff + n * 2048 + k * 1024); } } while (0)
#define PG8_MMA(ai, bj, At, Bt) do { __builtin_amdgcn_s_setprio(1); _Pragma("unroll") for (int m = 0; m < 4; ++m) _Pragma("unroll") for (int n = 0; n < 2; ++n) { \
        if constexpr (FP8) asm volatile("v_mfma_f32_16x16x128_f8f6f4 %0, %1, %2, %0" : "+v"(acc[ai][bj][m][n]) : "v"(Bt##8[n]), "v"(At##8[m]));     \
        else { _Pragma("unroll") for (int k = 0; k < 2; ++k) acc[ai][bj][m][n] = __builtin_amdgcn_mfma_f32_16x16x32_bf16(Bt[n][k], At[m][k], acc[ai][bj][m][n], 0, 0, 0); } } __builtin_amdgcn_s_setprio(0); } while (0)
#define PG8_WAIT_V(n) asm volatile("s_waitcnt vmcnt(" #n ")" ::: "memory")
#define PG8_WAIT_L(n) asm volatile("s_waitcnt lgkmcnt(" #n ")" ::: "memory")
#define PG8_BAR __builtin_amdgcn_s_barrier()
#define PG8_SCHED __builtin_amdgcn_sched_barrier(0)
#define PG8_AOFF(u, dst) do { int t_ = tid; asm volatile("" : "+v"(t_));     \
        _Pragma("unroll") for (int _h = 0; _h < 2; ++_h) _Pragma("unroll") for (int _i = 0; _i < 2; ++_i) \
        { int R_, C_; stage_rc(t_ * 16 + _i * 8192, R_, C_); dst[_h][_i] = (unsigned)((size_t)S.arow(u, _h * HALF + R_) * (size_t)rowB + (size_t)(C_ * 2)); } } while (0)
    Unit cur, nxt; int ui = 0;
    if (!S.next(0, cur)) return;
    f32x4 acc[2][2][4][2];
#pragma unroll
    for (int a = 0; a < 2; ++a)
#pragma unroll
        for (int b = 0; b < 2; ++b)
#pragma unroll
            for (int m = 0; m < 4; ++m)
#pragma unroll
                for (int n = 0; n < 2; ++n) acc[a][b][m][n] = (f32x4){0.f, 0.f, 0.f, 0.f};
    bf16x8 At[4][2], B0[2][2], B1[2][2]; v8i At8[4], B08[2], B18[2];
    unsigned aoC[2][2], aoN[2][2];
    PG8_AOFF(cur, aoC);
    const char* cB = S.bbase(cur);
    PG8_STGB(PG8_SB(0, 0), cB); PG8_STGB(PG8_SB(0, 1), cB + hstep); PG8_STGA(PG8_SA(0, 0), 0, aoC[0][0], aoC[0][1]); PG8_STGA(PG8_SA(0, 1), 0, aoC[1][0], aoC[1][1]);
    if (wr == 1) PG8_BAR;
    PG8_WAIT_V(2); PG8_BAR;
    PG8_STGB(PG8_SB(1, 0), cB + kstep); PG8_STGA(PG8_SA(1, 0), kstep, aoC[0][0], aoC[0][1]); PG8_STGB(PG8_SB(1, 1), cB + hstep + kstep);
    PG8_WAIT_V(6); PG8_BAR;
    for (;;) {
        const bool has_next = S.next(ui + 1, nxt);
        if (has_next) { PG8_AOFF(nxt, aoN); } else { aoN[0][0] = aoC[0][0]; aoN[0][1] = aoC[0][1]; aoN[1][0] = aoC[1][0]; aoN[1][1] = aoC[1][1]; }
        *(LAS u32x4*)(lds + STAGE_BYTES + tid * 16) = (u32x4){aoN[0][0], aoN[0][1], aoN[1][0], aoN[1][1]};
        const char* nB = has_next ? S.bbase(nxt) : cB;
        for (int t = 0; t < nt; t += 2) {
            asm volatile("" : "+v"(voffB[0]), "+v"(voffB[1]));
            const bool last = (t == nt - 2);
            const size_t k1 = (size_t)(t + 1) * kstep, k2 = last ? 0 : (size_t)(t + 2) * kstep, k3 = k2 + kstep;
            const char* b2 = last ? nB : cB + (size_t)(t + 2) * kstep; const char* b3 = b2 + kstep;
            PG8_LDB(B0, 0, 0); PG8_LDB(B1, 0, 1); PG8_SCHED; PG8_LDA(At, 0, 0); PG8_STGA(PG8_SA(1, 1), k1, aoC[1][0], aoC[1][1]);
            PG8_WAIT_V(8); PG8_WAIT_L(0); PG8_BAR; PG8_MMA(0, 0, At, B0); PG8_MMA(0, 1, At, B1); PG8_BAR; PG8_SCHED;
            if (last) { const u32x4 nx = *(const LAS u32x4*)(lds + STAGE_BYTES + tid * 16); aoC[0][0] = nx.x; aoC[0][1] = nx.y; aoC[1][0] = nx.z; aoC[1][1] = nx.w; }
            PG8_LDA(At, 0, 1); PG8_STGB(PG8_SB(0, 0), b2); PG8_STGB(PG8_SB(0, 1), b2 + hstep); PG8_STGA(PG8_SA(0, 0), k2, aoC[0][0], aoC[0][1]);
            PG8_WAIT_V(8); PG8_WAIT_L(0); PG8_BAR; PG8_MMA(1, 0, At, B0); PG8_MMA(1, 1, At, B1); PG8_BAR; PG8_SCHED;
            PG8_LDB(B0, 1, 0); PG8_LDB(B1, 1, 1); PG8_SCHED; PG8_LDA(At, 1, 0); PG8_STGA(PG8_SA(0, 1), k2, aoC[1][0], aoC[1][1]);
            PG8_WAIT_V(8); PG8_WAIT_L(0); PG8_BAR; PG8_MMA(0, 0, At, B0); PG8_MMA(0, 1, At, B1); PG8_BAR; PG8_SCHED;
            PG8_LDA(At, 1, 1); PG8_STGB(PG8_SB(1, 0), b3); PG8_STGB(PG8_SB(1, 1), b3 + hstep); PG8_STGA(PG8_SA(1, 0), k3, aoC[0][0], aoC[0][1]);
            PG8_WAIT_V(8); PG8_WAIT_L(0); PG8_BAR; PG8_MMA(1, 0, At, B0); PG8_MMA(1, 1, At, B1); PG8_BAR; PG8_SCHED;
        }
        if constexpr (FP8) asm volatile("s_nop 15\n\ts_nop 15" ::: "memory");
        if constexpr (ALIGN_EPI) { if (wr == 0) PG8_BAR; }
        { int t2_ = tid; asm volatile("" : "+v"(t2_)); const int l2_ = t2_ & 63; E(acc, cur, wr, wc, l2_ & 15, l2_ >> 4); }
        if (!has_next) break;
#pragma unroll
        for (int a = 0; a < 2; ++a)
#pragma unroll
            for (int b = 0; b < 2; ++b)
#pragma unroll
                for (int m = 0; m < 4; ++m)
#pragma unroll
                    for (int n = 0; n < 2; ++n) acc[a][b][m][n] = (f32x4){0.f, 0.f, 0.f, 0.f};
        cur = nxt; cB = nB; ++ui;
        if constexpr (ALIGN_EPI) { if (wr == 1) PG8_BAR; }
    }
    PG8_WAIT_V(0);
    if constexpr (!ALIGN_EPI) { if (wr == 0) PG8_BAR; }
    PG8_BAR;
#undef PG8_SA
#undef PG8_SB
#undef PG8_STGA
#undef PG8_STGB
#undef PG8_LDA
#undef PG8_LD8
#undef PG8_LDB
#undef PG8_MMA
#undef PG8_WAIT_V
#undef PG8_WAIT_L
#undef PG8_BAR
#undef PG8_SCHED
#undef PG8_AOFF
}

struct EpiProj {
    static constexpr bool PERM = true;
    bf16_t* O; const float* rstd; unsigned* kmax;
    __device__ __forceinline__ void operator()(const f32x4 (&acc)[2][2][4][2], const Unit& u, int wr, int wc, int fr, int fq) const {
        const int row0 = u.pm * BM + wr * 64 + fr, col0 = u.pn * BM + wc * 32 + 8 * fq;
        const float sc = (u.pn < 2) ? QSCALE : 1.f; const bool isk = (u.pn == 2 || u.pn == 3);
        float km[2] = {0.f, 0.f}; float rsv[8];
#pragma unroll
        for (int g = 0; g < 8; ++g) rsv[g] = rstd[row0 + (g >> 2) * HALF + (g & 3) * 16] * sc;
#pragma unroll
        for (int ai = 0; ai < 2; ++ai)
#pragma unroll
            for (int m = 0; m < 4; ++m) { const int row = row0 + ai * HALF + m * 16; const float rs = rsv[ai * 4 + m]; bf16_t* rowp = O + (size_t)row * NPROJ + col0;
#pragma unroll
                for (int bj = 0; bj < 2; ++bj) { const f32x4 v0 = acc[ai][bj][m][0] * rs, v1 = acc[ai][bj][m][1] * rs;
                    u32x4 w; w.x = cvtpk(v0[0], v0[1]); w.y = cvtpk(v0[2], v0[3]); w.z = cvtpk(v1[0], v1[1]); w.w = cvtpk(v1[2], v1[3]);
                    *(u32x4*)(rowp + bj * HALF) = w;
                    if (isk) { float s = bflo(w.x) * bflo(w.x) + bfhi(w.x) * bfhi(w.x) + bflo(w.y) * bflo(w.y) + bfhi(w.y) * bfhi(w.y) + bflo(w.z) * bflo(w.z) + bfhi(w.z) * bfhi(w.z) + bflo(w.w) * bflo(w.w) + bfhi(w.w) * bfhi(w.w);
                        s += __shfl_xor(s, 16); s += __shfl_xor(s, 32); km[bj] = fmaxf(km[bj], s); } } }
        if (isk) {
#pragma unroll
            for (int bj = 0; bj < 2; ++bj) { float v = km[bj]; v = fmaxf(v, __shfl_xor(v, 1)); v = fmaxf(v, __shfl_xor(v, 2)); v = fmaxf(v, __shfl_xor(v, 4)); v = fmaxf(v, __shfl_xor(v, 8));
                if ((threadIdx.x & 63) == 0) { const int b = u.pm >> 4, h = (u.pn - 2) * 4 + bj * 2 + (wc >> 1); atomicMax(kmax + (b * 8 + h) * 16, __float_as_uint(v)); } }
        }
    }
};
struct EpiOut {
    static constexpr bool PERM = false;
    const float* res; float* out;
    __device__ __forceinline__ void operator()(const f32x4 (&acc)[2][2][4][2], const Unit& u, int wr, int wc, int fr, int fq) const {
        const int row0 = u.pm * BM + wr * 64 + fr, col0 = u.pn * BM + wc * 32 + 4 * fq;
        f32x4 r[2][4];
#pragma unroll
        for (int q = 0; q < 4; ++q) r[0][q] = *(const f32x4*)(res + (size_t)row0 * D + col0 + (q >> 1) * HALF + (q & 1) * 16);
#pragma unroll
        for (int g = 0; g < 8; ++g) { const int ai = g >> 2, m = g & 3; const size_t off = (size_t)(row0 + ai * HALF + m * 16) * D + col0;
            if (g + 1 < 8) { const int ai2 = (g + 1) >> 2, m2 = (g + 1) & 3; const size_t off2 = (size_t)(row0 + ai2 * HALF + m2 * 16) * D + col0;
#pragma unroll
                for (int q = 0; q < 4; ++q) r[(g + 1) & 1][q] = *(const f32x4*)(res + off2 + (q >> 1) * HALF + (q & 1) * 16); }
#pragma unroll
            for (int q = 0; q < 4; ++q) *(f32x4*)(out + off + (q >> 1) * HALF + (q & 1) * 16) = r[g & 1][q] + acc[ai][q >> 1][m][q & 1]; }
    }
};
struct EpiGlu {
    static constexpr bool PERM = true;
    unsigned char* act; const u32x2* list; const float* b1r;
    __device__ __forceinline__ void operator()(const f32x4 (&acc)[2][2][4][2], const Unit& u, int wr, int wc, int fr, int fq) const {
        const int cb = u.pn * BM + wc * 32 + 8 * fq; const float* bp = b1r + (size_t)u.e * 2048 + cb; const char* lbase = (const char*)(list + (size_t)u.e * LISTCAP);
        float rsv[8];
#pragma unroll
        for (int g = 0; g < 8; ++g) { const int pos = u.lt * BM + (g >> 2) * HALF + wr * 64 + (g & 3) * 16 + fr; rsv[g] = 0.f; if (pos < u.cnt) rsv[g] = __uint_as_float(*(const unsigned*)(lbase + (unsigned)pos * 8u + 4u)) * (1.0f / W1_SCALE); }
        const f32x4 bg0 = *(const f32x4*)(bp), bg1 = *(const f32x4*)(bp + 4), bl0 = *(const f32x4*)(bp + HALF), bl1 = *(const f32x4*)(bp + HALF + 4);
#pragma unroll
        for (int ai = 0; ai < 2; ++ai)
#pragma unroll
            for (int m = 0; m < 4; ++m) { const int r = ai * HALF + wr * 64 + m * 16 + fr;
                const float rs = rsv[ai * 4 + m];
                float o[8];
                const f32x2 rs2 = {rs, rs};
#pragma unroll
                for (int p = 0; p < 4; ++p) {
                    const f32x4& ag = acc[ai][0][m][p >> 1]; const f32x4& al = acc[ai][1][m][p >> 1]; const f32x4& bgv = (p >> 1) ? bg1 : bg0; const f32x4& blv = (p >> 1) ? bl1 : bl0; const int q = 2 * (p & 1);
                    f32x2 g = (f32x2){ag[q], ag[q + 1]} * rs2 + (f32x2){bgv[q], bgv[q + 1]}, li = (f32x2){al[q], al[q + 1]} * rs2 + (f32x2){blv[q], blv[q + 1]};
                    g.x = __builtin_fminf(g.x, 7.f); g.y = __builtin_fminf(g.y, 7.f); li.x = __builtin_amdgcn_fmed3f(li.x, -7.f, 7.f); li.y = __builtin_amdgcn_fmed3f(li.y, -7.f, 7.f);
                    const f32x2 ea = g * (-1.702f * LOG2E); f32x2 d; d.x = __builtin_amdgcn_exp2f(ea.x); d.y = __builtin_amdgcn_exp2f(ea.y); d = d + 1.0f;
                    f32x2 rc; rc.x = __builtin_amdgcn_rcpf(d.x); rc.y = __builtin_amdgcn_rcpf(d.y);
                    const f32x2 tt = li * ACT_SCALE + ACT_SCALE, oo = (g * tt) * rc;
                    o[2 * p] = oo.x; o[2 * p + 1] = oo.y; }
                *(u32x2*)(act + (size_t)(u.pm * BM + r) * FF + u.pn * HALF + wc * 32 + 8 * fq) = (u32x2){pk4_fp8(o[0], o[1], o[2], o[3]), pk4_fp8(o[4], o[5], o[6], o[7])}; }
    }
};
struct EpiDown {
    static constexpr bool PERM = true;
    unsigned char* Y; const u32x2* list; const float* gate; const float* b2;
    __device__ __forceinline__ void operator()(const f32x4 (&acc)[2][2][4][2], const Unit& u, int wr, int wc, int fr, int fq) const {
        const int cb = u.pn * BM + wc * 32 + 8 * fq; const float* bp = b2 + (size_t)u.e * D + cb;
        f32x4 bv[2][2];
#pragma unroll
        for (int bj = 0; bj < 2; ++bj)
#pragma unroll
            for (int n = 0; n < 2; ++n) bv[bj][n] = *(const f32x4*)(bp + bj * HALF + 4 * n);
        unsigned entv[8]; float gtv[8];
#pragma unroll
        for (int g = 0; g < 8; ++g) { const int pos = u.lt * BM + (g >> 2) * HALF + wr * 64 + (g & 3) * 16 + fr; entv[g] = (pos < u.cnt) ? list[(size_t)u.e * LISTCAP + pos].x : 0xffffffffu; }
#pragma unroll
        for (int g = 0; g < 8; ++g) gtv[g] = (entv[g] != 0xffffffffu) ? gate[entv[g]] * Y_SCALE : 0.f;
#pragma unroll
        for (int ai = 0; ai < 2; ++ai)
#pragma unroll
            for (int m = 0; m < 4; ++m) {
                if (entv[ai * 4 + m] != 0xffffffffu) { const unsigned ent = entv[ai * 4 + m]; const float gt = gtv[ai * 4 + m]; unsigned char* rowp = Y + (size_t)ent * D + cb;
#pragma unroll
                    for (int bj = 0; bj < 2; ++bj) { const f32x4 v0 = (acc[ai][bj][m][0] * (1.0f / (W2_SCALE * ACT_SCALE)) + bv[bj][0]) * gt, v1 = (acc[ai][bj][m][1] * (1.0f / (W2_SCALE * ACT_SCALE)) + bv[bj][1]) * gt;
                        *(u32x2*)(rowp + bj * HALF) = (u32x2){pk4_fp8_sat(v0[0], v0[1], v0[2], v0[3]), pk4_fp8_sat(v1[0], v1[1], v1[2], v1[3])}; } } }
    }
};
}

#define XB_TMO      128
#define XB_XCNT(j)  (256  + 64 * (j))
#define XB_XSUB(j)  (1280 + 64 * (j))
#define XB_XGEN(j)  (2304 + 64 * (j))
#define XB_TOP      3328
#define XB_TOPGEN   3392
#define XCD_BAR_WORDS 3456
#define XB_SPIN_CAP (1u << 18)
__device__ __forceinline__ unsigned xb_ld(unsigned* p)              { return __hip_atomic_load(p, __ATOMIC_RELAXED, __HIP_MEMORY_SCOPE_AGENT); }
__device__ __forceinline__ unsigned xb_add(unsigned* p, unsigned v) { return __hip_atomic_fetch_add(p, v, __ATOMIC_RELAXED, __HIP_MEMORY_SCOPE_AGENT); }
__device__ __forceinline__ unsigned xb_xcc_id() { return (unsigned)__builtin_amdgcn_s_getreg((3 << 11) | 20) & 0xFu; }
#define XB_SPIN(cond, bar) do { unsigned _sp = 0; while (cond) { __builtin_amdgcn_s_sleep(1); \
    if ((++_sp & 255u) == 0u) { if (xb_ld(&(bar)[XB_TMO])) break; if (_sp > XB_SPIN_CAP) { atomicAdd(&(bar)[XB_TMO], 1u); break; } } } } while (0)
struct XcdBarrier { unsigned* bar; unsigned x; volatile LAS unsigned* st; };
__device__ __forceinline__ XcdBarrier xcd_barrier_post(unsigned* bar, volatile LAS unsigned* st) {
    XcdBarrier b; b.bar = bar; b.x = xb_xcc_id(); b.st = st;
    if (threadIdx.x == 0) (void)xb_add(&bar[XB_XCNT(b.x)], 1u);
    return b;
}
__device__ __forceinline__ void xcd_barrier_complete(unsigned* bar, unsigned x, unsigned& nloc, unsigned& nx) {
    const unsigned G = gridDim.x * gridDim.y * gridDim.z;
    unsigned sum, cnt, mine, sp = 0u;
    for (;;) {
        sum = 0u; cnt = 0u; mine = 0u;
#pragma unroll
        for (unsigned j = 0; j < 16; ++j) { const unsigned c = xb_ld(&bar[XB_XCNT(j)]); sum += c; cnt += (c > 0u) ? 1u : 0u; mine = (j == x) ? c : mine; }
        if (sum == G) break;
        __builtin_amdgcn_s_sleep(1);
        if ((++sp & 255u) == 0u) { if (xb_ld(&bar[XB_TMO])) break; if (sp > XB_SPIN_CAP) { atomicAdd(&bar[XB_TMO], 1u); break; } }
    }
    nloc = mine > 0u ? mine : 1u; nx = cnt > 0u ? cnt : 1u;
}
__device__ __forceinline__ void xcd_barrier(const XcdBarrier& b, const bool leader  ) {
    asm volatile("s_waitcnt vmcnt(0)" ::: "memory");
    __syncthreads();
    if (leader) {
        unsigned* bar = b.bar;
        __builtin_amdgcn_s_waitcnt(0);
        unsigned nloc = b.st[0], nx = b.st[1];
        if (nloc == 0u) { xcd_barrier_complete(bar, b.x, nloc, nx); b.st[0] = nloc; b.st[1] = nx; }
        const unsigned old = xb_add(&bar[XB_XSUB(b.x)], 1u);
        const unsigned gen = old / nloc;
        if (old + 1u == (gen + 1u) * nloc) {
            __builtin_amdgcn_fence(__ATOMIC_RELEASE, "agent");
            asm volatile("s_waitcnt vmcnt(0)" ::: "memory");
            const unsigned og = xb_add(&bar[XB_TOP], 1u);
            const unsigned tg = og / nx;
            if (og + 1u == (tg + 1u) * nx) xb_add(&bar[XB_TOPGEN], 1u);
            else XB_SPIN(xb_ld(&bar[XB_TOPGEN]) == tg, bar);
            __builtin_amdgcn_fence(__ATOMIC_ACQUIRE, "agent");
            xb_add(&bar[XB_XGEN(b.x)], 1u);
            asm volatile("s_waitcnt vmcnt(0)" ::: "memory");
        } else {
            XB_SPIN(xb_ld(&bar[XB_XGEN(b.x)]) == gen, bar);
            __builtin_amdgcn_fence(__ATOMIC_ACQUIRE, "agent");
            asm volatile("s_waitcnt vmcnt(0)" ::: "memory");
        }
    }
    __syncthreads();
}

enum { I_x = 0, I_norm_mix, I_w_in, I_b_fox_f, I_fox_gain, I_hgrn_lb, I_hgrn_gain, I_pool_w, I_pool_scale, I_w_out, I_norm_moe, I_w_router, I_b_router, I_w1, I_b1, I_w2, I_b2, I_norm_final };
struct Frame {
    LAS unsigned char* lds; unsigned char* ws; unsigned* ctl; float* out;
    int tid, lane, wave, bid, G;
};
__device__ __forceinline__ const float* inp(const Frame& F, int i) {
    const LAS unsigned* p = (const LAS unsigned*)(F.lds + LDSCTL_OFF + LC_INP) + 2 * i;
    const unsigned lo = __builtin_amdgcn_readfirstlane(p[0]), hi = __builtin_amdgcn_readfirstlane(p[1]);
    return (const float*)(((unsigned long long)hi << 32) | lo);
}

constexpr int P0_ROWB = 272;
template <bool INTERLEAVED, bool OUT8 = false>
__device__ __forceinline__ void p0_item(const float* src  , int ldn, const float* g  , void* dstv  , int K, int drow0, int extra, LAS unsigned char* tile, int lane, float scale = 1.f) {
    bf16_t* dst = (bf16_t*)dstv; unsigned char* dst8 = (unsigned char*)dstv;
    f32x4 v[16];
    const float* sp = src + (size_t)(lane >> 5) * ldn + 4 * (lane & 31);
#pragma unroll
    for (int j = 0; j < 16; ++j) v[j] = __builtin_nontemporal_load((const f32x4*)(sp + (size_t)(2 * j) * ldn));
    if (g) {
#pragma unroll
        for (int j = 0; j < 16; ++j) v[j] = v[j] * (g[2 * j + (lane >> 5)] * scale);
    } else if (OUT8) {
#pragma unroll
        for (int j = 0; j < 16; ++j) v[j] = v[j] * scale;
    }
#pragma unroll
    for (int j = 0; j < 16; ++j) { const int k = 2 * j + (lane >> 5); const unsigned w0 = cvtpk(v[j][0], v[j][1]), w1 = cvtpk(v[j][2], v[j][3]);
        if (INTERLEAVED) { const unsigned gg = (w0 & 0xffffu) | (w1 << 16), ll = (w0 >> 16) | (w1 & 0xffff0000u);
            *(LAS unsigned*)(tile + k * P0_ROWB + 4 * (lane & 31)) = gg; *(LAS unsigned*)(tile + k * P0_ROWB + 128 + 4 * (lane & 31)) = ll; }
        else *(LAS u32x2*)(tile + k * P0_ROWB + 8 * (lane & 31)) = (u32x2){w0, w1}; }
    LDS_WAIT(); asm volatile("" ::: "memory");
    const int gq = lane >> 4, i16 = lane & 15;
    const LAS unsigned char* rp = tile + (8 * gq + (i16 >> 2)) * P0_ROWB + 8 * (lane & 3);
#pragma unroll
    for (int nb = 0; nb < 8; ++nb) {
        const v4i16_t lo = __builtin_amdgcn_ds_read_tr16_b64_v4i16((LAS v4i16_t*)(rp + nb * 32)), hi = __builtin_amdgcn_ds_read_tr16_b64_v4i16((LAS v4i16_t*)(rp + nb * 32 + 4 * P0_ROWB));
        const int tc = nb * 16 + i16, row = drow0 + tc + (tc >= 64 ? extra : 0);
        if (OUT8) { *(u32x2*)(dst8 + (size_t)row * K + 8 * gq) = (u32x2){pk4_fp8(bf2f((bf16_t)lo[0]), bf2f((bf16_t)lo[1]), bf2f((bf16_t)lo[2]), bf2f((bf16_t)lo[3])), pk4_fp8(bf2f((bf16_t)hi[0]), bf2f((bf16_t)hi[1]), bf2f((bf16_t)hi[2]), bf2f((bf16_t)hi[3]))}; }
        else { const bf16x8 o = (bf16x8){lo[0], lo[1], lo[2], lo[3], hi[0], hi[1], hi[2], hi[3]};
            *(bf16x8*)(dst + (size_t)row * K + 8 * gq) = o; } }
    LDS_WAIT(); asm volatile("" ::: "memory");
}
__device__ __forceinline__ void p0_prologue(const Frame& F) {
    LAS unsigned char* tile = F.lds + F.wave * (32 * P0_ROWB);
    const int gw = F.bid * NWAVES + F.wave, NGW = F.G * NWAVES;
    constexpr int I_IN = 32 * 22, I_OUT = 32 * 8, I_W1 = NE * 32 * 16, I_W2 = NE * 32 * 8, I_L = I_IN + I_OUT + I_W1 + I_W2;
    for (int it = gw; it < NL * I_L; it += NGW) {
        const int l = it / I_L; int r = it % I_L;
        if (r < I_IN) { const int nb = r / 32, kb = r % 32, n0 = 128 * nb, k0 = 32 * kb;
            p0_item<false>(inp(F, I_w_in) + ((size_t)l * D + k0) * IN_COLS + n0 + (n0 >= 1536 ? 8 : 0), IN_COLS, inp(F, I_norm_mix) + l * D + k0, (bf16_t*)(F.ws + WS_WIN + l * WIN_BYTES) + k0, D, n0, 0, tile, F.lane); continue; }
        r -= I_IN;
        if (r < I_OUT) { const int nb = r / 32, kb = r % 32, n0 = 128 * nb, k0 = 32 * kb;
            p0_item<false>(inp(F, I_w_out) + ((size_t)l * D + k0) * D + n0, D, nullptr, (bf16_t*)(F.ws + WS_WOUT + l * WOUT_BYTES) + k0, D, n0, 0, tile, F.lane); continue; }
        r -= I_OUT;
        if (r < I_W1) { const int e = r / (32 * 16), q = r % (32 * 16), cb = q / 32, kb = q % 32, k0 = 32 * kb, j0 = 64 * cb;
            p0_item<true, true>(inp(F, I_w1) + (((size_t)l * NE + e) * D + k0) * (2 * FF) + 2 * j0, 2 * FF, inp(F, I_norm_moe) + l * D + k0, F.ws + WS_W1 + ((size_t)l * NE + e) * W1E_BYTES + k0, D, (j0 >> 7) * 256 + (j0 & 127), 64, tile, F.lane, W1_SCALE); continue; }
        r -= I_W1;
        { const int e = r / (32 * 8), q = r % (32 * 8), nb = q / 32, kb = q % 32, n0 = 128 * nb, k0 = 32 * kb;
            p0_item<false, true>(inp(F, I_w2) + (((size_t)l * NE + e) * FF + k0) * D + n0, D, nullptr, F.ws + WS_W2 + ((size_t)l * NE + e) * W2E_BYTES + k0, FF, n0, 0, tile, F.lane, W2_SCALE); }
    }
    const int gt = F.bid * NTHREADS + F.tid, NGT = F.G * NTHREADS;
    float* b1r = (float*)(F.ws + WS_B1R);
    for (int i = gt; i < NL * NE * 2048; i += NGT) { const int le = i >> 11, n = i & 2047, pn = n >> 8, rr = n & 255; b1r[i] = inp(F, I_b1)[(size_t)le * 2048 + 2 * (128 * pn + (rr & 127)) + (rr >> 7)]; }
    { bf16_t* pwt = (bf16_t*)(F.ws + WS_PWT);
      for (int i = gt; i < NL * 4 * 64 * 64; i += NGT) { const int c = i & 63, d = (i >> 6) & 63, lg = i >> 12; pwt[i] = f2bf(inp(F, I_pool_w)[((size_t)lg * 64 + c) * 64 + d]); } }
    bf16_t* wf = (bf16_t*)(F.ws + WS_WFRAG);
    for (int i = gt; i < NL * 2 * 32 * 2 * 64 * 8; i += NGT) {
        const int j = i & 7, ln = (i >> 3) & 63, et = (i >> 9) & 1, ks = (i >> 10) & 31, kind = (i >> 15) & 1, l = i >> 16;
        const int e = 16 * et + (ln & 15), k = 32 * ks + 8 * (ln >> 4) + j;
        float v;
        if (kind == 0) v = (e < 8) ? inp(F, I_norm_mix)[l * D + k] * inp(F, I_w_in)[((size_t)l * D + k) * IN_COLS + 1536 + e] : 0.f;
        else v = inp(F, I_norm_moe)[l * D + k] * inp(F, I_w_router)[((size_t)l * D + k) * NE + e];
        const bf16_t h = f2bf(v), lo = f2bf(v - bf2f(h));
        const size_t base = ((((size_t)(l * 2 + kind) * 32 + ks) * 2 + et) * 2) * 512 + ln * 8 + j;
        wf[base] = h; wf[base + 512] = lo;
    }
}

template <int KIND, bool COMBINE, bool WRITE_H, bool DRY = false>
__device__ __forceinline__ void r_phase(const Frame& F, int l, const float* hin, float* hout) {
    const int lane = F.lane, r16 = lane & 15, q4 = lane >> 4;
    const u32x4* Wf = (const u32x4*)(F.ws + WS_WFRAG + (size_t)(l * 2 + KIND) * 131072);
    const bf16_t* Y = (const bf16_t*)(F.ws + WS_Y);
    bf16_t* HB = (bf16_t*)(F.ws + WS_HB);
    float* rstdp = (float*)(F.ws + (KIND == 0 ? WS_RSTD1 : WS_RSTD2));
    LAS float* lg = (LAS float*)(F.lds) + F.wave * (16 * 33);
    LAS int* r2cnt = (LAS int*)(F.lds + LDSCTL_OFF + LC_R2CNT); LAS int* r2base = (LAS int*)(F.lds + LDSCTL_OFF + LC_R2BASE);
    for (int task = F.bid; task < T / 128; task += F.G) {
        const int tok = task * 128 + F.wave * 16 + r16;
        const float* xr = hin + (size_t)tok * D + 8 * q4; float* ho = hout + (size_t)tok * D + 8 * q4;
        const unsigned char* yr = (const unsigned char*)Y + (size_t)tok * 4 * D + 8 * q4; bf16_t* hbr = HB + (size_t)tok * D + 8 * q4;
        f32x4 acc0 = {0.f, 0.f, 0.f, 0.f}, acc1 = {0.f, 0.f, 0.f, 0.f}; float ssq = 0.f;
        if (KIND == 1) { if (F.tid < 32) r2cnt[F.tid] = 0; }
#pragma unroll 2
        for (int ks = 0; ks < 32; ++ks) {
            f32x4 x0 = *(const f32x4*)(xr + 32 * ks), x1 = *(const f32x4*)(xr + 32 * ks + 4);
            if (COMBINE) {
#pragma unroll
                for (int k = 0; k < 4; ++k) { const u32x2 y = *(const u32x2*)(yr + (size_t)k * D + 32 * ks);
                    x0 += un4_fp8(y.x) * (1.0f / Y_SCALE); x1 += un4_fp8(y.y) * (1.0f / Y_SCALE); }
            }
            if (WRITE_H) { *(f32x4*)(ho + 32 * ks) = x0; *(f32x4*)(ho + 32 * ks + 4) = x1; }
            ssq += (x0[0] * x0[0] + x0[1] * x0[1]) + (x0[2] * x0[2] + x0[3] * x0[3]) + (x1[0] * x1[0] + x1[1] * x1[1]) + (x1[2] * x1[2] + x1[3] * x1[3]);
            u32x4 hw; hw.x = cvtpk(x0[0], x0[1]); hw.y = cvtpk(x0[2], x0[3]); hw.z = cvtpk(x1[0], x1[1]); hw.w = cvtpk(x1[2], x1[3]);
            u32x4 lw; lw.x = cvtpk(x0[0] - bflo(hw.x), x0[1] - bfhi(hw.x)); lw.y = cvtpk(x0[2] - bflo(hw.y), x0[3] - bfhi(hw.y)); lw.z = cvtpk(x1[0] - bflo(hw.z), x1[1] - bfhi(hw.z)); lw.w = cvtpk(x1[2] - bflo(hw.w), x1[3] - bfhi(hw.w));
            if (KIND == 0) *(u32x4*)(hbr + 32 * ks) = hw;
            else *(u32x2*)((unsigned char*)(F.ws + WS_HB8) + (size_t)tok * D + 8 * q4 + 32 * ks) = (u32x2){pk4_fp8_sat(x0[0], x0[1], x0[2], x0[3]), pk4_fp8_sat(x1[0], x1[1], x1[2], x1[3])};
            const bf16x8 xh = __builtin_bit_cast(bf16x8, hw), xl = __builtin_bit_cast(bf16x8, lw);
            const bf16x8 wh0 = __builtin_bit_cast(bf16x8, Wf[((ks * 2 + 0) * 2 + 0) * 64 + lane]), wl0 = __builtin_bit_cast(bf16x8, Wf[((ks * 2 + 0) * 2 + 1) * 64 + lane]);
            acc0 = __builtin_amdgcn_mfma_f32_16x16x32_bf16(wh0, xh, acc0, 0, 0, 0);
            acc0 = __builtin_amdgcn_mfma_f32_16x16x32_bf16(wl0, xh, acc0, 0, 0, 0);
            acc0 = __builtin_amdgcn_mfma_f32_16x16x32_bf16(wh0, xl, acc0, 0, 0, 0);
            if (KIND == 1) {
                const bf16x8 wh1 = __builtin_bit_cast(bf16x8, Wf[((ks * 2 + 1) * 2 + 0) * 64 + lane]), wl1 = __builtin_bit_cast(bf16x8, Wf[((ks * 2 + 1) * 2 + 1) * 64 + lane]);
                acc1 = __builtin_amdgcn_mfma_f32_16x16x32_bf16(wh1, xh, acc1, 0, 0, 0);
                acc1 = __builtin_amdgcn_mfma_f32_16x16x32_bf16(wl1, xh, acc1, 0, 0, 0);
                acc1 = __builtin_amdgcn_mfma_f32_16x16x32_bf16(wh1, xl, acc1, 0, 0, 0);
            }
        }
        ssq += __shfl_xor(ssq, 16); ssq += __shfl_xor(ssq, 32);
        const float rstd = 1.0f / sqrtf(ssq * (1.0f / D) + RMS_EPS);
        if (q4 == 0) rstdp[tok] = rstd;
        if (KIND == 0) {
            if (q4 < 2) { const f32x4 bf = *(const f32x4*)(inp(F, I_b_fox_f) + l * 8 + 4 * q4); f32x4 lf;
#pragma unroll
                for (int i = 0; i < 4; ++i) { const float z = rstd * acc0[i] + bf[i]; lf[i] = fminf(z, 0.f) - log1pf(expf(-fabsf(z))); }
                *(f32x4*)((float*)(F.ws + WS_LOGF) + (size_t)tok * 8 + 4 * q4) = lf; }
        } else if (!DRY) {
            const f32x4 b0 = *(const f32x4*)(inp(F, I_b_router) + l * NE + 4 * q4), b1v = *(const f32x4*)(inp(F, I_b_router) + l * NE + 16 + 4 * q4);
#pragma unroll
            for (int i = 0; i < 4; ++i) { lg[r16 * 33 + 4 * q4 + i] = rstd * acc0[i] + b0[i]; lg[r16 * 33 + 16 + 4 * q4 + i] = rstd * acc1[i] + b1v[i]; }
            LDS_WAIT(); asm volatile("" ::: "memory");
            float v0 = -INFINITY, v1 = -INFINITY, v2 = -INFINITY, v3 = -INFINITY; int i0 = 0, i1 = 0, i2 = 0, i3 = 0;
            if (lane < 16) {
                for (int e = 0; e < NE; ++e) { const float x = lg[lane * 33 + e];
                    if (x > v3) { if (x > v0) { v3 = v2; i3 = i2; v2 = v1; i2 = i1; v1 = v0; i1 = i0; v0 = x; i0 = e; }
                        else if (x > v1) { v3 = v2; i3 = i2; v2 = v1; i2 = i1; v1 = x; i1 = e; }
                        else if (x > v2) { v3 = v2; i3 = i2; v2 = x; i2 = e; }
                        else { v3 = x; i3 = e; } } }
            }
            __syncthreads();
            int rk0 = 0, rk1 = 0, rk2 = 0, rk3 = 0;
            if (lane < 16) { rk0 = __hip_atomic_fetch_add(&r2cnt[i0], 1, __ATOMIC_RELAXED, __HIP_MEMORY_SCOPE_WORKGROUP); rk1 = __hip_atomic_fetch_add(&r2cnt[i1], 1, __ATOMIC_RELAXED, __HIP_MEMORY_SCOPE_WORKGROUP); rk2 = __hip_atomic_fetch_add(&r2cnt[i2], 1, __ATOMIC_RELAXED, __HIP_MEMORY_SCOPE_WORKGROUP); rk3 = __hip_atomic_fetch_add(&r2cnt[i3], 1, __ATOMIC_RELAXED, __HIP_MEMORY_SCOPE_WORKGROUP); }
            __syncthreads();
            if (F.tid < 32) r2base[F.tid] = (int)atomicAdd(F.ctl + CW_CUR + (l * NE + F.tid) * 16, (unsigned)r2cnt[F.tid]);
            __syncthreads();
            if (lane < 16) {
                const float e1 = expf(v1 - v0), e2 = expf(v2 - v0), e3 = expf(v3 - v0), inv = 1.0f / (1.0f + e1 + e2 + e3);
                u32x2* list = (u32x2*)(F.ws + WS_LIST); float* gate = (float*)(F.ws + WS_GATE);
                const int tk = (task * 128 + F.wave * 16 + lane) * 4; const unsigned rb = __float_as_uint(__shfl(rstd, lane & 15));
                list[(size_t)i0 * LISTCAP + r2base[i0] + rk0] = (u32x2){(unsigned)(tk + 0), rb}; gate[tk + 0] = inv;
                list[(size_t)i1 * LISTCAP + r2base[i1] + rk1] = (u32x2){(unsigned)(tk + 1), rb}; gate[tk + 1] = e1 * inv;
                list[(size_t)i2 * LISTCAP + r2base[i2] + rk2] = (u32x2){(unsigned)(tk + 2), rb}; gate[tk + 2] = e2 * inv;
                list[(size_t)i3 * LISTCAP + r2base[i3] + rk3] = (u32x2){(unsigned)(tk + 3), rb}; gate[tk + 3] = e3 * inv;
            }
            __syncthreads();
        }
    }
}
__device__ __forceinline__ void r_final(const Frame& F) {
    const int lane = F.lane, tr = lane >> 5, c = lane & 31;
    const bf16_t* Y = (const bf16_t*)(F.ws + WS_Y);
    const float* gf = inp(F, I_norm_final);
    for (int task = F.bid; task < T / 128; task += F.G) {
#pragma unroll 1
        for (int pr = 0; pr < 8; ++pr) {
            const int tok = task * 128 + F.wave * 16 + pr * 2 + tr;
            float* xr = F.out + (size_t)tok * D + 8 * c; const unsigned char* yr = (const unsigned char*)Y + (size_t)tok * 4 * D + 8 * c;
            f32x4 x0[4], x1[4]; float ssq = 0.f;
#pragma unroll
            for (int i = 0; i < 4; ++i) { x0[i] = *(const f32x4*)(xr + 256 * i); x1[i] = *(const f32x4*)(xr + 256 * i + 4); }
#pragma unroll
            for (int i = 0; i < 4; ++i) {
#pragma unroll
                for (int k = 0; k < 4; ++k) { const u32x2 y = *(const u32x2*)(yr + (size_t)k * D + 256 * i);
                    x0[i] += un4_fp8(y.x) * (1.0f / Y_SCALE); x1[i] += un4_fp8(y.y) * (1.0f / Y_SCALE); }
                ssq += (x0[i][0] * x0[i][0] + x0[i][1] * x0[i][1]) + (x0[i][2] * x0[i][2] + x0[i][3] * x0[i][3]) + (x1[i][0] * x1[i][0] + x1[i][1] * x1[i][1]) + (x1[i][2] * x1[i][2] + x1[i][3] * x1[i][3]); }
            ssq += __shfl_xor(ssq, 1); ssq += __shfl_xor(ssq, 2); ssq += __shfl_xor(ssq, 4); ssq += __shfl_xor(ssq, 8); ssq += __shfl_xor(ssq, 16);
            const float rstd = 1.0f / sqrtf(ssq * (1.0f / D) + RMS_EPS);
#pragma unroll
            for (int i = 0; i < 4; ++i) { const f32x4 g0 = *(const f32x4*)(gf + 256 * i + 8 * c), g1 = *(const f32x4*)(gf + 256 * i + 8 * c + 4);
                *(f32x4*)(xr + 256 * i) = x0[i] * rstd * g0; *(f32x4*)(xr + 256 * i + 4) = x1[i] * rstd * g1; }
        }
    }
}
__device__ __forceinline__ void cumsum_step(const Frame& F) {
    LAS float* sc = (LAS float*)(F.lds + LDSCTL_OFF + LC_SCAN);
    const float* LF = (const float*)(F.ws + WS_LOGF); float* c2 = (float*)(F.ws + WS_C2);
    for (int seq = F.bid; seq < 64; seq += F.G) {
        const int b = seq >> 3, h = seq & 7, t0 = F.tid * 8; const float* lf = LF + ((size_t)b * SEQ + t0) * 8 + h;
        float v[8], s = 0.f;
#pragma unroll
        for (int j = 0; j < 8; ++j) { s += lf[j * 8]; v[j] = s; }
        float inc = s;
#pragma unroll
        for (int off = 1; off < 64; off <<= 1) { const float y = __shfl_up(inc, off); if (F.lane >= off) inc += y; }
        if (F.lane == 63) sc[F.wave] = inc;
        __syncthreads();
        float pre = 0.f;
        for (int w = 0; w < F.wave; ++w) pre += sc[w];
        const float base = pre + inc - s;
#pragma unroll
        for (int j = 0; j < 8; ++j) c2[(size_t)seq * SEQ + t0 + j] = (base + v[j]) * LOG2E;
        __syncthreads();
    }
}

__device__ __forceinline__ float max3f(float a, float b, float c) { float r; asm("v_max3_f32 %0, %1, %2, %3" : "=v"(r) : "v"(a), "v"(b), "v"(c)); return r; }
__device__ __forceinline__ float max2f(float a, float b) { float r; asm("v_max_f32_e32 %0, %1, %2" : "=v"(r) : "v"(a), "v"(b)); return r; }
__device__ __forceinline__ int crow(int r, int hi) { return (r & 3) + 8 * (r >> 2) + 4 * hi; }
constexpr int AT_KT = 0, AT_KTB = 8320, AT_VT = 2 * AT_KTB, AT_VTB = 8192, AT_CK = AT_VT + 2 * AT_VTB, AT_WSF = AT_CK + 512, AT_OST = AT_WSF + 2048, AT_END = AT_OST + 65536;
static_assert(AT_END <= PH_BYTES, "attention LDS");
__device__ __forceinline__ void attn_unit(const Frame& F, int l, int b, int h, int qb) {
    const int tid = F.tid, lane = F.lane, r32 = lane & 31, hi = lane >> 5, wid = F.wave;
    const bf16_t* proj = (const bf16_t*)(F.ws + WS_PA); bf16_t* mixed = (bf16_t*)(F.ws + WS_MIXED);
    const int bh = b * 8 + h; const float* c2 = (const float*)(F.ws + WS_C2) + (size_t)bh * SEQ;
    const size_t rowbase = (size_t)b * SEQ; const int q0 = qb * 256;
    LAS unsigned char* L = F.lds;
    LAS float* wsf = (LAS float*)(L + AT_WSF) + wid * 64;
    LAS float* ost = (LAS float*)(L + AT_OST) + wid * 2048;
    LAS unsigned* stopv = (LAS unsigned*)(L + LDSCTL_OFF + LC_STOP);
    const bf16_t* Qw = proj + (rowbase + q0 + wid * 32 + r32) * NPROJ + C_FQ + h * 64;
    bf16x8 qr[4]; float qn = 0.f;
#pragma unroll
    for (int d0 = 0; d0 < 4; ++d0) { const u32x4 w = *(const u32x4*)(Qw + d0 * 16 + hi * 8); qr[d0] = __builtin_bit_cast(bf16x8, w);
        qn += bflo(w.x) * bflo(w.x) + bfhi(w.x) * bfhi(w.x) + bflo(w.y) * bflo(w.y) + bfhi(w.y) * bfhi(w.y) + bflo(w.z) * bflo(w.z) + bfhi(w.z) * bfhi(w.z) + bflo(w.w) * bflo(w.w) + bfhi(w.w) * bfhi(w.w); }
    qn += __shfl_xor(qn, 32); qn = sqrtf(qn) * 1.001f;
    const float kb = sqrtf(2.0f * __uint_as_float(__hip_atomic_load(F.ctl + CW_KMAX + (l * 64 + bh) * 16, __ATOMIC_RELAXED, __HIP_MEMORY_SCOPE_AGENT))) * 1.001f;
    const float c2q = c2[q0 + wid * 32 + r32];
    f32x16 cq16;
#pragma unroll
    for (int r = 0; r < 16; ++r) cq16[r] = c2q;
    float lsum = 0.f; f32x16 o[2];
#pragma unroll
    for (int r = 0; r < 16; ++r) { o[0][r] = 0.f; o[1][r] = 0.f; }
    const int jd = 4 * qb + 3;
    const int lkey = tid >> 3, lpiece = tid & 7;
    const bf16_t* ksrc = proj + (rowbase + lkey) * NPROJ + C_FK + h * 64 + lpiece * 8;
    const bf16_t* vsrc = proj + (rowbase + lkey) * NPROJ + C_FV + h * 64 + lpiece * 8;
    const int kdst = lpiece * 1040 + lkey * 16, vdst = (lpiece >> 2) * 4096 + lkey * 64 + (lpiece & 3) * 16;
    u32x4 kA = *(const u32x4*)(ksrc + (size_t)jd * 64 * NPROJ), vA = *(const u32x4*)(vsrc + (size_t)jd * 64 * NPROJ); float cA = c2[jd * 64 + lane];
    u32x4 kB = kA, vB = vA; float cB = cA;
    if (jd >= 1) { kB = *(const u32x4*)(ksrc + (size_t)(jd - 1) * 64 * NPROJ); vB = *(const u32x4*)(vsrc + (size_t)(jd - 1) * 64 * NPROJ); cB = c2[(jd - 1) * 64 + lane]; }
    const int vrd = (4 * hi + ((lane & 15) >> 2)) * 64 + ((lane >> 4) & 1) * 32 + (lane & 3) * 8;
    const int qrel = wid * 32 + r32;
    int buf = 0; bool done = false, wstop = false, first = true;
    float mhat = 0.f;
#define AT_ITER(j, kR, vR, cR, cNext) do { \
        const float cklast = rdlane(cNext, 63);     \
        *(LAS u32x4*)(L + AT_KT + buf * AT_KTB + kdst) = kR; *(LAS u32x4*)(L + AT_VT + buf * AT_VTB + vdst) = vR; \
        if (tid < 64) ((LAS float*)(L + AT_CK))[buf * 64 + tid] = cR; \
        asm volatile("s_waitcnt lgkmcnt(0)\n\ts_barrier" ::: "memory");     \
        if ((j) < jd) { const u32x4 fa = *(const LAS u32x4*)(stopv + (((j) + 1) & 1) * 8), fb = *(const LAS u32x4*)(stopv + (((j) + 1) & 1) * 8 + 4); \
            if ((fa.x & fa.y & fa.z & fa.w & fb.x & fb.y & fb.z & fb.w) != 0u) { done = true; break; } } \
        if ((j) >= 2) { kR = *(const u32x4*)(ksrc + (size_t)((j) - 2) * 64 * NPROJ); vR = *(const u32x4*)(vsrc + (size_t)((j) - 2) * 64 * NPROJ); cR = c2[((j) - 2) * 64 + lane]; } \
        const int jrel = (j) - 4 * qb; \
        const bool active = !(jrel >= 0 && 64 * jrel > 32 * wid + 31) && !wstop; \
        if (active) { \
            const LAS unsigned char* Kb = L + AT_KT + buf * AT_KTB; const LAS unsigned char* Vb = L + AT_VT + buf * AT_VTB; const LAS float* Ck = (const LAS float*)(L + AT_CK) + buf * 64; \
            const float base = c2q - mhat; \
            f32x16 p0, p1; \
            _Pragma("unroll") for (int g = 0; g < 4; ++g) { const f32x4 ca = *(const LAS f32x4*)(Ck + 8 * g + 4 * hi), cb = *(const LAS f32x4*)(Ck + 32 + 8 * g + 4 * hi); \
                _Pragma("unroll") for (int i = 0; i < 4; ++i) { p0[4 * g + i] = base - ca[i]; p1[4 * g + i] = base - cb[i]; } } \
            bf16x8 kf0[4], kf1[4]; \
            _Pragma("unroll") for (int d0 = 0; d0 < 4; ++d0) { kf0[d0] = *(const LAS bf16x8*)(Kb + (2 * d0 + hi) * 1040 + r32 * 16); kf1[d0] = *(const LAS bf16x8*)(Kb + (2 * d0 + hi) * 1040 + (32 + r32) * 16); } \
            _Pragma("unroll") for (int d0 = 0; d0 < 4; ++d0) { \
                p0 = __builtin_amdgcn_mfma_f32_32x32x16_bf16(kf0[d0], qr[d0], p0, 0, 0, 0); p1 = __builtin_amdgcn_mfma_f32_32x32x16_bf16(kf1[d0], qr[d0], p1, 0, 0, 0); } \
            asm volatile("s_nop 15\n\ts_nop 7" : "+v"(p0), "+v"(p1));     \
            if (jrel >= 0) { const int kbase = 64 * jrel + 4 * hi; \
                _Pragma("unroll") for (int r = 0; r < 16; ++r) { const int kv = kbase + (r & 3) + 8 * (r >> 2); if (kv > qrel) p0[r] = -INFINITY; if (kv + 32 > qrel) p1[r] = -INFINITY; } } \
            float mx = max3f(p0[0], p0[1], p1[0]), mb_ = max3f(p0[2], p0[3], p1[1]); mx = max3f(mx, p1[2], p1[3]); \
            _Pragma("unroll") for (int r = 4; r < 16; r += 4) { mx = max3f(mx, p0[r], p0[r + 1]); mb_ = max3f(mb_, p0[r + 2], p0[r + 3]); mx = max3f(mx, p1[r], p1[r + 1]); mb_ = max3f(mb_, p1[r + 2], p1[r + 3]); } \
            mx = max2f(mx, mb_); \
            { auto rr = __builtin_amdgcn_permlane32_swap(__float_as_uint(mx), __float_as_uint(mx), false, false); mx = max2f(__uint_as_float(rr[0]), __uint_as_float(rr[1])); } \
            if (first || __any(mx > 8.0f)) { \
                const float dl = first ? mx : fmaxf(mx, 0.f); mhat += dl; \
                _Pragma("unroll") for (int r = 0; r < 16; ++r) { p0[r] -= dl; p1[r] -= dl; } \
                const float alpha = __builtin_amdgcn_exp2f(-dl); lsum *= alpha; \
                if (!first) { \
                    if (hi == 0) wsf[r32] = alpha; \
                    LDS_WAIT(); asm volatile("" ::: "memory"); \
                    _Pragma("unroll") for (int r = 0; r < 16; ++r) { const float a = wsf[crow(r, hi)]; o[0][r] *= a; o[1][r] *= a; } } \
                first = false; \
            } \
            _Pragma("unroll") for (int r = 0; r < 16; ++r) { p0[r] = __builtin_amdgcn_exp2f(p0[r]); p1[r] = __builtin_amdgcn_exp2f(p1[r]); } \
            { f32x2 sa = {p0[0] + p1[0], p0[1] + p1[1]}; \
              _Pragma("unroll") for (int r = 2; r < 16; r += 2) { sa += (f32x2){p0[r], p0[r + 1]}; sa += (f32x2){p1[r], p1[r + 1]}; } \
              lsum += sa[0] + sa[1]; } \
            u32x4 pw[4]; \
            pw[0] = (u32x4){cvtpk(p0[0], p0[1]), cvtpk(p0[2], p0[3]), cvtpk(p0[4], p0[5]), cvtpk(p0[6], p0[7])}; \
            pw[1] = (u32x4){cvtpk(p0[8], p0[9]), cvtpk(p0[10], p0[11]), cvtpk(p0[12], p0[13]), cvtpk(p0[14], p0[15])}; \
            pw[2] = (u32x4){cvtpk(p1[0], p1[1]), cvtpk(p1[2], p1[3]), cvtpk(p1[4], p1[5]), cvtpk(p1[6], p1[7])}; \
            pw[3] = (u32x4){cvtpk(p1[8], p1[9]), cvtpk(p1[10], p1[11]), cvtpk(p1[12], p1[13]), cvtpk(p1[14], p1[15])}; \
            _Pragma("unroll") for (int s = 0; s < 4; ++s) \
                _Pragma("unroll") for (int d0 = 0; d0 < 2; ++d0) { \
                    const LAS unsigned char* vp = Vb + d0 * 4096 + s * 1024 + vrd; \
                    const v4i16_t lo = __builtin_amdgcn_ds_read_tr16_b64_v4i16((LAS v4i16_t*)vp), hv = __builtin_amdgcn_ds_read_tr16_b64_v4i16((LAS v4i16_t*)(vp + 512)); \
                    const bf16x8 vf = (bf16x8){lo[0], lo[1], lo[2], lo[3], hv[0], hv[1], hv[2], hv[3]}; \
                    o[d0] = __builtin_amdgcn_mfma_f32_32x32x16_bf16(__builtin_bit_cast(bf16x8, pw[s]), vf, o[d0], 0, 0, 0); } \
        } \
        if ((j) > 0) { if (active) { const float ub = qn * kb + (c2q - cklast); if (__all((ub - mhat) < -152.0f)) wstop = true; } if (lane == 0) stopv[((j) & 1) * 8 + wid] = wstop ? 1u : 0u; } \
        buf ^= 1; \
    } while (0)
    for (int j = jd; j >= 0; j -= 2) {
        AT_ITER(j, kA, vA, cA, cB);
        if (done || j == 0) break;
        AT_ITER(j - 1, kB, vB, cB, cA);
        if (done) break;
    }
#undef AT_ITER
    lsum += __shfl_xor(lsum, 32);
    if (hi == 0) wsf[32 + r32] = 1.0f / lsum;
    LDS_WAIT(); asm volatile("" ::: "memory");
#pragma unroll
    for (int r = 0; r < 16; ++r) { const int q = crow(r, hi); const float inv = wsf[32 + q]; ost[q * 64 + r32] = o[0][r] * inv; ost[q * 64 + 32 + r32] = o[1][r] * inv; }
    LDS_WAIT(); asm volatile("" ::: "memory");
    { const int row = lane >> 1, half = lane & 1; const LAS float* src = ost + row * 64 + half * 32; float v[32]; float ss = 0.f;
#pragma unroll
        for (int i = 0; i < 8; ++i) { const f32x4 t4 = *(const LAS f32x4*)(src + 4 * i); v[4 * i] = t4[0]; v[4 * i + 1] = t4[1]; v[4 * i + 2] = t4[2]; v[4 * i + 3] = t4[3]; ss += (t4[0] * t4[0] + t4[1] * t4[1]) + (t4[2] * t4[2] + t4[3] * t4[3]); }
        ss += __shfl_xor(ss, 1);
        const float rs = 1.0f / sqrtf(ss * (1.0f / 64.0f) + RMS_EPS);
        const float* gn = inp(F, I_fox_gain) + l * 512 + h * 64 + half * 32;
        bf16_t* dst = mixed + (rowbase + q0 + wid * 32 + row) * D + h * 64 + half * 32;
#pragma unroll
        for (int i = 0; i < 4; ++i) { const f32x4 ga = *(const f32x4*)(gn + 8 * i), gb = *(const f32x4*)(gn + 8 * i + 4); u32x4 w;
            w.x = cvtpk(v[8 * i] * rs * ga[0], v[8 * i + 1] * rs * ga[1]); w.y = cvtpk(v[8 * i + 2] * rs * ga[2], v[8 * i + 3] * rs * ga[3]);
            w.z = cvtpk(v[8 * i + 4] * rs * gb[0], v[8 * i + 5] * rs * gb[1]); w.w = cvtpk(v[8 * i + 6] * rs * gb[2], v[8 * i + 7] * rs * gb[3]);
            *(u32x4*)(dst + 8 * i) = w; } }
    __syncthreads();
}

__device__ __forceinline__ float hg_lb(const Frame& F, int l, int col) {
    float x[NL], mx = -INFINITY;
#pragma unroll
    for (int i = 0; i < NL; ++i) { x[i] = inp(F, I_hgrn_lb)[i * 256 + col]; mx = fmaxf(mx, x[i]); }
    float s = 0.f, a = 0.f;
#pragma unroll
    for (int i = 0; i < NL; ++i) { x[i] = expf(x[i] - mx); s += x[i]; }
#pragma unroll
    for (int i = 1; i < NL; ++i) if (i <= l) a += x[i];
    return a / s;
}
constexpr int HG_SEG = 128, HG_NSEG = SEQ / HG_SEG, HG_NPART = 1, HG_WAVES = 4;
static_assert(HG_NSEG == 32, "the FIX phase's balanced deal assumes 32 segments");
constexpr int HGL_ROW = 136, HGL_QT = 0, HGL_KT = 32 * HGL_ROW, HGL_KP = 2 * 32 * HGL_ROW, HGL_V = HGL_KP + 4096, HGL_PE = HGL_V + 4096, HGL_BYTES = HGL_PE + 256;
static_assert(NWAVES * HGL_BYTES <= PH_BYTES, "HGRN2 LDS");
__device__ __forceinline__ void hg_mfma_unit(const Frame& F, int l, int u) {
    const int seg = u % HG_NSEG, bh = u / HG_NSEG, b = bh >> 2, hd = bh & 3, lane = F.lane, r32 = lane & 31, hi = lane >> 5;
    LAS unsigned char* W = F.lds + F.wave * HGL_BYTES;
    const size_t tokS = (size_t)b * SEQ + seg * HG_SEG;
    const bf16_t* proj = (const bf16_t*)(F.ws + WS_PA);
    float* oraw = (float*)(F.ws + WS_ORAW); bf16_t* QE = (bf16_t*)(F.ws + WS_QE);
    const float lbv = hg_lb(F, l, hd * 64 + lane);
    f32x16 Sacc[2][2];
#pragma unroll
    for (int kb = 0; kb < 2; ++kb)
#pragma unroll
        for (int vb = 0; vb < 2; ++vb)
#pragma unroll
            for (int r = 0; r < 16; ++r) Sacc[kb][vb][r] = 0.f;
    float Pseg = 1.0f;
    const int vrd = (4 * hi + ((lane & 15) >> 2)) * 64 + ((lane >> 4) & 1) * 32 + (lane & 3) * 8;
    int tb = 0;
    while (tb < HG_SEG) {
        const int nmax = (HG_SEG - tb) < 32 ? (HG_SEG - tb) : 32;
        const char* pu8 = (const char*)(proj + (tokS + tb) * NPROJ + hd * 64);
        const unsigned lo2 = (unsigned)lane * 2u;
        char* qe8 = (char*)(QE + (tokS + tb) * 256 + hd * 64);
        char* or8 = (char*)(oraw + (tokS + tb) * 256 + hd * 64);
        const unsigned lof = (unsigned)(4 * hi * 256 + r32) * 4u;
        float fv[32], qv[32]; u32x4 vreg[4];
#pragma unroll
        for (int t = 0; t < 32; ++t) { const bool ok = t < nmax; fv[t] = ok ? bf2f(*(const bf16_t*)(pu8 + (size_t)t * (NPROJ * 2) + C_GF * 2 + lo2)) : 0.f; qv[t] = ok ? bf2f(*(const bf16_t*)(pu8 + (size_t)t * (NPROJ * 2) + C_GQ * 2 + lo2)) : 0.f; }
#pragma unroll
        for (int it = 0; it < 4; ++it) { const int c = lane + 64 * it, sr = c >> 3, pc = c & 7;
            vreg[it] = (u32x4){0u, 0u, 0u, 0u}; if (sr < nmax) vreg[it] = *(const u32x4*)(pu8 + (size_t)sr * (NPROJ * 2) + C_GI * 2 + pc * 16); }
        int nl = 32; { float P = 1.0f;
#pragma unroll
            for (int t = 0; t < 32; ++t) { const float sg = __builtin_amdgcn_rcpf(1.0f + __builtin_amdgcn_exp2f(-LOG2E * fv[t])); float f = fmaxf(lbv + (1.0f - lbv) * sg, 1e-30f); if (t >= nmax) f = 1.0f; fv[t] = f; P *= f; if (P < 1e-32f && nl == 32) nl = t; } }
#pragma unroll
        for (int off = 1; off < 64; off <<= 1) { const int o = __shfl_xor(nl, off); nl = o < nl ? o : nl; }
        const int n = __builtin_amdgcn_readfirstlane(nl < nmax ? nl : nmax);
#pragma unroll
        for (int it = 0; it < 4; ++it) { const int c = lane + 64 * it, sr = c >> 3, pc = c & 7;
            *(LAS u32x4*)(W + HGL_V + (pc >> 2) * 2048 + sr * 64 + (pc & 3) * 16) = (sr < n) ? vreg[it] : (u32x4){0u, 0u, 0u, 0u}; }
        float P = 1.0f;
        {
#pragma unroll
          for (int t = 0; t < 32; ++t) { const bool ok = t < n; const float f = fv[t]; if (ok) P *= f;
            const float qt = ok ? qv[t] * P : 0.f, kt = ok ? (1.0f - f) * __builtin_amdgcn_rcpf(P) : 0.f;
            *(LAS bf16_t*)(W + HGL_QT + t * HGL_ROW + lane * 2) = f2bf(qt); *(LAS bf16_t*)(W + HGL_KT + t * HGL_ROW + lane * 2) = f2bf(kt);
            if (ok) *(bf16_t*)(qe8 + (size_t)t * 512 + lo2) = f2bf(qv[t] * (Pseg * P)); } }
        { float suf = 1.0f;
#pragma unroll
          for (int t = 31; t >= 0; --t) { const bool ok = t < n; const float f = fv[t]; const float kp = ok ? (1.0f - f) * suf : 0.f; if (ok) suf *= f;
            *(LAS bf16_t*)(W + HGL_KP + (lane >> 5) * 2048 + t * 64 + (lane & 31) * 2) = f2bf(kp); } }
        ((LAS float*)(W + HGL_PE))[lane] = P;
        Pseg *= P;
        LDS_WAIT(); asm volatile("" ::: "memory");
        f32x16 st;
#pragma unroll
        for (int r = 0; r < 16; ++r) st[r] = 0.f;
#pragma unroll
        for (int d0 = 0; d0 < 4; ++d0) { const bf16x8 ka = *(const LAS bf16x8*)(W + HGL_KT + r32 * HGL_ROW + (16 * d0 + 8 * hi) * 2), qb = *(const LAS bf16x8*)(W + HGL_QT + r32 * HGL_ROW + (16 * d0 + 8 * hi) * 2);
            st = __builtin_amdgcn_mfma_f32_32x32x16_bf16(ka, qb, st, 0, 0, 0); }
#pragma unroll
        for (int r = 0; r < 16; ++r) if (crow(r, hi) > r32) st[r] = 0.f;
        u32x4 pst[2];
        pst[0] = (u32x4){cvtpk(st[0], st[1]), cvtpk(st[2], st[3]), cvtpk(st[4], st[5]), cvtpk(st[6], st[7])};
        pst[1] = (u32x4){cvtpk(st[8], st[9]), cvtpk(st[10], st[11]), cvtpk(st[12], st[13]), cvtpk(st[14], st[15])};
        bf16x8 vf[2][2];
#pragma unroll
        for (int s2 = 0; s2 < 2; ++s2)
#pragma unroll
            for (int vb = 0; vb < 2; ++vb) { const LAS unsigned char* vp = W + HGL_V + vb * 2048 + s2 * 1024 + vrd;
                const v4i16_t lo = __builtin_amdgcn_ds_read_tr16_b64_v4i16((LAS v4i16_t*)vp), hv = __builtin_amdgcn_ds_read_tr16_b64_v4i16((LAS v4i16_t*)(vp + 512));
                vf[s2][vb] = (bf16x8){lo[0], lo[1], lo[2], lo[3], hv[0], hv[1], hv[2], hv[3]}; }
        f32x16 oacc[2];
#pragma unroll
        for (int vb = 0; vb < 2; ++vb) {
#pragma unroll
            for (int r = 0; r < 16; ++r) oacc[vb][r] = 0.f;
#pragma unroll
            for (int s2 = 0; s2 < 2; ++s2) oacc[vb] = __builtin_amdgcn_mfma_f32_32x32x16_bf16(__builtin_bit_cast(bf16x8, pst[s2]), vf[s2][vb], oacc[vb], 0, 0, 0);
        }
#pragma unroll
        for (int kst = 0; kst < 4; ++kst) {
            const u32x2 qa = *(const LAS u32x2*)(W + HGL_QT + r32 * HGL_ROW + (16 * kst + 4 * hi) * 2), qc = *(const LAS u32x2*)(W + HGL_QT + r32 * HGL_ROW + (16 * kst + 8 + 4 * hi) * 2);
            const bf16x8 qf = __builtin_bit_cast(bf16x8, (u32x4){qa.x, qa.y, qc.x, qc.y});
#pragma unroll
            for (int vb = 0; vb < 2; ++vb) { const f32x16& S = Sacc[kst >> 1][vb]; const int o8 = 8 * (kst & 1);
                const u32x4 sp = (u32x4){cvtpk(S[o8 + 0], S[o8 + 1]), cvtpk(S[o8 + 2], S[o8 + 3]), cvtpk(S[o8 + 4], S[o8 + 5]), cvtpk(S[o8 + 6], S[o8 + 7])};
                oacc[vb] = __builtin_amdgcn_mfma_f32_32x32x16_bf16(qf, __builtin_bit_cast(bf16x8, sp), oacc[vb], 0, 0, 0); }
        }
#pragma unroll
        for (int vb = 0; vb < 2; ++vb)
#pragma unroll
            for (int r = 0; r < 16; ++r) { const int t = crow(r, hi); if (t < n) *(float*)(or8 + (size_t)(((r & 3) + 8 * (r >> 2)) * 1024 + vb * 128) + lof) = oacc[vb][r]; }
#pragma unroll
        for (int kb = 0; kb < 2; ++kb) {
            float pe[16];
#pragma unroll
            for (int g = 0; g < 4; ++g) { const f32x4 p4 = *(const LAS f32x4*)(W + HGL_PE + (32 * kb + 8 * g + 4 * hi) * 4); pe[4 * g] = p4[0]; pe[4 * g + 1] = p4[1]; pe[4 * g + 2] = p4[2]; pe[4 * g + 3] = p4[3]; }
            bf16x8 kf[2];
#pragma unroll
            for (int s2 = 0; s2 < 2; ++s2) { const LAS unsigned char* kp = W + HGL_KP + kb * 2048 + s2 * 1024 + vrd;
                const v4i16_t lo = __builtin_amdgcn_ds_read_tr16_b64_v4i16((LAS v4i16_t*)kp), hv = __builtin_amdgcn_ds_read_tr16_b64_v4i16((LAS v4i16_t*)(kp + 512));
                kf[s2] = (bf16x8){lo[0], lo[1], lo[2], lo[3], hv[0], hv[1], hv[2], hv[3]}; }
#pragma unroll
            for (int vb = 0; vb < 2; ++vb) {
#pragma unroll
                for (int r = 0; r < 16; ++r) Sacc[kb][vb][r] *= pe[r];
#pragma unroll
                for (int s2 = 0; s2 < 2; ++s2) Sacc[kb][vb] = __builtin_amdgcn_mfma_f32_32x32x16_bf16(kf[s2], vf[s2][vb], Sacc[kb][vb], 0, 0, 0);
            }
        }
        LDS_WAIT(); asm volatile("" ::: "memory");
        tb += n;
    }
    char* send8 = (char*)((float*)(F.ws + WS_SEND2) + (size_t)(bh * HG_NSEG + seg) * 4096);
    const unsigned lsf = (unsigned)(4 * hi * 64 + r32) * 4u;
#pragma unroll
    for (int kb = 0; kb < 2; ++kb)
#pragma unroll
        for (int vb = 0; vb < 2; ++vb)
#pragma unroll
            for (int r = 0; r < 16; ++r) *(float*)(send8 + (size_t)((32 * kb + (r & 3) + 8 * (r >> 2)) * 256 + vb * 128) + lsf) = Sacc[kb][vb][r];
    ((float*)(F.ws + WS_PSEG))[(bh * HG_NSEG + seg) * 64 + lane] = Pseg;
}
__device__ __forceinline__ void hg_fix_phase(const Frame& F, int l) {
    const int lane = F.lane, r16 = lane & 15, q4 = lane >> 4, tid = F.tid;
    LAS bf16_t* ST = (LAS bf16_t*)(F.lds);
    const float* oraw = (const float*)(F.ws + WS_ORAW); const bf16_t* proj = (const bf16_t*)(F.ws + WS_PA); bf16_t* mixed = (bf16_t*)(F.ws + WS_MIXED);
    const bf16_t* QE = (const bf16_t*)(F.ws + WS_QE); const float* SEND = (const float*)(F.ws + WS_SEND2); const float* PSEG = (const float*)(F.ws + WS_PSEG);
    for (int uu = F.bid; uu < 32 * HG_NSEG * DUP(7); uu += F.G) {
        const int u = uu % (32 * HG_NSEG), blk = u & 255, iq = u >> 8, s8 = blk & 7, seg = (iq == 0) ? s8 : (iq == 1) ? 15 - s8 : (iq == 2) ? 16 + s8 : 31 - s8, bh = blk >> 3, b = bh >> 2, hd = bh & 3;
        if (seg > 0) {
            const int k = tid >> 3, v8 = (tid & 7) * 8; float S[8];
#pragma unroll
            for (int i = 0; i < 8; ++i) S[i] = 0.f;
#pragma unroll 4
            for (int sp = 0; sp < seg; ++sp) { const float P = PSEG[(bh * HG_NSEG + sp) * 64 + k]; const float* se = SEND + ((size_t)(bh * HG_NSEG + sp) * 64 + k) * 64 + v8;
                const f32x4 a = *(const f32x4*)se, c = *(const f32x4*)(se + 4);
                S[0] = P * S[0] + a[0]; S[1] = P * S[1] + a[1]; S[2] = P * S[2] + a[2]; S[3] = P * S[3] + a[3]; S[4] = P * S[4] + c[0]; S[5] = P * S[5] + c[1]; S[6] = P * S[6] + c[2]; S[7] = P * S[7] + c[3]; }
#pragma unroll
            for (int i = 0; i < 8; ++i) ST[(v8 + i) * 72 + k] = f2bf(S[i]);
        }
        __syncthreads();
        {
            const size_t tok0 = (size_t)b * SEQ + seg * HG_SEG + F.wave * 16;
            f32x4 acc[4];
#pragma unroll
            for (int vb = 0; vb < 4; ++vb) acc[vb] = (f32x4){0.f, 0.f, 0.f, 0.f};
            if (seg > 0) {
#pragma unroll
                for (int kst = 0; kst < 2; ++kst) { const bf16x8 af = __builtin_bit_cast(bf16x8, *(const u32x4*)(QE + (tok0 + r16) * 256 + hd * 64 + 32 * kst + 8 * q4));
#pragma unroll
                    for (int vb = 0; vb < 4; ++vb) { const bf16x8 bfv = *(const LAS bf16x8*)(ST + (vb * 16 + r16) * 72 + 32 * kst + 8 * q4); acc[vb] = __builtin_amdgcn_mfma_f32_16x16x32_bf16(af, bfv, acc[vb], 0, 0, 0); } }
            }
            float ss[4] = {0.f, 0.f, 0.f, 0.f};
#pragma unroll
            for (int vb = 0; vb < 4; ++vb)
#pragma unroll
                for (int r = 0; r < 4; ++r) { const size_t o = (tok0 + 4 * q4 + r) * 256 + hd * 64 + vb * 16 + r16;
                    float x = acc[vb][r];
#pragma unroll
                    for (int k4 = 0; k4 < HG_NPART; ++k4) x += oraw[(size_t)k4 * T * 256 + o];
                    acc[vb][r] = x; ss[r] += x * x; }
#pragma unroll
            for (int r = 0; r < 4; ++r) { float t = ss[r]; t += __shfl_xor(t, 1); t += __shfl_xor(t, 2); t += __shfl_xor(t, 4); t += __shfl_xor(t, 8); ss[r] = 1.0f / sqrtf(t * (1.0f / 64.0f) + RMS_EPS); }
#pragma unroll
            for (int vb = 0; vb < 4; ++vb) { const float gn = inp(F, I_hgrn_gain)[l * 256 + hd * 64 + vb * 16 + r16];
#pragma unroll
                for (int r = 0; r < 4; ++r) { const size_t tok = tok0 + 4 * q4 + r; const float g = bf2f(proj[tok * NPROJ + C_GG + hd * 64 + vb * 16 + r16]);
                    const float si = g * __builtin_amdgcn_rcpf(1.0f + __builtin_amdgcn_exp2f(-LOG2E * g)); mixed[tok * D + 512 + hd * 64 + vb * 16 + r16] = f2bf(acc[vb][r] * ss[r] * gn * si); } }
        }
        __syncthreads();
    }
}
constexpr int PL_ROW = 136, PL_BYTES = 64 * PL_ROW;
static_assert(NWAVES * PL_BYTES <= PH_BYTES, "pool LDS");
template <int W> __device__ __forceinline__ void pool_body(const Frame& F, int l, int b, int g, int seg) {
    const int lane = F.lane, r32 = lane & 31, hi = lane >> 5, t0 = seg * 64;
    LAS unsigned char* PT = F.lds + F.wave * PL_BYTES;
    const char* ub = (const char*)((const bf16_t*)(F.ws + WS_PA) + (size_t)b * SEQ * NPROJ + C_PU + g * 64);
    const unsigned lo2 = (unsigned)lane * 2u;
    float prev[16], cur[16];
#pragma unroll
    for (int i = 0; i < 16; ++i) { const int t = t0 - 16 + i; prev[i] = (t >= 0) ? bf2f(*(const bf16_t*)(ub + (size_t)(t < 0 ? 0 : t) * (NPROJ * 2) + lo2)) : 0.f; }
    float wsum = 0.f;
#pragma unroll
    for (int i = 1; i <= W; ++i) wsum += prev[16 - i];
#pragma unroll
    for (int ci = 0; ci < 4; ++ci) {
#pragma unroll
        for (int i = 0; i < 16; ++i) cur[i] = bf2f(*(const bf16_t*)(ub + (size_t)(t0 + 16 * ci + i) * (NPROJ * 2) + lo2));
#pragma unroll
        for (int i = 0; i < 16; ++i) { const float ut = cur[i]; wsum += ut; wsum -= (i - W >= 0) ? cur[(i - W >= 0) ? i - W : 0] : prev[(i - W >= 0) ? 0 : 16 + i - W];
            const int t = t0 + 16 * ci + i; const float pooled = wsum / (float)((t + 1 < W) ? (t + 1) : W) - ut;
            *(LAS bf16_t*)(PT + (16 * ci + i) * PL_ROW + lane * 2) = f2bf(pooled); }
#pragma unroll
        for (int i = 0; i < 16; ++i) prev[i] = cur[i];
    }
    LDS_WAIT(); asm volatile("" ::: "memory");
    const bf16_t* pwt = (const bf16_t*)(F.ws + WS_PWT) + (size_t)(l * 4 + g) * 4096;
    bf16x8 bw[2][4];
#pragma unroll
    for (int db = 0; db < 2; ++db)
#pragma unroll
        for (int st = 0; st < 4; ++st) bw[db][st] = __builtin_bit_cast(bf16x8, *(const u32x4*)(pwt + (32 * db + r32) * 64 + 16 * st + 8 * hi));
    char* ob = (char*)((bf16_t*)(F.ws + WS_MIXED) + ((size_t)b * SEQ + t0) * D + 768 + g * 64);
    const unsigned lof = (unsigned)(4 * hi * D + r32) * 2u;
#pragma unroll
    for (int tb2 = 0; tb2 < 2; ++tb2)
#pragma unroll
        for (int db = 0; db < 2; ++db) {
            f32x16 acc;
#pragma unroll
            for (int r = 0; r < 16; ++r) acc[r] = 0.f;
#pragma unroll
            for (int st = 0; st < 4; ++st) { const bf16x8 af = *(const LAS bf16x8*)(PT + (32 * tb2 + r32) * PL_ROW + (16 * st + 8 * hi) * 2); acc = __builtin_amdgcn_mfma_f32_32x32x16_bf16(af, bw[db][st], acc, 0, 0, 0); }
            const float psc = inp(F, I_pool_scale)[l * 256 + g * 64 + 32 * db + r32];
#pragma unroll
            for (int r = 0; r < 16; ++r) *(bf16_t*)(ob + (size_t)((32 * tb2 + (r & 3) + 8 * (r >> 2)) * D + 32 * db) * 2 + lof) = f2bf(acc[r] * psc);
        }
    LDS_WAIT(); asm volatile("" ::: "memory");
}
__device__ __forceinline__ void pool_unit(const Frame& F, int l, int u) {
    const int seg = u & 63, g = (u >> 6) & 3, b = u >> 8;
    if (g == 0) pool_body<2>(F, l, b, g, seg); else if (g == 1) pool_body<4>(F, l, b, g, seg); else if (g == 2) pool_body<8>(F, l, b, g, seg); else pool_body<16>(F, l, b, g, seg);
}

struct Args { const float* in[18]; float* out; unsigned char* ws; int ph_lo, ph_hi; };
constexpr int N_PHASES = 2 + 8 * NL;

__global__ void __launch_bounds__(NTHREADS, 2) trunk_fwd(Args args) {
    extern __shared__ __attribute__((aligned(16))) unsigned char lds_raw[];
    Frame F;
    F.lds = (LAS unsigned char*)lds_raw; F.ws = args.ws; F.ctl = (unsigned*)(args.ws + WS_CTL); F.out = args.out;
    F.tid = threadIdx.x; F.lane = F.tid & 63; F.wave = __builtin_amdgcn_readfirstlane(F.tid >> 6);
    for (int u = F.tid; u < (LDS_BYTES - LDSCTL_OFF) / 4; u += NTHREADS) ((LAS unsigned*)(F.lds + LDSCTL_OFF))[u] = 0u;
    __syncthreads();
    if (F.tid == 0) {
#pragma unroll
        for (int i = 0; i < 18; ++i) ((LAS unsigned long long*)(F.lds + LDSCTL_OFF + LC_INP))[i] = (unsigned long long)args.in[i];
    }
    __syncthreads();
    const int lo = args.ph_lo, hi = args.ph_hi; const bool use_bar = (hi - lo) > 1;
    XcdBarrier bar; bar.bar = F.ctl + CW_BAR; bar.x = 0; bar.st = nullptr;
    if (use_bar) bar = xcd_barrier_post(F.ctl + CW_BAR, (volatile LAS unsigned*)(F.lds + LDSCTL_OFF + LC_BAR));
#ifndef PHMASK
#define PHMASK 0xFFFF
#endif
#define PM(b) ((PHMASK >> (b)) & 1)
#define FRESH() do { int l_; asm volatile("v_mbcnt_lo_u32_b32 %0, -1, 0\n\tv_mbcnt_hi_u32_b32 %0, -1, %0" : "=v"(l_));     F.lane = l_; F.tid = F.wave * 64 + l_; int b_ = blockIdx.x, g_ = gridDim.x; asm volatile("" : "+s"(b_), "+s"(g_)); F.bid = b_; F.G = g_; } while (0)
#ifndef PROBEMASK
#define PROBEMASK 0
#endif
    unsigned long long probe_acc = 0ull, probe_t0 = 0ull;
#define PB(b) ((PROBEMASK >> (b)) & 1)
#define PROBE_BEGIN(b) do { if (PB(b)) probe_t0 = __builtin_amdgcn_s_memrealtime(); } while (0)
#define PROBE_END(b) do { if (PB(b)) probe_acc += __builtin_amdgcn_s_memrealtime() - probe_t0; } while (0)
#define IN(k) (lo <= (k) && (k) < hi)
#define PTYPE(k) ((k) == 0 ? 0 : (((k) - 1) & 7) + 1)
#define PBS(k) (PB(10) || PB(11 + PTYPE(k)))
#define SEAM(k) do { if (use_bar && (k) + 1 < hi) { if (PBS(k)) probe_t0 = __builtin_amdgcn_s_memrealtime(); int sl_; asm volatile("v_mbcnt_lo_u32_b32 %0, -1, 0\n\tv_mbcnt_hi_u32_b32 %0, -1, %0" : "=v"(sl_)); xcd_barrier(bar, F.wave == 0 && sl_ == 0); if (PBS(k)) probe_acc += __builtin_amdgcn_s_memrealtime() - probe_t0; } } while (0)
    if (IN(0) && PM(0)) { PROBE_BEGIN(0); for (int rep = 0; rep < DUP(5); ++rep) { FRESH(); p0_prologue(F); } PROBE_END(0); SEAM(0); }
    for (int l = 0; l < NL; ++l) {
        const int pb = 1 + 8 * l;
        if (IN(pb + 0) && PM(1)) { FRESH(); PROBE_BEGIN(1); if (l == 0) r_phase<0, false, false>(F, l, inp(F, I_x), F.out); else { if (DUP(6) > 1) r_phase<0, true, false, true>(F, l, F.out, F.out); r_phase<0, true, true>(F, l, F.out, F.out); } PROBE_END(1); SEAM(pb + 0); }
        if (IN(pb + 1) && PM(2)) { FRESH(); PROBE_BEGIN(2);
            cumsum_step(F);
            pg8::StaticOrder S; S.init(T, NPROJ, D, F.G, F.bid, (const bf16_t*)(F.ws + WS_WIN + l * WIN_BYTES)); S.rep = DUP(2);
            pg8::EpiProj E{(bf16_t*)(F.ws + WS_PA), (const float*)(F.ws + WS_RSTD1), F.ctl + CW_KMAX + l * 64 * 16};
            pg8::gemm_phase<pg8::EpiProj, pg8::StaticOrder, true>(F.tid, F.lds, (const bf16_t*)(F.ws + WS_HB), D, S, E);
            PROBE_END(2); SEAM(pb + 1);
        }
        if (IN(pb + 2) && PM(3)) { FRESH(); PROBE_BEGIN(3);
            const int gw = F.bid * NWAVES + F.wave, NGW = F.G * NWAVES;
            for (int u = gw; u < 2048; u += NGW) pool_unit(F, l, u);
            __syncthreads();
            if (F.wave < HG_WAVES) for (int u = F.wave * F.G + F.bid; u < 32 * HG_NSEG * DUP(0); u += HG_WAVES * F.G) hg_mfma_unit(F, l, u % (32 * HG_NSEG));
            __syncthreads();
            { LAS int* aq = (LAS int*)(F.lds + LDSCTL_OFF + LC_AQ);
              for (int rep = 0; rep < DUP(1); ++rep)
              for (;;) {
                if (F.tid == 0) aq[0] = (int)__hip_atomic_fetch_add(F.ctl + CW_AQ + 16 * (l + 4 * rep), 1u, __ATOMIC_RELAXED, __HIP_MEMORY_SCOPE_AGENT);
                __syncthreads();
                const int idx = aq[0];
                __syncthreads();
                if (idx >= 1024) break;
                attn_unit(F, l, (idx >> 3) & 7, idx & 7, 15 - (idx >> 6)); } }
            PROBE_END(3); SEAM(pb + 2);
        }
        if (IN(pb + 3) && PM(4)) { FRESH(); PROBE_BEGIN(4); hg_fix_phase(F, l); PROBE_END(4); SEAM(pb + 3); }
        if (IN(pb + 4) && PM(5)) { FRESH(); PROBE_BEGIN(5);
            pg8::StaticOrder S; S.init(T, D, D, F.G, F.bid, (const bf16_t*)(F.ws + WS_WOUT + l * WOUT_BYTES));
            if (DUP(8) > 1) { pg8::EpiOut E0{l == 0 ? inp(F, I_x) : F.out, (float*)(F.ws + WS_Y)}; pg8::gemm_phase<pg8::EpiOut, pg8::StaticOrder, true>(F.tid, F.lds, (const bf16_t*)(F.ws + WS_MIXED), D, S, E0); }
            pg8::EpiOut E{l == 0 ? inp(F, I_x) : F.out, F.out};
            pg8::gemm_phase<pg8::EpiOut, pg8::StaticOrder, true>(F.tid, F.lds, (const bf16_t*)(F.ws + WS_MIXED), D, S, E);
            PROBE_END(5); SEAM(pb + 4);
        }
        if (IN(pb + 5) && PM(6)) { FRESH(); PROBE_BEGIN(6); if (DUP(6) > 1) r_phase<1, false, false, true>(F, l, F.out, F.out); r_phase<1, false, false>(F, l, F.out, F.out); PROBE_END(6); SEAM(pb + 5); }
        if ((IN(pb + 6) && PM(7)) || (IN(pb + 7) && PM(8))) { FRESH();
            LAS int* tb = (LAS int*)(F.lds + LDSCTL_OFF + LC_TB); LAS int* cn = (LAS int*)(F.lds + LDSCTL_OFF + LC_CN);
            if (F.tid < NE) cn[F.tid] = (int)__hip_atomic_load(F.ctl + CW_CUR + (l * NE + F.tid) * 16, __ATOMIC_RELAXED, __HIP_MEMORY_SCOPE_AGENT);
            __syncthreads();
            if (F.tid == 0) { int a = 0; for (int e = 0; e < NE; ++e) { tb[e] = a; a += (cn[e] + 255) >> 8; } tb[NE] = a; }
            __syncthreads();
            const int ntile = tb[NE];
            if (IN(pb + 6) && PM(7)) { PROBE_BEGIN(7);
                typedef pg8::MoeOrder<true, W1E_BYTES, (size_t)256 * D> Ord1; Ord1 S; S.rep = DUP(3); S.nM = ntile; S.nN = 2 * FF / 256; S.nwg = S.nM * S.nN; S.G = F.G; S.c = F.bid; S.Wt = (const char*)(F.ws + WS_W1 + (size_t)l * NE * W1E_BYTES);
                S.tb = tb; S.cn = cn; S.list = (const u32x2*)(F.ws + WS_LIST);
                pg8::EpiGlu E{(unsigned char*)(F.ws + WS_PA), (const u32x2*)(F.ws + WS_LIST), (const float*)(F.ws + WS_B1R) + (size_t)l * NE * 2048};
                pg8::gemm_phase<pg8::EpiGlu, Ord1, true, true>(F.tid, F.lds, F.ws + WS_HB8, D, S, E);
                PROBE_END(7); SEAM(pb + 6);
            }
            if (IN(pb + 7) && PM(8)) { FRESH(); PROBE_BEGIN(8);
                typedef pg8::MoeOrder<false, W2E_BYTES, (size_t)256 * FF> Ord2; Ord2 S; S.rep = DUP(4); S.nM = ntile; S.nN = D / 256; S.nwg = S.nM * S.nN; S.G = F.G; S.c = F.bid; S.Wt = (const char*)(F.ws + WS_W2 + (size_t)l * NE * W2E_BYTES);
                S.tb = tb; S.cn = cn; S.list = (const u32x2*)(F.ws + WS_LIST);
                pg8::EpiDown E{(unsigned char*)(F.ws + WS_Y), (const u32x2*)(F.ws + WS_LIST), (const float*)(F.ws + WS_GATE), inp(F, I_b2) + (size_t)l * NE * D};
                pg8::gemm_phase<pg8::EpiDown, Ord2, true, true>(F.tid, F.lds, F.ws + WS_PA, FF, S, E);
                PROBE_END(8); SEAM(pb + 7);
            }
        }
    }
    if (IN(N_PHASES - 1) && PM(9)) { FRESH(); PROBE_BEGIN(9); r_final(F); PROBE_END(9); }
#ifndef PROBE_BLOCK
#define PROBE_BLOCK 0
#endif
    if (PROBEMASK != 0 && blockIdx.x == PROBE_BLOCK) { const unsigned long long tw = __builtin_amdgcn_s_memrealtime(); while (__builtin_amdgcn_s_memrealtime() - tw < probe_acc) __builtin_amdgcn_s_sleep(8); }
#undef IN
#undef SEAM
}

extern "C" void kernel_launch(void* const* d_in, const int* in_sizes, int n_in, void* d_out, int out_size, void* d_ws, size_t ws_size, hipStream_t stream) {
    static int grid = 0;
    if (grid == 0) {
        if (n_in != 18 || out_size != T * D || ws_size < WS_END) { fprintf(stderr, "kernel_launch: unexpected shapes (n_in %d out %d ws %zu need %zu)\n", n_in, out_size, ws_size, (size_t)WS_END); grid = -1; return; }
        int dev = 0, cus = 0;
        if (hipGetDevice(&dev) != hipSuccess || hipDeviceGetAttribute(&cus, hipDeviceAttributeMultiprocessorCount, dev) != hipSuccess) { grid = -1; return; }
        if (hipFuncSetAttribute((const void*)trunk_fwd, hipFuncAttributeMaxDynamicSharedMemorySize, LDS_BYTES) != hipSuccess) { fprintf(stderr, "kernel_launch: hipFuncSetAttribute failed\n"); grid = -1; return; }
        int per_cu = 0;
        if (hipOccupancyMaxActiveBlocksPerMultiprocessor(&per_cu, (const void*)trunk_fwd, NTHREADS, LDS_BYTES) != hipSuccess || per_cu < 1) { fprintf(stderr, "kernel_launch: occupancy query says %d\n", per_cu); (void)hipGetLastError(); }
        grid = cus;
    }
    if (grid < 0) return;
    (void)hipMemsetAsync((char*)d_ws + WS_CTL, 0, CTL_ZERO_BYTES, stream);
    Args a{};
    for (int i = 0; i < 18; ++i) a.in[i] = (const float*)d_in[i];
    a.out = (float*)d_out; a.ws = (unsigned char*)d_ws;
#if MK_SPLIT
    for (int p = 0; p < N_PHASES; ++p) { a.ph_lo = p; a.ph_hi = p + 1; hipLaunchKernelGGL(trunk_fwd, dim3(grid), dim3(NTHREADS), LDS_BYTES, stream, a); }
#else
    a.ph_lo = 0; a.ph_hi = N_PHASES; hipLaunchKernelGGL(trunk_fwd, dim3(grid), dim3(NTHREADS), LDS_BYTES, stream, a);
#endif
}
```

```cpp
#include <hip/hip_runtime.h>
#include <cstdio>
#include <cstdint>

#ifndef MK_SPLIT
#define MK_SPLIT 0
#endif

#ifndef DUPMASK
#define DUPMASK 0
#endif
#define DUP(b) (1 + ((DUPMASK >> (b)) & 1))
#define LAS __attribute__((address_space(3)))
#define GAS __attribute__((address_space(1)))
typedef unsigned short bf16_t;
typedef short bf16x8 __attribute__((ext_vector_type(8)));
typedef float f32x4 __attribute__((ext_vector_type(4)));
typedef float f32x2 __attribute__((ext_vector_type(2)));
typedef float f32x16 __attribute__((ext_vector_type(16)));
typedef unsigned u32x4 __attribute__((ext_vector_type(4)));
typedef unsigned u32x2 __attribute__((ext_vector_type(2)));
typedef __bf16 bf16x2_t __attribute__((ext_vector_type(2)));
typedef short v4i16_t __attribute__((ext_vector_type(4)));
typedef int v8i __attribute__((ext_vector_type(8)));
struct bf16x8_pair { bf16x8 a, b; };

constexpr int NB = 8, SEQ = 4096, T = NB * SEQ, D = 1024, NL = 4;
constexpr int NPROJ = 2816;
constexpr int C_FQ = 0, C_FK = 512, C_FV = 1024, C_GQ = 1536, C_GF = 1792, C_GI = 2048, C_GG = 2304, C_PU = 2560;
constexpr int IN_COLS = 2824;
constexpr int NE = 32, TOPK = 4, FF = 1024, MROWS = T * TOPK, LISTCAP = MROWS, MAXTILES = MROWS / 256 + NE;
constexpr float RMS_EPS = 1e-5f, LOG2E = 1.4426950408889634f;
constexpr float QSCALE = 0.125f * LOG2E;
constexpr int NWAVES = 8, NTHREADS = 512;

constexpr size_t MiB = 1u << 20;
constexpr size_t WS_CTL = 0, CTL_ZERO_BYTES = 1 * MiB;
constexpr size_t WS_RSTD1 = 1 * MiB, WS_RSTD2 = WS_RSTD1 + 128 * 1024;
constexpr size_t WS_LOGF = 2 * MiB, WS_C2 = 3 * MiB, WS_GATE = 4 * MiB, WS_B1R = 5 * MiB, WS_WFRAG = 6 * MiB, WS_LIST = 8 * MiB;
constexpr size_t WS_WIN = 40 * MiB, WIN_BYTES = (size_t)NPROJ * D * 2;
constexpr size_t WS_WOUT = 62 * MiB, WOUT_BYTES = (size_t)D * D * 2;
constexpr size_t WS_W1 = 70 * MiB, W1E_BYTES = (size_t)2 * FF * D;
constexpr size_t WS_W2 = 582 * MiB, W2E_BYTES = (size_t)D * FF;
constexpr size_t WS_HB8 = 400 * MiB;
constexpr float W1_SCALE = 64.f, W2_SCALE = 128.f, ACT_SCALE = 4.f, Y_SCALE = 16.f;
constexpr size_t WS_HB = 838 * MiB;
constexpr size_t WS_PA = 902 * MiB;
constexpr size_t WS_MIXED = WS_PA + 176 * MiB;
constexpr size_t WS_Y = 1174 * MiB;
constexpr size_t WS_ORAW = 1430 * MiB;
constexpr size_t WS_SEND = 1558 * MiB;
constexpr size_t WS_PSEG = 1566 * MiB;
constexpr size_t WS_QE = 1567 * MiB;
constexpr size_t WS_PWT = 1583 * MiB;
constexpr size_t WS_SEND2 = 1584 * MiB;
constexpr size_t WS_END = 1600 * MiB;
static_assert(WS_WIN + NL * WIN_BYTES <= WS_WOUT && WS_WOUT + NL * WOUT_BYTES <= WS_W1 && WS_W1 + (size_t)NL * NE * W1E_BYTES <= WS_W2 && WS_W2 + (size_t)NL * NE * W2E_BYTES <= WS_HB, "ws map");
static_assert((size_t)MAXTILES * 256 * FF * 2 <= 272 * MiB && (size_t)T * NPROJ * 2 <= 176 * MiB, "ws map 2");
constexpr int CW_TMO = 0, CW_BAR = 4096, CW_CUR = 16384, CW_KMAX = 32768, CW_AQ = 40960, CW_GQ = 45056;
constexpr int PH_BYTES = 139264, LDSCTL_OFF = PH_BYTES, LDS_BYTES = PH_BYTES + 2048;
static_assert(PH_BYTES >= 131072 + 512 * 16, "GEMM phase: stage buffers + parked A offsets");
constexpr int LC_BAR = 0, LC_TB = 64, LC_CN = 256, LC_R2CNT = 512, LC_R2BASE = 640, LC_STOP = 768, LC_SCAN = 896, LC_INP = 1024, LC_AQ = 1280, LC_GQ = 1296;

__device__ __forceinline__ unsigned cvtpk(float lo, float hi) { f32x2 v = {lo, hi}; bf16x2_t b = __builtin_convertvector(v, bf16x2_t); return __builtin_bit_cast(unsigned, b); }
__device__ __forceinline__ float bflo(unsigned w) { return __uint_as_float(w << 16); }
__device__ __forceinline__ float bfhi(unsigned w) { return __uint_as_float(w & 0xffff0000u); }
__device__ __forceinline__ float bf2f(bf16_t h) { return __uint_as_float((unsigned)h << 16); }
__device__ __forceinline__ bf16_t f2bf(float f) { return (bf16_t)(cvtpk(f, 0.f) & 0xffffu); }
__device__ __forceinline__ float rdlane(float v, int l) { return __uint_as_float((unsigned)__builtin_amdgcn_readlane((int)__float_as_uint(v), l)); }
__device__ __forceinline__ unsigned pk4_fp8(float a, float b, float c, float d) { int w = __builtin_amdgcn_cvt_pk_fp8_f32(a, b, 0, false); w = __builtin_amdgcn_cvt_pk_fp8_f32(c, d, w, true); return (unsigned)w; }
__device__ __forceinline__ unsigned pk4_fp8_sat(float a, float b, float c, float d) {
    return pk4_fp8(__builtin_amdgcn_fmed3f(a, -448.f, 448.f), __builtin_amdgcn_fmed3f(b, -448.f, 448.f), __builtin_amdgcn_fmed3f(c, -448.f, 448.f), __builtin_amdgcn_fmed3f(d, -448.f, 448.f)); }
__device__ __forceinline__ f32x4 un4_fp8(unsigned w) { const f32x2 a = __builtin_amdgcn_cvt_pk_f32_fp8((int)w, false), b = __builtin_amdgcn_cvt_pk_f32_fp8((int)w, true); return (f32x4){a.x, a.y, b.x, b.y}; }
#define LDS_WAIT() asm volatile("s_waitcnt lgkmcnt(0)" ::: "memory")
#define VM_WAIT() asm volatile("s_waitcnt vmcnt(0)" ::: "memory")

__device__ __forceinline__ unsigned hw_xcc_id() { return (unsigned)__builtin_amdgcn_s_getreg((3 << 11) | 20) & 0x7u; }
namespace pg8 {
constexpr int BM = 256, BK = 64, HALF = 128, HTB = HALF * BK * 2, STAGE_BYTES = 8 * HTB, NXCD = 8, WGM = 8;
__host__ __device__ __forceinline__ int lds_byte(int r, int c) { const int st = (r >> 4) * 2 + (c >> 5), rr = r & 15, cc = c & 31, ob = rr * 64 + cc * 2; return st * 1024 + (ob ^ (((ob >> 9) & 1) << 5)); }
__host__ __device__ __forceinline__ void stage_rc(int b, int& R, int& C) { const int st = b / 1024, sb = b % 1024, swz = sb ^ (((sb >> 9) & 1) << 5); R = (st >> 1) * 16 + swz / 64; C = (st & 1) * 32 + (swz % 64) / 2; }
__host__ __device__ __forceinline__ int perm32(int rho) { const int n = rho >> 4, i = rho & 15; return 8 * (i >> 2) + 4 * n + (i & 3); }

struct Unit { int pm, pn, e, lt, cnt; };

__device__ __forceinline__ void tile_of(int L, int nM, int nN, int& pm, int& pn) {
    const int nwg = nM * nN; int wgid = L;
    { const int q = nwg / NXCD, r = nwg % NXCD, xcd = wgid % NXCD, off = wgid / NXCD; wgid = (xcd < r ? xcd * (q + 1) : r * (q + 1) + (xcd - r) * q) + off; }
    const int nig = WGM * nN, gid = wgid / nig, fm = gid * WGM, gsz = (nM - fm) < WGM ? (nM - fm) : WGM;
    pm = fm + ((wgid % nig) % gsz); pn = (wgid % nig) / gsz;
}
struct StaticOrder {
    static constexpr bool DYN = false;
    int nM, nN, nwg, G, c, rep = 1; const char* Bt; size_t tstep;
    __device__ void init(int M, int N, int K, int G_, int c_, const bf16_t* Bt_) { nM = M / BM; nN = N / BM; nwg = nM * nN; G = G_; c = c_; Bt = (const char*)Bt_; tstep = (size_t)BM * K * 2; }
    __device__ __forceinline__ bool next(int i, Unit& u) const { long L = (long)i * G + c; if (L >= (long)nwg * rep) return false; L %= nwg; tile_of((int)L, nM, nN, u.pm, u.pn); u.e = 0; u.lt = 0; u.cnt = 0; return true; }
    __device__ __forceinline__ const char* bbase(const Unit& u) const { return Bt + (size_t)u.pn * tstep; }
    __device__ __forceinline__ int arow(const Unit& u, int r) const { return u.pm * BM + r; }
    __device__ __forceinline__ unsigned claim() const { return 0u; }
    __device__ __forceinline__ bool unit_of(unsigned, Unit&) const { return false; }
};
template <bool GATHER, size_t ESTRIDE, size_t TSTEP> struct MoeOrder {
    static constexpr bool DYN = true;
    static constexpr size_t estride = ESTRIDE, tstep = TSTEP;
    int nM, nN, nwg, G, c, rep = 1; const char* Wt; LAS const int* tb; LAS const int* cn; const u32x2* list; unsigned* qctr; int xcc; LAS int* koffp;
    __device__ __forceinline__ int qsize(int q8) const { return nwg / NXCD + (q8 < nwg % NXCD ? 1 : 0); }
    __device__ __forceinline__ unsigned claim() const {
        for (int koff = *koffp; koff < NXCD; ++koff) { const int q8 = (xcc + koff) & (NXCD - 1); const unsigned idx = __hip_atomic_fetch_add(qctr + 16 * q8, 1u, __ATOMIC_RELAXED, __HIP_MEMORY_SCOPE_AGENT);
            if ((int)idx < qsize(q8)) { *koffp = koff; return ((unsigned)q8 << 24) | idx; } }
        *koffp = NXCD; return 0xffffffffu; }
    __device__ __forceinline__ bool unit_of(unsigned val, Unit& u) const {
        if (val == 0xffffffffu) return false;
        const int q8 = (int)(val >> 24), idx = (int)(val & 0xffffffu), q = nwg / NXCD, r = nwg % NXCD, base = (q8 < r ? q8 * (q + 1) : r * (q + 1) + (q8 - r) * q);
        const int wgid = base + idx, nig = WGM * nN, gid = wgid / nig, fm = gid * WGM, gsz = (nM - fm) < WGM ? (nM - fm) : WGM;
        u.pm = fm + ((wgid % nig) % gsz); u.pn = (wgid % nig) / gsz;
        int e = 0; while (e < NE - 1 && __builtin_amdgcn_readfirstlane(tb[e + 1]) <= u.pm) ++e;
        u.e = e; u.lt = u.pm - __builtin_amdgcn_readfirstlane(tb[e]); u.cnt = __builtin_amdgcn_readfirstlane(cn[e]); return true; }
    __device__ __forceinline__ bool next(int, Unit&) const { return false; }
    __device__ __forceinline__ const char* bbase(const Unit& u) const { return Wt + (size_t)u.e * estride + (size_t)u.pn * tstep; }
    __device__ __forceinline__ int arow(const Unit& u, int r) const {
        if (!GATHER) return u.pm * BM + r;
        const int pos = u.lt * BM + r; const char* lb = (const char*)(list + (size_t)u.e * LISTCAP);
        return pos < u.cnt ? (int)(*(const unsigned*)(lb + (unsigned)pos * 8u) >> 2) : 0; }
};

template <class Epi, class Sched, bool ALIGN_EPI, bool FP8 = false>
__device__ __forceinline__ void gemm_phase(const int tid, LAS unsigned char* lds, const void* Abase, const int  , const Sched& S, const Epi& E) {
    constexpr int K = 1024;
    const int wid = __builtin_amdgcn_readfirstlane(tid >> 6), lane = tid & 63, wr = wid >> 2, wc = wid & 3, fr = lane & 15, fq = lane >> 4;
    constexpr int rowB = FP8 ? K : 2 * K;
    constexpr int nt = rowB / (BK * 2);
    unsigned voffB[2];
#pragma unroll
    for (int i = 0; i < 2; ++i) { int R, C; stage_rc(tid * 16 + i * 8192, R, C); const int Rb = Epi::PERM ? ((R & ~31) + perm32(R & 31)) : R; voffB[i] = (unsigned)(Rb * rowB + C * 2); }
    constexpr size_t kstep = (size_t)(BK * 2);
    constexpr size_t hstep = (size_t)HALF * rowB;
    const unsigned ldsw = (unsigned)wid * 1024u;
    const int a8off = (fq >> 1) * 1024 + ((fr * 64 + 32 * (fq & 1)) ^ (((fr >> 3) & 1) << 5));
    const int aoff = FP8 ? (wr * 8192 + a8off) : lds_byte(wr * 64 + fr, fq * 8), boff = FP8 ? (wc * 4096 + a8off) : lds_byte(wc * 32 + fr, fq * 8);
    const char* A8 = (const char*)Abase;
#define PG8_SA(b, h) (((b) * 2 + (h)) * HTB)
#define PG8_SB(b, h) ((4 + (b) * 2 + (h)) * HTB)
#define PG8_STGB(bufoff, gbase) do { _Pragma("unroll") for (int _i = 0; _i < 2; ++_i) \
        __builtin_amdgcn_global_load_lds((const unsigned*)((const char*)(gbase) + voffB[_i]), (LAS unsigned*)(lds + (bufoff) + ldsw + _i * 8192), 16, 0, 0); } while (0)
#define PG8_STGA(bufoff, kb, o0, o1) do { \
        __builtin_amdgcn_global_load_lds((const unsigned*)(A8 + (size_t)(kb) + (o0)), (LAS unsigned*)(lds + (bufoff) + ldsw), 16, 0, 0); \
        __builtin_amdgcn_global_load_lds((const unsigned*)(A8 + (size_t)(kb) + (o1)), (LAS unsigned*)(lds + (bufoff) + ldsw + 8192), 16, 0, 0); } while (0)
#define PG8_LD8(off) __builtin_bit_cast(v8i, bf16x8_pair{*(const LAS bf16x8*)(lds + (off)), *(const LAS bf16x8*)(lds + (off) + 16)})
#define PG8_LDA(dst, b, h) do { if constexpr (FP8) { _Pragma("unroll") for (int m = 0; m < 4; ++m) dst##8[m] = PG8_LD8(PG8_SA(b, h) + aoff + m * 2048); } \
        else { _Pragma("unroll") for (int m = 0; m < 4; ++m) _Pragma("unroll") for (int k = 0; k < 2; ++k) dst[m][k] = *(const LAS bf16x8*)(lds + PG8_SA(b, h) + aoff + m * 2048 + k * 1024); } } while (0)
#define PG8_LDB(dst, b, h) do { if constexpr (FP8) { _Pragma("unroll") for (int n = 0; n < 2; ++n) dst##8[n] = PG8_LD8(PG8_SB(b, h) + boff + n * 2048); } \
        else { _Pragma("unroll") for (int n = 0; n < 2; ++n) _Pragma("unroll") for (int k = 0; k < 2; ++k) dst[n][k] = *(const LAS bf16x8*)(lds + PG8_SB(b, h) + boff + n * 2048 + k * 1024); } } while (0)
#define PG8_MMA(ai, bj, At, Bt) do { __builtin_amdgcn_s_setprio(1); _Pragma("unroll") for (int m = 0; m < 4; ++m) _Pragma("unroll") for (int n = 0; n < 2; ++n) { \
        if constexpr (FP8) asm volatile("v_mfma_f32_16x16x128_f8f6f4 %0, %1, %2, %0" : "+v"(acc[ai][bj][m][n]) : "v"(Bt##8[n]), "v"(At##8[m]));     \
        else { _Pragma("unroll") for (int k = 0; k < 2; ++k) acc[ai][bj][m][n] = __builtin_amdgcn_mfma_f32_16x16x32_bf16(Bt[n][k], At[m][k], acc[ai][bj][m][n], 0, 0, 0); } } __builtin_amdgcn_s_setprio(0); } while (0)
#define PG8_WAIT_V(n) asm volatile("s_waitcnt vmcnt(" #n ")" ::: "memory")
#define PG8_WAIT_L(n) asm volatile("s_waitcnt lgkmcnt(" #n ")" ::: "memory")
#define PG8_BAR __builtin_amdgcn_s_barrier()
#define PG8_SCHED __builtin_amdgcn_sched_barrier(0)
#define PG8_AOFF(u, dst) do { int t_ = tid; asm volatile("" : "+v"(t_));     \
        _Pragma("unroll") for (int _h = 0; _h < 2; ++_h) _Pragma("unroll") for (int _i = 0; _i < 2; ++_i) \
        { int R_, C_; stage_rc(t_ * 16 + _i * 8192, R_, C_); dst[_h][_i] = (unsigned)((size_t)S.arow(u, _h * HALF + R_) * (size_t)rowB + (size_t)(C_ * 2)); } } while (0)
    Unit cur, nxt; int ui = 0;
    LAS unsigned* slotv = (LAS unsigned*)(lds + STAGE_BYTES + 8192 + LC_GQ);
    if constexpr (Sched::DYN) {
        if (tid == 0) { slotv[2] = 0u; slotv[0] = S.claim(); slotv[1] = S.claim(); }
        __syncthreads();
        if (!S.unit_of((unsigned)__builtin_amdgcn_readfirstlane((int)slotv[0]), cur)) return;
    } else { if (!S.next(0, cur)) return; }
    f32x4 acc[2][2][4][2];
#pragma unroll
    for (int a = 0; a < 2; ++a)
#pragma unroll
        for (int b = 0; b < 2; ++b)
#pragma unroll
            for (int m = 0; m < 4; ++m)
#pragma unroll
                for (int n = 0; n < 2; ++n) acc[a][b][m][n] = (f32x4){0.f, 0.f, 0.f, 0.f};
    bf16x8 At[4][2], B0[2][2], B1[2][2]; v8i At8[4], B08[2], B18[2];
    unsigned aoC[2][2], aoN[2][2];
    PG8_AOFF(cur, aoC);
    const char* cB = S.bbase(cur);
    PG8_STGB(PG8_SB(0, 0), cB); PG8_STGB(PG8_SB(0, 1), cB + hstep); PG8_STGA(PG8_SA(0, 0), 0, aoC[0][0], aoC[0][1]); PG8_STGA(PG8_SA(0, 1), 0, aoC[1][0], aoC[1][1]);
    if (wr == 1) PG8_BAR;
    PG8_WAIT_V(2); PG8_BAR;
    PG8_STGB(PG8_SB(1, 0), cB + kstep); PG8_STGA(PG8_SA(1, 0), kstep, aoC[0][0], aoC[0][1]); PG8_STGB(PG8_SB(1, 1), cB + hstep + kstep);
    PG8_WAIT_V(6); PG8_BAR;
    for (;;) {
        bool has_next = false; const char* nB = cB;
#define PG8_PICK_NEXT() do { if (has_next) { PG8_AOFF(nxt, aoN); } else { aoN[0][0] = aoC[0][0]; aoN[0][1] = aoC[0][1]; aoN[1][0] = aoC[1][0]; aoN[1][1] = aoC[1][1]; } \
        *(LAS u32x4*)(lds + STAGE_BYTES + tid * 16) = (u32x4){aoN[0][0], aoN[0][1], aoN[1][0], aoN[1][1]};     \
        nB = has_next ? S.bbase(nxt) : cB; } while (0)
        if constexpr (!Sched::DYN) { has_next = S.next(ui + 1, nxt); PG8_PICK_NEXT(); }
        for (int t = 0; t < nt; t += 2) {
            if constexpr (Sched::DYN) { if (t == 2) { has_next = S.unit_of((unsigned)__builtin_amdgcn_readfirstlane((int)slotv[(ui + 1) & 1]), nxt); PG8_PICK_NEXT(); } }
            asm volatile("" : "+v"(voffB[0]), "+v"(voffB[1]));
            const bool last = (t == nt - 2);
            const size_t k1 = (size_t)(t + 1) * kstep, k2 = last ? 0 : (size_t)(t + 2) * kstep, k3 = k2 + kstep;
            const char* b2 = last ? nB : cB + (size_t)(t + 2) * kstep; const char* b3 = b2 + kstep;
            PG8_LDB(B0, 0, 0); PG8_LDB(B1, 0, 1); PG8_SCHED; PG8_LDA(At, 0, 0); PG8_STGA(PG8_SA(1, 1), k1, aoC[1][0], aoC[1][1]);
            PG8_WAIT_V(8); PG8_WAIT_L(0); PG8_BAR; PG8_MMA(0, 0, At, B0); PG8_MMA(0, 1, At, B1); PG8_BAR; PG8_SCHED;
            if (last) { const u32x4 nx = *(const LAS u32x4*)(lds + STAGE_BYTES + tid * 16); aoC[0][0] = nx.x; aoC[0][1] = nx.y; aoC[1][0] = nx.z; aoC[1][1] = nx.w; }
            PG8_LDA(At, 0, 1); PG8_STGB(PG8_SB(0, 0), b2); PG8_STGB(PG8_SB(0, 1), b2 + hstep); PG8_STGA(PG8_SA(0, 0), k2, aoC[0][0], aoC[0][1]);
            PG8_WAIT_V(8); PG8_WAIT_L(0); PG8_BAR; PG8_MMA(1, 0, At, B0); PG8_MMA(1, 1, At, B1); PG8_BAR; PG8_SCHED;
            PG8_LDB(B0, 1, 0); PG8_LDB(B1, 1, 1); PG8_SCHED; PG8_LDA(At, 1, 0); PG8_STGA(PG8_SA(0, 1), k2, aoC[1][0], aoC[1][1]);
            PG8_WAIT_V(8); PG8_WAIT_L(0); PG8_BAR; PG8_MMA(0, 0, At, B0); PG8_MMA(0, 1, At, B1); PG8_BAR; PG8_SCHED;
            PG8_LDA(At, 1, 1); PG8_STGB(PG8_SB(1, 0), b3); PG8_STGB(PG8_SB(1, 1), b3 + hstep); PG8_STGA(PG8_SA(1, 0), k3, aoC[0][0], aoC[0][1]);
            PG8_WAIT_V(8); PG8_WAIT_L(0); PG8_BAR; PG8_MMA(1, 0, At, B0); PG8_MMA(1, 1, At, B1); PG8_BAR; PG8_SCHED;
        }
        if constexpr (FP8) asm volatile("s_nop 15\n\ts_nop 15" ::: "memory");
        if constexpr (ALIGN_EPI) { if (wr == 0) PG8_BAR; }
        unsigned claimv = 0u; if constexpr (Sched::DYN) { if (tid == 0) claimv = S.claim(); }
        { int t2_ = tid; asm volatile("" : "+v"(t2_)); const int l2_ = t2_ & 63; E(acc, cur, wr, wc, l2_ & 15, l2_ >> 4); }
        if constexpr (Sched::DYN) { if (tid == 0) slotv[ui & 1] = claimv; }
        if (!has_next) break;
#pragma unroll
        for (int a = 0; a < 2; ++a)
#pragma unroll
            for (int b = 0; b < 2; ++b)
#pragma unroll
                for (int m = 0; m < 4; ++m)
#pragma unroll
                    for (int n = 0; n < 2; ++n) acc[a][b][m][n] = (f32x4){0.f, 0.f, 0.f, 0.f};
        cur = nxt; cB = nB; ++ui;
        if constexpr (ALIGN_EPI) { if (wr == 1) PG8_BAR; }
    }
    PG8_WAIT_V(0);
    if constexpr (!ALIGN_EPI) { if (wr == 0) PG8_BAR; }
    PG8_BAR;
#undef PG8_SA
#undef PG8_SB
#undef PG8_STGA
#undef PG8_STGB
#undef PG8_LDA
#undef PG8_LD8
#undef PG8_LDB
#undef PG8_MMA
#undef PG8_WAIT_V
#undef PG8_WAIT_L
#undef PG8_BAR
#undef PG8_SCHED
#undef PG8_AOFF
#undef PG8_PICK_NEXT
}

struct EpiProj {
    static constexpr bool PERM = true;
    bf16_t* O; const float* rstd; unsigned* kmax;
    __device__ __forceinline__ void operator()(const f32x4 (&acc)[2][2][4][2], const Unit& u, int wr, int wc, int fr, int fq) const {
        const int row0 = u.pm * BM + wr * 64 + fr, col0 = u.pn * BM + wc * 32 + 8 * fq;
        const float sc = (u.pn < 2) ? QSCALE : 1.f; const bool isk = (u.pn == 2 || u.pn == 3);
        float km[2] = {0.f, 0.f}; float rsv[8];
#pragma unroll
        for (int g = 0; g < 8; ++g) rsv[g] = rstd[row0 + (g >> 2) * HALF + (g & 3) * 16] * sc;
#pragma unroll
        for (int ai = 0; ai < 2; ++ai)
#pragma unroll
            for (int m = 0; m < 4; ++m) { const int row = row0 + ai * HALF + m * 16; const float rs = rsv[ai * 4 + m]; bf16_t* rowp = O + (size_t)row * NPROJ + col0;
#pragma unroll
                for (int bj = 0; bj < 2; ++bj) { const f32x4 v0 = acc[ai][bj][m][0] * rs, v1 = acc[ai][bj][m][1] * rs;
                    u32x4 w; w.x = cvtpk(v0[0], v0[1]); w.y = cvtpk(v0[2], v0[3]); w.z = cvtpk(v1[0], v1[1]); w.w = cvtpk(v1[2], v1[3]);
                    *(u32x4*)(rowp + bj * HALF) = w;
                    if (isk) { float s = bflo(w.x) * bflo(w.x) + bfhi(w.x) * bfhi(w.x) + bflo(w.y) * bflo(w.y) + bfhi(w.y) * bfhi(w.y) + bflo(w.z) * bflo(w.z) + bfhi(w.z) * bfhi(w.z) + bflo(w.w) * bflo(w.w) + bfhi(w.w) * bfhi(w.w);
                        s += __shfl_xor(s, 16); s += __shfl_xor(s, 32); km[bj] = fmaxf(km[bj], s); } } }
        if (isk) {
#pragma unroll
            for (int bj = 0; bj < 2; ++bj) { float v = km[bj]; v = fmaxf(v, __shfl_xor(v, 1)); v = fmaxf(v, __shfl_xor(v, 2)); v = fmaxf(v, __shfl_xor(v, 4)); v = fmaxf(v, __shfl_xor(v, 8));
                if ((threadIdx.x & 63) == 0) { const int b = u.pm >> 4, h = (u.pn - 2) * 4 + bj * 2 + (wc >> 1); atomicMax(kmax + (b * 8 + h) * 16, __float_as_uint(v)); } }
        }
    }
};
struct EpiOut {
    static constexpr bool PERM = false;
    const float* res; float* out;
    __device__ __forceinline__ void operator()(const f32x4 (&acc)[2][2][4][2], const Unit& u, int wr, int wc, int fr, int fq) const {
        const int row0 = u.pm * BM + wr * 64 + fr, col0 = u.pn * BM + wc * 32 + 4 * fq;
        f32x4 r[2][4];
#pragma unroll
        for (int q = 0; q < 4; ++q) r[0][q] = *(const f32x4*)(res + (size_t)row0 * D + col0 + (q >> 1) * HALF + (q & 1) * 16);
#pragma unroll
        for (int g = 0; g < 8; ++g) { const int ai = g >> 2, m = g & 3; const size_t off = (size_t)(row0 + ai * HALF + m * 16) * D + col0;
            if (g + 1 < 8) { const int ai2 = (g + 1) >> 2, m2 = (g + 1) & 3; const size_t off2 = (size_t)(row0 + ai2 * HALF + m2 * 16) * D + col0;
#pragma unroll
                for (int q = 0; q < 4; ++q) r[(g + 1) & 1][q] = *(const f32x4*)(res + off2 + (q >> 1) * HALF + (q & 1) * 16); }
#pragma unroll
            for (int q = 0; q < 4; ++q) *(f32x4*)(out + off + (q >> 1) * HALF + (q & 1) * 16) = r[g & 1][q] + acc[ai][q >> 1][m][q & 1]; }
    }
};
struct EpiGlu {
    static constexpr bool PERM = true;
    unsigned char* act; const u32x2* list; const float* b1r;
    __device__ __forceinline__ void operator()(const f32x4 (&acc)[2][2][4][2], const Unit& u, int wr, int wc, int fr, int fq) const {
        const int cb = u.pn * BM + wc * 32 + 8 * fq; const float* bp = b1r + (size_t)u.e * 2048 + cb; const char* lbase = (const char*)(list + (size_t)u.e * LISTCAP);
        float rsv[8];
#pragma unroll
        for (int g = 0; g < 8; ++g) { const int pos = u.lt * BM + (g >> 2) * HALF + wr * 64 + (g & 3) * 16 + fr; rsv[g] = 0.f; if (pos < u.cnt) rsv[g] = __uint_as_float(*(const unsigned*)(lbase + (unsigned)pos * 8u + 4u)) * (1.0f / W1_SCALE); }
        const f32x4 bg0 = *(const f32x4*)(bp), bg1 = *(const f32x4*)(bp + 4), bl0 = *(const f32x4*)(bp + HALF), bl1 = *(const f32x4*)(bp + HALF + 4);
#pragma unroll
        for (int ai = 0; ai < 2; ++ai)
#pragma unroll
            for (int m = 0; m < 4; ++m) { const int r = ai * HALF + wr * 64 + m * 16 + fr;
                const float rs = rsv[ai * 4 + m];
                float o[8];
                const f32x2 rs2 = {rs, rs};
#pragma unroll
                for (int p = 0; p < 4; ++p) {
                    const f32x4& ag = acc[ai][0][m][p >> 1]; const f32x4& al = acc[ai][1][m][p >> 1]; const f32x4& bgv = (p >> 1) ? bg1 : bg0; const f32x4& blv = (p >> 1) ? bl1 : bl0; const int q = 2 * (p & 1);
                    f32x2 g = (f32x2){ag[q], ag[q + 1]} * rs2 + (f32x2){bgv[q], bgv[q + 1]}, li = (f32x2){al[q], al[q + 1]} * rs2 + (f32x2){blv[q], blv[q + 1]};
                    g.x = __builtin_fminf(g.x, 7.f); g.y = __builtin_fminf(g.y, 7.f); li.x = __builtin_amdgcn_fmed3f(li.x, -7.f, 7.f); li.y = __builtin_amdgcn_fmed3f(li.y, -7.f, 7.f);
                    const f32x2 ea = g * (-1.702f * LOG2E); f32x2 d; d.x = __builtin_amdgcn_exp2f(ea.x); d.y = __builtin_amdgcn_exp2f(ea.y); d = d + 1.0f;
                    f32x2 rc; rc.x = __builtin_amdgcn_rcpf(d.x); rc.y = __builtin_amdgcn_rcpf(d.y);
                    const f32x2 tt = li * ACT_SCALE + ACT_SCALE, oo = (g * tt) * rc;
                    o[2 * p] = oo.x; o[2 * p + 1] = oo.y; }
                *(u32x2*)(act + (size_t)(u.pm * BM + r) * FF + u.pn * HALF + wc * 32 + 8 * fq) = (u32x2){pk4_fp8(o[0], o[1], o[2], o[3]), pk4_fp8(o[4], o[5], o[6], o[7])}; }
    }
};
struct EpiDown {
    static constexpr bool PERM = true;
    unsigned char* Y; const u32x2* list; const float* gate; const float* b2;
    __device__ __forceinline__ void operator()(const f32x4 (&acc)[2][2][4][2], const Unit& u, int wr, int wc, int fr, int fq) const {
        const int cb = u.pn * BM + wc * 32 + 8 * fq; const float* bp = b2 + (size_t)u.e * D + cb;
        f32x4 bv[2][2];
#pragma unroll
        for (int bj = 0; bj < 2; ++bj)
#pragma unroll
            for (int n = 0; n < 2; ++n) bv[bj][n] = *(const f32x4*)(bp + bj * HALF + 4 * n);
        unsigned entv[8]; float gtv[8];
#pragma unroll
        for (int g = 0; g < 8; ++g) { const int pos = u.lt * BM + (g >> 2) * HALF + wr * 64 + (g & 3) * 16 + fr; entv[g] = (pos < u.cnt) ? list[(size_t)u.e * LISTCAP + pos].x : 0xffffffffu; }
#pragma unroll
        for (int g = 0; g < 8; ++g) gtv[g] = (entv[g] != 0xffffffffu) ? gate[entv[g]] * Y_SCALE : 0.f;
#pragma unroll
        for (int ai = 0; ai < 2; ++ai)
#pragma unroll
            for (int m = 0; m < 4; ++m) {
                if (entv[ai * 4 + m] != 0xffffffffu) { const unsigned ent = entv[ai * 4 + m]; const float gt = gtv[ai * 4 + m]; unsigned char* rowp = Y + (size_t)ent * D + cb;
#pragma unroll
                    for (int bj = 0; bj < 2; ++bj) { const f32x4 v0 = (acc[ai][bj][m][0] * (1.0f / (W2_SCALE * ACT_SCALE)) + bv[bj][0]) * gt, v1 = (acc[ai][bj][m][1] * (1.0f / (W2_SCALE * ACT_SCALE)) + bv[bj][1]) * gt;
                        *(u32x2*)(rowp + bj * HALF) = (u32x2){pk4_fp8_sat(v0[0], v0[1], v0[2], v0[3]), pk4_fp8_sat(v1[0], v1[1], v1[2], v1[3])}; } } }
    }
};
}

#define XB_TMO      128
#define XB_XCNT(j)  (256  + 64 * (j))
#define XB_XSUB(j)  (1280 + 64 * (j))
#define XB_XGEN(j)  (2304 + 64 * (j))
#define XB_TOP      3328
#define XB_TOPGEN   3392
#define XCD_BAR_WORDS 3456
#define XB_SPIN_CAP (1u << 18)
__device__ __forceinline__ unsigned xb_ld(unsigned* p)              { return __hip_atomic_load(p, __ATOMIC_RELAXED, __HIP_MEMORY_SCOPE_AGENT); }
__device__ __forceinline__ unsigned xb_add(unsigned* p, unsigned v) { return __hip_atomic_fetch_add(p, v, __ATOMIC_RELAXED, __HIP_MEMORY_SCOPE_AGENT); }
__device__ __forceinline__ unsigned xb_xcc_id() { return (unsigned)__builtin_amdgcn_s_getreg((3 << 11) | 20) & 0xFu; }
#define XB_SPIN(cond, bar) do { unsigned _sp = 0; while (cond) { __builtin_amdgcn_s_sleep(1); \
    if ((++_sp & 255u) == 0u) { if (xb_ld(&(bar)[XB_TMO])) break; if (_sp > XB_SPIN_CAP) { atomicAdd(&(bar)[XB_TMO], 1u); break; } } } } while (0)
struct XcdBarrier { unsigned* bar; unsigned x; volatile LAS unsigned* st; };
__device__ __forceinline__ XcdBarrier xcd_barrier_post(unsigned* bar, volatile LAS unsigned* st) {
    XcdBarrier b; b.bar = bar; b.x = xb_xcc_id(); b.st = st;
    if (threadIdx.x == 0) (void)xb_add(&bar[XB_XCNT(b.x)], 1u);
    return b;
}
__device__ __forceinline__ void xcd_barrier_complete(unsigned* bar, unsigned x, unsigned& nloc, unsigned& nx) {
    const unsigned G = gridDim.x * gridDim.y * gridDim.z;
    unsigned sum, cnt, mine, sp = 0u;
    for (;;) {
        sum = 0u; cnt = 0u; mine = 0u;
#pragma unroll
        for (unsigned j = 0; j < 16; ++j) { const unsigned c = xb_ld(&bar[XB_XCNT(j)]); sum += c; cnt += (c > 0u) ? 1u : 0u; mine = (j == x) ? c : mine; }
        if (sum == G) break;
        __builtin_amdgcn_s_sleep(1);
        if ((++sp & 255u) == 0u) { if (xb_ld(&bar[XB_TMO])) break; if (sp > XB_SPIN_CAP) { atomicAdd(&bar[XB_TMO], 1u); break; } }
    }
    nloc = mine > 0u ? mine : 1u; nx = cnt > 0u ? cnt : 1u;
}
__device__ __forceinline__ void xcd_barrier(const XcdBarrier& b, const bool leader  ) {
    asm volatile("s_waitcnt vmcnt(0)" ::: "memory");
    __syncthreads();
    if (leader) {
        unsigned* bar = b.bar;
        __builtin_amdgcn_s_waitcnt(0);
        unsigned nloc = b.st[0], nx = b.st[1];
        if (nloc == 0u) { xcd_barrier_complete(bar, b.x, nloc, nx); b.st[0] = nloc; b.st[1] = nx; }
        const unsigned old = xb_add(&bar[XB_XSUB(b.x)], 1u);
        const unsigned gen = old / nloc;
        if (old + 1u == (gen + 1u) * nloc) {
            __builtin_amdgcn_fence(__ATOMIC_RELEASE, "agent");
            asm volatile("s_waitcnt vmcnt(0)" ::: "memory");
            const unsigned og = xb_add(&bar[XB_TOP], 1u);
            const unsigned tg = og / nx;
            if (og + 1u == (tg + 1u) * nx) xb_add(&bar[XB_TOPGEN], 1u);
            else XB_SPIN(xb_ld(&bar[XB_TOPGEN]) == tg, bar);
            __builtin_amdgcn_fence(__ATOMIC_ACQUIRE, "agent");
            xb_add(&bar[XB_XGEN(b.x)], 1u);
            asm volatile("s_waitcnt vmcnt(0)" ::: "memory");
        } else {
            XB_SPIN(xb_ld(&bar[XB_XGEN(b.x)]) == gen, bar);
            __builtin_amdgcn_fence(__ATOMIC_ACQUIRE, "agent");
            asm volatile("s_waitcnt vmcnt(0)" ::: "memory");
        }
    }
    __syncthreads();
}

enum { I_x = 0, I_norm_mix, I_w_in, I_b_fox_f, I_fox_gain, I_hgrn_lb, I_hgrn_gain, I_pool_w, I_pool_scale, I_w_out, I_norm_moe, I_w_router, I_b_router, I_w1, I_b1, I_w2, I_b2, I_norm_final };
struct Frame {
    LAS unsigned char* lds; unsigned char* ws; unsigned* ctl; float* out;
    int tid, lane, wave, bid, G;
};
__device__ __forceinline__ const float* inp(const Frame& F, int i) {
    const LAS unsigned* p = (const LAS unsigned*)(F.lds + LDSCTL_OFF + LC_INP) + 2 * i;
    const unsigned lo = __builtin_amdgcn_readfirstlane(p[0]), hi = __builtin_amdgcn_readfirstlane(p[1]);
    return (const float*)(((unsigned long long)hi << 32) | lo);
}

constexpr int P0_ROWB = 272;
template <bool INTERLEAVED, bool OUT8 = false>
__device__ __forceinline__ void p0_item(const float* src  , int ldn, const float* g  , void* dstv  , int K, int drow0, int extra, LAS unsigned char* tile, int lane, float scale = 1.f) {
    bf16_t* dst = (bf16_t*)dstv; unsigned char* dst8 = (unsigned char*)dstv;
    f32x4 v[16];
    const float* sp = src + (size_t)(lane >> 5) * ldn + 4 * (lane & 31);
#pragma unroll
    for (int j = 0; j < 16; ++j) v[j] = __builtin_nontemporal_load((const f32x4*)(sp + (size_t)(2 * j) * ldn));
    if (g) {
#pragma unroll
        for (int j = 0; j < 16; ++j) v[j] = v[j] * (g[2 * j + (lane >> 5)] * scale);
    } else if (OUT8) {
#pragma unroll
        for (int j = 0; j < 16; ++j) v[j] = v[j] * scale;
    }
#pragma unroll
    for (int j = 0; j < 16; ++j) { const int k = 2 * j + (lane >> 5); const unsigned w0 = cvtpk(v[j][0], v[j][1]), w1 = cvtpk(v[j][2], v[j][3]);
        if (INTERLEAVED) { const unsigned gg = (w0 & 0xffffu) | (w1 << 16), ll = (w0 >> 16) | (w1 & 0xffff0000u);
            *(LAS unsigned*)(tile + k * P0_ROWB + 4 * (lane & 31)) = gg; *(LAS unsigned*)(tile + k * P0_ROWB + 128 + 4 * (lane & 31)) = ll; }
        else *(LAS u32x2*)(tile + k * P0_ROWB + 8 * (lane & 31)) = (u32x2){w0, w1}; }
    LDS_WAIT(); asm volatile("" ::: "memory");
    const int gq = lane >> 4, i16 = lane & 15;
    const LAS unsigned char* rp = tile + (8 * gq + (i16 >> 2)) * P0_ROWB + 8 * (lane & 3);
#pragma unroll
    for (int nb = 0; nb < 8; ++nb) {
        const v4i16_t lo = __builtin_amdgcn_ds_read_tr16_b64_v4i16((LAS v4i16_t*)(rp + nb * 32)), hi = __builtin_amdgcn_ds_read_tr16_b64_v4i16((LAS v4i16_t*)(rp + nb * 32 + 4 * P0_ROWB));
        const int tc = nb * 16 + i16, row = drow0 + tc + (tc >= 64 ? extra : 0);
        if (OUT8) { *(u32x2*)(dst8 + (size_t)row * K + 8 * gq) = (u32x2){pk4_fp8(bf2f((bf16_t)lo[0]), bf2f((bf16_t)lo[1]), bf2f((bf16_t)lo[2]), bf2f((bf16_t)lo[3])), pk4_fp8(bf2f((bf16_t)hi[0]), bf2f((bf16_t)hi[1]), bf2f((bf16_t)hi[2]), bf2f((bf16_t)hi[3]))}; }
        else { const bf16x8 o = (bf16x8){lo[0], lo[1], lo[2], lo[3], hi[0], hi[1], hi[2], hi[3]};
            *(bf16x8*)(dst + (size_t)row * K + 8 * gq) = o; } }
    LDS_WAIT(); asm volatile("" ::: "memory");
}
__device__ __forceinline__ void p0_prologue(const Frame& F) {
    LAS unsigned char* tile = F.lds + F.wave * (32 * P0_ROWB);
    const int gw = F.bid * NWAVES + F.wave, NGW = F.G * NWAVES;
    constexpr int I_IN = 32 * 22, I_OUT = 32 * 8, I_W1 = NE * 32 * 16, I_W2 = NE * 32 * 8, I_L = I_IN + I_OUT + I_W1 + I_W2;
    for (int it = gw; it < NL * I_L; it += NGW) {
        const int l = it / I_L; int r = it % I_L;
        if (r < I_IN) { const int nb = r / 32, kb = r % 32, n0 = 128 * nb, k0 = 32 * kb;
            p0_item<false>(inp(F, I_w_in) + ((size_t)l * D + k0) * IN_COLS + n0 + (n0 >= 1536 ? 8 : 0), IN_COLS, inp(F, I_norm_mix) + l * D + k0, (bf16_t*)(F.ws + WS_WIN + l * WIN_BYTES) + k0, D, n0, 0, tile, F.lane); continue; }
        r -= I_IN;
        if (r < I_OUT) { const int nb = r / 32, kb = r % 32, n0 = 128 * nb, k0 = 32 * kb;
            p0_item<false>(inp(F, I_w_out) + ((size_t)l * D + k0) * D + n0, D, nullptr, (bf16_t*)(F.ws + WS_WOUT + l * WOUT_BYTES) + k0, D, n0, 0, tile, F.lane); continue; }
        r -= I_OUT;
        if (r < I_W1) { const int e = r / (32 * 16), q = r % (32 * 16), cb = q / 32, kb = q % 32, k0 = 32 * kb, j0 = 64 * cb;
            p0_item<true, true>(inp(F, I_w1) + (((size_t)l * NE + e) * D + k0) * (2 * FF) + 2 * j0, 2 * FF, inp(F, I_norm_moe) + l * D + k0, F.ws + WS_W1 + ((size_t)l * NE + e) * W1E_BYTES + k0, D, (j0 >> 7) * 256 + (j0 & 127), 64, tile, F.lane, W1_SCALE); continue; }
        r -= I_W1;
        { const int e = r / (32 * 8), q = r % (32 * 8), nb = q / 32, kb = q % 32, n0 = 128 * nb, k0 = 32 * kb;
            p0_item<false, true>(inp(F, I_w2) + (((size_t)l * NE + e) * FF + k0) * D + n0, D, nullptr, F.ws + WS_W2 + ((size_t)l * NE + e) * W2E_BYTES + k0, FF, n0, 0, tile, F.lane, W2_SCALE); }
    }
    const int gt = F.bid * NTHREADS + F.tid, NGT = F.G * NTHREADS;
    float* b1r = (float*)(F.ws + WS_B1R);
    for (int i = gt; i < NL * NE * 2048; i += NGT) { const int le = i >> 11, n = i & 2047, pn = n >> 8, rr = n & 255; b1r[i] = inp(F, I_b1)[(size_t)le * 2048 + 2 * (128 * pn + (rr & 127)) + (rr >> 7)]; }
    { bf16_t* pwt = (bf16_t*)(F.ws + WS_PWT);
      for (int i = gt; i < NL * 4 * 64 * 64; i += NGT) { const int c = i & 63, d = (i >> 6) & 63, lg = i >> 12; pwt[i] = f2bf(inp(F, I_pool_w)[((size_t)lg * 64 + c) * 64 + d]); } }
    bf16_t* wf = (bf16_t*)(F.ws + WS_WFRAG);
    for (int i = gt; i < NL * 2 * 32 * 2 * 64 * 8; i += NGT) {
        const int j = i & 7, ln = (i >> 3) & 63, et = (i >> 9) & 1, ks = (i >> 10) & 31, kind = (i >> 15) & 1, l = i >> 16;
        const int e = 16 * et + (ln & 15), k = 32 * ks + 8 * (ln >> 4) + j;
        float v;
        if (kind == 0) v = (e < 8) ? inp(F, I_norm_mix)[l * D + k] * inp(F, I_w_in)[((size_t)l * D + k) * IN_COLS + 1536 + e] : 0.f;
        else v = inp(F, I_norm_moe)[l * D + k] * inp(F, I_w_router)[((size_t)l * D + k) * NE + e];
        const bf16_t h = f2bf(v), lo = f2bf(v - bf2f(h));
        const size_t base = ((((size_t)(l * 2 + kind) * 32 + ks) * 2 + et) * 2) * 512 + ln * 8 + j;
        wf[base] = h; wf[base + 512] = lo;
    }
}

template <int KIND, bool COMBINE, bool WRITE_H, bool DRY = false>
__device__ __forceinline__ void r_phase(const Frame& F, int l, const float* hin, float* hout) {
    const int lane = F.lane, r16 = lane & 15, q4 = lane >> 4;
    const u32x4* Wf = (const u32x4*)(F.ws + WS_WFRAG + (size_t)(l * 2 + KIND) * 131072);
    const bf16_t* Y = (const bf16_t*)(F.ws + WS_Y);
    bf16_t* HB = (bf16_t*)(F.ws + WS_HB);
    float* rstdp = (float*)(F.ws + (KIND == 0 ? WS_RSTD1 : WS_RSTD2));
    LAS float* lg = (LAS float*)(F.lds) + F.wave * (16 * 33);
    LAS int* r2cnt = (LAS int*)(F.lds + LDSCTL_OFF + LC_R2CNT); LAS int* r2base = (LAS int*)(F.lds + LDSCTL_OFF + LC_R2BASE);
    for (int task = F.bid; task < T / 128; task += F.G) {
        const int tok = task * 128 + F.wave * 16 + r16;
        const float* xr = hin + (size_t)tok * D + 8 * q4; float* ho = hout + (size_t)tok * D + 8 * q4;
        const unsigned char* yr = (const unsigned char*)Y + (size_t)tok * 4 * D + 8 * q4; bf16_t* hbr = HB + (size_t)tok * D + 8 * q4;
        f32x4 acc0 = {0.f, 0.f, 0.f, 0.f}, acc1 = {0.f, 0.f, 0.f, 0.f}; float ssq = 0.f;
        if (KIND == 1) { if (F.tid < 32) r2cnt[F.tid] = 0; }
#pragma unroll 2
        for (int ks = 0; ks < 32; ++ks) {
            f32x4 x0 = *(const f32x4*)(xr + 32 * ks), x1 = *(const f32x4*)(xr + 32 * ks + 4);
            if (COMBINE) {
#pragma unroll
                for (int k = 0; k < 4; ++k) { const u32x2 y = *(const u32x2*)(yr + (size_t)k * D + 32 * ks);
                    x0 += un4_fp8(y.x) * (1.0f / Y_SCALE); x1 += un4_fp8(y.y) * (1.0f / Y_SCALE); }
            }
            if (WRITE_H) { *(f32x4*)(ho + 32 * ks) = x0; *(f32x4*)(ho + 32 * ks + 4) = x1; }
            ssq += (x0[0] * x0[0] + x0[1] * x0[1]) + (x0[2] * x0[2] + x0[3] * x0[3]) + (x1[0] * x1[0] + x1[1] * x1[1]) + (x1[2] * x1[2] + x1[3] * x1[3]);
            u32x4 hw; hw.x = cvtpk(x0[0], x0[1]); hw.y = cvtpk(x0[2], x0[3]); hw.z = cvtpk(x1[0], x1[1]); hw.w = cvtpk(x1[2], x1[3]);
            u32x4 lw; lw.x = cvtpk(x0[0] - bflo(hw.x), x0[1] - bfhi(hw.x)); lw.y = cvtpk(x0[2] - bflo(hw.y), x0[3] - bfhi(hw.y)); lw.z = cvtpk(x1[0] - bflo(hw.z), x1[1] - bfhi(hw.z)); lw.w = cvtpk(x1[2] - bflo(hw.w), x1[3] - bfhi(hw.w));
            if (KIND == 0) *(u32x4*)(hbr + 32 * ks) = hw;
            else *(u32x2*)((unsigned char*)(F.ws + WS_HB8) + (size_t)tok * D + 8 * q4 + 32 * ks) = (u32x2){pk4_fp8_sat(x0[0], x0[1], x0[2], x0[3]), pk4_fp8_sat(x1[0], x1[1], x1[2], x1[3])};
            const bf16x8 xh = __builtin_bit_cast(bf16x8, hw), xl = __builtin_bit_cast(bf16x8, lw);
            const bf16x8 wh0 = __builtin_bit_cast(bf16x8, Wf[((ks * 2 + 0) * 2 + 0) * 64 + lane]), wl0 = __builtin_bit_cast(bf16x8, Wf[((ks * 2 + 0) * 2 + 1) * 64 + lane]);
            acc0 = __builtin_amdgcn_mfma_f32_16x16x32_bf16(wh0, xh, acc0, 0, 0, 0);
            acc0 = __builtin_amdgcn_mfma_f32_16x16x32_bf16(wl0, xh, acc0, 0, 0, 0);
            acc0 = __builtin_amdgcn_mfma_f32_16x16x32_bf16(wh0, xl, acc0, 0, 0, 0);
            if (KIND == 1) {
                const bf16x8 wh1 = __builtin_bit_cast(bf16x8, Wf[((ks * 2 + 1) * 2 + 0) * 64 + lane]), wl1 = __builtin_bit_cast(bf16x8, Wf[((ks * 2 + 1) * 2 + 1) * 64 + lane]);
                acc1 = __builtin_amdgcn_mfma_f32_16x16x32_bf16(wh1, xh, acc1, 0, 0, 0);
                acc1 = __builtin_amdgcn_mfma_f32_16x16x32_bf16(wl1, xh, acc1, 0, 0, 0);
                acc1 = __builtin_amdgcn_mfma_f32_16x16x32_bf16(wh1, xl, acc1, 0, 0, 0);
            }
        }
        ssq += __shfl_xor(ssq, 16); ssq += __shfl_xor(ssq, 32);
        const float rstd = 1.0f / sqrtf(ssq * (1.0f / D) + RMS_EPS);
        if (q4 == 0) rstdp[tok] = rstd;
        if (KIND == 0) {
            if (q4 < 2) { const f32x4 bf = *(const f32x4*)(inp(F, I_b_fox_f) + l * 8 + 4 * q4); f32x4 lf;
#pragma unroll
                for (int i = 0; i < 4; ++i) { const float z = rstd * acc0[i] + bf[i]; lf[i] = fminf(z, 0.f) - log1pf(expf(-fabsf(z))); }
                *(f32x4*)((float*)(F.ws + WS_LOGF) + (size_t)tok * 8 + 4 * q4) = lf; }
        } else if (!DRY) {
            const f32x4 b0 = *(const f32x4*)(inp(F, I_b_router) + l * NE + 4 * q4), b1v = *(const f32x4*)(inp(F, I_b_router) + l * NE + 16 + 4 * q4);
#pragma unroll
            for (int i = 0; i < 4; ++i) { lg[r16 * 33 + 4 * q4 + i] = rstd * acc0[i] + b0[i]; lg[r16 * 33 + 16 + 4 * q4 + i] = rstd * acc1[i] + b1v[i]; }
            LDS_WAIT(); asm volatile("" ::: "memory");
            float v0 = -INFINITY, v1 = -INFINITY, v2 = -INFINITY, v3 = -INFINITY; int i0 = 0, i1 = 0, i2 = 0, i3 = 0;
            if (lane < 16) {
                for (int e = 0; e < NE; ++e) { const float x = lg[lane * 33 + e];
                    if (x > v3) { if (x > v0) { v3 = v2; i3 = i2; v2 = v1; i2 = i1; v1 = v0; i1 = i0; v0 = x; i0 = e; }
                        else if (x > v1) { v3 = v2; i3 = i2; v2 = v1; i2 = i1; v1 = x; i1 = e; }
                        else if (x > v2) { v3 = v2; i3 = i2; v2 = x; i2 = e; }
                        else { v3 = x; i3 = e; } } }
            }
            __syncthreads();
            int rk0 = 0, rk1 = 0, rk2 = 0, rk3 = 0;
            if (lane < 16) { rk0 = __hip_atomic_fetch_add(&r2cnt[i0], 1, __ATOMIC_RELAXED, __HIP_MEMORY_SCOPE_WORKGROUP); rk1 = __hip_atomic_fetch_add(&r2cnt[i1], 1, __ATOMIC_RELAXED, __HIP_MEMORY_SCOPE_WORKGROUP); rk2 = __hip_atomic_fetch_add(&r2cnt[i2], 1, __ATOMIC_RELAXED, __HIP_MEMORY_SCOPE_WORKGROUP); rk3 = __hip_atomic_fetch_add(&r2cnt[i3], 1, __ATOMIC_RELAXED, __HIP_MEMORY_SCOPE_WORKGROUP); }
            __syncthreads();
            if (F.tid < 32) r2base[F.tid] = (int)atomicAdd(F.ctl + CW_CUR + (l * NE + F.tid) * 16, (unsigned)r2cnt[F.tid]);
            __syncthreads();
            if (lane < 16) {
                const float e1 = expf(v1 - v0), e2 = expf(v2 - v0), e3 = expf(v3 - v0), inv = 1.0f / (1.0f + e1 + e2 + e3);
                u32x2* list = (u32x2*)(F.ws + WS_LIST); float* gate = (float*)(F.ws + WS_GATE);
                const int tk = (task * 128 + F.wave * 16 + lane) * 4; const unsigned rb = __float_as_uint(__shfl(rstd, lane & 15));
                list[(size_t)i0 * LISTCAP + r2base[i0] + rk0] = (u32x2){(unsigned)(tk + 0), rb}; gate[tk + 0] = inv;
                list[(size_t)i1 * LISTCAP + r2base[i1] + rk1] = (u32x2){(unsigned)(tk + 1), rb}; gate[tk + 1] = e1 * inv;
                list[(size_t)i2 * LISTCAP + r2base[i2] + rk2] = (u32x2){(unsigned)(tk + 2), rb}; gate[tk + 2] = e2 * inv;
                list[(size_t)i3 * LISTCAP + r2base[i3] + rk3] = (u32x2){(unsigned)(tk + 3), rb}; gate[tk + 3] = e3 * inv;
            }
            __syncthreads();
        }
    }
}
__device__ __forceinline__ void r_final(const Frame& F) {
    const int lane = F.lane, tr = lane >> 5, c = lane & 31;
    const bf16_t* Y = (const bf16_t*)(F.ws + WS_Y);
    const float* gf = inp(F, I_norm_final);
    for (int task = F.bid; task < T / 128; task += F.G) {
#pragma unroll 1
        for (int pr = 0; pr < 8; ++pr) {
            const int tok = task * 128 + F.wave * 16 + pr * 2 + tr;
            float* xr = F.out + (size_t)tok * D + 8 * c; const unsigned char* yr = (const unsigned char*)Y + (size_t)tok * 4 * D + 8 * c;
            f32x4 x0[4], x1[4]; float ssq = 0.f;
#pragma unroll
            for (int i = 0; i < 4; ++i) { x0[i] = *(const f32x4*)(xr + 256 * i); x1[i] = *(const f32x4*)(xr + 256 * i + 4); }
#pragma unroll
            for (int i = 0; i < 4; ++i) {
#pragma unroll
                for (int k = 0; k < 4; ++k) { const u32x2 y = *(const u32x2*)(yr + (size_t)k * D + 256 * i);
                    x0[i] += un4_fp8(y.x) * (1.0f / Y_SCALE); x1[i] += un4_fp8(y.y) * (1.0f / Y_SCALE); }
                ssq += (x0[i][0] * x0[i][0] + x0[i][1] * x0[i][1]) + (x0[i][2] * x0[i][2] + x0[i][3] * x0[i][3]) + (x1[i][0] * x1[i][0] + x1[i][1] * x1[i][1]) + (x1[i][2] * x1[i][2] + x1[i][3] * x1[i][3]); }
            ssq += __shfl_xor(ssq, 1); ssq += __shfl_xor(ssq, 2); ssq += __shfl_xor(ssq, 4); ssq += __shfl_xor(ssq, 8); ssq += __shfl_xor(ssq, 16);
            const float rstd = 1.0f / sqrtf(ssq * (1.0f / D) + RMS_EPS);
#pragma unroll
            for (int i = 0; i < 4; ++i) { const f32x4 g0 = *(const f32x4*)(gf + 256 * i + 8 * c), g1 = *(const f32x4*)(gf + 256 * i + 8 * c + 4);
                *(f32x4*)(xr + 256 * i) = x0[i] * rstd * g0; *(f32x4*)(xr + 256 * i + 4) = x1[i] * rstd * g1; }
        }
    }
}
__device__ __forceinline__ void cumsum_step(const Frame& F) {
    LAS float* sc = (LAS float*)(F.lds + LDSCTL_OFF + LC_SCAN);
    const float* LF = (const float*)(F.ws + WS_LOGF); float* c2 = (float*)(F.ws + WS_C2);
    for (int seq = F.bid; seq < 64; seq += F.G) {
        const int b = seq >> 3, h = seq & 7, t0 = F.tid * 8; const float* lf = LF + ((size_t)b * SEQ + t0) * 8 + h;
        float v[8], s = 0.f;
#pragma unroll
        for (int j = 0; j < 8; ++j) { s += lf[j * 8]; v[j] = s; }
        float inc = s;
#pragma unroll
        for (int off = 1; off < 64; off <<= 1) { const float y = __shfl_up(inc, off); if (F.lane >= off) inc += y; }
        if (F.lane == 63) sc[F.wave] = inc;
        __syncthreads();
        float pre = 0.f;
        for (int w = 0; w < F.wave; ++w) pre += sc[w];
        const float base = pre + inc - s;
#pragma unroll
        for (int j = 0; j < 8; ++j) c2[(size_t)seq * SEQ + t0 + j] = (base + v[j]) * LOG2E;
        __syncthreads();
    }
}

__device__ __forceinline__ float max3f(float a, float b, float c) { float r; asm("v_max3_f32 %0, %1, %2, %3" : "=v"(r) : "v"(a), "v"(b), "v"(c)); return r; }
__device__ __forceinline__ float max2f(float a, float b) { float r; asm("v_max_f32_e32 %0, %1, %2" : "=v"(r) : "v"(a), "v"(b)); return r; }
__device__ __forceinline__ int crow(int r, int hi) { return (r & 3) + 8 * (r >> 2) + 4 * hi; }
constexpr int AT_KT = 0, AT_KTB = 8320, AT_VT = 2 * AT_KTB, AT_VTB = 8192, AT_CK = AT_VT + 2 * AT_VTB, AT_WSF = AT_CK + 512, AT_OST = AT_WSF + 2048, AT_END = AT_OST + 65536;
static_assert(AT_END <= PH_BYTES, "attention LDS");
__device__ __forceinline__ void attn_unit(const Frame& F, int l, int b, int h, int qb) {
    const int tid = F.tid, lane = F.lane, r32 = lane & 31, hi = lane >> 5, wid = F.wave;
    const bf16_t* proj = (const bf16_t*)(F.ws + WS_PA); bf16_t* mixed = (bf16_t*)(F.ws + WS_MIXED);
    const int bh = b * 8 + h; const float* c2 = (const float*)(F.ws + WS_C2) + (size_t)bh * SEQ;
    const size_t rowbase = (size_t)b * SEQ; const int q0 = qb * 256;
    LAS unsigned char* L = F.lds;
    LAS float* wsf = (LAS float*)(L + AT_WSF) + wid * 64;
    LAS float* ost = (LAS float*)(L + AT_OST) + wid * 2048;
    LAS unsigned* stopv = (LAS unsigned*)(L + LDSCTL_OFF + LC_STOP);
    const bf16_t* Qw = proj + (rowbase + q0 + wid * 32 + r32) * NPROJ + C_FQ + h * 64;
    bf16x8 qr[4]; float qn = 0.f;
#pragma unroll
    for (int d0 = 0; d0 < 4; ++d0) { const u32x4 w = *(const u32x4*)(Qw + d0 * 16 + hi * 8); qr[d0] = __builtin_bit_cast(bf16x8, w);
        qn += bflo(w.x) * bflo(w.x) + bfhi(w.x) * bfhi(w.x) + bflo(w.y) * bflo(w.y) + bfhi(w.y) * bfhi(w.y) + bflo(w.z) * bflo(w.z) + bfhi(w.z) * bfhi(w.z) + bflo(w.w) * bflo(w.w) + bfhi(w.w) * bfhi(w.w); }
    qn += __shfl_xor(qn, 32); qn = sqrtf(qn) * 1.001f;
    const float kb = sqrtf(2.0f * __uint_as_float(__hip_atomic_load(F.ctl + CW_KMAX + (l * 64 + bh) * 16, __ATOMIC_RELAXED, __HIP_MEMORY_SCOPE_AGENT))) * 1.001f;
    const float c2q = c2[q0 + wid * 32 + r32];
    f32x16 cq16;
#pragma unroll
    for (int r = 0; r < 16; ++r) cq16[r] = c2q;
    float lsum = 0.f; f32x16 o[2];
#pragma unroll
    for (int r = 0; r < 16; ++r) { o[0][r] = 0.f; o[1][r] = 0.f; }
    const int jd = 4 * qb + 3;
    const int lkey = tid >> 3, lpiece = tid & 7;
    const bf16_t* ksrc = proj + (rowbase + lkey) * NPROJ + C_FK + h * 64 + lpiece * 8;
    const bf16_t* vsrc = proj + (rowbase + lkey) * NPROJ + C_FV + h * 64 + lpiece * 8;
    const int kdst = lpiece * 1040 + lkey * 16, vdst = (lpiece >> 2) * 4096 + lkey * 64 + (lpiece & 3) * 16;
    u32x4 kA = *(const u32x4*)(ksrc + (size_t)jd * 64 * NPROJ), vA = *(const u32x4*)(vsrc + (size_t)jd * 64 * NPROJ); float cA = c2[jd * 64 + lane];
    u32x4 kB = kA, vB = vA; float cB = cA;
    if (jd >= 1) { kB = *(const u32x4*)(ksrc + (size_t)(jd - 1) * 64 * NPROJ); vB = *(const u32x4*)(vsrc + (size_t)(jd - 1) * 64 * NPROJ); cB = c2[(jd - 1) * 64 + lane]; }
    const int vrd = (4 * hi + ((lane & 15) >> 2)) * 64 + ((lane >> 4) & 1) * 32 + (lane & 3) * 8;
    const int qrel = wid * 32 + r32;
    int buf = 0; bool done = false, wstop = false, first = true;
    float mhat = 0.f;
#define AT_ITER(j, kR, vR, cR, cNext) do { \
        const float cklast = rdlane(cNext, 63);     \
        *(LAS u32x4*)(L + AT_KT + buf * AT_KTB + kdst) = kR; *(LAS u32x4*)(L + AT_VT + buf * AT_VTB + vdst) = vR; \
        if (tid < 64) ((LAS float*)(L + AT_CK))[buf * 64 + tid] = cR; \
        asm volatile("s_waitcnt lgkmcnt(0)\n\ts_barrier" ::: "memory");     \
        if ((j) < jd) { const u32x4 fa = *(const LAS u32x4*)(stopv + (((j) + 1) & 1) * 8), fb = *(const LAS u32x4*)(stopv + (((j) + 1) & 1) * 8 + 4); \
            if ((fa.x & fa.y & fa.z & fa.w & fb.x & fb.y & fb.z & fb.w) != 0u) { done = true; break; } } \
        if ((j) >= 2) { kR = *(const u32x4*)(ksrc + (size_t)((j) - 2) * 64 * NPROJ); vR = *(const u32x4*)(vsrc + (size_t)((j) - 2) * 64 * NPROJ); cR = c2[((j) - 2) * 64 + lane]; } \
        const int jrel = (j) - 4 * qb; \
        const bool active = !(jrel >= 0 && 64 * jrel > 32 * wid + 31) && !wstop; \
        if (active) { \
            const LAS unsigned char* Kb = L + AT_KT + buf * AT_KTB; const LAS unsigned char* Vb = L + AT_VT + buf * AT_VTB; const LAS float* Ck = (const LAS float*)(L + AT_CK) + buf * 64; \
            const float base = c2q - mhat; \
            f32x16 p0, p1; \
            _Pragma("unroll") for (int g = 0; g < 4; ++g) { const f32x4 ca = *(const LAS f32x4*)(Ck + 8 * g + 4 * hi), cb = *(const LAS f32x4*)(Ck + 32 + 8 * g + 4 * hi); \
                _Pragma("unroll") for (int i = 0; i < 4; ++i) { p0[4 * g + i] = base - ca[i]; p1[4 * g + i] = base - cb[i]; } } \
            bf16x8 kf0[4], kf1[4]; \
            _Pragma("unroll") for (int d0 = 0; d0 < 4; ++d0) { kf0[d0] = *(const LAS bf16x8*)(Kb + (2 * d0 + hi) * 1040 + r32 * 16); kf1[d0] = *(const LAS bf16x8*)(Kb + (2 * d0 + hi) * 1040 + (32 + r32) * 16); } \
            _Pragma("unroll") for (int d0 = 0; d0 < 4; ++d0) { \
                p0 = __builtin_amdgcn_mfma_f32_32x32x16_bf16(kf0[d0], qr[d0], p0, 0, 0, 0); p1 = __builtin_amdgcn_mfma_f32_32x32x16_bf16(kf1[d0], qr[d0], p1, 0, 0, 0); } \
            asm volatile("s_nop 15\n\ts_nop 7" : "+v"(p0), "+v"(p1));     \
            if (jrel >= 0) { const int kbase = 64 * jrel + 4 * hi; \
                _Pragma("unroll") for (int r = 0; r < 16; ++r) { const int kv = kbase + (r & 3) + 8 * (r >> 2); if (kv > qrel) p0[r] = -INFINITY; if (kv + 32 > qrel) p1[r] = -INFINITY; } } \
            float mx = max3f(p0[0], p0[1], p1[0]), mb_ = max3f(p0[2], p0[3], p1[1]); mx = max3f(mx, p1[2], p1[3]); \
            _Pragma("unroll") for (int r = 4; r < 16; r += 4) { mx = max3f(mx, p0[r], p0[r + 1]); mb_ = max3f(mb_, p0[r + 2], p0[r + 3]); mx = max3f(mx, p1[r], p1[r + 1]); mb_ = max3f(mb_, p1[r + 2], p1[r + 3]); } \
            mx = max2f(mx, mb_); \
            { auto rr = __builtin_amdgcn_permlane32_swap(__float_as_uint(mx), __float_as_uint(mx), false, false); mx = max2f(__uint_as_float(rr[0]), __uint_as_float(rr[1])); } \
            if (first || __any(mx > 8.0f)) { \
                const float dl = first ? mx : fmaxf(mx, 0.f); mhat += dl; \
                _Pragma("unroll") for (int r = 0; r < 16; ++r) { p0[r] -= dl; p1[r] -= dl; } \
                const float alpha = __builtin_amdgcn_exp2f(-dl); lsum *= alpha; \
                if (!first) { \
                    if (hi == 0) wsf[r32] = alpha; \
                    LDS_WAIT(); asm volatile("" ::: "memory"); \
                    _Pragma("unroll") for (int r = 0; r < 16; ++r) { const float a = wsf[crow(r, hi)]; o[0][r] *= a; o[1][r] *= a; } } \
                first = false; \
            } \
            _Pragma("unroll") for (int r = 0; r < 16; ++r) { p0[r] = __builtin_amdgcn_exp2f(p0[r]); p1[r] = __builtin_amdgcn_exp2f(p1[r]); } \
            { f32x2 sa = {p0[0] + p1[0], p0[1] + p1[1]}; \
              _Pragma("unroll") for (int r = 2; r < 16; r += 2) { sa += (f32x2){p0[r], p0[r + 1]}; sa += (f32x2){p1[r], p1[r + 1]}; } \
              lsum += sa[0] + sa[1]; } \
            u32x4 pw[4]; \
            pw[0] = (u32x4){cvtpk(p0[0], p0[1]), cvtpk(p0[2], p0[3]), cvtpk(p0[4], p0[5]), cvtpk(p0[6], p0[7])}; \
            pw[1] = (u32x4){cvtpk(p0[8], p0[9]), cvtpk(p0[10], p0[11]), cvtpk(p0[12], p0[13]), cvtpk(p0[14], p0[15])}; \
            pw[2] = (u32x4){cvtpk(p1[0], p1[1]), cvtpk(p1[2], p1[3]), cvtpk(p1[4], p1[5]), cvtpk(p1[6], p1[7])}; \
            pw[3] = (u32x4){cvtpk(p1[8], p1[9]), cvtpk(p1[10], p1[11]), cvtpk(p1[12], p1[13]), cvtpk(p1[14], p1[15])}; \
            _Pragma("unroll") for (int s = 0; s < 4; ++s) \
                _Pragma("unroll") for (int d0 = 0; d0 < 2; ++d0) { \
                    const LAS unsigned char* vp = Vb + d0 * 4096 + s * 1024 + vrd; \
                    const v4i16_t lo = __builtin_amdgcn_ds_read_tr16_b64_v4i16((LAS v4i16_t*)vp), hv = __builtin_amdgcn_ds_read_tr16_b64_v4i16((LAS v4i16_t*)(vp + 512)); \
                    const bf16x8 vf = (bf16x8){lo[0], lo[1], lo[2], lo[3], hv[0], hv[1], hv[2], hv[3]}; \
                    o[d0] = __builtin_amdgcn_mfma_f32_32x32x16_bf16(__builtin_bit_cast(bf16x8, pw[s]), vf, o[d0], 0, 0, 0); } \
        } \
        if ((j) > 0) { if (active) { const float ub = qn * kb + (c2q - cklast); if (__all((ub - mhat) < -152.0f)) wstop = true; } if (lane == 0) stopv[((j) & 1) * 8 + wid] = wstop ? 1u : 0u; } \
        buf ^= 1; \
    } while (0)
    for (int j = jd; j >= 0; j -= 2) {
        AT_ITER(j, kA, vA, cA, cB);
        if (done || j == 0) break;
        AT_ITER(j - 1, kB, vB, cB, cA);
        if (done) break;
    }
#undef AT_ITER
    lsum += __shfl_xor(lsum, 32);
    if (hi == 0) wsf[32 + r32] = 1.0f / lsum;
    LDS_WAIT(); asm volatile("" ::: "memory");
#pragma unroll
    for (int r = 0; r < 16; ++r) { const int q = crow(r, hi); const float inv = wsf[32 + q]; ost[q * 64 + r32] = o[0][r] * inv; ost[q * 64 + 32 + r32] = o[1][r] * inv; }
    LDS_WAIT(); asm volatile("" ::: "memory");
    { const int row = lane >> 1, half = lane & 1; const LAS float* src = ost + row * 64 + half * 32; float v[32]; float ss = 0.f;
#pragma unroll
        for (int i = 0; i < 8; ++i) { const f32x4 t4 = *(const LAS f32x4*)(src + 4 * i); v[4 * i] = t4[0]; v[4 * i + 1] = t4[1]; v[4 * i + 2] = t4[2]; v[4 * i + 3] = t4[3]; ss += (t4[0] * t4[0] + t4[1] * t4[1]) + (t4[2] * t4[2] + t4[3] * t4[3]); }
        ss += __shfl_xor(ss, 1);
        const float rs = 1.0f / sqrtf(ss * (1.0f / 64.0f) + RMS_EPS);
        const float* gn = inp(F, I_fox_gain) + l * 512 + h * 64 + half * 32;
        bf16_t* dst = mixed + (rowbase + q0 + wid * 32 + row) * D + h * 64 + half * 32;
#pragma unroll
        for (int i = 0; i < 4; ++i) { const f32x4 ga = *(const f32x4*)(gn + 8 * i), gb = *(const f32x4*)(gn + 8 * i + 4); u32x4 w;
            w.x = cvtpk(v[8 * i] * rs * ga[0], v[8 * i + 1] * rs * ga[1]); w.y = cvtpk(v[8 * i + 2] * rs * ga[2], v[8 * i + 3] * rs * ga[3]);
            w.z = cvtpk(v[8 * i + 4] * rs * gb[0], v[8 * i + 5] * rs * gb[1]); w.w = cvtpk(v[8 * i + 6] * rs * gb[2], v[8 * i + 7] * rs * gb[3]);
            *(u32x4*)(dst + 8 * i) = w; } }
    __syncthreads();
}

__device__ __forceinline__ float hg_lb(const Frame& F, int l, int col) {
    float x[NL], mx = -INFINITY;
#pragma unroll
    for (int i = 0; i < NL; ++i) { x[i] = inp(F, I_hgrn_lb)[i * 256 + col]; mx = fmaxf(mx, x[i]); }
    float s = 0.f, a = 0.f;
#pragma unroll
    for (int i = 0; i < NL; ++i) { x[i] = expf(x[i] - mx); s += x[i]; }
#pragma unroll
    for (int i = 1; i < NL; ++i) if (i <= l) a += x[i];
    return a / s;
}
constexpr int HG_SEG = 128, HG_NSEG = SEQ / HG_SEG, HG_NPART = 1, HG_WAVES = 4;
static_assert(HG_NSEG == 32, "the FIX phase's balanced deal assumes 32 segments");
constexpr int HGL_ROW = 136, HGL_QT = 0, HGL_KT = 32 * HGL_ROW, HGL_KP = 2 * 32 * HGL_ROW, HGL_V = HGL_KP + 4096, HGL_PE = HGL_V + 4096, HGL_BYTES = HGL_PE + 256;
static_assert(NWAVES * HGL_BYTES <= PH_BYTES, "HGRN2 LDS");
__device__ __forceinline__ void hg_mfma_unit(const Frame& F, int l, int u) {
    const int seg = u % HG_NSEG, bh = u / HG_NSEG, b = bh >> 2, hd = bh & 3, lane = F.lane, r32 = lane & 31, hi = lane >> 5;
    LAS unsigned char* W = F.lds + F.wave * HGL_BYTES;
    const size_t tokS = (size_t)b * SEQ + seg * HG_SEG;
    const bf16_t* proj = (const bf16_t*)(F.ws + WS_PA);
    float* oraw = (float*)(F.ws + WS_ORAW); bf16_t* QE = (bf16_t*)(F.ws + WS_QE);
    const float lbv = hg_lb(F, l, hd * 64 + lane);
    f32x16 Sacc[2][2];
#pragma unroll
    for (int kb = 0; kb < 2; ++kb)
#pragma unroll
        for (int vb = 0; vb < 2; ++vb)
#pragma unroll
            for (int r = 0; r < 16; ++r) Sacc[kb][vb][r] = 0.f;
    float Pseg = 1.0f;
    const int vrd = (4 * hi + ((lane & 15) >> 2)) * 64 + ((lane >> 4) & 1) * 32 + (lane & 3) * 8;
    int tb = 0;
    while (tb < HG_SEG) {
        const int nmax = (HG_SEG - tb) < 32 ? (HG_SEG - tb) : 32;
        const char* pu8 = (const char*)(proj + (tokS + tb) * NPROJ + hd * 64);
        const unsigned lo2 = (unsigned)lane * 2u;
        char* qe8 = (char*)(QE + (tokS + tb) * 256 + hd * 64);
        char* or8 = (char*)(oraw + (tokS + tb) * 256 + hd * 64);
        const unsigned lof = (unsigned)(4 * hi * 256 + r32) * 4u;
        float fv[32], qv[32]; u32x4 vreg[4];
#pragma unroll
        for (int t = 0; t < 32; ++t) { const bool ok = t < nmax; fv[t] = ok ? bf2f(*(const bf16_t*)(pu8 + (size_t)t * (NPROJ * 2) + C_GF * 2 + lo2)) : 0.f; qv[t] = ok ? bf2f(*(const bf16_t*)(pu8 + (size_t)t * (NPROJ * 2) + C_GQ * 2 + lo2)) : 0.f; }
#pragma unroll
        for (int it = 0; it < 4; ++it) { const int c = lane + 64 * it, sr = c >> 3, pc = c & 7;
            vreg[it] = (u32x4){0u, 0u, 0u, 0u}; if (sr < nmax) vreg[it] = *(const u32x4*)(pu8 + (size_t)sr * (NPROJ * 2) + C_GI * 2 + pc * 16); }
        int nl = 32; { float P = 1.0f;
#pragma unroll
            for (int t = 0; t < 32; ++t) { const float sg = __builtin_amdgcn_rcpf(1.0f + __builtin_amdgcn_exp2f(-LOG2E * fv[t])); float f = fmaxf(lbv + (1.0f - lbv) * sg, 1e-30f); if (t >= nmax) f = 1.0f; fv[t] = f; P *= f; if (P < 1e-32f && nl == 32) nl = t; } }
#pragma unroll
        for (int off = 1; off < 64; off <<= 1) { const int o = __shfl_xor(nl, off); nl = o < nl ? o : nl; }
        const int n = __builtin_amdgcn_readfirstlane(nl < nmax ? nl : nmax);
#pragma unroll
        for (int it = 0; it < 4; ++it) { const int c = lane + 64 * it, sr = c >> 3, pc = c & 7;
            *(LAS u32x4*)(W + HGL_V + (pc >> 2) * 2048 + sr * 64 + (pc & 3) * 16) = (sr < n) ? vreg[it] : (u32x4){0u, 0u, 0u, 0u}; }
        float P = 1.0f;
        {
#pragma unroll
          for (int t = 0; t < 32; ++t) { const bool ok = t < n; const float f = fv[t]; if (ok) P *= f;
            const float qt = ok ? qv[t] * P : 0.f, kt = ok ? (1.0f - f) * __builtin_amdgcn_rcpf(P) : 0.f;
            *(LAS bf16_t*)(W + HGL_QT + t * HGL_ROW + lane * 2) = f2bf(qt); *(LAS bf16_t*)(W + HGL_KT + t * HGL_ROW + lane * 2) = f2bf(kt);
            if (ok) *(bf16_t*)(qe8 + (size_t)t * 512 + lo2) = f2bf(qv[t] * (Pseg * P)); } }
        { float suf = 1.0f;
#pragma unroll
          for (int t = 31; t >= 0; --t) { const bool ok = t < n; const float f = fv[t]; const float kp = ok ? (1.0f - f) * suf : 0.f; if (ok) suf *= f;
            *(LAS bf16_t*)(W + HGL_KP + (lane >> 5) * 2048 + t * 64 + (lane & 31) * 2) = f2bf(kp); } }
        ((LAS float*)(W + HGL_PE))[lane] = P;
        Pseg *= P;
        LDS_WAIT(); asm volatile("" ::: "memory");
        f32x16 st;
#pragma unroll
        for (int r = 0; r < 16; ++r) st[r] = 0.f;
#pragma unroll
        for (int d0 = 0; d0 < 4; ++d0) { const bf16x8 ka = *(const LAS bf16x8*)(W + HGL_KT + r32 * HGL_ROW + (16 * d0 + 8 * hi) * 2), qb = *(const LAS bf16x8*)(W + HGL_QT + r32 * HGL_ROW + (16 * d0 + 8 * hi) * 2);
            st = __builtin_amdgcn_mfma_f32_32x32x16_bf16(ka, qb, st, 0, 0, 0); }
#pragma unroll
        for (int r = 0; r < 16; ++r) if (crow(r, hi) > r32) st[r] = 0.f;
        u32x4 pst[2];
        pst[0] = (u32x4){cvtpk(st[0], st[1]), cvtpk(st[2], st[3]), cvtpk(st[4], st[5]), cvtpk(st[6], st[7])};
        pst[1] = (u32x4){cvtpk(st[8], st[9]), cvtpk(st[10], st[11]), cvtpk(st[12], st[13]), cvtpk(st[14], st[15])};
        bf16x8 vf[2][2];
#pragma unroll
        for (int s2 = 0; s2 < 2; ++s2)
#pragma unroll
            for (int vb = 0; vb < 2; ++vb) { const LAS unsigned char* vp = W + HGL_V + vb * 2048 + s2 * 1024 + vrd;
                const v4i16_t lo = __builtin_amdgcn_ds_read_tr16_b64_v4i16((LAS v4i16_t*)vp), hv = __builtin_amdgcn_ds_read_tr16_b64_v4i16((LAS v4i16_t*)(vp + 512));
                vf[s2][vb] = (bf16x8){lo[0], lo[1], lo[2], lo[3], hv[0], hv[1], hv[2], hv[3]}; }
        f32x16 oacc[2];
#pragma unroll
        for (int vb = 0; vb < 2; ++vb) {
#pragma unroll
            for (int r = 0; r < 16; ++r) oacc[vb][r] = 0.f;
#pragma unroll
            for (int s2 = 0; s2 < 2; ++s2) oacc[vb] = __builtin_amdgcn_mfma_f32_32x32x16_bf16(__builtin_bit_cast(bf16x8, pst[s2]), vf[s2][vb], oacc[vb], 0, 0, 0);
        }
#pragma unroll
        for (int kst = 0; kst < 4; ++kst) {
            const u32x2 qa = *(const LAS u32x2*)(W + HGL_QT + r32 * HGL_ROW + (16 * kst + 4 * hi) * 2), qc = *(const LAS u32x2*)(W + HGL_QT + r32 * HGL_ROW + (16 * kst + 8 + 4 * hi) * 2);
            const bf16x8 qf = __builtin_bit_cast(bf16x8, (u32x4){qa.x, qa.y, qc.x, qc.y});
#pragma unroll
            for (int vb = 0; vb < 2; ++vb) { const f32x16& S = Sacc[kst >> 1][vb]; const int o8 = 8 * (kst & 1);
                const u32x4 sp = (u32x4){cvtpk(S[o8 + 0], S[o8 + 1]), cvtpk(S[o8 + 2], S[o8 + 3]), cvtpk(S[o8 + 4], S[o8 + 5]), cvtpk(S[o8 + 6], S[o8 + 7])};
                oacc[vb] = __builtin_amdgcn_mfma_f32_32x32x16_bf16(qf, __builtin_bit_cast(bf16x8, sp), oacc[vb], 0, 0, 0); }
        }
#pragma unroll
        for (int vb = 0; vb < 2; ++vb)
#pragma unroll
            for (int r = 0; r < 16; ++r) { const int t = crow(r, hi); if (t < n) *(float*)(or8 + (size_t)(((r & 3) + 8 * (r >> 2)) * 1024 + vb * 128) + lof) = oacc[vb][r]; }
#pragma unroll
        for (int kb = 0; kb < 2; ++kb) {
            float pe[16];
#pragma unroll
            for (int g = 0; g < 4; ++g) { const f32x4 p4 = *(const LAS f32x4*)(W + HGL_PE + (32 * kb + 8 * g + 4 * hi) * 4); pe[4 * g] = p4[0]; pe[4 * g + 1] = p4[1]; pe[4 * g + 2] = p4[2]; pe[4 * g + 3] = p4[3]; }
            bf16x8 kf[2];
#pragma unroll
            for (int s2 = 0; s2 < 2; ++s2) { const LAS unsigned char* kp = W + HGL_KP + kb * 2048 + s2 * 1024 + vrd;
                const v4i16_t lo = __builtin_amdgcn_ds_read_tr16_b64_v4i16((LAS v4i16_t*)kp), hv = __builtin_amdgcn_ds_read_tr16_b64_v4i16((LAS v4i16_t*)(kp + 512));
                kf[s2] = (bf16x8){lo[0], lo[1], lo[2], lo[3], hv[0], hv[1], hv[2], hv[3]}; }
#pragma unroll
            for (int vb = 0; vb < 2; ++vb) {
#pragma unroll
                for (int r = 0; r < 16; ++r) Sacc[kb][vb][r] *= pe[r];
#pragma unroll
                for (int s2 = 0; s2 < 2; ++s2) Sacc[kb][vb] = __builtin_amdgcn_mfma_f32_32x32x16_bf16(kf[s2], vf[s2][vb], Sacc[kb][vb], 0, 0, 0);
            }
        }
        LDS_WAIT(); asm volatile("" ::: "memory");
        tb += n;
    }
    char* send8 = (char*)((float*)(F.ws + WS_SEND2) + (size_t)(bh * HG_NSEG + seg) * 4096);
    const unsigned lsf = (unsigned)(4 * hi * 64 + r32) * 4u;
#pragma unroll
    for (int kb = 0; kb < 2; ++kb)
#pragma unroll
        for (int vb = 0; vb < 2; ++vb)
#pragma unroll
            for (int r = 0; r < 16; ++r) *(float*)(send8 + (size_t)((32 * kb + (r & 3) + 8 * (r >> 2)) * 256 + vb * 128) + lsf) = Sacc[kb][vb][r];
    ((float*)(F.ws + WS_PSEG))[(bh * HG_NSEG + seg) * 64 + lane] = Pseg;
}
__device__ __forceinline__ void hg_fix_phase(const Frame& F, int l) {
    const int lane = F.lane, r16 = lane & 15, q4 = lane >> 4, tid = F.tid;
    LAS bf16_t* ST = (LAS bf16_t*)(F.lds);
    const float* oraw = (const float*)(F.ws + WS_ORAW); const bf16_t* proj = (const bf16_t*)(F.ws + WS_PA); bf16_t* mixed = (bf16_t*)(F.ws + WS_MIXED);
    const bf16_t* QE = (const bf16_t*)(F.ws + WS_QE); const float* SEND = (const float*)(F.ws + WS_SEND2); const float* PSEG = (const float*)(F.ws + WS_PSEG);
    for (int uu = F.bid; uu < 32 * HG_NSEG * DUP(7); uu += F.G) {
        const int u = uu % (32 * HG_NSEG), blk = u & 255, iq = u >> 8, s8 = blk & 7, seg = (iq == 0) ? s8 : (iq == 1) ? 15 - s8 : (iq == 2) ? 16 + s8 : 31 - s8, bh = blk >> 3, b = bh >> 2, hd = bh & 3;
        if (seg > 0) {
            const int k = tid >> 3, v8 = (tid & 7) * 8; float S[8];
#pragma unroll
            for (int i = 0; i < 8; ++i) S[i] = 0.f;
#pragma unroll 4
            for (int sp = 0; sp < seg; ++sp) { const float P = PSEG[(bh * HG_NSEG + sp) * 64 + k]; const float* se = SEND + ((size_t)(bh * HG_NSEG + sp) * 64 + k) * 64 + v8;
                const f32x4 a = *(const f32x4*)se, c = *(const f32x4*)(se + 4);
                S[0] = P * S[0] + a[0]; S[1] = P * S[1] + a[1]; S[2] = P * S[2] + a[2]; S[3] = P * S[3] + a[3]; S[4] = P * S[4] + c[0]; S[5] = P * S[5] + c[1]; S[6] = P * S[6] + c[2]; S[7] = P * S[7] + c[3]; }
#pragma unroll
            for (int i = 0; i < 8; ++i) ST[(v8 + i) * 72 + k] = f2bf(S[i]);
        }
        __syncthreads();
        {
            const size_t tok0 = (size_t)b * SEQ + seg * HG_SEG + F.wave * 16;
            f32x4 acc[4];
#pragma unroll
            for (int vb = 0; vb < 4; ++vb) acc[vb] = (f32x4){0.f, 0.f, 0.f, 0.f};
            if (seg > 0) {
#pragma unroll
                for (int kst = 0; kst < 2; ++kst) { const bf16x8 af = __builtin_bit_cast(bf16x8, *(const u32x4*)(QE + (tok0 + r16) * 256 + hd * 64 + 32 * kst + 8 * q4));
#pragma unroll
                    for (int vb = 0; vb < 4; ++vb) { const bf16x8 bfv = *(const LAS bf16x8*)(ST + (vb * 16 + r16) * 72 + 32 * kst + 8 * q4); acc[vb] = __builtin_amdgcn_mfma_f32_16x16x32_bf16(af, bfv, acc[vb], 0, 0, 0); } }
            }
            float ss[4] = {0.f, 0.f, 0.f, 0.f};
#pragma unroll
            for (int vb = 0; vb < 4; ++vb)
#pragma unroll
                for (int r = 0; r < 4; ++r) { const size_t o = (tok0 + 4 * q4 + r) * 256 + hd * 64 + vb * 16 + r16;
                    float x = acc[vb][r];
#pragma unroll
                    for (int k4 = 0; k4 < HG_NPART; ++k4) x += oraw[(size_t)k4 * T * 256 + o];
                    acc[vb][r] = x; ss[r] += x * x; }
#pragma unroll
            for (int r = 0; r < 4; ++r) { float t = ss[r]; t += __shfl_xor(t, 1); t += __shfl_xor(t, 2); t += __shfl_xor(t, 4); t += __shfl_xor(t, 8); ss[r] = 1.0f / sqrtf(t * (1.0f / 64.0f) + RMS_EPS); }
#pragma unroll
            for (int vb = 0; vb < 4; ++vb) { const float gn = inp(F, I_hgrn_gain)[l * 256 + hd * 64 + vb * 16 + r16];
#pragma unroll
                for (int r = 0; r < 4; ++r) { const size_t tok = tok0 + 4 * q4 + r; const float g = bf2f(proj[tok * NPROJ + C_GG + hd * 64 + vb * 16 + r16]);
                    const float si = g * __builtin_amdgcn_rcpf(1.0f + __builtin_amdgcn_exp2f(-LOG2E * g)); mixed[tok * D + 512 + hd * 64 + vb * 16 + r16] = f2bf(acc[vb][r] * ss[r] * gn * si); } }
        }
        __syncthreads();
    }
}
constexpr int PL_ROW = 136, PL_BYTES = 64 * PL_ROW;
static_assert(NWAVES * PL_BYTES <= PH_BYTES, "pool LDS");
template <int W> __device__ __forceinline__ void pool_body(const Frame& F, int l, int b, int g, int seg) {
    const int lane = F.lane, r32 = lane & 31, hi = lane >> 5, t0 = seg * 64;
    LAS unsigned char* PT = F.lds + F.wave * PL_BYTES;
    const char* ub = (const char*)((const bf16_t*)(F.ws + WS_PA) + (size_t)b * SEQ * NPROJ + C_PU + g * 64);
    const unsigned lo2 = (unsigned)lane * 2u;
    float prev[16], cur[16];
#pragma unroll
    for (int i = 0; i < 16; ++i) { const int t = t0 - 16 + i; prev[i] = (t >= 0) ? bf2f(*(const bf16_t*)(ub + (size_t)(t < 0 ? 0 : t) * (NPROJ * 2) + lo2)) : 0.f; }
    float wsum = 0.f;
#pragma unroll
    for (int i = 1; i <= W; ++i) wsum += prev[16 - i];
#pragma unroll
    for (int ci = 0; ci < 4; ++ci) {
#pragma unroll
        for (int i = 0; i < 16; ++i) cur[i] = bf2f(*(const bf16_t*)(ub + (size_t)(t0 + 16 * ci + i) * (NPROJ * 2) + lo2));
#pragma unroll
        for (int i = 0; i < 16; ++i) { const float ut = cur[i]; wsum += ut; wsum -= (i - W >= 0) ? cur[(i - W >= 0) ? i - W : 0] : prev[(i - W >= 0) ? 0 : 16 + i - W];
            const int t = t0 + 16 * ci + i; const float pooled = wsum / (float)((t + 1 < W) ? (t + 1) : W) - ut;
            *(LAS bf16_t*)(PT + (16 * ci + i) * PL_ROW + lane * 2) = f2bf(pooled); }
#pragma unroll
        for (int i = 0; i < 16; ++i) prev[i] = cur[i];
    }
    LDS_WAIT(); asm volatile("" ::: "memory");
    const bf16_t* pwt = (const bf16_t*)(F.ws + WS_PWT) + (size_t)(l * 4 + g) * 4096;
    bf16x8 bw[2][4];
#pragma unroll
    for (int db = 0; db < 2; ++db)
#pragma unroll
        for (int st = 0; st < 4; ++st) bw[db][st] = __builtin_bit_cast(bf16x8, *(const u32x4*)(pwt + (32 * db + r32) * 64 + 16 * st + 8 * hi));
    char* ob = (char*)((bf16_t*)(F.ws + WS_MIXED) + ((size_t)b * SEQ + t0) * D + 768 + g * 64);
    const unsigned lof = (unsigned)(4 * hi * D + r32) * 2u;
#pragma unroll
    for (int tb2 = 0; tb2 < 2; ++tb2)
#pragma unroll
        for (int db = 0; db < 2; ++db) {
            f32x16 acc;
#pragma unroll
            for (int r = 0; r < 16; ++r) acc[r] = 0.f;
#pragma unroll
            for (int st = 0; st < 4; ++st) { const bf16x8 af = *(const LAS bf16x8*)(PT + (32 * tb2 + r32) * PL_ROW + (16 * st + 8 * hi) * 2); acc = __builtin_amdgcn_mfma_f32_32x32x16_bf16(af, bw[db][st], acc, 0, 0, 0); }
            const float psc = inp(F, I_pool_scale)[l * 256 + g * 64 + 32 * db + r32];
#pragma unroll
            for (int r = 0; r < 16; ++r) *(bf16_t*)(ob + (size_t)((32 * tb2 + (r & 3) + 8 * (r >> 2)) * D + 32 * db) * 2 + lof) = f2bf(acc[r] * psc);
        }
    LDS_WAIT(); asm volatile("" ::: "memory");
}
__device__ __forceinline__ void pool_unit(const Frame& F, int l, int u) {
    const int seg = u & 63, g = (u >> 6) & 3, b = u >> 8;
    if (g == 0) pool_body<2>(F, l, b, g, seg); else if (g == 1) pool_body<4>(F, l, b, g, seg); else if (g == 2) pool_body<8>(F, l, b, g, seg); else pool_body<16>(F, l, b, g, seg);
}

struct Args { const float* in[18]; float* out; unsigned char* ws; int ph_lo, ph_hi; };
constexpr int N_PHASES = 2 + 8 * NL;

__global__ void __launch_bounds__(NTHREADS, 2) trunk_fwd(Args args) {
    extern __shared__ __attribute__((aligned(16))) unsigned char lds_raw[];
    Frame F;
    F.lds = (LAS unsigned char*)lds_raw; F.ws = args.ws; F.ctl = (unsigned*)(args.ws + WS_CTL); F.out = args.out;
    F.tid = threadIdx.x; F.lane = F.tid & 63; F.wave = __builtin_amdgcn_readfirstlane(F.tid >> 6);
    for (int u = F.tid; u < (LDS_BYTES - LDSCTL_OFF) / 4; u += NTHREADS) ((LAS unsigned*)(F.lds + LDSCTL_OFF))[u] = 0u;
    __syncthreads();
    if (F.tid == 0) {
#pragma unroll
        for (int i = 0; i < 18; ++i) ((LAS unsigned long long*)(F.lds + LDSCTL_OFF + LC_INP))[i] = (unsigned long long)args.in[i];
    }
    __syncthreads();
    const int lo = args.ph_lo, hi = args.ph_hi; const bool use_bar = (hi - lo) > 1;
    XcdBarrier bar; bar.bar = F.ctl + CW_BAR; bar.x = 0; bar.st = nullptr;
    if (use_bar) bar = xcd_barrier_post(F.ctl + CW_BAR, (volatile LAS unsigned*)(F.lds + LDSCTL_OFF + LC_BAR));
#ifndef PHMASK
#define PHMASK 0xFFFF
#endif
#define PM(b) ((PHMASK >> (b)) & 1)
#define FRESH() do { int l_; asm volatile("v_mbcnt_lo_u32_b32 %0, -1, 0\n\tv_mbcnt_hi_u32_b32 %0, -1, %0" : "=v"(l_));     F.lane = l_; F.tid = F.wave * 64 + l_; int b_ = blockIdx.x, g_ = gridDim.x; asm volatile("" : "+s"(b_), "+s"(g_)); F.bid = b_; F.G = g_; } while (0)
#ifndef PROBEMASK
#define PROBEMASK 0
#endif
    unsigned long long probe_acc = 0ull, probe_t0 = 0ull;
#define PB(b) ((PROBEMASK >> (b)) & 1)
#define PROBE_BEGIN(b) do { if (PB(b)) probe_t0 = __builtin_amdgcn_s_memrealtime(); } while (0)
#define PROBE_END(b) do { if (PB(b)) probe_acc += __builtin_amdgcn_s_memrealtime() - probe_t0; } while (0)
#define IN(k) (lo <= (k) && (k) < hi)
#define PTYPE(k) ((k) == 0 ? 0 : (((k) - 1) & 7) + 1)
#define PBS(k) (PB(10) || PB(11 + PTYPE(k)))
#define SEAM(k) do { if (use_bar && (k) + 1 < hi) { if (PBS(k)) probe_t0 = __builtin_amdgcn_s_memrealtime(); int sl_; asm volatile("v_mbcnt_lo_u32_b32 %0, -1, 0\n\tv_mbcnt_hi_u32_b32 %0, -1, %0" : "=v"(sl_)); xcd_barrier(bar, F.wave == 0 && sl_ == 0); if (PBS(k)) probe_acc += __builtin_amdgcn_s_memrealtime() - probe_t0; } } while (0)
    if (IN(0) && PM(0)) { PROBE_BEGIN(0); for (int rep = 0; rep < DUP(5); ++rep) { FRESH(); p0_prologue(F); } PROBE_END(0); SEAM(0); }
    for (int l = 0; l < NL; ++l) {
        const int pb = 1 + 8 * l;
        if (IN(pb + 0) && PM(1)) { FRESH(); PROBE_BEGIN(1); if (l == 0) r_phase<0, false, false>(F, l, inp(F, I_x), F.out); else { if (DUP(6) > 1) r_phase<0, true, false, true>(F, l, F.out, F.out); r_phase<0, true, true>(F, l, F.out, F.out); } PROBE_END(1); SEAM(pb + 0); }
        if (IN(pb + 1) && PM(2)) { FRESH(); PROBE_BEGIN(2);
            cumsum_step(F);
            pg8::StaticOrder S; S.init(T, NPROJ, D, F.G, F.bid, (const bf16_t*)(F.ws + WS_WIN + l * WIN_BYTES)); S.rep = DUP(2);
            pg8::EpiProj E{(bf16_t*)(F.ws + WS_PA), (const float*)(F.ws + WS_RSTD1), F.ctl + CW_KMAX + l * 64 * 16};
            pg8::gemm_phase<pg8::EpiProj, pg8::StaticOrder, true>(F.tid, F.lds, (const bf16_t*)(F.ws + WS_HB), D, S, E);
            PROBE_END(2); SEAM(pb + 1);
        }
        if (IN(pb + 2) && PM(3)) { FRESH(); PROBE_BEGIN(3);
            const int gw = F.bid * NWAVES + F.wave, NGW = F.G * NWAVES;
            for (int u = gw; u < 2048; u += NGW) pool_unit(F, l, u);
            __syncthreads();
            if (F.wave < HG_WAVES) for (int u = F.wave * F.G + F.bid; u < 32 * HG_NSEG * DUP(0); u += HG_WAVES * F.G) hg_mfma_unit(F, l, u % (32 * HG_NSEG));
            __syncthreads();
            { LAS int* aq = (LAS int*)(F.lds + LDSCTL_OFF + LC_AQ);
              for (int rep = 0; rep < DUP(1); ++rep)
              for (;;) {
                if (F.tid == 0) aq[0] = (int)__hip_atomic_fetch_add(F.ctl + CW_AQ + 16 * (l + 4 * rep), 1u, __ATOMIC_RELAXED, __HIP_MEMORY_SCOPE_AGENT);
                __syncthreads();
                const int idx = aq[0];
                __syncthreads();
                if (idx >= 1024) break;
                attn_unit(F, l, (idx >> 3) & 7, idx & 7, 15 - (idx >> 6)); } }
            PROBE_END(3); SEAM(pb + 2);
        }
        if (IN(pb + 3) && PM(4)) { FRESH(); PROBE_BEGIN(4); hg_fix_phase(F, l); PROBE_END(4); SEAM(pb + 3); }
        if (IN(pb + 4) && PM(5)) { FRESH(); PROBE_BEGIN(5);
            pg8::StaticOrder S; S.init(T, D, D, F.G, F.bid, (const bf16_t*)(F.ws + WS_WOUT + l * WOUT_BYTES));
            if (DUP(8) > 1) { pg8::EpiOut E0{l == 0 ? inp(F, I_x) : F.out, (float*)(F.ws + WS_Y)}; pg8::gemm_phase<pg8::EpiOut, pg8::StaticOrder, true>(F.tid, F.lds, (const bf16_t*)(F.ws + WS_MIXED), D, S, E0); }
            pg8::EpiOut E{l == 0 ? inp(F, I_x) : F.out, F.out};
            pg8::gemm_phase<pg8::EpiOut, pg8::StaticOrder, true>(F.tid, F.lds, (const bf16_t*)(F.ws + WS_MIXED), D, S, E);
            PROBE_END(5); SEAM(pb + 4);
        }
        if (IN(pb + 5) && PM(6)) { FRESH(); PROBE_BEGIN(6); if (DUP(6) > 1) r_phase<1, false, false, true>(F, l, F.out, F.out); r_phase<1, false, false>(F, l, F.out, F.out); PROBE_END(6); SEAM(pb + 5); }
        if ((IN(pb + 6) && PM(7)) || (IN(pb + 7) && PM(8))) { FRESH();
            LAS int* tb = (LAS int*)(F.lds + LDSCTL_OFF + LC_TB); LAS int* cn = (LAS int*)(F.lds + LDSCTL_OFF + LC_CN);
            if (F.tid < NE) cn[F.tid] = (int)__hip_atomic_load(F.ctl + CW_CUR + (l * NE + F.tid) * 16, __ATOMIC_RELAXED, __HIP_MEMORY_SCOPE_AGENT);
            __syncthreads();
            if (F.tid == 0) { int a = 0; for (int e = 0; e < NE; ++e) { tb[e] = a; a += (cn[e] + 255) >> 8; } tb[NE] = a; }
            __syncthreads();
            const int ntile = tb[NE];
            if (IN(pb + 6) && PM(7)) { PROBE_BEGIN(7);
                typedef pg8::MoeOrder<true, W1E_BYTES, (size_t)256 * D> Ord1; Ord1 S; S.rep = DUP(3); S.nM = ntile; S.nN = 2 * FF / 256; S.nwg = S.nM * S.nN; S.G = F.G; S.c = F.bid; S.Wt = (const char*)(F.ws + WS_W1 + (size_t)l * NE * W1E_BYTES);
                S.tb = tb; S.cn = cn; S.list = (const u32x2*)(F.ws + WS_LIST); S.qctr = F.ctl + CW_GQ + (l * 2 + 0) * 8 * 16; S.xcc = (int)hw_xcc_id(); S.koffp = (LAS int*)(F.lds + LDSCTL_OFF + LC_GQ + 8);
                pg8::EpiGlu E{(unsigned char*)(F.ws + WS_PA), (const u32x2*)(F.ws + WS_LIST), (const float*)(F.ws + WS_B1R) + (size_t)l * NE * 2048};
                pg8::gemm_phase<pg8::EpiGlu, Ord1, true, true>(F.tid, F.lds, F.ws + WS_HB8, D, S, E);
                PROBE_END(7); SEAM(pb + 6);
            }
            if (IN(pb + 7) && PM(8)) { FRESH(); PROBE_BEGIN(8);
                typedef pg8::MoeOrder<false, W2E_BYTES, (size_t)256 * FF> Ord2; Ord2 S; S.rep = DUP(4); S.nM = ntile; S.nN = D / 256; S.nwg = S.nM * S.nN; S.G = F.G; S.c = F.bid; S.Wt = (const char*)(F.ws + WS_W2 + (size_t)l * NE * W2E_BYTES);
                S.tb = tb; S.cn = cn; S.list = (const u32x2*)(F.ws + WS_LIST); S.qctr = F.ctl + CW_GQ + (l * 2 + 1) * 8 * 16; S.xcc = (int)hw_xcc_id(); S.koffp = (LAS int*)(F.lds + LDSCTL_OFF + LC_GQ + 8);
                pg8::EpiDown E{(unsigned char*)(F.ws + WS_Y), (const u32x2*)(F.ws + WS_LIST), (const float*)(F.ws + WS_GATE), inp(F, I_b2) + (size_t)l * NE * D};
                pg8::gemm_phase<pg8::EpiDown, Ord2, true, true>(F.tid, F.lds, F.ws + WS_PA, FF, S, E);
                PROBE_END(8); SEAM(pb + 7);
            }
        }
    }
    if (IN(N_PHASES - 1) && PM(9)) { FRESH(); PROBE_BEGIN(9); r_final(F); PROBE_END(9); }
#ifndef PROBE_BLOCK
#define PROBE_BLOCK 0
#endif
    if (PROBEMASK != 0 && blockIdx.x == PROBE_BLOCK) { const unsigned long long tw = __builtin_amdgcn_s_memrealtime(); while (__builtin_amdgcn_s_memrealtime() - tw < probe_acc) __builtin_amdgcn_s_sleep(8); }
#undef IN
#undef SEAM
}

extern "C" void kernel_launch(void* const* d_in, const int* in_sizes, int n_in, void* d_out, int out_size, void* d_ws, size_t ws_size, hipStream_t stream) {
    static int grid = 0;
    if (grid == 0) {
        if (n_in != 18 || out_size != T * D || ws_size < WS_END) { fprintf(stderr, "kernel_launch: unexpected shapes (n_in %d out %d ws %zu need %zu)\n", n_in, out_size, ws_size, (size_t)WS_END); grid = -1; return; }
        int dev = 0, cus = 0;
        if (hipGetDevice(&dev) != hipSuccess || hipDeviceGetAttribute(&cus, hipDeviceAttributeMultiprocessorCount, dev) != hipSuccess) { grid = -1; return; }
        if (hipFuncSetAttribute((const void*)trunk_fwd, hipFuncAttributeMaxDynamicSharedMemorySize, LDS_BYTES) != hipSuccess) { fprintf(stderr, "kernel_launch: hipFuncSetAttribute failed\n"); grid = -1; return; }
        int per_cu = 0;
        if (hipOccupancyMaxActiveBlocksPerMultiprocessor(&per_cu, (const void*)trunk_fwd, NTHREADS, LDS_BYTES) != hipSuccess || per_cu < 1) { fprintf(stderr, "kernel_launch: occupancy query says %d\n", per_cu); (void)hipGetLastError(); }
        grid = cus;
    }
    if (grid < 0) return;
    (void)hipMemsetAsync((char*)d_ws + WS_CTL, 0, CTL_ZERO_BYTES, stream);
    Args a{};
    for (int i = 0; i < 18; ++i) a.in[i] = (const float*)d_in[i];
    a.out = (float*)d_out; a.ws = (unsigned char*)d_ws;
#if MK_SPLIT
    for (int p = 0; p < N_PHASES; ++p) { a.ph_lo = p; a.ph_hi = p + 1; hipLaunchKernelGGL(trunk_fwd, dim3(grid), dim3(NTHREADS), LDS_BYTES, stream, a); }
#else
    a.ph_lo = 0; a.ph_hi = N_PHASES; hipLaunchKernelGGL(trunk_fwd, dim3(grid), dim3(NTHREADS), LDS_BYTES, stream, a);
#endif
}
```

```cpp
#include <hip/hip_runtime.h>
#include <cstdio>
#include <cstdint>

#ifndef MK_SPLIT
#define MK_SPLIT 0
#endif

#ifndef DUPMASK
#define DUPMASK 0
#endif
#define DUP(b) (1 + ((DUPMASK >> (b)) & 1))
#define LAS __attribute__((address_space(3)))
#define GAS __attribute__((address_space(1)))
typedef unsigned short bf16_t;
typedef short bf16x8 __attribute__((ext_vector_type(8)));
typedef float f32x4 __attribute__((ext_vector_type(4)));
typedef float f32x2 __attribute__((ext_vector_type(2)));
typedef float f32x16 __attribute__((ext_vector_type(16)));
typedef unsigned u32x4 __attribute__((ext_vector_type(4)));
typedef unsigned u32x2 __attribute__((ext_vector_type(2)));
typedef __bf16 bf16x2_t __attribute__((ext_vector_type(2)));
typedef short v4i16_t __attribute__((ext_vector_type(4)));
typedef int v8i __attribute__((ext_vector_type(8)));
struct bf16x8_pair { bf16x8 a, b; };

constexpr int NB = 8, SEQ = 4096, T = NB * SEQ, D = 1024, NL = 4;
constexpr int NPROJ = 2816;
constexpr int C_FQ = 0, C_FK = 512, C_FV = 1024, C_GQ = 1536, C_GF = 1792, C_GI = 2048, C_GG = 2304, C_PU = 2560;
constexpr int IN_COLS = 2824;
constexpr int NE = 32, TOPK = 4, FF = 1024, MROWS = T * TOPK, LISTCAP = MROWS, MAXTILES = MROWS / 256 + NE;
constexpr float RMS_EPS = 1e-5f, LOG2E = 1.4426950408889634f;
constexpr float QSCALE = 0.125f * LOG2E;
constexpr int NWAVES = 8, NTHREADS = 512;

constexpr size_t MiB = 1u << 20;
constexpr size_t WS_CTL = 0, CTL_ZERO_BYTES = 1 * MiB;
constexpr size_t WS_RSTD1 = 1 * MiB, WS_RSTD2 = WS_RSTD1 + 128 * 1024;
constexpr size_t WS_LOGF = 2 * MiB, WS_C2 = 3 * MiB, WS_GATE = 4 * MiB, WS_B1R = 5 * MiB, WS_WFRAG = 6 * MiB, WS_LIST = 8 * MiB;
constexpr size_t WS_WIN = 40 * MiB, WIN_BYTES = (size_t)NPROJ * D * 2;
constexpr size_t WS_WOUT = 62 * MiB, WOUT_BYTES = (size_t)D * D * 2;
constexpr size_t WS_W1 = 70 * MiB, W1E_BYTES = (size_t)2 * FF * D;
constexpr size_t WS_W2 = 582 * MiB, W2E_BYTES = (size_t)D * FF;
constexpr size_t WS_HB8 = 400 * MiB;
constexpr float W1_SCALE = 64.f, W2_SCALE = 128.f, ACT_SCALE = 4.f, Y_SCALE = 16.f;
constexpr size_t WS_HB = 838 * MiB;
constexpr size_t WS_PA = 902 * MiB;
constexpr size_t WS_MIXED = WS_PA + 176 * MiB;
constexpr size_t WS_Y = 1174 * MiB;
constexpr size_t WS_ORAW = 1430 * MiB;
constexpr size_t WS_SEND = 1558 * MiB;
constexpr size_t WS_PSEG = 1566 * MiB;
constexpr size_t WS_QE = 1567 * MiB;
constexpr size_t WS_PWT = 1583 * MiB;
constexpr size_t WS_SEND2 = 1584 * MiB;
constexpr size_t WS_GLIST = 1600 * MiB;
constexpr size_t WS_END = 1616 * MiB;
static_assert(WS_WIN + NL * WIN_BYTES <= WS_WOUT && WS_WOUT + NL * WOUT_BYTES <= WS_W1 && WS_W1 + (size_t)NL * NE * W1E_BYTES <= WS_W2 && WS_W2 + (size_t)NL * NE * W2E_BYTES <= WS_HB, "ws map");
static_assert((size_t)MAXTILES * 256 * FF * 2 <= 272 * MiB && (size_t)T * NPROJ * 2 <= 176 * MiB, "ws map 2");
constexpr int CW_TMO = 0, CW_BAR = 4096, CW_CUR = 16384, CW_KMAX = 32768, CW_AQ = 40960;
constexpr int PH_BYTES = 139264, LDSCTL_OFF = PH_BYTES, LDS_BYTES = PH_BYTES + 2048;
static_assert(PH_BYTES >= 131072 + 512 * 16, "GEMM phase: stage buffers + parked A offsets");
constexpr int LC_BAR = 0, LC_TB = 64, LC_CN = 256, LC_R2CNT = 512, LC_R2BASE = 640, LC_STOP = 768, LC_SCAN = 896, LC_INP = 1024, LC_AQ = 1280;

__device__ __forceinline__ unsigned cvtpk(float lo, float hi) { f32x2 v = {lo, hi}; bf16x2_t b = __builtin_convertvector(v, bf16x2_t); return __builtin_bit_cast(unsigned, b); }
__device__ __forceinline__ float bflo(unsigned w) { return __uint_as_float(w << 16); }
__device__ __forceinline__ float bfhi(unsigned w) { return __uint_as_float(w & 0xffff0000u); }
__device__ __forceinline__ float bf2f(bf16_t h) { return __uint_as_float((unsigned)h << 16); }
__device__ __forceinline__ bf16_t f2bf(float f) { return (bf16_t)(cvtpk(f, 0.f) & 0xffffu); }
__device__ __forceinline__ float rdlane(float v, int l) { return __uint_as_float((unsigned)__builtin_amdgcn_readlane((int)__float_as_uint(v), l)); }
__device__ __forceinline__ unsigned pk4_fp8(float a, float b, float c, float d) { int w = __builtin_amdgcn_cvt_pk_fp8_f32(a, b, 0, false); w = __builtin_amdgcn_cvt_pk_fp8_f32(c, d, w, true); return (unsigned)w; }
__device__ __forceinline__ unsigned pk4_fp8_sat(float a, float b, float c, float d) {
    return pk4_fp8(__builtin_amdgcn_fmed3f(a, -448.f, 448.f), __builtin_amdgcn_fmed3f(b, -448.f, 448.f), __builtin_amdgcn_fmed3f(c, -448.f, 448.f), __builtin_amdgcn_fmed3f(d, -448.f, 448.f)); }
__device__ __forceinline__ f32x4 un4_fp8(unsigned w) { const f32x2 a = __builtin_amdgcn_cvt_pk_f32_fp8((int)w, false), b = __builtin_amdgcn_cvt_pk_f32_fp8((int)w, true); return (f32x4){a.x, a.y, b.x, b.y}; }
#define LDS_WAIT() asm volatile("s_waitcnt lgkmcnt(0)" ::: "memory")
#define VM_WAIT() asm volatile("s_waitcnt vmcnt(0)" ::: "memory")

namespace pg8 {
constexpr int BM = 256, BK = 64, HALF = 128, HTB = HALF * BK * 2, STAGE_BYTES = 8 * HTB, NXCD = 8, WGM = 8;
__host__ __device__ __forceinline__ int lds_byte(int r, int c) { const int st = (r >> 4) * 2 + (c >> 5), rr = r & 15, cc = c & 31, ob = rr * 64 + cc * 2; return st * 1024 + (ob ^ (((ob >> 9) & 1) << 5)); }
__host__ __device__ __forceinline__ void stage_rc(int b, int& R, int& C) { const int st = b / 1024, sb = b % 1024, swz = sb ^ (((sb >> 9) & 1) << 5); R = (st >> 1) * 16 + swz / 64; C = (st & 1) * 32 + (swz % 64) / 2; }
__host__ __device__ __forceinline__ int perm32(int rho) { const int n = rho >> 4, i = rho & 15; return 8 * (i >> 2) + 4 * n + (i & 3); }

struct Unit { int pm, pn, e, lt, cnt; };

__device__ __forceinline__ void tile_of(int L, int nM, int nN, int& pm, int& pn) {
    const int nwg = nM * nN; int wgid = L;
    { const int q = nwg / NXCD, r = nwg % NXCD, xcd = wgid % NXCD, off = wgid / NXCD; wgid = (xcd < r ? xcd * (q + 1) : r * (q + 1) + (xcd - r) * q) + off; }
    const int nig = WGM * nN, gid = wgid / nig, fm = gid * WGM, gsz = (nM - fm) < WGM ? (nM - fm) : WGM;
    pm = fm + ((wgid % nig) % gsz); pn = (wgid % nig) / gsz;
}
struct StaticOrder {
    int nM, nN, nwg, G, c, rep = 1; const char* Bt; size_t tstep;
    __device__ void init(int M, int N, int K, int G_, int c_, const bf16_t* Bt_) { nM = M / BM; nN = N / BM; nwg = nM * nN; G = G_; c = c_; Bt = (const char*)Bt_; tstep = (size_t)BM * K * 2; }
    __device__ __forceinline__ bool next(int i, Unit& u) const { long L = (long)i * G + c; if (L >= (long)nwg * rep) return false; L %= nwg; tile_of((int)L, nM, nN, u.pm, u.pn); u.e = 0; u.lt = 0; u.cnt = 0; return true; }
    __device__ __forceinline__ const char* bbase(const Unit& u) const { return Bt + (size_t)u.pn * tstep; }
    __device__ __forceinline__ int arow(const Unit& u, int r) const { return u.pm * BM + r; }
};
template <bool GATHER, size_t ESTRIDE, size_t TSTEP> struct MoeOrder {
    static constexpr size_t estride = ESTRIDE, tstep = TSTEP;
    int nM, nN, nwg, G, c, rep = 1; const char* Wt; LAS const int* tb; LAS const int* cn; const u32x2* list;
    __device__ __forceinline__ bool next(int i, Unit& u) const {
        long L = (long)i * G + c; if (L >= (long)nwg * rep) return false; L %= nwg; tile_of((int)L, nM, nN, u.pm, u.pn);
        int e = 0; while (e < NE - 1 && __builtin_amdgcn_readfirstlane(tb[e + 1]) <= u.pm) ++e;
        u.e = e; u.lt = u.pm - __builtin_amdgcn_readfirstlane(tb[e]); u.cnt = __builtin_amdgcn_readfirstlane(cn[e]); return true; }
    __device__ __forceinline__ const char* bbase(const Unit& u) const { return Wt + (size_t)u.e * estride + (size_t)u.pn * tstep; }
    __device__ __forceinline__ int arow(const Unit& u, int r) const {
        if (!GATHER) return u.pm * BM + r;
        const int pos = u.lt * BM + r; const char* lb = (const char*)(list + (size_t)u.e * LISTCAP);
        return pos < u.cnt ? (int)(*(const unsigned*)(lb + (unsigned)pos * 8u) >> 2) : 0; }
};

#ifndef PROBE_EPI
#define PROBE_EPI 0
#endif
template <class Epi, class Sched, bool ALIGN_EPI, bool FP8 = false>
__device__ __forceinline__ unsigned long long gemm_phase(const int tid, LAS unsigned char* lds, const void* Abase, const int  , const Sched& S, const Epi& E) {
    constexpr int K = 1024;
    const int wid = __builtin_amdgcn_readfirstlane(tid >> 6), lane = tid & 63, wr = wid >> 2, wc = wid & 3, fr = lane & 15, fq = lane >> 4;
    constexpr int rowB = FP8 ? K : 2 * K;
    constexpr int nt = rowB / (BK * 2);
    unsigned voffB[2];
#pragma unroll
    for (int i = 0; i < 2; ++i) { int R, C; stage_rc(tid * 16 + i * 8192, R, C); const int Rb = Epi::PERM ? ((R & ~31) + perm32(R & 31)) : R; voffB[i] = (unsigned)(Rb * rowB + C * 2); }
    constexpr size_t kstep = (size_t)(BK * 2);
    constexpr size_t hstep = (size_t)HALF * rowB;
    const unsigned ldsw = (unsigned)wid * 1024u;
    const int a8off = (fq >> 1) * 1024 + ((fr * 64 + 32 * (fq & 1)) ^ (((fr >> 3) & 1) << 5));
    const int aoff = FP8 ? (wr * 8192 + a8off) : lds_byte(wr * 64 + fr, fq * 8), boff = FP8 ? (wc * 4096 + a8off) : lds_byte(wc * 32 + fr, fq * 8);
    const char* A8 = (const char*)Abase;
#define PG8_SA(b, h) (((b) * 2 + (h)) * HTB)
#define PG8_SB(b, h) ((4 + (b) * 2 + (h)) * HTB)
#define PG8_STGB(bufoff, gbase) do { _Pragma("unroll") for (int _i = 0; _i < 2; ++_i) \
        __builtin_amdgcn_global_load_lds((const unsigned*)((const char*)(gbase) + voffB[_i]), (LAS unsigned*)(lds + (bufoff) + ldsw + _i * 8192), 16, 0, 0); } while (0)
#define PG8_STGA(bufoff, kb, o0, o1) do { \
        __builtin_amdgcn_global_load_lds((const unsigned*)(A8 + (size_t)(kb) + (o0)), (LAS unsigned*)(lds + (bufoff) + ldsw), 16, 0, 0); \
        __builtin_amdgcn_global_load_lds((const unsigned*)(A8 + (size_t)(kb) + (o1)), (LAS unsigned*)(lds + (bufoff) + ldsw + 8192), 16, 0, 0); } while (0)
#define PG8_LD8(off) __builtin_bit_cast(v8i, bf16x8_pair{*(const LAS bf16x8*)(lds + (off)), *(const LAS bf16x8*)(lds + (off) + 16)})
#define PG8_LDA(dst, b, h) do { if constexpr (FP8) { _Pragma("unroll") for (int m = 0; m < 4; ++m) dst##8[m] = PG8_LD8(PG8_SA(b, h) + aoff + m * 2048); } \
        else { _Pragma("unroll") for (int m = 0; m < 4; ++m) _Pragma("unroll") for (int k = 0; k < 2; ++k) dst[m][k] = *(const LAS bf16x8*)(lds + PG8_SA(b, h) + aoff + m * 2048 + k * 1024); } } while (0)
#define PG8_LDB(dst, b, h) do { if constexpr (FP8) { _Pragma("unroll") for (int n = 0; n < 2; ++n) dst##8[n] = PG8_LD8(PG8_SB(b, h) + boff + n * 2048); } \
        else { _Pragma("unroll") for (int n = 0; n < 2; ++n) _Pragma("unroll") for (int k = 0; k < 2; ++k) dst[n][k] = *(const LAS bf16x8*)(lds + PG8_SB(b, h) + boff + n * 2048 + k * 1024); } } while (0)
#define PG8_MMA(ai, bj, At, Bt) do { __builtin_amdgcn_s_setprio(1); _Pragma("unroll") for (int m = 0; m < 4; ++m) _Pragma("unroll") for (int n = 0; n < 2; ++n) { \
        if constexpr (FP8) asm volatile("v_mfma_f32_16x16x128_f8f6f4 %0, %1, %2, %0" : "+v"(acc[ai][bj][m][n]) : "v"(Bt##8[n]), "v"(At##8[m]));     \
        else { _Pragma("unroll") for (int k = 0; k < 2; ++k) acc[ai][bj][m][n] = __builtin_amdgcn_mfma_f32_16x16x32_bf16(Bt[n][k], At[m][k], acc[ai][bj][m][n], 0, 0, 0); } } __builtin_amdgcn_s_setprio(0); } while (0)
#define PG8_WAIT_V(n) asm volatile("s_waitcnt vmcnt(" #n ")" ::: "memory")
#define PG8_WAIT_L(n) asm volatile("s_waitcnt lgkmcnt(" #n ")" ::: "memory")
#define PG8_BAR __builtin_amdgcn_s_barrier()
#define PG8_SCHED __builtin_amdgcn_sched_barrier(0)
#define PG8_AOFF(u, dst) do { int t_ = tid; asm volatile("" : "+v"(t_));     \
        _Pragma("unroll") for (int _h = 0; _h < 2; ++_h) _Pragma("unroll") for (int _i = 0; _i < 2; ++_i) \
        { int R_, C_; stage_rc(t_ * 16 + _i * 8192, R_, C_); dst[_h][_i] = (unsigned)((size_t)S.arow(u, _h * HALF + R_) * (size_t)rowB + (size_t)(C_ * 2)); } } while (0)
    Unit cur, nxt; int ui = 0; unsigned long long epi_acc = 0ull;
    if (!S.next(0, cur)) return 0ull;
    f32x4 acc[2][2][4][2];
#pragma unroll
    for (int a = 0; a < 2; ++a)
#pragma unroll
        for (int b = 0; b < 2; ++b)
#pragma unroll
            for (int m = 0; m < 4; ++m)
#pragma unroll
                for (int n = 0; n < 2; ++n) acc[a][b][m][n] = (f32x4){0.f, 0.f, 0.f, 0.f};
    bf16x8 At[4][2], B0[2][2], B1[2][2]; v8i At8[4], B08[2], B18[2];
    unsigned aoC[2][2], aoN[2][2];
    PG8_AOFF(cur, aoC);
    const char* cB = S.bbase(cur);
    PG8_STGB(PG8_SB(0, 0), cB); PG8_STGB(PG8_SB(0, 1), cB + hstep); PG8_STGA(PG8_SA(0, 0), 0, aoC[0][0], aoC[0][1]); PG8_STGA(PG8_SA(0, 1), 0, aoC[1][0], aoC[1][1]);
    if (wr == 1) PG8_BAR;
    PG8_WAIT_V(2); PG8_BAR;
    PG8_STGB(PG8_SB(1, 0), cB + kstep); PG8_STGA(PG8_SA(1, 0), kstep, aoC[0][0], aoC[0][1]); PG8_STGB(PG8_SB(1, 1), cB + hstep + kstep);
    PG8_WAIT_V(6); PG8_BAR;
    for (;;) {
        const bool has_next = S.next(ui + 1, nxt);
        if (has_next) { PG8_AOFF(nxt, aoN); } else { aoN[0][0] = aoC[0][0]; aoN[0][1] = aoC[0][1]; aoN[1][0] = aoC[1][0]; aoN[1][1] = aoC[1][1]; }
        *(LAS u32x4*)(lds + STAGE_BYTES + tid * 16) = (u32x4){aoN[0][0], aoN[0][1], aoN[1][0], aoN[1][1]};
        const char* nB = has_next ? S.bbase(nxt) : cB;
        for (int t = 0; t < nt; t += 2) {
            asm volatile("" : "+v"(voffB[0]), "+v"(voffB[1]));
            const bool last = (t == nt - 2);
            const size_t k1 = (size_t)(t + 1) * kstep, k2 = last ? 0 : (size_t)(t + 2) * kstep, k3 = k2 + kstep;
            const char* b2 = last ? nB : cB + (size_t)(t + 2) * kstep; const char* b3 = b2 + kstep;
            PG8_LDB(B0, 0, 0); PG8_LDB(B1, 0, 1); PG8_SCHED; PG8_LDA(At, 0, 0); PG8_STGA(PG8_SA(1, 1), k1, aoC[1][0], aoC[1][1]);
            PG8_WAIT_V(8); PG8_WAIT_L(0); PG8_BAR; PG8_MMA(0, 0, At, B0); PG8_MMA(0, 1, At, B1); PG8_BAR; PG8_SCHED;
            if (last) { const u32x4 nx = *(const LAS u32x4*)(lds + STAGE_BYTES + tid * 16); aoC[0][0] = nx.x; aoC[0][1] = nx.y; aoC[1][0] = nx.z; aoC[1][1] = nx.w; }
            PG8_LDA(At, 0, 1); PG8_STGB(PG8_SB(0, 0), b2); PG8_STGB(PG8_SB(0, 1), b2 + hstep); PG8_STGA(PG8_SA(0, 0), k2, aoC[0][0], aoC[0][1]);
            PG8_WAIT_V(8); PG8_WAIT_L(0); PG8_BAR; PG8_MMA(1, 0, At, B0); PG8_MMA(1, 1, At, B1); PG8_BAR; PG8_SCHED;
            PG8_LDB(B0, 1, 0); PG8_LDB(B1, 1, 1); PG8_SCHED; PG8_LDA(At, 1, 0); PG8_STGA(PG8_SA(0, 1), k2, aoC[1][0], aoC[1][1]);
            PG8_WAIT_V(8); PG8_WAIT_L(0); PG8_BAR; PG8_MMA(0, 0, At, B0); PG8_MMA(0, 1, At, B1); PG8_BAR; PG8_SCHED;
            PG8_LDA(At, 1, 1); PG8_STGB(PG8_SB(1, 0), b3); PG8_STGB(PG8_SB(1, 1), b3 + hstep); PG8_STGA(PG8_SA(1, 0), k3, aoC[0][0], aoC[0][1]);
            PG8_WAIT_V(8); PG8_WAIT_L(0); PG8_BAR; PG8_MMA(1, 0, At, B0); PG8_MMA(1, 1, At, B1); PG8_BAR; PG8_SCHED;
        }
        if constexpr (FP8) asm volatile("s_nop 15\n\ts_nop 15" ::: "memory");
        const unsigned long long te0 = PROBE_EPI ? __builtin_amdgcn_s_memrealtime() : 0ull;
        if constexpr (ALIGN_EPI) { if (wr == 0) PG8_BAR; }
        { int t2_ = tid; asm volatile("" : "+v"(t2_)); const int l2_ = t2_ & 63; E(acc, cur, wr, wc, l2_ & 15, l2_ >> 4); }
        if (PROBE_EPI) { asm volatile("s_waitcnt vmcnt(0)" ::: "memory"); epi_acc += __builtin_amdgcn_s_memrealtime() - te0; }
        if (!has_next) break;
#pragma unroll
        for (int a = 0; a < 2; ++a)
#pragma unroll
            for (int b = 0; b < 2; ++b)
#pragma unroll
                for (int m = 0; m < 4; ++m)
#pragma unroll
                    for (int n = 0; n < 2; ++n) acc[a][b][m][n] = (f32x4){0.f, 0.f, 0.f, 0.f};
        cur = nxt; cB = nB; ++ui;
        if constexpr (ALIGN_EPI) { if (wr == 1) PG8_BAR; }
    }
    PG8_WAIT_V(0);
    if constexpr (!ALIGN_EPI) { if (wr == 0) PG8_BAR; }
    PG8_BAR;
    return epi_acc;
#undef PG8_SA
#undef PG8_SB
#undef PG8_STGA
#undef PG8_STGB
#undef PG8_LDA
#undef PG8_LD8
#undef PG8_LDB
#undef PG8_MMA
#undef PG8_WAIT_V
#undef PG8_WAIT_L
#undef PG8_BAR
#undef PG8_SCHED
#undef PG8_AOFF
}

struct EpiProj {
    static constexpr bool PERM = true;
    bf16_t* O; const float* rstd; unsigned* kmax;
    __device__ __forceinline__ void operator()(const f32x4 (&acc)[2][2][4][2], const Unit& u, int wr, int wc, int fr, int fq) const {
        const int row0 = u.pm * BM + wr * 64 + fr, col0 = u.pn * BM + wc * 32 + 8 * fq;
        const float sc = (u.pn < 2) ? QSCALE : 1.f; const bool isk = (u.pn == 2 || u.pn == 3);
        float km[2] = {0.f, 0.f}; float rsv[8];
#pragma unroll
        for (int g = 0; g < 8; ++g) rsv[g] = rstd[row0 + (g >> 2) * HALF + (g & 3) * 16] * sc;
#pragma unroll
        for (int ai = 0; ai < 2; ++ai)
#pragma unroll
            for (int m = 0; m < 4; ++m) { const int row = row0 + ai * HALF + m * 16; const float rs = rsv[ai * 4 + m]; bf16_t* rowp = O + (size_t)row * NPROJ + col0;
#pragma unroll
                for (int bj = 0; bj < 2; ++bj) { const f32x4 v0 = acc[ai][bj][m][0] * rs, v1 = acc[ai][bj][m][1] * rs;
                    u32x4 w; w.x = cvtpk(v0[0], v0[1]); w.y = cvtpk(v0[2], v0[3]); w.z = cvtpk(v1[0], v1[1]); w.w = cvtpk(v1[2], v1[3]);
                    *(u32x4*)(rowp + bj * HALF) = w;
                    if (isk) { float s = bflo(w.x) * bflo(w.x) + bfhi(w.x) * bfhi(w.x) + bflo(w.y) * bflo(w.y) + bfhi(w.y) * bfhi(w.y) + bflo(w.z) * bflo(w.z) + bfhi(w.z) * bfhi(w.z) + bflo(w.w) * bflo(w.w) + bfhi(w.w) * bfhi(w.w);
                        s += __shfl_xor(s, 16); s += __shfl_xor(s, 32); km[bj] = fmaxf(km[bj], s); } } }
        if (isk) {
#pragma unroll
            for (int bj = 0; bj < 2; ++bj) { float v = km[bj]; v = fmaxf(v, __shfl_xor(v, 1)); v = fmaxf(v, __shfl_xor(v, 2)); v = fmaxf(v, __shfl_xor(v, 4)); v = fmaxf(v, __shfl_xor(v, 8));
                if ((threadIdx.x & 63) == 0) { const int b = u.pm >> 4, h = (u.pn - 2) * 4 + bj * 2 + (wc >> 1); atomicMax(kmax + (b * 8 + h) * 16, __float_as_uint(v)); } }
        }
    }
};
struct EpiOut {
    static constexpr bool PERM = false;
    const float* res; float* out;
    __device__ __forceinline__ void operator()(const f32x4 (&acc)[2][2][4][2], const Unit& u, int wr, int wc, int fr, int fq) const {
        const int row0 = u.pm * BM + wr * 64 + fr, col0 = u.pn * BM + wc * 32 + 4 * fq;
        f32x4 r[2][4];
#pragma unroll
        for (int q = 0; q < 4; ++q) r[0][q] = *(const f32x4*)(res + (size_t)row0 * D + col0 + (q >> 1) * HALF + (q & 1) * 16);
#pragma unroll
        for (int g = 0; g < 8; ++g) { const int ai = g >> 2, m = g & 3; const size_t off = (size_t)(row0 + ai * HALF + m * 16) * D + col0;
            if (g + 1 < 8) { const int ai2 = (g + 1) >> 2, m2 = (g + 1) & 3; const size_t off2 = (size_t)(row0 + ai2 * HALF + m2 * 16) * D + col0;
#pragma unroll
                for (int q = 0; q < 4; ++q) r[(g + 1) & 1][q] = *(const f32x4*)(res + off2 + (q >> 1) * HALF + (q & 1) * 16); }
#pragma unroll
            for (int q = 0; q < 4; ++q) *(f32x4*)(out + off + (q >> 1) * HALF + (q & 1) * 16) = r[g & 1][q] + acc[ai][q >> 1][m][q & 1]; }
    }
};
struct EpiGlu {
    static constexpr bool PERM = true;
    unsigned char* act; const u32x2* list; const float* b1r;
    __device__ __forceinline__ void operator()(const f32x4 (&acc)[2][2][4][2], const Unit& u, int wr, int wc, int fr, int fq) const {
        const int cb = u.pn * BM + wc * 32 + 8 * fq; const float* bp = b1r + (size_t)u.e * 2048 + cb; const char* lbase = (const char*)(list + (size_t)u.e * LISTCAP);
        float rsv[8];
#pragma unroll
        for (int g = 0; g < 8; ++g) { const int pos = u.lt * BM + (g >> 2) * HALF + wr * 64 + (g & 3) * 16 + fr; rsv[g] = 0.f; if (pos < u.cnt) rsv[g] = __uint_as_float(*(const unsigned*)(lbase + (unsigned)pos * 8u + 4u)) * (1.0f / W1_SCALE); }
        const f32x4 bg0 = *(const f32x4*)(bp), bg1 = *(const f32x4*)(bp + 4), bl0 = *(const f32x4*)(bp + HALF), bl1 = *(const f32x4*)(bp + HALF + 4);
#pragma unroll
        for (int ai = 0; ai < 2; ++ai)
#pragma unroll
            for (int m = 0; m < 4; ++m) { const int r = ai * HALF + wr * 64 + m * 16 + fr;
                const float rs = rsv[ai * 4 + m];
                float o[8];
                const f32x2 rs2 = {rs, rs};
#pragma unroll
                for (int p = 0; p < 4; ++p) {
                    const f32x4& ag = acc[ai][0][m][p >> 1]; const f32x4& al = acc[ai][1][m][p >> 1]; const f32x4& bgv = (p >> 1) ? bg1 : bg0; const f32x4& blv = (p >> 1) ? bl1 : bl0; const int q = 2 * (p & 1);
                    f32x2 g = (f32x2){ag[q], ag[q + 1]} * rs2 + (f32x2){bgv[q], bgv[q + 1]}, li = (f32x2){al[q], al[q + 1]} * rs2 + (f32x2){blv[q], blv[q + 1]};
                    g.x = __builtin_fminf(g.x, 7.f); g.y = __builtin_fminf(g.y, 7.f); li.x = __builtin_amdgcn_fmed3f(li.x, -7.f, 7.f); li.y = __builtin_amdgcn_fmed3f(li.y, -7.f, 7.f);
                    const f32x2 ea = g * (-1.702f * LOG2E); f32x2 d; d.x = __builtin_amdgcn_exp2f(ea.x); d.y = __builtin_amdgcn_exp2f(ea.y); d = d + 1.0f;
                    f32x2 rc; rc.x = __builtin_amdgcn_rcpf(d.x); rc.y = __builtin_amdgcn_rcpf(d.y);
                    const f32x2 tt = li * ACT_SCALE + ACT_SCALE, oo = (g * tt) * rc;
                    o[2 * p] = oo.x; o[2 * p + 1] = oo.y; }
                *(u32x2*)(act + (size_t)(u.pm * BM + r) * FF + u.pn * HALF + wc * 32 + 8 * fq) = (u32x2){pk4_fp8(o[0], o[1], o[2], o[3]), pk4_fp8(o[4], o[5], o[6], o[7])}; }
    }
};
struct EpiDown {
    static constexpr bool PERM = true;
    unsigned char* Y; const u32x2* list; const float* gate; const float* b2;
    __device__ __forceinline__ void operator()(const f32x4 (&acc)[2][2][4][2], const Unit& u, int wr, int wc, int fr, int fq) const {
        const int cb = u.pn * BM + wc * 32 + 8 * fq; const float* bp = b2 + (size_t)u.e * D + cb;
        f32x4 bv[2][2];
#pragma unroll
        for (int bj = 0; bj < 2; ++bj)
#pragma unroll
            for (int n = 0; n < 2; ++n) bv[bj][n] = *(const f32x4*)(bp + bj * HALF + 4 * n);
        unsigned entv[8]; float gtv[8];
#pragma unroll
        for (int g = 0; g < 8; ++g) { const int pos = u.lt * BM + (g >> 2) * HALF + wr * 64 + (g & 3) * 16 + fr; entv[g] = (pos < u.cnt) ? list[(size_t)u.e * LISTCAP + pos].x : 0xffffffffu; }
#pragma unroll
        for (int g = 0; g < 8; ++g) { const int pos = u.lt * BM + (g >> 2) * HALF + wr * 64 + (g & 3) * 16 + fr; gtv[g] = (pos < u.cnt) ? gate[(size_t)u.e * LISTCAP + pos] * Y_SCALE : 0.f; }
#pragma unroll
        for (int ai = 0; ai < 2; ++ai)
#pragma unroll
            for (int m = 0; m < 4; ++m) {
                if (entv[ai * 4 + m] != 0xffffffffu) { const unsigned ent = entv[ai * 4 + m]; const float gt = gtv[ai * 4 + m]; unsigned char* rowp = Y + (size_t)ent * D + cb;
#pragma unroll
                    for (int bj = 0; bj < 2; ++bj) { const f32x4 v0 = (acc[ai][bj][m][0] * (1.0f / (W2_SCALE * ACT_SCALE)) + bv[bj][0]) * gt, v1 = (acc[ai][bj][m][1] * (1.0f / (W2_SCALE * ACT_SCALE)) + bv[bj][1]) * gt;
                        *(u32x2*)(rowp + bj * HALF) = (u32x2){pk4_fp8_sat(v0[0], v0[1], v0[2], v0[3]), pk4_fp8_sat(v1[0], v1[1], v1[2], v1[3])}; } } }
    }
};
}

#define XB_TMO      128
#define XB_XCNT(j)  (256  + 64 * (j))
#define XB_XSUB(j)  (1280 + 64 * (j))
#define XB_XGEN(j)  (2304 + 64 * (j))
#define XB_TOP      3328
#define XB_TOPGEN   3392
#define XCD_BAR_WORDS 3456
#define XB_SPIN_CAP (1u << 18)
__device__ __forceinline__ unsigned xb_ld(unsigned* p)              { return __hip_atomic_load(p, __ATOMIC_RELAXED, __HIP_MEMORY_SCOPE_AGENT); }
__device__ __forceinline__ unsigned xb_add(unsigned* p, unsigned v) { return __hip_atomic_fetch_add(p, v, __ATOMIC_RELAXED, __HIP_MEMORY_SCOPE_AGENT); }
__device__ __forceinline__ unsigned xb_xcc_id() { return (unsigned)__builtin_amdgcn_s_getreg((3 << 11) | 20) & 0xFu; }
#define XB_SPIN(cond, bar) do { unsigned _sp = 0; while (cond) { __builtin_amdgcn_s_sleep(1); \
    if ((++_sp & 255u) == 0u) { if (xb_ld(&(bar)[XB_TMO])) break; if (_sp > XB_SPIN_CAP) { atomicAdd(&(bar)[XB_TMO], 1u); break; } } } } while (0)
struct XcdBarrier { unsigned* bar; unsigned x; volatile LAS unsigned* st; };
__device__ __forceinline__ XcdBarrier xcd_barrier_post(unsigned* bar, volatile LAS unsigned* st) {
    XcdBarrier b; b.bar = bar; b.x = xb_xcc_id(); b.st = st;
    if (threadIdx.x == 0) (void)xb_add(&bar[XB_XCNT(b.x)], 1u);
    return b;
}
__device__ __forceinline__ void xcd_barrier_complete(unsigned* bar, unsigned x, unsigned& nloc, unsigned& nx) {
    const unsigned G = gridDim.x * gridDim.y * gridDim.z;
    unsigned sum, cnt, mine, sp = 0u;
    for (;;) {
        sum = 0u; cnt = 0u; mine = 0u;
#pragma unroll
        for (unsigned j = 0; j < 16; ++j) { const unsigned c = xb_ld(&bar[XB_XCNT(j)]); sum += c; cnt += (c > 0u) ? 1u : 0u; mine = (j == x) ? c : mine; }
        if (sum == G) break;
        __builtin_amdgcn_s_sleep(1);
        if ((++sp & 255u) == 0u) { if (xb_ld(&bar[XB_TMO])) break; if (sp > XB_SPIN_CAP) { atomicAdd(&bar[XB_TMO], 1u); break; } }
    }
    nloc = mine > 0u ? mine : 1u; nx = cnt > 0u ? cnt : 1u;
}
__device__ __forceinline__ void xcd_barrier(const XcdBarrier& b, const bool leader  ) {
    asm volatile("s_waitcnt vmcnt(0)" ::: "memory");
    __syncthreads();
    if (leader) {
        unsigned* bar = b.bar;
        __builtin_amdgcn_s_waitcnt(0);
        unsigned nloc = b.st[0], nx = b.st[1];
        if (nloc == 0u) { xcd_barrier_complete(bar, b.x, nloc, nx); b.st[0] = nloc; b.st[1] = nx; }
        const unsigned old = xb_add(&bar[XB_XSUB(b.x)], 1u);
        const unsigned gen = old / nloc;
        if (old + 1u == (gen + 1u) * nloc) {
            __builtin_amdgcn_fence(__ATOMIC_RELEASE, "agent");
            asm volatile("s_waitcnt vmcnt(0)" ::: "memory");
            const unsigned og = xb_add(&bar[XB_TOP], 1u);
            const unsigned tg = og / nx;
            if (og + 1u == (tg + 1u) * nx) xb_add(&bar[XB_TOPGEN], 1u);
            else XB_SPIN(xb_ld(&bar[XB_TOPGEN]) == tg, bar);
            __builtin_amdgcn_fence(__ATOMIC_ACQUIRE, "agent");
            xb_add(&bar[XB_XGEN(b.x)], 1u);
            asm volatile("s_waitcnt vmcnt(0)" ::: "memory");
        } else {
            XB_SPIN(xb_ld(&bar[XB_XGEN(b.x)]) == gen, bar);
            __builtin_amdgcn_fence(__ATOMIC_ACQUIRE, "agent");
            asm volatile("s_waitcnt vmcnt(0)" ::: "memory");
        }
    }
    __syncthreads();
}

enum { I_x = 0, I_norm_mix, I_w_in, I_b_fox_f, I_fox_gain, I_hgrn_lb, I_hgrn_gain, I_pool_w, I_pool_scale, I_w_out, I_norm_moe, I_w_router, I_b_router, I_w1, I_b1, I_w2, I_b2, I_norm_final };
struct Frame {
    LAS unsigned char* lds; unsigned char* ws; unsigned* ctl; float* out;
    int tid, lane, wave, bid, G;
};
__device__ __forceinline__ const float* inp(const Frame& F, int i) {
    const LAS unsigned* p = (const LAS unsigned*)(F.lds + LDSCTL_OFF + LC_INP) + 2 * i;
    const unsigned lo = __builtin_amdgcn_readfirstlane(p[0]), hi = __builtin_amdgcn_readfirstlane(p[1]);
    return (const float*)(((unsigned long long)hi << 32) | lo);
}

constexpr int P0_ROWB = 272;
template <bool INTERLEAVED, bool OUT8 = false>
__device__ __forceinline__ void p0_item(const float* src  , int ldn, const float* g  , void* dstv  , int K, int drow0, int extra, LAS unsigned char* tile, int lane, float scale = 1.f) {
    bf16_t* dst = (bf16_t*)dstv; unsigned char* dst8 = (unsigned char*)dstv;
    f32x4 v[16];
    const float* sp = src + (size_t)(lane >> 5) * ldn + 4 * (lane & 31);
#pragma unroll
    for (int j = 0; j < 16; ++j) v[j] = __builtin_nontemporal_load((const f32x4*)(sp + (size_t)(2 * j) * ldn));
    if (g) {
#pragma unroll
        for (int j = 0; j < 16; ++j) v[j] = v[j] * (g[2 * j + (lane >> 5)] * scale);
    } else if (OUT8) {
#pragma unroll
        for (int j = 0; j < 16; ++j) v[j] = v[j] * scale;
    }
#pragma unroll
    for (int j = 0; j < 16; ++j) { const int k = 2 * j + (lane >> 5); const unsigned w0 = cvtpk(v[j][0], v[j][1]), w1 = cvtpk(v[j][2], v[j][3]);
        if (INTERLEAVED) { const unsigned gg = (w0 & 0xffffu) | (w1 << 16), ll = (w0 >> 16) | (w1 & 0xffff0000u);
            *(LAS unsigned*)(tile + k * P0_ROWB + 4 * (lane & 31)) = gg; *(LAS unsigned*)(tile + k * P0_ROWB + 128 + 4 * (lane & 31)) = ll; }
        else *(LAS u32x2*)(tile + k * P0_ROWB + 8 * (lane & 31)) = (u32x2){w0, w1}; }
    LDS_WAIT(); asm volatile("" ::: "memory");
    const int gq = lane >> 4, i16 = lane & 15;
    const LAS unsigned char* rp = tile + (8 * gq + (i16 >> 2)) * P0_ROWB + 8 * (lane & 3);
#pragma unroll
    for (int nb = 0; nb < 8; ++nb) {
        const v4i16_t lo = __builtin_amdgcn_ds_read_tr16_b64_v4i16((LAS v4i16_t*)(rp + nb * 32)), hi = __builtin_amdgcn_ds_read_tr16_b64_v4i16((LAS v4i16_t*)(rp + nb * 32 + 4 * P0_ROWB));
        const int tc = nb * 16 + i16, row = drow0 + tc + (tc >= 64 ? extra : 0);
        if (OUT8) { *(u32x2*)(dst8 + (size_t)row * K + 8 * gq) = (u32x2){pk4_fp8(bf2f((bf16_t)lo[0]), bf2f((bf16_t)lo[1]), bf2f((bf16_t)lo[2]), bf2f((bf16_t)lo[3])), pk4_fp8(bf2f((bf16_t)hi[0]), bf2f((bf16_t)hi[1]), bf2f((bf16_t)hi[2]), bf2f((bf16_t)hi[3]))}; }
        else { const bf16x8 o = (bf16x8){lo[0], lo[1], lo[2], lo[3], hi[0], hi[1], hi[2], hi[3]};
            *(bf16x8*)(dst + (size_t)row * K + 8 * gq) = o; } }
    LDS_WAIT(); asm volatile("" ::: "memory");
}
__device__ __forceinline__ void p0_prologue(const Frame& F) {
    LAS unsigned char* tile = F.lds + F.wave * (32 * P0_ROWB);
    const int gw = F.bid * NWAVES + F.wave, NGW = F.G * NWAVES;
    constexpr int I_IN = 32 * 22, I_OUT = 32 * 8, I_W1 = NE * 32 * 16, I_W2 = NE * 32 * 8, I_L = I_IN + I_OUT + I_W1 + I_W2;
    for (int it = gw; it < NL * I_L; it += NGW) {
        const int l = it / I_L; int r = it % I_L;
        if (r < I_IN) { const int nb = r / 32, kb = r % 32, n0 = 128 * nb, k0 = 32 * kb;
            p0_item<false>(inp(F, I_w_in) + ((size_t)l * D + k0) * IN_COLS + n0 + (n0 >= 1536 ? 8 : 0), IN_COLS, inp(F, I_norm_mix) + l * D + k0, (bf16_t*)(F.ws + WS_WIN + l * WIN_BYTES) + k0, D, n0, 0, tile, F.lane); continue; }
        r -= I_IN;
        if (r < I_OUT) { const int nb = r / 32, kb = r % 32, n0 = 128 * nb, k0 = 32 * kb;
            p0_item<false>(inp(F, I_w_out) + ((size_t)l * D + k0) * D + n0, D, nullptr, (bf16_t*)(F.ws + WS_WOUT + l * WOUT_BYTES) + k0, D, n0, 0, tile, F.lane); continue; }
        r -= I_OUT;
        if (r < I_W1) { const int e = r / (32 * 16), q = r % (32 * 16), cb = q / 32, kb = q % 32, k0 = 32 * kb, j0 = 64 * cb;
            p0_item<true, true>(inp(F, I_w1) + (((size_t)l * NE + e) * D + k0) * (2 * FF) + 2 * j0, 2 * FF, inp(F, I_norm_moe) + l * D + k0, F.ws + WS_W1 + ((size_t)l * NE + e) * W1E_BYTES + k0, D, (j0 >> 7) * 256 + (j0 & 127), 64, tile, F.lane, W1_SCALE); continue; }
        r -= I_W1;
        { const int e = r / (32 * 8), q = r % (32 * 8), nb = q / 32, kb = q % 32, n0 = 128 * nb, k0 = 32 * kb;
            p0_item<false, true>(inp(F, I_w2) + (((size_t)l * NE + e) * FF + k0) * D + n0, D, nullptr, F.ws + WS_W2 + ((size_t)l * NE + e) * W2E_BYTES + k0, FF, n0, 0, tile, F.lane, W2_SCALE); }
    }
    const int gt = F.bid * NTHREADS + F.tid, NGT = F.G * NTHREADS;
    float* b1r = (float*)(F.ws + WS_B1R);
    for (int i = gt; i < NL * NE * 2048; i += NGT) { const int le = i >> 11, n = i & 2047, pn = n >> 8, rr = n & 255; b1r[i] = inp(F, I_b1)[(size_t)le * 2048 + 2 * (128 * pn + (rr & 127)) + (rr >> 7)]; }
    { bf16_t* pwt = (bf16_t*)(F.ws + WS_PWT);
      for (int i = gt; i < NL * 4 * 64 * 64; i += NGT) { const int c = i & 63, d = (i >> 6) & 63, lg = i >> 12; pwt[i] = f2bf(inp(F, I_pool_w)[((size_t)lg * 64 + c) * 64 + d]); } }
    bf16_t* wf = (bf16_t*)(F.ws + WS_WFRAG);
    for (int i = gt; i < NL * 2 * 32 * 2 * 64 * 8; i += NGT) {
        const int j = i & 7, ln = (i >> 3) & 63, et = (i >> 9) & 1, ks = (i >> 10) & 31, kind = (i >> 15) & 1, l = i >> 16;
        const int e = 16 * et + (ln & 15), k = 32 * ks + 8 * (ln >> 4) + j;
        float v;
        if (kind == 0) v = (e < 8) ? inp(F, I_norm_mix)[l * D + k] * inp(F, I_w_in)[((size_t)l * D + k) * IN_COLS + 1536 + e] : 0.f;
        else v = inp(F, I_norm_moe)[l * D + k] * inp(F, I_w_router)[((size_t)l * D + k) * NE + e];
        const bf16_t h = f2bf(v), lo = f2bf(v - bf2f(h));
        const size_t base = ((((size_t)(l * 2 + kind) * 32 + ks) * 2 + et) * 2) * 512 + ln * 8 + j;
        wf[base] = h; wf[base + 512] = lo;
    }
}

template <int KIND, bool COMBINE, bool WRITE_H, bool DRY = false>
__device__ __forceinline__ void r_phase(const Frame& F, int l, const float* hin, float* hout) {
    const int lane = F.lane, r16 = lane & 15, q4 = lane >> 4;
    const u32x4* Wf = (const u32x4*)(F.ws + WS_WFRAG + (size_t)(l * 2 + KIND) * 131072);
    const bf16_t* Y = (const bf16_t*)(F.ws + WS_Y);
    bf16_t* HB = (bf16_t*)(F.ws + WS_HB);
    float* rstdp = (float*)(F.ws + (KIND == 0 ? WS_RSTD1 : WS_RSTD2));
    LAS float* lg = (LAS float*)(F.lds) + F.wave * (16 * 33);
    LAS int* r2cnt = (LAS int*)(F.lds + LDSCTL_OFF + LC_R2CNT); LAS int* r2base = (LAS int*)(F.lds + LDSCTL_OFF + LC_R2BASE);
    for (int task = F.bid; task < T / 128; task += F.G) {
        const int tok = task * 128 + F.wave * 16 + r16;
        const float* xr = hin + (size_t)tok * D + 8 * q4; float* ho = hout + (size_t)tok * D + 8 * q4;
        const unsigned char* yr = (const unsigned char*)Y + (size_t)tok * 4 * D + 8 * q4; bf16_t* hbr = HB + (size_t)tok * D + 8 * q4;
        f32x4 acc0 = {0.f, 0.f, 0.f, 0.f}, acc1 = {0.f, 0.f, 0.f, 0.f}; float ssq = 0.f;
        if (KIND == 1) { if (F.tid < 32) r2cnt[F.tid] = 0; }
        f32x4 nx0 = *(const f32x4*)(xr), nx1 = *(const f32x4*)(xr + 4); u32x2 ny[4];
        u32x4 nwh0 = Wf[(0 * 2 + 0) * 64 + lane], nwl0 = Wf[(0 * 2 + 1) * 64 + lane], nwh1 = nwh0, nwl1 = nwl0;
        if (KIND == 1) { nwh1 = Wf[(1 * 2 + 0) * 64 + lane]; nwl1 = Wf[(1 * 2 + 1) * 64 + lane]; }
        if (COMBINE) {
#pragma unroll
            for (int k = 0; k < 4; ++k) ny[k] = *(const u32x2*)(yr + (size_t)k * D);
        }
#pragma unroll 2
        for (int ks = 0; ks < 32; ++ks) {
            f32x4 x0 = nx0, x1 = nx1; u32x2 yv[4];
            const u32x4 cwh0 = nwh0, cwl0 = nwl0, cwh1 = nwh1, cwl1 = nwl1;
#pragma unroll
            for (int k = 0; k < 4; ++k) yv[k] = COMBINE ? ny[k] : (u32x2){0u, 0u};
            if (ks + 1 < 32) {
                nx0 = *(const f32x4*)(xr + 32 * (ks + 1)); nx1 = *(const f32x4*)(xr + 32 * (ks + 1) + 4);
                nwh0 = Wf[(((ks + 1) * 2 + 0) * 2 + 0) * 64 + lane]; nwl0 = Wf[(((ks + 1) * 2 + 0) * 2 + 1) * 64 + lane];
                if (KIND == 1) { nwh1 = Wf[(((ks + 1) * 2 + 1) * 2 + 0) * 64 + lane]; nwl1 = Wf[(((ks + 1) * 2 + 1) * 2 + 1) * 64 + lane]; }
                if (COMBINE) {
#pragma unroll
                    for (int k = 0; k < 4; ++k) ny[k] = *(const u32x2*)(yr + (size_t)k * D + 32 * (ks + 1));
                }
            }
            if (COMBINE) {
#pragma unroll
                for (int k = 0; k < 4; ++k) { x0 += un4_fp8(yv[k].x) * (1.0f / Y_SCALE); x1 += un4_fp8(yv[k].y) * (1.0f / Y_SCALE); }
            }
            if (WRITE_H) { *(f32x4*)(ho + 32 * ks) = x0; *(f32x4*)(ho + 32 * ks + 4) = x1; }
            ssq += (x0[0] * x0[0] + x0[1] * x0[1]) + (x0[2] * x0[2] + x0[3] * x0[3]) + (x1[0] * x1[0] + x1[1] * x1[1]) + (x1[2] * x1[2] + x1[3] * x1[3]);
            u32x4 hw; hw.x = cvtpk(x0[0], x0[1]); hw.y = cvtpk(x0[2], x0[3]); hw.z = cvtpk(x1[0], x1[1]); hw.w = cvtpk(x1[2], x1[3]);
            u32x4 lw; lw.x = cvtpk(x0[0] - bflo(hw.x), x0[1] - bfhi(hw.x)); lw.y = cvtpk(x0[2] - bflo(hw.y), x0[3] - bfhi(hw.y)); lw.z = cvtpk(x1[0] - bflo(hw.z), x1[1] - bfhi(hw.z)); lw.w = cvtpk(x1[2] - bflo(hw.w), x1[3] - bfhi(hw.w));
            if (KIND == 0) *(u32x4*)(hbr + 32 * ks) = hw;
            else *(u32x2*)((unsigned char*)(F.ws + WS_HB8) + (size_t)tok * D + 8 * q4 + 32 * ks) = (u32x2){pk4_fp8_sat(x0[0], x0[1], x0[2], x0[3]), pk4_fp8_sat(x1[0], x1[1], x1[2], x1[3])};
            const bf16x8 xh = __builtin_bit_cast(bf16x8, hw), xl = __builtin_bit_cast(bf16x8, lw);
            const bf16x8 wh0 = __builtin_bit_cast(bf16x8, cwh0), wl0 = __builtin_bit_cast(bf16x8, cwl0);
            acc0 = __builtin_amdgcn_mfma_f32_16x16x32_bf16(wh0, xh, acc0, 0, 0, 0);
            acc0 = __builtin_amdgcn_mfma_f32_16x16x32_bf16(wl0, xh, acc0, 0, 0, 0);
            acc0 = __builtin_amdgcn_mfma_f32_16x16x32_bf16(wh0, xl, acc0, 0, 0, 0);
            if (KIND == 1) {
                const bf16x8 wh1 = __builtin_bit_cast(bf16x8, cwh1), wl1 = __builtin_bit_cast(bf16x8, cwl1);
                acc1 = __builtin_amdgcn_mfma_f32_16x16x32_bf16(wh1, xh, acc1, 0, 0, 0);
                acc1 = __builtin_amdgcn_mfma_f32_16x16x32_bf16(wl1, xh, acc1, 0, 0, 0);
                acc1 = __builtin_amdgcn_mfma_f32_16x16x32_bf16(wh1, xl, acc1, 0, 0, 0);
            }
        }
        ssq += __shfl_xor(ssq, 16); ssq += __shfl_xor(ssq, 32);
        const float rstd = 1.0f / sqrtf(ssq * (1.0f / D) + RMS_EPS);
        if (q4 == 0) rstdp[tok] = rstd;
        if (KIND == 0) {
            if (q4 < 2) { const f32x4 bf = *(const f32x4*)(inp(F, I_b_fox_f) + l * 8 + 4 * q4); f32x4 lf;
#pragma unroll
                for (int i = 0; i < 4; ++i) { const float z = rstd * acc0[i] + bf[i]; lf[i] = fminf(z, 0.f) - log1pf(expf(-fabsf(z))); }
                *(f32x4*)((float*)(F.ws + WS_LOGF) + (size_t)tok * 8 + 4 * q4) = lf; }
        } else if (!DRY) {
            const f32x4 b0 = *(const f32x4*)(inp(F, I_b_router) + l * NE + 4 * q4), b1v = *(const f32x4*)(inp(F, I_b_router) + l * NE + 16 + 4 * q4);
#pragma unroll
            for (int i = 0; i < 4; ++i) { lg[r16 * 33 + 4 * q4 + i] = rstd * acc0[i] + b0[i]; lg[r16 * 33 + 16 + 4 * q4 + i] = rstd * acc1[i] + b1v[i]; }
            LDS_WAIT(); asm volatile("" ::: "memory");
            float v0 = -INFINITY, v1 = -INFINITY, v2 = -INFINITY, v3 = -INFINITY; int i0 = 0, i1 = 0, i2 = 0, i3 = 0;
            if (lane < 16) {
                for (int e = 0; e < NE; ++e) { const float x = lg[lane * 33 + e];
                    if (x > v3) { if (x > v0) { v3 = v2; i3 = i2; v2 = v1; i2 = i1; v1 = v0; i1 = i0; v0 = x; i0 = e; }
                        else if (x > v1) { v3 = v2; i3 = i2; v2 = v1; i2 = i1; v1 = x; i1 = e; }
                        else if (x > v2) { v3 = v2; i3 = i2; v2 = x; i2 = e; }
                        else { v3 = x; i3 = e; } } }
            }
            __syncthreads();
            int rk0 = 0, rk1 = 0, rk2 = 0, rk3 = 0;
            if (lane < 16) { rk0 = __hip_atomic_fetch_add(&r2cnt[i0], 1, __ATOMIC_RELAXED, __HIP_MEMORY_SCOPE_WORKGROUP); rk1 = __hip_atomic_fetch_add(&r2cnt[i1], 1, __ATOMIC_RELAXED, __HIP_MEMORY_SCOPE_WORKGROUP); rk2 = __hip_atomic_fetch_add(&r2cnt[i2], 1, __ATOMIC_RELAXED, __HIP_MEMORY_SCOPE_WORKGROUP); rk3 = __hip_atomic_fetch_add(&r2cnt[i3], 1, __ATOMIC_RELAXED, __HIP_MEMORY_SCOPE_WORKGROUP); }
            __syncthreads();
            if (F.tid < 32) r2base[F.tid] = (int)atomicAdd(F.ctl + CW_CUR + (l * NE + F.tid) * 16, (unsigned)r2cnt[F.tid]);
            __syncthreads();
            if (lane < 16) {
                const float e1 = expf(v1 - v0), e2 = expf(v2 - v0), e3 = expf(v3 - v0), inv = 1.0f / (1.0f + e1 + e2 + e3);
                u32x2* list = (u32x2*)(F.ws + WS_LIST); float* gate = (float*)(F.ws + WS_GLIST);
                const int tk = (task * 128 + F.wave * 16 + lane) * 4; const unsigned rb = __float_as_uint(__shfl(rstd, lane & 15));
                { const size_t p0_ = (size_t)i0 * LISTCAP + r2base[i0] + rk0, p1_ = (size_t)i1 * LISTCAP + r2base[i1] + rk1, p2_ = (size_t)i2 * LISTCAP + r2base[i2] + rk2, p3_ = (size_t)i3 * LISTCAP + r2base[i3] + rk3;
                  list[p0_] = (u32x2){(unsigned)(tk + 0), rb}; gate[p0_] = inv;
                  list[p1_] = (u32x2){(unsigned)(tk + 1), rb}; gate[p1_] = e1 * inv;
                  list[p2_] = (u32x2){(unsigned)(tk + 2), rb}; gate[p2_] = e2 * inv;
                  list[p3_] = (u32x2){(unsigned)(tk + 3), rb}; gate[p3_] = e3 * inv; }
            }
            __syncthreads();
        }
    }
}
__device__ __forceinline__ void r_final(const Frame& F) {
    const int lane = F.lane, tr = lane >> 5, c = lane & 31;
    const bf16_t* Y = (const bf16_t*)(F.ws + WS_Y);
    const float* gf = inp(F, I_norm_final);
    for (int task = F.bid; task < T / 128; task += F.G) {
#pragma unroll 1
        for (int pr = 0; pr < 8; ++pr) {
            const int tok = task * 128 + F.wave * 16 + pr * 2 + tr;
            float* xr = F.out + (size_t)tok * D + 8 * c; const unsigned char* yr = (const unsigned char*)Y + (size_t)tok * 4 * D + 8 * c;
            f32x4 x0[4], x1[4]; float ssq = 0.f;
#pragma unroll
            for (int i = 0; i < 4; ++i) { x0[i] = *(const f32x4*)(xr + 256 * i); x1[i] = *(const f32x4*)(xr + 256 * i + 4); }
#pragma unroll
            for (int i = 0; i < 4; ++i) {
#pragma unroll
                for (int k = 0; k < 4; ++k) { const u32x2 y = *(const u32x2*)(yr + (size_t)k * D + 256 * i);
                    x0[i] += un4_fp8(y.x) * (1.0f / Y_SCALE); x1[i] += un4_fp8(y.y) * (1.0f / Y_SCALE); }
                ssq += (x0[i][0] * x0[i][0] + x0[i][1] * x0[i][1]) + (x0[i][2] * x0[i][2] + x0[i][3] * x0[i][3]) + (x1[i][0] * x1[i][0] + x1[i][1] * x1[i][1]) + (x1[i][2] * x1[i][2] + x1[i][3] * x1[i][3]); }
            ssq += __shfl_xor(ssq, 1); ssq += __shfl_xor(ssq, 2); ssq += __shfl_xor(ssq, 4); ssq += __shfl_xor(ssq, 8); ssq += __shfl_xor(ssq, 16);
            const float rstd = 1.0f / sqrtf(ssq * (1.0f / D) + RMS_EPS);
#pragma unroll
            for (int i = 0; i < 4; ++i) { const f32x4 g0 = *(const f32x4*)(gf + 256 * i + 8 * c), g1 = *(const f32x4*)(gf + 256 * i + 8 * c + 4);
                *(f32x4*)(xr + 256 * i) = x0[i] * rstd * g0; *(f32x4*)(xr + 256 * i + 4) = x1[i] * rstd * g1; }
        }
    }
}
__device__ __forceinline__ void cumsum_step(const Frame& F) {
    LAS float* sc = (LAS float*)(F.lds + LDSCTL_OFF + LC_SCAN);
    const float* LF = (const float*)(F.ws + WS_LOGF); float* c2 = (float*)(F.ws + WS_C2);
    for (int seq = F.bid; seq < 64; seq += F.G) {
        const int b = seq >> 3, h = seq & 7, t0 = F.tid * 8; const float* lf = LF + ((size_t)b * SEQ + t0) * 8 + h;
        float v[8], s = 0.f;
#pragma unroll
        for (int j = 0; j < 8; ++j) { s += lf[j * 8]; v[j] = s; }
        float inc = s;
#pragma unroll
        for (int off = 1; off < 64; off <<= 1) { const float y = __shfl_up(inc, off); if (F.lane >= off) inc += y; }
        if (F.lane == 63) sc[F.wave] = inc;
        __syncthreads();
        float pre = 0.f;
        for (int w = 0; w < F.wave; ++w) pre += sc[w];
        const float base = pre + inc - s;
#pragma unroll
        for (int j = 0; j < 8; ++j) c2[(size_t)seq * SEQ + t0 + j] = (base + v[j]) * LOG2E;
        __syncthreads();
    }
}

__device__ __forceinline__ float max3f(float a, float b, float c) { float r; asm("v_max3_f32 %0, %1, %2, %3" : "=v"(r) : "v"(a), "v"(b), "v"(c)); return r; }
__device__ __forceinline__ float max2f(float a, float b) { float r; asm("v_max_f32_e32 %0, %1, %2" : "=v"(r) : "v"(a), "v"(b)); return r; }
__device__ __forceinline__ int crow(int r, int hi) { return (r & 3) + 8 * (r >> 2) + 4 * hi; }
constexpr int AT_KT = 0, AT_KTB = 8320, AT_VT = 2 * AT_KTB, AT_VTB = 8192, AT_CK = AT_VT + 2 * AT_VTB, AT_WSF = AT_CK + 512, AT_OST = AT_WSF + 2048, AT_END = AT_OST + 65536;
static_assert(AT_END <= PH_BYTES, "attention LDS");
__device__ __forceinline__ void attn_unit(const Frame& F, int l, int b, int h, int qb) {
    const int tid = F.tid, lane = F.lane, r32 = lane & 31, hi = lane >> 5, wid = F.wave;
    const bf16_t* proj = (const bf16_t*)(F.ws + WS_PA); bf16_t* mixed = (bf16_t*)(F.ws + WS_MIXED);
    const int bh = b * 8 + h; const float* c2 = (const float*)(F.ws + WS_C2) + (size_t)bh * SEQ;
    const size_t rowbase = (size_t)b * SEQ; const int q0 = qb * 256;
    LAS unsigned char* L = F.lds;
    LAS float* wsf = (LAS float*)(L + AT_WSF) + wid * 64;
    LAS float* ost = (LAS float*)(L + AT_OST) + wid * 2048;
    LAS unsigned* stopv = (LAS unsigned*)(L + LDSCTL_OFF + LC_STOP);
    const bf16_t* Qw = proj + (rowbase + q0 + wid * 32 + r32) * NPROJ + C_FQ + h * 64;
    bf16x8 qr[4]; float qn = 0.f;
#pragma unroll
    for (int d0 = 0; d0 < 4; ++d0) { const u32x4 w = *(const u32x4*)(Qw + d0 * 16 + hi * 8); qr[d0] = __builtin_bit_cast(bf16x8, w);
        qn += bflo(w.x) * bflo(w.x) + bfhi(w.x) * bfhi(w.x) + bflo(w.y) * bflo(w.y) + bfhi(w.y) * bfhi(w.y) + bflo(w.z) * bflo(w.z) + bfhi(w.z) * bfhi(w.z) + bflo(w.w) * bflo(w.w) + bfhi(w.w) * bfhi(w.w); }
    qn += __shfl_xor(qn, 32); qn = sqrtf(qn) * 1.001f;
    const float kb = sqrtf(2.0f * __uint_as_float(__hip_atomic_load(F.ctl + CW_KMAX + (l * 64 + bh) * 16, __ATOMIC_RELAXED, __HIP_MEMORY_SCOPE_AGENT))) * 1.001f;
    const float c2q = c2[q0 + wid * 32 + r32];
    f32x16 cq16;
#pragma unroll
    for (int r = 0; r < 16; ++r) cq16[r] = c2q;
    float lsum = 0.f; f32x16 o[2];
#pragma unroll
    for (int r = 0; r < 16; ++r) { o[0][r] = 0.f; o[1][r] = 0.f; }
    const int jd = 4 * qb + 3;
    const int lkey = tid >> 3, lpiece = tid & 7;
    const bf16_t* ksrc = proj + (rowbase + lkey) * NPROJ + C_FK + h * 64 + lpiece * 8;
    const bf16_t* vsrc = proj + (rowbase + lkey) * NPROJ + C_FV + h * 64 + lpiece * 8;
    const int kdst = lpiece * 1040 + lkey * 16, vdst = (lpiece >> 2) * 4096 + lkey * 64 + (lpiece & 3) * 16;
    u32x4 kA = *(const u32x4*)(ksrc + (size_t)jd * 64 * NPROJ), vA = *(const u32x4*)(vsrc + (size_t)jd * 64 * NPROJ); float cA = c2[jd * 64 + lane];
    u32x4 kB = kA, vB = vA; float cB = cA;
    if (jd >= 1) { kB = *(const u32x4*)(ksrc + (size_t)(jd - 1) * 64 * NPROJ); vB = *(const u32x4*)(vsrc + (size_t)(jd - 1) * 64 * NPROJ); cB = c2[(jd - 1) * 64 + lane]; }
    const int vrd = (4 * hi + ((lane & 15) >> 2)) * 64 + ((lane >> 4) & 1) * 32 + (lane & 3) * 8;
    const int qrel = wid * 32 + r32;
    int buf = 0; bool done = false, wstop = false, first = true;
    float mhat = 0.f;
#define AT_ITER(j, kR, vR, cR, cNext) do { \
        const float cklast = rdlane(cNext, 63);     \
        *(LAS u32x4*)(L + AT_KT + buf * AT_KTB + kdst) = kR; *(LAS u32x4*)(L + AT_VT + buf * AT_VTB + vdst) = vR; \
        if (tid < 64) ((LAS float*)(L + AT_CK))[buf * 64 + tid] = cR; \
        asm volatile("s_waitcnt lgkmcnt(0)\n\ts_barrier" ::: "memory");     \
        if ((j) < jd) { const u32x4 fa = *(const LAS u32x4*)(stopv + (((j) + 1) & 1) * 8), fb = *(const LAS u32x4*)(stopv + (((j) + 1) & 1) * 8 + 4); \
            if ((fa.x & fa.y & fa.z & fa.w & fb.x & fb.y & fb.z & fb.w) != 0u) { done = true; break; } } \
        if ((j) >= 2) { kR = *(const u32x4*)(ksrc + (size_t)((j) - 2) * 64 * NPROJ); vR = *(const u32x4*)(vsrc + (size_t)((j) - 2) * 64 * NPROJ); cR = c2[((j) - 2) * 64 + lane]; } \
        const int jrel = (j) - 4 * qb; \
        const bool active = !(jrel >= 0 && 64 * jrel > 32 * wid + 31) && !wstop; \
        if (active) { \
            const LAS unsigned char* Kb = L + AT_KT + buf * AT_KTB; const LAS unsigned char* Vb = L + AT_VT + buf * AT_VTB; const LAS float* Ck = (const LAS float*)(L + AT_CK) + buf * 64; \
            const float base = c2q - mhat; \
            f32x16 p0, p1; \
            _Pragma("unroll") for (int g = 0; g < 4; ++g) { const f32x4 ca = *(const LAS f32x4*)(Ck + 8 * g + 4 * hi), cb = *(const LAS f32x4*)(Ck + 32 + 8 * g + 4 * hi); \
                _Pragma("unroll") for (int i = 0; i < 4; ++i) { p0[4 * g + i] = base - ca[i]; p1[4 * g + i] = base - cb[i]; } } \
            bf16x8 kf0[4], kf1[4]; \
            _Pragma("unroll") for (int d0 = 0; d0 < 4; ++d0) { kf0[d0] = *(const LAS bf16x8*)(Kb + (2 * d0 + hi) * 1040 + r32 * 16); kf1[d0] = *(const LAS bf16x8*)(Kb + (2 * d0 + hi) * 1040 + (32 + r32) * 16); } \
            _Pragma("unroll") for (int d0 = 0; d0 < 4; ++d0) { \
                p0 = __builtin_amdgcn_mfma_f32_32x32x16_bf16(kf0[d0], qr[d0], p0, 0, 0, 0); p1 = __builtin_amdgcn_mfma_f32_32x32x16_bf16(kf1[d0], qr[d0], p1, 0, 0, 0); } \
            asm volatile("s_nop 15\n\ts_nop 7" : "+v"(p0), "+v"(p1));     \
            if (jrel >= 0) { const int kbase = 64 * jrel + 4 * hi; \
                _Pragma("unroll") for (int r = 0; r < 16; ++r) { const int kv = kbase + (r & 3) + 8 * (r >> 2); if (kv > qrel) p0[r] = -INFINITY; if (kv + 32 > qrel) p1[r] = -INFINITY; } } \
            float mx = max3f(p0[0], p0[1], p1[0]), mb_ = max3f(p0[2], p0[3], p1[1]); mx = max3f(mx, p1[2], p1[3]); \
            _Pragma("unroll") for (int r = 4; r < 16; r += 4) { mx = max3f(mx, p0[r], p0[r + 1]); mb_ = max3f(mb_, p0[r + 2], p0[r + 3]); mx = max3f(mx, p1[r], p1[r + 1]); mb_ = max3f(mb_, p1[r + 2], p1[r + 3]); } \
            mx = max2f(mx, mb_); \
            { auto rr = __builtin_amdgcn_permlane32_swap(__float_as_uint(mx), __float_as_uint(mx), false, false); mx = max2f(__uint_as_float(rr[0]), __uint_as_float(rr[1])); } \
            if (first || __any(mx > 8.0f)) { \
                const float dl = first ? mx : fmaxf(mx, 0.f); mhat += dl; \
                _Pragma("unroll") for (int r = 0; r < 16; ++r) { p0[r] -= dl; p1[r] -= dl; } \
                const float alpha = __builtin_amdgcn_exp2f(-dl); lsum *= alpha; \
                if (!first) { \
                    if (hi == 0) wsf[r32] = alpha; \
                    LDS_WAIT(); asm volatile("" ::: "memory"); \
                    _Pragma("unroll") for (int r = 0; r < 16; ++r) { const float a = wsf[crow(r, hi)]; o[0][r] *= a; o[1][r] *= a; } } \
                first = false; \
            } \
            _Pragma("unroll") for (int r = 0; r < 16; ++r) { p0[r] = __builtin_amdgcn_exp2f(p0[r]); p1[r] = __builtin_amdgcn_exp2f(p1[r]); } \
            { f32x2 sa = {p0[0] + p1[0], p0[1] + p1[1]}; \
              _Pragma("unroll") for (int r = 2; r < 16; r += 2) { sa += (f32x2){p0[r], p0[r + 1]}; sa += (f32x2){p1[r], p1[r + 1]}; } \
              lsum += sa[0] + sa[1]; } \
            u32x4 pw[4]; \
            pw[0] = (u32x4){cvtpk(p0[0], p0[1]), cvtpk(p0[2], p0[3]), cvtpk(p0[4], p0[5]), cvtpk(p0[6], p0[7])}; \
            pw[1] = (u32x4){cvtpk(p0[8], p0[9]), cvtpk(p0[10], p0[11]), cvtpk(p0[12], p0[13]), cvtpk(p0[14], p0[15])}; \
            pw[2] = (u32x4){cvtpk(p1[0], p1[1]), cvtpk(p1[2], p1[3]), cvtpk(p1[4], p1[5]), cvtpk(p1[6], p1[7])}; \
            pw[3] = (u32x4){cvtpk(p1[8], p1[9]), cvtpk(p1[10], p1[11]), cvtpk(p1[12], p1[13]), cvtpk(p1[14], p1[15])}; \
            _Pragma("unroll") for (int s = 0; s < 4; ++s) \
                _Pragma("unroll") for (int d0 = 0; d0 < 2; ++d0) { \
                    const LAS unsigned char* vp = Vb + d0 * 4096 + s * 1024 + vrd; \
                    const v4i16_t lo = __builtin_amdgcn_ds_read_tr16_b64_v4i16((LAS v4i16_t*)vp), hv = __builtin_amdgcn_ds_read_tr16_b64_v4i16((LAS v4i16_t*)(vp + 512)); \
                    const bf16x8 vf = (bf16x8){lo[0], lo[1], lo[2], lo[3], hv[0], hv[1], hv[2], hv[3]}; \
                    o[d0] = __builtin_amdgcn_mfma_f32_32x32x16_bf16(__builtin_bit_cast(bf16x8, pw[s]), vf, o[d0], 0, 0, 0); } \
        } \
        if ((j) > 0) { if (active) { const float ub = qn * kb + (c2q - cklast); if (__all((ub - mhat) < -152.0f)) wstop = true; } if (lane == 0) stopv[((j) & 1) * 8 + wid] = wstop ? 1u : 0u; } \
        buf ^= 1; \
    } while (0)
    for (int j = jd; j >= 0; j -= 2) {
        AT_ITER(j, kA, vA, cA, cB);
        if (done || j == 0) break;
        AT_ITER(j - 1, kB, vB, cB, cA);
        if (done) break;
    }
#undef AT_ITER
    lsum += __shfl_xor(lsum, 32);
    if (hi == 0) wsf[32 + r32] = 1.0f / lsum;
    LDS_WAIT(); asm volatile("" ::: "memory");
#pragma unroll
    for (int r = 0; r < 16; ++r) { const int q = crow(r, hi); const float inv = wsf[32 + q]; ost[q * 64 + r32] = o[0][r] * inv; ost[q * 64 + 32 + r32] = o[1][r] * inv; }
    LDS_WAIT(); asm volatile("" ::: "memory");
    { const int row = lane >> 1, half = lane & 1; const LAS float* src = ost + row * 64 + half * 32; float v[32]; float ss = 0.f;
#pragma unroll
        for (int i = 0; i < 8; ++i) { const f32x4 t4 = *(const LAS f32x4*)(src + 4 * i); v[4 * i] = t4[0]; v[4 * i + 1] = t4[1]; v[4 * i + 2] = t4[2]; v[4 * i + 3] = t4[3]; ss += (t4[0] * t4[0] + t4[1] * t4[1]) + (t4[2] * t4[2] + t4[3] * t4[3]); }
        ss += __shfl_xor(ss, 1);
        const float rs = 1.0f / sqrtf(ss * (1.0f / 64.0f) + RMS_EPS);
        const float* gn = inp(F, I_fox_gain) + l * 512 + h * 64 + half * 32;
        bf16_t* dst = mixed + (rowbase + q0 + wid * 32 + row) * D + h * 64 + half * 32;
#pragma unroll
        for (int i = 0; i < 4; ++i) { const f32x4 ga = *(const f32x4*)(gn + 8 * i), gb = *(const f32x4*)(gn + 8 * i + 4); u32x4 w;
            w.x = cvtpk(v[8 * i] * rs * ga[0], v[8 * i + 1] * rs * ga[1]); w.y = cvtpk(v[8 * i + 2] * rs * ga[2], v[8 * i + 3] * rs * ga[3]);
            w.z = cvtpk(v[8 * i + 4] * rs * gb[0], v[8 * i + 5] * rs * gb[1]); w.w = cvtpk(v[8 * i + 6] * rs * gb[2], v[8 * i + 7] * rs * gb[3]);
            *(u32x4*)(dst + 8 * i) = w; } }
    __syncthreads();
}

__device__ __forceinline__ float hg_lb(const Frame& F, int l, int col) {
    float x[NL], mx = -INFINITY;
#pragma unroll
    for (int i = 0; i < NL; ++i) { x[i] = inp(F, I_hgrn_lb)[i * 256 + col]; mx = fmaxf(mx, x[i]); }
    float s = 0.f, a = 0.f;
#pragma unroll
    for (int i = 0; i < NL; ++i) { x[i] = expf(x[i] - mx); s += x[i]; }
#pragma unroll
    for (int i = 1; i < NL; ++i) if (i <= l) a += x[i];
    return a / s;
}
constexpr int HG_SEG = 128, HG_NSEG = SEQ / HG_SEG, HG_NPART = 1, HG_WAVES = 4;
static_assert(HG_NSEG == 32, "the FIX phase's balanced deal assumes 32 segments");
constexpr int HGL_ROW = 136, HGL_QT = 0, HGL_KT = 32 * HGL_ROW, HGL_KP = 2 * 32 * HGL_ROW, HGL_V = HGL_KP + 4096, HGL_PE = HGL_V + 4096, HGL_BYTES = HGL_PE + 256;
static_assert(NWAVES * HGL_BYTES <= PH_BYTES, "HGRN2 LDS");
#ifndef PROBE_HG
#define PROBE_HG 0
#endif
__device__ __forceinline__ unsigned long long hg_mfma_unit(const Frame& F, int l, int u) {
    unsigned long long hacc = 0ull;
    const int seg = u % HG_NSEG, bh = u / HG_NSEG, b = bh >> 2, hd = bh & 3, lane = F.lane, r32 = lane & 31, hi = lane >> 5;
    LAS unsigned char* W = F.lds + F.wave * HGL_BYTES;
    const size_t tokS = (size_t)b * SEQ + seg * HG_SEG;
    const bf16_t* proj = (const bf16_t*)(F.ws + WS_PA);
    float* oraw = (float*)(F.ws + WS_ORAW); bf16_t* QE = (bf16_t*)(F.ws + WS_QE);
    const float lbv = hg_lb(F, l, hd * 64 + lane);
    f32x16 Sacc[2][2];
#pragma unroll
    for (int kb = 0; kb < 2; ++kb)
#pragma unroll
        for (int vb = 0; vb < 2; ++vb)
#pragma unroll
            for (int r = 0; r < 16; ++r) Sacc[kb][vb][r] = 0.f;
    float Pseg = 1.0f;
    const int vrd = (4 * hi + ((lane & 15) >> 2)) * 64 + ((lane >> 4) & 1) * 32 + (lane & 3) * 8;
    int tb = 0;
    while (tb < HG_SEG) {
        const unsigned long long th0 = PROBE_HG ? __builtin_amdgcn_s_memrealtime() : 0ull;
        const int nmax = (HG_SEG - tb) < 32 ? (HG_SEG - tb) : 32;
        const char* pu8 = (const char*)(proj + (tokS + tb) * NPROJ + hd * 64);
        const unsigned lo2 = (unsigned)lane * 2u;
        char* qe8 = (char*)(QE + (tokS + tb) * 256 + hd * 64);
        char* or8 = (char*)(oraw + (tokS + tb) * 256 + hd * 64);
        const unsigned lof = (unsigned)(4 * hi * 256 + r32) * 4u;
        char* dmy8 = (char*)(F.ws + WS_PSEG + 768 * 1024);
        float fv[32], qv[32]; u32x4 vreg[4], fr4[4], qr4[4];
#pragma unroll
        for (int it = 0; it < 4; ++it) { const int c = lane + 64 * it, sr = c >> 3, pc = c & 7; const char* rp = pu8 + (size_t)sr * (NPROJ * 2) + pc * 16;
            fr4[it] = *(const u32x4*)(rp + C_GF * 2); qr4[it] = *(const u32x4*)(rp + C_GQ * 2); vreg[it] = *(const u32x4*)(rp + C_GI * 2); }
        __builtin_amdgcn_sched_barrier(0);
#pragma unroll
        for (int it = 0; it < 4; ++it) { const int c = lane + 64 * it, sr = c >> 3, pc = c & 7;
            *(LAS u32x2*)(W + HGL_QT + sr * HGL_ROW + pc * 16) = (u32x2){fr4[it].x, fr4[it].y}; *(LAS u32x2*)(W + HGL_QT + sr * HGL_ROW + pc * 16 + 8) = (u32x2){fr4[it].z, fr4[it].w};
            *(LAS u32x2*)(W + HGL_KT + sr * HGL_ROW + pc * 16) = (u32x2){qr4[it].x, qr4[it].y}; *(LAS u32x2*)(W + HGL_KT + sr * HGL_ROW + pc * 16 + 8) = (u32x2){qr4[it].z, qr4[it].w}; }
        LDS_WAIT(); asm volatile("" ::: "memory");
#pragma unroll
        for (int t = 0; t < 32; ++t) { fv[t] = bf2f(*(const LAS bf16_t*)(W + HGL_QT + t * HGL_ROW + lane * 2)); qv[t] = bf2f(*(const LAS bf16_t*)(W + HGL_KT + t * HGL_ROW + lane * 2)); }
        LDS_WAIT(); asm volatile("" ::: "memory");
        int nl = 32; { float P = 1.0f;
#pragma unroll
            for (int t = 0; t < 32; ++t) { const float sg = __builtin_amdgcn_rcpf(1.0f + __builtin_amdgcn_exp2f(-LOG2E * fv[t])); float f = fmaxf(lbv + (1.0f - lbv) * sg, 1e-30f); if (t >= nmax) f = 1.0f; fv[t] = f; P *= f; if (P < 1e-32f && nl == 32) nl = t; } }
#pragma unroll
        for (int off = 1; off < 64; off <<= 1) { const int o = __shfl_xor(nl, off); nl = o < nl ? o : nl; }
        const int n = __builtin_amdgcn_readfirstlane(nl < nmax ? nl : nmax);
        if (PROBE_HG == 1) hacc += __builtin_amdgcn_s_memrealtime() - th0;
#pragma unroll
        for (int it = 0; it < 4; ++it) { const int c = lane + 64 * it, sr = c >> 3, pc = c & 7;
            *(LAS u32x4*)(W + HGL_V + (pc >> 2) * 2048 + sr * 64 + (pc & 3) * 16) = (sr < n) ? vreg[it] : (u32x4){0u, 0u, 0u, 0u}; }
        float P = 1.0f;
        {
#pragma unroll
          for (int t = 0; t < 32; ++t) { const bool ok = t < n; const float f = fv[t]; if (ok) P *= f;
            const float qt = ok ? qv[t] * P : 0.f, kt = ok ? (1.0f - f) * __builtin_amdgcn_rcpf(P) : 0.f;
            *(LAS bf16_t*)(W + HGL_QT + t * HGL_ROW + lane * 2) = f2bf(qt); *(LAS bf16_t*)(W + HGL_KT + t * HGL_ROW + lane * 2) = f2bf(kt);
            *(bf16_t*)((t < nmax ? qe8 + (size_t)t * 512 : dmy8) + lo2) = f2bf(qv[t] * (Pseg * P)); } }
        { float suf = 1.0f;
#pragma unroll
          for (int t = 31; t >= 0; --t) { const bool ok = t < n; const float f = fv[t]; const float kp = ok ? (1.0f - f) * suf : 0.f; if (ok) suf *= f;
            *(LAS bf16_t*)(W + HGL_KP + (lane >> 5) * 2048 + t * 64 + (lane & 31) * 2) = f2bf(kp); } }
        ((LAS float*)(W + HGL_PE))[lane] = P;
        Pseg *= P;
        LDS_WAIT(); asm volatile("" ::: "memory");
        if (PROBE_HG == 2) hacc += __builtin_amdgcn_s_memrealtime() - th0;
        f32x16 st;
#pragma unroll
        for (int r = 0; r < 16; ++r) st[r] = 0.f;
#pragma unroll
        for (int d0 = 0; d0 < 4; ++d0) { const bf16x8 ka = *(const LAS bf16x8*)(W + HGL_KT + r32 * HGL_ROW + (16 * d0 + 8 * hi) * 2), qb = *(const LAS bf16x8*)(W + HGL_QT + r32 * HGL_ROW + (16 * d0 + 8 * hi) * 2);
            st = __builtin_amdgcn_mfma_f32_32x32x16_bf16(ka, qb, st, 0, 0, 0); }
#pragma unroll
        for (int r = 0; r < 16; ++r) if (crow(r, hi) > r32) st[r] = 0.f;
        u32x4 pst[2];
        pst[0] = (u32x4){cvtpk(st[0], st[1]), cvtpk(st[2], st[3]), cvtpk(st[4], st[5]), cvtpk(st[6], st[7])};
        pst[1] = (u32x4){cvtpk(st[8], st[9]), cvtpk(st[10], st[11]), cvtpk(st[12], st[13]), cvtpk(st[14], st[15])};
        bf16x8 vf[2][2];
#pragma unroll
        for (int s2 = 0; s2 < 2; ++s2)
#pragma unroll
            for (int vb = 0; vb < 2; ++vb) { const LAS unsigned char* vp = W + HGL_V + vb * 2048 + s2 * 1024 + vrd;
                const v4i16_t lo = __builtin_amdgcn_ds_read_tr16_b64_v4i16((LAS v4i16_t*)vp), hv = __builtin_amdgcn_ds_read_tr16_b64_v4i16((LAS v4i16_t*)(vp + 512));
                vf[s2][vb] = (bf16x8){lo[0], lo[1], lo[2], lo[3], hv[0], hv[1], hv[2], hv[3]}; }
        f32x16 oacc[2];
#pragma unroll
        for (int vb = 0; vb < 2; ++vb) {
#pragma unroll
            for (int r = 0; r < 16; ++r) oacc[vb][r] = 0.f;
#pragma unroll
            for (int s2 = 0; s2 < 2; ++s2) oacc[vb] = __builtin_amdgcn_mfma_f32_32x32x16_bf16(__builtin_bit_cast(bf16x8, pst[s2]), vf[s2][vb], oacc[vb], 0, 0, 0);
        }
#pragma unroll
        for (int kst = 0; kst < 4; ++kst) {
            const u32x2 qa = *(const LAS u32x2*)(W + HGL_QT + r32 * HGL_ROW + (16 * kst + 4 * hi) * 2), qc = *(const LAS u32x2*)(W + HGL_QT + r32 * HGL_ROW + (16 * kst + 8 + 4 * hi) * 2);
            const bf16x8 qf = __builtin_bit_cast(bf16x8, (u32x4){qa.x, qa.y, qc.x, qc.y});
#pragma unroll
            for (int vb = 0; vb < 2; ++vb) { const f32x16& S = Sacc[kst >> 1][vb]; const int o8 = 8 * (kst & 1);
                const u32x4 sp = (u32x4){cvtpk(S[o8 + 0], S[o8 + 1]), cvtpk(S[o8 + 2], S[o8 + 3]), cvtpk(S[o8 + 4], S[o8 + 5]), cvtpk(S[o8 + 6], S[o8 + 7])};
                oacc[vb] = __builtin_amdgcn_mfma_f32_32x32x16_bf16(qf, __builtin_bit_cast(bf16x8, sp), oacc[vb], 0, 0, 0); }
        }
#pragma unroll
        for (int vb = 0; vb < 2; ++vb)
#pragma unroll
            for (int r = 0; r < 16; ++r) { const int t = crow(r, hi); *(float*)((t < nmax ? or8 + (size_t)(((r & 3) + 8 * (r >> 2)) * 1024 + vb * 128) + lof : dmy8 + 4 * lane)) = oacc[vb][r]; }
#pragma unroll
        for (int kb = 0; kb < 2; ++kb) {
            float pe[16];
#pragma unroll
            for (int g = 0; g < 4; ++g) { const f32x4 p4 = *(const LAS f32x4*)(W + HGL_PE + (32 * kb + 8 * g + 4 * hi) * 4); pe[4 * g] = p4[0]; pe[4 * g + 1] = p4[1]; pe[4 * g + 2] = p4[2]; pe[4 * g + 3] = p4[3]; }
            bf16x8 kf[2];
#pragma unroll
            for (int s2 = 0; s2 < 2; ++s2) { const LAS unsigned char* kp = W + HGL_KP + kb * 2048 + s2 * 1024 + vrd;
                const v4i16_t lo = __builtin_amdgcn_ds_read_tr16_b64_v4i16((LAS v4i16_t*)kp), hv = __builtin_amdgcn_ds_read_tr16_b64_v4i16((LAS v4i16_t*)(kp + 512));
                kf[s2] = (bf16x8){lo[0], lo[1], lo[2], lo[3], hv[0], hv[1], hv[2], hv[3]}; }
#pragma unroll
            for (int vb = 0; vb < 2; ++vb) {
#pragma unroll
                for (int r = 0; r < 16; ++r) Sacc[kb][vb][r] *= pe[r];
#pragma unroll
                for (int s2 = 0; s2 < 2; ++s2) Sacc[kb][vb] = __builtin_amdgcn_mfma_f32_32x32x16_bf16(kf[s2], vf[s2][vb], Sacc[kb][vb], 0, 0, 0);
            }
        }
        LDS_WAIT(); asm volatile("" ::: "memory");
        tb += n;
    }
    char* send8 = (char*)((float*)(F.ws + WS_SEND2) + (size_t)(bh * HG_NSEG + seg) * 4096);
    const unsigned lsf = (unsigned)(4 * hi * 64 + r32) * 4u;
#pragma unroll
    for (int kb = 0; kb < 2; ++kb)
#pragma unroll
        for (int vb = 0; vb < 2; ++vb)
#pragma unroll
            for (int r = 0; r < 16; ++r) *(float*)(send8 + (size_t)((32 * kb + (r & 3) + 8 * (r >> 2)) * 256 + vb * 128) + lsf) = Sacc[kb][vb][r];
    ((float*)(F.ws + WS_PSEG))[(bh * HG_NSEG + seg) * 64 + lane] = Pseg;
    return hacc;
}
__device__ __forceinline__ void hg_fix_phase(const Frame& F, int l) {
    const int lane = F.lane, r16 = lane & 15, q4 = lane >> 4, tid = F.tid;
    LAS bf16_t* ST = (LAS bf16_t*)(F.lds);
    const float* oraw = (const float*)(F.ws + WS_ORAW); const bf16_t* proj = (const bf16_t*)(F.ws + WS_PA); bf16_t* mixed = (bf16_t*)(F.ws + WS_MIXED);
    const bf16_t* QE = (const bf16_t*)(F.ws + WS_QE); const float* SEND = (const float*)(F.ws + WS_SEND2); const float* PSEG = (const float*)(F.ws + WS_PSEG);
    for (int uu = F.bid; uu < 32 * (HG_NSEG / 4) * DUP(7); uu += F.G) {
        const int u = uu % (32 * (HG_NSEG / 4)), grp = u & 7, bh = u >> 3, b = bh >> 2, hd = bh & 3;
        const int k = tid >> 3, v8 = (tid & 7) * 8; float S[8];
#pragma unroll
        for (int i = 0; i < 8; ++i) S[i] = 0.f;
#pragma unroll 4
        for (int sp = 0; sp < 4 * grp; ++sp) { const float P = PSEG[(bh * HG_NSEG + sp) * 64 + k]; const float* se = SEND + ((size_t)(bh * HG_NSEG + sp) * 64 + k) * 64 + v8;
            const f32x4 a = *(const f32x4*)se, c = *(const f32x4*)(se + 4);
            S[0] = P * S[0] + a[0]; S[1] = P * S[1] + a[1]; S[2] = P * S[2] + a[2]; S[3] = P * S[3] + a[3]; S[4] = P * S[4] + c[0]; S[5] = P * S[5] + c[1]; S[6] = P * S[6] + c[2]; S[7] = P * S[7] + c[3]; }
#pragma unroll 1
        for (int sq = 0; sq < 4; ++sq) {
            const int seg = 4 * grp + sq;
            const float Pn = PSEG[(bh * HG_NSEG + seg) * 64 + k]; const float* sen = SEND + ((size_t)(bh * HG_NSEG + seg) * 64 + k) * 64 + v8;
            const f32x4 an = *(const f32x4*)sen, cn4 = *(const f32x4*)(sen + 4);
            u32x4 qev[2];
#pragma unroll
            for (int kst = 0; kst < 2; ++kst) qev[kst] = *(const u32x4*)(QE + ((size_t)b * SEQ + seg * HG_SEG + F.wave * 16 + r16) * 256 + hd * 64 + 32 * kst + 8 * q4);
            if (seg > 0) {
#pragma unroll
                for (int i = 0; i < 8; ++i) ST[(v8 + i) * 72 + k] = f2bf(S[i]);
            }
            __syncthreads();
            {
                const size_t tok0 = (size_t)b * SEQ + seg * HG_SEG + F.wave * 16;
                f32x4 acc[4];
#pragma unroll
                for (int vb = 0; vb < 4; ++vb) acc[vb] = (f32x4){0.f, 0.f, 0.f, 0.f};
                if (seg > 0) {
#pragma unroll
                    for (int kst = 0; kst < 2; ++kst) { const bf16x8 af = __builtin_bit_cast(bf16x8, qev[kst]);
#pragma unroll
                        for (int vb = 0; vb < 4; ++vb) { const bf16x8 bfv = *(const LAS bf16x8*)(ST + (vb * 16 + r16) * 72 + 32 * kst + 8 * q4); acc[vb] = __builtin_amdgcn_mfma_f32_16x16x32_bf16(af, bfv, acc[vb], 0, 0, 0); } }
                }
                float ov[4][4], gv[4][4];
#pragma unroll
                for (int vb = 0; vb < 4; ++vb)
#pragma unroll
                    for (int r = 0; r < 4; ++r) { const size_t tok = tok0 + 4 * q4 + r; ov[vb][r] = oraw[tok * 256 + hd * 64 + vb * 16 + r16]; gv[vb][r] = bf2f(proj[tok * NPROJ + C_GG + hd * 64 + vb * 16 + r16]); }
                __builtin_amdgcn_sched_barrier(0);
                float ss[4] = {0.f, 0.f, 0.f, 0.f};
#pragma unroll
                for (int vb = 0; vb < 4; ++vb)
#pragma unroll
                    for (int r = 0; r < 4; ++r) { const float x = acc[vb][r] + ov[vb][r]; acc[vb][r] = x; ss[r] += x * x; }
#pragma unroll
                for (int r = 0; r < 4; ++r) { float t = ss[r]; t += __shfl_xor(t, 1); t += __shfl_xor(t, 2); t += __shfl_xor(t, 4); t += __shfl_xor(t, 8); ss[r] = 1.0f / sqrtf(t * (1.0f / 64.0f) + RMS_EPS); }
#pragma unroll
                for (int vb = 0; vb < 4; ++vb) { const float gn = inp(F, I_hgrn_gain)[l * 256 + hd * 64 + vb * 16 + r16];
#pragma unroll
                    for (int r = 0; r < 4; ++r) { const size_t tok = tok0 + 4 * q4 + r; const float g = gv[vb][r];
                        const float si = g * __builtin_amdgcn_rcpf(1.0f + __builtin_amdgcn_exp2f(-LOG2E * g)); mixed[tok * D + 512 + hd * 64 + vb * 16 + r16] = f2bf(acc[vb][r] * ss[r] * gn * si); } }
            }
            __syncthreads();
            S[0] = Pn * S[0] + an[0]; S[1] = Pn * S[1] + an[1]; S[2] = Pn * S[2] + an[2]; S[3] = Pn * S[3] + an[3]; S[4] = Pn * S[4] + cn4[0]; S[5] = Pn * S[5] + cn4[1]; S[6] = Pn * S[6] + cn4[2]; S[7] = Pn * S[7] + cn4[3];
        }
    }
}
constexpr int PL_ROW = 136, PL_BYTES = 64 * PL_ROW;
static_assert(NWAVES * PL_BYTES <= PH_BYTES, "pool LDS");
template <int W> __device__ __forceinline__ void pool_body(const Frame& F, int l, int b, int g, int seg) {
    const int lane = F.lane, r32 = lane & 31, hi = lane >> 5, t0 = seg * 64;
    LAS unsigned char* PT = F.lds + F.wave * PL_BYTES;
    const char* ub = (const char*)((const bf16_t*)(F.ws + WS_PA) + (size_t)b * SEQ * NPROJ + C_PU + g * 64);
    const unsigned lo2 = (unsigned)lane * 2u;
    float prev[16], cur[16];
#pragma unroll
    for (int i = 0; i < 16; ++i) { const int t = t0 - 16 + i; const float pv = bf2f(*(const bf16_t*)(ub + (size_t)(t < 0 ? 0 : t) * (NPROJ * 2) + lo2)); prev[i] = (t >= 0) ? pv : 0.f; }
    __builtin_amdgcn_sched_barrier(0);
    float wsum = 0.f;
#pragma unroll
    for (int i = 1; i <= W; ++i) wsum += prev[16 - i];
#pragma unroll
    for (int ci = 0; ci < 4; ++ci) {
#pragma unroll
        for (int i = 0; i < 16; ++i) cur[i] = bf2f(*(const bf16_t*)(ub + (size_t)(t0 + 16 * ci + i) * (NPROJ * 2) + lo2));
        __builtin_amdgcn_sched_barrier(0);
#pragma unroll
        for (int i = 0; i < 16; ++i) { const float ut = cur[i]; wsum += ut; wsum -= (i - W >= 0) ? cur[(i - W >= 0) ? i - W : 0] : prev[(i - W >= 0) ? 0 : 16 + i - W];
            const int t = t0 + 16 * ci + i; const float pooled = wsum / (float)((t + 1 < W) ? (t + 1) : W) - ut;
            *(LAS bf16_t*)(PT + (16 * ci + i) * PL_ROW + lane * 2) = f2bf(pooled); }
#pragma unroll
        for (int i = 0; i < 16; ++i) prev[i] = cur[i];
    }
    LDS_WAIT(); asm volatile("" ::: "memory");
    const bf16_t* pwt = (const bf16_t*)(F.ws + WS_PWT) + (size_t)(l * 4 + g) * 4096;
    bf16x8 bw[2][4];
#pragma unroll
    for (int db = 0; db < 2; ++db)
#pragma unroll
        for (int st = 0; st < 4; ++st) bw[db][st] = __builtin_bit_cast(bf16x8, *(const u32x4*)(pwt + (32 * db + r32) * 64 + 16 * st + 8 * hi));
    char* ob = (char*)((bf16_t*)(F.ws + WS_MIXED) + ((size_t)b * SEQ + t0) * D + 768 + g * 64);
    const unsigned lof = (unsigned)(4 * hi * D + r32) * 2u;
#pragma unroll
    for (int tb2 = 0; tb2 < 2; ++tb2)
#pragma unroll
        for (int db = 0; db < 2; ++db) {
            f32x16 acc;
#pragma unroll
            for (int r = 0; r < 16; ++r) acc[r] = 0.f;
#pragma unroll
            for (int st = 0; st < 4; ++st) { const bf16x8 af = *(const LAS bf16x8*)(PT + (32 * tb2 + r32) * PL_ROW + (16 * st + 8 * hi) * 2); acc = __builtin_amdgcn_mfma_f32_32x32x16_bf16(af, bw[db][st], acc, 0, 0, 0); }
            const float psc = inp(F, I_pool_scale)[l * 256 + g * 64 + 32 * db + r32];
#pragma unroll
            for (int r = 0; r < 16; ++r) *(bf16_t*)(ob + (size_t)((32 * tb2 + (r & 3) + 8 * (r >> 2)) * D + 32 * db) * 2 + lof) = f2bf(acc[r] * psc);
        }
    LDS_WAIT(); asm volatile("" ::: "memory");
}
__device__ __forceinline__ void pool_unit(const Frame& F, int l, int u) {
    const int seg = u & 63, g = (u >> 6) & 3, b = u >> 8;
    if (g == 0) pool_body<2>(F, l, b, g, seg); else if (g == 1) pool_body<4>(F, l, b, g, seg); else if (g == 2) pool_body<8>(F, l, b, g, seg); else pool_body<16>(F, l, b, g, seg);
}

struct Args { const float* in[18]; float* out; unsigned char* ws; int ph_lo, ph_hi; };
constexpr int N_PHASES = 2 + 8 * NL;

__global__ void __launch_bounds__(NTHREADS, 2) trunk_fwd(Args args) {
    extern __shared__ __attribute__((aligned(16))) unsigned char lds_raw[];
    Frame F;
    F.lds = (LAS unsigned char*)lds_raw; F.ws = args.ws; F.ctl = (unsigned*)(args.ws + WS_CTL); F.out = args.out;
    F.tid = threadIdx.x; F.lane = F.tid & 63; F.wave = __builtin_amdgcn_readfirstlane(F.tid >> 6);
    for (int u = F.tid; u < (LDS_BYTES - LDSCTL_OFF) / 4; u += NTHREADS) ((LAS unsigned*)(F.lds + LDSCTL_OFF))[u] = 0u;
    __syncthreads();
    if (F.tid == 0) {
#pragma unroll
        for (int i = 0; i < 18; ++i) ((LAS unsigned long long*)(F.lds + LDSCTL_OFF + LC_INP))[i] = (unsigned long long)args.in[i];
    }
    __syncthreads();
    const int lo = args.ph_lo, hi = args.ph_hi; const bool use_bar = (hi - lo) > 1;
    XcdBarrier bar; bar.bar = F.ctl + CW_BAR; bar.x = 0; bar.st = nullptr;
    if (use_bar) bar = xcd_barrier_post(F.ctl + CW_BAR, (volatile LAS unsigned*)(F.lds + LDSCTL_OFF + LC_BAR));
#ifndef PHMASK
#define PHMASK 0xFFFF
#endif
#define PM(b) ((PHMASK >> (b)) & 1)
#define FRESH() do { int l_; asm volatile("v_mbcnt_lo_u32_b32 %0, -1, 0\n\tv_mbcnt_hi_u32_b32 %0, -1, %0" : "=v"(l_));     F.lane = l_; F.tid = F.wave * 64 + l_; int b_ = blockIdx.x, g_ = gridDim.x; asm volatile("" : "+s"(b_), "+s"(g_)); F.bid = b_; F.G = g_; } while (0)
#ifndef PROBEMASK
#define PROBEMASK 0
#endif
    unsigned long long probe_acc = 0ull, probe_t0 = 0ull;
#define PB(b) ((PROBEMASK >> (b)) & 1)
#define PROBE_BEGIN(b) do { if (PB(b)) probe_t0 = __builtin_amdgcn_s_memrealtime(); } while (0)
#define PROBE_END(b) do { if (PB(b)) probe_acc += __builtin_amdgcn_s_memrealtime() - probe_t0; } while (0)
#define IN(k) (lo <= (k) && (k) < hi)
#define PTYPE(k) ((k) == 0 ? 0 : (((k) - 1) & 7) + 1)
#define PBS(k) (PB(10) || PB(11 + PTYPE(k)))
#define SEAM(k) do { if (use_bar && (k) + 1 < hi) { if (PBS(k)) probe_t0 = __builtin_amdgcn_s_memrealtime(); int sl_; asm volatile("v_mbcnt_lo_u32_b32 %0, -1, 0\n\tv_mbcnt_hi_u32_b32 %0, -1, %0" : "=v"(sl_)); xcd_barrier(bar, F.wave == 0 && sl_ == 0); if (PBS(k)) probe_acc += __builtin_amdgcn_s_memrealtime() - probe_t0; } } while (0)
    if (IN(0) && PM(0)) { PROBE_BEGIN(0); for (int rep = 0; rep < DUP(5); ++rep) { FRESH(); p0_prologue(F); } PROBE_END(0); SEAM(0); }
    for (int l = 0; l < NL; ++l) {
        const int pb = 1 + 8 * l;
        if (IN(pb + 0) && PM(1)) { FRESH(); PROBE_BEGIN(1); if (l == 0) r_phase<0, false, false>(F, l, inp(F, I_x), F.out); else { if (DUP(6) > 1) r_phase<0, true, false, true>(F, l, F.out, F.out); r_phase<0, true, true>(F, l, F.out, F.out); } PROBE_END(1); SEAM(pb + 0); }
        if (IN(pb + 1) && PM(2)) { FRESH(); PROBE_BEGIN(2);
            cumsum_step(F);
            pg8::StaticOrder S; S.init(T, NPROJ, D, F.G, F.bid, (const bf16_t*)(F.ws + WS_WIN + l * WIN_BYTES)); S.rep = DUP(2);
            pg8::EpiProj E{(bf16_t*)(F.ws + WS_PA), (const float*)(F.ws + WS_RSTD1), F.ctl + CW_KMAX + l * 64 * 16};
            pg8::gemm_phase<pg8::EpiProj, pg8::StaticOrder, true>(F.tid, F.lds, (const bf16_t*)(F.ws + WS_HB), D, S, E);
            PROBE_END(2); SEAM(pb + 1);
        }
        if (IN(pb + 2) && PM(3)) { FRESH(); PROBE_BEGIN(3);
            const int gw = F.bid * NWAVES + F.wave, NGW = F.G * NWAVES;
            if (PB(21)) probe_t0 = __builtin_amdgcn_s_memrealtime();
            for (int u = gw; u < 2048; u += NGW) pool_unit(F, l, u);
            __syncthreads();
            if (PB(21)) probe_acc += __builtin_amdgcn_s_memrealtime() - probe_t0;
            if (PB(22)) probe_t0 = __builtin_amdgcn_s_memrealtime();
            if (F.wave < HG_WAVES) for (int u = F.wave * F.G + F.bid; u < 32 * HG_NSEG * DUP(0); u += HG_WAVES * F.G) { const unsigned long long ha = hg_mfma_unit(F, l, u % (32 * HG_NSEG)); if (PROBE_HG) probe_acc += ha; }
            __syncthreads();
            if (PB(22)) probe_acc += __builtin_amdgcn_s_memrealtime() - probe_t0;
            { LAS int* aq = (LAS int*)(F.lds + LDSCTL_OFF + LC_AQ);
              for (int rep = 0; rep < DUP(1); ++rep)
              for (;;) {
                if (F.tid == 0) aq[0] = (int)__hip_atomic_fetch_add(F.ctl + CW_AQ + 16 * (l + 4 * rep), 1u, __ATOMIC_RELAXED, __HIP_MEMORY_SCOPE_AGENT);
                __syncthreads();
                const int idx = aq[0];
                __syncthreads();
                if (idx >= 1024) break;
                attn_unit(F, l, (idx >> 3) & 7, idx & 7, 15 - (idx >> 6)); } }
            PROBE_END(3); SEAM(pb + 2);
        }
        if (IN(pb + 3) && PM(4)) { FRESH(); PROBE_BEGIN(4); hg_fix_phase(F, l); PROBE_END(4); SEAM(pb + 3); }
        if (IN(pb + 4) && PM(5)) { FRESH(); PROBE_BEGIN(5);
            pg8::StaticOrder S; S.init(T, D, D, F.G, F.bid, (const bf16_t*)(F.ws + WS_WOUT + l * WOUT_BYTES));
            if (DUP(8) > 1) { pg8::EpiOut E0{l == 0 ? inp(F, I_x) : F.out, (float*)(F.ws + WS_Y)}; pg8::gemm_phase<pg8::EpiOut, pg8::StaticOrder, true>(F.tid, F.lds, (const bf16_t*)(F.ws + WS_MIXED), D, S, E0); }
            pg8::EpiOut E{l == 0 ? inp(F, I_x) : F.out, F.out};
            pg8::gemm_phase<pg8::EpiOut, pg8::StaticOrder, true>(F.tid, F.lds, (const bf16_t*)(F.ws + WS_MIXED), D, S, E);
            PROBE_END(5); SEAM(pb + 4);
        }
        if (IN(pb + 5) && PM(6)) { FRESH(); PROBE_BEGIN(6); if (DUP(6) > 1) r_phase<1, false, false, true>(F, l, F.out, F.out); r_phase<1, false, false>(F, l, F.out, F.out); PROBE_END(6); SEAM(pb + 5); }
        if ((IN(pb + 6) && PM(7)) || (IN(pb + 7) && PM(8))) { FRESH();
            LAS int* tb = (LAS int*)(F.lds + LDSCTL_OFF + LC_TB); LAS int* cn = (LAS int*)(F.lds + LDSCTL_OFF + LC_CN);
            if (F.tid < NE) cn[F.tid] = (int)__hip_atomic_load(F.ctl + CW_CUR + (l * NE + F.tid) * 16, __ATOMIC_RELAXED, __HIP_MEMORY_SCOPE_AGENT);
            __syncthreads();
            if (F.tid == 0) { int a = 0; for (int e = 0; e < NE; ++e) { tb[e] = a; a += (cn[e] + 255) >> 8; } tb[NE] = a; }
            __syncthreads();
            const int ntile = tb[NE];
            if (IN(pb + 6) && PM(7)) { PROBE_BEGIN(7);
                typedef pg8::MoeOrder<true, W1E_BYTES, (size_t)256 * D> Ord1; Ord1 S; S.rep = DUP(3); S.nM = ntile; S.nN = 2 * FF / 256; S.nwg = S.nM * S.nN; S.G = F.G; S.c = F.bid; S.Wt = (const char*)(F.ws + WS_W1 + (size_t)l * NE * W1E_BYTES);
                S.tb = tb; S.cn = cn; S.list = (const u32x2*)(F.ws + WS_LIST);
                pg8::EpiGlu E{(unsigned char*)(F.ws + WS_PA), (const u32x2*)(F.ws + WS_LIST), (const float*)(F.ws + WS_B1R) + (size_t)l * NE * 2048};
                pg8::gemm_phase<pg8::EpiGlu, Ord1, true, true>(F.tid, F.lds, F.ws + WS_HB8, D, S, E);
                PROBE_END(7); SEAM(pb + 6);
            }
            if (IN(pb + 7) && PM(8)) { FRESH(); PROBE_BEGIN(8);
                typedef pg8::MoeOrder<false, W2E_BYTES, (size_t)256 * FF> Ord2; Ord2 S; S.rep = DUP(4); S.nM = ntile; S.nN = D / 256; S.nwg = S.nM * S.nN; S.G = F.G; S.c = F.bid; S.Wt = (const char*)(F.ws + WS_W2 + (size_t)l * NE * W2E_BYTES);
                S.tb = tb; S.cn = cn; S.list = (const u32x2*)(F.ws + WS_LIST);
                pg8::EpiDown E{(unsigned char*)(F.ws + WS_Y), (const u32x2*)(F.ws + WS_LIST), (const float*)(F.ws + WS_GLIST), inp(F, I_b2) + (size_t)l * NE * D};
                { const unsigned long long ea = pg8::gemm_phase<pg8::EpiDown, Ord2, true, true>(F.tid, F.lds, F.ws + WS_PA, FF, S, E); if (PROBE_EPI) probe_acc += ea; }
                PROBE_END(8); SEAM(pb + 7);
            }
        }
    }
    if (IN(N_PHASES - 1) && PM(9)) { FRESH(); PROBE_BEGIN(9); r_final(F); PROBE_END(9); }
#ifndef PROBE_BLOCK
#define PROBE_BLOCK 0
#endif
    if ((PROBEMASK != 0 || PROBE_EPI || PROBE_HG) && blockIdx.x == PROBE_BLOCK) { const unsigned long long tw = __builtin_amdgcn_s_memrealtime(); while (__builtin_amdgcn_s_memrealtime() - tw < probe_acc) __builtin_amdgcn_s_sleep(8); }
#undef IN
#undef SEAM
}

extern "C" void kernel_launch(void* const* d_in, const int* in_sizes, int n_in, void* d_out, int out_size, void* d_ws, size_t ws_size, hipStream_t stream) {
    static int grid = 0;
    if (grid == 0) {
        if (n_in != 18 || out_size != T * D || ws_size < WS_END) { fprintf(stderr, "kernel_launch: unexpected shapes (n_in %d out %d ws %zu need %zu)\n", n_in, out_size, ws_size, (size_t)WS_END); grid = -1; return; }
        int dev = 0, cus = 0;
        if (hipGetDevice(&dev) != hipSuccess || hipDeviceGetAttribute(&cus, hipDeviceAttributeMultiprocessorCount, dev) != hipSuccess) { grid = -1; return; }
        if (hipFuncSetAttribute((const void*)trunk_fwd, hipFuncAttributeMaxDynamicSharedMemorySize, LDS_BYTES) != hipSuccess) { fprintf(stderr, "kernel_launch: hipFuncSetAttribute failed\n"); grid = -1; return; }
        int per_cu = 0;
        if (hipOccupancyMaxActiveBlocksPerMultiprocessor(&per_cu, (const void*)trunk_fwd, NTHREADS, LDS_BYTES) != hipSuccess || per_cu < 1) { fprintf(stderr, "kernel_launch: occupancy query says %d\n", per_cu); (void)hipGetLastError(); }
        grid = cus;
    }
    if (grid < 0) return;
    (void)hipMemsetAsync((char*)d_ws + WS_CTL, 0, CTL_ZERO_BYTES, stream);
    Args a{};
    for (int i = 0; i < 18; ++i) a.in[i] = (const float*)d_in[i];
    a.out = (float*)d_out; a.ws = (unsigned char*)d_ws;
#if MK_SPLIT
    for (int p = 0; p < N_PHASES; ++p) { a.ph_lo = p; a.ph_hi = p + 1; hipLaunchKernelGGL(trunk_fwd, dim3(grid), dim3(NTHREADS), LDS_BYTES, stream, a); }
#else
    a.ph_lo = 0; a.ph_hi = N_PHASES; hipLaunchKernelGGL(trunk_fwd, dim3(grid), dim3(NTHREADS), LDS_BYTES, stream, a);
#endif
}
```

```cpp
#include <hip/hip_runtime.h>
#include <cstdio>
#include <cstdint>

#ifndef MK_SPLIT
#define MK_SPLIT 0
#endif

#ifndef DUPMASK
#define DUPMASK 0
#endif
#define DUP(b) (1 + ((DUPMASK >> (b)) & 1))
#define LAS __attribute__((address_space(3)))
#define GAS __attribute__((address_space(1)))
typedef unsigned short bf16_t;
typedef short bf16x8 __attribute__((ext_vector_type(8)));
typedef float f32x4 __attribute__((ext_vector_type(4)));
typedef float f32x2 __attribute__((ext_vector_type(2)));
typedef float f32x16 __attribute__((ext_vector_type(16)));
typedef unsigned u32x4 __attribute__((ext_vector_type(4)));
typedef unsigned u32x2 __attribute__((ext_vector_type(2)));
typedef __bf16 bf16x2_t __attribute__((ext_vector_type(2)));
typedef short v4i16_t __attribute__((ext_vector_type(4)));
typedef int v8i __attribute__((ext_vector_type(8)));
struct bf16x8_pair { bf16x8 a, b; };

constexpr int NB = 8, SEQ = 4096, T = NB * SEQ, D = 1024, NL = 4;
constexpr int NPROJ = 2816;
constexpr int C_FQ = 0, C_FK = 512, C_FV = 1024, C_GQ = 1536, C_GF = 1792, C_GI = 2048, C_GG = 2304, C_PU = 2560;
constexpr int IN_COLS = 2824;
constexpr int NE = 32, TOPK = 4, FF = 1024, MROWS = T * TOPK, LISTCAP = MROWS, MAXTILES = MROWS / 256 + NE;
constexpr float RMS_EPS = 1e-5f, LOG2E = 1.4426950408889634f;
constexpr float QSCALE = 0.125f * LOG2E;
constexpr int NWAVES = 8, NTHREADS = 512;

constexpr size_t MiB = 1u << 20;
constexpr size_t WS_CTL = 0, CTL_ZERO_BYTES = 1 * MiB;
constexpr size_t WS_RSTD1 = 1 * MiB, WS_RSTD2 = WS_RSTD1 + 128 * 1024;
constexpr size_t WS_LOGF = 2 * MiB, WS_C2 = 3 * MiB, WS_GATE = 4 * MiB, WS_B1R = 5 * MiB, WS_WFRAG = 6 * MiB, WS_LIST = 8 * MiB;
constexpr size_t WS_WIN = 40 * MiB, WIN_BYTES = (size_t)NPROJ * D * 2;
constexpr size_t WS_WOUT = 62 * MiB, WOUT_BYTES = (size_t)D * D * 2;
constexpr size_t WS_W1 = 70 * MiB, W1E_BYTES = (size_t)2 * FF * D;
constexpr size_t WS_W2 = 582 * MiB, W2E_BYTES = (size_t)D * FF;
constexpr size_t WS_HB8 = 400 * MiB;
constexpr float W1_SCALE = 64.f, W2_SCALE = 128.f, ACT_SCALE = 4.f, Y_SCALE = 16.f;
constexpr size_t WS_HB = 838 * MiB;
constexpr size_t WS_PA = 902 * MiB;
constexpr size_t WS_MIXED = WS_PA + 176 * MiB;
constexpr size_t WS_Y = 1174 * MiB;
constexpr size_t WS_ORAW = 1430 * MiB;
constexpr size_t WS_SEND = 1558 * MiB;
constexpr size_t WS_PSEG = 1566 * MiB;
constexpr size_t WS_QE = 1567 * MiB;
constexpr size_t WS_PWT = 1583 * MiB;
constexpr size_t WS_SEND2 = 1584 * MiB;
constexpr size_t WS_GLIST = 1600 * MiB;
constexpr size_t WS_END = 1616 * MiB;
static_assert(WS_WIN + NL * WIN_BYTES <= WS_WOUT && WS_WOUT + NL * WOUT_BYTES <= WS_W1 && WS_W1 + (size_t)NL * NE * W1E_BYTES <= WS_W2 && WS_W2 + (size_t)NL * NE * W2E_BYTES <= WS_HB, "ws map");
static_assert((size_t)MAXTILES * 256 * FF * 2 <= 272 * MiB && (size_t)T * NPROJ * 2 <= 176 * MiB, "ws map 2");
constexpr int CW_TMO = 0, CW_BAR = 4096, CW_CUR = 16384, CW_KMAX = 32768, CW_AQ = 40960;
constexpr int PH_BYTES = 139264, LDSCTL_OFF = PH_BYTES, LDS_BYTES = PH_BYTES + 2048;
static_assert(PH_BYTES >= 131072 + 512 * 16, "GEMM phase: stage buffers + parked A offsets");
constexpr int LC_BAR = 0, LC_TB = 64, LC_CN = 256, LC_R2CNT = 512, LC_R2BASE = 640, LC_STOP = 768, LC_SCAN = 896, LC_INP = 1024, LC_AQ = 1280;

__device__ __forceinline__ unsigned cvtpk(float lo, float hi) { f32x2 v = {lo, hi}; bf16x2_t b = __builtin_convertvector(v, bf16x2_t); return __builtin_bit_cast(unsigned, b); }
__device__ __forceinline__ float bflo(unsigned w) { return __uint_as_float(w << 16); }
__device__ __forceinline__ float bfhi(unsigned w) { return __uint_as_float(w & 0xffff0000u); }
__device__ __forceinline__ float bf2f(bf16_t h) { return __uint_as_float((unsigned)h << 16); }
__device__ __forceinline__ bf16_t f2bf(float f) { return (bf16_t)(cvtpk(f, 0.f) & 0xffffu); }
__device__ __forceinline__ float rdlane(float v, int l) { return __uint_as_float((unsigned)__builtin_amdgcn_readlane((int)__float_as_uint(v), l)); }
__device__ __forceinline__ unsigned pk4_fp8(float a, float b, float c, float d) { int w = __builtin_amdgcn_cvt_pk_fp8_f32(a, b, 0, false); w = __builtin_amdgcn_cvt_pk_fp8_f32(c, d, w, true); return (unsigned)w; }
__device__ __forceinline__ unsigned pk4_fp8_sat(float a, float b, float c, float d) {
    return pk4_fp8(__builtin_amdgcn_fmed3f(a, -448.f, 448.f), __builtin_amdgcn_fmed3f(b, -448.f, 448.f), __builtin_amdgcn_fmed3f(c, -448.f, 448.f), __builtin_amdgcn_fmed3f(d, -448.f, 448.f)); }
__device__ __forceinline__ f32x4 un4_fp8(unsigned w) { const f32x2 a = __builtin_amdgcn_cvt_pk_f32_fp8((int)w, false), b = __builtin_amdgcn_cvt_pk_f32_fp8((int)w, true); return (f32x4){a.x, a.y, b.x, b.y}; }
#define LDS_WAIT() asm volatile("s_waitcnt lgkmcnt(0)" ::: "memory")
#define VM_WAIT() asm volatile("s_waitcnt vmcnt(0)" ::: "memory")

namespace pg8 {
constexpr int BM = 256, BK = 64, HALF = 128, HTB = HALF * BK * 2, STAGE_BYTES = 8 * HTB, NXCD = 8, WGM = 8;
__host__ __device__ __forceinline__ int lds_byte(int r, int c) { const int st = (r >> 4) * 2 + (c >> 5), rr = r & 15, cc = c & 31, ob = rr * 64 + cc * 2; return st * 1024 + (ob ^ (((ob >> 9) & 1) << 5)); }
__host__ __device__ __forceinline__ void stage_rc(int b, int& R, int& C) { const int st = b / 1024, sb = b % 1024, swz = sb ^ (((sb >> 9) & 1) << 5); R = (st >> 1) * 16 + swz / 64; C = (st & 1) * 32 + (swz % 64) / 2; }
__host__ __device__ __forceinline__ int perm32(int rho) { const int n = rho >> 4, i = rho & 15; return 8 * (i >> 2) + 4 * n + (i & 3); }

struct Unit { int pm, pn, e, lt, cnt; };

__device__ __forceinline__ void tile_of(int L, int nM, int nN, int& pm, int& pn) {
    const int nwg = nM * nN; int wgid = L;
    { const int q = nwg / NXCD, r = nwg % NXCD, xcd = wgid % NXCD, off = wgid / NXCD; wgid = (xcd < r ? xcd * (q + 1) : r * (q + 1) + (xcd - r) * q) + off; }
    const int nig = WGM * nN, gid = wgid / nig, fm = gid * WGM, gsz = (nM - fm) < WGM ? (nM - fm) : WGM;
    pm = fm + ((wgid % nig) % gsz); pn = (wgid % nig) / gsz;
}
struct StaticOrder {
    int nM, nN, nwg, G, c, rep = 1; const char* Bt; size_t tstep;
    __device__ void init(int M, int N, int K, int G_, int c_, const bf16_t* Bt_) { nM = M / BM; nN = N / BM; nwg = nM * nN; G = G_; c = c_; Bt = (const char*)Bt_; tstep = (size_t)BM * K * 2; }
    __device__ __forceinline__ bool next(int i, Unit& u) const { long L = (long)i * G + c; if (L >= (long)nwg * rep) return false; L %= nwg; tile_of((int)L, nM, nN, u.pm, u.pn); u.e = 0; u.lt = 0; u.cnt = 0; return true; }
    __device__ __forceinline__ const char* bbase(const Unit& u) const { return Bt + (size_t)u.pn * tstep; }
    __device__ __forceinline__ int arow(const Unit& u, int r) const { return u.pm * BM + r; }
};
template <bool GATHER, size_t ESTRIDE, size_t TSTEP> struct MoeOrder {
    static constexpr size_t estride = ESTRIDE, tstep = TSTEP;
    int nM, nN, nwg, G, c, rep = 1; const char* Wt; LAS const int* tb; LAS const int* cn; const u32x2* list;
    __device__ __forceinline__ bool next(int i, Unit& u) const {
        long L = (long)i * G + (c + i) % G; if (L >= (long)nwg * rep) return false; L %= nwg; tile_of((int)L, nM, nN, u.pm, u.pn);
        int e = 0; while (e < NE - 1 && __builtin_amdgcn_readfirstlane(tb[e + 1]) <= u.pm) ++e;
        u.e = e; u.lt = u.pm - __builtin_amdgcn_readfirstlane(tb[e]); u.cnt = __builtin_amdgcn_readfirstlane(cn[e]); return true; }
    __device__ __forceinline__ const char* bbase(const Unit& u) const { return Wt + (size_t)u.e * estride + (size_t)u.pn * tstep; }
    __device__ __forceinline__ int arow(const Unit& u, int r) const {
        if (!GATHER) return u.pm * BM + r;
        const int pos = u.lt * BM + r; const char* lb = (const char*)(list + (size_t)u.e * LISTCAP);
        return pos < u.cnt ? (int)(*(const unsigned*)(lb + (unsigned)pos * 8u) >> 2) : 0; }
};

#ifndef PROBE_EPI
#define PROBE_EPI 0
#endif
#ifndef PROBE_EPI_SEL
#define PROBE_EPI_SEL 3
#endif
template <class Epi, class Sched, bool ALIGN_EPI, bool FP8 = false>
__device__ __forceinline__ unsigned long long gemm_phase(const int tid, LAS unsigned char* lds, const void* Abase, const int  , const Sched& S, const Epi& E) {
    constexpr int K = 1024;
    const int wid = __builtin_amdgcn_readfirstlane(tid >> 6), lane = tid & 63, wr = wid >> 2, wc = wid & 3, fr = lane & 15, fq = lane >> 4;
    constexpr int rowB = FP8 ? K : 2 * K;
    constexpr int nt = rowB / (BK * 2);
    unsigned voffB[2];
#pragma unroll
    for (int i = 0; i < 2; ++i) { int R, C; stage_rc(tid * 16 + i * 8192, R, C); const int Rb = Epi::PERM ? ((R & ~31) + perm32(R & 31)) : R; voffB[i] = (unsigned)(Rb * rowB + C * 2); }
    constexpr size_t kstep = (size_t)(BK * 2);
    constexpr size_t hstep = (size_t)HALF * rowB;
    const unsigned ldsw = (unsigned)wid * 1024u;
    const int a8off = (fq >> 1) * 1024 + ((fr * 64 + 32 * (fq & 1)) ^ (((fr >> 3) & 1) << 5));
    const int aoff = FP8 ? (wr * 8192 + a8off) : lds_byte(wr * 64 + fr, fq * 8), boff = FP8 ? (wc * 4096 + a8off) : lds_byte(wc * 32 + fr, fq * 8);
    const char* A8 = (const char*)Abase;
#define PG8_SA(b, h) (((b) * 2 + (h)) * HTB)
#define PG8_SB(b, h) ((4 + (b) * 2 + (h)) * HTB)
#define PG8_STGB(bufoff, gbase) do { _Pragma("unroll") for (int _i = 0; _i < 2; ++_i) \
        __builtin_amdgcn_global_load_lds((const unsigned*)((const char*)(gbase) + voffB[_i]), (LAS unsigned*)(lds + (bufoff) + ldsw + _i * 8192), 16, 0, 0); } while (0)
#define PG8_STGA(bufoff, kb, o0, o1) do { \
        __builtin_amdgcn_global_load_lds((const unsigned*)(A8 + (size_t)(kb) + (o0)), (LAS unsigned*)(lds + (bufoff) + ldsw), 16, 0, 0); \
        __builtin_amdgcn_global_load_lds((const unsigned*)(A8 + (size_t)(kb) + (o1)), (LAS unsigned*)(lds + (bufoff) + ldsw + 8192), 16, 0, 0); } while (0)
#define PG8_LD8(off) __builtin_bit_cast(v8i, bf16x8_pair{*(const LAS bf16x8*)(lds + (off)), *(const LAS bf16x8*)(lds + (off) + 16)})
#define PG8_LDA(dst, b, h) do { if constexpr (FP8) { _Pragma("unroll") for (int m = 0; m < 4; ++m) dst##8[m] = PG8_LD8(PG8_SA(b, h) + aoff + m * 2048); } \
        else { _Pragma("unroll") for (int m = 0; m < 4; ++m) _Pragma("unroll") for (int k = 0; k < 2; ++k) dst[m][k] = *(const LAS bf16x8*)(lds + PG8_SA(b, h) + aoff + m * 2048 + k * 1024); } } while (0)
#define PG8_LDB(dst, b, h) do { if constexpr (FP8) { _Pragma("unroll") for (int n = 0; n < 2; ++n) dst##8[n] = PG8_LD8(PG8_SB(b, h) + boff + n * 2048); } \
        else { _Pragma("unroll") for (int n = 0; n < 2; ++n) _Pragma("unroll") for (int k = 0; k < 2; ++k) dst[n][k] = *(const LAS bf16x8*)(lds + PG8_SB(b, h) + boff + n * 2048 + k * 1024); } } while (0)
#define PG8_MMA(ai, bj, At, Bt) do { __builtin_amdgcn_s_setprio(1); _Pragma("unroll") for (int m = 0; m < 4; ++m) _Pragma("unroll") for (int n = 0; n < 2; ++n) { \
        if constexpr (FP8) asm volatile("v_mfma_f32_16x16x128_f8f6f4 %0, %1, %2, %0" : "+v"(acc[ai][bj][m][n]) : "v"(Bt##8[n]), "v"(At##8[m]));     \
        else { _Pragma("unroll") for (int k = 0; k < 2; ++k) acc[ai][bj][m][n] = __builtin_amdgcn_mfma_f32_16x16x32_bf16(Bt[n][k], At[m][k], acc[ai][bj][m][n], 0, 0, 0); } } __builtin_amdgcn_s_setprio(0); } while (0)
#define PG8_WAIT_V(n) asm volatile("s_waitcnt vmcnt(" #n ")" ::: "memory")
#define PG8_WAIT_L(n) asm volatile("s_waitcnt lgkmcnt(" #n ")" ::: "memory")
#define PG8_BAR __builtin_amdgcn_s_barrier()
#define PG8_SCHED __builtin_amdgcn_sched_barrier(0)
#define PG8_AOFF(u, dst) do { int t_ = tid; asm volatile("" : "+v"(t_));     \
        _Pragma("unroll") for (int _h = 0; _h < 2; ++_h) _Pragma("unroll") for (int _i = 0; _i < 2; ++_i) \
        { int R_, C_; stage_rc(t_ * 16 + _i * 8192, R_, C_); dst[_h][_i] = (unsigned)((size_t)S.arow(u, _h * HALF + R_) * (size_t)rowB + (size_t)(C_ * 2)); } } while (0)
    Unit cur, nxt; int ui = 0; unsigned long long epi_acc = 0ull;
    if (!S.next(0, cur)) return 0ull;
    f32x4 acc[2][2][4][2];
#pragma unroll
    for (int a = 0; a < 2; ++a)
#pragma unroll
        for (int b = 0; b < 2; ++b)
#pragma unroll
            for (int m = 0; m < 4; ++m)
#pragma unroll
                for (int n = 0; n < 2; ++n) acc[a][b][m][n] = (f32x4){0.f, 0.f, 0.f, 0.f};
    bf16x8 At[4][2], B0[2][2], B1[2][2]; v8i At8[4], B08[2], B18[2];
    unsigned aoC[2][2], aoN[2][2];
    PG8_AOFF(cur, aoC);
    const char* cB = S.bbase(cur);
    PG8_STGB(PG8_SB(0, 0), cB); PG8_STGB(PG8_SB(0, 1), cB + hstep); PG8_STGA(PG8_SA(0, 0), 0, aoC[0][0], aoC[0][1]); PG8_STGA(PG8_SA(0, 1), 0, aoC[1][0], aoC[1][1]);
    if (wr == 1) PG8_BAR;
    PG8_WAIT_V(2); PG8_BAR;
    PG8_STGB(PG8_SB(1, 0), cB + kstep); PG8_STGA(PG8_SA(1, 0), kstep, aoC[0][0], aoC[0][1]); PG8_STGB(PG8_SB(1, 1), cB + hstep + kstep);
    PG8_WAIT_V(6); PG8_BAR;
    for (;;) {
        const bool has_next = S.next(ui + 1, nxt);
        if (has_next) { PG8_AOFF(nxt, aoN); } else { aoN[0][0] = aoC[0][0]; aoN[0][1] = aoC[0][1]; aoN[1][0] = aoC[1][0]; aoN[1][1] = aoC[1][1]; }
        *(LAS u32x4*)(lds + STAGE_BYTES + tid * 16) = (u32x4){aoN[0][0], aoN[0][1], aoN[1][0], aoN[1][1]};
        const char* nB = has_next ? S.bbase(nxt) : cB;
        for (int t = 0; t < nt; t += 2) {
            asm volatile("" : "+v"(voffB[0]), "+v"(voffB[1]));
            const bool last = (t == nt - 2);
            const size_t k1 = (size_t)(t + 1) * kstep, k2 = last ? 0 : (size_t)(t + 2) * kstep, k3 = k2 + kstep;
            const char* b2 = last ? nB : cB + (size_t)(t + 2) * kstep; const char* b3 = b2 + kstep;
            PG8_LDB(B0, 0, 0); PG8_LDB(B1, 0, 1); PG8_SCHED; PG8_LDA(At, 0, 0); PG8_STGA(PG8_SA(1, 1), k1, aoC[1][0], aoC[1][1]);
            PG8_WAIT_V(8); PG8_WAIT_L(0); PG8_BAR; PG8_MMA(0, 0, At, B0); PG8_MMA(0, 1, At, B1); PG8_BAR; PG8_SCHED;
            if (last) { const u32x4 nx = *(const LAS u32x4*)(lds + STAGE_BYTES + tid * 16); aoC[0][0] = nx.x; aoC[0][1] = nx.y; aoC[1][0] = nx.z; aoC[1][1] = nx.w; }
            PG8_LDA(At, 0, 1); PG8_STGB(PG8_SB(0, 0), b2); PG8_STGB(PG8_SB(0, 1), b2 + hstep); PG8_STGA(PG8_SA(0, 0), k2, aoC[0][0], aoC[0][1]);
            PG8_WAIT_V(8); PG8_WAIT_L(0); PG8_BAR; PG8_MMA(1, 0, At, B0); PG8_MMA(1, 1, At, B1); PG8_BAR; PG8_SCHED;
            PG8_LDB(B0, 1, 0); PG8_LDB(B1, 1, 1); PG8_SCHED; PG8_LDA(At, 1, 0); PG8_STGA(PG8_SA(0, 1), k2, aoC[1][0], aoC[1][1]);
            PG8_WAIT_V(8); PG8_WAIT_L(0); PG8_BAR; PG8_MMA(0, 0, At, B0); PG8_MMA(0, 1, At, B1); PG8_BAR; PG8_SCHED;
            PG8_LDA(At, 1, 1); PG8_STGB(PG8_SB(1, 0), b3); PG8_STGB(PG8_SB(1, 1), b3 + hstep); PG8_STGA(PG8_SA(1, 0), k3, aoC[0][0], aoC[0][1]);
            PG8_WAIT_V(8); PG8_WAIT_L(0); PG8_BAR; PG8_MMA(1, 0, At, B0); PG8_MMA(1, 1, At, B1); PG8_BAR; PG8_SCHED;
        }
        if constexpr (FP8) asm volatile("s_nop 15\n\ts_nop 15" ::: "memory");
        const unsigned long long te0 = PROBE_EPI ? __builtin_amdgcn_s_memrealtime() : 0ull;
        if constexpr (ALIGN_EPI) { if (wr == 0) PG8_BAR; }
        { int t2_ = tid; asm volatile("" : "+v"(t2_)); const int l2_ = t2_ & 63; E(acc, cur, wr, wc, l2_ & 15, l2_ >> 4); }
        if (PROBE_EPI) { if (PROBE_EPI == 1) asm volatile("s_waitcnt vmcnt(0)" ::: "memory"); epi_acc += __builtin_amdgcn_s_memrealtime() - te0; }
        if (!has_next) break;
#pragma unroll
        for (int a = 0; a < 2; ++a)
#pragma unroll
            for (int b = 0; b < 2; ++b)
#pragma unroll
                for (int m = 0; m < 4; ++m)
#pragma unroll
                    for (int n = 0; n < 2; ++n) acc[a][b][m][n] = (f32x4){0.f, 0.f, 0.f, 0.f};
        cur = nxt; cB = nB; ++ui;
        if constexpr (ALIGN_EPI) { if (wr == 1) PG8_BAR; }
    }
    PG8_WAIT_V(0);
    if constexpr (!ALIGN_EPI) { if (wr == 0) PG8_BAR; }
    PG8_BAR;
    return epi_acc;
#undef PG8_SA
#undef PG8_SB
#undef PG8_STGA
#undef PG8_STGB
#undef PG8_LDA
#undef PG8_LD8
#undef PG8_LDB
#undef PG8_MMA
#undef PG8_WAIT_V
#undef PG8_WAIT_L
#undef PG8_BAR
#undef PG8_SCHED
#undef PG8_AOFF
}

struct EpiProj {
    static constexpr bool PERM = true;
    bf16_t* O; const float* rstd; unsigned* kmax;
    __device__ __forceinline__ void operator()(const f32x4 (&acc)[2][2][4][2], const Unit& u, int wr, int wc, int fr, int fq) const {
        const int row0 = u.pm * BM + wr * 64 + fr, col0 = u.pn * BM + wc * 32 + 8 * fq;
        const float sc = (u.pn < 2) ? QSCALE : 1.f; const bool isk = (u.pn == 2 || u.pn == 3);
        float km[2] = {0.f, 0.f}; float rsv[8];
#pragma unroll
        for (int g = 0; g < 8; ++g) rsv[g] = rstd[row0 + (g >> 2) * HALF + (g & 3) * 16] * sc;
#pragma unroll
        for (int ai = 0; ai < 2; ++ai)
#pragma unroll
            for (int m = 0; m < 4; ++m) { const int row = row0 + ai * HALF + m * 16; const float rs = rsv[ai * 4 + m]; bf16_t* rowp = O + (size_t)row * NPROJ + col0;
#pragma unroll
                for (int bj = 0; bj < 2; ++bj) { const f32x4 v0 = acc[ai][bj][m][0] * rs, v1 = acc[ai][bj][m][1] * rs;
                    u32x4 w; w.x = cvtpk(v0[0], v0[1]); w.y = cvtpk(v0[2], v0[3]); w.z = cvtpk(v1[0], v1[1]); w.w = cvtpk(v1[2], v1[3]);
                    *(u32x4*)(rowp + bj * HALF) = w;
                    if (isk) { float s = bflo(w.x) * bflo(w.x) + bfhi(w.x) * bfhi(w.x) + bflo(w.y) * bflo(w.y) + bfhi(w.y) * bfhi(w.y) + bflo(w.z) * bflo(w.z) + bfhi(w.z) * bfhi(w.z) + bflo(w.w) * bflo(w.w) + bfhi(w.w) * bfhi(w.w);
                        s += __shfl_xor(s, 16); s += __shfl_xor(s, 32); km[bj] = fmaxf(km[bj], s); } } }
        if (isk) {
#pragma unroll
            for (int bj = 0; bj < 2; ++bj) { float v = km[bj]; v = fmaxf(v, __shfl_xor(v, 1)); v = fmaxf(v, __shfl_xor(v, 2)); v = fmaxf(v, __shfl_xor(v, 4)); v = fmaxf(v, __shfl_xor(v, 8));
                if ((threadIdx.x & 63) == 0) { const int b = u.pm >> 4, h = (u.pn - 2) * 4 + bj * 2 + (wc >> 1); atomicMax(kmax + (b * 8 + h) * 16, __float_as_uint(v)); } }
        }
    }
};
struct EpiOut {
    static constexpr bool PERM = false;
    const float* res; float* out;
    __device__ __forceinline__ void operator()(const f32x4 (&acc)[2][2][4][2], const Unit& u, int wr, int wc, int fr, int fq) const {
        const int row0 = u.pm * BM + wr * 64 + fr, col0 = u.pn * BM + wc * 32 + 4 * fq;
        f32x4 r[2][4];
#pragma unroll
        for (int q = 0; q < 4; ++q) r[0][q] = *(const f32x4*)(res + (size_t)row0 * D + col0 + (q >> 1) * HALF + (q & 1) * 16);
#pragma unroll
        for (int g = 0; g < 8; ++g) { const int ai = g >> 2, m = g & 3; const size_t off = (size_t)(row0 + ai * HALF + m * 16) * D + col0;
            if (g + 1 < 8) { const int ai2 = (g + 1) >> 2, m2 = (g + 1) & 3; const size_t off2 = (size_t)(row0 + ai2 * HALF + m2 * 16) * D + col0;
#pragma unroll
                for (int q = 0; q < 4; ++q) r[(g + 1) & 1][q] = *(const f32x4*)(res + off2 + (q >> 1) * HALF + (q & 1) * 16); }
#pragma unroll
            for (int q = 0; q < 4; ++q) *(f32x4*)(out + off + (q >> 1) * HALF + (q & 1) * 16) = r[g & 1][q] + acc[ai][q >> 1][m][q & 1]; }
    }
};
struct EpiGlu {
    static constexpr bool PERM = true;
    unsigned char* act; const u32x2* list; const float* b1r;
    __device__ __forceinline__ void operator()(const f32x4 (&acc)[2][2][4][2], const Unit& u, int wr, int wc, int fr, int fq) const {
        const int cb = u.pn * BM + wc * 32 + 8 * fq; const float* bp = b1r + (size_t)u.e * 2048 + cb; const char* lbase = (const char*)(list + (size_t)u.e * LISTCAP);
        float rsv[8];
#pragma unroll
        for (int g = 0; g < 8; ++g) { const int pos = u.lt * BM + (g >> 2) * HALF + wr * 64 + (g & 3) * 16 + fr; rsv[g] = 0.f; if (pos < u.cnt) rsv[g] = __uint_as_float(*(const unsigned*)(lbase + (unsigned)pos * 8u + 4u)) * (1.0f / W1_SCALE); }
        const f32x4 bg0 = *(const f32x4*)(bp), bg1 = *(const f32x4*)(bp + 4), bl0 = *(const f32x4*)(bp + HALF), bl1 = *(const f32x4*)(bp + HALF + 4);
#pragma unroll
        for (int ai = 0; ai < 2; ++ai)
#pragma unroll
            for (int m = 0; m < 4; ++m) { const int r = ai * HALF + wr * 64 + m * 16 + fr;
                const float rs = rsv[ai * 4 + m];
                float o[8];
                const f32x2 rs2 = {rs, rs};
#pragma unroll
                for (int p = 0; p < 4; ++p) {
                    const f32x4& ag = acc[ai][0][m][p >> 1]; const f32x4& al = acc[ai][1][m][p >> 1]; const f32x4& bgv = (p >> 1) ? bg1 : bg0; const f32x4& blv = (p >> 1) ? bl1 : bl0; const int q = 2 * (p & 1);
                    f32x2 g = (f32x2){ag[q], ag[q + 1]} * rs2 + (f32x2){bgv[q], bgv[q + 1]}, li = (f32x2){al[q], al[q + 1]} * rs2 + (f32x2){blv[q], blv[q + 1]};
                    g.x = __builtin_fminf(g.x, 7.f); g.y = __builtin_fminf(g.y, 7.f); li.x = __builtin_amdgcn_fmed3f(li.x, -7.f, 7.f); li.y = __builtin_amdgcn_fmed3f(li.y, -7.f, 7.f);
                    const f32x2 ea = g * (-1.702f * LOG2E); f32x2 d; d.x = __builtin_amdgcn_exp2f(ea.x); d.y = __builtin_amdgcn_exp2f(ea.y); d = d + 1.0f;
                    f32x2 rc; rc.x = __builtin_amdgcn_rcpf(d.x); rc.y = __builtin_amdgcn_rcpf(d.y);
                    const f32x2 tt = li * ACT_SCALE + ACT_SCALE, oo = (g * tt) * rc;
                    o[2 * p] = oo.x; o[2 * p + 1] = oo.y; }
                *(u32x2*)(act + (size_t)(u.pm * BM + r) * FF + u.pn * HALF + wc * 32 + 8 * fq) = (u32x2){pk4_fp8(o[0], o[1], o[2], o[3]), pk4_fp8(o[4], o[5], o[6], o[7])}; }
    }
};
struct EpiDown {
    static constexpr bool PERM = true;
    unsigned char* Y; const u32x2* list; const float* gate; const float* b2;
    __device__ __forceinline__ void operator()(const f32x4 (&acc)[2][2][4][2], const Unit& u, int wr, int wc, int fr, int fq) const {
        const int cb = u.pn * BM + wc * 32 + 8 * fq; const float* bp = b2 + (size_t)u.e * D + cb;
        f32x4 bv[2][2];
#pragma unroll
        for (int bj = 0; bj < 2; ++bj)
#pragma unroll
            for (int n = 0; n < 2; ++n) bv[bj][n] = *(const f32x4*)(bp + bj * HALF + 4 * n);
        unsigned entv[8]; float gtv[8];
#pragma unroll
        for (int g = 0; g < 8; ++g) { const int pos = u.lt * BM + (g >> 2) * HALF + wr * 64 + (g & 3) * 16 + fr; entv[g] = (pos < u.cnt) ? list[(size_t)u.e * LISTCAP + pos].x : 0xffffffffu; }
#pragma unroll
        for (int g = 0; g < 8; ++g) { const int pos = u.lt * BM + (g >> 2) * HALF + wr * 64 + (g & 3) * 16 + fr; gtv[g] = (pos < u.cnt) ? gate[(size_t)u.e * LISTCAP + pos] * Y_SCALE : 0.f; }
#pragma unroll
        for (int ai = 0; ai < 2; ++ai)
#pragma unroll
            for (int m = 0; m < 4; ++m) {
                if (entv[ai * 4 + m] != 0xffffffffu) { const unsigned ent = entv[ai * 4 + m]; const float gt = gtv[ai * 4 + m]; unsigned char* rowp = Y + (size_t)ent * D + cb;
#pragma unroll
                    for (int bj = 0; bj < 2; ++bj) { const f32x4 v0 = (acc[ai][bj][m][0] * (1.0f / (W2_SCALE * ACT_SCALE)) + bv[bj][0]) * gt, v1 = (acc[ai][bj][m][1] * (1.0f / (W2_SCALE * ACT_SCALE)) + bv[bj][1]) * gt;
                        *(u32x2*)(rowp + bj * HALF) = (u32x2){pk4_fp8_sat(v0[0], v0[1], v0[2], v0[3]), pk4_fp8_sat(v1[0], v1[1], v1[2], v1[3])}; } } }
    }
};
}

#define XB_TMO      128
#define XB_XCNT(j)  (256  + 64 * (j))
#define XB_XSUB(j)  (1280 + 64 * (j))
#define XB_XGEN(j)  (2304 + 64 * (j))
#define XB_TOP      3328
#define XB_TOPGEN   3392
#define XCD_BAR_WORDS 3456
#define XB_SPIN_CAP (1u << 18)
__device__ __forceinline__ unsigned xb_ld(unsigned* p)              { return __hip_atomic_load(p, __ATOMIC_RELAXED, __HIP_MEMORY_SCOPE_AGENT); }
__device__ __forceinline__ unsigned xb_add(unsigned* p, unsigned v) { return __hip_atomic_fetch_add(p, v, __ATOMIC_RELAXED, __HIP_MEMORY_SCOPE_AGENT); }
__device__ __forceinline__ unsigned xb_xcc_id() { return (unsigned)__builtin_amdgcn_s_getreg((3 << 11) | 20) & 0xFu; }
#define XB_SPIN(cond, bar) do { unsigned _sp = 0; while (cond) { __builtin_amdgcn_s_sleep(1); \
    if ((++_sp & 255u) == 0u) { if (xb_ld(&(bar)[XB_TMO])) break; if (_sp > XB_SPIN_CAP) { atomicAdd(&(bar)[XB_TMO], 1u); break; } } } } while (0)
struct XcdBarrier { unsigned* bar; unsigned x; volatile LAS unsigned* st; };
__device__ __forceinline__ XcdBarrier xcd_barrier_post(unsigned* bar, volatile LAS unsigned* st) {
    XcdBarrier b; b.bar = bar; b.x = xb_xcc_id(); b.st = st;
    if (threadIdx.x == 0) (void)xb_add(&bar[XB_XCNT(b.x)], 1u);
    return b;
}
__device__ __forceinline__ void xcd_barrier_complete(unsigned* bar, unsigned x, unsigned& nloc, unsigned& nx) {
    const unsigned G = gridDim.x * gridDim.y * gridDim.z;
    unsigned sum, cnt, mine, sp = 0u;
    for (;;) {
        sum = 0u; cnt = 0u; mine = 0u;
#pragma unroll
        for (unsigned j = 0; j < 16; ++j) { const unsigned c = xb_ld(&bar[XB_XCNT(j)]); sum += c; cnt += (c > 0u) ? 1u : 0u; mine = (j == x) ? c : mine; }
        if (sum == G) break;
        __builtin_amdgcn_s_sleep(1);
        if ((++sp & 255u) == 0u) { if (xb_ld(&bar[XB_TMO])) break; if (sp > XB_SPIN_CAP) { atomicAdd(&bar[XB_TMO], 1u); break; } }
    }
    nloc = mine > 0u ? mine : 1u; nx = cnt > 0u ? cnt : 1u;
}
__device__ __forceinline__ void xcd_barrier(const XcdBarrier& b, const bool leader  ) {
    asm volatile("s_waitcnt vmcnt(0)" ::: "memory");
    __syncthreads();
    if (leader) {
        unsigned* bar = b.bar;
        __builtin_amdgcn_s_waitcnt(0);
        unsigned nloc = b.st[0], nx = b.st[1];
        if (nloc == 0u) { xcd_barrier_complete(bar, b.x, nloc, nx); b.st[0] = nloc; b.st[1] = nx; }
        const unsigned old = xb_add(&bar[XB_XSUB(b.x)], 1u);
        const unsigned gen = old / nloc;
        if (old + 1u == (gen + 1u) * nloc) {
            __builtin_amdgcn_fence(__ATOMIC_RELEASE, "agent");
            asm volatile("s_waitcnt vmcnt(0)" ::: "memory");
            const unsigned og = xb_add(&bar[XB_TOP], 1u);
            const unsigned tg = og / nx;
            if (og + 1u == (tg + 1u) * nx) xb_add(&bar[XB_TOPGEN], 1u);
            else XB_SPIN(xb_ld(&bar[XB_TOPGEN]) == tg, bar);
            __builtin_amdgcn_fence(__ATOMIC_ACQUIRE, "agent");
            xb_add(&bar[XB_XGEN(b.x)], 1u);
            asm volatile("s_waitcnt vmcnt(0)" ::: "memory");
        } else {
            XB_SPIN(xb_ld(&bar[XB_XGEN(b.x)]) == gen, bar);
            __builtin_amdgcn_fence(__ATOMIC_ACQUIRE, "agent");
            asm volatile("s_waitcnt vmcnt(0)" ::: "memory");
        }
    }
    __syncthreads();
}

enum { I_x = 0, I_norm_mix, I_w_in, I_b_fox_f, I_fox_gain, I_hgrn_lb, I_hgrn_gain, I_pool_w, I_pool_scale, I_w_out, I_norm_moe, I_w_router, I_b_router, I_w1, I_b1, I_w2, I_b2, I_norm_final };
struct Frame {
    LAS unsigned char* lds; unsigned char* ws; unsigned* ctl; float* out;
    int tid, lane, wave, bid, G;
};
__device__ __forceinline__ const float* inp(const Frame& F, int i) {
    const LAS unsigned* p = (const LAS unsigned*)(F.lds + LDSCTL_OFF + LC_INP) + 2 * i;
    const unsigned lo = __builtin_amdgcn_readfirstlane(p[0]), hi = __builtin_amdgcn_readfirstlane(p[1]);
    return (const float*)(((unsigned long long)hi << 32) | lo);
}

constexpr int P0_ROWB = 272;
struct P0Item { const float* src; const float* g; unsigned char* dst; int ldn, K, drow0, extra, interleaved, out8; float scale; };
__device__ __forceinline__ void p0_load(const P0Item& d, f32x4 (&v)[16], int lane) {
    const float* sp = d.src + (size_t)(lane >> 5) * d.ldn + 4 * (lane & 31);
#pragma unroll
    for (int j = 0; j < 16; ++j) v[j] = __builtin_nontemporal_load((const f32x4*)(sp + (size_t)(2 * j) * d.ldn));
}
__device__ __forceinline__ void p0_store(const P0Item& d, f32x4 (&v)[16], LAS unsigned char* tile, int lane) {
    if (d.g) {
#pragma unroll
        for (int j = 0; j < 16; ++j) v[j] = v[j] * (d.g[2 * j + (lane >> 5)] * d.scale);
    } else {
#pragma unroll
        for (int j = 0; j < 16; ++j) v[j] = v[j] * d.scale;
    }
#pragma unroll
    for (int j = 0; j < 16; ++j) { const int k = 2 * j + (lane >> 5); const unsigned w0 = cvtpk(v[j][0], v[j][1]), w1 = cvtpk(v[j][2], v[j][3]);
        if (d.interleaved) { const unsigned gg = (w0 & 0xffffu) | (w1 << 16), ll = (w0 >> 16) | (w1 & 0xffff0000u);
            *(LAS unsigned*)(tile + k * P0_ROWB + 4 * (lane & 31)) = gg; *(LAS unsigned*)(tile + k * P0_ROWB + 128 + 4 * (lane & 31)) = ll; }
        else *(LAS u32x2*)(tile + k * P0_ROWB + 8 * (lane & 31)) = (u32x2){w0, w1}; }
    LDS_WAIT(); asm volatile("" ::: "memory");
    const int gq = lane >> 4, i16 = lane & 15;
    const LAS unsigned char* rp = tile + (8 * gq + (i16 >> 2)) * P0_ROWB + 8 * (lane & 3);
#pragma unroll
    for (int nb = 0; nb < 8; ++nb) {
        const v4i16_t lo = __builtin_amdgcn_ds_read_tr16_b64_v4i16((LAS v4i16_t*)(rp + nb * 32)), hi = __builtin_amdgcn_ds_read_tr16_b64_v4i16((LAS v4i16_t*)(rp + nb * 32 + 4 * P0_ROWB));
        const int tc = nb * 16 + i16, row = d.drow0 + tc + (tc >= 64 ? d.extra : 0);
        if (d.out8) { *(u32x2*)(d.dst + (size_t)row * d.K + 8 * gq) = (u32x2){pk4_fp8(bf2f((bf16_t)lo[0]), bf2f((bf16_t)lo[1]), bf2f((bf16_t)lo[2]), bf2f((bf16_t)lo[3])), pk4_fp8(bf2f((bf16_t)hi[0]), bf2f((bf16_t)hi[1]), bf2f((bf16_t)hi[2]), bf2f((bf16_t)hi[3]))}; }
        else { const bf16x8 o = (bf16x8){lo[0], lo[1], lo[2], lo[3], hi[0], hi[1], hi[2], hi[3]};
            *(bf16x8*)((bf16_t*)d.dst + (size_t)row * d.K + 8 * gq) = o; } }
    LDS_WAIT(); asm volatile("" ::: "memory");
}
constexpr int P0_I_IN = 32 * 22, P0_I_OUT = 32 * 8, P0_I_W1 = NE * 32 * 16, P0_I_W2 = NE * 32 * 8, P0_I_L = P0_I_IN + P0_I_OUT + P0_I_W1 + P0_I_W2;
__device__ __forceinline__ P0Item p0_decode(const Frame& F, int it) {
    P0Item d; const int l = it / P0_I_L; int r = it % P0_I_L;
    if (r < P0_I_IN) { const int nb = r / 32, kb = r % 32, n0 = 128 * nb, k0 = 32 * kb;
        d.src = inp(F, I_w_in) + ((size_t)l * D + k0) * IN_COLS + n0 + (n0 >= 1536 ? 8 : 0); d.ldn = IN_COLS; d.g = inp(F, I_norm_mix) + l * D + k0; d.dst = F.ws + WS_WIN + l * WIN_BYTES + (size_t)k0 * 2; d.K = D; d.drow0 = n0; d.extra = 0; d.interleaved = 0; d.out8 = 0; d.scale = 1.f; return d; }
    r -= P0_I_IN;
    if (r < P0_I_OUT) { const int nb = r / 32, kb = r % 32, n0 = 128 * nb, k0 = 32 * kb;
        d.src = inp(F, I_w_out) + ((size_t)l * D + k0) * D + n0; d.ldn = D; d.g = nullptr; d.dst = F.ws + WS_WOUT + l * WOUT_BYTES + (size_t)k0 * 2; d.K = D; d.drow0 = n0; d.extra = 0; d.interleaved = 0; d.out8 = 0; d.scale = 1.f; return d; }
    r -= P0_I_OUT;
    if (r < P0_I_W1) { const int e = r / (32 * 16), q = r % (32 * 16), cb = q / 32, kb = q % 32, k0 = 32 * kb, j0 = 64 * cb;
        d.src = inp(F, I_w1) + (((size_t)l * NE + e) * D + k0) * (2 * FF) + 2 * j0; d.ldn = 2 * FF; d.g = inp(F, I_norm_moe) + l * D + k0; d.dst = F.ws + WS_W1 + ((size_t)l * NE + e) * W1E_BYTES + k0; d.K = D; d.drow0 = (j0 >> 7) * 256 + (j0 & 127); d.extra = 64; d.interleaved = 1; d.out8 = 1; d.scale = W1_SCALE; return d; }
    r -= P0_I_W1;
    { const int e = r / (32 * 8), q = r % (32 * 8), nb = q / 32, kb = q % 32, n0 = 128 * nb, k0 = 32 * kb;
        d.src = inp(F, I_w2) + (((size_t)l * NE + e) * FF + k0) * D + n0; d.ldn = D; d.g = nullptr; d.dst = F.ws + WS_W2 + ((size_t)l * NE + e) * W2E_BYTES + k0; d.K = FF; d.drow0 = n0; d.extra = 0; d.interleaved = 0; d.out8 = 1; d.scale = W2_SCALE; return d; }
}
__device__ __forceinline__ void p0_prologue(const Frame& F) {
    LAS unsigned char* tile = F.lds + F.wave * (32 * P0_ROWB);
    const int gw = F.bid * NWAVES + F.wave, NGW = F.G * NWAVES;
    { f32x4 va[16], vb[16]; int it = gw; constexpr int NIT = NL * P0_I_L;
      if (it < NIT) { P0Item da = p0_decode(F, it); p0_load(da, va, F.lane);
        for (;;) {
            const bool hb_ = it + NGW < NIT; P0Item db = da; if (hb_) { db = p0_decode(F, it + NGW); p0_load(db, vb, F.lane); }
            p0_store(da, va, tile, F.lane);
            if (!hb_) break;
            it += NGW;
            const bool ha_ = it + NGW < NIT; if (ha_) { da = p0_decode(F, it + NGW); p0_load(da, va, F.lane); }
            p0_store(db, vb, tile, F.lane);
            if (!ha_) break;
            it += NGW;
        } } }
    const int gt = F.bid * NTHREADS + F.tid, NGT = F.G * NTHREADS;
    float* b1r = (float*)(F.ws + WS_B1R);
    for (int i = gt; i < NL * NE * 2048; i += NGT) { const int le = i >> 11, n = i & 2047, pn = n >> 8, rr = n & 255; b1r[i] = inp(F, I_b1)[(size_t)le * 2048 + 2 * (128 * pn + (rr & 127)) + (rr >> 7)]; }
    { bf16_t* pwt = (bf16_t*)(F.ws + WS_PWT);
      for (int i = gt; i < NL * 4 * 64 * 64; i += NGT) { const int c = i & 63, d = (i >> 6) & 63, lg = i >> 12; pwt[i] = f2bf(inp(F, I_pool_w)[((size_t)lg * 64 + c) * 64 + d]); } }
    bf16_t* wf = (bf16_t*)(F.ws + WS_WFRAG);
    for (int i = gt; i < NL * 2 * 32 * 2 * 64 * 8; i += NGT) {
        const int j = i & 7, ln = (i >> 3) & 63, et = (i >> 9) & 1, ks = (i >> 10) & 31, kind = (i >> 15) & 1, l = i >> 16;
        const int e = 16 * et + (ln & 15), k = 32 * ks + 8 * (ln >> 4) + j;
        float v;
        if (kind == 0) v = (e < 8) ? inp(F, I_norm_mix)[l * D + k] * inp(F, I_w_in)[((size_t)l * D + k) * IN_COLS + 1536 + e] : 0.f;
        else v = inp(F, I_norm_moe)[l * D + k] * inp(F, I_w_router)[((size_t)l * D + k) * NE + e];
        const bf16_t h = f2bf(v), lo = f2bf(v - bf2f(h));
        const size_t base = ((((size_t)(l * 2 + kind) * 32 + ks) * 2 + et) * 2) * 512 + ln * 8 + j;
        wf[base] = h; wf[base + 512] = lo;
    }
}

template <int KIND, bool COMBINE, bool WRITE_H, bool DRY = false>
__device__ __forceinline__ void r_phase(const Frame& F, int l, const float* hin, float* hout) {
    const int lane = F.lane, r16 = lane & 15, q4 = lane >> 4;
    const u32x4* Wf = (const u32x4*)(F.ws + WS_WFRAG + (size_t)(l * 2 + KIND) * 131072);
    const bf16_t* Y = (const bf16_t*)(F.ws + WS_Y);
    bf16_t* HB = (bf16_t*)(F.ws + WS_HB);
    float* rstdp = (float*)(F.ws + (KIND == 0 ? WS_RSTD1 : WS_RSTD2));
    LAS float* lg = (LAS float*)(F.lds) + F.wave * (16 * 33);
    LAS int* r2cnt = (LAS int*)(F.lds + LDSCTL_OFF + LC_R2CNT); LAS int* r2base = (LAS int*)(F.lds + LDSCTL_OFF + LC_R2BASE);
    for (int task = F.bid; task < T / 128; task += F.G) {
        const int tok = task * 128 + F.wave * 16 + r16;
        const float* xr = hin + (size_t)tok * D + 8 * q4; float* ho = hout + (size_t)tok * D + 8 * q4;
        const unsigned char* yr = (const unsigned char*)Y + (size_t)tok * 4 * D + 8 * q4; bf16_t* hbr = HB + (size_t)tok * D + 8 * q4;
        f32x4 acc0 = {0.f, 0.f, 0.f, 0.f}, acc1 = {0.f, 0.f, 0.f, 0.f}; float ssq = 0.f;
        if (KIND == 1) { if (F.tid < 32) r2cnt[F.tid] = 0; }
        f32x4 nx0 = *(const f32x4*)(xr), nx1 = *(const f32x4*)(xr + 4); u32x2 ny[4];
        u32x4 nwh0 = Wf[(0 * 2 + 0) * 64 + lane], nwl0 = Wf[(0 * 2 + 1) * 64 + lane], nwh1 = nwh0, nwl1 = nwl0;
        if (KIND == 1) { nwh1 = Wf[(1 * 2 + 0) * 64 + lane]; nwl1 = Wf[(1 * 2 + 1) * 64 + lane]; }
        if (COMBINE) {
#pragma unroll
            for (int k = 0; k < 4; ++k) ny[k] = *(const u32x2*)(yr + (size_t)k * D);
        }
#pragma unroll 2
        for (int ks = 0; ks < 32; ++ks) {
            f32x4 x0 = nx0, x1 = nx1; u32x2 yv[4];
            const u32x4 cwh0 = nwh0, cwl0 = nwl0, cwh1 = nwh1, cwl1 = nwl1;
#pragma unroll
            for (int k = 0; k < 4; ++k) yv[k] = COMBINE ? ny[k] : (u32x2){0u, 0u};
            if (ks + 1 < 32) {
                nx0 = *(const f32x4*)(xr + 32 * (ks + 1)); nx1 = *(const f32x4*)(xr + 32 * (ks + 1) + 4);
                nwh0 = Wf[(((ks + 1) * 2 + 0) * 2 + 0) * 64 + lane]; nwl0 = Wf[(((ks + 1) * 2 + 0) * 2 + 1) * 64 + lane];
                if (KIND == 1) { nwh1 = Wf[(((ks + 1) * 2 + 1) * 2 + 0) * 64 + lane]; nwl1 = Wf[(((ks + 1) * 2 + 1) * 2 + 1) * 64 + lane]; }
                if (COMBINE) {
#pragma unroll
                    for (int k = 0; k < 4; ++k) ny[k] = *(const u32x2*)(yr + (size_t)k * D + 32 * (ks + 1));
                }
            }
            if (COMBINE) {
#pragma unroll
                for (int k = 0; k < 4; ++k) { x0 += un4_fp8(yv[k].x) * (1.0f / Y_SCALE); x1 += un4_fp8(yv[k].y) * (1.0f / Y_SCALE); }
            }
            if (WRITE_H) { *(f32x4*)(ho + 32 * ks) = x0; *(f32x4*)(ho + 32 * ks + 4) = x1; }
            ssq += (x0[0] * x0[0] + x0[1] * x0[1]) + (x0[2] * x0[2] + x0[3] * x0[3]) + (x1[0] * x1[0] + x1[1] * x1[1]) + (x1[2] * x1[2] + x1[3] * x1[3]);
            u32x4 hw; hw.x = cvtpk(x0[0], x0[1]); hw.y = cvtpk(x0[2], x0[3]); hw.z = cvtpk(x1[0], x1[1]); hw.w = cvtpk(x1[2], x1[3]);
            u32x4 lw; lw.x = cvtpk(x0[0] - bflo(hw.x), x0[1] - bfhi(hw.x)); lw.y = cvtpk(x0[2] - bflo(hw.y), x0[3] - bfhi(hw.y)); lw.z = cvtpk(x1[0] - bflo(hw.z), x1[1] - bfhi(hw.z)); lw.w = cvtpk(x1[2] - bflo(hw.w), x1[3] - bfhi(hw.w));
            if (KIND == 0) *(u32x4*)(hbr + 32 * ks) = hw;
            else *(u32x2*)((unsigned char*)(F.ws + WS_HB8) + (size_t)tok * D + 8 * q4 + 32 * ks) = (u32x2){pk4_fp8_sat(x0[0], x0[1], x0[2], x0[3]), pk4_fp8_sat(x1[0], x1[1], x1[2], x1[3])};
            const bf16x8 xh = __builtin_bit_cast(bf16x8, hw), xl = __builtin_bit_cast(bf16x8, lw);
            const bf16x8 wh0 = __builtin_bit_cast(bf16x8, cwh0), wl0 = __builtin_bit_cast(bf16x8, cwl0);
            acc0 = __builtin_amdgcn_mfma_f32_16x16x32_bf16(wh0, xh, acc0, 0, 0, 0);
            acc0 = __builtin_amdgcn_mfma_f32_16x16x32_bf16(wl0, xh, acc0, 0, 0, 0);
            acc0 = __builtin_amdgcn_mfma_f32_16x16x32_bf16(wh0, xl, acc0, 0, 0, 0);
            if (KIND == 1) {
                const bf16x8 wh1 = __builtin_bit_cast(bf16x8, cwh1), wl1 = __builtin_bit_cast(bf16x8, cwl1);
                acc1 = __builtin_amdgcn_mfma_f32_16x16x32_bf16(wh1, xh, acc1, 0, 0, 0);
                acc1 = __builtin_amdgcn_mfma_f32_16x16x32_bf16(wl1, xh, acc1, 0, 0, 0);
                acc1 = __builtin_amdgcn_mfma_f32_16x16x32_bf16(wh1, xl, acc1, 0, 0, 0);
            }
        }
        ssq += __shfl_xor(ssq, 16); ssq += __shfl_xor(ssq, 32);
        const float rstd = 1.0f / sqrtf(ssq * (1.0f / D) + RMS_EPS);
        if (q4 == 0) rstdp[tok] = rstd;
        if (KIND == 0) {
            if (q4 < 2) { const f32x4 bf = *(const f32x4*)(inp(F, I_b_fox_f) + l * 8 + 4 * q4); f32x4 lf;
#pragma unroll
                for (int i = 0; i < 4; ++i) { const float z = rstd * acc0[i] + bf[i]; lf[i] = fminf(z, 0.f) - log1pf(expf(-fabsf(z))); }
                *(f32x4*)((float*)(F.ws + WS_LOGF) + (size_t)tok * 8 + 4 * q4) = lf; }
        } else if (!DRY) {
            const f32x4 b0 = *(const f32x4*)(inp(F, I_b_router) + l * NE + 4 * q4), b1v = *(const f32x4*)(inp(F, I_b_router) + l * NE + 16 + 4 * q4);
#pragma unroll
            for (int i = 0; i < 4; ++i) { lg[r16 * 33 + 4 * q4 + i] = rstd * acc0[i] + b0[i]; lg[r16 * 33 + 16 + 4 * q4 + i] = rstd * acc1[i] + b1v[i]; }
            LDS_WAIT(); asm volatile("" ::: "memory");
            float v0 = -INFINITY, v1 = -INFINITY, v2 = -INFINITY, v3 = -INFINITY; int i0 = 0, i1 = 0, i2 = 0, i3 = 0;
            if (lane < 16) {
                for (int e = 0; e < NE; ++e) { const float x = lg[lane * 33 + e];
                    if (x > v3) { if (x > v0) { v3 = v2; i3 = i2; v2 = v1; i2 = i1; v1 = v0; i1 = i0; v0 = x; i0 = e; }
                        else if (x > v1) { v3 = v2; i3 = i2; v2 = v1; i2 = i1; v1 = x; i1 = e; }
                        else if (x > v2) { v3 = v2; i3 = i2; v2 = x; i2 = e; }
                        else { v3 = x; i3 = e; } } }
            }
            __syncthreads();
            int rk0 = 0, rk1 = 0, rk2 = 0, rk3 = 0;
            if (lane < 16) { rk0 = __hip_atomic_fetch_add(&r2cnt[i0], 1, __ATOMIC_RELAXED, __HIP_MEMORY_SCOPE_WORKGROUP); rk1 = __hip_atomic_fetch_add(&r2cnt[i1], 1, __ATOMIC_RELAXED, __HIP_MEMORY_SCOPE_WORKGROUP); rk2 = __hip_atomic_fetch_add(&r2cnt[i2], 1, __ATOMIC_RELAXED, __HIP_MEMORY_SCOPE_WORKGROUP); rk3 = __hip_atomic_fetch_add(&r2cnt[i3], 1, __ATOMIC_RELAXED, __HIP_MEMORY_SCOPE_WORKGROUP); }
            __syncthreads();
            if (F.tid < 32) r2base[F.tid] = (int)atomicAdd(F.ctl + CW_CUR + (l * NE + F.tid) * 16, (unsigned)r2cnt[F.tid]);
            __syncthreads();
            if (lane < 16) {
                const float e1 = expf(v1 - v0), e2 = expf(v2 - v0), e3 = expf(v3 - v0), inv = 1.0f / (1.0f + e1 + e2 + e3);
                u32x2* list = (u32x2*)(F.ws + WS_LIST); float* gate = (float*)(F.ws + WS_GLIST);
                const int tk = (task * 128 + F.wave * 16 + lane) * 4; const unsigned rb = __float_as_uint(__shfl(rstd, lane & 15));
                { const size_t p0_ = (size_t)i0 * LISTCAP + r2base[i0] + rk0, p1_ = (size_t)i1 * LISTCAP + r2base[i1] + rk1, p2_ = (size_t)i2 * LISTCAP + r2base[i2] + rk2, p3_ = (size_t)i3 * LISTCAP + r2base[i3] + rk3;
                  list[p0_] = (u32x2){(unsigned)(tk + 0), rb}; gate[p0_] = inv;
                  list[p1_] = (u32x2){(unsigned)(tk + 1), rb}; gate[p1_] = e1 * inv;
                  list[p2_] = (u32x2){(unsigned)(tk + 2), rb}; gate[p2_] = e2 * inv;
                  list[p3_] = (u32x2){(unsigned)(tk + 3), rb}; gate[p3_] = e3 * inv; }
            }
            __syncthreads();
        }
    }
}
__device__ __forceinline__ void r_final(const Frame& F) {
    const int lane = F.lane, tr = lane >> 5, c = lane & 31;
    const bf16_t* Y = (const bf16_t*)(F.ws + WS_Y);
    const float* gf = inp(F, I_norm_final);
    for (int task = F.bid; task < T / 128; task += F.G) {
#pragma unroll 1
        for (int pr = 0; pr < 8; ++pr) {
            const int tok = task * 128 + F.wave * 16 + pr * 2 + tr;
            float* xr = F.out + (size_t)tok * D + 8 * c; const unsigned char* yr = (const unsigned char*)Y + (size_t)tok * 4 * D + 8 * c;
            f32x4 x0[4], x1[4]; float ssq = 0.f;
#pragma unroll
            for (int i = 0; i < 4; ++i) { x0[i] = *(const f32x4*)(xr + 256 * i); x1[i] = *(const f32x4*)(xr + 256 * i + 4); }
#pragma unroll
            for (int i = 0; i < 4; ++i) {
#pragma unroll
                for (int k = 0; k < 4; ++k) { const u32x2 y = *(const u32x2*)(yr + (size_t)k * D + 256 * i);
                    x0[i] += un4_fp8(y.x) * (1.0f / Y_SCALE); x1[i] += un4_fp8(y.y) * (1.0f / Y_SCALE); }
                ssq += (x0[i][0] * x0[i][0] + x0[i][1] * x0[i][1]) + (x0[i][2] * x0[i][2] + x0[i][3] * x0[i][3]) + (x1[i][0] * x1[i][0] + x1[i][1] * x1[i][1]) + (x1[i][2] * x1[i][2] + x1[i][3] * x1[i][3]); }
            ssq += __shfl_xor(ssq, 1); ssq += __shfl_xor(ssq, 2); ssq += __shfl_xor(ssq, 4); ssq += __shfl_xor(ssq, 8); ssq += __shfl_xor(ssq, 16);
            const float rstd = 1.0f / sqrtf(ssq * (1.0f / D) + RMS_EPS);
#pragma unroll
            for (int i = 0; i < 4; ++i) { const f32x4 g0 = *(const f32x4*)(gf + 256 * i + 8 * c), g1 = *(const f32x4*)(gf + 256 * i + 8 * c + 4);
                *(f32x4*)(xr + 256 * i) = x0[i] * rstd * g0; *(f32x4*)(xr + 256 * i + 4) = x1[i] * rstd * g1; }
        }
    }
}
__device__ __forceinline__ void cumsum_step(const Frame& F) {
    LAS float* sc = (LAS float*)(F.lds + LDSCTL_OFF + LC_SCAN);
    const float* LF = (const float*)(F.ws + WS_LOGF); float* c2 = (float*)(F.ws + WS_C2);
    for (int seq = F.bid; seq < 64; seq += F.G) {
        const int b = seq >> 3, h = seq & 7, t0 = F.tid * 8; const float* lf = LF + ((size_t)b * SEQ + t0) * 8 + h;
        float v[8], s = 0.f;
#pragma unroll
        for (int j = 0; j < 8; ++j) { s += lf[j * 8]; v[j] = s; }
        float inc = s;
#pragma unroll
        for (int off = 1; off < 64; off <<= 1) { const float y = __shfl_up(inc, off); if (F.lane >= off) inc += y; }
        if (F.lane == 63) sc[F.wave] = inc;
        __syncthreads();
        float pre = 0.f;
        for (int w = 0; w < F.wave; ++w) pre += sc[w];
        const float base = pre + inc - s;
#pragma unroll
        for (int j = 0; j < 8; ++j) c2[(size_t)seq * SEQ + t0 + j] = (base + v[j]) * LOG2E;
        __syncthreads();
    }
}

__device__ __forceinline__ float max3f(float a, float b, float c) { float r; asm("v_max3_f32 %0, %1, %2, %3" : "=v"(r) : "v"(a), "v"(b), "v"(c)); return r; }
__device__ __forceinline__ float max2f(float a, float b) { float r; asm("v_max_f32_e32 %0, %1, %2" : "=v"(r) : "v"(a), "v"(b)); return r; }
__device__ __forceinline__ int crow(int r, int hi) { return (r & 3) + 8 * (r >> 2) + 4 * hi; }
constexpr int AT_KT = 0, AT_KTB = 8320, AT_VT = 2 * AT_KTB, AT_VTB = 8192, AT_CK = AT_VT + 2 * AT_VTB, AT_WSF = AT_CK + 512, AT_OST = AT_WSF + 2048, AT_END = AT_OST + 65536;
static_assert(AT_END <= PH_BYTES, "attention LDS");
__device__ __forceinline__ void attn_unit(const Frame& F, int l, int b, int h, int qb) {
    const int tid = F.tid, lane = F.lane, r32 = lane & 31, hi = lane >> 5, wid = F.wave;
    const bf16_t* proj = (const bf16_t*)(F.ws + WS_PA); bf16_t* mixed = (bf16_t*)(F.ws + WS_MIXED);
    const int bh = b * 8 + h; const float* c2 = (const float*)(F.ws + WS_C2) + (size_t)bh * SEQ;
    const size_t rowbase = (size_t)b * SEQ; const int q0 = qb * 256;
    LAS unsigned char* L = F.lds;
    LAS float* wsf = (LAS float*)(L + AT_WSF) + wid * 64;
    LAS float* ost = (LAS float*)(L + AT_OST) + wid * 2048;
    LAS unsigned* stopv = (LAS unsigned*)(L + LDSCTL_OFF + LC_STOP);
    const bf16_t* Qw = proj + (rowbase + q0 + wid * 32 + r32) * NPROJ + C_FQ + h * 64;
    bf16x8 qr[4]; float qn = 0.f;
#pragma unroll
    for (int d0 = 0; d0 < 4; ++d0) { const u32x4 w = *(const u32x4*)(Qw + d0 * 16 + hi * 8); qr[d0] = __builtin_bit_cast(bf16x8, w);
        qn += bflo(w.x) * bflo(w.x) + bfhi(w.x) * bfhi(w.x) + bflo(w.y) * bflo(w.y) + bfhi(w.y) * bfhi(w.y) + bflo(w.z) * bflo(w.z) + bfhi(w.z) * bfhi(w.z) + bflo(w.w) * bflo(w.w) + bfhi(w.w) * bfhi(w.w); }
    qn += __shfl_xor(qn, 32); qn = sqrtf(qn) * 1.001f;
    const float kb = sqrtf(2.0f * __uint_as_float(__hip_atomic_load(F.ctl + CW_KMAX + (l * 64 + bh) * 16, __ATOMIC_RELAXED, __HIP_MEMORY_SCOPE_AGENT))) * 1.001f;
    const float c2q = c2[q0 + wid * 32 + r32];
    f32x16 cq16;
#pragma unroll
    for (int r = 0; r < 16; ++r) cq16[r] = c2q;
    float lsum = 0.f; f32x16 o[2];
#pragma unroll
    for (int r = 0; r < 16; ++r) { o[0][r] = 0.f; o[1][r] = 0.f; }
    const int jd = 4 * qb + 3;
    const int lkey = tid >> 3, lpiece = tid & 7;
    const bf16_t* ksrc = proj + (rowbase + lkey) * NPROJ + C_FK + h * 64 + lpiece * 8;
    const bf16_t* vsrc = proj + (rowbase + lkey) * NPROJ + C_FV + h * 64 + lpiece * 8;
    const int kdst = lpiece * 1040 + lkey * 16, vdst = (lpiece >> 2) * 4096 + lkey * 64 + (lpiece & 3) * 16;
    u32x4 kA = *(const u32x4*)(ksrc + (size_t)jd * 64 * NPROJ), vA = *(const u32x4*)(vsrc + (size_t)jd * 64 * NPROJ); float cA = c2[jd * 64 + lane];
    u32x4 kB = kA, vB = vA; float cB = cA;
    if (jd >= 1) { kB = *(const u32x4*)(ksrc + (size_t)(jd - 1) * 64 * NPROJ); vB = *(const u32x4*)(vsrc + (size_t)(jd - 1) * 64 * NPROJ); cB = c2[(jd - 1) * 64 + lane]; }
    const int vrd = (4 * hi + ((lane & 15) >> 2)) * 64 + ((lane >> 4) & 1) * 32 + (lane & 3) * 8;
    const int qrel = wid * 32 + r32;
    int buf = 0; bool done = false, wstop = false, first = true;
    float mhat = 0.f;
#define AT_ITER(j, kR, vR, cR, cNext) do { \
        const float cklast = rdlane(cNext, 63);     \
        *(LAS u32x4*)(L + AT_KT + buf * AT_KTB + kdst) = kR; *(LAS u32x4*)(L + AT_VT + buf * AT_VTB + vdst) = vR; \
        if (tid < 64) ((LAS float*)(L + AT_CK))[buf * 64 + tid] = cR; \
        asm volatile("s_waitcnt lgkmcnt(0)\n\ts_barrier" ::: "memory");     \
        if ((j) < jd) { const u32x4 fa = *(const LAS u32x4*)(stopv + (((j) + 1) & 1) * 8), fb = *(const LAS u32x4*)(stopv + (((j) + 1) & 1) * 8 + 4); \
            if ((fa.x & fa.y & fa.z & fa.w & fb.x & fb.y & fb.z & fb.w) != 0u) { done = true; break; } } \
        if ((j) >= 2) { kR = *(const u32x4*)(ksrc + (size_t)((j) - 2) * 64 * NPROJ); vR = *(const u32x4*)(vsrc + (size_t)((j) - 2) * 64 * NPROJ); cR = c2[((j) - 2) * 64 + lane]; } \
        const int jrel = (j) - 4 * qb; \
        const bool active = !(jrel >= 0 && 64 * jrel > 32 * wid + 31) && !wstop; \
        if (active) { \
            const LAS unsigned char* Kb = L + AT_KT + buf * AT_KTB; const LAS unsigned char* Vb = L + AT_VT + buf * AT_VTB; const LAS float* Ck = (const LAS float*)(L + AT_CK) + buf * 64; \
            const float base = c2q - mhat; \
            f32x16 p0, p1; \
            _Pragma("unroll") for (int g = 0; g < 4; ++g) { const f32x4 ca = *(const LAS f32x4*)(Ck + 8 * g + 4 * hi), cb = *(const LAS f32x4*)(Ck + 32 + 8 * g + 4 * hi); \
                _Pragma("unroll") for (int i = 0; i < 4; ++i) { p0[4 * g + i] = base - ca[i]; p1[4 * g + i] = base - cb[i]; } } \
            bf16x8 kf0[4], kf1[4]; \
            _Pragma("unroll") for (int d0 = 0; d0 < 4; ++d0) { kf0[d0] = *(const LAS bf16x8*)(Kb + (2 * d0 + hi) * 1040 + r32 * 16); kf1[d0] = *(const LAS bf16x8*)(Kb + (2 * d0 + hi) * 1040 + (32 + r32) * 16); } \
            _Pragma("unroll") for (int d0 = 0; d0 < 4; ++d0) { \
                p0 = __builtin_amdgcn_mfma_f32_32x32x16_bf16(kf0[d0], qr[d0], p0, 0, 0, 0); p1 = __builtin_amdgcn_mfma_f32_32x32x16_bf16(kf1[d0], qr[d0], p1, 0, 0, 0); } \
            asm volatile("s_nop 15\n\ts_nop 7" : "+v"(p0), "+v"(p1));     \
            if (jrel >= 0) { const int kbase = 64 * jrel + 4 * hi; \
                _Pragma("unroll") for (int r = 0; r < 16; ++r) { const int kv = kbase + (r & 3) + 8 * (r >> 2); if (kv > qrel) p0[r] = -INFINITY; if (kv + 32 > qrel) p1[r] = -INFINITY; } } \
            float mx = max3f(p0[0], p0[1], p1[0]), mb_ = max3f(p0[2], p0[3], p1[1]); mx = max3f(mx, p1[2], p1[3]); \
            _Pragma("unroll") for (int r = 4; r < 16; r += 4) { mx = max3f(mx, p0[r], p0[r + 1]); mb_ = max3f(mb_, p0[r + 2], p0[r + 3]); mx = max3f(mx, p1[r], p1[r + 1]); mb_ = max3f(mb_, p1[r + 2], p1[r + 3]); } \
            mx = max2f(mx, mb_); \
            { auto rr = __builtin_amdgcn_permlane32_swap(__float_as_uint(mx), __float_as_uint(mx), false, false); mx = max2f(__uint_as_float(rr[0]), __uint_as_float(rr[1])); } \
            if (first || __any(mx > 8.0f)) { \
                const float dl = first ? mx : fmaxf(mx, 0.f); mhat += dl; \
                _Pragma("unroll") for (int r = 0; r < 16; ++r) { p0[r] -= dl; p1[r] -= dl; } \
                const float alpha = __builtin_amdgcn_exp2f(-dl); lsum *= alpha; \
                if (!first) { \
                    if (hi == 0) wsf[r32] = alpha; \
                    LDS_WAIT(); asm volatile("" ::: "memory"); \
                    _Pragma("unroll") for (int r = 0; r < 16; ++r) { const float a = wsf[crow(r, hi)]; o[0][r] *= a; o[1][r] *= a; } } \
                first = false; \
            } \
            _Pragma("unroll") for (int r = 0; r < 16; ++r) { p0[r] = __builtin_amdgcn_exp2f(p0[r]); p1[r] = __builtin_amdgcn_exp2f(p1[r]); } \
            { f32x2 sa = {p0[0] + p1[0], p0[1] + p1[1]}; \
              _Pragma("unroll") for (int r = 2; r < 16; r += 2) { sa += (f32x2){p0[r], p0[r + 1]}; sa += (f32x2){p1[r], p1[r + 1]}; } \
              lsum += sa[0] + sa[1]; } \
            u32x4 pw[4]; \
            pw[0] = (u32x4){cvtpk(p0[0], p0[1]), cvtpk(p0[2], p0[3]), cvtpk(p0[4], p0[5]), cvtpk(p0[6], p0[7])}; \
            pw[1] = (u32x4){cvtpk(p0[8], p0[9]), cvtpk(p0[10], p0[11]), cvtpk(p0[12], p0[13]), cvtpk(p0[14], p0[15])}; \
            pw[2] = (u32x4){cvtpk(p1[0], p1[1]), cvtpk(p1[2], p1[3]), cvtpk(p1[4], p1[5]), cvtpk(p1[6], p1[7])}; \
            pw[3] = (u32x4){cvtpk(p1[8], p1[9]), cvtpk(p1[10], p1[11]), cvtpk(p1[12], p1[13]), cvtpk(p1[14], p1[15])}; \
            _Pragma("unroll") for (int s = 0; s < 4; ++s) \
                _Pragma("unroll") for (int d0 = 0; d0 < 2; ++d0) { \
                    const LAS unsigned char* vp = Vb + d0 * 4096 + s * 1024 + vrd; \
                    const v4i16_t lo = __builtin_amdgcn_ds_read_tr16_b64_v4i16((LAS v4i16_t*)vp), hv = __builtin_amdgcn_ds_read_tr16_b64_v4i16((LAS v4i16_t*)(vp + 512)); \
                    const bf16x8 vf = (bf16x8){lo[0], lo[1], lo[2], lo[3], hv[0], hv[1], hv[2], hv[3]}; \
                    o[d0] = __builtin_amdgcn_mfma_f32_32x32x16_bf16(__builtin_bit_cast(bf16x8, pw[s]), vf, o[d0], 0, 0, 0); } \
        } \
        if ((j) > 0) { if (active) { const float ub = qn * kb + (c2q - cklast); if (__all((ub - mhat) < -152.0f)) wstop = true; } if (lane == 0) stopv[((j) & 1) * 8 + wid] = wstop ? 1u : 0u; } \
        buf ^= 1; \
    } while (0)
    for (int j = jd; j >= 0; j -= 2) {
        AT_ITER(j, kA, vA, cA, cB);
        if (done || j == 0) break;
        AT_ITER(j - 1, kB, vB, cB, cA);
        if (done) break;
    }
#undef AT_ITER
    lsum += __shfl_xor(lsum, 32);
    if (hi == 0) wsf[32 + r32] = 1.0f / lsum;
    LDS_WAIT(); asm volatile("" ::: "memory");
#pragma unroll
    for (int r = 0; r < 16; ++r) { const int q = crow(r, hi); const float inv = wsf[32 + q]; ost[q * 64 + r32] = o[0][r] * inv; ost[q * 64 + 32 + r32] = o[1][r] * inv; }
    LDS_WAIT(); asm volatile("" ::: "memory");
    { const int row = lane >> 1, half = lane & 1; const LAS float* src = ost + row * 64 + half * 32; float v[32]; float ss = 0.f;
#pragma unroll
        for (int i = 0; i < 8; ++i) { const f32x4 t4 = *(const LAS f32x4*)(src + 4 * i); v[4 * i] = t4[0]; v[4 * i + 1] = t4[1]; v[4 * i + 2] = t4[2]; v[4 * i + 3] = t4[3]; ss += (t4[0] * t4[0] + t4[1] * t4[1]) + (t4[2] * t4[2] + t4[3] * t4[3]); }
        ss += __shfl_xor(ss, 1);
        const float rs = 1.0f / sqrtf(ss * (1.0f / 64.0f) + RMS_EPS);
        const float* gn = inp(F, I_fox_gain) + l * 512 + h * 64 + half * 32;
        bf16_t* dst = mixed + (rowbase + q0 + wid * 32 + row) * D + h * 64 + half * 32;
#pragma unroll
        for (int i = 0; i < 4; ++i) { const f32x4 ga = *(const f32x4*)(gn + 8 * i), gb = *(const f32x4*)(gn + 8 * i + 4); u32x4 w;
            w.x = cvtpk(v[8 * i] * rs * ga[0], v[8 * i + 1] * rs * ga[1]); w.y = cvtpk(v[8 * i + 2] * rs * ga[2], v[8 * i + 3] * rs * ga[3]);
            w.z = cvtpk(v[8 * i + 4] * rs * gb[0], v[8 * i + 5] * rs * gb[1]); w.w = cvtpk(v[8 * i + 6] * rs * gb[2], v[8 * i + 7] * rs * gb[3]);
            *(u32x4*)(dst + 8 * i) = w; } }
    __syncthreads();
}

__device__ __forceinline__ float hg_lb(const Frame& F, int l, int col) {
    float x[NL], mx = -INFINITY;
#pragma unroll
    for (int i = 0; i < NL; ++i) { x[i] = inp(F, I_hgrn_lb)[i * 256 + col]; mx = fmaxf(mx, x[i]); }
    float s = 0.f, a = 0.f;
#pragma unroll
    for (int i = 0; i < NL; ++i) { x[i] = expf(x[i] - mx); s += x[i]; }
#pragma unroll
    for (int i = 1; i < NL; ++i) if (i <= l) a += x[i];
    return a / s;
}
constexpr int HG_SEG = 128, HG_NSEG = SEQ / HG_SEG, HG_NPART = 1, HG_WAVES = 4;
static_assert(HG_NSEG == 32, "the FIX phase's balanced deal assumes 32 segments");
constexpr int HGL_ROW = 136, HGL_QT = 0, HGL_KT = 32 * HGL_ROW, HGL_KP = 2 * 32 * HGL_ROW, HGL_V = HGL_KP + 4096, HGL_PE = HGL_V + 4096, HGL_BYTES = HGL_PE + 256;
static_assert(NWAVES * HGL_BYTES <= PH_BYTES, "HGRN2 LDS");
#ifndef PROBE_HG
#define PROBE_HG 0
#endif
__device__ __forceinline__ unsigned long long hg_mfma_unit(const Frame& F, int l, int u) {
    unsigned long long hacc = 0ull;
    const int seg = u % HG_NSEG, bh = u / HG_NSEG, b = bh >> 2, hd = bh & 3, lane = F.lane, r32 = lane & 31, hi = lane >> 5;
    LAS unsigned char* W = F.lds + F.wave * HGL_BYTES;
    const size_t tokS = (size_t)b * SEQ + seg * HG_SEG;
    const bf16_t* proj = (const bf16_t*)(F.ws + WS_PA);
    float* oraw = (float*)(F.ws + WS_ORAW); bf16_t* QE = (bf16_t*)(F.ws + WS_QE);
    const float lbv = hg_lb(F, l, hd * 64 + lane);
    f32x16 Sacc[2][2];
#pragma unroll
    for (int kb = 0; kb < 2; ++kb)
#pragma unroll
        for (int vb = 0; vb < 2; ++vb)
#pragma unroll
            for (int r = 0; r < 16; ++r) Sacc[kb][vb][r] = 0.f;
    float Pseg = 1.0f;
    const int vrd = (4 * hi + ((lane & 15) >> 2)) * 64 + ((lane >> 4) & 1) * 32 + (lane & 3) * 8;
    int tb = 0;
    while (tb < HG_SEG) {
        const unsigned long long th0 = PROBE_HG ? __builtin_amdgcn_s_memrealtime() : 0ull;
        const int nmax = (HG_SEG - tb) < 32 ? (HG_SEG - tb) : 32;
        const char* pu8 = (const char*)(proj + (tokS + tb) * NPROJ + hd * 64);
        const unsigned lo2 = (unsigned)lane * 2u;
        char* qe8 = (char*)(QE + (tokS + tb) * 256 + hd * 64);
        char* or8 = (char*)(oraw + (tokS + tb) * 256 + hd * 64);
        const unsigned lof = (unsigned)(4 * hi * 256 + r32) * 4u;
        char* dmy8 = (char*)(F.ws + WS_PSEG + 768 * 1024);
        float fv[32], qv[32]; u32x4 vreg[4], fr4[4], qr4[4];
#pragma unroll
        for (int it = 0; it < 4; ++it) { const int c = lane + 64 * it, sr = c >> 3, pc = c & 7; const char* rp = pu8 + (size_t)sr * (NPROJ * 2) + pc * 16;
            fr4[it] = *(const u32x4*)(rp + C_GF * 2); qr4[it] = *(const u32x4*)(rp + C_GQ * 2); vreg[it] = *(const u32x4*)(rp + C_GI * 2); }
        __builtin_amdgcn_sched_barrier(0);
#pragma unroll
        for (int it = 0; it < 4; ++it) { const int c = lane + 64 * it, sr = c >> 3, pc = c & 7;
            *(LAS u32x2*)(W + HGL_QT + sr * HGL_ROW + pc * 16) = (u32x2){fr4[it].x, fr4[it].y}; *(LAS u32x2*)(W + HGL_QT + sr * HGL_ROW + pc * 16 + 8) = (u32x2){fr4[it].z, fr4[it].w};
            *(LAS u32x2*)(W + HGL_KT + sr * HGL_ROW + pc * 16) = (u32x2){qr4[it].x, qr4[it].y}; *(LAS u32x2*)(W + HGL_KT + sr * HGL_ROW + pc * 16 + 8) = (u32x2){qr4[it].z, qr4[it].w}; }
        LDS_WAIT(); asm volatile("" ::: "memory");
#pragma unroll
        for (int t = 0; t < 32; ++t) { fv[t] = bf2f(*(const LAS bf16_t*)(W + HGL_QT + t * HGL_ROW + lane * 2)); qv[t] = bf2f(*(const LAS bf16_t*)(W + HGL_KT + t * HGL_ROW + lane * 2)); }
        LDS_WAIT(); asm volatile("" ::: "memory");
        int nl = 32; { float P = 1.0f;
#pragma unroll
            for (int t = 0; t < 32; ++t) { const float sg = __builtin_amdgcn_rcpf(1.0f + __builtin_amdgcn_exp2f(-LOG2E * fv[t])); float f = fmaxf(lbv + (1.0f - lbv) * sg, 1e-30f); if (t >= nmax) f = 1.0f; fv[t] = f; P *= f; if (P < 1e-32f && nl == 32) nl = t; } }
#pragma unroll
        for (int off = 1; off < 64; off <<= 1) { const int o = __shfl_xor(nl, off); nl = o < nl ? o : nl; }
        const int n = __builtin_amdgcn_readfirstlane(nl < nmax ? nl : nmax);
        if (PROBE_HG == 1) hacc += __builtin_amdgcn_s_memrealtime() - th0;
#pragma unroll
        for (int it = 0; it < 4; ++it) { const int c = lane + 64 * it, sr = c >> 3, pc = c & 7;
            *(LAS u32x4*)(W + HGL_V + (pc >> 2) * 2048 + sr * 64 + (pc & 3) * 16) = (sr < n) ? vreg[it] : (u32x4){0u, 0u, 0u, 0u}; }
        float P = 1.0f;
        {
#pragma unroll
          for (int t = 0; t < 32; ++t) { const bool ok = t < n; const float f = fv[t]; if (ok) P *= f;
            const float qt = ok ? qv[t] * P : 0.f, kt = ok ? (1.0f - f) * __builtin_amdgcn_rcpf(P) : 0.f;
            *(LAS bf16_t*)(W + HGL_QT + t * HGL_ROW + lane * 2) = f2bf(qt); *(LAS bf16_t*)(W + HGL_KT + t * HGL_ROW + lane * 2) = f2bf(kt);
            *(bf16_t*)((t < nmax ? qe8 + (size_t)t * 512 : dmy8) + lo2) = f2bf(qv[t] * (Pseg * P)); } }
        { float suf = 1.0f;
#pragma unroll
          for (int t = 31; t >= 0; --t) { const bool ok = t < n; const float f = fv[t]; const float kp = ok ? (1.0f - f) * suf : 0.f; if (ok) suf *= f;
            *(LAS bf16_t*)(W + HGL_KP + (lane >> 5) * 2048 + t * 64 + (lane & 31) * 2) = f2bf(kp); } }
        ((LAS float*)(W + HGL_PE))[lane] = P;
        Pseg *= P;
        LDS_WAIT(); asm volatile("" ::: "memory");
        if (PROBE_HG == 2) hacc += __builtin_amdgcn_s_memrealtime() - th0;
        f32x16 st;
#pragma unroll
        for (int r = 0; r < 16; ++r) st[r] = 0.f;
#pragma unroll
        for (int d0 = 0; d0 < 4; ++d0) { const bf16x8 ka = *(const LAS bf16x8*)(W + HGL_KT + r32 * HGL_ROW + (16 * d0 + 8 * hi) * 2), qb = *(const LAS bf16x8*)(W + HGL_QT + r32 * HGL_ROW + (16 * d0 + 8 * hi) * 2);
            st = __builtin_amdgcn_mfma_f32_32x32x16_bf16(ka, qb, st, 0, 0, 0); }
#pragma unroll
        for (int r = 0; r < 16; ++r) if (crow(r, hi) > r32) st[r] = 0.f;
        u32x4 pst[2];
        pst[0] = (u32x4){cvtpk(st[0], st[1]), cvtpk(st[2], st[3]), cvtpk(st[4], st[5]), cvtpk(st[6], st[7])};
        pst[1] = (u32x4){cvtpk(st[8], st[9]), cvtpk(st[10], st[11]), cvtpk(st[12], st[13]), cvtpk(st[14], st[15])};
        bf16x8 vf[2][2];
#pragma unroll
        for (int s2 = 0; s2 < 2; ++s2)
#pragma unroll
            for (int vb = 0; vb < 2; ++vb) { const LAS unsigned char* vp = W + HGL_V + vb * 2048 + s2 * 1024 + vrd;
                const v4i16_t lo = __builtin_amdgcn_ds_read_tr16_b64_v4i16((LAS v4i16_t*)vp), hv = __builtin_amdgcn_ds_read_tr16_b64_v4i16((LAS v4i16_t*)(vp + 512));
                vf[s2][vb] = (bf16x8){lo[0], lo[1], lo[2], lo[3], hv[0], hv[1], hv[2], hv[3]}; }
        f32x16 oacc[2];
#pragma unroll
        for (int vb = 0; vb < 2; ++vb) {
#pragma unroll
            for (int r = 0; r < 16; ++r) oacc[vb][r] = 0.f;
#pragma unroll
            for (int s2 = 0; s2 < 2; ++s2) oacc[vb] = __builtin_amdgcn_mfma_f32_32x32x16_bf16(__builtin_bit_cast(bf16x8, pst[s2]), vf[s2][vb], oacc[vb], 0, 0, 0);
        }
#pragma unroll
        for (int kst = 0; kst < 4; ++kst) {
            const u32x2 qa = *(const LAS u32x2*)(W + HGL_QT + r32 * HGL_ROW + (16 * kst + 4 * hi) * 2), qc = *(const LAS u32x2*)(W + HGL_QT + r32 * HGL_ROW + (16 * kst + 8 + 4 * hi) * 2);
            const bf16x8 qf = __builtin_bit_cast(bf16x8, (u32x4){qa.x, qa.y, qc.x, qc.y});
#pragma unroll
            for (int vb = 0; vb < 2; ++vb) { const f32x16& S = Sacc[kst >> 1][vb]; const int o8 = 8 * (kst & 1);
                const u32x4 sp = (u32x4){cvtpk(S[o8 + 0], S[o8 + 1]), cvtpk(S[o8 + 2], S[o8 + 3]), cvtpk(S[o8 + 4], S[o8 + 5]), cvtpk(S[o8 + 6], S[o8 + 7])};
                oacc[vb] = __builtin_amdgcn_mfma_f32_32x32x16_bf16(qf, __builtin_bit_cast(bf16x8, sp), oacc[vb], 0, 0, 0); }
        }
#pragma unroll
        for (int vb = 0; vb < 2; ++vb)
#pragma unroll
            for (int r = 0; r < 16; ++r) { const int t = crow(r, hi); *(float*)((t < nmax ? or8 + (size_t)(((r & 3) + 8 * (r >> 2)) * 1024 + vb * 128) + lof : dmy8 + 4 * lane)) = oacc[vb][r]; }
#pragma unroll
        for (int kb = 0; kb < 2; ++kb) {
            float pe[16];
#pragma unroll
            for (int g = 0; g < 4; ++g) { const f32x4 p4 = *(const LAS f32x4*)(W + HGL_PE + (32 * kb + 8 * g + 4 * hi) * 4); pe[4 * g] = p4[0]; pe[4 * g + 1] = p4[1]; pe[4 * g + 2] = p4[2]; pe[4 * g + 3] = p4[3]; }
            bf16x8 kf[2];
#pragma unroll
            for (int s2 = 0; s2 < 2; ++s2) { const LAS unsigned char* kp = W + HGL_KP + kb * 2048 + s2 * 1024 + vrd;
                const v4i16_t lo = __builtin_amdgcn_ds_read_tr16_b64_v4i16((LAS v4i16_t*)kp), hv = __builtin_amdgcn_ds_read_tr16_b64_v4i16((LAS v4i16_t*)(kp + 512));
                kf[s2] = (bf16x8){lo[0], lo[1], lo[2], lo[3], hv[0], hv[1], hv[2], hv[3]}; }
#pragma unroll
            for (int vb = 0; vb < 2; ++vb) {
#pragma unroll
                for (int r = 0; r < 16; ++r) Sacc[kb][vb][r] *= pe[r];
#pragma unroll
                for (int s2 = 0; s2 < 2; ++s2) Sacc[kb][vb] = __builtin_amdgcn_mfma_f32_32x32x16_bf16(kf[s2], vf[s2][vb], Sacc[kb][vb], 0, 0, 0);
            }
        }
        LDS_WAIT(); asm volatile("" ::: "memory");
        tb += n;
    }
    char* send8 = (char*)((float*)(F.ws + WS_SEND2) + (size_t)(bh * HG_NSEG + seg) * 4096);
    const unsigned lsf = (unsigned)(4 * hi * 64 + r32) * 4u;
#pragma unroll
    for (int kb = 0; kb < 2; ++kb)
#pragma unroll
        for (int vb = 0; vb < 2; ++vb)
#pragma unroll
            for (int r = 0; r < 16; ++r) *(float*)(send8 + (size_t)((32 * kb + (r & 3) + 8 * (r >> 2)) * 256 + vb * 128) + lsf) = Sacc[kb][vb][r];
    ((float*)(F.ws + WS_PSEG))[(bh * HG_NSEG + seg) * 64 + lane] = Pseg;
    return hacc;
}
__device__ __forceinline__ void hg_fix_phase(const Frame& F, int l) {
    const int lane = F.lane, r16 = lane & 15, q4 = lane >> 4, tid = F.tid;
    LAS bf16_t* ST = (LAS bf16_t*)(F.lds);
    const float* oraw = (const float*)(F.ws + WS_ORAW); const bf16_t* proj = (const bf16_t*)(F.ws + WS_PA); bf16_t* mixed = (bf16_t*)(F.ws + WS_MIXED);
    const bf16_t* QE = (const bf16_t*)(F.ws + WS_QE); const float* SEND = (const float*)(F.ws + WS_SEND2); const float* PSEG = (const float*)(F.ws + WS_PSEG);
    for (int uu = F.bid; uu < 32 * (HG_NSEG / 4) * DUP(7); uu += F.G) {
        const int u = uu % (32 * (HG_NSEG / 4)), grp = u & 7, bh = u >> 3, b = bh >> 2, hd = bh & 3;
        const int k = tid >> 3, v8 = (tid & 7) * 8; float S[8];
#pragma unroll
        for (int i = 0; i < 8; ++i) S[i] = 0.f;
#pragma unroll 4
        for (int sp = 0; sp < 4 * grp; ++sp) { const float P = PSEG[(bh * HG_NSEG + sp) * 64 + k]; const float* se = SEND + ((size_t)(bh * HG_NSEG + sp) * 64 + k) * 64 + v8;
            const f32x4 a = *(const f32x4*)se, c = *(const f32x4*)(se + 4);
            S[0] = P * S[0] + a[0]; S[1] = P * S[1] + a[1]; S[2] = P * S[2] + a[2]; S[3] = P * S[3] + a[3]; S[4] = P * S[4] + c[0]; S[5] = P * S[5] + c[1]; S[6] = P * S[6] + c[2]; S[7] = P * S[7] + c[3]; }
#pragma unroll 1
        for (int sq = 0; sq < 4; ++sq) {
            const int seg = 4 * grp + sq;
            const float Pn = PSEG[(bh * HG_NSEG + seg) * 64 + k]; const float* sen = SEND + ((size_t)(bh * HG_NSEG + seg) * 64 + k) * 64 + v8;
            const f32x4 an = *(const f32x4*)sen, cn4 = *(const f32x4*)(sen + 4);
            u32x4 qev[2];
#pragma unroll
            for (int kst = 0; kst < 2; ++kst) qev[kst] = *(const u32x4*)(QE + ((size_t)b * SEQ + seg * HG_SEG + F.wave * 16 + r16) * 256 + hd * 64 + 32 * kst + 8 * q4);
            if (seg > 0) {
#pragma unroll
                for (int i = 0; i < 8; ++i) ST[(v8 + i) * 72 + k] = f2bf(S[i]);
            }
            __syncthreads();
            {
                const size_t tok0 = (size_t)b * SEQ + seg * HG_SEG + F.wave * 16;
                f32x4 acc[4];
#pragma unroll
                for (int vb = 0; vb < 4; ++vb) acc[vb] = (f32x4){0.f, 0.f, 0.f, 0.f};
                if (seg > 0) {
#pragma unroll
                    for (int kst = 0; kst < 2; ++kst) { const bf16x8 af = __builtin_bit_cast(bf16x8, qev[kst]);
#pragma unroll
                        for (int vb = 0; vb < 4; ++vb) { const bf16x8 bfv = *(const LAS bf16x8*)(ST + (vb * 16 + r16) * 72 + 32 * kst + 8 * q4); acc[vb] = __builtin_amdgcn_mfma_f32_16x16x32_bf16(af, bfv, acc[vb], 0, 0, 0); } }
                }
                float ov[4][4], gv[4][4];
#pragma unroll
                for (int vb = 0; vb < 4; ++vb)
#pragma unroll
                    for (int r = 0; r < 4; ++r) { const size_t tok = tok0 + 4 * q4 + r; ov[vb][r] = oraw[tok * 256 + hd * 64 + vb * 16 + r16]; gv[vb][r] = bf2f(proj[tok * NPROJ + C_GG + hd * 64 + vb * 16 + r16]); }
                __builtin_amdgcn_sched_barrier(0);
                float ss[4] = {0.f, 0.f, 0.f, 0.f};
#pragma unroll
                for (int vb = 0; vb < 4; ++vb)
#pragma unroll
                    for (int r = 0; r < 4; ++r) { const float x = acc[vb][r] + ov[vb][r]; acc[vb][r] = x; ss[r] += x * x; }
#pragma unroll
                for (int r = 0; r < 4; ++r) { float t = ss[r]; t += __shfl_xor(t, 1); t += __shfl_xor(t, 2); t += __shfl_xor(t, 4); t += __shfl_xor(t, 8); ss[r] = 1.0f / sqrtf(t * (1.0f / 64.0f) + RMS_EPS); }
#pragma unroll
                for (int vb = 0; vb < 4; ++vb) { const float gn = inp(F, I_hgrn_gain)[l * 256 + hd * 64 + vb * 16 + r16];
#pragma unroll
                    for (int r = 0; r < 4; ++r) { const size_t tok = tok0 + 4 * q4 + r; const float g = gv[vb][r];
                        const float si = g * __builtin_amdgcn_rcpf(1.0f + __builtin_amdgcn_exp2f(-LOG2E * g)); mixed[tok * D + 512 + hd * 64 + vb * 16 + r16] = f2bf(acc[vb][r] * ss[r] * gn * si); } }
            }
            __syncthreads();
            S[0] = Pn * S[0] + an[0]; S[1] = Pn * S[1] + an[1]; S[2] = Pn * S[2] + an[2]; S[3] = Pn * S[3] + an[3]; S[4] = Pn * S[4] + cn4[0]; S[5] = Pn * S[5] + cn4[1]; S[6] = Pn * S[6] + cn4[2]; S[7] = Pn * S[7] + cn4[3];
        }
    }
}
constexpr int PL_ROW = 136, PL_BYTES = 64 * PL_ROW;
static_assert(NWAVES * PL_BYTES <= PH_BYTES, "pool LDS");
template <int W> __device__ __forceinline__ void pool_body(const Frame& F, int l, int b, int g, int seg) {
    const int lane = F.lane, r32 = lane & 31, hi = lane >> 5, t0 = seg * 64;
    LAS unsigned char* PT = F.lds + F.wave * PL_BYTES;
    const char* ub = (const char*)((const bf16_t*)(F.ws + WS_PA) + (size_t)b * SEQ * NPROJ + C_PU + g * 64);
    const unsigned lo2 = (unsigned)lane * 2u;
    float uv[80];
#pragma unroll
    for (int i = 0; i < 80; ++i) { const int t = t0 - 16 + i; const float pv = bf2f(*(const bf16_t*)(ub + (size_t)(t < 0 ? 0 : t) * (NPROJ * 2) + lo2)); uv[i] = (t >= 0) ? pv : 0.f; }
    __builtin_amdgcn_sched_barrier(0);
    float wsum = 0.f;
#pragma unroll
    for (int i = 1; i <= W; ++i) wsum += uv[16 - i];
#pragma unroll
    for (int i = 0; i < 64; ++i) { const float ut = uv[16 + i]; wsum += ut; wsum -= uv[16 + i - W];
        const int t = t0 + i; const float pooled = wsum / (float)((t + 1 < W) ? (t + 1) : W) - ut;
        *(LAS bf16_t*)(PT + i * PL_ROW + lane * 2) = f2bf(pooled); }
    LDS_WAIT(); asm volatile("" ::: "memory");
    const bf16_t* pwt = (const bf16_t*)(F.ws + WS_PWT) + (size_t)(l * 4 + g) * 4096;
    bf16x8 bw[2][4];
#pragma unroll
    for (int db = 0; db < 2; ++db)
#pragma unroll
        for (int st = 0; st < 4; ++st) bw[db][st] = __builtin_bit_cast(bf16x8, *(const u32x4*)(pwt + (32 * db + r32) * 64 + 16 * st + 8 * hi));
    char* ob = (char*)((bf16_t*)(F.ws + WS_MIXED) + ((size_t)b * SEQ + t0) * D + 768 + g * 64);
    const unsigned lof = (unsigned)(4 * hi * D + r32) * 2u;
#pragma unroll
    for (int tb2 = 0; tb2 < 2; ++tb2)
#pragma unroll
        for (int db = 0; db < 2; ++db) {
            f32x16 acc;
#pragma unroll
            for (int r = 0; r < 16; ++r) acc[r] = 0.f;
#pragma unroll
            for (int st = 0; st < 4; ++st) { const bf16x8 af = *(const LAS bf16x8*)(PT + (32 * tb2 + r32) * PL_ROW + (16 * st + 8 * hi) * 2); acc = __builtin_amdgcn_mfma_f32_32x32x16_bf16(af, bw[db][st], acc, 0, 0, 0); }
            const float psc = inp(F, I_pool_scale)[l * 256 + g * 64 + 32 * db + r32];
#pragma unroll
            for (int r = 0; r < 16; ++r) *(bf16_t*)(ob + (size_t)((32 * tb2 + (r & 3) + 8 * (r >> 2)) * D + 32 * db) * 2 + lof) = f2bf(acc[r] * psc);
        }
    LDS_WAIT(); asm volatile("" ::: "memory");
}
__device__ __forceinline__ void pool_unit(const Frame& F, int l, int u) {
    const int seg = u & 63, g = (u >> 6) & 3, b = u >> 8;
    if (g == 0) pool_body<2>(F, l, b, g, seg); else if (g == 1) pool_body<4>(F, l, b, g, seg); else if (g == 2) pool_body<8>(F, l, b, g, seg); else pool_body<16>(F, l, b, g, seg);
}

struct Args { const float* in[18]; float* out; unsigned char* ws; int ph_lo, ph_hi; };
constexpr int N_PHASES = 2 + 8 * NL;

__global__ void __launch_bounds__(NTHREADS, 2) trunk_fwd(Args args) {
    extern __shared__ __attribute__((aligned(16))) unsigned char lds_raw[];
    Frame F;
    F.lds = (LAS unsigned char*)lds_raw; F.ws = args.ws; F.ctl = (unsigned*)(args.ws + WS_CTL); F.out = args.out;
    F.tid = threadIdx.x; F.lane = F.tid & 63; F.wave = __builtin_amdgcn_readfirstlane(F.tid >> 6);
    for (int u = F.tid; u < (LDS_BYTES - LDSCTL_OFF) / 4; u += NTHREADS) ((LAS unsigned*)(F.lds + LDSCTL_OFF))[u] = 0u;
    __syncthreads();
    if (F.tid == 0) {
#pragma unroll
        for (int i = 0; i < 18; ++i) ((LAS unsigned long long*)(F.lds + LDSCTL_OFF + LC_INP))[i] = (unsigned long long)args.in[i];
    }
    __syncthreads();
    const int lo = args.ph_lo, hi = args.ph_hi; const bool use_bar = (hi - lo) > 1;
    XcdBarrier bar; bar.bar = F.ctl + CW_BAR; bar.x = 0; bar.st = nullptr;
    if (use_bar) bar = xcd_barrier_post(F.ctl + CW_BAR, (volatile LAS unsigned*)(F.lds + LDSCTL_OFF + LC_BAR));
#ifndef PHMASK
#define PHMASK 0xFFFF
#endif
#define PM(b) ((PHMASK >> (b)) & 1)
#define FRESH() do { int l_; asm volatile("v_mbcnt_lo_u32_b32 %0, -1, 0\n\tv_mbcnt_hi_u32_b32 %0, -1, %0" : "=v"(l_));     F.lane = l_; F.tid = F.wave * 64 + l_; int b_ = blockIdx.x, g_ = gridDim.x; asm volatile("" : "+s"(b_), "+s"(g_)); F.bid = b_; F.G = g_; } while (0)
#ifndef PROBEMASK
#define PROBEMASK 0
#endif
    unsigned long long probe_acc = 0ull, probe_t0 = 0ull;
#define PB(b) ((PROBEMASK >> (b)) & 1)
#define PROBE_BEGIN(b) do { if (PB(b)) probe_t0 = __builtin_amdgcn_s_memrealtime(); } while (0)
#define PROBE_END(b) do { if (PB(b)) probe_acc += __builtin_amdgcn_s_memrealtime() - probe_t0; } while (0)
#define IN(k) (lo <= (k) && (k) < hi)
#define PTYPE(k) ((k) == 0 ? 0 : (((k) - 1) & 7) + 1)
#define PBS(k) (PB(10) || PB(11 + PTYPE(k)))
#define SEAM(k) do { if (use_bar && (k) + 1 < hi) { if (PBS(k)) probe_t0 = __builtin_amdgcn_s_memrealtime(); int sl_; asm volatile("v_mbcnt_lo_u32_b32 %0, -1, 0\n\tv_mbcnt_hi_u32_b32 %0, -1, %0" : "=v"(sl_)); xcd_barrier(bar, F.wave == 0 && sl_ == 0); if (PBS(k)) probe_acc += __builtin_amdgcn_s_memrealtime() - probe_t0; } } while (0)
    if (IN(0) && PM(0)) { PROBE_BEGIN(0); for (int rep = 0; rep < DUP(5); ++rep) { FRESH(); p0_prologue(F); } PROBE_END(0); SEAM(0); }
    for (int l = 0; l < NL; ++l) {
        const int pb = 1 + 8 * l;
        if (IN(pb + 0) && PM(1)) { FRESH(); PROBE_BEGIN(1); if (l == 0) r_phase<0, false, false>(F, l, inp(F, I_x), F.out); else { if (DUP(6) > 1) r_phase<0, true, false, true>(F, l, F.out, F.out); r_phase<0, true, true>(F, l, F.out, F.out); } PROBE_END(1); SEAM(pb + 0); }
        if (IN(pb + 1) && PM(2)) { FRESH(); PROBE_BEGIN(2);
            cumsum_step(F);
            pg8::StaticOrder S; S.init(T, NPROJ, D, F.G, F.bid, (const bf16_t*)(F.ws + WS_WIN + l * WIN_BYTES)); S.rep = DUP(2);
            pg8::EpiProj E{(bf16_t*)(F.ws + WS_PA), (const float*)(F.ws + WS_RSTD1), F.ctl + CW_KMAX + l * 64 * 16};
            { const unsigned long long ea = pg8::gemm_phase<pg8::EpiProj, pg8::StaticOrder, true>(F.tid, F.lds, (const bf16_t*)(F.ws + WS_HB), D, S, E); if (PROBE_EPI && PROBE_EPI_SEL == 1) probe_acc += ea; }
            PROBE_END(2); SEAM(pb + 1);
        }
        if (IN(pb + 2) && PM(3)) { FRESH(); PROBE_BEGIN(3);
            const int gw = F.bid * NWAVES + F.wave, NGW = F.G * NWAVES;
            if (PB(21)) probe_t0 = __builtin_amdgcn_s_memrealtime();
            for (int u = gw; u < 2048; u += NGW) pool_unit(F, l, u);
            __syncthreads();
            if (PB(21)) probe_acc += __builtin_amdgcn_s_memrealtime() - probe_t0;
            if (PB(22)) probe_t0 = __builtin_amdgcn_s_memrealtime();
            if (F.wave < HG_WAVES) for (int u = F.wave * F.G + F.bid; u < 32 * HG_NSEG * DUP(0); u += HG_WAVES * F.G) { const unsigned long long ha = hg_mfma_unit(F, l, u % (32 * HG_NSEG)); if (PROBE_HG) probe_acc += ha; }
            __syncthreads();
            if (PB(22)) probe_acc += __builtin_amdgcn_s_memrealtime() - probe_t0;
            { LAS int* aq = (LAS int*)(F.lds + LDSCTL_OFF + LC_AQ);
              for (int rep = 0; rep < DUP(1); ++rep)
              for (;;) {
                if (F.tid == 0) aq[0] = (int)__hip_atomic_fetch_add(F.ctl + CW_AQ + 16 * (l + 4 * rep), 1u, __ATOMIC_RELAXED, __HIP_MEMORY_SCOPE_AGENT);
                __syncthreads();
                const int idx = aq[0];
                __syncthreads();
                if (idx >= 1024) break;
                attn_unit(F, l, (idx >> 3) & 7, idx & 7, 15 - (idx >> 6)); } }
            PROBE_END(3); SEAM(pb + 2);
        }
        if (IN(pb + 3) && PM(4)) { FRESH(); PROBE_BEGIN(4); hg_fix_phase(F, l); PROBE_END(4); SEAM(pb + 3); }
        if (IN(pb + 4) && PM(5)) { FRESH(); PROBE_BEGIN(5);
            pg8::StaticOrder S; S.init(T, D, D, F.G, F.bid, (const bf16_t*)(F.ws + WS_WOUT + l * WOUT_BYTES));
            if (DUP(8) > 1) { pg8::EpiOut E0{l == 0 ? inp(F, I_x) : F.out, (float*)(F.ws + WS_Y)}; pg8::gemm_phase<pg8::EpiOut, pg8::StaticOrder, true>(F.tid, F.lds, (const bf16_t*)(F.ws + WS_MIXED), D, S, E0); }
            pg8::EpiOut E{l == 0 ? inp(F, I_x) : F.out, F.out};
            pg8::gemm_phase<pg8::EpiOut, pg8::StaticOrder, true>(F.tid, F.lds, (const bf16_t*)(F.ws + WS_MIXED), D, S, E);
            PROBE_END(5); SEAM(pb + 4);
        }
        if (IN(pb + 5) && PM(6)) { FRESH(); PROBE_BEGIN(6); if (DUP(6) > 1) r_phase<1, false, false, true>(F, l, F.out, F.out); r_phase<1, false, false>(F, l, F.out, F.out); PROBE_END(6); SEAM(pb + 5); }
        if ((IN(pb + 6) && PM(7)) || (IN(pb + 7) && PM(8))) { FRESH();
            LAS int* tb = (LAS int*)(F.lds + LDSCTL_OFF + LC_TB); LAS int* cn = (LAS int*)(F.lds + LDSCTL_OFF + LC_CN);
            if (F.tid < NE) cn[F.tid] = (int)__hip_atomic_load(F.ctl + CW_CUR + (l * NE + F.tid) * 16, __ATOMIC_RELAXED, __HIP_MEMORY_SCOPE_AGENT);
            __syncthreads();
            if (F.tid == 0) { int a = 0; for (int e = 0; e < NE; ++e) { tb[e] = a; a += (cn[e] + 255) >> 8; } tb[NE] = a; }
            __syncthreads();
            const int ntile = tb[NE];
            if (IN(pb + 6) && PM(7)) { PROBE_BEGIN(7);
                typedef pg8::MoeOrder<true, W1E_BYTES, (size_t)256 * D> Ord1; Ord1 S; S.rep = DUP(3); S.nM = ntile; S.nN = 2 * FF / 256; S.nwg = S.nM * S.nN; S.G = F.G; S.c = F.bid; S.Wt = (const char*)(F.ws + WS_W1 + (size_t)l * NE * W1E_BYTES);
                S.tb = tb; S.cn = cn; S.list = (const u32x2*)(F.ws + WS_LIST);
                pg8::EpiGlu E{(unsigned char*)(F.ws + WS_PA), (const u32x2*)(F.ws + WS_LIST), (const float*)(F.ws + WS_B1R) + (size_t)l * NE * 2048};
                pg8::gemm_phase<pg8::EpiGlu, Ord1, true, true>(F.tid, F.lds, F.ws + WS_HB8, D, S, E);
                PROBE_END(7); SEAM(pb + 6);
            }
            if (IN(pb + 7) && PM(8)) { FRESH(); PROBE_BEGIN(8);
                typedef pg8::MoeOrder<false, W2E_BYTES, (size_t)256 * FF> Ord2; Ord2 S; S.rep = DUP(4); S.nM = ntile; S.nN = D / 256; S.nwg = S.nM * S.nN; S.G = F.G; S.c = F.bid; S.Wt = (const char*)(F.ws + WS_W2 + (size_t)l * NE * W2E_BYTES);
                S.tb = tb; S.cn = cn; S.list = (const u32x2*)(F.ws + WS_LIST);
                pg8::EpiDown E{(unsigned char*)(F.ws + WS_Y), (const u32x2*)(F.ws + WS_LIST), (const float*)(F.ws + WS_GLIST), inp(F, I_b2) + (size_t)l * NE * D};
                { const unsigned long long ea = pg8::gemm_phase<pg8::EpiDown, Ord2, true, true>(F.tid, F.lds, F.ws + WS_PA, FF, S, E); if (PROBE_EPI && PROBE_EPI_SEL == 3) probe_acc += ea; }
                PROBE_END(8); SEAM(pb + 7);
            }
        }
    }
    if (IN(N_PHASES - 1) && PM(9)) { FRESH(); PROBE_BEGIN(9); r_final(F); PROBE_END(9); }
#ifndef PROBE_BLOCK
#define PROBE_BLOCK 0
#endif
    if ((PROBEMASK != 0 || PROBE_EPI || PROBE_HG) && blockIdx.x == PROBE_BLOCK) { const unsigned long long tw = __builtin_amdgcn_s_memrealtime(); while (__builtin_amdgcn_s_memrealtime() - tw < probe_acc) __builtin_amdgcn_s_sleep(8); }
#undef IN
#undef SEAM
}

extern "C" void kernel_launch(void* const* d_in, const int* in_sizes, int n_in, void* d_out, int out_size, void* d_ws, size_t ws_size, hipStream_t stream) {
    static int grid = 0;
    if (grid == 0) {
        if (n_in != 18 || out_size != T * D || ws_size < WS_END) { fprintf(stderr, "kernel_launch: unexpected shapes (n_in %d out %d ws %zu need %zu)\n", n_in, out_size, ws_size, (size_t)WS_END); grid = -1; return; }
        int dev = 0, cus = 0;
        if (hipGetDevice(&dev) != hipSuccess || hipDeviceGetAttribute(&cus, hipDeviceAttributeMultiprocessorCount, dev) != hipSuccess) { grid = -1; return; }
        if (hipFuncSetAttribute((const void*)trunk_fwd, hipFuncAttributeMaxDynamicSharedMemorySize, LDS_BYTES) != hipSuccess) { fprintf(stderr, "kernel_launch: hipFuncSetAttribute failed\n"); grid = -1; return; }
        int per_cu = 0;
        if (hipOccupancyMaxActiveBlocksPerMultiprocessor(&per_cu, (const void*)trunk_fwd, NTHREADS, LDS_BYTES) != hipSuccess || per_cu < 1) { fprintf(stderr, "kernel_launch: occupancy query says %d\n", per_cu); (void)hipGetLastError(); }
        grid = cus;
    }
    if (grid < 0) return;
    (void)hipMemsetAsync((char*)d_ws + WS_CTL, 0, CTL_ZERO_BYTES, stream);
    Args a{};
    for (int i = 0; i < 18; ++i) a.in[i] = (const float*)d_in[i];
    a.out = (float*)d_out; a.ws = (unsigned char*)d_ws;
#if MK_SPLIT
    for (int p = 0; p < N_PHASES; ++p) { a.ph_lo = p; a.ph_hi = p + 1; hipLaunchKernelGGL(trunk_fwd, dim3(grid), dim3(NTHREADS), LDS_BYTES, stream, a); }
#else
    a.ph_lo = 0; a.ph_hi = N_PHASES; hipLaunchKernelGGL(trunk_fwd, dim3(grid), dim3(NTHREADS), LDS_BYTES, stream, a);
#endif
}
```

```cpp
#include <hip/hip_runtime.h>
#include <cstdio>
#include <cstdint>

#ifndef MK_SPLIT
#define MK_SPLIT 0
#endif

#ifndef DUPMASK
#define DUPMASK 0
#endif
#define DUP(b) (1 + ((DUPMASK >> (b)) & 1))
#define LAS __attribute__((address_space(3)))
#define GAS __attribute__((address_space(1)))
typedef unsigned short bf16_t;
typedef short bf16x8 __attribute__((ext_vector_type(8)));
typedef float f32x4 __attribute__((ext_vector_type(4)));
typedef float f32x2 __attribute__((ext_vector_type(2)));
typedef float f32x16 __attribute__((ext_vector_type(16)));
typedef unsigned u32x4 __attribute__((ext_vector_type(4)));
typedef unsigned u32x2 __attribute__((ext_vector_type(2)));
typedef __bf16 bf16x2_t __attribute__((ext_vector_type(2)));
typedef short v4i16_t __attribute__((ext_vector_type(4)));
typedef int v8i __attribute__((ext_vector_type(8)));
struct bf16x8_pair { bf16x8 a, b; };

constexpr int NB = 8, SEQ = 4096, T = NB * SEQ, D = 1024, NL = 4;
constexpr int NPROJ = 2816;
constexpr int C_FQ = 0, C_FK = 512, C_FV = 1024, C_GQ = 1536, C_GF = 1792, C_GI = 2048, C_GG = 2304, C_PU = 2560;
constexpr int IN_COLS = 2824;
constexpr int NE = 32, TOPK = 4, FF = 1024, MROWS = T * TOPK, LISTCAP = MROWS, MAXTILES = MROWS / 256 + NE;
constexpr float RMS_EPS = 1e-5f, LOG2E = 1.4426950408889634f;
constexpr float QSCALE = 0.125f * LOG2E;
constexpr int NWAVES = 8, NTHREADS = 512;

constexpr size_t MiB = 1u << 20;
constexpr size_t WS_CTL = 0, CTL_ZERO_BYTES = 1 * MiB;
constexpr size_t WS_RSTD1 = 1 * MiB, WS_RSTD2 = WS_RSTD1 + 128 * 1024;
constexpr size_t WS_LOGF = 2 * MiB, WS_C2 = 3 * MiB, WS_GATE = 4 * MiB, WS_B1R = 5 * MiB, WS_WFRAG = 6 * MiB, WS_LIST = 8 * MiB;
constexpr size_t WS_WIN = 40 * MiB, WIN_BYTES = (size_t)NPROJ * D * 2;
constexpr size_t WS_WOUT = 62 * MiB, WOUT_BYTES = (size_t)D * D * 2;
constexpr size_t WS_W1 = 70 * MiB, W1E_BYTES = (size_t)2 * FF * D;
constexpr size_t WS_W2 = 582 * MiB, W2E_BYTES = (size_t)D * FF;
constexpr size_t WS_HB8 = 400 * MiB;
constexpr float W1_SCALE = 64.f, W2_SCALE = 128.f, ACT_SCALE = 4.f, Y_SCALE = 16.f, MIX_SCALE = 16.f, WOUT_SCALE = 256.f;
constexpr size_t WS_HB = 838 * MiB;
constexpr size_t WS_PA = 902 * MiB;
constexpr size_t WS_MIXED = WS_PA + 176 * MiB;
constexpr size_t WS_Y = 1174 * MiB;
constexpr size_t WS_ORAW = 1430 * MiB;
constexpr size_t WS_SEND = 1558 * MiB;
constexpr size_t WS_PSEG = 1566 * MiB;
constexpr size_t WS_QE = 1567 * MiB;
constexpr size_t WS_PWT = 1583 * MiB;
constexpr size_t WS_SEND2 = 1584 * MiB;
constexpr size_t WS_GLIST = 1600 * MiB;
constexpr size_t WS_END = 1616 * MiB;
static_assert(WS_WIN + NL * WIN_BYTES <= WS_WOUT && WS_WOUT + NL * WOUT_BYTES <= WS_W1 && WS_W1 + (size_t)NL * NE * W1E_BYTES <= WS_W2 && WS_W2 + (size_t)NL * NE * W2E_BYTES <= WS_HB, "ws map");
static_assert((size_t)MAXTILES * 256 * FF * 2 <= 272 * MiB && (size_t)T * NPROJ * 2 <= 176 * MiB, "ws map 2");
constexpr int CW_TMO = 0, CW_BAR = 4096, CW_CUR = 16384, CW_KMAX = 32768, CW_AQ = 40960, CW_PQ = 45056;
constexpr int PH_BYTES = 139264, LDSCTL_OFF = PH_BYTES, SLICE_OFF = PH_BYTES + 2048, SLICE_BYTES = 3072, UT_OFF = SLICE_OFF + 2 * SLICE_BYTES, UT_MAX = 64, LDS_BYTES = UT_OFF + UT_MAX * 32;
static_assert(PH_BYTES >= 131072 + 512 * 16, "GEMM phase: stage buffers + parked A offsets");
constexpr int LC_BAR = 0, LC_TB = 64, LC_CN = 256, LC_R2CNT = 512, LC_R2BASE = 640, LC_STOP = 768, LC_SCAN = 896, LC_INP = 1024, LC_AQ = 1280, LC_PQ = 1296, LC_TE = 1312;

__device__ __forceinline__ unsigned cvtpk(float lo, float hi) { f32x2 v = {lo, hi}; bf16x2_t b = __builtin_convertvector(v, bf16x2_t); return __builtin_bit_cast(unsigned, b); }
__device__ __forceinline__ float bflo(unsigned w) { return __uint_as_float(w << 16); }
__device__ __forceinline__ float bfhi(unsigned w) { return __uint_as_float(w & 0xffff0000u); }
__device__ __forceinline__ float bf2f(bf16_t h) { return __uint_as_float((unsigned)h << 16); }
__device__ __forceinline__ bf16_t f2bf(float f) { return (bf16_t)(cvtpk(f, 0.f) & 0xffffu); }
__device__ __forceinline__ float rdlane(float v, int l) { return __uint_as_float((unsigned)__builtin_amdgcn_readlane((int)__float_as_uint(v), l)); }
__device__ __forceinline__ unsigned pk4_fp8(float a, float b, float c, float d) { int w = __builtin_amdgcn_cvt_pk_fp8_f32(a, b, 0, false); w = __builtin_amdgcn_cvt_pk_fp8_f32(c, d, w, true); return (unsigned)w; }
__device__ __forceinline__ unsigned pk4_fp8_sat(float a, float b, float c, float d) {
    return pk4_fp8(__builtin_amdgcn_fmed3f(a, -448.f, 448.f), __builtin_amdgcn_fmed3f(b, -448.f, 448.f), __builtin_amdgcn_fmed3f(c, -448.f, 448.f), __builtin_amdgcn_fmed3f(d, -448.f, 448.f)); }
__device__ __forceinline__ f32x4 un4_fp8(unsigned w) { const f32x2 a = __builtin_amdgcn_cvt_pk_f32_fp8((int)w, false), b = __builtin_amdgcn_cvt_pk_f32_fp8((int)w, true); return (f32x4){a.x, a.y, b.x, b.y}; }
#define LDS_WAIT() asm volatile("s_waitcnt lgkmcnt(0)" ::: "memory")
#define VM_WAIT() asm volatile("s_waitcnt vmcnt(0)" ::: "memory")

namespace pg8 {
constexpr int BM = 256, BK = 64, HALF = 128, HTB = HALF * BK * 2, STAGE_BYTES = 8 * HTB, NXCD = 8, WGM = 8;
__host__ __device__ __forceinline__ int lds_byte(int r, int c) { const int st = (r >> 4) * 2 + (c >> 5), rr = r & 15, cc = c & 31, ob = rr * 64 + cc * 2; return st * 1024 + (ob ^ (((ob >> 9) & 1) << 5)); }
__host__ __device__ __forceinline__ void stage_rc(int b, int& R, int& C) { const int st = b / 1024, sb = b % 1024, swz = sb ^ (((sb >> 9) & 1) << 5); R = (st >> 1) * 16 + swz / 64; C = (st & 1) * 32 + (swz % 64) / 2; }
__host__ __device__ __forceinline__ int f8g(int r) { return ((r >> 1) & 1) | (((r >> 3) & 1) << 2); }
__host__ __device__ __forceinline__ void stage_rc8(int b, int& R, int& C) { const int blk = b / 2048, p = (b % 2048) / 16, r = p >> 3, kc = (p & 7) ^ f8g(r); R = blk * 16 + r; C = kc * 8; }
template <bool FP8> __host__ __device__ __forceinline__ void stage_rcx(int b, int& R, int& C) { if (FP8) stage_rc8(b, R, C); else stage_rc(b, R, C); }
__host__ __device__ __forceinline__ int perm32(int rho) { const int n = rho >> 4, i = rho & 15; return 8 * (i >> 2) + 4 * n + (i & 3); }

struct Unit { int pm, pn, e, lt, cnt; };

__device__ __forceinline__ void tile_of(int L, int nM, int nN, int& pm, int& pn) {
    const int nwg = nM * nN; int wgid = L;
    { const int q = nwg / NXCD, r = nwg % NXCD, xcd = wgid % NXCD, off = wgid / NXCD; wgid = (xcd < r ? xcd * (q + 1) : r * (q + 1) + (xcd - r) * q) + off; }
    const int nig = WGM * nN, gid = wgid / nig, fm = gid * WGM, gsz = (nM - fm) < WGM ? (nM - fm) : WGM;
    pm = fm + ((wgid % nig) % gsz); pn = (wgid % nig) / gsz;
}
struct StaticOrder {
    static constexpr bool GSLICE = false, ZC = false;
    int nM, nN, nwg, G, c, rep = 1; const char* Bt; size_t tstep;
    __device__ void init(int M, int N, int K, int G_, int c_, const bf16_t* Bt_) { nM = M / BM; nN = N / BM; nwg = nM * nN; G = G_; c = c_; Bt = (const char*)Bt_; tstep = (size_t)BM * K * 2; }
    __device__ __forceinline__ bool next_v(int i, Unit& u) const { u.pm = -1; u.pn = 0; u.e = 0; u.lt = 0; u.cnt = 0; long L = (long)i * G + c; if (L >= (long)nwg * rep) return false; L %= nwg; tile_of((int)L, nM, nN, u.pm, u.pn); return true; }
    __device__ __forceinline__ const char* bbase(const Unit& u) const { return Bt + (size_t)u.pn * tstep; }
    __device__ __forceinline__ int arow_pos(const Unit& u, int r) const { return u.pm * BM + r; }
    __device__ __forceinline__ int arow_fetch(const Unit&, int pos) const { return pos; }
};
template <bool GATHER, size_t ESTRIDE, size_t TSTEP> struct MoeOrder {
    static constexpr size_t estride = ESTRIDE, tstep = TSTEP;
    static constexpr bool ZC = true;
    static constexpr bool GSLICE = GATHER;
    __device__ __forceinline__ void fill_rows(const Unit& u, int wid, int lane, LAS unsigned char* dst) const {
        if (wid < 4) { const int pos = u.lt * BM + wid * 64 + lane, pc = pos < u.cnt ? pos : u.cnt - 1;
            __builtin_amdgcn_global_load_lds((const unsigned*)((const char*)(list + (size_t)u.e * LISTCAP) + (unsigned)pc * 8u), (LAS unsigned*)(dst + wid * 256), 4, 0, 0); } }
    int nM, nN, nwg, G, c, rep = 1; const char* Wt; LAS const int* tb; LAS const int* cn; LAS const unsigned char* te; const u32x2* list;
    __device__ __forceinline__ bool next_v(int i, Unit& u) const {
        u.pm = -1; u.pn = 0; u.e = 0; u.lt = 0; u.cnt = 0;
        long L = (long)i * G + (c + i) % G; if (L >= (long)nwg * rep) return false; L %= nwg; tile_of((int)L, nM, nN, u.pm, u.pn);
        const int e = (int)te[u.pm]; u.e = e; u.lt = u.pm - tb[e]; u.cnt = cn[e]; return true; }
    __device__ __forceinline__ const char* bbase(const Unit& u) const { return Wt + (size_t)u.e * estride + (size_t)u.pn * tstep; }
    __device__ __forceinline__ int arow_pos(const Unit& u, int r) const {
        if (!GATHER) return u.pm * BM + r;
        const int pos = u.lt * BM + r; return pos < u.cnt ? pos : u.cnt - 1; }
    __device__ __forceinline__ int arow_fetch(const Unit& u, int pos) const {
        if (!GATHER) return pos;
        const char* lb = (const char*)(list + (size_t)u.e * LISTCAP);
        return (int)(*(const unsigned*)(lb + (unsigned)pos * 8u) >> 2); }
};

#ifndef PROBE_EPI
#define PROBE_EPI 0
#endif
#ifndef PROBE_EPI_SEL
#define PROBE_EPI_SEL 3
#endif
template <class Epi, class Sched, bool ALIGN_EPI, bool FP8 = false>
__device__ __forceinline__ unsigned long long gemm_phase(const int tid, LAS unsigned char* lds, const void* Abase, const int  , const Sched& S, const Epi& E) {
    constexpr int K = 1024;
    const int wid = __builtin_amdgcn_readfirstlane(tid >> 6), lane = tid & 63, wr = wid >> 2, wc = wid & 3, fr = lane & 15, fq = lane >> 4;
    constexpr int rowB = FP8 ? K : 2 * K;
    constexpr int nt = rowB / (BK * 2);
    unsigned voffB[2];
#pragma unroll
    for (int i = 0; i < 2; ++i) { int R, C; stage_rcx<FP8>(tid * 16 + i * 8192, R, C); const int Rb = Epi::PERM ? ((R & ~31) + perm32(R & 31)) : R; voffB[i] = (unsigned)(Rb * rowB + C * 2); }
    constexpr size_t kstep = (size_t)(BK * 2);
    constexpr size_t hstep = (size_t)HALF * rowB;
    const unsigned ldsw = (unsigned)wid * 1024u;
    const int a8off = (fr * 8 + ((2 * fq) ^ f8g(fr))) * 16;
    const int aoff = FP8 ? (wr * 8192 + a8off) : lds_byte(wr * 64 + fr, fq * 8), boff = FP8 ? (wc * 4096 + a8off) : lds_byte(wc * 32 + fr, fq * 8);
    const int aoffx = wr * 8192 + (a8off ^ 16), boffx = wc * 4096 + (a8off ^ 16);
    const char* A8 = (const char*)Abase;
#define PG8_SA(b, h) (((b) * 2 + (h)) * HTB)
#define PG8_SB(b, h) ((4 + (b) * 2 + (h)) * HTB)
#define PG8_STGB(bufoff, gbase) do { _Pragma("unroll") for (int _i = 0; _i < 2; ++_i) \
        __builtin_amdgcn_global_load_lds((const unsigned*)((const char*)(gbase) + voffB[_i]), (LAS unsigned*)(lds + (bufoff) + ldsw + _i * 8192), 16, 0, 0); } while (0)
#define PG8_STGA(bufoff, kb, o0, o1) do { \
        __builtin_amdgcn_global_load_lds((const unsigned*)(A8 + (size_t)(kb) + (o0)), (LAS unsigned*)(lds + (bufoff) + ldsw), 16, 0, 0); \
        __builtin_amdgcn_global_load_lds((const unsigned*)(A8 + (size_t)(kb) + (o1)), (LAS unsigned*)(lds + (bufoff) + ldsw + 8192), 16, 0, 0); } while (0)
#define PG8_LD8(off, offx) __builtin_bit_cast(v8i, bf16x8_pair{*(const LAS bf16x8*)(lds + (off)), *(const LAS bf16x8*)(lds + (offx))})
#define PG8_LDA(dst, b, h) do { if constexpr (FP8) { _Pragma("unroll") for (int m = 0; m < 4; ++m) dst##8[m] = PG8_LD8(PG8_SA(b, h) + aoff + m * 2048, PG8_SA(b, h) + aoffx + m * 2048); } \
        else { _Pragma("unroll") for (int m = 0; m < 4; ++m) _Pragma("unroll") for (int k = 0; k < 2; ++k) dst[m][k] = *(const LAS bf16x8*)(lds + PG8_SA(b, h) + aoff + m * 2048 + k * 1024); } } while (0)
#define PG8_LDB(dst, b, h) do { if constexpr (FP8) { _Pragma("unroll") for (int n = 0; n < 2; ++n) dst##8[n] = PG8_LD8(PG8_SB(b, h) + boff + n * 2048, PG8_SB(b, h) + boffx + n * 2048); } \
        else { _Pragma("unroll") for (int n = 0; n < 2; ++n) _Pragma("unroll") for (int k = 0; k < 2; ++k) dst[n][k] = *(const LAS bf16x8*)(lds + PG8_SB(b, h) + boff + n * 2048 + k * 1024); } } while (0)
#define PG8_MMA(ai, bj, At, Bt, Z) do { __builtin_amdgcn_s_setprio(1); \
        if (Z) {     \
            _Pragma("unroll") for (int m = 0; m < 4; ++m) _Pragma("unroll") for (int n = 0; n < 2; ++n) { \
                if constexpr (FP8) asm volatile("v_mfma_f32_16x16x128_f8f6f4 %0, %1, %2, 0" : "=v"(acc[ai][bj][m][n]) : "v"(Bt##8[n]), "v"(At##8[m])); \
                else { acc[ai][bj][m][n] = __builtin_amdgcn_mfma_f32_16x16x32_bf16(Bt[n][0], At[m][0], (f32x4){0.f, 0.f, 0.f, 0.f}, 0, 0, 0); acc[ai][bj][m][n] = __builtin_amdgcn_mfma_f32_16x16x32_bf16(Bt[n][1], At[m][1], acc[ai][bj][m][n], 0, 0, 0); } } \
        } else { \
            _Pragma("unroll") for (int m = 0; m < 4; ++m) _Pragma("unroll") for (int n = 0; n < 2; ++n) { \
                if constexpr (FP8) asm volatile("v_mfma_f32_16x16x128_f8f6f4 %0, %1, %2, %0" : "+v"(acc[ai][bj][m][n]) : "v"(Bt##8[n]), "v"(At##8[m]));     \
                else { _Pragma("unroll") for (int k = 0; k < 2; ++k) acc[ai][bj][m][n] = __builtin_amdgcn_mfma_f32_16x16x32_bf16(Bt[n][k], At[m][k], acc[ai][bj][m][n], 0, 0, 0); } } \
        } __builtin_amdgcn_s_setprio(0); } while (0)
#define PG8_WAIT_V(n) asm volatile("s_waitcnt vmcnt(" #n ")" ::: "memory")
#define PG8_WAIT_L(n) asm volatile("s_waitcnt lgkmcnt(" #n ")" ::: "memory")
#define PG8_BAR __builtin_amdgcn_s_barrier()
#define PG8_SCHED __builtin_amdgcn_sched_barrier(0)
#define PG8_AOFF(u, dst) do { int t_ = tid; asm volatile("" : "+v"(t_));     \
        int p_[2][2]; unsigned c_[2][2]; \
        _Pragma("unroll") for (int _h = 0; _h < 2; ++_h) _Pragma("unroll") for (int _i = 0; _i < 2; ++_i) \
        { int R_, C_; stage_rcx<FP8>(t_ * 16 + _i * 8192, R_, C_); p_[_h][_i] = S.arow_pos(u, _h * HALF + R_); c_[_h][_i] = (unsigned)(C_ * 2); } \
        PG8_SCHED;     \
        _Pragma("unroll") for (int _h = 0; _h < 2; ++_h) _Pragma("unroll") for (int _i = 0; _i < 2; ++_i) p_[_h][_i] = S.arow_fetch(u, p_[_h][_i]); \
        PG8_SCHED; \
        _Pragma("unroll") for (int _h = 0; _h < 2; ++_h) _Pragma("unroll") for (int _i = 0; _i < 2; ++_i) dst[_h][_i] = (unsigned)((size_t)p_[_h][_i] * (size_t)rowB + (size_t)c_[_h][_i]); } while (0)
    Unit cur, nxt; int ui = 0; unsigned long long epi_acc = 0ull;
    { int t_ = tid; asm volatile("" : "+v"(t_));
      if (t_ < UT_MAX) { Unit q; (void)S.next_v(t_, q); LAS int* e_ = (LAS int*)(lds + UT_OFF) + t_ * 8; e_[0] = q.pm; e_[1] = q.pn; e_[2] = q.e; e_[3] = q.lt; e_[4] = q.cnt; } }
    asm volatile("s_waitcnt lgkmcnt(0)\n\ts_barrier" ::: "memory");
    auto NEXT = [&](int i, Unit& u) -> bool {
        if (i < UT_MAX) { const unsigned a_ = (unsigned)(unsigned long)(lds + UT_OFF) + (unsigned)i * 32u; u32x4 v_; unsigned c_;
            asm volatile("ds_read_b128 %0, %2\n\tds_read_b32 %1, %2 offset:16\n\ts_waitcnt lgkmcnt(0)" : "=&v"(v_), "=&v"(c_) : "v"(a_) : "memory");
            u.pm = __builtin_amdgcn_readfirstlane((int)v_.x); u.pn = __builtin_amdgcn_readfirstlane((int)v_.y); u.e = __builtin_amdgcn_readfirstlane((int)v_.z); u.lt = __builtin_amdgcn_readfirstlane((int)v_.w); u.cnt = __builtin_amdgcn_readfirstlane((int)c_);
            return u.pm >= 0; }
        const bool ok_ = S.next_v(i, u); u.pm = __builtin_amdgcn_readfirstlane(u.pm); u.pn = __builtin_amdgcn_readfirstlane(u.pn); u.e = __builtin_amdgcn_readfirstlane(u.e); u.lt = __builtin_amdgcn_readfirstlane(u.lt); u.cnt = __builtin_amdgcn_readfirstlane(u.cnt);
        return u.pm >= 0 && ok_; };
    if (!NEXT(0, cur)) return 0ull;
    f32x4 acc[2][2][4][2];
    if constexpr (!Sched::ZC) {
#pragma unroll
        for (int a = 0; a < 2; ++a)
#pragma unroll
            for (int b = 0; b < 2; ++b)
#pragma unroll
                for (int m = 0; m < 4; ++m)
#pragma unroll
                    for (int n = 0; n < 2; ++n) acc[a][b][m][n] = (f32x4){0.f, 0.f, 0.f, 0.f}; }
    bf16x8 At[4][2], B0[2][2], B1[2][2]; v8i At8[4], B08[2], B18[2];
    unsigned aoC[2][2], aoN[2][2];
    PG8_AOFF(cur, aoC);
    const char* cB = S.bbase(cur);
    PG8_STGB(PG8_SB(0, 0), cB); PG8_STGB(PG8_SB(0, 1), cB + hstep); PG8_STGA(PG8_SA(0, 0), 0, aoC[0][0], aoC[0][1]); PG8_STGA(PG8_SA(0, 1), 0, aoC[1][0], aoC[1][1]);
    if (wr == 1) PG8_BAR;
    PG8_WAIT_V(2); PG8_BAR;
    PG8_STGB(PG8_SB(1, 0), cB + kstep); PG8_STGA(PG8_SA(1, 0), kstep, aoC[0][0], aoC[0][1]); PG8_STGB(PG8_SB(1, 1), cB + hstep + kstep);
    PG8_WAIT_V(6); PG8_BAR;
    for (;;) {
        if constexpr (Epi::SLICE) { int t3_ = tid; asm volatile("" : "+v"(t3_)); E.fill(cur, wid, t3_ & 63, lds + SLICE_OFF + (ui & 1) * SLICE_BYTES); }
        const bool has_next = NEXT(ui + 1, nxt);
        if constexpr (Sched::GSLICE) {
            if (has_next) { int t4_ = tid; asm volatile("" : "+v"(t4_)); S.fill_rows(nxt, wid, t4_ & 63, lds + SLICE_OFF + ((ui + 1) & 1) * SLICE_BYTES + 1024); }
        } else {
            if (has_next) { PG8_AOFF(nxt, aoN); } else { aoN[0][0] = aoC[0][0]; aoN[0][1] = aoC[0][1]; aoN[1][0] = aoC[1][0]; aoN[1][1] = aoC[1][1]; }
            const unsigned pa_ = (unsigned)(unsigned long)(lds + STAGE_BYTES) + (unsigned)tid * 16u; const u32x4 pv_ = {aoN[0][0], aoN[0][1], aoN[1][0], aoN[1][1]};
            asm volatile("ds_write_b128 %0, %1" :: "v"(pa_), "v"(pv_) : "memory");
        }
        const char* nB = has_next ? S.bbase(nxt) : cB;
        for (int t = 0; t < nt; t += 2) {
            asm volatile("" : "+v"(voffB[0]), "+v"(voffB[1]));
            const bool last = (t == nt - 2);
            const size_t k1 = (size_t)(t + 1) * kstep, k2 = last ? 0 : (size_t)(t + 2) * kstep, k3 = k2 + kstep;
            const char* b2 = last ? nB : cB + (size_t)(t + 2) * kstep; const char* b3 = b2 + kstep;
            PG8_LDB(B0, 0, 0); PG8_LDB(B1, 0, 1); PG8_SCHED; PG8_LDA(At, 0, 0); PG8_STGA(PG8_SA(1, 1), k1, aoC[1][0], aoC[1][1]);
            PG8_WAIT_V(8); PG8_WAIT_L(0); PG8_BAR; PG8_MMA(0, 0, At, B0, Sched::ZC && t == 0); PG8_MMA(0, 1, At, B1, Sched::ZC && t == 0); PG8_BAR; PG8_SCHED;
            if (last) {
                if constexpr (Sched::GSLICE) {
                    if (has_next) { int t_ = tid; asm volatile("" : "+v"(t_)); int R0_, C0_, R1_, C1_; stage_rcx<FP8>(t_ * 16, R0_, C0_); stage_rcx<FP8>(t_ * 16 + 8192, R1_, C1_);
                        const unsigned sb_ = (unsigned)(unsigned long)(lds + SLICE_OFF + ((ui + 1) & 1) * SLICE_BYTES + 1024), a0_ = sb_ + 4u * (unsigned)R0_, a1_ = sb_ + 4u * (unsigned)R1_; unsigned e00, e01, e10, e11;
                        asm volatile("ds_read_b32 %0, %4\n\tds_read_b32 %1, %5\n\tds_read_b32 %2, %4 offset:512\n\tds_read_b32 %3, %5 offset:512\n\ts_waitcnt lgkmcnt(0)" : "=&v"(e00), "=&v"(e01), "=&v"(e10), "=&v"(e11) : "v"(a0_), "v"(a1_) : "memory");
                        aoC[0][0] = (e00 >> 2) * (unsigned)rowB + (unsigned)(C0_ * 2); aoC[0][1] = (e01 >> 2) * (unsigned)rowB + (unsigned)(C1_ * 2);
                        aoC[1][0] = (e10 >> 2) * (unsigned)rowB + (unsigned)(C0_ * 2); aoC[1][1] = (e11 >> 2) * (unsigned)rowB + (unsigned)(C1_ * 2); }
                } else { const unsigned pa_ = (unsigned)(unsigned long)(lds + STAGE_BYTES) + (unsigned)tid * 16u; u32x4 nx; asm volatile("ds_read_b128 %0, %1\n\ts_waitcnt lgkmcnt(0)" : "=v"(nx) : "v"(pa_) : "memory"); aoC[0][0] = nx.x; aoC[0][1] = nx.y; aoC[1][0] = nx.z; aoC[1][1] = nx.w; }
            }
            PG8_LDA(At, 0, 1); PG8_STGB(PG8_SB(0, 0), b2); PG8_STGB(PG8_SB(0, 1), b2 + hstep); PG8_STGA(PG8_SA(0, 0), k2, aoC[0][0], aoC[0][1]);
            PG8_WAIT_V(8); PG8_WAIT_L(0); PG8_BAR; PG8_MMA(1, 0, At, B0, Sched::ZC && t == 0); PG8_MMA(1, 1, At, B1, Sched::ZC && t == 0); PG8_BAR; PG8_SCHED;
            PG8_LDB(B0, 1, 0); PG8_LDB(B1, 1, 1); PG8_SCHED; PG8_LDA(At, 1, 0); PG8_STGA(PG8_SA(0, 1), k2, aoC[1][0], aoC[1][1]);
            PG8_WAIT_V(8); PG8_WAIT_L(0); PG8_BAR; PG8_MMA(0, 0, At, B0, false); PG8_MMA(0, 1, At, B1, false); PG8_BAR; PG8_SCHED;
            PG8_LDA(At, 1, 1); PG8_STGB(PG8_SB(1, 0), b3); PG8_STGB(PG8_SB(1, 1), b3 + hstep); PG8_STGA(PG8_SA(1, 0), k3, aoC[0][0], aoC[0][1]);
            PG8_WAIT_V(8); PG8_WAIT_L(0); PG8_BAR; PG8_MMA(1, 0, At, B0, false); PG8_MMA(1, 1, At, B1, false); PG8_BAR; PG8_SCHED;
        }
        if constexpr (FP8) asm volatile("s_nop 15\n\ts_nop 15" ::: "memory");
        const unsigned long long te0 = PROBE_EPI ? __builtin_amdgcn_s_memrealtime() : 0ull;
        if constexpr (ALIGN_EPI) { if (wr == 0) PG8_BAR; }
        { int t2_ = tid; asm volatile("" : "+v"(t2_)); const int l2_ = t2_ & 63; E(acc, cur, wr, wc, l2_ & 15, l2_ >> 4, lds + SLICE_OFF + (ui & 1) * SLICE_BYTES); }
        if (PROBE_EPI) { if (PROBE_EPI == 1) asm volatile("s_waitcnt vmcnt(0)" ::: "memory"); epi_acc += __builtin_amdgcn_s_memrealtime() - te0; }
        if (!has_next) break;
        if constexpr (!Sched::ZC) {
#pragma unroll
            for (int a = 0; a < 2; ++a)
#pragma unroll
                for (int b = 0; b < 2; ++b)
#pragma unroll
                    for (int m = 0; m < 4; ++m)
#pragma unroll
                        for (int n = 0; n < 2; ++n) acc[a][b][m][n] = (f32x4){0.f, 0.f, 0.f, 0.f}; }
        cur = nxt; cB = nB; ++ui;
        if constexpr (ALIGN_EPI) { if (wr == 1) PG8_BAR; }
    }
    PG8_WAIT_V(0);
    if constexpr (!ALIGN_EPI) { if (wr == 0) PG8_BAR; }
    PG8_BAR;
    return epi_acc;
#undef PG8_SA
#undef PG8_SB
#undef PG8_STGA
#undef PG8_STGB
#undef PG8_LDA
#undef PG8_LD8
#undef PG8_LDB
#undef PG8_MMA
#undef PG8_WAIT_V
#undef PG8_WAIT_L
#undef PG8_BAR
#undef PG8_SCHED
#undef PG8_AOFF
}

struct EpiProj {
    static constexpr bool PERM = true, SLICE = true;
    bf16_t* O; const float* rstd; unsigned* kmax;
    __device__ __forceinline__ void fill(const Unit& u, int wid, int lane, LAS unsigned char* sl) const {
        if (wid < 4) __builtin_amdgcn_global_load_lds((const unsigned*)((const char*)(rstd + u.pm * BM + wid * 64) + (unsigned)lane * 4u), (LAS unsigned*)(sl + wid * 256), 4, 0, 0); }
    __device__ __forceinline__ void operator()(const f32x4 (&acc)[2][2][4][2], const Unit& u, int wr, int wc, int fr, int fq, LAS unsigned char* sl) const {
        const int row0 = u.pm * BM + wr * 64 + fr, col0 = u.pn * BM + wc * 32 + 8 * fq;
        const float sc = (u.pn < 2) ? QSCALE : 1.f; const bool isk = (u.pn == 2 || u.pn == 3);
        float km[2] = {0.f, 0.f}; float rsv[8];
        { float r0, r1, r2, r3, r4, r5, r6, r7; const unsigned ra = (unsigned)(unsigned long)sl + 4u * (unsigned)(wr * 64 + fr);
          asm volatile("ds_read_b32 %0, %8\n\tds_read_b32 %1, %8 offset:64\n\tds_read_b32 %2, %8 offset:128\n\tds_read_b32 %3, %8 offset:192\n\t"
                       "ds_read_b32 %4, %8 offset:512\n\tds_read_b32 %5, %8 offset:576\n\tds_read_b32 %6, %8 offset:640\n\tds_read_b32 %7, %8 offset:704\n\ts_waitcnt lgkmcnt(0)"
                       : "=&v"(r0), "=&v"(r1), "=&v"(r2), "=&v"(r3), "=&v"(r4), "=&v"(r5), "=&v"(r6), "=&v"(r7) : "v"(ra) : "memory");
          rsv[0] = r0 * sc; rsv[1] = r1 * sc; rsv[2] = r2 * sc; rsv[3] = r3 * sc; rsv[4] = r4 * sc; rsv[5] = r5 * sc; rsv[6] = r6 * sc; rsv[7] = r7 * sc; }
#pragma unroll
        for (int ai = 0; ai < 2; ++ai)
#pragma unroll
            for (int m = 0; m < 4; ++m) { const int row = row0 + ai * HALF + m * 16; const float rs = rsv[ai * 4 + m]; bf16_t* rowp = O + (size_t)row * NPROJ + col0;
#pragma unroll
                for (int bj = 0; bj < 2; ++bj) { const f32x4 v0 = acc[ai][bj][m][0] * rs, v1 = acc[ai][bj][m][1] * rs;
                    u32x4 w; w.x = cvtpk(v0[0], v0[1]); w.y = cvtpk(v0[2], v0[3]); w.z = cvtpk(v1[0], v1[1]); w.w = cvtpk(v1[2], v1[3]);
                    *(u32x4*)(rowp + bj * HALF) = w;
                    if (isk) { float s = bflo(w.x) * bflo(w.x) + bfhi(w.x) * bfhi(w.x) + bflo(w.y) * bflo(w.y) + bfhi(w.y) * bfhi(w.y) + bflo(w.z) * bflo(w.z) + bfhi(w.z) * bfhi(w.z) + bflo(w.w) * bflo(w.w) + bfhi(w.w) * bfhi(w.w);
                        s += __shfl_xor(s, 16); s += __shfl_xor(s, 32); km[bj] = fmaxf(km[bj], s); } } }
        if (isk) {
#pragma unroll
            for (int bj = 0; bj < 2; ++bj) { float v = km[bj]; v = fmaxf(v, __shfl_xor(v, 1)); v = fmaxf(v, __shfl_xor(v, 2)); v = fmaxf(v, __shfl_xor(v, 4)); v = fmaxf(v, __shfl_xor(v, 8));
                if ((threadIdx.x & 63) == 0) { const int b = u.pm >> 4, h = (u.pn - 2) * 4 + bj * 2 + (wc >> 1); atomicMax(kmax + (b * 8 + h) * 16, __float_as_uint(v)); } }
        }
    }
};
struct EpiOut {
    static constexpr bool PERM = true, SLICE = false;
    bf16_t* h;
    __device__ __forceinline__ void operator()(const f32x4 (&acc)[2][2][4][2], const Unit& u, int wr, int wc, int fr, int fq, LAS unsigned char* sl) const {
        const int row0 = u.pm * BM + wr * 64 + fr, col0 = u.pn * BM + wc * 32 + 8 * fq;
        u32x4 r[8][2];
#pragma unroll
        for (int g = 0; g < 8; ++g) { const bf16_t* rowp = h + (size_t)(row0 + (g >> 2) * HALF + (g & 3) * 16) * D + col0;
#pragma unroll
            for (int bj = 0; bj < 2; ++bj) r[g][bj] = *(const u32x4*)(rowp + bj * HALF); }
        __builtin_amdgcn_sched_barrier(0);
#pragma unroll
        for (int g = 0; g < 8; ++g) { const int ai = g >> 2, m = g & 3; bf16_t* rowp = h + (size_t)(row0 + ai * HALF + m * 16) * D + col0;
#pragma unroll
            for (int bj = 0; bj < 2; ++bj) { const f32x4 v0 = acc[ai][bj][m][0], v1 = acc[ai][bj][m][1]; const u32x4 q = r[g][bj];
                constexpr float OS = 1.0f / (MIX_SCALE * WOUT_SCALE);
                u32x4 w; w.x = cvtpk(v0[0] * OS + bflo(q.x), v0[1] * OS + bfhi(q.x)); w.y = cvtpk(v0[2] * OS + bflo(q.y), v0[3] * OS + bfhi(q.y)); w.z = cvtpk(v1[0] * OS + bflo(q.z), v1[1] * OS + bfhi(q.z)); w.w = cvtpk(v1[2] * OS + bflo(q.w), v1[3] * OS + bfhi(q.w));
                *(u32x4*)(rowp + bj * HALF) = w; } }
    }
};
struct EpiGlu {
    static constexpr bool PERM = true, SLICE = true;
    unsigned char* act; const u32x2* list; const float* b1r;
    __device__ __forceinline__ void fill(const Unit& u, int wid, int lane, LAS unsigned char* sl) const {
        const int w4 = wid & 3;
        if (wid < 4) { const int pos = u.lt * BM + w4 * 64 + lane, pc = pos < u.cnt ? pos : u.cnt - 1;
            __builtin_amdgcn_global_load_lds((const unsigned*)((const char*)(list + (size_t)u.e * LISTCAP) + (unsigned)pc * 8u + 4u), (LAS unsigned*)(sl + w4 * 256), 4, 0, 0); }
        else __builtin_amdgcn_global_load_lds((const unsigned*)((const char*)(b1r + (size_t)u.e * 2048 + u.pn * BM + w4 * 64) + (unsigned)lane * 4u), (LAS unsigned*)(sl + 2048 + w4 * 256), 4, 0, 0);
    }
    __device__ __forceinline__ void operator()(const f32x4 (&acc)[2][2][4][2], const Unit& u, int wr, int wc, int fr, int fq, LAS unsigned char* sl) const {
        float rsv[8]; unsigned rv0, rv1, rv2, rv3, rv4, rv5, rv6, rv7; f32x4 bg0, bg1, bl0, bl1;
        { const unsigned ra = (unsigned)(unsigned long)sl + 4u * (unsigned)(wr * 64 + fr), ca = (unsigned)(unsigned long)sl + 2048u + 4u * (unsigned)(wc * 32 + 8 * fq);
          asm volatile("ds_read_b32 %0, %12\n\tds_read_b32 %1, %12 offset:64\n\tds_read_b32 %2, %12 offset:128\n\tds_read_b32 %3, %12 offset:192\n\t"
                       "ds_read_b32 %4, %12 offset:512\n\tds_read_b32 %5, %12 offset:576\n\tds_read_b32 %6, %12 offset:640\n\tds_read_b32 %7, %12 offset:704\n\t"
                       "ds_read_b128 %8, %13\n\tds_read_b128 %9, %13 offset:16\n\tds_read_b128 %10, %13 offset:512\n\tds_read_b128 %11, %13 offset:528\n\ts_waitcnt lgkmcnt(0)"
                       : "=&v"(rv0), "=&v"(rv1), "=&v"(rv2), "=&v"(rv3), "=&v"(rv4), "=&v"(rv5), "=&v"(rv6), "=&v"(rv7), "=&v"(bg0), "=&v"(bg1), "=&v"(bl0), "=&v"(bl1) : "v"(ra), "v"(ca) : "memory"); }
        { const unsigned rv[8] = {rv0, rv1, rv2, rv3, rv4, rv5, rv6, rv7};
#pragma unroll
          for (int g = 0; g < 8; ++g) rsv[g] = __uint_as_float(rv[g]) * (1.0f / W1_SCALE); }
#pragma unroll
        for (int ai = 0; ai < 2; ++ai)
#pragma unroll
            for (int m = 0; m < 4; ++m) { const int r = ai * HALF + wr * 64 + m * 16 + fr;
                const float rs = rsv[ai * 4 + m];
                float o[8];
                const f32x2 rs2 = {rs, rs};
#pragma unroll
                for (int p = 0; p < 4; ++p) {
                    const f32x4& ag = acc[ai][0][m][p >> 1]; const f32x4& al = acc[ai][1][m][p >> 1]; const f32x4& bgv = (p >> 1) ? bg1 : bg0; const f32x4& blv = (p >> 1) ? bl1 : bl0; const int q = 2 * (p & 1);
                    f32x2 g = (f32x2){ag[q], ag[q + 1]} * rs2 + (f32x2){bgv[q], bgv[q + 1]}, li = (f32x2){al[q], al[q + 1]} * rs2 + (f32x2){blv[q], blv[q + 1]};
                    g.x = __builtin_fminf(g.x, 7.f); g.y = __builtin_fminf(g.y, 7.f); li.x = __builtin_amdgcn_fmed3f(li.x, -7.f, 7.f); li.y = __builtin_amdgcn_fmed3f(li.y, -7.f, 7.f);
                    const f32x2 ea = g * (-1.702f * LOG2E); f32x2 d; d.x = __builtin_amdgcn_exp2f(ea.x); d.y = __builtin_amdgcn_exp2f(ea.y); d = d + 1.0f;
                    f32x2 rc; rc.x = __builtin_amdgcn_rcpf(d.x); rc.y = __builtin_amdgcn_rcpf(d.y);
                    const f32x2 tt = li * ACT_SCALE + ACT_SCALE, oo = (g * tt) * rc;
                    o[2 * p] = oo.x; o[2 * p + 1] = oo.y; }
                *(u32x2*)(act + (size_t)(u.pm * BM + r) * FF + u.pn * HALF + wc * 32 + 8 * fq) = (u32x2){pk4_fp8(o[0], o[1], o[2], o[3]), pk4_fp8(o[4], o[5], o[6], o[7])}; }
    }
};
struct EpiDown {
    static constexpr bool PERM = true, SLICE = true;
    unsigned char* Y; const u32x2* list; const float* gate; const float* b2;
    __device__ __forceinline__ void fill(const Unit& u, int wid, int lane, LAS unsigned char* sl) const {
        const int w4 = wid & 3; const int pos = u.lt * BM + w4 * 64 + lane, pc = pos < u.cnt ? pos : u.cnt - 1;
        if (wid < 4) {
            __builtin_amdgcn_global_load_lds((const unsigned*)((const char*)(list + (size_t)u.e * LISTCAP) + (unsigned)pc * 8u), (LAS unsigned*)(sl + w4 * 256), 4, 0, 0);
            __builtin_amdgcn_global_load_lds((const unsigned*)((const char*)(b2 + (size_t)u.e * D + u.pn * BM + w4 * 64) + (unsigned)lane * 4u), (LAS unsigned*)(sl + 2048 + w4 * 256), 4, 0, 0); }
        else __builtin_amdgcn_global_load_lds((const unsigned*)((const char*)(gate + (size_t)u.e * LISTCAP) + (unsigned)pc * 4u), (LAS unsigned*)(sl + 1024 + w4 * 256), 4, 0, 0);
    }
    __device__ __forceinline__ void operator()(const f32x4 (&acc)[2][2][4][2], const Unit& u, int wr, int wc, int fr, int fq, LAS unsigned char* sl) const {
        const int cb = u.pn * BM + wc * 32 + 8 * fq;
        f32x4 bv[2][2]; unsigned entv[8]; float gtv[8];
        { unsigned e0, e1, e2, e3, e4, e5, e6, e7, g0, g1, g2, g3, g4, g5, g6, g7;
          const unsigned ra = (unsigned)(unsigned long)sl + 4u * (unsigned)(wr * 64 + fr), ca = (unsigned)(unsigned long)sl + 2048u + 4u * (unsigned)(wc * 32 + 8 * fq);
          asm volatile("ds_read_b32 %0, %20\n\tds_read_b32 %1, %20 offset:64\n\tds_read_b32 %2, %20 offset:128\n\tds_read_b32 %3, %20 offset:192\n\t"
                       "ds_read_b32 %4, %20 offset:512\n\tds_read_b32 %5, %20 offset:576\n\tds_read_b32 %6, %20 offset:640\n\tds_read_b32 %7, %20 offset:704\n\t"
                       "ds_read_b32 %8, %20 offset:1024\n\tds_read_b32 %9, %20 offset:1088\n\tds_read_b32 %10, %20 offset:1152\n\tds_read_b32 %11, %20 offset:1216\n\t"
                       "ds_read_b32 %12, %20 offset:1536\n\tds_read_b32 %13, %20 offset:1600\n\tds_read_b32 %14, %20 offset:1664\n\tds_read_b32 %15, %20 offset:1728\n\t"
                       "ds_read_b128 %16, %21\n\tds_read_b128 %17, %21 offset:16\n\tds_read_b128 %18, %21 offset:512\n\tds_read_b128 %19, %21 offset:528\n\ts_waitcnt lgkmcnt(0)"
                       : "=&v"(e0), "=&v"(e1), "=&v"(e2), "=&v"(e3), "=&v"(e4), "=&v"(e5), "=&v"(e6), "=&v"(e7), "=&v"(g0), "=&v"(g1), "=&v"(g2), "=&v"(g3), "=&v"(g4), "=&v"(g5), "=&v"(g6), "=&v"(g7),
                         "=&v"(bv[0][0]), "=&v"(bv[0][1]), "=&v"(bv[1][0]), "=&v"(bv[1][1]) : "v"(ra), "v"(ca) : "memory");
          const unsigned ev[8] = {e0, e1, e2, e3, e4, e5, e6, e7}, gv[8] = {g0, g1, g2, g3, g4, g5, g6, g7};
#pragma unroll
          for (int g = 0; g < 8; ++g) { const int pos = u.lt * BM + (g >> 2) * HALF + wr * 64 + (g & 3) * 16 + fr; gtv[g] = __uint_as_float(gv[g]) * Y_SCALE; entv[g] = (pos < u.cnt) ? ev[g] : 0xffffffffu; } }
#pragma unroll
        for (int ai = 0; ai < 2; ++ai)
#pragma unroll
            for (int m = 0; m < 4; ++m) {
                if (entv[ai * 4 + m] != 0xffffffffu) { const unsigned ent = entv[ai * 4 + m]; const float gt = gtv[ai * 4 + m]; unsigned char* rowp = Y + (size_t)ent * D + cb;
#pragma unroll
                    for (int bj = 0; bj < 2; ++bj) { const f32x4 v0 = (acc[ai][bj][m][0] * (1.0f / (W2_SCALE * ACT_SCALE)) + bv[bj][0]) * gt, v1 = (acc[ai][bj][m][1] * (1.0f / (W2_SCALE * ACT_SCALE)) + bv[bj][1]) * gt;
                        *(u32x2*)(rowp + bj * HALF) = (u32x2){pk4_fp8_sat(v0[0], v0[1], v0[2], v0[3]), pk4_fp8_sat(v1[0], v1[1], v1[2], v1[3])}; } } }
    }
};
}

#define XB_TMO      128
#define XB_XCNT(j)  (256  + 64 * (j))
#define XB_XSUB(j)  (1280 + 64 * (j))
#define XB_XGEN(j)  (2304 + 64 * (j))
#define XB_TOP      3328
#define XB_TOPGEN   3392
#define XCD_BAR_WORDS 3456
#define XB_SPIN_CAP (1u << 18)
__device__ __forceinline__ unsigned xb_ld(unsigned* p)              { return __hip_atomic_load(p, __ATOMIC_RELAXED, __HIP_MEMORY_SCOPE_AGENT); }
__device__ __forceinline__ unsigned xb_add(unsigned* p, unsigned v) { return __hip_atomic_fetch_add(p, v, __ATOMIC_RELAXED, __HIP_MEMORY_SCOPE_AGENT); }
__device__ __forceinline__ unsigned xb_xcc_id() { return (unsigned)__builtin_amdgcn_s_getreg((3 << 11) | 20) & 0xFu; }
#define XB_SPIN(cond, bar) do { unsigned _sp = 0; while (cond) { __builtin_amdgcn_s_sleep(1); \
    if ((++_sp & 255u) == 0u) { if (xb_ld(&(bar)[XB_TMO])) break; if (_sp > XB_SPIN_CAP) { atomicAdd(&(bar)[XB_TMO], 1u); break; } } } } while (0)
struct XcdBarrier { unsigned* bar; unsigned x; volatile LAS unsigned* st; };
__device__ __forceinline__ XcdBarrier xcd_barrier_post(unsigned* bar, volatile LAS unsigned* st) {
    XcdBarrier b; b.bar = bar; b.x = xb_xcc_id(); b.st = st;
    if (threadIdx.x == 0) (void)xb_add(&bar[XB_XCNT(b.x)], 1u);
    return b;
}
__device__ __forceinline__ void xcd_barrier_complete(unsigned* bar, unsigned x, unsigned& nloc, unsigned& nx) {
    const unsigned G = gridDim.x * gridDim.y * gridDim.z;
    unsigned sum, cnt, mine, sp = 0u;
    for (;;) {
        sum = 0u; cnt = 0u; mine = 0u;
        unsigned cj[16];
        __builtin_amdgcn_sched_barrier(0);
#pragma unroll
        for (unsigned j = 0; j < 16; ++j) cj[j] = xb_ld(&bar[XB_XCNT(j)]);
        __builtin_amdgcn_sched_barrier(0);
#pragma unroll
        for (unsigned j = 0; j < 16; ++j) { const unsigned c = cj[j]; sum += c; cnt += (c > 0u) ? 1u : 0u; mine = (j == x) ? c : mine; }
        if (sum == G) break;
        __builtin_amdgcn_s_sleep(1);
        if ((++sp & 255u) == 0u) { if (xb_ld(&bar[XB_TMO])) break; if (sp > XB_SPIN_CAP) { atomicAdd(&bar[XB_TMO], 1u); break; } }
    }
    nloc = mine > 0u ? mine : 1u; nx = cnt > 0u ? cnt : 1u;
}
__device__ __forceinline__ void xcd_barrier(const XcdBarrier& b, const bool leader  ) {
    asm volatile("s_waitcnt vmcnt(0)" ::: "memory");
    __syncthreads();
    if (leader) {
        unsigned* bar = b.bar;
        __builtin_amdgcn_s_waitcnt(0);
        unsigned nloc = b.st[0], nx = b.st[1];
        if (nloc == 0u) { xcd_barrier_complete(bar, b.x, nloc, nx); b.st[0] = nloc; b.st[1] = nx; }
        const unsigned old = xb_add(&bar[XB_XSUB(b.x)], 1u);
        const unsigned gen = old / nloc;
        if (old + 1u == (gen + 1u) * nloc) {
            __builtin_amdgcn_fence(__ATOMIC_RELEASE, "agent");
            asm volatile("s_waitcnt vmcnt(0)" ::: "memory");
            const unsigned og = xb_add(&bar[XB_TOP], 1u);
            const unsigned tg = og / nx;
            if (og + 1u == (tg + 1u) * nx) xb_add(&bar[XB_TOPGEN], 1u);
            else XB_SPIN(xb_ld(&bar[XB_TOPGEN]) == tg, bar);
            __builtin_amdgcn_fence(__ATOMIC_ACQUIRE, "agent");
            xb_add(&bar[XB_XGEN(b.x)], 1u);
            asm volatile("s_waitcnt vmcnt(0)" ::: "memory");
        } else {
            XB_SPIN(xb_ld(&bar[XB_XGEN(b.x)]) == gen, bar);
            __builtin_amdgcn_fence(__ATOMIC_ACQUIRE, "agent");
            asm volatile("s_waitcnt vmcnt(0)" ::: "memory");
        }
    }
    __syncthreads();
}

enum { I_x = 0, I_norm_mix, I_w_in, I_b_fox_f, I_fox_gain, I_hgrn_lb, I_hgrn_gain, I_pool_w, I_pool_scale, I_w_out, I_norm_moe, I_w_router, I_b_router, I_w1, I_b1, I_w2, I_b2, I_norm_final };
struct Frame {
    LAS unsigned char* lds; unsigned char* ws; unsigned* ctl; float* out;
    int tid, lane, wave, bid, G;
};
__device__ __forceinline__ const float* inp(const Frame& F, int i) {
    const LAS unsigned* p = (const LAS unsigned*)(F.lds + LDSCTL_OFF + LC_INP) + 2 * i;
    const unsigned lo = __builtin_amdgcn_readfirstlane(p[0]), hi = __builtin_amdgcn_readfirstlane(p[1]);
    typedef const float __attribute__((address_space(1))) * gptr_t;
    return (const float*)(gptr_t)(((unsigned long long)hi << 32) | lo);
}

constexpr int P0_ROWB = 272;
struct P0Item { const float* src; const float* g; unsigned char* dst; int ldn, K, drow0, extra, interleaved, out8; float scale; };
__device__ __forceinline__ void p0_load(const P0Item& d, f32x4 (&v)[16], int lane) {
    const float* sp = d.src + (size_t)(lane >> 5) * d.ldn + 4 * (lane & 31);
#pragma unroll
    for (int j = 0; j < 16; ++j) v[j] = __builtin_nontemporal_load((const f32x4*)(sp + (size_t)(2 * j) * d.ldn));
}
constexpr int P0_IMG_ROW = 272, P0_IMG_BYTES = 128 * P0_IMG_ROW;
__device__ __forceinline__ void p0_store(const P0Item& d, f32x4 (&v)[16], LAS unsigned char* tile, LAS unsigned char* img, int wave, int lane) {
    if (d.g) {
#pragma unroll
        for (int j = 0; j < 16; ++j) v[j] = v[j] * (d.g[2 * j + (lane >> 5)] * d.scale);
    } else {
#pragma unroll
        for (int j = 0; j < 16; ++j) v[j] = v[j] * d.scale;
    }
#pragma unroll
    for (int j = 0; j < 16; ++j) { const int k = 2 * j + (lane >> 5); const unsigned w0 = cvtpk(v[j][0], v[j][1]), w1 = cvtpk(v[j][2], v[j][3]);
        if (d.interleaved) { const unsigned gg = (w0 & 0xffffu) | (w1 << 16), ll = (w0 >> 16) | (w1 & 0xffff0000u);
            *(LAS unsigned*)(tile + k * P0_ROWB + 4 * (lane & 31)) = gg; *(LAS unsigned*)(tile + k * P0_ROWB + 128 + 4 * (lane & 31)) = ll; }
        else *(LAS u32x2*)(tile + k * P0_ROWB + 8 * (lane & 31)) = (u32x2){w0, w1}; }
    LDS_WAIT(); asm volatile("" ::: "memory");
    const int gq = lane >> 4, i16 = lane & 15;
    const LAS unsigned char* rp = tile + (8 * gq + (i16 >> 2)) * P0_ROWB + 8 * (lane & 3);
#pragma unroll
    for (int nb = 0; nb < 8; ++nb) {
        const v4i16_t lo = __builtin_amdgcn_ds_read_tr16_b64_v4i16((LAS v4i16_t*)(rp + nb * 32)), hi = __builtin_amdgcn_ds_read_tr16_b64_v4i16((LAS v4i16_t*)(rp + nb * 32 + 4 * P0_ROWB));
        const int tc = nb * 16 + i16, row = d.drow0 + tc + (tc >= 64 ? d.extra : 0);
        if (d.out8) { *(LAS u32x2*)(img + tc * P0_IMG_ROW + wave * 32 + 8 * gq) = (u32x2){pk4_fp8(bf2f((bf16_t)lo[0]), bf2f((bf16_t)lo[1]), bf2f((bf16_t)lo[2]), bf2f((bf16_t)lo[3])), pk4_fp8(bf2f((bf16_t)hi[0]), bf2f((bf16_t)hi[1]), bf2f((bf16_t)hi[2]), bf2f((bf16_t)hi[3]))}; }
        else { const bf16x8 o = (bf16x8){lo[0], lo[1], lo[2], lo[3], hi[0], hi[1], hi[2], hi[3]};
            *(bf16x8*)((bf16_t*)d.dst + (size_t)row * d.K + 8 * gq) = o; } }
    LDS_WAIT(); asm volatile("" ::: "memory");
}
__device__ __forceinline__ void p0_flush(const P0Item& d, const LAS unsigned char* img, int wave, int lane) {
    if (!d.out8) return;
    unsigned char* base = d.dst - 32 * wave;
#pragma unroll
    for (int jj = 0; jj < 2; ++jj) { const int tc = wave * 16 + jj * 8 + (lane >> 3), row = d.drow0 + tc + (tc >= 64 ? d.extra : 0);
        const LAS unsigned char* ip = img + tc * P0_IMG_ROW + (lane & 7) * 16; unsigned char* op = base + (size_t)row * d.K + (lane & 7) * 16;
        const u32x4 q0 = *(const LAS u32x4*)(ip), q1 = *(const LAS u32x4*)(ip + 128);
        __builtin_nontemporal_store(q0, (u32x4*)(op)); __builtin_nontemporal_store(q1, (u32x4*)(op + 128)); }
}
constexpr int P0_I_IN = 32 * 22, P0_I_OUT = 32 * 8, P0_I_W1 = NE * 32 * 16, P0_I_W2 = NE * 32 * 8, P0_I_L = P0_I_IN + P0_I_OUT + P0_I_W1 + P0_I_W2;
__device__ __forceinline__ P0Item p0_decode(const Frame& F, int it) {
    P0Item d; const int l = it / P0_I_L; int r = it % P0_I_L;
    if (r < P0_I_IN) { const int nb = r / 32, kb = r % 32, n0 = 128 * nb, k0 = 32 * kb;
        d.src = inp(F, I_w_in) + ((size_t)l * D + k0) * IN_COLS + n0 + (n0 >= 1536 ? 8 : 0); d.ldn = IN_COLS; d.g = inp(F, I_norm_mix) + l * D + k0; d.dst = F.ws + WS_WIN + l * WIN_BYTES + (size_t)k0 * 2; d.K = D; d.drow0 = n0; d.extra = 0; d.interleaved = 0; d.out8 = 0; d.scale = 1.f; return d; }
    r -= P0_I_IN;
    if (r < P0_I_OUT) { const int nb = r / 32, kb = r % 32, n0 = 128 * nb, k0 = 32 * kb;
        d.src = inp(F, I_w_out) + ((size_t)l * D + k0) * D + n0; d.ldn = D; d.g = nullptr; d.dst = F.ws + WS_WOUT + l * WOUT_BYTES + (size_t)k0; d.K = D; d.drow0 = n0; d.extra = 0; d.interleaved = 0; d.out8 = 1; d.scale = WOUT_SCALE; return d; }
    r -= P0_I_OUT;
    if (r < P0_I_W1) { const int e = r / (32 * 16), q = r % (32 * 16), cb = q / 32, kb = q % 32, k0 = 32 * kb, j0 = 64 * cb;
        d.src = inp(F, I_w1) + (((size_t)l * NE + e) * D + k0) * (2 * FF) + 2 * j0; d.ldn = 2 * FF; d.g = inp(F, I_norm_moe) + l * D + k0; d.dst = F.ws + WS_W1 + ((size_t)l * NE + e) * W1E_BYTES + k0; d.K = D; d.drow0 = (j0 >> 7) * 256 + (j0 & 127); d.extra = 64; d.interleaved = 1; d.out8 = 1; d.scale = W1_SCALE; return d; }
    r -= P0_I_W1;
    { const int e = r / (32 * 8), q = r % (32 * 8), nb = q / 32, kb = q % 32, n0 = 128 * nb, k0 = 32 * kb;
        d.src = inp(F, I_w2) + (((size_t)l * NE + e) * FF + k0) * D + n0; d.ldn = D; d.g = nullptr; d.dst = F.ws + WS_W2 + ((size_t)l * NE + e) * W2E_BYTES + k0; d.K = FF; d.drow0 = n0; d.extra = 0; d.interleaved = 0; d.out8 = 1; d.scale = W2_SCALE; return d; }
}
__device__ __forceinline__ void p0_prologue(const Frame& F) {
    const bool lead_ = (F.wave == 0) && (F.lane == 0);
    LAS unsigned char* tile = F.lds + F.wave * (32 * P0_ROWB);
    { f32x4 va[16], vb[16]; constexpr int NIT = NL * P0_I_L, NGRP = NIT / NWAVES; static_assert(NIT % NWAVES == 0, "p0 groups");
      LAS int* pq = (LAS int*)(F.lds + LDSCTL_OFF + LC_PQ); unsigned* qh = F.ctl + CW_PQ;
      int g = F.bid, gn = NGRP;
      if (lead_) pq[1] = F.G + (int)__hip_atomic_fetch_add(qh, 1u, __ATOMIC_RELAXED, __HIP_MEMORY_SCOPE_AGENT);
      __syncthreads();
      gn = __builtin_amdgcn_readfirstlane(pq[1]);
      LAS unsigned char* img0 = F.lds + NWAVES * (32 * P0_ROWB); LAS unsigned char* img1 = img0 + P0_IMG_BYTES;
      if (g < NGRP) { P0Item da = p0_decode(F, g * NWAVES + F.wave); p0_load(da, va, F.lane);
        for (;;) {
            unsigned tq = 0u;
            if (lead_) tq = __hip_atomic_fetch_add(qh, 1u, __ATOMIC_RELAXED, __HIP_MEMORY_SCOPE_AGENT);
            const bool hb_ = gn < NGRP; P0Item db = da; if (hb_) { db = p0_decode(F, gn * NWAVES + F.wave); p0_load(db, vb, F.lane); }
            p0_store(da, va, tile, img0, F.wave, F.lane);
            if (lead_) pq[0] = F.G + (int)tq;
            __syncthreads();
            p0_flush(da, img0, F.wave, F.lane);
            if (!hb_) break;
            gn = __builtin_amdgcn_readfirstlane(pq[0]);
            if (lead_) tq = __hip_atomic_fetch_add(qh, 1u, __ATOMIC_RELAXED, __HIP_MEMORY_SCOPE_AGENT);
            const bool ha_ = gn < NGRP; if (ha_) { da = p0_decode(F, gn * NWAVES + F.wave); p0_load(da, va, F.lane); }
            p0_store(db, vb, tile, img1, F.wave, F.lane);
            if (lead_) pq[1] = F.G + (int)tq;
            __syncthreads();
            p0_flush(db, img1, F.wave, F.lane);
            if (!ha_) break;
            gn = __builtin_amdgcn_readfirstlane(pq[1]);
        } } }
    int l2_; asm volatile("v_mbcnt_lo_u32_b32 %0, -1, 0\n\tv_mbcnt_hi_u32_b32 %0, -1, %0" : "=v"(l2_));
    const int gt = F.bid * NTHREADS + F.wave * 64 + l2_, NGT = F.G * NTHREADS;
    float* b1r = (float*)(F.ws + WS_B1R);
    for (int i = gt; i < NL * NE * 2048; i += NGT) { const int le = i >> 11, n = i & 2047, pn = n >> 8, rr = n & 255; b1r[i] = inp(F, I_b1)[(size_t)le * 2048 + 2 * (128 * pn + (rr & 127)) + (rr >> 7)]; }
    { bf16_t* pwt = (bf16_t*)(F.ws + WS_PWT);
      for (int i = gt; i < NL * 4 * 64 * 64; i += NGT) { const int c = i & 63, d = (i >> 6) & 63, lg = i >> 12; pwt[i] = f2bf(inp(F, I_pool_w)[((size_t)lg * 64 + c) * 64 + d]); } }
    bf16_t* wf = (bf16_t*)(F.ws + WS_WFRAG);
    for (int i = gt; i < NL * 2 * 32 * 2 * 64 * 8; i += NGT) {
        const int j = i & 7, ln = (i >> 3) & 63, et = (i >> 9) & 1, ks = (i >> 10) & 31, kind = (i >> 15) & 1, l = i >> 16;
        const int e = 16 * et + (ln & 15), k = 32 * ks + 8 * (ln >> 4) + j;
        float v;
        if (kind == 0) v = (e < 8) ? inp(F, I_norm_mix)[l * D + k] * inp(F, I_w_in)[((size_t)l * D + k) * IN_COLS + 1536 + e] : 0.f;
        else v = inp(F, I_norm_moe)[l * D + k] * inp(F, I_w_router)[((size_t)l * D + k) * NE + e];
        const bf16_t h = f2bf(v), lo = f2bf(v - bf2f(h));
        const size_t base = ((((size_t)(l * 2 + kind) * 32 + ks) * 2 + et) * 2) * 512 + ln * 8 + j;
        wf[base] = h; wf[base + 512] = lo;
    }
}

template <int KIND, bool COMBINE, bool IN_BF16, bool DRY = false>
__device__ __forceinline__ void r_phase(const Frame& F, int l, const float* hin) {
    const int lane = F.lane, r16 = lane & 15, q4 = lane >> 4;
    const u32x4* Wf = (const u32x4*)(F.ws + WS_WFRAG + (size_t)(l * 2 + KIND) * 131072);
    const bf16_t* Y = (const bf16_t*)(F.ws + WS_Y);
    bf16_t* HB = (bf16_t*)(F.ws + WS_HB);
    float* rstdp = (float*)(F.ws + (KIND == 0 ? WS_RSTD1 : WS_RSTD2));
    LAS float* lg = (LAS float*)(F.lds) + F.wave * (16 * 33);
    LAS int* r2cnt = (LAS int*)(F.lds + LDSCTL_OFF + LC_R2CNT); LAS int* r2base = (LAS int*)(F.lds + LDSCTL_OFF + LC_R2BASE);
    for (int task = F.bid; task < T / 128; task += F.G) {
        const int tok = task * 128 + F.wave * 16 + r16;
        const float* xr = hin + (size_t)tok * D + 8 * q4;
        const unsigned char* yr = (const unsigned char*)Y + (size_t)tok * 4 * D + 8 * q4; bf16_t* hbr = HB + (size_t)tok * D + 8 * q4;
        f32x4 acc0 = {0.f, 0.f, 0.f, 0.f}, acc1 = {0.f, 0.f, 0.f, 0.f}; float ssq = 0.f;
        if (KIND == 1) { if (F.tid < 32) r2cnt[F.tid] = 0; }
        f32x4 nx0 = {0.f, 0.f, 0.f, 0.f}, nx1 = nx0; u32x4 nxb = {0u, 0u, 0u, 0u}; u32x2 ny[4];
        if (IN_BF16) nxb = *(const u32x4*)(hbr); else { nx0 = *(const f32x4*)(xr); nx1 = *(const f32x4*)(xr + 4); }
        u32x4 nwh0 = Wf[(0 * 2 + 0) * 64 + lane], nwl0 = Wf[(0 * 2 + 1) * 64 + lane], nwh1 = nwh0, nwl1 = nwl0;
        if (KIND == 1) { nwh1 = Wf[(1 * 2 + 0) * 64 + lane]; nwl1 = Wf[(1 * 2 + 1) * 64 + lane]; }
        if (COMBINE) {
#pragma unroll
            for (int k = 0; k < 4; ++k) ny[k] = *(const u32x2*)(yr + (size_t)k * D);
        }
#pragma unroll 2
        for (int ks = 0; ks < 32; ++ks) {
            f32x4 x0 = nx0, x1 = nx1; u32x2 yv[4]; const u32x4 xb = nxb;
            if (IN_BF16) { x0 = (f32x4){bflo(xb.x), bfhi(xb.x), bflo(xb.y), bfhi(xb.y)}; x1 = (f32x4){bflo(xb.z), bfhi(xb.z), bflo(xb.w), bfhi(xb.w)}; }
            const u32x4 cwh0 = nwh0, cwl0 = nwl0, cwh1 = nwh1, cwl1 = nwl1;
#pragma unroll
            for (int k = 0; k < 4; ++k) yv[k] = COMBINE ? ny[k] : (u32x2){0u, 0u};
            if (ks + 1 < 32) {
                if (IN_BF16) nxb = *(const u32x4*)(hbr + 32 * (ks + 1)); else { nx0 = *(const f32x4*)(xr + 32 * (ks + 1)); nx1 = *(const f32x4*)(xr + 32 * (ks + 1) + 4); }
                nwh0 = Wf[(((ks + 1) * 2 + 0) * 2 + 0) * 64 + lane]; nwl0 = Wf[(((ks + 1) * 2 + 0) * 2 + 1) * 64 + lane];
                if (KIND == 1) { nwh1 = Wf[(((ks + 1) * 2 + 1) * 2 + 0) * 64 + lane]; nwl1 = Wf[(((ks + 1) * 2 + 1) * 2 + 1) * 64 + lane]; }
                if (COMBINE) {
#pragma unroll
                    for (int k = 0; k < 4; ++k) ny[k] = *(const u32x2*)(yr + (size_t)k * D + 32 * (ks + 1));
                }
            }
            if (COMBINE) {
#pragma unroll
                for (int k = 0; k < 4; ++k) { x0 += un4_fp8(yv[k].x) * (1.0f / Y_SCALE); x1 += un4_fp8(yv[k].y) * (1.0f / Y_SCALE); }
            }
            ssq += (x0[0] * x0[0] + x0[1] * x0[1]) + (x0[2] * x0[2] + x0[3] * x0[3]) + (x1[0] * x1[0] + x1[1] * x1[1]) + (x1[2] * x1[2] + x1[3] * x1[3]);
            constexpr bool EXACT = IN_BF16 && !COMBINE;
            u32x4 hw; hw.x = cvtpk(x0[0], x0[1]); hw.y = cvtpk(x0[2], x0[3]); hw.z = cvtpk(x1[0], x1[1]); hw.w = cvtpk(x1[2], x1[3]);
            if (EXACT) hw = xb;
            u32x4 lw; lw.x = cvtpk(x0[0] - bflo(hw.x), x0[1] - bfhi(hw.x)); lw.y = cvtpk(x0[2] - bflo(hw.y), x0[3] - bfhi(hw.y)); lw.z = cvtpk(x1[0] - bflo(hw.z), x1[1] - bfhi(hw.z)); lw.w = cvtpk(x1[2] - bflo(hw.w), x1[3] - bfhi(hw.w));
            if (KIND == 0 && !DRY) *(u32x4*)(hbr + 32 * ks) = hw;
            else *(u32x2*)((unsigned char*)(F.ws + WS_HB8) + (size_t)tok * D + 8 * q4 + 32 * ks) = (u32x2){pk4_fp8_sat(x0[0], x0[1], x0[2], x0[3]), pk4_fp8_sat(x1[0], x1[1], x1[2], x1[3])};
            const bf16x8 xh = __builtin_bit_cast(bf16x8, hw), xl = __builtin_bit_cast(bf16x8, lw);
            const bf16x8 wh0 = __builtin_bit_cast(bf16x8, cwh0), wl0 = __builtin_bit_cast(bf16x8, cwl0);
            acc0 = __builtin_amdgcn_mfma_f32_16x16x32_bf16(wh0, xh, acc0, 0, 0, 0);
            acc0 = __builtin_amdgcn_mfma_f32_16x16x32_bf16(wl0, xh, acc0, 0, 0, 0);
            if (!EXACT) acc0 = __builtin_amdgcn_mfma_f32_16x16x32_bf16(wh0, xl, acc0, 0, 0, 0);
            if (KIND == 1) {
                const bf16x8 wh1 = __builtin_bit_cast(bf16x8, cwh1), wl1 = __builtin_bit_cast(bf16x8, cwl1);
                acc1 = __builtin_amdgcn_mfma_f32_16x16x32_bf16(wh1, xh, acc1, 0, 0, 0);
                acc1 = __builtin_amdgcn_mfma_f32_16x16x32_bf16(wl1, xh, acc1, 0, 0, 0);
                if (!EXACT) acc1 = __builtin_amdgcn_mfma_f32_16x16x32_bf16(wh1, xl, acc1, 0, 0, 0);
            }
        }
        ssq += __shfl_xor(ssq, 16); ssq += __shfl_xor(ssq, 32);
        const float rstd = 1.0f / sqrtf(ssq * (1.0f / D) + RMS_EPS);
        if (q4 == 0) rstdp[tok] = rstd;
        if (KIND == 0) {
            if (q4 < 2) { const f32x4 bf = *(const f32x4*)(inp(F, I_b_fox_f) + l * 8 + 4 * q4); f32x4 lf;
#pragma unroll
                for (int i = 0; i < 4; ++i) { const float z = rstd * acc0[i] + bf[i]; lf[i] = fminf(z, 0.f) - log1pf(expf(-fabsf(z))); }
                *(f32x4*)((float*)(F.ws + WS_LOGF) + (size_t)tok * 8 + 4 * q4) = lf; }
        } else if (!DRY) {
            const f32x4 b0 = *(const f32x4*)(inp(F, I_b_router) + l * NE + 4 * q4), b1v = *(const f32x4*)(inp(F, I_b_router) + l * NE + 16 + 4 * q4);
#pragma unroll
            for (int i = 0; i < 4; ++i) { lg[r16 * 33 + 4 * q4 + i] = rstd * acc0[i] + b0[i]; lg[r16 * 33 + 16 + 4 * q4 + i] = rstd * acc1[i] + b1v[i]; }
            LDS_WAIT(); asm volatile("" ::: "memory");
            float v0 = -INFINITY, v1 = -INFINITY, v2 = -INFINITY, v3 = -INFINITY; int i0 = 0, i1 = 0, i2 = 0, i3 = 0;
            if (lane < 16) {
                for (int e = 0; e < NE; ++e) { const float x = lg[lane * 33 + e];
                    if (x > v3) { if (x > v0) { v3 = v2; i3 = i2; v2 = v1; i2 = i1; v1 = v0; i1 = i0; v0 = x; i0 = e; }
                        else if (x > v1) { v3 = v2; i3 = i2; v2 = v1; i2 = i1; v1 = x; i1 = e; }
                        else if (x > v2) { v3 = v2; i3 = i2; v2 = x; i2 = e; }
                        else { v3 = x; i3 = e; } } }
            }
            __syncthreads();
            int rk0 = 0, rk1 = 0, rk2 = 0, rk3 = 0;
            if (lane < 16) { rk0 = __hip_atomic_fetch_add(&r2cnt[i0], 1, __ATOMIC_RELAXED, __HIP_MEMORY_SCOPE_WORKGROUP); rk1 = __hip_atomic_fetch_add(&r2cnt[i1], 1, __ATOMIC_RELAXED, __HIP_MEMORY_SCOPE_WORKGROUP); rk2 = __hip_atomic_fetch_add(&r2cnt[i2], 1, __ATOMIC_RELAXED, __HIP_MEMORY_SCOPE_WORKGROUP); rk3 = __hip_atomic_fetch_add(&r2cnt[i3], 1, __ATOMIC_RELAXED, __HIP_MEMORY_SCOPE_WORKGROUP); }
            __syncthreads();
            if (F.tid < 32) r2base[F.tid] = (int)atomicAdd(F.ctl + CW_CUR + (l * NE + F.tid) * 16, (unsigned)r2cnt[F.tid]);
            __syncthreads();
            if (lane < 16) {
                const float e1 = expf(v1 - v0), e2 = expf(v2 - v0), e3 = expf(v3 - v0), inv = 1.0f / (1.0f + e1 + e2 + e3);
                u32x2* list = (u32x2*)(F.ws + WS_LIST); float* gate = (float*)(F.ws + WS_GLIST);
                const int tk = (task * 128 + F.wave * 16 + lane) * 4; const unsigned rb = __float_as_uint(__shfl(rstd, lane & 15));
                { const size_t p0_ = (size_t)i0 * LISTCAP + r2base[i0] + rk0, p1_ = (size_t)i1 * LISTCAP + r2base[i1] + rk1, p2_ = (size_t)i2 * LISTCAP + r2base[i2] + rk2, p3_ = (size_t)i3 * LISTCAP + r2base[i3] + rk3;
                  list[p0_] = (u32x2){(unsigned)(tk + 0), rb}; gate[p0_] = inv;
                  list[p1_] = (u32x2){(unsigned)(tk + 1), rb}; gate[p1_] = e1 * inv;
                  list[p2_] = (u32x2){(unsigned)(tk + 2), rb}; gate[p2_] = e2 * inv;
                  list[p3_] = (u32x2){(unsigned)(tk + 3), rb}; gate[p3_] = e3 * inv; }
            }
            __syncthreads();
        }
    }
}
__device__ __forceinline__ void r_final(const Frame& F) {
    const int lane = F.lane, tr = lane >> 5, c = lane & 31;
    const bf16_t* Y = (const bf16_t*)(F.ws + WS_Y);
    const float* gf = inp(F, I_norm_final);
    f32x4 gv0[4], gv1[4];
#pragma unroll
    for (int i = 0; i < 4; ++i) { gv0[i] = *(const f32x4*)(gf + 256 * i + 8 * c); gv1[i] = *(const f32x4*)(gf + 256 * i + 8 * c + 4); }
    for (int task = F.bid; task < T / 128; task += F.G) {
        u32x4 hq[4], nhq[4]; u32x2 yq[4][4], nyq[4][4];
        { const int tok = task * 128 + F.wave * 16 + tr; const unsigned char* yr = (const unsigned char*)Y + (size_t)tok * 4 * D + 8 * c; const bf16_t* hr = (const bf16_t*)(F.ws + WS_HB) + (size_t)tok * D + 8 * c;
#pragma unroll
          for (int i = 0; i < 4; ++i) { nhq[i] = *(const u32x4*)(hr + 256 * i);
#pragma unroll
              for (int k = 0; k < 4; ++k) nyq[i][k] = *(const u32x2*)(yr + (size_t)k * D + 256 * i); } }
#pragma unroll 1
        for (int pr = 0; pr < 8; ++pr) {
            const int tok = task * 128 + F.wave * 16 + pr * 2 + tr;
            float* xr = F.out + (size_t)tok * D + 8 * c;
#pragma unroll
            for (int i = 0; i < 4; ++i) { hq[i] = nhq[i];
#pragma unroll
                for (int k = 0; k < 4; ++k) yq[i][k] = nyq[i][k]; }
            if (pr + 1 < 8) { const int tn = tok + 2; const unsigned char* yr = (const unsigned char*)Y + (size_t)tn * 4 * D + 8 * c; const bf16_t* hr = (const bf16_t*)(F.ws + WS_HB) + (size_t)tn * D + 8 * c;
#pragma unroll
                for (int i = 0; i < 4; ++i) { nhq[i] = *(const u32x4*)(hr + 256 * i);
#pragma unroll
                    for (int k = 0; k < 4; ++k) nyq[i][k] = *(const u32x2*)(yr + (size_t)k * D + 256 * i); } }
            f32x4 x0[4], x1[4]; float ssq = 0.f;
#pragma unroll
            for (int i = 0; i < 4; ++i) { const u32x4 q = hq[i]; x0[i] = (f32x4){bflo(q.x), bfhi(q.x), bflo(q.y), bfhi(q.y)}; x1[i] = (f32x4){bflo(q.z), bfhi(q.z), bflo(q.w), bfhi(q.w)}; }
#pragma unroll
            for (int i = 0; i < 4; ++i) {
#pragma unroll
                for (int k = 0; k < 4; ++k) { const u32x2 y = yq[i][k];
                    x0[i] += un4_fp8(y.x) * (1.0f / Y_SCALE); x1[i] += un4_fp8(y.y) * (1.0f / Y_SCALE); }
                ssq += (x0[i][0] * x0[i][0] + x0[i][1] * x0[i][1]) + (x0[i][2] * x0[i][2] + x0[i][3] * x0[i][3]) + (x1[i][0] * x1[i][0] + x1[i][1] * x1[i][1]) + (x1[i][2] * x1[i][2] + x1[i][3] * x1[i][3]); }
            ssq += __shfl_xor(ssq, 1); ssq += __shfl_xor(ssq, 2); ssq += __shfl_xor(ssq, 4); ssq += __shfl_xor(ssq, 8); ssq += __shfl_xor(ssq, 16);
            const float rstd = 1.0f / sqrtf(ssq * (1.0f / D) + RMS_EPS);
#pragma unroll
            for (int i = 0; i < 4; ++i) { *(f32x4*)(xr + 256 * i) = x0[i] * rstd * gv0[i]; *(f32x4*)(xr + 256 * i + 4) = x1[i] * rstd * gv1[i]; }
        }
    }
}
__device__ __forceinline__ void cumsum_step(const Frame& F) {
    LAS float* sc = (LAS float*)(F.lds + LDSCTL_OFF + LC_SCAN);
    const float* LF = (const float*)(F.ws + WS_LOGF); float* c2 = (float*)(F.ws + WS_C2);
    for (int seq = F.G - 1 - F.bid; seq < 64; seq += F.G) {
        const int b = seq >> 3, h = seq & 7, t0 = F.tid * 8; const float* lf = LF + ((size_t)b * SEQ + t0) * 8 + h;
        float v[8], s = 0.f;
#pragma unroll
        for (int j = 0; j < 8; ++j) { s += lf[j * 8]; v[j] = s; }
        float inc = s;
#pragma unroll
        for (int off = 1; off < 64; off <<= 1) { const float y = __shfl_up(inc, off); if (F.lane >= off) inc += y; }
        if (F.lane == 63) sc[F.wave] = inc;
        __syncthreads();
        float pre = 0.f;
        for (int w = 0; w < F.wave; ++w) pre += sc[w];
        const float base = pre + inc - s;
#pragma unroll
        for (int j = 0; j < 8; ++j) c2[(size_t)seq * SEQ + t0 + j] = (base + v[j]) * LOG2E;
        __syncthreads();
    }
}

__device__ __forceinline__ float max3f(float a, float b, float c) { float r; asm("v_max3_f32 %0, %1, %2, %3" : "=v"(r) : "v"(a), "v"(b), "v"(c)); return r; }
__device__ __forceinline__ float max2f(float a, float b) { float r; asm("v_max_f32_e32 %0, %1, %2" : "=v"(r) : "v"(a), "v"(b)); return r; }
__device__ __forceinline__ int crow(int r, int hi) { return (r & 3) + 8 * (r >> 2) + 4 * hi; }
constexpr int AT_KT = 0, AT_KTB = 8320, AT_VT = 2 * AT_KTB, AT_VTB = 8192, AT_CK = AT_VT + 2 * AT_VTB, AT_WSF = AT_CK + 512, AT_OST = AT_WSF + 2048, AT_END = AT_OST + 65536;
static_assert(AT_END <= PH_BYTES, "attention LDS");
__device__ __forceinline__ void attn_unit(const Frame& F, int l, int b, int h, int qb) {
    const int tid = F.tid, lane = F.lane, r32 = lane & 31, hi = lane >> 5, wid = F.wave;
    const bf16_t* proj = (const bf16_t*)(F.ws + WS_PA); bf16_t* mixed = (bf16_t*)(F.ws + WS_MIXED);
    const int bh = b * 8 + h; const float* c2 = (const float*)(F.ws + WS_C2) + (size_t)bh * SEQ;
    const size_t rowbase = (size_t)b * SEQ; const int q0 = qb * 256;
    LAS unsigned char* L = F.lds;
    LAS float* wsf = (LAS float*)(L + AT_WSF) + wid * 64;
    LAS float* ost = (LAS float*)(L + AT_OST) + wid * 2048;
    LAS unsigned* stopv = (LAS unsigned*)(L + LDSCTL_OFF + LC_STOP);
    const bf16_t* Qw = proj + (rowbase + q0 + wid * 32 + r32) * NPROJ + C_FQ + h * 64;
    bf16x8 qr[4]; float qn = 0.f;
#pragma unroll
    for (int d0 = 0; d0 < 4; ++d0) { const u32x4 w = *(const u32x4*)(Qw + d0 * 16 + hi * 8); qr[d0] = __builtin_bit_cast(bf16x8, w);
        qn += bflo(w.x) * bflo(w.x) + bfhi(w.x) * bfhi(w.x) + bflo(w.y) * bflo(w.y) + bfhi(w.y) * bfhi(w.y) + bflo(w.z) * bflo(w.z) + bfhi(w.z) * bfhi(w.z) + bflo(w.w) * bflo(w.w) + bfhi(w.w) * bfhi(w.w); }
    qn += __shfl_xor(qn, 32); qn = sqrtf(qn) * 1.001f;
    const float kb = sqrtf(2.0f * __uint_as_float(__hip_atomic_load(F.ctl + CW_KMAX + (l * 64 + bh) * 16, __ATOMIC_RELAXED, __HIP_MEMORY_SCOPE_AGENT))) * 1.001f;
    const float c2q = c2[q0 + wid * 32 + r32];
    f32x16 cq16;
#pragma unroll
    for (int r = 0; r < 16; ++r) cq16[r] = c2q;
    float lsum = 0.f; f32x16 o[2];
#pragma unroll
    for (int r = 0; r < 16; ++r) { o[0][r] = 0.f; o[1][r] = 0.f; }
    const int jd = 4 * qb + 3;
    const int lkey = tid >> 3, lpiece = tid & 7;
    const bf16_t* ksrc = proj + (rowbase + lkey) * NPROJ + C_FK + h * 64 + lpiece * 8;
    const bf16_t* vsrc = proj + (rowbase + lkey) * NPROJ + C_FV + h * 64 + lpiece * 8;
    const int kdst = lpiece * 1040 + lkey * 16, vdst = (lpiece >> 2) * 4096 + lkey * 64 + (lpiece & 3) * 16;
    u32x4 kA = *(const u32x4*)(ksrc + (size_t)jd * 64 * NPROJ), vA = *(const u32x4*)(vsrc + (size_t)jd * 64 * NPROJ); float cA = c2[jd * 64 + lane];
    u32x4 kB = kA, vB = vA; float cB = cA;
    if (jd >= 1) { kB = *(const u32x4*)(ksrc + (size_t)(jd - 1) * 64 * NPROJ); vB = *(const u32x4*)(vsrc + (size_t)(jd - 1) * 64 * NPROJ); cB = c2[(jd - 1) * 64 + lane]; }
    const int vrd = (4 * hi + ((lane & 15) >> 2)) * 64 + ((lane >> 4) & 1) * 32 + (lane & 3) * 8;
    const int qrel = wid * 32 + r32;
    int buf = 0; bool done = false, wstop = false, first = true;
    float mhat = 0.f;
#define AT_ITER(j, kR, vR, cR, cNext) do { \
        const float cklast = rdlane(cNext, 63);     \
        *(LAS u32x4*)(L + AT_KT + buf * AT_KTB + kdst) = kR; *(LAS u32x4*)(L + AT_VT + buf * AT_VTB + vdst) = vR; \
        if (tid < 64) ((LAS float*)(L + AT_CK))[buf * 64 + tid] = cR; \
        asm volatile("s_waitcnt lgkmcnt(0)\n\ts_barrier" ::: "memory");     \
        if ((j) < jd) { const u32x4 fa = *(const LAS u32x4*)(stopv + (((j) + 1) & 1) * 8), fb = *(const LAS u32x4*)(stopv + (((j) + 1) & 1) * 8 + 4); \
            if ((fa.x & fa.y & fa.z & fa.w & fb.x & fb.y & fb.z & fb.w) != 0u) { done = true; break; } } \
        if ((j) >= 2) { kR = *(const u32x4*)(ksrc + (size_t)((j) - 2) * 64 * NPROJ); vR = *(const u32x4*)(vsrc + (size_t)((j) - 2) * 64 * NPROJ); cR = c2[((j) - 2) * 64 + lane]; } \
        const int jrel = (j) - 4 * qb; \
        const bool active = !(jrel >= 0 && 64 * jrel > 32 * wid + 31) && !wstop; \
        if (active) { \
            const LAS unsigned char* Kb = L + AT_KT + buf * AT_KTB; const LAS unsigned char* Vb = L + AT_VT + buf * AT_VTB; const LAS float* Ck = (const LAS float*)(L + AT_CK) + buf * 64; \
            const float base = c2q - mhat; \
            f32x16 p0, p1; \
            _Pragma("unroll") for (int g = 0; g < 4; ++g) { const f32x4 ca = *(const LAS f32x4*)(Ck + 8 * g + 4 * hi), cb = *(const LAS f32x4*)(Ck + 32 + 8 * g + 4 * hi); \
                _Pragma("unroll") for (int i = 0; i < 4; ++i) { p0[4 * g + i] = base - ca[i]; p1[4 * g + i] = base - cb[i]; } } \
            bf16x8 kf0[4], kf1[4]; \
            _Pragma("unroll") for (int d0 = 0; d0 < 4; ++d0) { kf0[d0] = *(const LAS bf16x8*)(Kb + (2 * d0 + hi) * 1040 + r32 * 16); kf1[d0] = *(const LAS bf16x8*)(Kb + (2 * d0 + hi) * 1040 + (32 + r32) * 16); } \
            __builtin_amdgcn_sched_barrier(0);     \
            _Pragma("unroll") for (int d0 = 0; d0 < 4; ++d0) { \
                p0 = __builtin_amdgcn_mfma_f32_32x32x16_bf16(kf0[d0], qr[d0], p0, 0, 0, 0); p1 = __builtin_amdgcn_mfma_f32_32x32x16_bf16(kf1[d0], qr[d0], p1, 0, 0, 0); } \
            asm volatile("s_nop 15\n\ts_nop 7" : "+v"(p0), "+v"(p1));     \
            if (jrel >= 0) { const int kbase = 64 * jrel + 4 * hi; \
                _Pragma("unroll") for (int r = 0; r < 16; ++r) { const int kv = kbase + (r & 3) + 8 * (r >> 2); if (kv > qrel) p0[r] = -INFINITY; if (kv + 32 > qrel) p1[r] = -INFINITY; } } \
            float mx = max3f(p0[0], p0[1], p1[0]), mb_ = max3f(p0[2], p0[3], p1[1]); mx = max3f(mx, p1[2], p1[3]); \
            _Pragma("unroll") for (int r = 4; r < 16; r += 4) { mx = max3f(mx, p0[r], p0[r + 1]); mb_ = max3f(mb_, p0[r + 2], p0[r + 3]); mx = max3f(mx, p1[r], p1[r + 1]); mb_ = max3f(mb_, p1[r + 2], p1[r + 3]); } \
            mx = max2f(mx, mb_); \
            { auto rr = __builtin_amdgcn_permlane32_swap(__float_as_uint(mx), __float_as_uint(mx), false, false); mx = max2f(__uint_as_float(rr[0]), __uint_as_float(rr[1])); } \
            if (first || !__all(mx < -40.0f)) {     \
            if (first || __any(mx > 8.0f)) { \
                const float dl = first ? mx : fmaxf(mx, 0.f); mhat += dl; \
                _Pragma("unroll") for (int r = 0; r < 16; ++r) { p0[r] -= dl; p1[r] -= dl; } \
                const float alpha = __builtin_amdgcn_exp2f(-dl); lsum *= alpha; \
                if (!first) { \
                    if (hi == 0) wsf[r32] = alpha; \
                    LDS_WAIT(); asm volatile("" ::: "memory"); \
                    _Pragma("unroll") for (int r = 0; r < 16; ++r) { const float a = wsf[crow(r, hi)]; o[0][r] *= a; o[1][r] *= a; } } \
                first = false; \
            } \
            _Pragma("unroll") for (int r = 0; r < 16; ++r) { p0[r] = __builtin_amdgcn_exp2f(p0[r]); p1[r] = __builtin_amdgcn_exp2f(p1[r]); } \
            { f32x2 sa = {p0[0] + p1[0], p0[1] + p1[1]}; \
              _Pragma("unroll") for (int r = 2; r < 16; r += 2) { sa += (f32x2){p0[r], p0[r + 1]}; sa += (f32x2){p1[r], p1[r + 1]}; } \
              lsum += sa[0] + sa[1]; } \
            u32x4 pw[4]; \
            pw[0] = (u32x4){cvtpk(p0[0], p0[1]), cvtpk(p0[2], p0[3]), cvtpk(p0[4], p0[5]), cvtpk(p0[6], p0[7])}; \
            pw[1] = (u32x4){cvtpk(p0[8], p0[9]), cvtpk(p0[10], p0[11]), cvtpk(p0[12], p0[13]), cvtpk(p0[14], p0[15])}; \
            pw[2] = (u32x4){cvtpk(p1[0], p1[1]), cvtpk(p1[2], p1[3]), cvtpk(p1[4], p1[5]), cvtpk(p1[6], p1[7])}; \
            pw[3] = (u32x4){cvtpk(p1[8], p1[9]), cvtpk(p1[10], p1[11]), cvtpk(p1[12], p1[13]), cvtpk(p1[14], p1[15])}; \
            { v4i16_t vlo[2], vhv[2];     \
              { const LAS unsigned char* vp = Vb + vrd; vlo[0] = __builtin_amdgcn_ds_read_tr16_b64_v4i16((LAS v4i16_t*)vp); vhv[0] = __builtin_amdgcn_ds_read_tr16_b64_v4i16((LAS v4i16_t*)(vp + 512)); } \
              _Pragma("unroll") for (int st = 0; st < 8; ++st) { const int s = st >> 1, d0 = st & 1; \
                if (st + 1 < 8) { const LAS unsigned char* vp = Vb + ((st + 1) & 1) * 4096 + ((st + 1) >> 1) * 1024 + vrd; \
                    vlo[(st + 1) & 1] = __builtin_amdgcn_ds_read_tr16_b64_v4i16((LAS v4i16_t*)vp); vhv[(st + 1) & 1] = __builtin_amdgcn_ds_read_tr16_b64_v4i16((LAS v4i16_t*)(vp + 512)); } \
                __builtin_amdgcn_sched_barrier(0); \
                const v4i16_t lo = vlo[st & 1], hv = vhv[st & 1]; \
                const bf16x8 vf = (bf16x8){lo[0], lo[1], lo[2], lo[3], hv[0], hv[1], hv[2], hv[3]}; \
                o[d0] = __builtin_amdgcn_mfma_f32_32x32x16_bf16(__builtin_bit_cast(bf16x8, pw[s]), vf, o[d0], 0, 0, 0); \
                __builtin_amdgcn_sched_barrier(0); } } \
            } \
        } \
        if ((j) > 0) { if (active) { const float ub = qn * kb + (c2q - cklast); if (__all((ub - mhat) < -40.0f)) wstop = true; } if (lane == 0) stopv[((j) & 1) * 8 + wid] = wstop ? 1u : 0u; } \
        buf ^= 1; \
    } while (0)
    for (int j = jd; j >= 0; j -= 2) {
        AT_ITER(j, kA, vA, cA, cB);
        if (done || j == 0) break;
        AT_ITER(j - 1, kB, vB, cB, cA);
        if (done) break;
    }
#undef AT_ITER
    lsum += __shfl_xor(lsum, 32);
    if (hi == 0) wsf[32 + r32] = 1.0f / lsum;
    LDS_WAIT(); asm volatile("" ::: "memory");
#pragma unroll
    for (int r = 0; r < 16; ++r) { const int q = crow(r, hi); const float inv = wsf[32 + q]; ost[q * 64 + r32] = o[0][r] * inv; ost[q * 64 + 32 + r32] = o[1][r] * inv; }
    LDS_WAIT(); asm volatile("" ::: "memory");
    { const int row = lane >> 1, half = lane & 1; const LAS float* src = ost + row * 64 + half * 32; float v[32]; float ss = 0.f;
        const float* gn = inp(F, I_fox_gain) + l * 512 + h * 64 + half * 32; f32x4 gav[8];
#pragma unroll
        for (int i = 0; i < 8; ++i) gav[i] = *(const f32x4*)(gn + 4 * i);
#pragma unroll
        for (int i = 0; i < 8; ++i) { const f32x4 t4 = *(const LAS f32x4*)(src + 4 * i); v[4 * i] = t4[0]; v[4 * i + 1] = t4[1]; v[4 * i + 2] = t4[2]; v[4 * i + 3] = t4[3]; ss += (t4[0] * t4[0] + t4[1] * t4[1]) + (t4[2] * t4[2] + t4[3] * t4[3]); }
        ss += __shfl_xor(ss, 1);
        const float rs = 1.0f / sqrtf(ss * (1.0f / 64.0f) + RMS_EPS);
        unsigned char* dst = (unsigned char*)mixed + (rowbase + q0 + wid * 32 + row) * D + h * 64 + half * 32;
        const float rs16 = rs * MIX_SCALE; unsigned pw8[8];
#pragma unroll
        for (int i = 0; i < 8; ++i) { const f32x4 ga = gav[i]; pw8[i] = pk4_fp8_sat(v[4 * i] * rs16 * ga[0], v[4 * i + 1] * rs16 * ga[1], v[4 * i + 2] * rs16 * ga[2], v[4 * i + 3] * rs16 * ga[3]); }
        *(u32x4*)(dst) = (u32x4){pw8[0], pw8[1], pw8[2], pw8[3]}; *(u32x4*)(dst + 16) = (u32x4){pw8[4], pw8[5], pw8[6], pw8[7]}; }
    __syncthreads();
}

__device__ __forceinline__ float hg_lb(const Frame& F, int l, int col) {
    float x[NL], mx = -INFINITY;
#pragma unroll
    for (int i = 0; i < NL; ++i) { x[i] = inp(F, I_hgrn_lb)[i * 256 + col]; mx = fmaxf(mx, x[i]); }
    float s = 0.f, a = 0.f;
#pragma unroll
    for (int i = 0; i < NL; ++i) { x[i] = expf(x[i] - mx); s += x[i]; }
#pragma unroll
    for (int i = 1; i < NL; ++i) if (i <= l) a += x[i];
    return a / s;
}
constexpr int HG_SEG = 128, HG_NSEG = SEQ / HG_SEG, HG_NPART = 1, HG_WAVES = 4;
static_assert(HG_NSEG == 32, "the FIX phase's balanced deal assumes 32 segments");
constexpr int HGL_ROW = 136, HGL_QT = 0, HGL_KT = 32 * HGL_ROW, HGL_KP = 2 * 32 * HGL_ROW, HGL_V = HGL_KP + 4096, HGL_PE = HGL_V + 4096, HGL_BYTES = HGL_PE + 256;
static_assert(NWAVES * HGL_BYTES <= PH_BYTES, "HGRN2 LDS");
#ifndef PROBE_HG
#define PROBE_HG 0
#endif
__device__ __forceinline__ unsigned long long hg_mfma_unit(const Frame& F, int l, int u) {
    unsigned long long hacc = 0ull;
    const int seg = u % HG_NSEG, bh = u / HG_NSEG, b = bh >> 2, hd = bh & 3, lane = F.lane, r32 = lane & 31, hi = lane >> 5;
    LAS unsigned char* W = F.lds + F.wave * HGL_BYTES;
    const size_t tokS = (size_t)b * SEQ + seg * HG_SEG;
    const bf16_t* proj = (const bf16_t*)(F.ws + WS_PA);
    float* oraw = (float*)(F.ws + WS_ORAW); bf16_t* QE = (bf16_t*)(F.ws + WS_QE);
    const float lbv = hg_lb(F, l, hd * 64 + lane);
    f32x16 Sacc[2][2];
#pragma unroll
    for (int kb = 0; kb < 2; ++kb)
#pragma unroll
        for (int vb = 0; vb < 2; ++vb)
#pragma unroll
            for (int r = 0; r < 16; ++r) Sacc[kb][vb][r] = 0.f;
    float Pseg = 1.0f;
    const int vrd = (4 * hi + ((lane & 15) >> 2)) * 64 + ((lane >> 4) & 1) * 32 + (lane & 3) * 8;
    int tb = 0; u32x4 vreg[4], fr4[4], qr4[4]; bool havepf = false;
    while (tb < HG_SEG) {
        const unsigned long long th0 = PROBE_HG ? __builtin_amdgcn_s_memrealtime() : 0ull;
        const int nmax = (HG_SEG - tb) < 32 ? (HG_SEG - tb) : 32;
        const char* pu8 = (const char*)(proj + (tokS + tb) * NPROJ + hd * 64);
        const unsigned lo2 = (unsigned)lane * 2u;
        char* qe8 = (char*)(QE + (tokS + tb) * 256 + hd * 64);
        char* or8 = (char*)(oraw + (tokS + tb) * 256 + hd * 64);
        const unsigned lof = (unsigned)(4 * hi * 256 + r32) * 4u;
        char* dmy8 = (char*)(F.ws + WS_PSEG + 768 * 1024);
        float fv[32], qv[32];
        if (!havepf) {
#pragma unroll
            for (int it = 0; it < 4; ++it) { const int c = lane + 64 * it, sr = c >> 3, pc = c & 7; const char* rp = pu8 + (size_t)sr * (NPROJ * 2) + pc * 16;
                fr4[it] = *(const u32x4*)(rp + C_GF * 2); qr4[it] = *(const u32x4*)(rp + C_GQ * 2); } }
#pragma unroll
        for (int it = 0; it < 4; ++it) { const int c = lane + 64 * it, sr = c >> 3, pc = c & 7; vreg[it] = *(const u32x4*)(pu8 + (size_t)sr * (NPROJ * 2) + pc * 16 + C_GI * 2); }
        __builtin_amdgcn_sched_barrier(0);
#pragma unroll
        for (int it = 0; it < 4; ++it) { const int c = lane + 64 * it, sr = c >> 3, pc = c & 7;
            *(LAS u32x2*)(W + HGL_QT + sr * HGL_ROW + pc * 16) = (u32x2){fr4[it].x, fr4[it].y}; *(LAS u32x2*)(W + HGL_QT + sr * HGL_ROW + pc * 16 + 8) = (u32x2){fr4[it].z, fr4[it].w};
            *(LAS u32x2*)(W + HGL_KT + sr * HGL_ROW + pc * 16) = (u32x2){qr4[it].x, qr4[it].y}; *(LAS u32x2*)(W + HGL_KT + sr * HGL_ROW + pc * 16 + 8) = (u32x2){qr4[it].z, qr4[it].w}; }
        LDS_WAIT(); asm volatile("" ::: "memory");
#pragma unroll
        for (int t = 0; t < 32; ++t) { fv[t] = bf2f(*(const LAS bf16_t*)(W + HGL_QT + t * HGL_ROW + lane * 2)); qv[t] = bf2f(*(const LAS bf16_t*)(W + HGL_KT + t * HGL_ROW + lane * 2)); }
        LDS_WAIT(); asm volatile("" ::: "memory");
        int nl = 32; { float P = 1.0f;
#pragma unroll
            for (int t = 0; t < 32; ++t) { const float sg = __builtin_amdgcn_rcpf(1.0f + __builtin_amdgcn_exp2f(-LOG2E * fv[t])); float f = fmaxf(lbv + (1.0f - lbv) * sg, 1e-30f); if (t >= nmax) f = 1.0f; fv[t] = f; P *= f; if (P < 1e-32f && nl == 32) nl = t; } }
#pragma unroll
        for (int off = 1; off < 64; off <<= 1) { const int o = __shfl_xor(nl, off); nl = o < nl ? o : nl; }
        const int n = __builtin_amdgcn_readfirstlane(nl < nmax ? nl : nmax);
        if (PROBE_HG == 1) hacc += __builtin_amdgcn_s_memrealtime() - th0;
#pragma unroll
        for (int it = 0; it < 4; ++it) { const int c = lane + 64 * it, sr = c >> 3, pc = c & 7;
            *(LAS u32x4*)(W + HGL_V + (pc >> 2) * 2048 + sr * 64 + (pc & 3) * 16) = (sr < n) ? vreg[it] : (u32x4){0u, 0u, 0u, 0u}; }
        havepf = (tb + n) < HG_SEG;
        if (havepf) { const char* pn8 = pu8 + (size_t)n * (NPROJ * 2);
#pragma unroll
            for (int it = 0; it < 4; ++it) { const int c = lane + 64 * it, sr = c >> 3, pc = c & 7; const char* rp = pn8 + (size_t)sr * (NPROJ * 2) + pc * 16;
                fr4[it] = *(const u32x4*)(rp + C_GF * 2); qr4[it] = *(const u32x4*)(rp + C_GQ * 2); }
            __builtin_amdgcn_sched_barrier(0); }
        float P = 1.0f;
        {
#pragma unroll
          for (int t = 0; t < 32; ++t) { const bool ok = t < n; const float f = fv[t]; if (ok) P *= f;
            const float qt = ok ? qv[t] * P : 0.f, kt = ok ? (1.0f - f) * __builtin_amdgcn_rcpf(P) : 0.f;
            *(LAS bf16_t*)(W + HGL_QT + t * HGL_ROW + lane * 2) = f2bf(qt); *(LAS bf16_t*)(W + HGL_KT + t * HGL_ROW + lane * 2) = f2bf(kt);
            *(bf16_t*)((t < nmax ? qe8 + (size_t)t * 512 : dmy8) + lo2) = f2bf(qv[t] * (Pseg * P)); } }
        { float suf = 1.0f;
#pragma unroll
          for (int t = 31; t >= 0; --t) { const bool ok = t < n; const float f = fv[t]; const float kp = ok ? (1.0f - f) * suf : 0.f; if (ok) suf *= f;
            *(LAS bf16_t*)(W + HGL_KP + (lane >> 5) * 2048 + t * 64 + (lane & 31) * 2) = f2bf(kp); } }
        ((LAS float*)(W + HGL_PE))[lane] = P;
        Pseg *= P;
        LDS_WAIT(); asm volatile("" ::: "memory");
        if (PROBE_HG == 2) hacc += __builtin_amdgcn_s_memrealtime() - th0;
        f32x16 st;
#pragma unroll
        for (int r = 0; r < 16; ++r) st[r] = 0.f;
#pragma unroll
        for (int d0 = 0; d0 < 4; ++d0) { const bf16x8 ka = *(const LAS bf16x8*)(W + HGL_KT + r32 * HGL_ROW + (16 * d0 + 8 * hi) * 2), qb = *(const LAS bf16x8*)(W + HGL_QT + r32 * HGL_ROW + (16 * d0 + 8 * hi) * 2);
            st = __builtin_amdgcn_mfma_f32_32x32x16_bf16(ka, qb, st, 0, 0, 0); }
#pragma unroll
        for (int r = 0; r < 16; ++r) if (crow(r, hi) > r32) st[r] = 0.f;
        u32x4 pst[2];
        pst[0] = (u32x4){cvtpk(st[0], st[1]), cvtpk(st[2], st[3]), cvtpk(st[4], st[5]), cvtpk(st[6], st[7])};
        pst[1] = (u32x4){cvtpk(st[8], st[9]), cvtpk(st[10], st[11]), cvtpk(st[12], st[13]), cvtpk(st[14], st[15])};
        bf16x8 vf[2][2];
#pragma unroll
        for (int s2 = 0; s2 < 2; ++s2)
#pragma unroll
            for (int vb = 0; vb < 2; ++vb) { const LAS unsigned char* vp = W + HGL_V + vb * 2048 + s2 * 1024 + vrd;
                const v4i16_t lo = __builtin_amdgcn_ds_read_tr16_b64_v4i16((LAS v4i16_t*)vp), hv = __builtin_amdgcn_ds_read_tr16_b64_v4i16((LAS v4i16_t*)(vp + 512));
                vf[s2][vb] = (bf16x8){lo[0], lo[1], lo[2], lo[3], hv[0], hv[1], hv[2], hv[3]}; }
        f32x16 oacc[2];
#pragma unroll
        for (int vb = 0; vb < 2; ++vb) {
#pragma unroll
            for (int r = 0; r < 16; ++r) oacc[vb][r] = 0.f;
#pragma unroll
            for (int s2 = 0; s2 < 2; ++s2) oacc[vb] = __builtin_amdgcn_mfma_f32_32x32x16_bf16(__builtin_bit_cast(bf16x8, pst[s2]), vf[s2][vb], oacc[vb], 0, 0, 0);
        }
#pragma unroll
        for (int kst = 0; kst < 4; ++kst) {
            const u32x2 qa = *(const LAS u32x2*)(W + HGL_QT + r32 * HGL_ROW + (16 * kst + 4 * hi) * 2), qc = *(const LAS u32x2*)(W + HGL_QT + r32 * HGL_ROW + (16 * kst + 8 + 4 * hi) * 2);
            const bf16x8 qf = __builtin_bit_cast(bf16x8, (u32x4){qa.x, qa.y, qc.x, qc.y});
#pragma unroll
            for (int vb = 0; vb < 2; ++vb) { const f32x16& S = Sacc[kst >> 1][vb]; const int o8 = 8 * (kst & 1);
                const u32x4 sp = (u32x4){cvtpk(S[o8 + 0], S[o8 + 1]), cvtpk(S[o8 + 2], S[o8 + 3]), cvtpk(S[o8 + 4], S[o8 + 5]), cvtpk(S[o8 + 6], S[o8 + 7])};
                oacc[vb] = __builtin_amdgcn_mfma_f32_32x32x16_bf16(qf, __builtin_bit_cast(bf16x8, sp), oacc[vb], 0, 0, 0); }
        }
#pragma unroll
        for (int vb = 0; vb < 2; ++vb)
#pragma unroll
            for (int r = 0; r < 16; ++r) { const int t = crow(r, hi); *(float*)((t < nmax ? or8 + (size_t)(((r & 3) + 8 * (r >> 2)) * 1024 + vb * 128) + lof : dmy8 + 4 * lane)) = oacc[vb][r]; }
#pragma unroll
        for (int kb = 0; kb < 2; ++kb) {
            float pe[16];
#pragma unroll
            for (int g = 0; g < 4; ++g) { const f32x4 p4 = *(const LAS f32x4*)(W + HGL_PE + (32 * kb + 8 * g + 4 * hi) * 4); pe[4 * g] = p4[0]; pe[4 * g + 1] = p4[1]; pe[4 * g + 2] = p4[2]; pe[4 * g + 3] = p4[3]; }
            bf16x8 kf[2];
#pragma unroll
            for (int s2 = 0; s2 < 2; ++s2) { const LAS unsigned char* kp = W + HGL_KP + kb * 2048 + s2 * 1024 + vrd;
                const v4i16_t lo = __builtin_amdgcn_ds_read_tr16_b64_v4i16((LAS v4i16_t*)kp), hv = __builtin_amdgcn_ds_read_tr16_b64_v4i16((LAS v4i16_t*)(kp + 512));
                kf[s2] = (bf16x8){lo[0], lo[1], lo[2], lo[3], hv[0], hv[1], hv[2], hv[3]}; }
#pragma unroll
            for (int vb = 0; vb < 2; ++vb) {
#pragma unroll
                for (int r = 0; r < 16; ++r) Sacc[kb][vb][r] *= pe[r];
#pragma unroll
                for (int s2 = 0; s2 < 2; ++s2) Sacc[kb][vb] = __builtin_amdgcn_mfma_f32_32x32x16_bf16(kf[s2], vf[s2][vb], Sacc[kb][vb], 0, 0, 0);
            }
        }
        LDS_WAIT(); asm volatile("" ::: "memory");
        tb += n;
    }
    char* send8 = (char*)((float*)(F.ws + WS_SEND2) + (size_t)(bh * HG_NSEG + seg) * 4096);
    const unsigned lsf = (unsigned)(4 * hi * 64 + r32) * 4u;
#pragma unroll
    for (int kb = 0; kb < 2; ++kb)
#pragma unroll
        for (int vb = 0; vb < 2; ++vb)
#pragma unroll
            for (int r = 0; r < 16; ++r) *(float*)(send8 + (size_t)((32 * kb + (r & 3) + 8 * (r >> 2)) * 256 + vb * 128) + lsf) = Sacc[kb][vb][r];
    ((float*)(F.ws + WS_PSEG))[(bh * HG_NSEG + seg) * 64 + lane] = Pseg;
    return hacc;
}
__device__ __forceinline__ void hg_fix_phase(const Frame& F, int l) {
    const int lane = F.lane, r16 = lane & 15, q4 = lane >> 4, tid = F.tid;
    LAS bf16_t* ST = (LAS bf16_t*)(F.lds);
    const float* oraw = (const float*)(F.ws + WS_ORAW); const bf16_t* proj = (const bf16_t*)(F.ws + WS_PA); bf16_t* mixed = (bf16_t*)(F.ws + WS_MIXED);
    const bf16_t* QE = (const bf16_t*)(F.ws + WS_QE); const float* SEND = (const float*)(F.ws + WS_SEND2); const float* PSEG = (const float*)(F.ws + WS_PSEG);
    for (int uu = F.bid; uu < 32 * (HG_NSEG / 4) * DUP(7); uu += F.G) {
        const int u = uu % (32 * (HG_NSEG / 4)), grp = u & 7, bh = u >> 3, b = bh >> 2, hd = bh & 3;
        const int k = tid >> 3, v8 = (tid & 7) * 8; float S[8];
#pragma unroll
        for (int i = 0; i < 8; ++i) S[i] = 0.f;
#pragma unroll 4
        for (int sp = 0; sp < 4 * grp; ++sp) { const float P = PSEG[(bh * HG_NSEG + sp) * 64 + k]; const float* se = SEND + ((size_t)(bh * HG_NSEG + sp) * 64 + k) * 64 + v8;
            const f32x4 a = *(const f32x4*)se, c = *(const f32x4*)(se + 4);
            S[0] = P * S[0] + a[0]; S[1] = P * S[1] + a[1]; S[2] = P * S[2] + a[2]; S[3] = P * S[3] + a[3]; S[4] = P * S[4] + c[0]; S[5] = P * S[5] + c[1]; S[6] = P * S[6] + c[2]; S[7] = P * S[7] + c[3]; }
#pragma unroll 1
        for (int sq = 0; sq < 4; ++sq) {
            const int seg = 4 * grp + sq;
            const float Pn = PSEG[(bh * HG_NSEG + seg) * 64 + k]; const float* sen = SEND + ((size_t)(bh * HG_NSEG + seg) * 64 + k) * 64 + v8;
            const f32x4 an = *(const f32x4*)sen, cn4 = *(const f32x4*)(sen + 4);
            u32x4 qev[2];
#pragma unroll
            for (int kst = 0; kst < 2; ++kst) qev[kst] = *(const u32x4*)(QE + ((size_t)b * SEQ + seg * HG_SEG + F.wave * 16 + r16) * 256 + hd * 64 + 32 * kst + 8 * q4);
            if (seg > 0) {
#pragma unroll
                for (int i = 0; i < 8; ++i) ST[(v8 + i) * 72 + k] = f2bf(S[i]);
            }
            __syncthreads();
            {
                const size_t tok0 = (size_t)b * SEQ + seg * HG_SEG + F.wave * 16;
                f32x4 acc[4];
#pragma unroll
                for (int vb = 0; vb < 4; ++vb) acc[vb] = (f32x4){0.f, 0.f, 0.f, 0.f};
                if (seg > 0) {
#pragma unroll
                    for (int kst = 0; kst < 2; ++kst) { const bf16x8 af = __builtin_bit_cast(bf16x8, qev[kst]);
#pragma unroll
                        for (int vb = 0; vb < 4; ++vb) { const bf16x8 bfv = *(const LAS bf16x8*)(ST + (vb * 16 + r16) * 72 + 32 * kst + 8 * q4); acc[vb] = __builtin_amdgcn_mfma_f32_16x16x32_bf16(af, bfv, acc[vb], 0, 0, 0); } }
                }
                float ov[4][4], gv[4][4];
#pragma unroll
                for (int vb = 0; vb < 4; ++vb)
#pragma unroll
                    for (int r = 0; r < 4; ++r) { const size_t tok = tok0 + 4 * q4 + r; ov[vb][r] = oraw[tok * 256 + hd * 64 + vb * 16 + r16]; gv[vb][r] = bf2f(proj[tok * NPROJ + C_GG + hd * 64 + vb * 16 + r16]); }
                float gnv[4];
#pragma unroll
                for (int vb = 0; vb < 4; ++vb) gnv[vb] = inp(F, I_hgrn_gain)[l * 256 + hd * 64 + vb * 16 + r16];
                __builtin_amdgcn_sched_barrier(0);
                float ss[4] = {0.f, 0.f, 0.f, 0.f};
#pragma unroll
                for (int vb = 0; vb < 4; ++vb)
#pragma unroll
                    for (int r = 0; r < 4; ++r) { const float x = acc[vb][r] + ov[vb][r]; acc[vb][r] = x; ss[r] += x * x; }
#pragma unroll
                for (int r = 0; r < 4; ++r) { float t = ss[r]; t += __shfl_xor(t, 1); t += __shfl_xor(t, 2); t += __shfl_xor(t, 4); t += __shfl_xor(t, 8); ss[r] = 1.0f / sqrtf(t * (1.0f / 64.0f) + RMS_EPS); }
#pragma unroll
                for (int vb = 0; vb < 4; ++vb) { const float gn = gnv[vb];
#pragma unroll
                    for (int r = 0; r < 4; ++r) { const size_t tok = tok0 + 4 * q4 + r; const float g = gv[vb][r];
                        const float si = g * __builtin_amdgcn_rcpf(1.0f + __builtin_amdgcn_exp2f(-LOG2E * g)); ((unsigned char*)mixed)[tok * D + 512 + hd * 64 + vb * 16 + r16] = (unsigned char)(pk4_fp8_sat(acc[vb][r] * ss[r] * gn * si * MIX_SCALE, 0.f, 0.f, 0.f) & 0xffu); } }
            }
            __syncthreads();
            S[0] = Pn * S[0] + an[0]; S[1] = Pn * S[1] + an[1]; S[2] = Pn * S[2] + an[2]; S[3] = Pn * S[3] + an[3]; S[4] = Pn * S[4] + cn4[0]; S[5] = Pn * S[5] + cn4[1]; S[6] = Pn * S[6] + cn4[2]; S[7] = Pn * S[7] + cn4[3];
        }
    }
}
constexpr int PL_ROW = 136, PL_BYTES = 64 * PL_ROW;
static_assert(NWAVES * PL_BYTES <= PH_BYTES, "pool LDS");
static_assert(NWAVES * (32 * P0_ROWB) + 2 * P0_IMG_BYTES <= PH_BYTES, "prologue LDS");
template <int W> __device__ __forceinline__ void pool_body(const Frame& F, int l, int b, int g, int seg) {
    const int lane = F.lane, r32 = lane & 31, hi = lane >> 5, t0 = seg * 64;
    LAS unsigned char* PT = F.lds + F.wave * PL_BYTES;
    const char* ub = (const char*)((const bf16_t*)(F.ws + WS_PA) + (size_t)b * SEQ * NPROJ + C_PU + g * 64);
    const unsigned lo2 = (unsigned)lane * 2u;
    float uv[80]; bf16_t ur[80];
    __builtin_amdgcn_sched_barrier(0);
#pragma unroll
    for (int i = 0; i < 80; ++i) { const int t = t0 - 16 + i; ur[i] = *(const bf16_t*)(ub + (size_t)(t < 0 ? 0 : t) * (NPROJ * 2) + lo2); }
    __builtin_amdgcn_sched_barrier(0);
#pragma unroll
    for (int i = 0; i < 80; ++i) { const int t = t0 - 16 + i; uv[i] = (t >= 0) ? bf2f(ur[i]) : 0.f; }
    float wsum = 0.f;
#pragma unroll
    for (int i = 1; i <= W; ++i) wsum += uv[16 - i];
#pragma unroll
    for (int i = 0; i < 64; ++i) { const float ut = uv[16 + i]; wsum += ut; wsum -= uv[16 + i - W];
        const int t = t0 + i; const float pooled = wsum / (float)((t + 1 < W) ? (t + 1) : W) - ut;
        *(LAS bf16_t*)(PT + i * PL_ROW + lane * 2) = f2bf(pooled); }
    LDS_WAIT(); asm volatile("" ::: "memory");
    const bf16_t* pwt = (const bf16_t*)(F.ws + WS_PWT) + (size_t)(l * 4 + g) * 4096;
    bf16x8 bw[2][4];
#pragma unroll
    for (int db = 0; db < 2; ++db)
#pragma unroll
        for (int st = 0; st < 4; ++st) bw[db][st] = __builtin_bit_cast(bf16x8, *(const u32x4*)(pwt + (32 * db + r32) * 64 + 16 * st + 8 * hi));
    unsigned char* ob = (unsigned char*)(F.ws + WS_MIXED) + ((size_t)b * SEQ + t0) * D + 768 + g * 64;
    const unsigned lof = (unsigned)(4 * hi * D + r32);
#pragma unroll
    for (int tb2 = 0; tb2 < 2; ++tb2)
#pragma unroll
        for (int db = 0; db < 2; ++db) {
            f32x16 acc;
#pragma unroll
            for (int r = 0; r < 16; ++r) acc[r] = 0.f;
#pragma unroll
            for (int st = 0; st < 4; ++st) { const bf16x8 af = *(const LAS bf16x8*)(PT + (32 * tb2 + r32) * PL_ROW + (16 * st + 8 * hi) * 2); acc = __builtin_amdgcn_mfma_f32_32x32x16_bf16(af, bw[db][st], acc, 0, 0, 0); }
            const float psc = inp(F, I_pool_scale)[l * 256 + g * 64 + 32 * db + r32];
#pragma unroll
            for (int r = 0; r < 16; ++r) ob[(size_t)((32 * tb2 + (r & 3) + 8 * (r >> 2)) * D + 32 * db) + lof] = (unsigned char)(pk4_fp8_sat(acc[r] * psc * MIX_SCALE, 0.f, 0.f, 0.f) & 0xffu);
        }
    LDS_WAIT(); asm volatile("" ::: "memory");
}
__device__ __forceinline__ void pool_unit(const Frame& F, int l, int u) {
    const int seg = u & 63, g = (u >> 6) & 3, b = u >> 8;
    if (g == 0) pool_body<2>(F, l, b, g, seg); else if (g == 1) pool_body<4>(F, l, b, g, seg); else if (g == 2) pool_body<8>(F, l, b, g, seg); else pool_body<16>(F, l, b, g, seg);
}

struct Args { const float* in[18]; float* out; unsigned char* ws; int ph_lo, ph_hi; };
constexpr int N_PHASES = 2 + 8 * NL;

__global__ void __launch_bounds__(NTHREADS, 2) trunk_fwd(Args args) {
    extern __shared__ __attribute__((aligned(16))) unsigned char lds_raw[];
    Frame F;
    F.lds = (LAS unsigned char*)lds_raw; F.ws = args.ws; F.ctl = (unsigned*)(args.ws + WS_CTL); F.out = args.out;
    F.tid = threadIdx.x; F.lane = F.tid & 63; F.wave = __builtin_amdgcn_readfirstlane(F.tid >> 6);
    for (int u = F.tid; u < (LDS_BYTES - LDSCTL_OFF) / 4; u += NTHREADS) ((LAS unsigned*)(F.lds + LDSCTL_OFF))[u] = 0u;
    __syncthreads();
    if (F.tid == 0) {
#pragma unroll
        for (int i = 0; i < 18; ++i) ((LAS unsigned long long*)(F.lds + LDSCTL_OFF + LC_INP))[i] = (unsigned long long)args.in[i];
    }
    __syncthreads();
    const int lo = args.ph_lo, hi = args.ph_hi; const bool use_bar = (hi - lo) > 1;
    XcdBarrier bar; bar.bar = F.ctl + CW_BAR; bar.x = 0; bar.st = nullptr;
    if (use_bar) bar = xcd_barrier_post(F.ctl + CW_BAR, (volatile LAS unsigned*)(F.lds + LDSCTL_OFF + LC_BAR));
#ifndef PHMASK
#define PHMASK 0xFFFF
#endif
#define PM(b) ((PHMASK >> (b)) & 1)
#define FRESH() do { int l_; asm volatile("v_mbcnt_lo_u32_b32 %0, -1, 0\n\tv_mbcnt_hi_u32_b32 %0, -1, %0" : "=v"(l_));     F.lane = l_; F.tid = F.wave * 64 + l_; int b_ = blockIdx.x, g_ = gridDim.x; asm volatile("" : "+s"(b_), "+s"(g_)); F.bid = b_; F.G = g_; } while (0)
#ifndef PROBEMASK
#define PROBEMASK 0
#endif
    unsigned long long probe_acc = 0ull, probe_t0 = 0ull;
#define PB(b) ((PROBEMASK >> (b)) & 1)
#define PROBE_BEGIN(b) do { if (PB(b)) probe_t0 = __builtin_amdgcn_s_memrealtime(); } while (0)
#define PROBE_END(b) do { if (PB(b)) probe_acc += __builtin_amdgcn_s_memrealtime() - probe_t0; } while (0)
#define IN(k) (lo <= (k) && (k) < hi)
#define PTYPE(k) ((k) == 0 ? 0 : (((k) - 1) & 7) + 1)
#define PBS(k) (PB(10) || PB(11 + PTYPE(k)))
#define SEAM(k) do { if (use_bar && (k) + 1 < hi) { if (PBS(k)) probe_t0 = __builtin_amdgcn_s_memrealtime(); int sl_; asm volatile("v_mbcnt_lo_u32_b32 %0, -1, 0\n\tv_mbcnt_hi_u32_b32 %0, -1, %0" : "=v"(sl_)); xcd_barrier(bar, F.wave == 0 && sl_ == 0); if (PBS(k)) probe_acc += __builtin_amdgcn_s_memrealtime() - probe_t0; } } while (0)
    if (IN(0) && PM(0)) { PROBE_BEGIN(0); for (int rep = 0; rep < DUP(5); ++rep) { FRESH(); p0_prologue(F); } PROBE_END(0); SEAM(0); }
    for (int l = 0; l < NL; ++l) {
        const int pb = 1 + 8 * l;
        if (IN(pb + 0) && PM(1)) { FRESH(); PROBE_BEGIN(1); if (l == 0) r_phase<0, false, false>(F, l, inp(F, I_x)); else { if (DUP(6) > 1) r_phase<0, true, true, true>(F, l, nullptr); r_phase<0, true, true>(F, l, nullptr); } PROBE_END(1); SEAM(pb + 0); }
        if (IN(pb + 1) && PM(2)) { FRESH(); PROBE_BEGIN(2);
            cumsum_step(F);
            pg8::StaticOrder S; S.init(T, NPROJ, D, F.G, F.bid, (const bf16_t*)(F.ws + WS_WIN + l * WIN_BYTES)); S.rep = DUP(2);
            pg8::EpiProj E{(bf16_t*)(F.ws + WS_PA), (const float*)(F.ws + WS_RSTD1), F.ctl + CW_KMAX + l * 64 * 16};
            { const unsigned long long ea = pg8::gemm_phase<pg8::EpiProj, pg8::StaticOrder, true>(F.tid, F.lds, (const bf16_t*)(F.ws + WS_HB), D, S, E); if (PROBE_EPI && PROBE_EPI_SEL == 1) probe_acc += ea; }
            PROBE_END(2); SEAM(pb + 1);
        }
        if (IN(pb + 2) && PM(3)) { FRESH(); PROBE_BEGIN(3);
            const int gw = F.bid * NWAVES + F.wave, NGW = F.G * NWAVES;
            if (PB(21)) probe_t0 = __builtin_amdgcn_s_memrealtime();
            for (int u = gw; u < 2048; u += NGW) pool_unit(F, l, u);
            __syncthreads();
            if (PB(21)) probe_acc += __builtin_amdgcn_s_memrealtime() - probe_t0;
            if (PB(22)) probe_t0 = __builtin_amdgcn_s_memrealtime();
            if (F.wave < HG_WAVES) for (int u = F.wave * F.G + F.bid; u < 32 * HG_NSEG * DUP(0); u += HG_WAVES * F.G) { const unsigned long long ha = hg_mfma_unit(F, l, u % (32 * HG_NSEG)); if (PROBE_HG) probe_acc += ha; }
            __syncthreads();
            if (PB(22)) probe_acc += __builtin_amdgcn_s_memrealtime() - probe_t0;
            PROBE_END(3); SEAM(pb + 2);
        }
        if (IN(pb + 3) && PM(4)) { FRESH(); PROBE_BEGIN(4); hg_fix_phase(F, l);
            __syncthreads();
            { LAS int* aq = (LAS int*)(F.lds + LDSCTL_OFF + LC_AQ);
              for (int rep = 0; rep < DUP(1); ++rep)
              for (;;) {
                if (F.tid == 0) aq[0] = (int)__hip_atomic_fetch_add(F.ctl + CW_AQ + 16 * (l + 4 * rep), 1u, __ATOMIC_RELAXED, __HIP_MEMORY_SCOPE_AGENT);
                __syncthreads();
                const int idx = aq[0];
                __syncthreads();
                if (idx >= 1024) break;
                attn_unit(F, l, (idx >> 3) & 7, idx & 7, 15 - (idx >> 6)); } }
            PROBE_END(4); SEAM(pb + 3); }
        if (IN(pb + 4) && PM(5)) { FRESH(); PROBE_BEGIN(5);
            pg8::StaticOrder S; S.init(T, D, D, F.G, F.bid, (const bf16_t*)(F.ws + WS_WOUT + l * WOUT_BYTES)); S.tstep = (size_t)pg8::BM * D;
            pg8::EpiOut E{(bf16_t*)(F.ws + WS_HB)};
            pg8::gemm_phase<pg8::EpiOut, pg8::StaticOrder, true, true>(F.tid, F.lds, F.ws + WS_MIXED, D, S, E);
            PROBE_END(5); SEAM(pb + 4);
        }
        if (IN(pb + 5) && PM(6)) { FRESH(); PROBE_BEGIN(6); if (DUP(6) > 1) r_phase<1, false, true, true>(F, l, nullptr); r_phase<1, false, true>(F, l, nullptr); PROBE_END(6); SEAM(pb + 5); }
        if ((IN(pb + 6) && PM(7)) || (IN(pb + 7) && PM(8))) { FRESH();
            LAS int* tb = (LAS int*)(F.lds + LDSCTL_OFF + LC_TB); LAS int* cn = (LAS int*)(F.lds + LDSCTL_OFF + LC_CN);
            if (F.tid < NE) cn[F.tid] = (int)__hip_atomic_load(F.ctl + CW_CUR + (l * NE + F.tid) * 16, __ATOMIC_RELAXED, __HIP_MEMORY_SCOPE_AGENT);
            __syncthreads();
            if (F.tid == 0) { int a = 0; for (int e = 0; e < NE; ++e) { tb[e] = a; a += (cn[e] + 255) >> 8; } tb[NE] = a; }
            __syncthreads();
            const int ntile = tb[NE];
            LAS unsigned char* te = (LAS unsigned char*)(F.lds + LDSCTL_OFF + LC_TE);
            for (int pm = F.tid; pm < ntile; pm += NTHREADS) { int e = 0; while (e < NE - 1 && tb[e + 1] <= pm) ++e; te[pm] = (unsigned char)e; }
            __syncthreads();
            if (IN(pb + 6) && PM(7)) { PROBE_BEGIN(7);
                typedef pg8::MoeOrder<true, W1E_BYTES, (size_t)256 * D> Ord1; Ord1 S; S.rep = DUP(3); S.nM = ntile; S.nN = 2 * FF / 256; S.nwg = S.nM * S.nN; S.G = F.G; S.c = F.bid; S.Wt = (const char*)(F.ws + WS_W1 + (size_t)l * NE * W1E_BYTES);
                S.tb = tb; S.cn = cn; S.te = te; S.list = (const u32x2*)(F.ws + WS_LIST);
                pg8::EpiGlu E{(unsigned char*)(F.ws + WS_PA), (const u32x2*)(F.ws + WS_LIST), (const float*)(F.ws + WS_B1R) + (size_t)l * NE * 2048};
                pg8::gemm_phase<pg8::EpiGlu, Ord1, true, true>(F.tid, F.lds, F.ws + WS_HB8, D, S, E);
                PROBE_END(7); SEAM(pb + 6);
            }
            if (IN(pb + 7) && PM(8)) { FRESH(); PROBE_BEGIN(8);
                typedef pg8::MoeOrder<false, W2E_BYTES, (size_t)256 * FF> Ord2; Ord2 S; S.rep = DUP(4); S.nM = ntile; S.nN = D / 256; S.nwg = S.nM * S.nN; S.G = F.G; S.c = F.bid; S.Wt = (const char*)(F.ws + WS_W2 + (size_t)l * NE * W2E_BYTES);
                S.tb = tb; S.cn = cn; S.te = te; S.list = (const u32x2*)(F.ws + WS_LIST);
                pg8::EpiDown E{(unsigned char*)(F.ws + WS_Y), (const u32x2*)(F.ws + WS_LIST), (const float*)(F.ws + WS_GLIST), inp(F, I_b2) + (size_t)l * NE * D};
                { const unsigned long long ea = pg8::gemm_phase<pg8::EpiDown, Ord2, true, true>(F.tid, F.lds, F.ws + WS_PA, FF, S, E); if (PROBE_EPI && PROBE_EPI_SEL == 3) probe_acc += ea; }
                PROBE_END(8); SEAM(pb + 7);
            }
        }
    }
    if (IN(N_PHASES - 1) && PM(9)) { FRESH(); PROBE_BEGIN(9); r_final(F); PROBE_END(9); }
#ifndef PROBE_BLOCK
#define PROBE_BLOCK 0
#endif
    if ((PROBEMASK != 0 || PROBE_EPI || PROBE_HG) && blockIdx.x == PROBE_BLOCK) { const unsigned long long tw = __builtin_amdgcn_s_memrealtime(); while (__builtin_amdgcn_s_memrealtime() - tw < probe_acc) __builtin_amdgcn_s_sleep(8); }
#undef IN
#undef SEAM
}

extern "C" void kernel_launch(void* const* d_in, const int* in_sizes, int n_in, void* d_out, int out_size, void* d_ws, size_t ws_size, hipStream_t stream) {
    static int grid = 0;
    if (grid == 0) {
        if (n_in != 18 || out_size != T * D || ws_size < WS_END) { fprintf(stderr, "kernel_launch: unexpected shapes (n_in %d out %d ws %zu need %zu)\n", n_in, out_size, ws_size, (size_t)WS_END); grid = -1; return; }
        int dev = 0, cus = 0;
        if (hipGetDevice(&dev) != hipSuccess || hipDeviceGetAttribute(&cus, hipDeviceAttributeMultiprocessorCount, dev) != hipSuccess) { grid = -1; return; }
        if (hipFuncSetAttribute((const void*)trunk_fwd, hipFuncAttributeMaxDynamicSharedMemorySize, LDS_BYTES) != hipSuccess) { fprintf(stderr, "kernel_launch: hipFuncSetAttribute failed\n"); grid = -1; return; }
        int per_cu = 0;
        if (hipOccupancyMaxActiveBlocksPerMultiprocessor(&per_cu, (const void*)trunk_fwd, NTHREADS, LDS_BYTES) != hipSuccess || per_cu < 1) { fprintf(stderr, "kernel_launch: occupancy query says %d\n", per_cu); (void)hipGetLastError(); }
        grid = cus;
    }
    if (grid < 0) return;
    (void)hipMemsetAsync((char*)d_ws + WS_CTL, 0, CTL_ZERO_BYTES, stream);
    Args a{};
    for (int i = 0; i < 18; ++i) a.in[i] = (const float*)d_in[i];
    a.out = (float*)d_out; a.ws = (unsigned char*)d_ws;
#if MK_SPLIT
    for (int p = 0; p < N_PHASES; ++p) { a.ph_lo = p; a.ph_hi = p + 1; hipLaunchKernelGGL(trunk_fwd, dim3(grid), dim3(NTHREADS), LDS_BYTES, stream, a); }
#else
    a.ph_lo = 0; a.ph_hi = N_PHASES; hipLaunchKernelGGL(trunk_fwd, dim3(grid), dim3(NTHREADS), LDS_BYTES, stream, a);
#endif
}
```
